# Optimizing an MI355X kernel written in HIP

```python
import math
import jax, jax.numpy as jnp
from jax import lax
import numpy as np

D_MODEL = 1024
BATCH = 8
SEQ = 8192
DEPTH = 1

ATT_HEADS = 8
HEAD_DIM = 64
ATT_WIDTH = ATT_HEADS * HEAD_DIM
ATT_UP_DIM = D_MODEL // ATT_HEADS
BLOCK_Q = 128
POOL_WINDOWS = (2, 4, 8, 16)
POOL_GROUPS = len(POOL_WINDOWS)
POOL_GROUP_DIM = 128
POOL_WIDTH = POOL_GROUPS * POOL_GROUP_DIM
POOL_UP_DIM = D_MODEL // POOL_GROUPS
IN_SPLITS = (ATT_WIDTH, 2 * ATT_WIDTH, 3 * ATT_WIDTH, 3 * ATT_WIDTH + POOL_WIDTH,
             3 * ATT_WIDTH + POOL_WIDTH + D_MODEL)
IN_WIDTH = 3 * ATT_WIDTH + POOL_WIDTH + 2 * D_MODEL
N_KEYS = 128
N_EXPERTS = N_KEYS * N_KEYS
PEER_HEADS = 8
PEER_QUERY_DIM = 256
PEER_HALF_DIM = PEER_QUERY_DIM // 2
PEER_TOPK = 16
PEER_CHUNK = 128
PLE_DIM = 256
EPS = 1e-6

kernel_name = "hybrid_stickbreak_pool_peer_block"


def rmsnorm(x, g):
    xf = x.astype(jnp.float32)
    xf = xf * lax.rsqrt(jnp.mean(xf * xf, axis=-1, keepdims=True) + EPS)
    return xf.astype(x.dtype) * g


def stick_breaking_attention(q, k, v):
    B, S, H, dh = q.shape
    nb = S // BLOCK_Q
    scale = dh ** -0.5
    qb = q.reshape(B, nb, BLOCK_Q, H, dh).transpose(1, 0, 3, 2, 4)
    kt = k.transpose(0, 2, 1, 3)
    vt = v.transpose(0, 2, 1, 3)
    offs = jnp.arange(BLOCK_Q, dtype=jnp.int32)

    def one_query_block(args):
        i, q_blk = args
        q_pos = i * BLOCK_Q + offs

        def body(n, carry):
            acc, logsurv = carry
            j = i - n
            k_blk = lax.dynamic_slice_in_dim(kt, j * BLOCK_Q, BLOCK_Q, axis=2)
            v_blk = lax.dynamic_slice_in_dim(vt, j * BLOCK_Q, BLOCK_Q, axis=2)
            z = jnp.einsum('bhqd,bhkd->bhqk', q_blk, k_blk).astype(jnp.float32) * scale
            k_pos = j * BLOCK_Q + offs
            mask = k_pos[None, :] < q_pos[:, None]
            log_1m = jnp.where(mask, jax.nn.log_sigmoid(-z), 0.0)
            later = lax.cumsum(log_1m, axis=3, reverse=True) - log_1m
            w = jnp.where(mask,
                          jnp.exp(jax.nn.log_sigmoid(z) + later + logsurv[..., None]),
                          0.0)
            acc = acc + jnp.einsum('bhqk,bhkd->bhqd', w, v_blk.astype(jnp.float32))
            return acc, logsurv + jnp.sum(log_1m, axis=-1)

        init = (jnp.zeros((B, H, BLOCK_Q, dh), jnp.float32),
                jnp.zeros((B, H, BLOCK_Q), jnp.float32))
        acc, _ = lax.fori_loop(0, i + 1, body, init)
        return acc

    out = lax.map(one_query_block, (jnp.arange(nb, dtype=jnp.int32), qb))
    return out.transpose(1, 0, 3, 2, 4).reshape(B, S, H, dh).astype(q.dtype)


def multiscale_pool(u):
    B, S, C = u.shape
    uf = u.astype(jnp.float32)
    c0 = jnp.concatenate([jnp.zeros((B, 1, C), jnp.float32), jnp.cumsum(uf, axis=1)], axis=1)
    t = jnp.arange(1, S + 1, dtype=jnp.float32)
    outs = []
    for g, w in enumerate(POOL_WINDOWS):
        cg = c0[..., g * POOL_GROUP_DIM:(g + 1) * POOL_GROUP_DIM]
        lower = jnp.concatenate([jnp.zeros((B, w, POOL_GROUP_DIM), jnp.float32),
                                 cg[:, :S + 1 - w]], axis=1)
        window_sum = (cg - lower)[:, 1:]
        outs.append(window_sum / jnp.minimum(t, float(w))[None, :, None])
    pooled = jnp.concatenate(outs, axis=-1)
    return (pooled - uf).astype(u.dtype)


def peer(h, w_query, sub_keys, expert_u, expert_v):
    B, S, D = h.shape
    hc = h.reshape(-1, PEER_CHUNK, D)

    def one_chunk(h_c):
        q = (h_c @ w_query).reshape(PEER_CHUNK, PEER_HEADS, 2, PEER_HALF_DIM)
        scores = jnp.einsum('thcd,hcnd->thcn', q, sub_keys).astype(jnp.float32)
        s_top, i_top = lax.top_k(scores, PEER_TOPK)
        cand_s = s_top[:, :, 0, :, None] + s_top[:, :, 1, None, :]
        cand_i = i_top[:, :, 0, :, None] * N_KEYS + i_top[:, :, 1, None, :]
        best_s, best_pos = lax.top_k(cand_s.reshape(PEER_CHUNK, PEER_HEADS, -1), PEER_TOPK)
        idx = jnp.take_along_axis(cand_i.reshape(PEER_CHUNK, PEER_HEADS, -1), best_pos, axis=-1)
        gates = jax.nn.softmax(best_s, axis=-1)
        u = jnp.take(expert_u, idx, axis=0)
        act = jax.nn.gelu(jnp.einsum('thkd,td->thk', u, h_c).astype(jnp.float32),
                          approximate=False)
        v = jnp.take(expert_v, idx, axis=0)
        return jnp.einsum('thk,thkd->td', (gates * act).astype(h.dtype), v)

    return lax.map(one_chunk, hc).reshape(B, S, D)


def setup_inputs(seed: int = 0) -> dict:
    key = jax.random.key(seed)
    ks = jax.random.split(key, 20)
    f32 = jnp.float32

    def nrm(k, shape, scale):
        return jax.random.normal(k, shape, f32) * scale

    def gain(k, shape):
        return 1.0 + 0.02 * jax.random.normal(k, shape, f32)

    return {
        "x": nrm(ks[0], (BATCH, SEQ, D_MODEL), 1.0),
        "p": nrm(ks[1], (DEPTH, BATCH, SEQ, PLE_DIM), 1.0),
        "norm_mix": gain(ks[2], (DEPTH, D_MODEL)),
        "w_in": nrm(ks[3], (DEPTH, D_MODEL, IN_WIDTH), D_MODEL ** -0.5),
        "w_att_up": nrm(ks[4], (DEPTH, ATT_HEADS, HEAD_DIM, ATT_UP_DIM), HEAD_DIM ** -0.5),
        "w_pool_group": nrm(ks[5], (DEPTH, POOL_GROUPS, POOL_GROUP_DIM, POOL_UP_DIM),
                            POOL_GROUP_DIM ** -0.5),
        "pool_scale": gain(ks[6], (DEPTH, D_MODEL)),
        "w_out": nrm(ks[7], (DEPTH, D_MODEL, D_MODEL), D_MODEL ** -0.5),
        "norm_ffn": gain(ks[8], (DEPTH, D_MODEL)),
        "w_query": nrm(ks[9], (DEPTH, D_MODEL, PEER_HEADS * PEER_QUERY_DIM), D_MODEL ** -0.5),
        "sub_keys": nrm(ks[10], (DEPTH, PEER_HEADS, 2, N_KEYS, PEER_HALF_DIM),
                        PEER_HALF_DIM ** -0.5),
        "expert_u": nrm(ks[11], (DEPTH, N_EXPERTS, D_MODEL), D_MODEL ** -0.5),
        "expert_v": nrm(ks[12], (DEPTH, N_EXPERTS, D_MODEL), 0.5),
        "norm_ple": gain(ks[13], (DEPTH, D_MODEL)),
        "w_ple_gate": nrm(ks[14], (DEPTH, D_MODEL, D_MODEL), D_MODEL ** -0.5),
        "w_ple": nrm(ks[15], (DEPTH, PLE_DIM, D_MODEL), PLE_DIM ** -0.5),
        "norm_final": gain(ks[16], (D_MODEL,)),
    }


def reference(x, p, norm_mix, w_in, w_att_up, w_pool_group, pool_scale, w_out,
              norm_ffn, w_query, sub_keys, expert_u, expert_v, norm_ple, w_ple_gate,
              w_ple, norm_final):
    B, S, _ = x.shape
    for i in range(DEPTH):
        h = rmsnorm(x, norm_mix[i])
        proj = h @ w_in[i]
        q, k, v, u_pool, g_att, g_pool = jnp.split(proj, IN_SPLITS, axis=-1)
        q = q.reshape(B, S, ATT_HEADS, HEAD_DIM)
        k = k.reshape(B, S, ATT_HEADS, HEAD_DIM)
        v = v.reshape(B, S, ATT_HEADS, HEAD_DIM)
        y_att = stick_breaking_attention(q, k, v)
        a_up = jnp.einsum('bshd,hde->bshe', y_att, w_att_up[i]).reshape(B, S, D_MODEL)
        y_pool = multiscale_pool(u_pool).reshape(B, S, POOL_GROUPS, POOL_GROUP_DIM)
        p_up = jnp.einsum('bsgc,gce->bsge', y_pool, w_pool_group[i]).reshape(B, S, D_MODEL)
        p_up = p_up * pool_scale[i]
        merged = jax.nn.sigmoid(g_att) * a_up + jax.nn.sigmoid(g_pool) * p_up
        x = x + merged @ w_out[i]
        x = x + peer(rmsnorm(x, norm_ffn[i]), w_query[i], sub_keys[i], expert_u[i], expert_v[i])
        gate = jax.nn.sigmoid(rmsnorm(x, norm_ple[i]) @ w_ple_gate[i])
        x = x + gate * (p[i] @ w_ple[i])
    return rmsnorm(x, norm_final)
```

```cpp
#include <hip/hip_runtime.h>
#include <math.h>
#include <stdint.h>

namespace {
constexpr int D = 1024, NB = 8, S = 8192, T = NB * S;
constexpr int INW = 4096;
constexpr int NKEYS = 128, TOPK = 16, PH = 8;
constexpr float EPS = 1e-6f;

__device__ __forceinline__ float wave_sum(float v) {
#pragma unroll
    for (int o = 32; o > 0; o >>= 1) v += __shfl_xor(v, o);
    return v;
}
__device__ __forceinline__ float sigmoidf_(float x) { return 1.f / (1.f + expf(-x)); }

__global__ void __launch_bounds__(256) k_rms(const float* x, const float* g, float* out) {
    __shared__ float red[4];
    const size_t row = blockIdx.x;
    const float4 v = ((const float4*)(x + row * D))[threadIdx.x];
    float s = v.x * v.x + v.y * v.y + v.z * v.z + v.w * v.w;
    s = wave_sum(s);
    if ((threadIdx.x & 63) == 0) red[threadIdx.x >> 6] = s;
    __syncthreads();
    const float tot = red[0] + red[1] + red[2] + red[3];
    const float r = rsqrtf(tot * (1.f / D) + EPS);
    const float4 gg = ((const float4*)g)[threadIdx.x];
    float4 o; o.x = v.x * r * gg.x; o.y = v.y * r * gg.y; o.z = v.z * r * gg.z; o.w = v.w * r * gg.w;
    ((float4*)(out + row * D))[threadIdx.x] = o;
}

struct EpiStore { float* C; int ldc; int pad; __device__ void operator()(int r, int c, float v) const { C[(size_t)r * ldc + c] = v; } };
struct EpiResAdd { const float* R; float* C; int ldc; int pad; __device__ void operator()(int r, int c, float v) const { C[(size_t)r * ldc + c] = R[(size_t)r * ldc + c] + v; } };
struct EpiGate { const float* X; const float* E; float* C; int ldc; int pad;
    __device__ void operator()(int r, int c, float v) const { const size_t o = (size_t)r * ldc + c; C[o] = X[o] + sigmoidf_(v) * E[o]; } };

template <class Epi>
__global__ void __launch_bounds__(256) k_gemm(const float* __restrict__ A, const float* __restrict__ Bm, Epi epi, int lda, int ldb, int K, int pad_) {
    __shared__ float As[8][128 + 4];
    __shared__ float Bs[8][128 + 4];
    const int tid = threadIdx.x, tx = tid & 15, ty = tid >> 4;
    const int m0 = blockIdx.y * 128, n0 = blockIdx.x * 128;
    float acc[8][8];
#pragma unroll
    for (int i = 0; i < 8; ++i)
#pragma unroll
        for (int j = 0; j < 8; ++j) acc[i][j] = 0.f;
    const int ar = tid >> 1, ak = (tid & 1) * 4;
    const int bk = tid >> 5, bn = (tid & 31) * 4;
    for (int k0 = 0; k0 < K; k0 += 8) {
        const float4 av = *(const float4*)(A + (size_t)(m0 + ar) * lda + k0 + ak);
        const float4 bv = *(const float4*)(Bm + (size_t)(k0 + bk) * ldb + n0 + bn);
        As[ak + 0][ar] = av.x; As[ak + 1][ar] = av.y; As[ak + 2][ar] = av.z; As[ak + 3][ar] = av.w;
        *(float4*)&Bs[bk][bn] = bv;
        __syncthreads();
#pragma unroll
        for (int k = 0; k < 8; ++k) {
            const float4 a0 = *(const float4*)&As[k][ty * 8], a1 = *(const float4*)&As[k][ty * 8 + 4];
            const float4 b0 = *(const float4*)&Bs[k][tx * 8], b1 = *(const float4*)&Bs[k][tx * 8 + 4];
            const float a[8] = {a0.x, a0.y, a0.z, a0.w, a1.x, a1.y, a1.z, a1.w};
            const float b[8] = {b0.x, b0.y, b0.z, b0.w, b1.x, b1.y, b1.z, b1.w};
#pragma unroll
            for (int i = 0; i < 8; ++i)
#pragma unroll
                for (int j = 0; j < 8; ++j) acc[i][j] = fmaf(a[i], b[j], acc[i][j]);
        }
        __syncthreads();
    }
#pragma unroll
    for (int i = 0; i < 8; ++i)
#pragma unroll
        for (int j = 0; j < 8; ++j) epi(m0 + ty * 8 + i, n0 + tx * 8 + j, acc[i][j]);
}

__global__ void __launch_bounds__(64) k_attn(const float* __restrict__ proj, float* __restrict__ yatt) {
    const int t = blockIdx.x * 64 + threadIdx.x;
    const int h = blockIdx.y;
    float q[64], acc[64];
    const float* qp = proj + (size_t)t * INW + h * 64;
#pragma unroll
    for (int d = 0; d < 64; ++d) { q[d] = qp[d] * 0.125f; acc[d] = 0.f; }
    float surv = 1.f;
    for (int s = t - 1; s >= 0; --s) {
        const float* kp = proj + (size_t)s * INW + 512 + h * 64;
        float z = 0.f;
#pragma unroll
        for (int d = 0; d < 64; ++d) z = fmaf(q[d], kp[d], z);
        const float beta = 1.f / (1.f + expf(-z));
        const float w = beta * surv;
        const float* vp = kp + 512;
#pragma unroll
        for (int d = 0; d < 64; ++d) acc[d] = fmaf(w, vp[d], acc[d]);
        surv -= w;
        if (surv < 5.4e-20f) break;
    }
    float* o = yatt + (size_t)t * 512 + h * 64;
#pragma unroll
    for (int d = 0; d < 64; ++d) o[d] = acc[d];
}

__global__ void __launch_bounds__(256) k_pool(const float* __restrict__ proj, float* __restrict__ ypool) {
    const int i = blockIdx.x * 256 + threadIdx.x;
    const int t = i >> 9, c = i & 511, g = c >> 7, w = 2 << g;
    const int cnt = (t + 1 < w) ? (t + 1) : w;
    float s = 0.f;
    for (int j = 0; j < cnt; ++j) s += proj[(size_t)(t - j) * INW + 1536 + c];
    ypool[i] = s / (float)cnt - proj[(size_t)t * INW + 1536 + c];
}

__global__ void __launch_bounds__(256) k_merge(const float* __restrict__ proj, const float* __restrict__ yatt, const float* __restrict__ ypool,
                                               const float* __restrict__ wa, const float* __restrict__ wp, const float* __restrict__ pscale, float* __restrict__ merged) {
    const int t = blockIdx.x, tid = threadIdx.x;
    __shared__ float sa[512], sp[512];
    sa[tid] = yatt[(size_t)t * 512 + tid]; sa[tid + 256] = yatt[(size_t)t * 512 + tid + 256];
    sp[tid] = ypool[(size_t)t * 512 + tid]; sp[tid + 256] = ypool[(size_t)t * 512 + tid + 256];
    __syncthreads();
    for (int e = tid; e < D; e += 256) {
        const int h = e >> 7, ea = e & 127, g = e >> 8, ep = e & 255;
        float a = 0.f, p = 0.f;
        for (int d = 0; d < 64; ++d) a = fmaf(sa[h * 64 + d], wa[((size_t)h * 64 + d) * 128 + ea], a);
        for (int c = 0; c < 128; ++c) p = fmaf(sp[g * 128 + c], wp[((size_t)g * 128 + c) * 256 + ep], p);
        p *= pscale[e];
        const float ga = proj[(size_t)t * INW + 2048 + e], gp = proj[(size_t)t * INW + 3072 + e];
        merged[(size_t)t * D + e] = sigmoidf_(ga) * a + sigmoidf_(gp) * p;
    }
}

__global__ void __launch_bounds__(256) k_scores(const float* __restrict__ qp, const float* __restrict__ sk, float* __restrict__ sc) {
    const int t0 = blockIdx.x * 4, tid = threadIdx.x;
    __shared__ float sq[4][2048];
    for (int i = tid; i < 4 * 2048; i += 256) sq[i >> 11][i & 2047] = qp[(size_t)t0 * 2048 + i];
    __syncthreads();
    for (int j = tid; j < 2048; j += 256) {
        const int g = j >> 7;
        const float4* kr = (const float4*)(sk + (size_t)j * 128);
        float a0 = 0.f, a1 = 0.f, a2 = 0.f, a3 = 0.f;
        for (int d = 0; d < 32; ++d) {
            const float4 kv = kr[d];
            const float4 q0 = *(const float4*)&sq[0][g * 128 + d * 4], q1 = *(const float4*)&sq[1][g * 128 + d * 4];
            const float4 q2 = *(const float4*)&sq[2][g * 128 + d * 4], q3 = *(const float4*)&sq[3][g * 128 + d * 4];
            a0 = fmaf(q0.x, kv.x, a0); a0 = fmaf(q0.y, kv.y, a0); a0 = fmaf(q0.z, kv.z, a0); a0 = fmaf(q0.w, kv.w, a0);
            a1 = fmaf(q1.x, kv.x, a1); a1 = fmaf(q1.y, kv.y, a1); a1 = fmaf(q1.z, kv.z, a1); a1 = fmaf(q1.w, kv.w, a1);
            a2 = fmaf(q2.x, kv.x, a2); a2 = fmaf(q2.y, kv.y, a2); a2 = fmaf(q2.z, kv.z, a2); a2 = fmaf(q2.w, kv.w, a2);
            a3 = fmaf(q3.x, kv.x, a3); a3 = fmaf(q3.y, kv.y, a3); a3 = fmaf(q3.z, kv.z, a3); a3 = fmaf(q3.w, kv.w, a3);
        }
        sc[(size_t)(t0 + 0) * 2048 + j] = a0; sc[(size_t)(t0 + 1) * 2048 + j] = a1;
        sc[(size_t)(t0 + 2) * 2048 + j] = a2; sc[(size_t)(t0 + 3) * 2048 + j] = a3;
    }
}

__device__ __forceinline__ void wave_argmax(float& v, int& i) {
#pragma unroll
    for (int o = 32; o > 0; o >>= 1) {
        const float ov = __shfl_xor(v, o); const int oi = __shfl_xor(i, o);
        if (ov > v || (ov == v && oi < i)) { v = ov; i = oi; }
    }
}

__global__ void __launch_bounds__(256) k_topk(const float* __restrict__ sc, int* __restrict__ idx, float* __restrict__ gates) {
    const int wv = threadIdx.x >> 6, lane = threadIdx.x & 63;
    const int pair = blockIdx.x * 4 + wv;
    const int t = pair >> 3, h = pair & 7;
    __shared__ float stop[4][2][16];
    __shared__ int itop[4][2][16];
    for (int c = 0; c < 2; ++c) {
        const float* sr = sc + (size_t)t * 2048 + (h * 2 + c) * 128;
        float v0 = sr[lane], v1 = sr[lane + 64];
        for (int k = 0; k < TOPK; ++k) {
            float bv; int bi;
            if (v1 > v0) { bv = v1; bi = lane + 64; } else { bv = v0; bi = lane; }
            wave_argmax(bv, bi);
            if (lane == 0) { stop[wv][c][k] = bv; itop[wv][c][k] = bi; }
            if (bi == lane) v0 = -INFINITY;
            if (bi == lane + 64) v1 = -INFINITY;
        }
    }
    __syncthreads();
    float cv[4];
#pragma unroll
    for (int j = 0; j < 4; ++j) { const int p = lane + 64 * j; cv[j] = stop[wv][0][p >> 4] + stop[wv][1][p & 15]; }
    __shared__ float sbs[4][16];
    __shared__ int sbp[4][16];
    for (int k = 0; k < TOPK; ++k) {
        float bv = cv[0]; int bi = lane;
#pragma unroll
        for (int j = 1; j < 4; ++j) if (cv[j] > bv) { bv = cv[j]; bi = lane + 64 * j; }
        wave_argmax(bv, bi);
        if (lane == 0) { sbs[wv][k] = bv; sbp[wv][k] = bi; }
#pragma unroll
        for (int j = 0; j < 4; ++j) if (bi == lane + 64 * j) cv[j] = -INFINITY;
    }
    __syncthreads();
    const float mx = sbs[wv][0];
    const float myv = (lane < TOPK) ? sbs[wv][lane] : -INFINITY;
    const float ex = (lane < TOPK) ? expf(myv - mx) : 0.f;
    const float den = wave_sum(ex);
    if (lane < TOPK) {
        const int myp = sbp[wv][lane];
        const int e = itop[wv][0][myp >> 4] * NKEYS + itop[wv][1][myp & 15];
        idx[(size_t)t * 128 + h * 16 + lane] = e;
        gates[(size_t)t * 128 + h * 16 + lane] = ex / den;
    }
}

__global__ void __launch_bounds__(256) k_peer(const float* __restrict__ hn, const int* __restrict__ idx, const float* __restrict__ gates,
                                              const float* __restrict__ eu, const float* __restrict__ ev, float* xio) {
    const int t = blockIdx.x, tid = threadIdx.x, wv = tid >> 6, lane = tid & 63;
    __shared__ float coef[128];
    __shared__ int sidx[128];
    const float4* hr = (const float4*)(hn + (size_t)t * D);
    float4 hv[4];
#pragma unroll
    for (int j = 0; j < 4; ++j) hv[j] = hr[lane + 64 * j];
    if (tid < 128) sidx[tid] = idx[(size_t)t * 128 + tid];
    __syncthreads();
    for (int p = wv; p < 128; p += 4) {
        const float4* ur = (const float4*)(eu + (size_t)sidx[p] * D);
        float s = 0.f;
#pragma unroll
        for (int j = 0; j < 4; ++j) { const float4 u = ur[lane + 64 * j]; s += u.x * hv[j].x + u.y * hv[j].y + u.z * hv[j].z + u.w * hv[j].w; }
        s = wave_sum(s);
        const float act = 0.5f * s * (1.f + erff(s * 0.70710678118654752f));
        if (lane == 0) coef[p] = gates[(size_t)t * 128 + p] * act;
    }
    __syncthreads();
    float4 o = ((const float4*)(xio + (size_t)t * D))[tid];
    for (int p = 0; p < 128; ++p) {
        const float c = coef[p];
        const float4 v = ((const float4*)(ev + (size_t)sidx[p] * D))[tid];
        o.x = fmaf(c, v.x, o.x); o.y = fmaf(c, v.y, o.y); o.z = fmaf(c, v.z, o.z); o.w = fmaf(c, v.w, o.w);
    }
    ((float4*)(xio + (size_t)t * D))[tid] = o;
}
}

extern "C" void kernel_launch(void* const* d_in, const int* in_sizes, int n_in, void* d_out, int out_size, void* d_ws, size_t ws_size, hipStream_t stream) {
    const float* x = (const float*)d_in[0];
    const float* p = (const float*)d_in[1];
    const float* norm_mix = (const float*)d_in[2];
    const float* w_in = (const float*)d_in[3];
    const float* w_att_up = (const float*)d_in[4];
    const float* w_pool_group = (const float*)d_in[5];
    const float* pool_scale = (const float*)d_in[6];
    const float* w_out = (const float*)d_in[7];
    const float* norm_ffn = (const float*)d_in[8];
    const float* w_query = (const float*)d_in[9];
    const float* sub_keys = (const float*)d_in[10];
    const float* expert_u = (const float*)d_in[11];
    const float* expert_v = (const float*)d_in[12];
    const float* norm_ple = (const float*)d_in[13];
    const float* w_ple_gate = (const float*)d_in[14];
    const float* w_ple = (const float*)d_in[15];
    const float* norm_final = (const float*)d_in[16];
    float* out = (float*)d_out;
    char* ws = (char*)d_ws;
    constexpr size_t MiB = 1u << 20;
    float* hbuf = (float*)(ws + 0 * MiB);
    float* proj = (float*)(ws + 32 * MiB);
    float* yatt = (float*)(ws + 160 * MiB);
    float* ypool = (float*)(ws + 176 * MiB);
    float* merged = (float*)(ws + 192 * MiB);
    float* qp = (float*)(ws + 224 * MiB);
    float* sc = (float*)(ws + 288 * MiB);
    int* idx = (int*)(ws + 352 * MiB);
    float* gates = (float*)(ws + 356 * MiB);
    float* ebuf = (float*)(ws + 360 * MiB);
    for (int b = 0; b < NB; ++b) {
        const float* xb = x + (size_t)b * S * D;
        const float* pb = p + (size_t)b * S * 256;
        float* ob = out + (size_t)b * S * D;
        k_rms<<<S, 256, 0, stream>>>(xb, norm_mix, hbuf);
        k_gemm<EpiStore><<<dim3(INW / 128, S / 128), 256, 0, stream>>>(hbuf, w_in, EpiStore{proj, INW}, D, INW, D, 0);
        k_attn<<<dim3(S / 64, 8), 64, 0, stream>>>(proj, yatt);
        k_pool<<<S * 512 / 256, 256, 0, stream>>>(proj, ypool);
        k_merge<<<S, 256, 0, stream>>>(proj, yatt, ypool, w_att_up, w_pool_group, pool_scale, merged);
        k_gemm<EpiResAdd><<<dim3(D / 128, S / 128), 256, 0, stream>>>(merged, w_out, EpiResAdd{xb, ob, D}, D, D, D, 0);
        k_rms<<<S, 256, 0, stream>>>(ob, norm_ffn, hbuf);
        k_gemm<EpiStore><<<dim3(2048 / 128, S / 128), 256, 0, stream>>>(hbuf, w_query, EpiStore{qp, 2048}, D, 2048, D, 0);
        k_scores<<<S / 4, 256, 0, stream>>>(qp, sub_keys, sc);
        k_topk<<<S * 8 / 4, 256, 0, stream>>>(sc, idx, gates);
        k_peer<<<S, 256, 0, stream>>>(hbuf, idx, gates, expert_u, expert_v, ob);
        k_rms<<<S, 256, 0, stream>>>(ob, norm_ple, hbuf);
        k_gemm<EpiStore><<<dim3(D / 128, S / 128), 256, 0, stream>>>(pb, w_ple, EpiStore{ebuf, D}, 256, D, 256, 0);
        k_gemm<EpiGate><<<dim3(D / 128, S / 128), 256, 0, stream>>>(hbuf, w_ple_gate, EpiGate{ob, ebuf, ob, D}, D, D, D, 0);
        k_rms<<<S, 256, 0, stream>>>(ob, norm_final, ob);
    }
}
```

```cpp
#include <hip/hip_runtime.h>
#include <cstdio>
#include <cstdint>
#include <math.h>
__device__ __forceinline__ int otid() { int t = threadIdx.x; asm volatile("" : "+v"(t)); return t; }

namespace pg8 {
#define PG8_LAS __attribute__((address_space(3)))
typedef unsigned short bf16_t;
typedef short bf16x8 __attribute__((ext_vector_type(8)));
typedef float f32x4 __attribute__((ext_vector_type(4)));
typedef unsigned u32x4 __attribute__((ext_vector_type(4)));
constexpr int BM = 256, BK = 64, HALF = 128, HTB = HALF * BK * 2  , STAGE_BYTES = 8 * HTB, NXCD = 8, WGM = 8;

__host__ __device__ __forceinline__ int lds_byte(int r, int c) { const int st = (r >> 4) * 2 + (c >> 5), rr = r & 15, cc = c & 31, ob = rr * 64 + cc * 2; return st * 1024 + (ob ^ (((ob >> 9) & 1) << 5)); }
__host__ __device__ __forceinline__ void stage_rc(int b, int& R, int& C) { const int st = b / 1024, sb = b % 1024, swz = sb ^ (((sb >> 9) & 1) << 5); R = (st >> 1) * 16 + swz / 64; C = (st & 1) * 32 + (swz % 64) / 2; }
__host__ __device__ __forceinline__ int perm32(int rho) { const int n = rho >> 4, i = rho & 15; return 8 * (i >> 2) + 4 * n + (i & 3); }

struct Unit { int pm, pn; };
struct Gemm { const bf16_t* A; const bf16_t* Bt; int K, lda, ldb, akoff; };

struct StaticOrder {
    int nM, nN, nwg, G, c;
    __host__ __device__ void init(int M, int N, int G_, int c_) { nM = M / BM; nN = N / BM; nwg = nM * nN; G = G_; c = c_; }
    __host__ __device__ bool next(int i, Unit& u) const {
        const long L = (long)i * G + c; if (L >= nwg) return false;
        int wgid = (int)L; { const int q = nwg / NXCD, r = nwg % NXCD, xcd = wgid % NXCD, off = wgid / NXCD; wgid = (xcd < r ? xcd * (q + 1) : r * (q + 1) + (xcd - r) * q) + off; }
        const int nig = WGM * nN, gid = wgid / nig, fm = gid * WGM, gsz = (nM - fm) < WGM ? (nM - fm) : WGM;
        u.pm = fm + ((wgid % nig) % gsz); u.pn = (wgid % nig) / gsz; return true;
    }
    __device__ __forceinline__ void a_ready(const Unit&) const {}
    __device__ __forceinline__ void done(const Unit&) const {}
};

template <class Epi, class Sched, bool ALIGN_EPI = false, bool SP2 = false>
__device__ __forceinline__ void gemm_phase(PG8_LAS unsigned char* lds, const Gemm g, const Sched& S, const Epi& E) {
    const int tid = otid(), wid = __builtin_amdgcn_readfirstlane(tid >> 6), lane = tid & 63, wr = wid >> 2, wc = wid & 3, fr = lane & 15, fq = lane >> 4;
    const int K = g.K, nt = K / BK;
    unsigned voffA[2], voffB[2];
#pragma unroll
    for (int i = 0; i < 2; ++i) { int R, C; stage_rc(tid * 16 + i * 8192, R, C); const int Rb = Epi::PERM ? ((R & ~31) + perm32(R & 31)) : R;
        voffA[i] = (unsigned)(R * g.lda + C) * 2u; voffB[i] = (unsigned)(Rb * g.ldb + C) * 2u; }
    const size_t kstep = (size_t)(BK * 2);
    const size_t hstepA = (size_t)HALF * g.lda * 2, hstepB = (size_t)HALF * g.ldb * 2;
    const size_t tstepA = 2 * hstepA, tstepB = 2 * hstepB, akb = (size_t)g.akoff * 2;
    const unsigned ldsw = (unsigned)wid * 1024u;
    const int aoff = lds_byte(wr * 64 + fr, fq * 8), boff = lds_byte(wc * 32 + fr, fq * 8);
#define PG8_SA(b, h) (((b) * 2 + (h)) * HTB)
#define PG8_SB(b, h) ((4 + (b) * 2 + (h)) * HTB)
#define PG8_STAGE(bufoff, gbase, voff) do { _Pragma("unroll") for (int _i = 0; _i < 2; ++_i) \
        __builtin_amdgcn_global_load_lds((const unsigned*)((const char*)(gbase) + (voff)[_i]), (PG8_LAS unsigned*)(lds + (bufoff) + ldsw + _i * 8192), 16, 0, 0); } while (0)
#define PG8_LDA(dst, b, h) do { _Pragma("unroll") for (int m = 0; m < 4; ++m) _Pragma("unroll") for (int k = 0; k < 2; ++k) dst[m][k] = *(const PG8_LAS bf16x8*)(lds + PG8_SA(b, h) + aoff + m * 2048 + k * 1024); } while (0)
#define PG8_LDB(dst, b, h) do { _Pragma("unroll") for (int n = 0; n < 2; ++n) _Pragma("unroll") for (int k = 0; k < 2; ++k) dst[n][k] = *(const PG8_LAS bf16x8*)(lds + PG8_SB(b, h) + boff + n * 2048 + k * 1024); } while (0)
#define PG8_MMA(ai, bj, At, Bt) do { __builtin_amdgcn_s_setprio(1); _Pragma("unroll") for (int m = 0; m < 4; ++m) _Pragma("unroll") for (int n = 0; n < 2; ++n) _Pragma("unroll") for (int k = 0; k < 2; ++k) \
        acc[ai][bj][m][n] = __builtin_amdgcn_mfma_f32_16x16x32_bf16(Bt[n][k], At[m][k], acc[ai][bj][m][n], 0, 0, 0); __builtin_amdgcn_s_setprio(0); } while (0)
#define PG8_WAIT_V(n) asm volatile("s_waitcnt vmcnt(" #n ")" ::: "memory")
#define PG8_WAIT_L(n) asm volatile("s_waitcnt lgkmcnt(" #n ")" ::: "memory")
#define PG8_BAR __builtin_amdgcn_s_barrier()
#define PG8_SCHED __builtin_amdgcn_sched_barrier(0)
    Unit cur, nxt; int ui = 0;
    if (!S.next(0, cur)) return;
    f32x4 acc[2][2][4][2];
#pragma unroll
    for (int a = 0; a < 2; ++a)
#pragma unroll
        for (int b = 0; b < 2; ++b)
#pragma unroll
            for (int m = 0; m < 4; ++m)
#pragma unroll
                for (int n = 0; n < 2; ++n) acc[a][b][m][n] = (f32x4){0.f, 0.f, 0.f, 0.f};
    bf16x8 At[4][2], B0[2][2], B1[2][2];
    const char* cA = (const char*)g.A + (size_t)cur.pm * tstepA + (size_t)cur.pn * akb; const char* cB = (const char*)g.Bt + (size_t)cur.pn * tstepB;
    S.a_ready(cur);
    if constexpr (SP2) {
        PG8_STAGE(PG8_SB(0, 0), cB, voffB); PG8_STAGE(PG8_SB(0, 1), cB + hstepB, voffB); PG8_STAGE(PG8_SA(0, 0), cA, voffA); PG8_STAGE(PG8_SA(0, 1), cA + hstepA, voffA);
        if (wr == 1) PG8_BAR;
        PG8_WAIT_V(2); PG8_BAR;
        PG8_STAGE(PG8_SB(1, 0), cB + kstep, voffB); PG8_STAGE(PG8_SA(1, 0), cA + kstep, voffA); PG8_STAGE(PG8_SB(1, 1), cB + hstepB + kstep, voffB);
        PG8_WAIT_V(6); PG8_BAR;
    } else {
        PG8_STAGE(PG8_SB(0, 0), cB, voffB); PG8_STAGE(PG8_SA(0, 0), cA, voffA); PG8_STAGE(PG8_SB(0, 1), cB + hstepB, voffB); PG8_STAGE(PG8_SA(0, 1), cA + hstepA, voffA);
        if (wr == 1) PG8_BAR;
        PG8_WAIT_V(4); PG8_BAR;
        PG8_STAGE(PG8_SB(1, 0), cB + kstep, voffB); PG8_STAGE(PG8_SA(1, 0), cA + kstep, voffA); PG8_STAGE(PG8_SB(1, 1), cB + hstepB + kstep, voffB);
        PG8_WAIT_V(6); PG8_BAR;
    }
    for (;;) {
        const bool has_next = S.next(ui + 1, nxt);
        const char* nA = has_next ? (const char*)g.A + (size_t)nxt.pm * tstepA + (size_t)nxt.pn * akb : cA; const char* nB = has_next ? (const char*)g.Bt + (size_t)nxt.pn * tstepB : cB;
        for (int t = 0; t < nt; t += 2) {
            const bool last = (t == nt - 2);
            const char* a1 = cA + (size_t)(t + 1) * kstep;
            const char* a2 = last ? nA : cA + (size_t)(t + 2) * kstep; const char* b2 = last ? nB : cB + (size_t)(t + 2) * kstep;
            const char* a3 = a2 + kstep; const char* b3 = b2 + kstep;
            if (last && has_next) S.a_ready(nxt);
            if constexpr (SP2) {
            PG8_LDB(B0, 0, 0); PG8_LDB(B1, 0, 1); PG8_SCHED; PG8_LDA(At, 0, 0); PG8_STAGE(PG8_SA(1, 1), a1 + hstepA, voffA);
            PG8_WAIT_V(8); PG8_WAIT_L(0); PG8_BAR; PG8_MMA(0, 0, At, B0); PG8_MMA(0, 1, At, B1); PG8_BAR; PG8_SCHED;
            PG8_LDA(At, 0, 1); PG8_STAGE(PG8_SB(0, 0), b2, voffB); PG8_STAGE(PG8_SB(0, 1), b2 + hstepB, voffB); PG8_STAGE(PG8_SA(0, 0), a2, voffA);
            PG8_WAIT_V(8); PG8_WAIT_L(0); PG8_BAR; PG8_MMA(1, 0, At, B0); PG8_MMA(1, 1, At, B1); PG8_BAR; PG8_SCHED;
            PG8_LDB(B0, 1, 0); PG8_LDB(B1, 1, 1); PG8_SCHED; PG8_LDA(At, 1, 0); PG8_STAGE(PG8_SA(0, 1), a2 + hstepA, voffA);
            PG8_WAIT_V(8); PG8_WAIT_L(0); PG8_BAR; PG8_MMA(0, 0, At, B0); PG8_MMA(0, 1, At, B1); PG8_BAR; PG8_SCHED;
            PG8_LDA(At, 1, 1); PG8_STAGE(PG8_SB(1, 0), b3, voffB); PG8_STAGE(PG8_SB(1, 1), b3 + hstepB, voffB); PG8_STAGE(PG8_SA(1, 0), a3, voffA);
            PG8_WAIT_V(8); PG8_WAIT_L(0); PG8_BAR; PG8_MMA(1, 0, At, B0); PG8_MMA(1, 1, At, B1); PG8_BAR; PG8_SCHED;
            } else {
            PG8_LDB(B0, 0, 0); PG8_SCHED; PG8_LDA(At, 0, 0); PG8_STAGE(PG8_SA(1, 1), a1 + hstepA, voffA);
            PG8_WAIT_L(8); PG8_BAR; PG8_WAIT_L(0); PG8_MMA(0, 0, At, B0); PG8_BAR; PG8_SCHED;
            PG8_LDB(B1, 0, 1); PG8_STAGE(PG8_SB(0, 0), b2, voffB);
            PG8_BAR; PG8_WAIT_L(0); PG8_MMA(0, 1, At, B1); PG8_BAR;
            PG8_LDA(At, 0, 1); PG8_STAGE(PG8_SA(0, 0), a2, voffA);
            PG8_BAR; PG8_WAIT_L(0); PG8_MMA(1, 0, At, B0); PG8_BAR; PG8_SCHED;
            PG8_STAGE(PG8_SB(0, 1), b2 + hstepB, voffB);
            PG8_WAIT_V(6); PG8_BAR; PG8_MMA(1, 1, At, B1); PG8_BAR;
            PG8_LDB(B0, 1, 0); PG8_SCHED; PG8_LDA(At, 1, 0); PG8_STAGE(PG8_SA(0, 1), a2 + hstepA, voffA);
            PG8_WAIT_L(8); PG8_BAR; PG8_WAIT_L(0); PG8_MMA(0, 0, At, B0); PG8_BAR; PG8_SCHED;
            PG8_LDB(B1, 1, 1); PG8_STAGE(PG8_SB(1, 0), b3, voffB);
            PG8_BAR; PG8_WAIT_L(0); PG8_MMA(0, 1, At, B1); PG8_BAR;
            PG8_LDA(At, 1, 1); PG8_STAGE(PG8_SA(1, 0), a3, voffA);
            PG8_BAR; PG8_WAIT_L(0); PG8_MMA(1, 0, At, B0); PG8_BAR; PG8_SCHED;
            PG8_STAGE(PG8_SB(1, 1), b3 + hstepB, voffB);
            PG8_WAIT_V(6); PG8_BAR; PG8_MMA(1, 1, At, B1); PG8_BAR;
            }
        }
        if constexpr (ALIGN_EPI) { if (wr == 0) PG8_BAR; }
        if constexpr (!Epi::AFTER_DRAIN) { E(acc, cur, wr, wc, fr, fq); S.done(cur); }
        if (!has_next) break;
#pragma unroll
        for (int a = 0; a < 2; ++a)
#pragma unroll
            for (int b = 0; b < 2; ++b)
#pragma unroll
                for (int m = 0; m < 4; ++m)
#pragma unroll
                    for (int n = 0; n < 2; ++n) acc[a][b][m][n] = (f32x4){0.f, 0.f, 0.f, 0.f};
        cur = nxt; cA = nA; cB = nB; ++ui;
        if constexpr (ALIGN_EPI) { if (wr == 1) PG8_BAR; }
    }
    PG8_WAIT_V(0);
    if constexpr (!ALIGN_EPI) { if (wr == 0) PG8_BAR; }
    PG8_BAR;
    if constexpr (Epi::AFTER_DRAIN) { E.fused(acc, cur, wr, wc, fr, fq, lds, wid, lane); S.done(cur); }
#undef PG8_SA
#undef PG8_SB
#undef PG8_STAGE
#undef PG8_LDA
#undef PG8_LDB
#undef PG8_MMA
#undef PG8_WAIT_V
#undef PG8_WAIT_L
#undef PG8_BAR
#undef PG8_SCHED
}
}


namespace pg8 {
typedef unsigned u32x2 __attribute__((ext_vector_type(2)));
__device__ __forceinline__ unsigned cvt_pk_bf16(float lo, float hi) { unsigned r; asm volatile("v_cvt_pk_bf16_f32 %0, %1, %2" : "=v"(r) : "v"(lo), "v"(hi)); return r; }
__device__ __forceinline__ float sigm(float x) { return __builtin_amdgcn_rcpf(1.0f + __builtin_amdgcn_exp2f(-1.4426950408889634f * x)); }
__device__ __forceinline__ float bf_lo(unsigned w) { return __uint_as_float(w << 16); }
__device__ __forceinline__ float bf_hi(unsigned w) { return __uint_as_float(w & 0xffff0000u); }

struct PanelSched {
    int panel, n, skip_lo, skip_n, mode;
    __device__ __forceinline__ bool next(int i, Unit& u) const {
        if (i >= n) return false;
        if (mode == 0) { u.pm = panel; u.pn = i + (i >= skip_lo ? skip_n : 0); } else { u.pm = i; u.pn = panel; }
        return true;
    }
    __device__ __forceinline__ void a_ready(const Unit&) const {}
    __device__ __forceinline__ void done(const Unit&) const {}
};

struct EpiProj {
    static constexpr bool PERM = true, AFTER_DRAIN = false;
    bf16_t *PQ, *PK, *PU, *PG;
    __device__ __forceinline__ void operator()(const f32x4 (&acc)[2][2][4][2], const Unit& u, int wr, int wc, int fr, int fq) const {
        const int pn = u.pn; bf16_t* base; int ld, colt; bool sg = false;
        if (pn < 2) { base = PQ; ld = 512; colt = pn * 256; }
        else if (pn < 4) { base = PK; ld = 512; colt = (pn - 2) * 256; }
        else if (pn < 8) { base = PU; ld = 512; colt = (pn - 6) * 256; }
        else { base = PG; ld = 2048; colt = (pn - 8) * 256; sg = true; }
        const int row0 = u.pm * BM + wr * 64 + fr, col0 = colt + wc * 32 + 8 * fq;
#pragma unroll
        for (int ai = 0; ai < 2; ++ai)
#pragma unroll
            for (int m = 0; m < 4; ++m) { bf16_t* rowp = base + (size_t)(row0 + ai * HALF + m * 16) * ld + col0;
#pragma unroll
                for (int bj = 0; bj < 2; ++bj) { f32x4 v0 = acc[ai][bj][m][0], v1 = acc[ai][bj][m][1];
                    if (sg) { v0 = (f32x4){sigm(v0[0]), sigm(v0[1]), sigm(v0[2]), sigm(v0[3])}; v1 = (f32x4){sigm(v1[0]), sigm(v1[1]), sigm(v1[2]), sigm(v1[3])}; }
                    u32x4 w; w.x = cvt_pk_bf16(v0[0], v0[1]); w.y = cvt_pk_bf16(v0[2], v0[3]); w.z = cvt_pk_bf16(v1[0], v1[1]); w.w = cvt_pk_bf16(v1[2], v1[3]);
                    *(u32x4*)(rowp + bj * HALF) = w; } }
    }
};
struct EpiPlain {
    static constexpr bool PERM = true, AFTER_DRAIN = false;
    bf16_t* O; int ldc;
    __device__ __forceinline__ void operator()(const f32x4 (&acc)[2][2][4][2], const Unit& u, int wr, int wc, int fr, int fq) const {
        const int row0 = u.pm * BM + wr * 64 + fr, col0 = u.pn * BM + wc * 32 + 8 * fq;
#pragma unroll
        for (int ai = 0; ai < 2; ++ai)
#pragma unroll
            for (int m = 0; m < 4; ++m) { bf16_t* rowp = O + (size_t)(row0 + ai * HALF + m * 16) * ldc + col0;
#pragma unroll
                for (int bj = 0; bj < 2; ++bj) { const f32x4 v0 = acc[ai][bj][m][0], v1 = acc[ai][bj][m][1];
                    u32x4 w; w.x = cvt_pk_bf16(v0[0], v0[1]); w.y = cvt_pk_bf16(v0[2], v0[3]); w.z = cvt_pk_bf16(v1[0], v1[1]); w.w = cvt_pk_bf16(v1[2], v1[3]);
                    *(u32x4*)(rowp + bj * HALF) = w; } }
    }
};
template <bool ADD> struct EpiMerge {
    static constexpr bool PERM = true, AFTER_DRAIN = false;
    const bf16_t* G; bf16_t* MG; int goff;
    __device__ __forceinline__ void operator()(const f32x4 (&acc)[2][2][4][2], const Unit& u, int wr, int wc, int fr, int fq) const {
        const int row0 = u.pm * BM + wr * 64 + fr, col0 = u.pn * BM + wc * 32 + 8 * fq;
#pragma unroll
        for (int ai = 0; ai < 2; ++ai)
#pragma unroll
            for (int m = 0; m < 4; ++m) { const size_t row = (size_t)(row0 + ai * HALF + m * 16);
#pragma unroll
                for (int bj = 0; bj < 2; ++bj) { const f32x4 v0 = acc[ai][bj][m][0], v1 = acc[ai][bj][m][1];
                    const u32x4 gw = *(const u32x4*)(G + row * 2048 + goff + col0 + bj * HALF);
                    float r0 = bf_lo(gw.x) * v0[0], r1 = bf_hi(gw.x) * v0[1], r2 = bf_lo(gw.y) * v0[2], r3 = bf_hi(gw.y) * v0[3];
                    float r4 = bf_lo(gw.z) * v1[0], r5 = bf_hi(gw.z) * v1[1], r6 = bf_lo(gw.w) * v1[2], r7 = bf_hi(gw.w) * v1[3];
                    bf16_t* mp = MG + row * 1024 + col0 + bj * HALF;
                    if (ADD) { const u32x4 pw = *(const u32x4*)mp;
                        r0 += bf_lo(pw.x); r1 += bf_hi(pw.x); r2 += bf_lo(pw.y); r3 += bf_hi(pw.y); r4 += bf_lo(pw.z); r5 += bf_hi(pw.z); r6 += bf_lo(pw.w); r7 += bf_hi(pw.w); }
                    u32x4 w; w.x = cvt_pk_bf16(r0, r1); w.y = cvt_pk_bf16(r2, r3); w.z = cvt_pk_bf16(r4, r5); w.w = cvt_pk_bf16(r6, r7);
                    *(u32x4*)mp = w; }
                asm volatile("" ::: "memory"); }
    }
};
struct EpiRes {
    static constexpr bool PERM = false, AFTER_DRAIN = false;
    const float* X; float* OUT;
    __device__ __forceinline__ void operator()(const f32x4 (&acc)[2][2][4][2], const Unit& u, int wr, int wc, int fr, int fq) const {
        const int col0 = u.pn * BM + wc * 32 + 4 * fq;
#pragma unroll
        for (int ai = 0; ai < 2; ++ai)
#pragma unroll
            for (int m = 0; m < 4; ++m) { const size_t off = (size_t)(u.pm * BM + ai * HALF + wr * 64 + m * 16 + fr) * 1024 + col0;
#pragma unroll
                for (int bj = 0; bj < 2; ++bj)
#pragma unroll
                    for (int n = 0; n < 2; ++n) { const f32x4 xs = *(const f32x4*)(X + off + bj * HALF + n * 16); *(f32x4*)(OUT + off + bj * HALF + n * 16) = xs + acc[ai][bj][m][n]; }
                asm volatile("" ::: "memory"); }
    }
};
struct EpiGate {
    static constexpr bool PERM = false, AFTER_DRAIN = false;
    float* OUT; const bf16_t* E;
    __device__ __forceinline__ void operator()(const f32x4 (&acc)[2][2][4][2], const Unit& u, int wr, int wc, int fr, int fq) const {
        const int col0 = u.pn * BM + wc * 32 + 4 * fq;
#pragma unroll
        for (int ai = 0; ai < 2; ++ai)
#pragma unroll
            for (int m = 0; m < 4; ++m) { const size_t off = (size_t)(u.pm * BM + ai * HALF + wr * 64 + m * 16 + fr) * 1024 + col0;
#pragma unroll
                for (int bj = 0; bj < 2; ++bj)
#pragma unroll
                    for (int n = 0; n < 2; ++n) { const size_t o2 = off + bj * HALF + n * 16; const f32x4 xs = *(const f32x4*)(OUT + o2); const u32x2 ew = *(const u32x2*)(E + o2); const f32x4 a = acc[ai][bj][m][n];
                        f32x4 r; r[0] = xs[0] + sigm(a[0]) * bf_lo(ew.x); r[1] = xs[1] + sigm(a[1]) * bf_hi(ew.x); r[2] = xs[2] + sigm(a[2]) * bf_lo(ew.y); r[3] = xs[3] + sigm(a[3]) * bf_hi(ew.y);
                        *(f32x4*)(OUT + o2) = r; }
                asm volatile("" ::: "memory"); }
    }
};
}

#define GAS __attribute__((address_space(1)))
#define LAS __attribute__((address_space(3)))
typedef unsigned short bf16;
typedef unsigned v4u __attribute__((ext_vector_type(4)));
typedef float f32x4 __attribute__((ext_vector_type(4)));
typedef short bf16x8 __attribute__((ext_vector_type(8)));
typedef GAS unsigned gu32;
typedef GAS unsigned long long gu64;
#define RLX_AGENT __ATOMIC_RELAXED, __HIP_MEMORY_SCOPE_AGENT
#define LDS_WAIT() asm volatile("s_waitcnt lgkmcnt(0)" ::: "memory")
#define VM_WAIT() asm volatile("s_waitcnt vmcnt(0)" ::: "memory")
__device__ __forceinline__ unsigned long long rt() { return __builtin_amdgcn_s_memrealtime(); }
__device__ __forceinline__ unsigned f2bf(float f) { unsigned u = __builtin_bit_cast(unsigned, f); return (u + 0x7fffu + ((u >> 16) & 1u)) >> 16; }
__device__ __forceinline__ unsigned pk2(float lo, float hi) { return f2bf(lo) | (f2bf(hi) << 16); }

#define XB_TMO      128
#define XB_XCNT(j)  (256  + 64 * (j))
#define XB_XSUB(j)  (1280 + 64 * (j))
#define XB_XGEN(j)  (2304 + 64 * (j))
#define XB_TOP      3328
#define XB_TOPGEN   3392
#define XCD_BAR_WORDS 3456
#define XB_SPIN_CAP (1u << 18)

__device__ __forceinline__ unsigned xb_ld(unsigned* p)              { return __hip_atomic_load(p, __ATOMIC_RELAXED, __HIP_MEMORY_SCOPE_AGENT); }
__device__ __forceinline__ unsigned xb_add(unsigned* p, unsigned v) { return __hip_atomic_fetch_add(p, v, __ATOMIC_RELAXED, __HIP_MEMORY_SCOPE_AGENT); }
__device__ __forceinline__ unsigned xb_xcc_id() { return (unsigned)__builtin_amdgcn_s_getreg((3 << 11) | 20) & 0xFu; }
#define XB_SPIN(cond, bar) do { unsigned _sp = 0; while (cond) { __builtin_amdgcn_s_sleep(1); \
    if ((++_sp & 255u) == 0u) { if (xb_ld(&(bar)[XB_TMO])) break; if (_sp > XB_SPIN_CAP) { atomicAdd(&(bar)[XB_TMO], 1u); break; } } } } while (0)

struct XcdBarrier {
    unsigned* bar; unsigned x;
    volatile LAS unsigned* st;
};

__device__ __forceinline__ XcdBarrier xcd_barrier_post(unsigned* bar, volatile LAS unsigned* st) {
    XcdBarrier b; b.bar = bar; b.x = xb_xcc_id(); b.st = st;
    if (threadIdx.x == 0) (void)xb_add(&bar[XB_XCNT(b.x)], 1u);
    return b;
}
__device__ __forceinline__ void xcd_barrier_complete(unsigned* bar, unsigned x, unsigned& nloc, unsigned& nx) {
    const unsigned G = gridDim.x * gridDim.y * gridDim.z;
    unsigned sum, cnt, mine, sp = 0u;
    for (;;) {
        sum = 0u; cnt = 0u; mine = 0u;
#pragma unroll
        for (unsigned j = 0; j < 16; ++j) { const unsigned c = xb_ld(&bar[XB_XCNT(j)]); sum += c; cnt += (c > 0u) ? 1u : 0u; mine = (j == x) ? c : mine; }
        if (sum == G) break;
        __builtin_amdgcn_s_sleep(1);
        if ((++sp & 255u) == 0u) { if (xb_ld(&bar[XB_TMO])) break; if (sp > XB_SPIN_CAP) { atomicAdd(&bar[XB_TMO], 1u); break; } }
    }
    nloc = mine > 0u ? mine : 1u; nx = cnt > 0u ? cnt : 1u;
}

__device__ __forceinline__ void xcd_barrier(const XcdBarrier& b) {
    asm volatile("s_waitcnt vmcnt(0)" ::: "memory");
    __syncthreads();
    if (threadIdx.x == 0) {
        unsigned* bar = b.bar;
        __builtin_amdgcn_s_waitcnt(0);
        unsigned nloc = b.st[0], nx = b.st[1];
        if (nloc == 0u) { xcd_barrier_complete(bar, b.x, nloc, nx); b.st[0] = nloc; b.st[1] = nx; }
        const unsigned old = xb_add(&bar[XB_XSUB(b.x)], 1u);
        const unsigned gen = old / nloc;
        if (old + 1u == (gen + 1u) * nloc) {
            __builtin_amdgcn_fence(__ATOMIC_RELEASE, "agent");
            asm volatile("s_waitcnt vmcnt(0)" ::: "memory");
            const unsigned og = xb_add(&bar[XB_TOP], 1u);
            const unsigned tg = og / nx;
            if (og + 1u == (tg + 1u) * nx) xb_add(&bar[XB_TOPGEN], 1u);
            else XB_SPIN(xb_ld(&bar[XB_TOPGEN]) == tg, bar);
            __builtin_amdgcn_fence(__ATOMIC_ACQUIRE, "agent");
            xb_add(&bar[XB_XGEN(b.x)], 1u);
            asm volatile("s_waitcnt vmcnt(0)" ::: "memory");
        } else {
            XB_SPIN(xb_ld(&bar[XB_XGEN(b.x)]) == gen, bar);
            __builtin_amdgcn_fence(__ATOMIC_ACQUIRE, "agent");
            asm volatile("s_waitcnt vmcnt(0)" ::: "memory");
        }
    }
    __syncthreads();
}


constexpr int NWAVES = 8, NTHR = 512;
constexpr int TOK = 65536, DM = 1024, SEQ = 8192, NPANEL = 256;
constexpr float RMS_EPS = 1e-6f;
constexpr float C2 = 0.125f * 1.4426950408889634f;
constexpr float SURV_THR = 5.4210108624275222e-20f;
constexpr size_t MiB = 1u << 20;
constexpr size_t WS_CTL = 0, CTL_ZERO_BYTES = 64 * 1024;
constexpr size_t WS_WIN = 2 * MiB, WS_WOUT = 10 * MiB, WS_WQ = 12 * MiB, WS_WPG = 16 * MiB, WS_WPLE = 18 * MiB;
constexpr size_t WS_BDA = 18 * MiB + 512 * 1024, WS_BDP = 18 * MiB + 768 * 1024, WS_SK = 19 * MiB;
constexpr size_t WS_EU = 32 * MiB, WS_EV = 64 * MiB;
constexpr size_t WS_XN = 96 * MiB;
constexpr size_t WS_PQ = 224 * MiB, WS_PK = 288 * MiB, WS_PVT = 352 * MiB, WS_PU = 416 * MiB;
constexpr size_t WS_PG = 480 * MiB;
constexpr size_t WS_YA = 736 * MiB, WS_YP = 800 * MiB;
constexpr size_t WS_MG = 864 * MiB, WS_END = 992 * MiB;
constexpr int CW_BAR = 1024;
constexpr int RING_BYTES = 131072, LDSCTL_OFF = RING_BYTES, MISC_OFF = LDSCTL_OFF + 320, LDS_BYTES = 147456;

typedef float f32x16 __attribute__((ext_vector_type(16)));
typedef float f32x2 __attribute__((ext_vector_type(2)));
typedef __bf16 bf16x2v __attribute__((ext_vector_type(2)));

__device__ __forceinline__ float wave_sum(float v) {
#pragma unroll
    for (int o = 1; o < 64; o <<= 1) v += __shfl_xor(v, o);
    return v;
}
__device__ __forceinline__ float bflo(unsigned w) { return __uint_as_float(w << 16); }
__device__ __forceinline__ float bfhi(unsigned w) { return __uint_as_float(w & 0xffff0000u); }
__device__ __forceinline__ unsigned cvtpk(float lo, float hi) { return pg8::cvt_pk_bf16(lo, hi); }

__device__ __forceinline__ void p0_transpose_item(const float* W, int K, int N, bf16* WT, const float* kscale, int nlo, float nls, LAS float* scr, int item, int lane) {
    const int nblk = N / 32, kb = item / nblk, nb = item % nblk, k0 = 64 * kb, n0 = 32 * nb;
    const float ns = (n0 + (lane & 31)) < nlo ? nls : 1.0f;
#pragma unroll 8
    for (int i = 0; i < 32; ++i) { const int kk = 2 * i + (lane >> 5); float v = W[(size_t)(k0 + kk) * N + n0 + (lane & 31)] * ns; if (kscale) v *= kscale[k0 + kk]; scr[kk * 33 + (lane & 31)] = v; }
    LDS_WAIT(); asm volatile("" ::: "memory");
    const int c = lane & 7;
#pragma unroll
    for (int j = 0; j < 4; ++j) { const int n = (lane >> 3) + 8 * j; const LAS float* s = scr + (8 * c) * 33 + n;
        v4u o; o.x = pk2(s[0 * 33], s[1 * 33]); o.y = pk2(s[2 * 33], s[3 * 33]); o.z = pk2(s[4 * 33], s[5 * 33]); o.w = pk2(s[6 * 33], s[7 * 33]);
        *(GAS v4u*)(WT + (size_t)(n0 + n) * K + k0 + 8 * c) = o; }
    LDS_WAIT(); asm volatile("" ::: "memory");
}
__device__ __forceinline__ void rms_row_to_bf16(const float* xrow, bf16* orow, int lane) {
    const GAS f32x4* xr = (const GAS f32x4*)xrow + lane;
    f32x4 v[4]; float s = 0.f;
#pragma unroll
    for (int j = 0; j < 4; ++j) { v[j] = xr[64 * j]; s += (v[j].x * v[j].x + v[j].y * v[j].y) + (v[j].z * v[j].z + v[j].w * v[j].w); }
    const float r = 1.f / sqrtf(wave_sum(s) * (1.f / DM) + RMS_EPS);
    GAS unsigned long long* o8 = (GAS unsigned long long*)orow + lane;
#pragma unroll
    for (int j = 0; j < 4; ++j) o8[64 * j] = (unsigned long long)pk2(v[j].x * r, v[j].y * r) | ((unsigned long long)pk2(v[j].z * r, v[j].w * r) << 32);
}
__device__ __forceinline__ void cvt8_store(const float* src, bf16* dst) {
    const f32x4 a = *(const GAS f32x4*)src, b = *(const GAS f32x4*)(src + 4);
    v4u o; o.x = pk2(a.x, a.y); o.y = pk2(a.z, a.w); o.z = pk2(b.x, b.y); o.w = pk2(b.z, b.w);
    *(GAS v4u*)dst = o;
}

__device__ __forceinline__ void attn_panel(int panel, const bf16* PQ, const bf16* PK, const bf16* PVT, bf16* YA) {
    const int tid = otid(), lane = tid & 63, wid = __builtin_amdgcn_readfirstlane(tid >> 6);
    const int r32 = lane & 31, hh = lane >> 5;
    const size_t seq0 = (size_t)(panel >> 5) * SEQ;
    const int pos0 = (panel & 31) * 256 + wid * 32;
    const int kap = 16 * ((r32 >> 2) & 1) + (r32 & 3) + 4 * (r32 >> 3);
    for (int h = 0; h < 8; ++h) {
        bf16x8 qf[4];
        { const bf16* qrow = PQ + (seq0 + pos0 + r32) * 512 + h * 64 + 8 * hh;
#pragma unroll
          for (int s = 0; s < 4; ++s) qf[s] = *(const GAS bf16x8*)(qrow + 16 * s); }
        f32x16 o0 = {}, o1 = {};
        float Sin = 1.f;
        for (int kb = pos0; kb >= 0; kb -= 32) {
            const bf16* krow = PK + (seq0 + kb + kap) * 512 + h * 64 + 8 * hh;
            const bf16* vrow = PVT + (size_t)(h * 64 + kap) * TOK + seq0 + kb + 16 * hh;
            bf16x8 kf[4], vf[2][2];
#pragma unroll
            for (int s = 0; s < 4; ++s) kf[s] = *(const GAS bf16x8*)(krow + 16 * s);
#pragma unroll
            for (int db = 0; db < 2; ++db)
#pragma unroll
                for (int s = 0; s < 2; ++s) vf[db][s] = *(const GAS bf16x8*)(vrow + (size_t)db * 32 * TOK + 8 * s);
            f32x16 z = {};
#pragma unroll
            for (int s = 0; s < 4; ++s) z = __builtin_amdgcn_mfma_f32_32x32x16_bf16(kf[s], qf[s], z, 0, 0, 0);
            const bool diag = (kb == pos0);
            float w[16]; float Sl = 1.f;
#pragma unroll
            for (int reg = 15; reg >= 0; --reg) {
                float beta = __builtin_amdgcn_rcpf(1.0f + __builtin_amdgcn_exp2f(-z[reg]));
                if (diag && (16 * hh + reg >= r32)) beta = 0.f;
                const float wl = beta * Sl; Sl -= wl; w[reg] = wl;
            }
            const float Pp = __shfl_xor(Sl, 32);
            const float scale = hh ? Sin : Sin * Pp;
            Sin = Sin * Sl * Pp;
            v4u pw0, pw1;
            pw0.x = cvtpk(w[0] * scale, w[1] * scale); pw0.y = cvtpk(w[2] * scale, w[3] * scale); pw0.z = cvtpk(w[4] * scale, w[5] * scale); pw0.w = cvtpk(w[6] * scale, w[7] * scale);
            pw1.x = cvtpk(w[8] * scale, w[9] * scale); pw1.y = cvtpk(w[10] * scale, w[11] * scale); pw1.z = cvtpk(w[12] * scale, w[13] * scale); pw1.w = cvtpk(w[14] * scale, w[15] * scale);
            const bf16x8 p0 = __builtin_bit_cast(bf16x8, pw0), p1 = __builtin_bit_cast(bf16x8, pw1);
            o0 = __builtin_amdgcn_mfma_f32_32x32x16_bf16(vf[0][0], p0, o0, 0, 0, 0);
            o0 = __builtin_amdgcn_mfma_f32_32x32x16_bf16(vf[0][1], p1, o0, 0, 0, 0);
            o1 = __builtin_amdgcn_mfma_f32_32x32x16_bf16(vf[1][0], p0, o1, 0, 0, 0);
            o1 = __builtin_amdgcn_mfma_f32_32x32x16_bf16(vf[1][1], p1, o1, 0, 0, 0);
            if (__all(Sin < SURV_THR)) break;
        }
        bf16* orow = YA + (seq0 + pos0 + r32) * 512 + h * 64 + 16 * hh;
        v4u a, b2;
        a.x = cvtpk(o0[0], o0[1]); a.y = cvtpk(o0[2], o0[3]); a.z = cvtpk(o0[4], o0[5]); a.w = cvtpk(o0[6], o0[7]);
        b2.x = cvtpk(o0[8], o0[9]); b2.y = cvtpk(o0[10], o0[11]); b2.z = cvtpk(o0[12], o0[13]); b2.w = cvtpk(o0[14], o0[15]);
        *(GAS v4u*)orow = a; *(GAS v4u*)(orow + 8) = b2;
        a.x = cvtpk(o1[0], o1[1]); a.y = cvtpk(o1[2], o1[3]); a.z = cvtpk(o1[4], o1[5]); a.w = cvtpk(o1[6], o1[7]);
        b2.x = cvtpk(o1[8], o1[9]); b2.y = cvtpk(o1[10], o1[11]); b2.z = cvtpk(o1[12], o1[13]); b2.w = cvtpk(o1[14], o1[15]);
        *(GAS v4u*)(orow + 32) = a; *(GAS v4u*)(orow + 40) = b2;
    }
}

__device__ __forceinline__ void pool_panel(int panel, const bf16* PU, bf16* YP) {
    const int tid = otid();
    const int chunk = tid & 63, tg = tid >> 6, w = 2 << (chunk >> 4);
    const int posb = (panel & 31) * 256; const size_t row0 = (size_t)panel * 256;
    for (int i = 0; i < 32; ++i) {
        const int t = tg * 32 + i, pos = posb + t, cnt = (pos + 1 < w) ? (pos + 1) : w;
        float s[8];
#pragma unroll
        for (int k = 0; k < 8; ++k) s[k] = 0.f;
        v4u cur = {0u, 0u, 0u, 0u};
        for (int j = 0; j < cnt; ++j) {
            const v4u v = *(const GAS v4u*)(PU + (row0 + t - j) * 512 + chunk * 8);
            if (j == 0) cur = v;
            s[0] += bflo(v.x); s[1] += bfhi(v.x); s[2] += bflo(v.y); s[3] += bfhi(v.y); s[4] += bflo(v.z); s[5] += bfhi(v.z); s[6] += bflo(v.w); s[7] += bfhi(v.w);
        }
        const float ic = 1.0f / (float)cnt;
        v4u o;
        o.x = cvtpk(s[0] * ic - bflo(cur.x), s[1] * ic - bfhi(cur.x)); o.y = cvtpk(s[2] * ic - bflo(cur.y), s[3] * ic - bfhi(cur.y));
        o.z = cvtpk(s[4] * ic - bflo(cur.z), s[5] * ic - bfhi(cur.z)); o.w = cvtpk(s[6] * ic - bflo(cur.w), s[7] * ic - bfhi(cur.w));
        *(GAS v4u*)(YP + (row0 + t) * 512 + chunk * 8) = o;
    }
}

#define HD __host__ __device__ __forceinline__
HD int f2s(float f) { int i = __builtin_bit_cast(int, f); return i ^ ((i >> 31) & 0x7fffffff); }
HD float s2f(int i) { i ^= ((i >> 31) & 0x7fffffff); return __builtin_bit_cast(float, i); }
HD void ce_desc(int& a, int& b) { const int mx = a > b ? a : b, mn = a > b ? b : a; a = mx; b = mn; }
template <int J, int K> HD void bpass16(int (&v)[16]) {
#pragma unroll
    for (int i = 0; i < 16; ++i) { const int l = i ^ J; if (l > i) { if ((i & K) == 0) ce_desc(v[i], v[l]); else ce_desc(v[l], v[i]); } }
}
HD void bitonic_sort16_desc(int (&v)[16]) {
    bpass16<1, 2>(v); bpass16<2, 4>(v); bpass16<1, 4>(v); bpass16<4, 8>(v); bpass16<2, 8>(v); bpass16<1, 8>(v);
    bpass16<8, 16>(v); bpass16<4, 16>(v); bpass16<2, 16>(v); bpass16<1, 16>(v);
}
HD void bitonic_merge16_desc(int (&v)[16]) {
    bpass16<8, 16>(v); bpass16<4, 16>(v); bpass16<2, 16>(v); bpass16<1, 16>(v);
}
HD void merge_prune16(int (&x)[16], const int (&y)[16]) {
#pragma unroll
    for (int i = 0; i < 16; ++i) x[i] = x[i] > y[15 - i] ? x[i] : y[15 - i];
    bitonic_merge16_desc(x);
}
HD int cx_i(int hf, int t) { if (hf == 0) return 0; return t < 5 ? 2 : t < 9 ? 3 : t < 12 ? 4 : t < 14 ? 5 : 6; }
HD int cx_j(int hf, int t) { if (hf == 0) return t; return t < 5 ? t : t < 9 ? t - 5 : t < 12 ? t - 9 : t < 14 ? t - 12 : t - 14; }
HD int cy_i(int hf, int t) { if (hf == 0) return t < 8 ? 1 : 23 - t; return 7; }
HD int cy_j(int hf, int t) { if (hf == 0) return t < 8 ? t : 0; return t; }

__device__ __forceinline__ void top16_of_group(const bf16* qrow  , const bf16* skg  , int hh, int (&res)[16]) {
    bf16x8 qf[8];
#pragma unroll
    for (int s = 0; s < 8; ++s) qf[s] = *(const GAS bf16x8*)(qrow + 16 * s);
    int v[4][16];
#pragma unroll
    for (int kb = 0; kb < 4; ++kb) {
        f32x16 acc = {};
#pragma unroll
        for (int s = 0; s < 8; ++s) { const bf16x8 af = *(const GAS bf16x8*)(skg + (size_t)kb * 32 * 128 + 16 * s); acc = __builtin_amdgcn_mfma_f32_32x32x16_bf16(af, qf[s], acc, 0, 0, 0); }
#pragma unroll
        for (int reg = 0; reg < 16; ++reg) { const int keyid = 32 * kb + (reg & 3) + 8 * (reg >> 2) + 4 * hh; v[kb][reg] = (f2s(acc[reg]) & ~127) | keyid; }
    }
    bitonic_sort16_desc(v[0]); bitonic_sort16_desc(v[1]); bitonic_sort16_desc(v[2]); bitonic_sort16_desc(v[3]);
    merge_prune16(v[0], v[1]); merge_prune16(v[2], v[3]); merge_prune16(v[0], v[2]);
    int y[16];
#pragma unroll
    for (int i = 0; i < 16; ++i) y[i] = __shfl_xor(v[0][i], 32);
    merge_prune16(v[0], y);
#pragma unroll
    for (int i = 0; i < 16; ++i) res[i] = v[0][i];
}

__device__ __forceinline__ void topk_panel(int panel, const bf16* QP, const bf16* SK, int* IDXp, float* GTp  , LAS int* lut  ) {
    const int tid = otid(), lane = tid & 63, wid = __builtin_amdgcn_readfirstlane(tid >> 6);
    const int r32 = lane & 31, hh = lane >> 5;
    const int lrow = wid * 32 + r32;
    const size_t row = (size_t)panel * 256 + lrow;
    for (int h = 0; h < 8; ++h) {
        int a[16], b[16];
        top16_of_group(QP + row * 2048 + (2 * h) * 128 + 8 * hh, SK + ((size_t)(2 * h) * 128 + r32) * 128 + 8 * hh, hh, a);
        top16_of_group(QP + row * 2048 + (2 * h + 1) * 128 + 8 * hh, SK + ((size_t)(2 * h + 1) * 128 + r32) * 128 + 8 * hh, hh, b);
        float fa[16], fb[16];
#pragma unroll
        for (int i = 0; i < 16; ++i) { fa[i] = s2f(a[i] & ~127); fb[i] = s2f(b[i] & ~127); lut[i * 512 + tid] = a[i] & 127; lut[(16 + i) * 512 + tid] = b[i] & 127; }
        int X[16], Y[16];
#pragma unroll
        for (int t = 0; t < 16; ++t) {
            const float s0 = fa[cx_i(0, t)] + fb[cx_j(0, t)], s1 = fa[cx_i(1, t)] + fb[cx_j(1, t)];
            const int c0 = cx_i(0, t) * 16 + cx_j(0, t), c1 = cx_i(1, t) * 16 + cx_j(1, t);
            X[t] = hh ? ((f2s(s1) & ~255) | c1) : ((f2s(s0) & ~255) | c0);
            const float u0 = fa[cy_i(0, t)] + fb[cy_j(0, t)];
            const int d0 = cy_i(0, t) * 16 + cy_j(0, t);
            int y1 = (int)0x80000000;
            if (t < 2) { const float u1 = fa[cy_i(1, t)] + fb[cy_j(1, t)]; y1 = (f2s(u1) & ~255) | (cy_i(1, t) * 16 + cy_j(1, t)); }
            Y[t] = hh ? y1 : ((f2s(u0) & ~255) | d0);
        }
        bitonic_sort16_desc(X); bitonic_merge16_desc(Y); merge_prune16(X, Y);
#pragma unroll
        for (int i = 0; i < 16; ++i) Y[i] = __shfl_xor(X[i], 32);
        merge_prune16(X, Y);
        const float mx = s2f(X[0] & ~255);
        float ex[16], den = 0.f;
#pragma unroll
        for (int i = 0; i < 16; ++i) { ex[i] = __builtin_amdgcn_exp2f((s2f(X[i] & ~255) - mx) * 1.4426950408889634f); den += ex[i]; }
        const float rden = 1.0f / den;
        int oi[8]; float og[8];
#pragma unroll
        for (int t = 0; t < 8; ++t) {
            const int msk = -hh;
            const int code = (X[t] ^ ((X[t] ^ X[8 + t]) & msk)) & 255;
            const int e1 = lut[(code >> 4) * 512 + tid], e2 = lut[(16 + (code & 15)) * 512 + tid];
            const int exl = __builtin_bit_cast(int, ex[t]), exh = __builtin_bit_cast(int, ex[8 + t]);
            oi[t] = e1 * 128 + e2; og[t] = __builtin_bit_cast(float, exl ^ ((exl ^ exh) & msk)) * rden;
        }
        int* ip = IDXp + lrow * 128 + h * 16 + 8 * hh; float* gp = GTp + lrow * 128 + h * 16 + 8 * hh;
        *(GAS v4u*)ip = (v4u){(unsigned)oi[0], (unsigned)oi[1], (unsigned)oi[2], (unsigned)oi[3]}; *(GAS v4u*)(ip + 4) = (v4u){(unsigned)oi[4], (unsigned)oi[5], (unsigned)oi[6], (unsigned)oi[7]};
        *(GAS f32x4*)gp = (f32x4){og[0], og[1], og[2], og[3]}; *(GAS f32x4*)(gp + 4) = (f32x4){og[4], og[5], og[6], og[7]};
    }
}

__device__ __forceinline__ float dot2bf(unsigned w, unsigned x, float acc) { return __builtin_amdgcn_fdot2_f32_bf16(__builtin_bit_cast(bf16x2v, w), __builtin_bit_cast(bf16x2v, x), acc, false); }
__device__ __forceinline__ float dot8(const v4u a, const v4u b, float acc) {
    acc = dot2bf(a.x, b.x, acc); acc = dot2bf(a.y, b.y, acc); acc = dot2bf(a.z, b.z, acc); acc = dot2bf(a.w, b.w, acc);
    return acc;
}
#define RS_LEVEL(v, n, m) do { _Pragma("unroll") for (int _e = 0; _e < (n); ++_e) { const bool _up = (lane & (m)) != 0; const float _send = _up ? v[_e] : v[_e + (n)]; const float _keep = _up ? v[_e + (n)] : v[_e]; v[_e] = _keep + __shfl_xor(_send, (m)); } } while (0)
__device__ __forceinline__ void fma8(float (&o)[8], float c, const v4u v) {
    o[0] = fmaf(c, bflo(v.x), o[0]); o[1] = fmaf(c, bfhi(v.x), o[1]); o[2] = fmaf(c, bflo(v.y), o[2]); o[3] = fmaf(c, bfhi(v.y), o[3]);
    o[4] = fmaf(c, bflo(v.z), o[4]); o[5] = fmaf(c, bfhi(v.z), o[5]); o[6] = fmaf(c, bflo(v.w), o[6]); o[7] = fmaf(c, bfhi(v.w), o[7]);
}
__device__ __forceinline__ void peer_panel(int panel, bf16* XN, const int* IDXp, const float* GTp, const bf16* EU, const bf16* EV, float* XIO) {
    const int tid = otid(), lane = tid & 63, wid = __builtin_amdgcn_readfirstlane(tid >> 6);
    for (int ti = 0; ti < 32; ++ti) {
        const int lrow = wid * 32 + ti;
        const size_t row = (size_t)panel * 256 + lrow;
        const v4u hA = *(const GAS v4u*)(XN + row * DM + 8 * lane), hB = *(const GAS v4u*)(XN + row * DM + 512 + 8 * lane);
        const int i0 = IDXp[lrow * 128 + lane], i1 = IDXp[lrow * 128 + 64 + lane];
        const float g0 = GTp[lrow * 128 + lane], g1 = GTp[lrow * 128 + 64 + lane];
        float coef[2];
#pragma unroll
        for (int hf = 0; hf < 2; ++hf) {
            const int iv = hf ? i1 : i0;
            float q[8];
#pragma unroll
            for (int k = 0; k < 8; ++k) q[k] = 0.f;
            for (int c = 0; c < 8; ++c) {
                v4u ua[8], ub[8];
#pragma unroll
                for (int j = 0; j < 8; ++j) { const int ex = __builtin_amdgcn_readlane(iv, c * 8 + j); const GAS v4u* up = (const GAS v4u*)(EU + (size_t)ex * DM) + lane; ua[j] = up[0]; ub[j] = up[64]; }
                float p[8];
#pragma unroll
                for (int j = 0; j < 8; ++j) p[j] = dot8(ub[j], hB, dot8(ua[j], hA, 0.f));
                RS_LEVEL(p, 4, 4); RS_LEVEL(p, 2, 2); RS_LEVEL(p, 1, 1);
#pragma unroll
                for (int k = 0; k < 8; ++k) q[k] = (c == k) ? p[0] : q[k];
            }
            RS_LEVEL(q, 4, 32); RS_LEVEL(q, 2, 16); RS_LEVEL(q, 1, 8);
            const float s = q[0];
            const float act = 0.5f * s * (1.0f + erff(s * 0.70710678118654752f));
            coef[hf] = (hf ? g1 : g0) * act;
        }
        float oA[8], oB[8];
        { const GAS f32x4* xp = (const GAS f32x4*)(XIO + row * DM + 8 * lane); const f32x4 x0 = xp[0], x1 = xp[1], x2 = xp[128], x3 = xp[129];
          oA[0] = x0.x; oA[1] = x0.y; oA[2] = x0.z; oA[3] = x0.w; oA[4] = x1.x; oA[5] = x1.y; oA[6] = x1.z; oA[7] = x1.w;
          oB[0] = x2.x; oB[1] = x2.y; oB[2] = x2.z; oB[3] = x2.w; oB[4] = x3.x; oB[5] = x3.y; oB[6] = x3.z; oB[7] = x3.w; }
#pragma unroll
        for (int hf = 0; hf < 2; ++hf) {
            const int iv = hf ? i1 : i0; const float cv = coef[hf];
            for (int c = 0; c < 8; ++c) {
                v4u va[8], vb[8];
#pragma unroll
                for (int j = 0; j < 8; ++j) { const int ex = __builtin_amdgcn_readlane(iv, c * 8 + j); const GAS v4u* vp = (const GAS v4u*)(EV + (size_t)ex * DM) + lane; va[j] = vp[0]; vb[j] = vp[64]; }
#pragma unroll
                for (int j = 0; j < 8; ++j) { const float cf = __builtin_bit_cast(float, __builtin_amdgcn_readlane(__builtin_bit_cast(int, cv), c * 8 + j)); fma8(oA, cf, va[j]); fma8(oB, cf, vb[j]); }
            }
        }
        float ss = 0.f;
#pragma unroll
        for (int k = 0; k < 8; ++k) ss += oA[k] * oA[k] + oB[k] * oB[k];
        const float r = 1.f / sqrtf(wave_sum(ss) * (1.f / DM) + RMS_EPS);
        { GAS f32x4* xp = (GAS f32x4*)(XIO + row * DM + 8 * lane);
          xp[0] = (f32x4){oA[0], oA[1], oA[2], oA[3]}; xp[1] = (f32x4){oA[4], oA[5], oA[6], oA[7]}; xp[128] = (f32x4){oB[0], oB[1], oB[2], oB[3]}; xp[129] = (f32x4){oB[4], oB[5], oB[6], oB[7]}; }
        v4u ha, hb;
        ha.x = cvtpk(oA[0] * r, oA[1] * r); ha.y = cvtpk(oA[2] * r, oA[3] * r); ha.z = cvtpk(oA[4] * r, oA[5] * r); ha.w = cvtpk(oA[6] * r, oA[7] * r);
        hb.x = cvtpk(oB[0] * r, oB[1] * r); hb.y = cvtpk(oB[2] * r, oB[3] * r); hb.z = cvtpk(oB[4] * r, oB[5] * r); hb.w = cvtpk(oB[6] * r, oB[7] * r);
        *(GAS v4u*)(XN + row * DM + 8 * lane) = ha; *(GAS v4u*)(XN + row * DM + 512 + 8 * lane) = hb;
    }
}


struct Args {
    const float *x, *p, *norm_mix, *w_in, *w_att_up, *w_pool_group, *pool_scale, *w_out, *norm_ffn, *w_query, *sub_keys, *expert_u, *expert_v, *norm_ple, *w_ple_gate, *w_ple, *norm_final;
    float* out; unsigned char* ws; int ph_hi, pad;
};

#ifndef MK_PH_HI
#define MK_PH_HI 99
#endif

typedef const __attribute__((address_space(4))) Args* CArgs;
__device__ __forceinline__ CArgs kargs() { CArgs p = (CArgs)__builtin_amdgcn_kernarg_segment_ptr(); asm volatile("" : "+s"(p)); return p; }
#define WSP(T, off) ((T*)(kargs()->ws + (off)))
__global__ void __launch_bounds__(NTHR, 2) mega_fwd(Args a_unused) {
    extern __shared__ __attribute__((aligned(16))) unsigned char lds_raw[];
    LAS unsigned char* lds = (LAS unsigned char*)lds_raw;
    volatile LAS unsigned* MISC = (volatile LAS unsigned*)(lds + MISC_OFF);
    const int G = gridDim.x; const int bx = blockIdx.x;
    const int vcu = (G % 8 == 0) ? (bx % 8) * (G / 8) + bx / 8 : bx;
    gu32* ctl = (gu32*)(kargs()->ws + WS_CTL);
    for (int u = threadIdx.x; u < (LDS_BYTES - LDSCTL_OFF) / 4; u += NTHR) ((LAS unsigned*)(lds + LDSCTL_OFF))[u] = 0u;
    __syncthreads();
    (void)xcd_barrier_post((unsigned*)(ctl + CW_BAR), MISC + 8);
#define GRID_BAR() do { XcdBarrier _b; _b.bar = (unsigned*)((gu32*)(kargs()->ws + WS_CTL) + CW_BAR); _b.x = xb_xcc_id(); _b.st = (volatile LAS unsigned*)(lds + MISC_OFF) + 8; xcd_barrier(_b); } while (0)
#define LOCAL_SEAM() do { VM_WAIT(); __syncthreads(); if (threadIdx.x == 0) { __builtin_amdgcn_fence(__ATOMIC_ACQUIRE, "agent"); VM_WAIT(); } __syncthreads(); } while (0)

    {
        const int tid = otid(), lane = tid & 63, wid = __builtin_amdgcn_readfirstlane(tid >> 6);
        const CArgs a = kargs(); unsigned char* ws = a->ws;
        bf16 *WIN = (bf16*)(ws + WS_WIN), *WOUT = (bf16*)(ws + WS_WOUT), *WQ = (bf16*)(ws + WS_WQ), *WPG = (bf16*)(ws + WS_WPG), *WPLE = (bf16*)(ws + WS_WPLE);
        bf16 *BDA = (bf16*)(ws + WS_BDA), *BDP = (bf16*)(ws + WS_BDP), *SK = (bf16*)(ws + WS_SK), *EU = (bf16*)(ws + WS_EU), *EV = (bf16*)(ws + WS_EV), *XN = (bf16*)(ws + WS_XN);
        LAS float* scr = (LAS float*)(lds + wid * 16384);
        const int gw = vcu * NWAVES + wid, NGW = G * NWAVES;
        constexpr int I_IN = (1024 / 64) * (4096 / 32), I_OUT = (1024 / 64) * (1024 / 32), I_Q = (1024 / 64) * (2048 / 32), I_PG = I_OUT, I_PLE = (256 / 64) * (1024 / 32);
        constexpr int NITEMS = I_IN + I_OUT + I_Q + I_PG + I_PLE;
        for (int it = gw; it < NITEMS; it += NGW) {
            int r = it;
            if (r < I_IN) { p0_transpose_item(a->w_in, 1024, 4096, WIN, a->norm_mix, 512, C2, scr, r, lane); continue; } r -= I_IN;
            if (r < I_OUT) { p0_transpose_item(a->w_out, 1024, 1024, WOUT, nullptr, 0, 1.f, scr, r, lane); continue; } r -= I_OUT;
            if (r < I_Q) { p0_transpose_item(a->w_query, 1024, 2048, WQ, a->norm_ffn, 0, 1.f, scr, r, lane); continue; } r -= I_Q;
            if (r < I_PG) { p0_transpose_item(a->w_ple_gate, 1024, 1024, WPG, a->norm_ple, 0, 1.f, scr, r, lane); continue; } r -= I_PG;
            p0_transpose_item(a->w_ple, 256, 1024, WPLE, nullptr, 0, 1.f, scr, r, lane);
        }
        const int gt = vcu * NTHR + tid, NGT = G * NTHR;
        for (int it = gt; it < 1024 * 16; it += NGT) {
            const int n = it >> 4, k8 = (it & 15) * 8, head = n >> 7, g = n >> 8;
            float va[8], vp[8]; const float ps = a->pool_scale[n];
#pragma unroll
            for (int j = 0; j < 8; ++j) {
                const int k = k8 + j;
                va[j] = ((k >> 6) == (head & 1)) ? a->w_att_up[((size_t)head * 64 + (k & 63)) * 128 + (n & 127)] : 0.f;
                vp[j] = a->w_pool_group[((size_t)g * 128 + k) * 256 + (n & 255)] * ps;
            }
            v4u o; o.x = pk2(va[0], va[1]); o.y = pk2(va[2], va[3]); o.z = pk2(va[4], va[5]); o.w = pk2(va[6], va[7]);
            *(GAS v4u*)(BDA + (size_t)n * 128 + k8) = o;
            o.x = pk2(vp[0], vp[1]); o.y = pk2(vp[2], vp[3]); o.z = pk2(vp[4], vp[5]); o.w = pk2(vp[6], vp[7]);
            *(GAS v4u*)(BDP + (size_t)n * 128 + k8) = o;
        }
        for (int it = gt; it < 16 * 128 * 128 / 8; it += NGT) cvt8_store(a->sub_keys + (size_t)it * 8, SK + (size_t)it * 8);
        for (int it = gt; it < 16384 * 1024 / 8; it += NGT) { cvt8_store(a->expert_u + (size_t)it * 8, EU + (size_t)it * 8); cvt8_store(a->expert_v + (size_t)it * 8, EV + (size_t)it * 8); }
        for (int panel = bx; panel < NPANEL; panel += G)
            for (int r = wid; r < 256; r += NWAVES) { const size_t row = (size_t)panel * 256 + r; rms_row_to_bf16(a->x + row * DM, XN + row * DM, lane); }
    }
    GRID_BAR();

    if (MK_PH_HI > 1) {
        for (int panel = bx; panel < NPANEL; panel += G) {
            { pg8::Gemm g{WSP(bf16, WS_XN), WSP(bf16, WS_WIN), 1024, 1024, 1024, 0}; pg8::PanelSched S{panel, 14, 4, 2, 0}; pg8::EpiProj E{WSP(bf16, WS_PQ), WSP(bf16, WS_PK), WSP(bf16, WS_PU), WSP(bf16, WS_PG)};
              pg8::gemm_phase<pg8::EpiProj, pg8::PanelSched, true, true>(lds, g, S, E); }
            { pg8::Gemm g{WSP(bf16, WS_WIN) + (size_t)1024 * 1024, WSP(bf16, WS_XN), 1024, 1024, 1024, 0}; pg8::PanelSched S{panel, 2, 99, 0, 1}; pg8::EpiPlain E{WSP(bf16, WS_PVT), TOK};
              pg8::gemm_phase<pg8::EpiPlain, pg8::PanelSched, true, true>(lds, g, S, E); }
        }
    }
    GRID_BAR();

    for (int panel = bx; panel < NPANEL; panel += G) {
        const size_t prow = (size_t)panel * 256;
        if (MK_PH_HI > 2) { attn_panel(panel, WSP(bf16, WS_PQ), WSP(bf16, WS_PK), WSP(bf16, WS_PVT), WSP(bf16, WS_YA)); pool_panel(panel, WSP(bf16, WS_PU), WSP(bf16, WS_YP)); LOCAL_SEAM(); }
        if (MK_PH_HI > 3) {
            { pg8::Gemm g{WSP(bf16, WS_YA), WSP(bf16, WS_BDA), 128, 512, 128, 128}; pg8::PanelSched S{panel, 4, 99, 0, 0}; pg8::EpiMerge<false> E{WSP(bf16, WS_PG), WSP(bf16, WS_MG), 0};
              pg8::gemm_phase<pg8::EpiMerge<false>, pg8::PanelSched, true, true>(lds, g, S, E); }
            { pg8::Gemm g{WSP(bf16, WS_YP), WSP(bf16, WS_BDP), 128, 512, 128, 128}; pg8::PanelSched S{panel, 4, 99, 0, 0}; pg8::EpiMerge<true> E{WSP(bf16, WS_PG), WSP(bf16, WS_MG), 1024};
              pg8::gemm_phase<pg8::EpiMerge<true>, pg8::PanelSched, true, true>(lds, g, S, E); }
            LOCAL_SEAM();
        }
        if (MK_PH_HI > 4) {
            { pg8::Gemm g{WSP(bf16, WS_MG), WSP(bf16, WS_WOUT), 1024, 1024, 1024, 0}; pg8::PanelSched S{panel, 4, 99, 0, 0}; pg8::EpiRes E{kargs()->x, kargs()->out};
              pg8::gemm_phase<pg8::EpiRes, pg8::PanelSched, true, true>(lds, g, S, E); }
            LOCAL_SEAM();
        }
        if (MK_PH_HI > 5) {
            { const int tid = otid(), lane = tid & 63, wid = __builtin_amdgcn_readfirstlane(tid >> 6); const float* xo = kargs()->out; bf16* XN = WSP(bf16, WS_XN); for (int r = wid; r < 256; r += NWAVES) rms_row_to_bf16(xo + (prow + r) * DM, XN + (prow + r) * DM, lane); }
            LOCAL_SEAM();
        }
        if (MK_PH_HI > 6) {
            { pg8::Gemm g{WSP(bf16, WS_XN), WSP(bf16, WS_WQ), 1024, 1024, 1024, 0}; pg8::PanelSched S{panel, 8, 99, 0, 0}; pg8::EpiPlain E{WSP(bf16, WS_PG), 2048};
              pg8::gemm_phase<pg8::EpiPlain, pg8::PanelSched, true, true>(lds, g, S, E); }
            LOCAL_SEAM();
        }
        #define IDXP ((int*)(kargs()->ws + WS_YA + (size_t)panel * 262144))
#define GTP ((float*)(kargs()->ws + WS_YA + (size_t)panel * 262144 + 131072))
        if (MK_PH_HI > 7) { topk_panel(panel, WSP(bf16, WS_PG), WSP(bf16, WS_SK), IDXP, GTP, (LAS int*)lds); LOCAL_SEAM(); }
        if (MK_PH_HI > 8) { peer_panel(panel, WSP(bf16, WS_XN), IDXP, GTP, WSP(bf16, WS_EU), WSP(bf16, WS_EV), kargs()->out); LOCAL_SEAM(); }
        if (MK_PH_HI > 9) {
            { const int tid = otid(); const float* pp = kargs()->p; bf16* YP = WSP(bf16, WS_YP); for (int it = tid; it < 256 * 256 / 8; it += NTHR) { const int r = it >> 5, c8 = (it & 31) * 8; cvt8_store(pp + (prow + r) * 256 + c8, YP + (prow + r) * 512 + c8); } }
            LOCAL_SEAM();
            { pg8::Gemm g{WSP(bf16, WS_YP), WSP(bf16, WS_WPLE), 256, 512, 256, 0}; pg8::PanelSched S{panel, 4, 99, 0, 0}; pg8::EpiPlain E{WSP(bf16, WS_MG), 1024};
              pg8::gemm_phase<pg8::EpiPlain, pg8::PanelSched, true, true>(lds, g, S, E); }
            LOCAL_SEAM();
        }
        if (MK_PH_HI > 10) {
            { pg8::Gemm g{WSP(bf16, WS_XN), WSP(bf16, WS_WPG), 1024, 1024, 1024, 0}; pg8::PanelSched S{panel, 4, 99, 0, 0}; pg8::EpiGate E{kargs()->out, WSP(bf16, WS_MG)};
              pg8::gemm_phase<pg8::EpiGate, pg8::PanelSched, true, true>(lds, g, S, E); }
            LOCAL_SEAM();
        }
        if (MK_PH_HI > 11) {
            const int tid = otid(), lane = tid & 63, wid = __builtin_amdgcn_readfirstlane(tid >> 6);
            for (int r = wid; r < 256; r += NWAVES) {
                GAS f32x4* xr = (GAS f32x4*)(kargs()->out + (prow + r) * DM) + lane; const GAS f32x4* gr = (const GAS f32x4*)kargs()->norm_final + lane;
                f32x4 v[4]; float s = 0.f;
#pragma unroll
                for (int j = 0; j < 4; ++j) { v[j] = xr[64 * j]; s += (v[j].x * v[j].x + v[j].y * v[j].y) + (v[j].z * v[j].z + v[j].w * v[j].w); }
                const float rr = 1.f / sqrtf(wave_sum(s) * (1.f / DM) + RMS_EPS);
#pragma unroll
                for (int j = 0; j < 4; ++j) xr[64 * j] = v[j] * rr * gr[64 * j];
            }
        }
    }
#undef LOCAL_SEAM
}


#if MK_PH_HI < 99
namespace ref {
constexpr int D = 1024, NB = 8, S = 8192, T = NB * S;
constexpr int INW = 4096;
constexpr int NKEYS = 128, TOPK = 16, PH = 8;
constexpr float EPS = 1e-6f;

__device__ __forceinline__ float wave_sum(float v) {
#pragma unroll
    for (int o = 32; o > 0; o >>= 1) v += __shfl_xor(v, o);
    return v;
}
__device__ __forceinline__ float sigmoidf_(float x) { return 1.f / (1.f + expf(-x)); }

__global__ void __launch_bounds__(256) k_rms(const float* x, const float* g, float* out) {
    __shared__ float red[4];
    const size_t row = blockIdx.x;
    const float4 v = ((const float4*)(x + row * D))[threadIdx.x];
    float s = v.x * v.x + v.y * v.y + v.z * v.z + v.w * v.w;
    s = wave_sum(s);
    if ((threadIdx.x & 63) == 0) red[threadIdx.x >> 6] = s;
    __syncthreads();
    const float tot = red[0] + red[1] + red[2] + red[3];
    const float r = rsqrtf(tot * (1.f / D) + EPS);
    const float4 gg = ((const float4*)g)[threadIdx.x];
    float4 o; o.x = v.x * r * gg.x; o.y = v.y * r * gg.y; o.z = v.z * r * gg.z; o.w = v.w * r * gg.w;
    ((float4*)(out + row * D))[threadIdx.x] = o;
}

struct EpiStore { float* C; int ldc; int pad; __device__ void operator()(int r, int c, float v) const { C[(size_t)r * ldc + c] = v; } };
struct EpiResAdd { const float* R; float* C; int ldc; int pad; __device__ void operator()(int r, int c, float v) const { C[(size_t)r * ldc + c] = R[(size_t)r * ldc + c] + v; } };
struct EpiGate { const float* X; const float* E; float* C; int ldc; int pad;
    __device__ void operator()(int r, int c, float v) const { const size_t o = (size_t)r * ldc + c; C[o] = X[o] + sigmoidf_(v) * E[o]; } };

template <class Epi>
__global__ void __launch_bounds__(256) k_gemm(const float* __restrict__ A, const float* __restrict__ Bm, Epi epi, int lda, int ldb, int K, int pad_) {
    __shared__ float As[8][128 + 4];
    __shared__ float Bs[8][128 + 4];
    const int tid = threadIdx.x, tx = tid & 15, ty = tid >> 4;
    const int m0 = blockIdx.y * 128, n0 = blockIdx.x * 128;
    float acc[8][8];
#pragma unroll
    for (int i = 0; i < 8; ++i)
#pragma unroll
        for (int j = 0; j < 8; ++j) acc[i][j] = 0.f;
    const int ar = tid >> 1, ak = (tid & 1) * 4;
    const int bk = tid >> 5, bn = (tid & 31) * 4;
    for (int k0 = 0; k0 < K; k0 += 8) {
        const float4 av = *(const float4*)(A + (size_t)(m0 + ar) * lda + k0 + ak);
        const float4 bv = *(const float4*)(Bm + (size_t)(k0 + bk) * ldb + n0 + bn);
        As[ak + 0][ar] = av.x; As[ak + 1][ar] = av.y; As[ak + 2][ar] = av.z; As[ak + 3][ar] = av.w;
        *(float4*)&Bs[bk][bn] = bv;
        __syncthreads();
#pragma unroll
        for (int k = 0; k < 8; ++k) {
            const float4 a0 = *(const float4*)&As[k][ty * 8], a1 = *(const float4*)&As[k][ty * 8 + 4];
            const float4 b0 = *(const float4*)&Bs[k][tx * 8], b1 = *(const float4*)&Bs[k][tx * 8 + 4];
            const float a[8] = {a0.x, a0.y, a0.z, a0.w, a1.x, a1.y, a1.z, a1.w};
            const float b[8] = {b0.x, b0.y, b0.z, b0.w, b1.x, b1.y, b1.z, b1.w};
#pragma unroll
            for (int i = 0; i < 8; ++i)
#pragma unroll
                for (int j = 0; j < 8; ++j) acc[i][j] = fmaf(a[i], b[j], acc[i][j]);
        }
        __syncthreads();
    }
#pragma unroll
    for (int i = 0; i < 8; ++i)
#pragma unroll
        for (int j = 0; j < 8; ++j) epi(m0 + ty * 8 + i, n0 + tx * 8 + j, acc[i][j]);
}

__global__ void __launch_bounds__(64) k_attn(const float* __restrict__ proj, float* __restrict__ yatt) {
    const int t = blockIdx.x * 64 + threadIdx.x;
    const int h = blockIdx.y;
    float q[64], acc[64];
    const float* qp = proj + (size_t)t * INW + h * 64;
#pragma unroll
    for (int d = 0; d < 64; ++d) { q[d] = qp[d] * 0.125f; acc[d] = 0.f; }
    float surv = 1.f;
    for (int s = t - 1; s >= 0; --s) {
        const float* kp = proj + (size_t)s * INW + 512 + h * 64;
        float z = 0.f;
#pragma unroll
        for (int d = 0; d < 64; ++d) z = fmaf(q[d], kp[d], z);
        const float beta = 1.f / (1.f + expf(-z));
        const float w = beta * surv;
        const float* vp = kp + 512;
#pragma unroll
        for (int d = 0; d < 64; ++d) acc[d] = fmaf(w, vp[d], acc[d]);
        surv -= w;
        if (surv < 5.4e-20f) break;
    }
    float* o = yatt + (size_t)t * 512 + h * 64;
#pragma unroll
    for (int d = 0; d < 64; ++d) o[d] = acc[d];
}

__global__ void __launch_bounds__(256) k_pool(const float* __restrict__ proj, float* __restrict__ ypool) {
    const int i = blockIdx.x * 256 + threadIdx.x;
    const int t = i >> 9, c = i & 511, g = c >> 7, w = 2 << g;
    const int cnt = (t + 1 < w) ? (t + 1) : w;
    float s = 0.f;
    for (int j = 0; j < cnt; ++j) s += proj[(size_t)(t - j) * INW + 1536 + c];
    ypool[i] = s / (float)cnt - proj[(size_t)t * INW + 1536 + c];
}

__global__ void __launch_bounds__(256) k_merge(const float* __restrict__ proj, const float* __restrict__ yatt, const float* __restrict__ ypool,
                                               const float* __restrict__ wa, const float* __restrict__ wp, const float* __restrict__ pscale, float* __restrict__ merged) {
    const int t = blockIdx.x, tid = threadIdx.x;
    __shared__ float sa[512], sp[512];
    sa[tid] = yatt[(size_t)t * 512 + tid]; sa[tid + 256] = yatt[(size_t)t * 512 + tid + 256];
    sp[tid] = ypool[(size_t)t * 512 + tid]; sp[tid + 256] = ypool[(size_t)t * 512 + tid + 256];
    __syncthreads();
    for (int e = tid; e < D; e += 256) {
        const int h = e >> 7, ea = e & 127, g = e >> 8, ep = e & 255;
        float a = 0.f, p = 0.f;
        for (int d = 0; d < 64; ++d) a = fmaf(sa[h * 64 + d], wa[((size_t)h * 64 + d) * 128 + ea], a);
        for (int c = 0; c < 128; ++c) p = fmaf(sp[g * 128 + c], wp[((size_t)g * 128 + c) * 256 + ep], p);
        p *= pscale[e];
        const float ga = proj[(size_t)t * INW + 2048 + e], gp = proj[(size_t)t * INW + 3072 + e];
        merged[(size_t)t * D + e] = sigmoidf_(ga) * a + sigmoidf_(gp) * p;
    }
}

__global__ void __launch_bounds__(256) k_scores(const float* __restrict__ qp, const float* __restrict__ sk, float* __restrict__ sc) {
    const int t0 = blockIdx.x * 4, tid = threadIdx.x;
    __shared__ float sq[4][2048];
    for (int i = tid; i < 4 * 2048; i += 256) sq[i >> 11][i & 2047] = qp[(size_t)t0 * 2048 + i];
    __syncthreads();
    for (int j = tid; j < 2048; j += 256) {
        const int g = j >> 7;
        const float4* kr = (const float4*)(sk + (size_t)j * 128);
        float a0 = 0.f, a1 = 0.f, a2 = 0.f, a3 = 0.f;
        for (int d = 0; d < 32; ++d) {
            const float4 kv = kr[d];
            const float4 q0 = *(const float4*)&sq[0][g * 128 + d * 4], q1 = *(const float4*)&sq[1][g * 128 + d * 4];
            const float4 q2 = *(const float4*)&sq[2][g * 128 + d * 4], q3 = *(const float4*)&sq[3][g * 128 + d * 4];
            a0 = fmaf(q0.x, kv.x, a0); a0 = fmaf(q0.y, kv.y, a0); a0 = fmaf(q0.z, kv.z, a0); a0 = fmaf(q0.w, kv.w, a0);
            a1 = fmaf(q1.x, kv.x, a1); a1 = fmaf(q1.y, kv.y, a1); a1 = fmaf(q1.z, kv.z, a1); a1 = fmaf(q1.w, kv.w, a1);
            a2 = fmaf(q2.x, kv.x, a2); a2 = fmaf(q2.y, kv.y, a2); a2 = fmaf(q2.z, kv.z, a2); a2 = fmaf(q2.w, kv.w, a2);
            a3 = fmaf(q3.x, kv.x, a3); a3 = fmaf(q3.y, kv.y, a3); a3 = fmaf(q3.z, kv.z, a3); a3 = fmaf(q3.w, kv.w, a3);
        }
        sc[(size_t)(t0 + 0) * 2048 + j] = a0; sc[(size_t)(t0 + 1) * 2048 + j] = a1;
        sc[(size_t)(t0 + 2) * 2048 + j] = a2; sc[(size_t)(t0 + 3) * 2048 + j] = a3;
    }
}

__device__ __forceinline__ void wave_argmax(float& v, int& i) {
#pragma unroll
    for (int o = 32; o > 0; o >>= 1) {
        const float ov = __shfl_xor(v, o); const int oi = __shfl_xor(i, o);
        if (ov > v || (ov == v && oi < i)) { v = ov; i = oi; }
    }
}

__global__ void __launch_bounds__(256) k_topk(const float* __restrict__ sc, int* __restrict__ idx, float* __restrict__ gates) {
    const int wv = threadIdx.x >> 6, lane = threadIdx.x & 63;
    const int pair = blockIdx.x * 4 + wv;
    const int t = pair >> 3, h = pair & 7;
    __shared__ float stop[4][2][16];
    __shared__ int itop[4][2][16];
    for (int c = 0; c < 2; ++c) {
        const float* sr = sc + (size_t)t * 2048 + (h * 2 + c) * 128;
        float v0 = sr[lane], v1 = sr[lane + 64];
        for (int k = 0; k < TOPK; ++k) {
            float bv; int bi;
            if (v1 > v0) { bv = v1; bi = lane + 64; } else { bv = v0; bi = lane; }
            wave_argmax(bv, bi);
            if (lane == 0) { stop[wv][c][k] = bv; itop[wv][c][k] = bi; }
            if (bi == lane) v0 = -INFINITY;
            if (bi == lane + 64) v1 = -INFINITY;
        }
    }
    __syncthreads();
    float cv[4];
#pragma unroll
    for (int j = 0; j < 4; ++j) { const int p = lane + 64 * j; cv[j] = stop[wv][0][p >> 4] + stop[wv][1][p & 15]; }
    __shared__ float sbs[4][16];
    __shared__ int sbp[4][16];
    for (int k = 0; k < TOPK; ++k) {
        float bv = cv[0]; int bi = lane;
#pragma unroll
        for (int j = 1; j < 4; ++j) if (cv[j] > bv) { bv = cv[j]; bi = lane + 64 * j; }
        wave_argmax(bv, bi);
        if (lane == 0) { sbs[wv][k] = bv; sbp[wv][k] = bi; }
#pragma unroll
        for (int j = 0; j < 4; ++j) if (bi == lane + 64 * j) cv[j] = -INFINITY;
    }
    __syncthreads();
    const float mx = sbs[wv][0];
    const float myv = (lane < TOPK) ? sbs[wv][lane] : -INFINITY;
    const float ex = (lane < TOPK) ? expf(myv - mx) : 0.f;
    const float den = wave_sum(ex);
    if (lane < TOPK) {
        const int myp = sbp[wv][lane];
        const int e = itop[wv][0][myp >> 4] * NKEYS + itop[wv][1][myp & 15];
        idx[(size_t)t * 128 + h * 16 + lane] = e;
        gates[(size_t)t * 128 + h * 16 + lane] = ex / den;
    }
}

__global__ void __launch_bounds__(256) k_peer(const float* __restrict__ hn, const int* __restrict__ idx, const float* __restrict__ gates,
                                              const float* __restrict__ eu, const float* __restrict__ ev, float* xio) {
    const int t = blockIdx.x, tid = threadIdx.x, wv = tid >> 6, lane = tid & 63;
    __shared__ float coef[128];
    __shared__ int sidx[128];
    const float4* hr = (const float4*)(hn + (size_t)t * D);
    float4 hv[4];
#pragma unroll
    for (int j = 0; j < 4; ++j) hv[j] = hr[lane + 64 * j];
    if (tid < 128) sidx[tid] = idx[(size_t)t * 128 + tid];
    __syncthreads();
    for (int p = wv; p < 128; p += 4) {
        const float4* ur = (const float4*)(eu + (size_t)sidx[p] * D);
        float s = 0.f;
#pragma unroll
        for (int j = 0; j < 4; ++j) { const float4 u = ur[lane + 64 * j]; s += u.x * hv[j].x + u.y * hv[j].y + u.z * hv[j].z + u.w * hv[j].w; }
        s = wave_sum(s);
        const float act = 0.5f * s * (1.f + erff(s * 0.70710678118654752f));
        if (lane == 0) coef[p] = gates[(size_t)t * 128 + p] * act;
    }
    __syncthreads();
    float4 o = ((const float4*)(xio + (size_t)t * D))[tid];
    for (int p = 0; p < 128; ++p) {
        const float c = coef[p];
        const float4 v = ((const float4*)(ev + (size_t)sidx[p] * D))[tid];
        o.x = fmaf(c, v.x, o.x); o.y = fmaf(c, v.y, o.y); o.z = fmaf(c, v.z, o.z); o.w = fmaf(c, v.w, o.w);
    }
    ((float4*)(xio + (size_t)t * D))[tid] = o;
}

__global__ void __launch_bounds__(256) k_bf16_to_f32(const unsigned short* __restrict__ src, float* __restrict__ dst) {
    const size_t i = (size_t)blockIdx.x * 256 + threadIdx.x; dst[i] = __uint_as_float((unsigned)src[i] << 16);
}
__global__ void __launch_bounds__(128) k_gather_idx(const unsigned char* __restrict__ ya, int row0, int* __restrict__ idx, float* __restrict__ gates) {
    const int r = blockIdx.x, grow = row0 + r, panel = grow >> 8, lrow = grow & 255;
    const int* ip = (const int*)(ya + (size_t)panel * 262144); const float* gp = (const float*)(ya + (size_t)panel * 262144 + 131072);
    idx[(size_t)r * 128 + threadIdx.x] = ip[lrow * 128 + threadIdx.x]; gates[(size_t)r * 128 + threadIdx.x] = gp[lrow * 128 + threadIdx.x];
}
}
#endif

extern "C" void kernel_launch(void* const* d_in, const int* in_sizes, int n_in, void* d_out, int out_size, void* d_ws, size_t ws_size, hipStream_t stream) {
    static int grid = 0;
    if (grid == 0) {
        if (n_in != 17 || in_sizes[0] != TOK * DM || out_size != TOK * DM || ws_size < WS_END) { fprintf(stderr, "kernel_launch: unexpected shapes (n_in %d, in0 %d, out %d, ws %zu); nothing launched\n", n_in, n_in > 0 ? in_sizes[0] : -1, out_size, ws_size); grid = -1; return; }
        int dev = 0, cus = 0;
        if (hipGetDevice(&dev) != hipSuccess || hipDeviceGetAttribute(&cus, hipDeviceAttributeMultiprocessorCount, dev) != hipSuccess) { fprintf(stderr, "kernel_launch: device query failed\n"); grid = -1; return; }
        if (hipFuncSetAttribute((const void*)mega_fwd, hipFuncAttributeMaxDynamicSharedMemorySize, LDS_BYTES) != hipSuccess) { fprintf(stderr, "kernel_launch: hipFuncSetAttribute failed\n"); grid = -1; return; }
        int per_cu = 0;
        if (hipOccupancyMaxActiveBlocksPerMultiprocessor(&per_cu, (const void*)mega_fwd, NTHR, LDS_BYTES) != hipSuccess || per_cu < 1) fprintf(stderr, "kernel_launch: note: occupancy query reports %d workgroups per CU\n", per_cu);
        (void)hipGetLastError();
        grid = cus;
    }
    if (grid < 0) return;
    if (hipMemsetAsync((char*)d_ws + WS_CTL, 0, CTL_ZERO_BYTES, stream) != hipSuccess) { fprintf(stderr, "kernel_launch: memset failed\n"); return; }
    Args a{};
    a.x = (const float*)d_in[0]; a.p = (const float*)d_in[1]; a.norm_mix = (const float*)d_in[2]; a.w_in = (const float*)d_in[3]; a.w_att_up = (const float*)d_in[4];
    a.w_pool_group = (const float*)d_in[5]; a.pool_scale = (const float*)d_in[6]; a.w_out = (const float*)d_in[7]; a.norm_ffn = (const float*)d_in[8]; a.w_query = (const float*)d_in[9];
    a.sub_keys = (const float*)d_in[10]; a.expert_u = (const float*)d_in[11]; a.expert_v = (const float*)d_in[12]; a.norm_ple = (const float*)d_in[13]; a.w_ple_gate = (const float*)d_in[14];
    a.w_ple = (const float*)d_in[15]; a.norm_final = (const float*)d_in[16];
    a.out = (float*)d_out; a.ws = (unsigned char*)d_ws; a.ph_hi = MK_PH_HI; a.pad = 0;
    hipLaunchKernelGGL(mega_fwd, dim3(grid), dim3(NTHR), LDS_BYTES, stream, a);
    { const hipError_t le = hipPeekAtLastError(); if (le != hipSuccess) fprintf(stderr, "kernel_launch: launch failed: %s\n", hipGetErrorName(le)); }
#if MK_PH_HI < 99
    {
        using namespace ref;
        char* ws = (char*)d_ws; float* out = (float*)d_out;
        float* hbuf = (float*)(ws + 0 * MiB); float* qp = (float*)(ws + 32 * MiB); float* sc = (float*)(ws + 96 * MiB);
        int* idx = (int*)(ws + 160 * MiB); float* gates = (float*)(ws + 164 * MiB); float* ebuf = (float*)(ws + 168 * MiB);
        for (int b = 0; b < NB; ++b) {
            const float* pb = a.p + (size_t)b * S * 256; float* ob = out + (size_t)b * S * D;
#if MK_PH_HI == 5
            k_rms<<<S, 256, 0, stream>>>(ob, a.norm_ffn, hbuf);
            k_gemm<EpiStore><<<dim3(2048 / 128, S / 128), 256, 0, stream>>>(hbuf, a.w_query, EpiStore{qp, 2048}, D, 2048, D, 0);
            k_scores<<<S / 4, 256, 0, stream>>>(qp, a.sub_keys, sc);
            k_topk<<<S * 8 / 4, 256, 0, stream>>>(sc, idx, gates);
            k_peer<<<S, 256, 0, stream>>>(hbuf, idx, gates, a.expert_u, a.expert_v, ob);
#elif MK_PH_HI == 7
            k_rms<<<S, 256, 0, stream>>>(ob, a.norm_ffn, hbuf);
            k_bf16_to_f32<<<S * 2048 / 256, 256, 0, stream>>>((const unsigned short*)(ws + WS_PG) + (size_t)b * S * 2048, qp);
            k_scores<<<S / 4, 256, 0, stream>>>(qp, a.sub_keys, sc);
            k_topk<<<S * 8 / 4, 256, 0, stream>>>(sc, idx, gates);
            k_peer<<<S, 256, 0, stream>>>(hbuf, idx, gates, a.expert_u, a.expert_v, ob);
#elif MK_PH_HI == 8
            k_rms<<<S, 256, 0, stream>>>(ob, a.norm_ffn, hbuf);
            k_gather_idx<<<S, 128, 0, stream>>>((const unsigned char*)(ws + WS_YA), b * S, idx, gates);
            k_peer<<<S, 256, 0, stream>>>(hbuf, idx, gates, a.expert_u, a.expert_v, ob);
#endif
            k_rms<<<S, 256, 0, stream>>>(ob, a.norm_ple, hbuf);
            k_gemm<EpiStore><<<dim3(D / 128, S / 128), 256, 0, stream>>>(pb, a.w_ple, EpiStore{ebuf, D}, 256, D, 256, 0);
            k_gemm<EpiGate><<<dim3(D / 128, S / 128), 256, 0, stream>>>(hbuf, a.w_ple_gate, EpiGate{ob, ebuf, ob, D}, D, D, D, 0);
            k_rms<<<S, 256, 0, stream>>>(ob, a.norm_final, ob);
        }
    }
#endif
}
```

```cpp
#include <hip/hip_runtime.h>
#include <cstdio>
#include <cstdint>
#include <math.h>
__device__ __forceinline__ int lane_id() { int l; asm volatile("v_mbcnt_lo_u32_b32 %0, -1, 0\n\tv_mbcnt_hi_u32_b32 %0, -1, %0" : "=v"(l)); return l; }
__device__ __forceinline__ int otid(int wid0) { return (wid0 << 6) | lane_id(); }

namespace pg8 {
#define PG8_LAS __attribute__((address_space(3)))
typedef unsigned short bf16_t;
typedef short bf16x8 __attribute__((ext_vector_type(8)));
typedef float f32x4 __attribute__((ext_vector_type(4)));
typedef unsigned u32x4 __attribute__((ext_vector_type(4)));
constexpr int BM = 256, BK = 64, HALF = 128, HTB = HALF * BK * 2  , STAGE_BYTES = 8 * HTB, NXCD = 8, WGM = 8;

__host__ __device__ __forceinline__ int lds_byte(int r, int c) { const int st = (r >> 4) * 2 + (c >> 5), rr = r & 15, cc = c & 31, ob = rr * 64 + cc * 2; return st * 1024 + (ob ^ (((ob >> 9) & 1) << 5)); }
__host__ __device__ __forceinline__ void stage_rc(int b, int& R, int& C) { const int st = b / 1024, sb = b % 1024, swz = sb ^ (((sb >> 9) & 1) << 5); R = (st >> 1) * 16 + swz / 64; C = (st & 1) * 32 + (swz % 64) / 2; }
__host__ __device__ __forceinline__ int perm32(int rho) { const int n = rho >> 4, i = rho & 15; return 8 * (i >> 2) + 4 * n + (i & 3); }

struct Unit { int pm, pn; };
struct Gemm { const bf16_t* A; const bf16_t* Bt; int K, lda, ldb, akoff; };

struct StaticOrder {
    int nM, nN, nwg, G, c;
    __host__ __device__ void init(int M, int N, int G_, int c_) { nM = M / BM; nN = N / BM; nwg = nM * nN; G = G_; c = c_; }
    __host__ __device__ bool next(int i, Unit& u) const {
        const long L = (long)i * G + c; if (L >= nwg) return false;
        int wgid = (int)L; { const int q = nwg / NXCD, r = nwg % NXCD, xcd = wgid % NXCD, off = wgid / NXCD; wgid = (xcd < r ? xcd * (q + 1) : r * (q + 1) + (xcd - r) * q) + off; }
        const int nig = WGM * nN, gid = wgid / nig, fm = gid * WGM, gsz = (nM - fm) < WGM ? (nM - fm) : WGM;
        u.pm = fm + ((wgid % nig) % gsz); u.pn = (wgid % nig) / gsz; return true;
    }
    __device__ __forceinline__ void a_ready(const Unit&) const {}
    __device__ __forceinline__ void done(const Unit&) const {}
};

template <class Epi, class Sched, bool ALIGN_EPI = false, bool SP2 = false>
__device__ __forceinline__ void gemm_phase(PG8_LAS unsigned char* lds, const Gemm g, const Sched& S, const Epi& E, const int wid0) {
    const int tid = otid(wid0), wid = __builtin_amdgcn_readfirstlane(tid >> 6), lane = tid & 63, wr = wid >> 2, wc = wid & 3, fr = lane & 15, fq = lane >> 4;
    const int K = g.K, nt = K / BK;
    unsigned voffA[2], voffB[2];
#pragma unroll
    for (int i = 0; i < 2; ++i) { int R, C; stage_rc(tid * 16 + i * 8192, R, C); const int Rb = Epi::PERM ? ((R & ~31) + perm32(R & 31)) : R;
        voffA[i] = (unsigned)(R * g.lda + C) * 2u; voffB[i] = (unsigned)(Rb * g.ldb + C) * 2u; }
    const size_t kstep = (size_t)(BK * 2);
    const size_t hstepA = (size_t)HALF * g.lda * 2, hstepB = (size_t)HALF * g.ldb * 2;
    const size_t tstepA = 2 * hstepA, tstepB = 2 * hstepB, akb = (size_t)g.akoff * 2;
    const unsigned ldsw = (unsigned)wid * 1024u;
    const int aoff = lds_byte(wr * 64 + fr, fq * 8), boff = lds_byte(wc * 32 + fr, fq * 8);
#define PG8_SA(b, h) (((b) * 2 + (h)) * HTB)
#define PG8_SB(b, h) ((4 + (b) * 2 + (h)) * HTB)
#define PG8_STAGE(bufoff, gbase, voff) do { _Pragma("unroll") for (int _i = 0; _i < 2; ++_i) \
        __builtin_amdgcn_global_load_lds((const unsigned*)((const char*)(gbase) + (voff)[_i]), (PG8_LAS unsigned*)(lds + (bufoff) + ldsw + _i * 8192), 16, 0, 0); } while (0)
#define PG8_LDA(dst, b, h) do { _Pragma("unroll") for (int m = 0; m < 4; ++m) _Pragma("unroll") for (int k = 0; k < 2; ++k) dst[m][k] = *(const PG8_LAS bf16x8*)(lds + PG8_SA(b, h) + aoff + m * 2048 + k * 1024); } while (0)
#define PG8_LDB(dst, b, h) do { _Pragma("unroll") for (int n = 0; n < 2; ++n) _Pragma("unroll") for (int k = 0; k < 2; ++k) dst[n][k] = *(const PG8_LAS bf16x8*)(lds + PG8_SB(b, h) + boff + n * 2048 + k * 1024); } while (0)
#define PG8_MMA(ai, bj, At, Bt) do { __builtin_amdgcn_s_setprio(1); _Pragma("unroll") for (int m = 0; m < 4; ++m) _Pragma("unroll") for (int n = 0; n < 2; ++n) _Pragma("unroll") for (int k = 0; k < 2; ++k) \
        acc[ai][bj][m][n] = __builtin_amdgcn_mfma_f32_16x16x32_bf16(Bt[n][k], At[m][k], acc[ai][bj][m][n], 0, 0, 0); __builtin_amdgcn_s_setprio(0); } while (0)
#define PG8_WAIT_V(n) asm volatile("s_waitcnt vmcnt(" #n ")" ::: "memory")
#define PG8_WAIT_L(n) asm volatile("s_waitcnt lgkmcnt(" #n ")" ::: "memory")
#define PG8_BAR __builtin_amdgcn_s_barrier()
#define PG8_SCHED __builtin_amdgcn_sched_barrier(0)
    Unit cur, nxt; int ui = 0;
    if (!S.next(0, cur)) return;
    f32x4 acc[2][2][4][2];
#pragma unroll
    for (int a = 0; a < 2; ++a)
#pragma unroll
        for (int b = 0; b < 2; ++b)
#pragma unroll
            for (int m = 0; m < 4; ++m)
#pragma unroll
                for (int n = 0; n < 2; ++n) acc[a][b][m][n] = (f32x4){0.f, 0.f, 0.f, 0.f};
    bf16x8 At[4][2], B0[2][2], B1[2][2];
    const char* cA = (const char*)g.A + (size_t)cur.pm * tstepA + (size_t)cur.pn * akb; const char* cB = (const char*)g.Bt + (size_t)cur.pn * tstepB;
    S.a_ready(cur);
    if constexpr (SP2) {
        PG8_STAGE(PG8_SB(0, 0), cB, voffB); PG8_STAGE(PG8_SB(0, 1), cB + hstepB, voffB); PG8_STAGE(PG8_SA(0, 0), cA, voffA); PG8_STAGE(PG8_SA(0, 1), cA + hstepA, voffA);
        if (wr == 1) PG8_BAR;
        PG8_WAIT_V(2); PG8_BAR;
        PG8_STAGE(PG8_SB(1, 0), cB + kstep, voffB); PG8_STAGE(PG8_SA(1, 0), cA + kstep, voffA); PG8_STAGE(PG8_SB(1, 1), cB + hstepB + kstep, voffB);
        PG8_WAIT_V(6); PG8_BAR;
    } else {
        PG8_STAGE(PG8_SB(0, 0), cB, voffB); PG8_STAGE(PG8_SA(0, 0), cA, voffA); PG8_STAGE(PG8_SB(0, 1), cB + hstepB, voffB); PG8_STAGE(PG8_SA(0, 1), cA + hstepA, voffA);
        if (wr == 1) PG8_BAR;
        PG8_WAIT_V(4); PG8_BAR;
        PG8_STAGE(PG8_SB(1, 0), cB + kstep, voffB); PG8_STAGE(PG8_SA(1, 0), cA + kstep, voffA); PG8_STAGE(PG8_SB(1, 1), cB + hstepB + kstep, voffB);
        PG8_WAIT_V(6); PG8_BAR;
    }
    for (;;) {
        const bool has_next = S.next(ui + 1, nxt);
        const char* nA = has_next ? (const char*)g.A + (size_t)nxt.pm * tstepA + (size_t)nxt.pn * akb : cA; const char* nB = has_next ? (const char*)g.Bt + (size_t)nxt.pn * tstepB : cB;
        for (int t = 0; t < nt; t += 2) {
            const bool last = (t == nt - 2);
            const char* a1 = cA + (size_t)(t + 1) * kstep;
            const char* a2 = last ? nA : cA + (size_t)(t + 2) * kstep; const char* b2 = last ? nB : cB + (size_t)(t + 2) * kstep;
            const char* a3 = a2 + kstep; const char* b3 = b2 + kstep;
            if (last && has_next) S.a_ready(nxt);
            if constexpr (SP2) {
            PG8_LDB(B0, 0, 0); PG8_LDB(B1, 0, 1); PG8_SCHED; PG8_LDA(At, 0, 0); PG8_STAGE(PG8_SA(1, 1), a1 + hstepA, voffA);
            PG8_WAIT_V(8); PG8_WAIT_L(0); PG8_BAR; PG8_MMA(0, 0, At, B0); PG8_MMA(0, 1, At, B1); PG8_BAR; PG8_SCHED;
            PG8_LDA(At, 0, 1); PG8_STAGE(PG8_SB(0, 0), b2, voffB); PG8_STAGE(PG8_SB(0, 1), b2 + hstepB, voffB); PG8_STAGE(PG8_SA(0, 0), a2, voffA);
            PG8_WAIT_V(8); PG8_WAIT_L(0); PG8_BAR; PG8_MMA(1, 0, At, B0); PG8_MMA(1, 1, At, B1); PG8_BAR; PG8_SCHED;
            PG8_LDB(B0, 1, 0); PG8_LDB(B1, 1, 1); PG8_SCHED; PG8_LDA(At, 1, 0); PG8_STAGE(PG8_SA(0, 1), a2 + hstepA, voffA);
            PG8_WAIT_V(8); PG8_WAIT_L(0); PG8_BAR; PG8_MMA(0, 0, At, B0); PG8_MMA(0, 1, At, B1); PG8_BAR; PG8_SCHED;
            PG8_LDA(At, 1, 1); PG8_STAGE(PG8_SB(1, 0), b3, voffB); PG8_STAGE(PG8_SB(1, 1), b3 + hstepB, voffB); PG8_STAGE(PG8_SA(1, 0), a3, voffA);
            PG8_WAIT_V(8); PG8_WAIT_L(0); PG8_BAR; PG8_MMA(1, 0, At, B0); PG8_MMA(1, 1, At, B1); PG8_BAR; PG8_SCHED;
            } else {
            PG8_LDB(B0, 0, 0); PG8_SCHED; PG8_LDA(At, 0, 0); PG8_STAGE(PG8_SA(1, 1), a1 + hstepA, voffA);
            PG8_WAIT_L(8); PG8_BAR; PG8_WAIT_L(0); PG8_MMA(0, 0, At, B0); PG8_BAR; PG8_SCHED;
            PG8_LDB(B1, 0, 1); PG8_STAGE(PG8_SB(0, 0), b2, voffB);
            PG8_BAR; PG8_WAIT_L(0); PG8_MMA(0, 1, At, B1); PG8_BAR;
            PG8_LDA(At, 0, 1); PG8_STAGE(PG8_SA(0, 0), a2, voffA);
            PG8_BAR; PG8_WAIT_L(0); PG8_MMA(1, 0, At, B0); PG8_BAR; PG8_SCHED;
            PG8_STAGE(PG8_SB(0, 1), b2 + hstepB, voffB);
            PG8_WAIT_V(6); PG8_BAR; PG8_MMA(1, 1, At, B1); PG8_BAR;
            PG8_LDB(B0, 1, 0); PG8_SCHED; PG8_LDA(At, 1, 0); PG8_STAGE(PG8_SA(0, 1), a2 + hstepA, voffA);
            PG8_WAIT_L(8); PG8_BAR; PG8_WAIT_L(0); PG8_MMA(0, 0, At, B0); PG8_BAR; PG8_SCHED;
            PG8_LDB(B1, 1, 1); PG8_STAGE(PG8_SB(1, 0), b3, voffB);
            PG8_BAR; PG8_WAIT_L(0); PG8_MMA(0, 1, At, B1); PG8_BAR;
            PG8_LDA(At, 1, 1); PG8_STAGE(PG8_SA(1, 0), a3, voffA);
            PG8_BAR; PG8_WAIT_L(0); PG8_MMA(1, 0, At, B0); PG8_BAR; PG8_SCHED;
            PG8_STAGE(PG8_SB(1, 1), b3 + hstepB, voffB);
            PG8_WAIT_V(6); PG8_BAR; PG8_MMA(1, 1, At, B1); PG8_BAR;
            }
        }
        if constexpr (ALIGN_EPI) { if (wr == 0) PG8_BAR; }
        if constexpr (!Epi::AFTER_DRAIN) { E(acc, cur, wr, wc, fr, fq); S.done(cur); }
        if (!has_next) break;
#pragma unroll
        for (int a = 0; a < 2; ++a)
#pragma unroll
            for (int b = 0; b < 2; ++b)
#pragma unroll
                for (int m = 0; m < 4; ++m)
#pragma unroll
                    for (int n = 0; n < 2; ++n) acc[a][b][m][n] = (f32x4){0.f, 0.f, 0.f, 0.f};
        cur = nxt; cA = nA; cB = nB; ++ui;
        if constexpr (ALIGN_EPI) { if (wr == 1) PG8_BAR; }
    }
    PG8_WAIT_V(0);
    if constexpr (!ALIGN_EPI) { if (wr == 0) PG8_BAR; }
    PG8_BAR;
    if constexpr (Epi::AFTER_DRAIN) { E.fused(acc, cur, wr, wc, fr, fq, lds, wid, lane); S.done(cur); }
#undef PG8_SA
#undef PG8_SB
#undef PG8_STAGE
#undef PG8_LDA
#undef PG8_LDB
#undef PG8_MMA
#undef PG8_WAIT_V
#undef PG8_WAIT_L
#undef PG8_BAR
#undef PG8_SCHED
}
}


namespace pg8 {
typedef unsigned u32x2 __attribute__((ext_vector_type(2)));
__device__ __forceinline__ unsigned cvt_pk_bf16(float lo, float hi) { unsigned r; asm volatile("v_cvt_pk_bf16_f32 %0, %1, %2" : "=v"(r) : "v"(lo), "v"(hi)); return r; }
__device__ __forceinline__ float sigm(float x) { return __builtin_amdgcn_rcpf(1.0f + __builtin_amdgcn_exp2f(-1.4426950408889634f * x)); }
__device__ __forceinline__ float bf_lo(unsigned w) { return __uint_as_float(w << 16); }
__device__ __forceinline__ float bf_hi(unsigned w) { return __uint_as_float(w & 0xffff0000u); }

struct PanelSched {
    int panel, n, skip_lo, skip_n, mode;
    __device__ __forceinline__ bool next(int i, Unit& u) const {
        if (i >= n) return false;
        if (mode == 0) { u.pm = panel; u.pn = i + (i >= skip_lo ? skip_n : 0); } else { u.pm = i; u.pn = panel; }
        return true;
    }
    __device__ __forceinline__ void a_ready(const Unit&) const {}
    __device__ __forceinline__ void done(const Unit&) const {}
};

struct EpiProj {
    static constexpr bool PERM = true, AFTER_DRAIN = false;
    bf16_t *PQ, *PK, *PU, *PG;
    __device__ __forceinline__ void operator()(const f32x4 (&acc)[2][2][4][2], const Unit& u, int wr, int wc, int fr, int fq) const {
        const int pn = u.pn; bf16_t* base; int ld, colt; bool sg = false;
        if (pn < 2) { base = PQ; ld = 512; colt = pn * 256; }
        else if (pn < 4) { base = PK; ld = 512; colt = (pn - 2) * 256; }
        else if (pn < 8) { base = PU; ld = 512; colt = (pn - 6) * 256; }
        else { base = PG; ld = 2048; colt = (pn - 8) * 256; sg = true; }
        const int row0 = u.pm * BM + wr * 64 + fr, col0 = colt + wc * 32 + 8 * fq;
#pragma unroll
        for (int ai = 0; ai < 2; ++ai)
#pragma unroll
            for (int m = 0; m < 4; ++m) { bf16_t* rowp = base + (size_t)(row0 + ai * HALF + m * 16) * ld + col0;
#pragma unroll
                for (int bj = 0; bj < 2; ++bj) { f32x4 v0 = acc[ai][bj][m][0], v1 = acc[ai][bj][m][1];
                    if (sg) { v0 = (f32x4){sigm(v0[0]), sigm(v0[1]), sigm(v0[2]), sigm(v0[3])}; v1 = (f32x4){sigm(v1[0]), sigm(v1[1]), sigm(v1[2]), sigm(v1[3])}; }
                    u32x4 w; w.x = cvt_pk_bf16(v0[0], v0[1]); w.y = cvt_pk_bf16(v0[2], v0[3]); w.z = cvt_pk_bf16(v1[0], v1[1]); w.w = cvt_pk_bf16(v1[2], v1[3]);
                    *(u32x4*)(rowp + bj * HALF) = w; } }
    }
};
struct EpiPlain {
    static constexpr bool PERM = true, AFTER_DRAIN = false;
    bf16_t* O; int ldc;
    __device__ __forceinline__ void operator()(const f32x4 (&acc)[2][2][4][2], const Unit& u, int wr, int wc, int fr, int fq) const {
        const int row0 = u.pm * BM + wr * 64 + fr, col0 = u.pn * BM + wc * 32 + 8 * fq;
#pragma unroll
        for (int ai = 0; ai < 2; ++ai)
#pragma unroll
            for (int m = 0; m < 4; ++m) { bf16_t* rowp = O + (size_t)(row0 + ai * HALF + m * 16) * ldc + col0;
#pragma unroll
                for (int bj = 0; bj < 2; ++bj) { const f32x4 v0 = acc[ai][bj][m][0], v1 = acc[ai][bj][m][1];
                    u32x4 w; w.x = cvt_pk_bf16(v0[0], v0[1]); w.y = cvt_pk_bf16(v0[2], v0[3]); w.z = cvt_pk_bf16(v1[0], v1[1]); w.w = cvt_pk_bf16(v1[2], v1[3]);
                    *(u32x4*)(rowp + bj * HALF) = w; } }
    }
};
template <bool ADD> struct EpiMerge {
    static constexpr bool PERM = true, AFTER_DRAIN = false;
    const bf16_t* G; bf16_t* MG; int goff;
    __device__ __forceinline__ void operator()(const f32x4 (&acc)[2][2][4][2], const Unit& u, int wr, int wc, int fr, int fq) const {
        const int row0 = u.pm * BM + wr * 64 + fr, col0 = u.pn * BM + wc * 32 + 8 * fq;
#pragma unroll
        for (int ai = 0; ai < 2; ++ai)
#pragma unroll
            for (int m = 0; m < 4; ++m) { const size_t row = (size_t)(row0 + ai * HALF + m * 16);
#pragma unroll
                for (int bj = 0; bj < 2; ++bj) { const f32x4 v0 = acc[ai][bj][m][0], v1 = acc[ai][bj][m][1];
                    const u32x4 gw = *(const u32x4*)(G + row * 2048 + goff + col0 + bj * HALF);
                    float r0 = bf_lo(gw.x) * v0[0], r1 = bf_hi(gw.x) * v0[1], r2 = bf_lo(gw.y) * v0[2], r3 = bf_hi(gw.y) * v0[3];
                    float r4 = bf_lo(gw.z) * v1[0], r5 = bf_hi(gw.z) * v1[1], r6 = bf_lo(gw.w) * v1[2], r7 = bf_hi(gw.w) * v1[3];
                    bf16_t* mp = MG + row * 1024 + col0 + bj * HALF;
                    if (ADD) { const u32x4 pw = *(const u32x4*)mp;
                        r0 += bf_lo(pw.x); r1 += bf_hi(pw.x); r2 += bf_lo(pw.y); r3 += bf_hi(pw.y); r4 += bf_lo(pw.z); r5 += bf_hi(pw.z); r6 += bf_lo(pw.w); r7 += bf_hi(pw.w); }
                    u32x4 w; w.x = cvt_pk_bf16(r0, r1); w.y = cvt_pk_bf16(r2, r3); w.z = cvt_pk_bf16(r4, r5); w.w = cvt_pk_bf16(r6, r7);
                    *(u32x4*)mp = w; }
                asm volatile("" ::: "memory"); }
    }
};
struct EpiRes {
    static constexpr bool PERM = false, AFTER_DRAIN = false;
    const float* X; float* OUT;
    __device__ __forceinline__ void operator()(const f32x4 (&acc)[2][2][4][2], const Unit& u, int wr, int wc, int fr, int fq) const {
        const int col0 = u.pn * BM + wc * 32 + 4 * fq;
#pragma unroll
        for (int ai = 0; ai < 2; ++ai)
#pragma unroll
            for (int m = 0; m < 4; ++m) { const size_t off = (size_t)(u.pm * BM + ai * HALF + wr * 64 + m * 16 + fr) * 1024 + col0;
#pragma unroll
                for (int bj = 0; bj < 2; ++bj)
#pragma unroll
                    for (int n = 0; n < 2; ++n) { const f32x4 xs = *(const f32x4*)(X + off + bj * HALF + n * 16); *(f32x4*)(OUT + off + bj * HALF + n * 16) = xs + acc[ai][bj][m][n]; }
                asm volatile("" ::: "memory"); }
    }
};
struct EpiGate {
    static constexpr bool PERM = false, AFTER_DRAIN = false;
    float* OUT; const bf16_t* E;
    __device__ __forceinline__ void operator()(const f32x4 (&acc)[2][2][4][2], const Unit& u, int wr, int wc, int fr, int fq) const {
        const int col0 = u.pn * BM + wc * 32 + 4 * fq;
#pragma unroll
        for (int ai = 0; ai < 2; ++ai)
#pragma unroll
            for (int m = 0; m < 4; ++m) { const size_t off = (size_t)(u.pm * BM + ai * HALF + wr * 64 + m * 16 + fr) * 1024 + col0;
#pragma unroll
                for (int bj = 0; bj < 2; ++bj)
#pragma unroll
                    for (int n = 0; n < 2; ++n) { const size_t o2 = off + bj * HALF + n * 16; const f32x4 xs = *(const f32x4*)(OUT + o2); const u32x2 ew = *(const u32x2*)(E + o2); const f32x4 a = acc[ai][bj][m][n];
                        f32x4 r; r[0] = xs[0] + sigm(a[0]) * bf_lo(ew.x); r[1] = xs[1] + sigm(a[1]) * bf_hi(ew.x); r[2] = xs[2] + sigm(a[2]) * bf_lo(ew.y); r[3] = xs[3] + sigm(a[3]) * bf_hi(ew.y);
                        *(f32x4*)(OUT + o2) = r; }
                asm volatile("" ::: "memory"); }
    }
};
}

#define GAS __attribute__((address_space(1)))
#define LAS __attribute__((address_space(3)))
typedef unsigned short bf16;
typedef unsigned v4u __attribute__((ext_vector_type(4)));
typedef float f32x4 __attribute__((ext_vector_type(4)));
typedef short bf16x8 __attribute__((ext_vector_type(8)));
typedef GAS unsigned gu32;
typedef GAS unsigned long long gu64;
#define RLX_AGENT __ATOMIC_RELAXED, __HIP_MEMORY_SCOPE_AGENT
#define LDS_WAIT() asm volatile("s_waitcnt lgkmcnt(0)" ::: "memory")
#define VM_WAIT() asm volatile("s_waitcnt vmcnt(0)" ::: "memory")
__device__ __forceinline__ unsigned long long rt() { return __builtin_amdgcn_s_memrealtime(); }
__device__ __forceinline__ unsigned f2bf(float f) { unsigned u = __builtin_bit_cast(unsigned, f); return (u + 0x7fffu + ((u >> 16) & 1u)) >> 16; }
__device__ __forceinline__ unsigned pk2(float lo, float hi) { return f2bf(lo) | (f2bf(hi) << 16); }

#define XB_TMO      128
#define XB_XCNT(j)  (256  + 64 * (j))
#define XB_XSUB(j)  (1280 + 64 * (j))
#define XB_XGEN(j)  (2304 + 64 * (j))
#define XB_TOP      3328
#define XB_TOPGEN   3392
#define XCD_BAR_WORDS 3456
#define XB_SPIN_CAP (1u << 18)

__device__ __forceinline__ unsigned xb_ld(unsigned* p)              { return __hip_atomic_load(p, __ATOMIC_RELAXED, __HIP_MEMORY_SCOPE_AGENT); }
__device__ __forceinline__ unsigned xb_add(unsigned* p, unsigned v) { return __hip_atomic_fetch_add(p, v, __ATOMIC_RELAXED, __HIP_MEMORY_SCOPE_AGENT); }
__device__ __forceinline__ unsigned xb_xcc_id() { return (unsigned)__builtin_amdgcn_s_getreg((3 << 11) | 20) & 0xFu; }
#define XB_SPIN(cond, bar) do { unsigned _sp = 0; while (cond) { __builtin_amdgcn_s_sleep(1); \
    if ((++_sp & 255u) == 0u) { if (xb_ld(&(bar)[XB_TMO])) break; if (_sp > XB_SPIN_CAP) { atomicAdd(&(bar)[XB_TMO], 1u); break; } } } } while (0)

struct XcdBarrier {
    unsigned* bar; unsigned x;
    volatile LAS unsigned* st;
};

__device__ __forceinline__ XcdBarrier xcd_barrier_post(unsigned* bar, volatile LAS unsigned* st, const bool is_t0) {
    XcdBarrier b; b.bar = bar; b.x = xb_xcc_id(); b.st = st;
    if (is_t0) (void)xb_add(&bar[XB_XCNT(b.x)], 1u);
    return b;
}
__device__ __forceinline__ void xcd_barrier_complete(unsigned* bar, unsigned x, unsigned& nloc, unsigned& nx) {
    const unsigned G = gridDim.x * gridDim.y * gridDim.z;
    unsigned sum, cnt, mine, sp = 0u;
    for (;;) {
        sum = 0u; cnt = 0u; mine = 0u;
#pragma unroll
        for (unsigned j = 0; j < 16; ++j) { const unsigned c = xb_ld(&bar[XB_XCNT(j)]); sum += c; cnt += (c > 0u) ? 1u : 0u; mine = (j == x) ? c : mine; }
        if (sum == G) break;
        __builtin_amdgcn_s_sleep(1);
        if ((++sp & 255u) == 0u) { if (xb_ld(&bar[XB_TMO])) break; if (sp > XB_SPIN_CAP) { atomicAdd(&bar[XB_TMO], 1u); break; } }
    }
    nloc = mine > 0u ? mine : 1u; nx = cnt > 0u ? cnt : 1u;
}

__device__ __forceinline__ void xcd_barrier(const XcdBarrier& b, const bool is_t0) {
    asm volatile("s_waitcnt vmcnt(0)" ::: "memory");
    __syncthreads();
    if (is_t0) {
        unsigned* bar = b.bar;
        __builtin_amdgcn_s_waitcnt(0);
        unsigned nloc = b.st[0], nx = b.st[1];
        if (nloc == 0u) { xcd_barrier_complete(bar, b.x, nloc, nx); b.st[0] = nloc; b.st[1] = nx; }
        const unsigned old = xb_add(&bar[XB_XSUB(b.x)], 1u);
        const unsigned gen = old / nloc;
        if (old + 1u == (gen + 1u) * nloc) {
            __builtin_amdgcn_fence(__ATOMIC_RELEASE, "agent");
            asm volatile("s_waitcnt vmcnt(0)" ::: "memory");
            const unsigned og = xb_add(&bar[XB_TOP], 1u);
            const unsigned tg = og / nx;
            if (og + 1u == (tg + 1u) * nx) xb_add(&bar[XB_TOPGEN], 1u);
            else XB_SPIN(xb_ld(&bar[XB_TOPGEN]) == tg, bar);
            __builtin_amdgcn_fence(__ATOMIC_ACQUIRE, "agent");
            xb_add(&bar[XB_XGEN(b.x)], 1u);
            asm volatile("s_waitcnt vmcnt(0)" ::: "memory");
        } else {
            XB_SPIN(xb_ld(&bar[XB_XGEN(b.x)]) == gen, bar);
            __builtin_amdgcn_fence(__ATOMIC_ACQUIRE, "agent");
            asm volatile("s_waitcnt vmcnt(0)" ::: "memory");
        }
    }
    __syncthreads();
}


constexpr int NWAVES = 8, NTHR = 512;
constexpr int TOK = 65536, DM = 1024, SEQ = 8192, NPANEL = 256;
constexpr float RMS_EPS = 1e-6f;
constexpr float C2 = 0.125f * 1.4426950408889634f;
constexpr float SURV_THR = 5.4210108624275222e-20f;
constexpr size_t MiB = 1u << 20;
constexpr size_t WS_CTL = 0, CTL_ZERO_BYTES = 64 * 1024;
constexpr size_t WS_WIN = 2 * MiB, WS_WOUT = 10 * MiB, WS_WQ = 12 * MiB, WS_WPG = 16 * MiB, WS_WPLE = 18 * MiB;
constexpr size_t WS_BDA = 18 * MiB + 512 * 1024, WS_BDP = 18 * MiB + 768 * 1024, WS_SK = 19 * MiB;
constexpr size_t WS_EU = 32 * MiB, WS_EV = 64 * MiB, WS_SU = 20 * MiB, WS_SV = 20 * MiB + 65536;
constexpr size_t WS_XN = 96 * MiB;
constexpr size_t WS_PQ = 224 * MiB, WS_PK = 288 * MiB, WS_PVT = 352 * MiB, WS_PU = 416 * MiB;
constexpr size_t WS_PG = 480 * MiB;
constexpr size_t WS_YA = 736 * MiB, WS_YP = 800 * MiB;
constexpr size_t WS_MG = 864 * MiB, WS_END = 992 * MiB;
constexpr int CW_BAR = 1024;
constexpr int RING_BYTES = 131072, LDSCTL_OFF = RING_BYTES, MISC_OFF = LDSCTL_OFF + 320, LDS_BYTES = 147456;

typedef float f32x16 __attribute__((ext_vector_type(16)));
typedef float f32x2 __attribute__((ext_vector_type(2)));
typedef __bf16 bf16x2v __attribute__((ext_vector_type(2)));

__device__ __forceinline__ float wave_sum(float v) {
#pragma unroll
    for (int o = 1; o < 64; o <<= 1) v += __shfl_xor(v, o);
    return v;
}
__device__ __forceinline__ float bflo(unsigned w) { return __uint_as_float(w << 16); }
__device__ __forceinline__ float bfhi(unsigned w) { return __uint_as_float(w & 0xffff0000u); }
__device__ __forceinline__ unsigned cvtpk(float lo, float hi) { return pg8::cvt_pk_bf16(lo, hi); }

__device__ __forceinline__ void p0_transpose_item(const float* W, int K, int N, bf16* WT, const float* kscale, int nlo, float nls, LAS float* scr, int item, int lane) {
    const int nblk = N / 32, kb = item / nblk, nb = item % nblk, k0 = 64 * kb, n0 = 32 * nb;
    const float ns = (n0 + (lane & 31)) < nlo ? nls : 1.0f;
#pragma unroll 8
    for (int i = 0; i < 32; ++i) { const int kk = 2 * i + (lane >> 5); float v = W[(size_t)(k0 + kk) * N + n0 + (lane & 31)] * ns; if (kscale) v *= kscale[k0 + kk]; scr[kk * 33 + (lane & 31)] = v; }
    LDS_WAIT(); asm volatile("" ::: "memory");
    const int c = lane & 7;
#pragma unroll
    for (int j = 0; j < 4; ++j) { const int n = (lane >> 3) + 8 * j; const LAS float* s = scr + (8 * c) * 33 + n;
        v4u o; o.x = pk2(s[0 * 33], s[1 * 33]); o.y = pk2(s[2 * 33], s[3 * 33]); o.z = pk2(s[4 * 33], s[5 * 33]); o.w = pk2(s[6 * 33], s[7 * 33]);
        *(GAS v4u*)(WT + (size_t)(n0 + n) * K + k0 + 8 * c) = o; }
    LDS_WAIT(); asm volatile("" ::: "memory");
}
__device__ __forceinline__ void rms_row_to_bf16(const float* xrow, bf16* orow, int lane) {
    const GAS f32x4* xr = (const GAS f32x4*)xrow + lane;
    f32x4 v[4]; float s = 0.f;
#pragma unroll
    for (int j = 0; j < 4; ++j) { v[j] = xr[64 * j]; s += (v[j].x * v[j].x + v[j].y * v[j].y) + (v[j].z * v[j].z + v[j].w * v[j].w); }
    const float r = 1.f / sqrtf(wave_sum(s) * (1.f / DM) + RMS_EPS);
    GAS unsigned long long* o8 = (GAS unsigned long long*)orow + lane;
#pragma unroll
    for (int j = 0; j < 4; ++j) o8[64 * j] = (unsigned long long)pk2(v[j].x * r, v[j].y * r) | ((unsigned long long)pk2(v[j].z * r, v[j].w * r) << 32);
}
__device__ __forceinline__ void cvt8_store(const float* src, bf16* dst) {
    const f32x4 a = *(const GAS f32x4*)src, b = *(const GAS f32x4*)(src + 4);
    v4u o; o.x = pk2(a.x, a.y); o.y = pk2(a.z, a.w); o.z = pk2(b.x, b.y); o.w = pk2(b.z, b.w);
    *(GAS v4u*)dst = o;
}

__device__ __forceinline__ void attn_panel(int panel, const bf16* PQ, const bf16* PK, const bf16* PVT, bf16* YA, const int wid0) {
    const int tid = otid(wid0), lane = tid & 63, wid = __builtin_amdgcn_readfirstlane(tid >> 6);
    const int r32 = lane & 31, hh = lane >> 5;
    const size_t seq0 = (size_t)(panel >> 5) * SEQ;
    const int pos0 = (panel & 31) * 256 + wid * 32;
    const int kap = 16 * ((r32 >> 2) & 1) + (r32 & 3) + 4 * (r32 >> 3);
    for (int h = 0; h < 8; ++h) {
        bf16x8 qf[4];
        { const bf16* qrow = PQ + (seq0 + pos0 + r32) * 512 + h * 64 + 8 * hh;
#pragma unroll
          for (int s = 0; s < 4; ++s) qf[s] = *(const GAS bf16x8*)(qrow + 16 * s); }
        f32x16 o0 = {}, o1 = {};
        float Sin = 1.f;
        for (int kb = pos0; kb >= 0; kb -= 32) {
            const bf16* krow = PK + (seq0 + kb + kap) * 512 + h * 64 + 8 * hh;
            const bf16* vrow = PVT + (size_t)(h * 64 + kap) * TOK + seq0 + kb + 16 * hh;
            bf16x8 kf[4], vf[2][2];
#pragma unroll
            for (int s = 0; s < 4; ++s) kf[s] = *(const GAS bf16x8*)(krow + 16 * s);
#pragma unroll
            for (int db = 0; db < 2; ++db)
#pragma unroll
                for (int s = 0; s < 2; ++s) vf[db][s] = *(const GAS bf16x8*)(vrow + (size_t)db * 32 * TOK + 8 * s);
            f32x16 z = {};
#pragma unroll
            for (int s = 0; s < 4; ++s) z = __builtin_amdgcn_mfma_f32_32x32x16_bf16(kf[s], qf[s], z, 0, 0, 0);
            const bool diag = (kb == pos0);
            float w[16]; float Sl = 1.f;
#pragma unroll
            for (int reg = 15; reg >= 0; --reg) {
                float beta = __builtin_amdgcn_rcpf(1.0f + __builtin_amdgcn_exp2f(-z[reg]));
                if (diag && (16 * hh + reg >= r32)) beta = 0.f;
                const float wl = beta * Sl; Sl -= wl; w[reg] = wl;
            }
            const float Pp = __shfl_xor(Sl, 32);
            const float scale = hh ? Sin : Sin * Pp;
            Sin = Sin * Sl * Pp;
            v4u pw0, pw1;
            pw0.x = cvtpk(w[0] * scale, w[1] * scale); pw0.y = cvtpk(w[2] * scale, w[3] * scale); pw0.z = cvtpk(w[4] * scale, w[5] * scale); pw0.w = cvtpk(w[6] * scale, w[7] * scale);
            pw1.x = cvtpk(w[8] * scale, w[9] * scale); pw1.y = cvtpk(w[10] * scale, w[11] * scale); pw1.z = cvtpk(w[12] * scale, w[13] * scale); pw1.w = cvtpk(w[14] * scale, w[15] * scale);
            const bf16x8 p0 = __builtin_bit_cast(bf16x8, pw0), p1 = __builtin_bit_cast(bf16x8, pw1);
            o0 = __builtin_amdgcn_mfma_f32_32x32x16_bf16(vf[0][0], p0, o0, 0, 0, 0);
            o0 = __builtin_amdgcn_mfma_f32_32x32x16_bf16(vf[0][1], p1, o0, 0, 0, 0);
            o1 = __builtin_amdgcn_mfma_f32_32x32x16_bf16(vf[1][0], p0, o1, 0, 0, 0);
            o1 = __builtin_amdgcn_mfma_f32_32x32x16_bf16(vf[1][1], p1, o1, 0, 0, 0);
            if (__all(Sin < SURV_THR)) break;
        }
        bf16* orow = YA + (seq0 + pos0 + r32) * 512 + h * 64 + 16 * hh;
        v4u a, b2;
        a.x = cvtpk(o0[0], o0[1]); a.y = cvtpk(o0[2], o0[3]); a.z = cvtpk(o0[4], o0[5]); a.w = cvtpk(o0[6], o0[7]);
        b2.x = cvtpk(o0[8], o0[9]); b2.y = cvtpk(o0[10], o0[11]); b2.z = cvtpk(o0[12], o0[13]); b2.w = cvtpk(o0[14], o0[15]);
        *(GAS v4u*)orow = a; *(GAS v4u*)(orow + 8) = b2;
        a.x = cvtpk(o1[0], o1[1]); a.y = cvtpk(o1[2], o1[3]); a.z = cvtpk(o1[4], o1[5]); a.w = cvtpk(o1[6], o1[7]);
        b2.x = cvtpk(o1[8], o1[9]); b2.y = cvtpk(o1[10], o1[11]); b2.z = cvtpk(o1[12], o1[13]); b2.w = cvtpk(o1[14], o1[15]);
        *(GAS v4u*)(orow + 32) = a; *(GAS v4u*)(orow + 40) = b2;
    }
}

__device__ __forceinline__ void pool_panel(int panel, const bf16* PU, bf16* YP, const int wid0) {
    const int tid = otid(wid0);
    const int chunk = tid & 63, tg = tid >> 6, w = 2 << (chunk >> 4);
    const int posb = (panel & 31) * 256; const size_t row0 = (size_t)panel * 256;
    for (int i = 0; i < 32; ++i) {
        const int t = tg * 32 + i, pos = posb + t, cnt = (pos + 1 < w) ? (pos + 1) : w;
        float s[8];
#pragma unroll
        for (int k = 0; k < 8; ++k) s[k] = 0.f;
        v4u cur = {0u, 0u, 0u, 0u};
        for (int j = 0; j < cnt; ++j) {
            const v4u v = *(const GAS v4u*)(PU + (row0 + t - j) * 512 + chunk * 8);
            if (j == 0) cur = v;
            s[0] += bflo(v.x); s[1] += bfhi(v.x); s[2] += bflo(v.y); s[3] += bfhi(v.y); s[4] += bflo(v.z); s[5] += bfhi(v.z); s[6] += bflo(v.w); s[7] += bfhi(v.w);
        }
        const float ic = 1.0f / (float)cnt;
        v4u o;
        o.x = cvtpk(s[0] * ic - bflo(cur.x), s[1] * ic - bfhi(cur.x)); o.y = cvtpk(s[2] * ic - bflo(cur.y), s[3] * ic - bfhi(cur.y));
        o.z = cvtpk(s[4] * ic - bflo(cur.z), s[5] * ic - bfhi(cur.z)); o.w = cvtpk(s[6] * ic - bflo(cur.w), s[7] * ic - bfhi(cur.w));
        *(GAS v4u*)(YP + (row0 + t) * 512 + chunk * 8) = o;
    }
}

#define HD __host__ __device__ __forceinline__
HD int f2s(float f) { int i = __builtin_bit_cast(int, f); return i ^ ((i >> 31) & 0x7fffffff); }
HD float s2f(int i) { i ^= ((i >> 31) & 0x7fffffff); return __builtin_bit_cast(float, i); }
HD void ce_desc(int& a, int& b) { const int mx = a > b ? a : b, mn = a > b ? b : a; a = mx; b = mn; }
template <int J, int K> HD void bpass16(int (&v)[16]) {
#pragma unroll
    for (int i = 0; i < 16; ++i) { const int l = i ^ J; if (l > i) { if ((i & K) == 0) ce_desc(v[i], v[l]); else ce_desc(v[l], v[i]); } }
}
HD void bitonic_sort16_desc(int (&v)[16]) {
    bpass16<1, 2>(v); bpass16<2, 4>(v); bpass16<1, 4>(v); bpass16<4, 8>(v); bpass16<2, 8>(v); bpass16<1, 8>(v);
    bpass16<8, 16>(v); bpass16<4, 16>(v); bpass16<2, 16>(v); bpass16<1, 16>(v);
}
HD void bitonic_merge16_desc(int (&v)[16]) {
    bpass16<8, 16>(v); bpass16<4, 16>(v); bpass16<2, 16>(v); bpass16<1, 16>(v);
}
HD void merge_prune16(int (&x)[16], const int (&y)[16]) {
#pragma unroll
    for (int i = 0; i < 16; ++i) x[i] = x[i] > y[15 - i] ? x[i] : y[15 - i];
    bitonic_merge16_desc(x);
}
HD int cx_i(int hf, int t) { if (hf == 0) return 0; return t < 5 ? 2 : t < 9 ? 3 : t < 12 ? 4 : t < 14 ? 5 : 6; }
HD int cx_j(int hf, int t) { if (hf == 0) return t; return t < 5 ? t : t < 9 ? t - 5 : t < 12 ? t - 9 : t < 14 ? t - 12 : t - 14; }
HD int cy_i(int hf, int t) { if (hf == 0) return t < 8 ? 1 : 23 - t; return 7; }
HD int cy_j(int hf, int t) { if (hf == 0) return t < 8 ? t : 0; return t; }

__device__ __forceinline__ void top16_of_group(const bf16* qrow  , const bf16* skg  , int hh, int (&res)[16]) {
    bf16x8 qf[8];
#pragma unroll
    for (int s = 0; s < 8; ++s) qf[s] = *(const GAS bf16x8*)(qrow + 16 * s);
    int v[4][16];
#pragma unroll
    for (int kb = 0; kb < 4; ++kb) {
        f32x16 acc = {};
#pragma unroll
        for (int s = 0; s < 8; ++s) { const bf16x8 af = *(const GAS bf16x8*)(skg + (size_t)kb * 32 * 128 + 16 * s); acc = __builtin_amdgcn_mfma_f32_32x32x16_bf16(af, qf[s], acc, 0, 0, 0); }
#pragma unroll
        for (int reg = 0; reg < 16; ++reg) { const int keyid = 32 * kb + (reg & 3) + 8 * (reg >> 2) + 4 * hh; v[kb][reg] = (f2s(acc[reg]) & ~127) | keyid; }
    }
    bitonic_sort16_desc(v[0]); bitonic_sort16_desc(v[1]); bitonic_sort16_desc(v[2]); bitonic_sort16_desc(v[3]);
    merge_prune16(v[0], v[1]); merge_prune16(v[2], v[3]); merge_prune16(v[0], v[2]);
    int y[16];
#pragma unroll
    for (int i = 0; i < 16; ++i) y[i] = __shfl_xor(v[0][i], 32);
    merge_prune16(v[0], y);
#pragma unroll
    for (int i = 0; i < 16; ++i) res[i] = v[0][i];
}

__device__ __forceinline__ void topk_panel(int panel, const bf16* QP, const bf16* SK, int* IDXp, float* GTp  , LAS int* lut  , const int wid0) {
    const int tid = otid(wid0), lane = tid & 63, wid = __builtin_amdgcn_readfirstlane(tid >> 6);
    const int r32 = lane & 31, hh = lane >> 5;
    const int lrow = wid * 32 + r32;
    const size_t row = (size_t)panel * 256 + lrow;
    for (int h = 0; h < 8; ++h) {
        int a[16], b[16];
        top16_of_group(QP + row * 2048 + (2 * h) * 128 + 8 * hh, SK + ((size_t)(2 * h) * 128 + r32) * 128 + 8 * hh, hh, a);
        top16_of_group(QP + row * 2048 + (2 * h + 1) * 128 + 8 * hh, SK + ((size_t)(2 * h + 1) * 128 + r32) * 128 + 8 * hh, hh, b);
        float fa[16], fb[16];
#pragma unroll
        for (int i = 0; i < 16; ++i) { fa[i] = s2f(a[i] & ~127); fb[i] = s2f(b[i] & ~127); lut[i * 512 + tid] = a[i] & 127; lut[(16 + i) * 512 + tid] = b[i] & 127; }
        int X[16], Y[16];
#pragma unroll
        for (int t = 0; t < 16; ++t) {
            const float s0 = fa[cx_i(0, t)] + fb[cx_j(0, t)], s1 = fa[cx_i(1, t)] + fb[cx_j(1, t)];
            const int c0 = cx_i(0, t) * 16 + cx_j(0, t), c1 = cx_i(1, t) * 16 + cx_j(1, t);
            X[t] = hh ? ((f2s(s1) & ~255) | c1) : ((f2s(s0) & ~255) | c0);
            const float u0 = fa[cy_i(0, t)] + fb[cy_j(0, t)];
            const int d0 = cy_i(0, t) * 16 + cy_j(0, t);
            int y1 = (int)0x80000000;
            if (t < 2) { const float u1 = fa[cy_i(1, t)] + fb[cy_j(1, t)]; y1 = (f2s(u1) & ~255) | (cy_i(1, t) * 16 + cy_j(1, t)); }
            Y[t] = hh ? y1 : ((f2s(u0) & ~255) | d0);
        }
        bitonic_sort16_desc(X); bitonic_merge16_desc(Y); merge_prune16(X, Y);
#pragma unroll
        for (int i = 0; i < 16; ++i) Y[i] = __shfl_xor(X[i], 32);
        merge_prune16(X, Y);
        const float mx = s2f(X[0] & ~255);
        float ex[16], den = 0.f;
#pragma unroll
        for (int i = 0; i < 16; ++i) { ex[i] = __builtin_amdgcn_exp2f((s2f(X[i] & ~255) - mx) * 1.4426950408889634f); den += ex[i]; }
        const float rden = 1.0f / den;
        int oi[8]; float og[8];
#pragma unroll
        for (int t = 0; t < 8; ++t) {
            const int msk = -hh;
            const int code = (X[t] ^ ((X[t] ^ X[8 + t]) & msk)) & 255;
            const int e1 = lut[(code >> 4) * 512 + tid], e2 = lut[(16 + (code & 15)) * 512 + tid];
            const int exl = __builtin_bit_cast(int, ex[t]), exh = __builtin_bit_cast(int, ex[8 + t]);
            oi[t] = e1 * 128 + e2; og[t] = __builtin_bit_cast(float, exl ^ ((exl ^ exh) & msk)) * rden;
        }
        int* ip = IDXp + lrow * 128 + h * 16 + 8 * hh; float* gp = GTp + lrow * 128 + h * 16 + 8 * hh;
        *(GAS v4u*)ip = (v4u){(unsigned)oi[0], (unsigned)oi[1], (unsigned)oi[2], (unsigned)oi[3]}; *(GAS v4u*)(ip + 4) = (v4u){(unsigned)oi[4], (unsigned)oi[5], (unsigned)oi[6], (unsigned)oi[7]};
        *(GAS f32x4*)gp = (f32x4){og[0], og[1], og[2], og[3]}; *(GAS f32x4*)(gp + 4) = (f32x4){og[4], og[5], og[6], og[7]};
    }
}

typedef float f32x2v __attribute__((ext_vector_type(2)));
__device__ __forceinline__ void quant_row_fp8(const float* src, unsigned char* dst, float* sc_out, int lane) {
    const GAS f32x4* s = (const GAS f32x4*)src + 4 * lane;
    f32x4 v[4]; float m = 0.f;
#pragma unroll
    for (int j = 0; j < 4; ++j) { v[j] = s[j]; m = fmaxf(m, fmaxf(fmaxf(fabsf(v[j].x), fabsf(v[j].y)), fmaxf(fabsf(v[j].z), fabsf(v[j].w)))); }
#pragma unroll
    for (int o = 1; o < 64; o <<= 1) m = fmaxf(m, __shfl_xor(m, o));
    const float sc = m > 0.f ? 224.0f / m : 1.0f;
    v4u w;
    { int t = 0; t = __builtin_amdgcn_cvt_pk_fp8_f32(v[0].x * sc, v[0].y * sc, t, false); t = __builtin_amdgcn_cvt_pk_fp8_f32(v[0].z * sc, v[0].w * sc, t, true); w.x = (unsigned)t; }
    { int t = 0; t = __builtin_amdgcn_cvt_pk_fp8_f32(v[1].x * sc, v[1].y * sc, t, false); t = __builtin_amdgcn_cvt_pk_fp8_f32(v[1].z * sc, v[1].w * sc, t, true); w.y = (unsigned)t; }
    { int t = 0; t = __builtin_amdgcn_cvt_pk_fp8_f32(v[2].x * sc, v[2].y * sc, t, false); t = __builtin_amdgcn_cvt_pk_fp8_f32(v[2].z * sc, v[2].w * sc, t, true); w.z = (unsigned)t; }
    { int t = 0; t = __builtin_amdgcn_cvt_pk_fp8_f32(v[3].x * sc, v[3].y * sc, t, false); t = __builtin_amdgcn_cvt_pk_fp8_f32(v[3].z * sc, v[3].w * sc, t, true); w.w = (unsigned)t; }
    *(GAS v4u*)(dst + 16 * lane) = w;
    if (lane == 0) *sc_out = m > 0.f ? m * (1.0f / 224.0f) : 1.0f;
}
__device__ __forceinline__ void dq4(unsigned w, float (&f)[4]) {
    const f32x2v lo = __builtin_amdgcn_cvt_pk_f32_fp8((int)w, false), hi = __builtin_amdgcn_cvt_pk_f32_fp8((int)w, true);
    f[0] = lo.x; f[1] = lo.y; f[2] = hi.x; f[3] = hi.y;
}
__device__ __forceinline__ float dot16_fp8(const v4u u, const float (&h)[16]) {
    float f0[4], f1[4], f2[4], f3[4]; dq4(u.x, f0); dq4(u.y, f1); dq4(u.z, f2); dq4(u.w, f3);
    float a = f0[0] * h[0], b = f1[0] * h[4], c = f2[0] * h[8], d = f3[0] * h[12];
    a = fmaf(f0[1], h[1], a); b = fmaf(f1[1], h[5], b); c = fmaf(f2[1], h[9], c); d = fmaf(f3[1], h[13], d);
    a = fmaf(f0[2], h[2], a); b = fmaf(f1[2], h[6], b); c = fmaf(f2[2], h[10], c); d = fmaf(f3[2], h[14], d);
    a = fmaf(f0[3], h[3], a); b = fmaf(f1[3], h[7], b); c = fmaf(f2[3], h[11], c); d = fmaf(f3[3], h[15], d);
    return (a + b) + (c + d);
}
__device__ __forceinline__ void fma16_fp8(float (&o)[16], float cf, const v4u v) {
    float f0[4], f1[4], f2[4], f3[4]; dq4(v.x, f0); dq4(v.y, f1); dq4(v.z, f2); dq4(v.w, f3);
#pragma unroll
    for (int k = 0; k < 4; ++k) { o[k] = fmaf(cf, f0[k], o[k]); o[4 + k] = fmaf(cf, f1[k], o[4 + k]); o[8 + k] = fmaf(cf, f2[k], o[8 + k]); o[12 + k] = fmaf(cf, f3[k], o[12 + k]); }
}
#define RS_LEVEL(v, n, m) do { _Pragma("unroll") for (int _e = 0; _e < (n); ++_e) { const bool _up = (lane & (m)) != 0; const float _send = _up ? v[_e] : v[_e + (n)]; const float _keep = _up ? v[_e + (n)] : v[_e]; v[_e] = _keep + __shfl_xor(_send, (m)); } } while (0)
__device__ __forceinline__ void peer_panel(int panel, bf16* XN, const int* IDXp, const float* GTp, const unsigned char* EU8, const unsigned char* EV8, const float* SU, const float* SV, float* XIO, const int wid0) {
    const int tid = otid(wid0), lane = tid & 63, wid = __builtin_amdgcn_readfirstlane(tid >> 6);
    for (int ti = 0; ti < 32; ++ti) {
        const int lrow = wid * 32 + ti;
        const size_t row = (size_t)panel * 256 + lrow;
        const int i0 = IDXp[lrow * 128 + lane], i1 = IDXp[lrow * 128 + 64 + lane];
        const float g0 = GTp[lrow * 128 + lane], g1 = GTp[lrow * 128 + 64 + lane];
        const float su0 = SU[i0], su1 = SU[i1], sv0 = SV[i0], sv1 = SV[i1];
        float h[16];
        { const v4u hA = *(const GAS v4u*)(XN + row * DM + 16 * lane), hB = *(const GAS v4u*)(XN + row * DM + 16 * lane + 8);
          h[0] = bflo(hA.x); h[1] = bfhi(hA.x); h[2] = bflo(hA.y); h[3] = bfhi(hA.y); h[4] = bflo(hA.z); h[5] = bfhi(hA.z); h[6] = bflo(hA.w); h[7] = bfhi(hA.w);
          h[8] = bflo(hB.x); h[9] = bfhi(hB.x); h[10] = bflo(hB.y); h[11] = bfhi(hB.y); h[12] = bflo(hB.z); h[13] = bfhi(hB.z); h[14] = bflo(hB.w); h[15] = bfhi(hB.w); }
        float coef[2];
#pragma unroll
        for (int hf = 0; hf < 2; ++hf) {
            const int iv = hf ? i1 : i0;
            float q[4];
#pragma unroll
            for (int k = 0; k < 4; ++k) q[k] = 0.f;
#pragma unroll
            for (int c = 0; c < 4; ++c) {
                v4u ua[16];
#pragma unroll
                for (int j = 0; j < 16; ++j) { const int ex = __builtin_amdgcn_readlane(iv, c * 16 + j); ua[j] = *((const GAS v4u*)(EU8 + (size_t)ex * DM) + lane); }
                float p[16];
#pragma unroll
                for (int j = 0; j < 16; ++j) p[j] = dot16_fp8(ua[j], h);
                RS_LEVEL(p, 8, 8); RS_LEVEL(p, 4, 4); RS_LEVEL(p, 2, 2); RS_LEVEL(p, 1, 1);
                q[c] = p[0];
            }
            RS_LEVEL(q, 2, 32); RS_LEVEL(q, 1, 16);
            const float s = q[0] * (hf ? su1 : su0);
            const float act = 0.5f * s * (1.0f + erff(s * 0.70710678118654752f));
            coef[hf] = (hf ? g1 : g0) * act * (hf ? sv1 : sv0);
        }
        float o[16];
        { const GAS f32x4* xp = (const GAS f32x4*)(XIO + row * DM + 16 * lane);
#pragma unroll
          for (int k = 0; k < 4; ++k) { const f32x4 x = xp[k]; o[4 * k] = x.x; o[4 * k + 1] = x.y; o[4 * k + 2] = x.z; o[4 * k + 3] = x.w; } }
#pragma unroll
        for (int hf = 0; hf < 2; ++hf) {
            const int iv = hf ? i1 : i0; const float cv = coef[hf];
#pragma unroll
            for (int c = 0; c < 4; ++c) {
                v4u va[16];
#pragma unroll
                for (int j = 0; j < 16; ++j) { const int ex = __builtin_amdgcn_readlane(iv, c * 16 + j); va[j] = *((const GAS v4u*)(EV8 + (size_t)ex * DM) + lane); }
#pragma unroll
                for (int j = 0; j < 16; ++j) { const float cf = __builtin_bit_cast(float, __builtin_amdgcn_readlane(__builtin_bit_cast(int, cv), c * 16 + j)); fma16_fp8(o, cf, va[j]); }
            }
        }
        float ss = 0.f;
#pragma unroll
        for (int k = 0; k < 16; ++k) ss += o[k] * o[k];
        const float r = 1.f / sqrtf(wave_sum(ss) * (1.f / DM) + RMS_EPS);
        { GAS f32x4* xp = (GAS f32x4*)(XIO + row * DM + 16 * lane);
#pragma unroll
          for (int k = 0; k < 4; ++k) xp[k] = (f32x4){o[4 * k], o[4 * k + 1], o[4 * k + 2], o[4 * k + 3]}; }
        v4u ha, hb;
        ha.x = cvtpk(o[0] * r, o[1] * r); ha.y = cvtpk(o[2] * r, o[3] * r); ha.z = cvtpk(o[4] * r, o[5] * r); ha.w = cvtpk(o[6] * r, o[7] * r);
        hb.x = cvtpk(o[8] * r, o[9] * r); hb.y = cvtpk(o[10] * r, o[11] * r); hb.z = cvtpk(o[12] * r, o[13] * r); hb.w = cvtpk(o[14] * r, o[15] * r);
        *(GAS v4u*)(XN + row * DM + 16 * lane) = ha; *(GAS v4u*)(XN + row * DM + 16 * lane + 8) = hb;
    }
}


struct Args {
    const float *x, *p, *norm_mix, *w_in, *w_att_up, *w_pool_group, *pool_scale, *w_out, *norm_ffn, *w_query, *sub_keys, *expert_u, *expert_v, *norm_ple, *w_ple_gate, *w_ple, *norm_final;
    float* out; unsigned char* ws; int ph_hi, pad;
};

#ifndef MK_PH_HI
#define MK_PH_HI 99
#endif

typedef const __attribute__((address_space(4))) Args* CArgs;
__device__ __forceinline__ CArgs kargs() { CArgs p = (CArgs)__builtin_amdgcn_kernarg_segment_ptr(); asm volatile("" : "+s"(p)); return p; }
#define WSP(T, off) ((T*)(kargs()->ws + (off)))
__global__ void __launch_bounds__(NTHR, 2) mega_fwd(Args a_unused) {
    extern __shared__ __attribute__((aligned(16))) unsigned char lds_raw[];
    LAS unsigned char* lds = (LAS unsigned char*)lds_raw;
    volatile LAS unsigned* MISC = (volatile LAS unsigned*)(lds + MISC_OFF);
    const int G = gridDim.x; const int bx = blockIdx.x;
    const int vcu = (G % 8 == 0) ? (bx % 8) * (G / 8) + bx / 8 : bx;
    gu32* ctl = (gu32*)(kargs()->ws + WS_CTL);
    const int wid0 = __builtin_amdgcn_readfirstlane((int)threadIdx.x >> 6);
#define IS_T0 (otid(wid0) == 0)
    for (int u = otid(wid0); u < (LDS_BYTES - LDSCTL_OFF) / 4; u += NTHR) ((LAS unsigned*)(lds + LDSCTL_OFF))[u] = 0u;
    __syncthreads();
    (void)xcd_barrier_post((unsigned*)(ctl + CW_BAR), MISC + 8, IS_T0);
#define GRID_BAR() do { XcdBarrier _b; _b.bar = (unsigned*)((gu32*)(kargs()->ws + WS_CTL) + CW_BAR); _b.x = xb_xcc_id(); _b.st = (volatile LAS unsigned*)(lds + MISC_OFF) + 8; xcd_barrier(_b, IS_T0); } while (0)
#define LOCAL_SEAM() do { VM_WAIT(); __syncthreads(); if (IS_T0) { __builtin_amdgcn_fence(__ATOMIC_ACQUIRE, "agent"); VM_WAIT(); } __syncthreads(); } while (0)

    {
        const int tid = otid(wid0), lane = tid & 63, wid = __builtin_amdgcn_readfirstlane(tid >> 6);
        const CArgs a = kargs(); unsigned char* ws = a->ws;
        bf16 *WIN = (bf16*)(ws + WS_WIN), *WOUT = (bf16*)(ws + WS_WOUT), *WQ = (bf16*)(ws + WS_WQ), *WPG = (bf16*)(ws + WS_WPG), *WPLE = (bf16*)(ws + WS_WPLE);
        bf16 *BDA = (bf16*)(ws + WS_BDA), *BDP = (bf16*)(ws + WS_BDP), *SK = (bf16*)(ws + WS_SK), *XN = (bf16*)(ws + WS_XN);
        LAS float* scr = (LAS float*)(lds + wid * 16384);
        const int gw = vcu * NWAVES + wid, NGW = G * NWAVES;
        constexpr int I_IN = (1024 / 64) * (4096 / 32), I_OUT = (1024 / 64) * (1024 / 32), I_Q = (1024 / 64) * (2048 / 32), I_PG = I_OUT, I_PLE = (256 / 64) * (1024 / 32);
        constexpr int NITEMS = I_IN + I_OUT + I_Q + I_PG + I_PLE;
        for (int it = gw; it < NITEMS; it += NGW) {
            int r = it;
            if (r < I_IN) { p0_transpose_item(a->w_in, 1024, 4096, WIN, a->norm_mix, 512, C2, scr, r, lane); continue; } r -= I_IN;
            if (r < I_OUT) { p0_transpose_item(a->w_out, 1024, 1024, WOUT, nullptr, 0, 1.f, scr, r, lane); continue; } r -= I_OUT;
            if (r < I_Q) { p0_transpose_item(a->w_query, 1024, 2048, WQ, a->norm_ffn, 0, 1.f, scr, r, lane); continue; } r -= I_Q;
            if (r < I_PG) { p0_transpose_item(a->w_ple_gate, 1024, 1024, WPG, a->norm_ple, 0, 1.f, scr, r, lane); continue; } r -= I_PG;
            p0_transpose_item(a->w_ple, 256, 1024, WPLE, nullptr, 0, 1.f, scr, r, lane);
        }
        const int gt = vcu * NTHR + tid, NGT = G * NTHR;
        for (int it = gt; it < 1024 * 16; it += NGT) {
            const int n = it >> 4, k8 = (it & 15) * 8, head = n >> 7, g = n >> 8;
            float va[8], vp[8]; const float ps = a->pool_scale[n];
#pragma unroll
            for (int j = 0; j < 8; ++j) {
                const int k = k8 + j;
                va[j] = ((k >> 6) == (head & 1)) ? a->w_att_up[((size_t)head * 64 + (k & 63)) * 128 + (n & 127)] : 0.f;
                vp[j] = a->w_pool_group[((size_t)g * 128 + k) * 256 + (n & 255)] * ps;
            }
            v4u o; o.x = pk2(va[0], va[1]); o.y = pk2(va[2], va[3]); o.z = pk2(va[4], va[5]); o.w = pk2(va[6], va[7]);
            *(GAS v4u*)(BDA + (size_t)n * 128 + k8) = o;
            o.x = pk2(vp[0], vp[1]); o.y = pk2(vp[2], vp[3]); o.z = pk2(vp[4], vp[5]); o.w = pk2(vp[6], vp[7]);
            *(GAS v4u*)(BDP + (size_t)n * 128 + k8) = o;
        }
        for (int it = gt; it < 16 * 128 * 128 / 8; it += NGT) cvt8_store(a->sub_keys + (size_t)it * 8, SK + (size_t)it * 8);
        for (int rr = gw; rr < 2 * 16384; rr += NGW) { const int e = rr >> 1;
            if (rr & 1) quant_row_fp8(a->expert_v + (size_t)e * DM, ws + WS_EV + (size_t)e * DM, (float*)(ws + WS_SV) + e, lane);
            else quant_row_fp8(a->expert_u + (size_t)e * DM, ws + WS_EU + (size_t)e * DM, (float*)(ws + WS_SU) + e, lane); }
        { const int panel = bx;
            for (int r = wid; r < 256; r += NWAVES) { const size_t row = (size_t)panel * 256 + r; rms_row_to_bf16(a->x + row * DM, XN + row * DM, lane); } }
    }
    GRID_BAR();

    if (MK_PH_HI > 1) {
        { const int panel = bx;
            { pg8::Gemm g{WSP(bf16, WS_XN), WSP(bf16, WS_WIN), 1024, 1024, 1024, 0}; pg8::PanelSched S{panel, 14, 4, 2, 0}; pg8::EpiProj E{WSP(bf16, WS_PQ), WSP(bf16, WS_PK), WSP(bf16, WS_PU), WSP(bf16, WS_PG)};
              pg8::gemm_phase<pg8::EpiProj, pg8::PanelSched, true, true>(lds, g, S, E, wid0); }
            { pg8::Gemm g{WSP(bf16, WS_WIN) + (size_t)1024 * 1024, WSP(bf16, WS_XN), 1024, 1024, 1024, 0}; pg8::PanelSched S{panel, 2, 99, 0, 1}; pg8::EpiPlain E{WSP(bf16, WS_PVT), TOK};
              pg8::gemm_phase<pg8::EpiPlain, pg8::PanelSched, true, true>(lds, g, S, E, wid0); }
        }
    }
    GRID_BAR();

    { const int panel = bx;
        const size_t prow = (size_t)panel * 256;
        if (MK_PH_HI > 2) { attn_panel(panel, WSP(bf16, WS_PQ), WSP(bf16, WS_PK), WSP(bf16, WS_PVT), WSP(bf16, WS_YA), wid0); pool_panel(panel, WSP(bf16, WS_PU), WSP(bf16, WS_YP), wid0); LOCAL_SEAM(); }
        if (MK_PH_HI > 3) {
            { pg8::Gemm g{WSP(bf16, WS_YA), WSP(bf16, WS_BDA), 128, 512, 128, 128}; pg8::PanelSched S{panel, 4, 99, 0, 0}; pg8::EpiMerge<false> E{WSP(bf16, WS_PG), WSP(bf16, WS_MG), 0};
              pg8::gemm_phase<pg8::EpiMerge<false>, pg8::PanelSched, true, true>(lds, g, S, E, wid0); }
            { pg8::Gemm g{WSP(bf16, WS_YP), WSP(bf16, WS_BDP), 128, 512, 128, 128}; pg8::PanelSched S{panel, 4, 99, 0, 0}; pg8::EpiMerge<true> E{WSP(bf16, WS_PG), WSP(bf16, WS_MG), 1024};
              pg8::gemm_phase<pg8::EpiMerge<true>, pg8::PanelSched, true, true>(lds, g, S, E, wid0); }
            LOCAL_SEAM();
        }
        if (MK_PH_HI > 4) {
            { pg8::Gemm g{WSP(bf16, WS_MG), WSP(bf16, WS_WOUT), 1024, 1024, 1024, 0}; pg8::PanelSched S{panel, 4, 99, 0, 0}; pg8::EpiRes E{kargs()->x, kargs()->out};
              pg8::gemm_phase<pg8::EpiRes, pg8::PanelSched, true, true>(lds, g, S, E, wid0); }
            LOCAL_SEAM();
        }
        if (MK_PH_HI > 5) {
            { const int tid = otid(wid0), lane = tid & 63, wid = __builtin_amdgcn_readfirstlane(tid >> 6); const float* xo = kargs()->out; bf16* XN = WSP(bf16, WS_XN); for (int r = wid; r < 256; r += NWAVES) rms_row_to_bf16(xo + (prow + r) * DM, XN + (prow + r) * DM, lane); }
            LOCAL_SEAM();
        }
        if (MK_PH_HI > 6) {
            { pg8::Gemm g{WSP(bf16, WS_XN), WSP(bf16, WS_WQ), 1024, 1024, 1024, 0}; pg8::PanelSched S{panel, 8, 99, 0, 0}; pg8::EpiPlain E{WSP(bf16, WS_PG), 2048};
              pg8::gemm_phase<pg8::EpiPlain, pg8::PanelSched, true, true>(lds, g, S, E, wid0); }
            LOCAL_SEAM();
        }
        #define IDXP ((int*)(kargs()->ws + WS_YA + (size_t)panel * 262144))
#define GTP ((float*)(kargs()->ws + WS_YA + (size_t)panel * 262144 + 131072))
        if (MK_PH_HI > 7) { topk_panel(panel, WSP(bf16, WS_PG), WSP(bf16, WS_SK), IDXP, GTP, (LAS int*)lds, wid0); LOCAL_SEAM(); }
        if (MK_PH_HI > 8) { peer_panel(panel, WSP(bf16, WS_XN), IDXP, GTP, WSP(unsigned char, WS_EU), WSP(unsigned char, WS_EV), WSP(float, WS_SU), WSP(float, WS_SV), kargs()->out, wid0); LOCAL_SEAM(); }
        if (MK_PH_HI > 9) {
            { const int tid = otid(wid0); const float* pp = kargs()->p; bf16* YP = WSP(bf16, WS_YP); for (int it = tid; it < 256 * 256 / 8; it += NTHR) { const int r = it >> 5, c8 = (it & 31) * 8; cvt8_store(pp + (prow + r) * 256 + c8, YP + (prow + r) * 512 + c8); } }
            LOCAL_SEAM();
            { pg8::Gemm g{WSP(bf16, WS_YP), WSP(bf16, WS_WPLE), 256, 512, 256, 0}; pg8::PanelSched S{panel, 4, 99, 0, 0}; pg8::EpiPlain E{WSP(bf16, WS_MG), 1024};
              pg8::gemm_phase<pg8::EpiPlain, pg8::PanelSched, true, true>(lds, g, S, E, wid0); }
            LOCAL_SEAM();
        }
        if (MK_PH_HI > 10) {
            { pg8::Gemm g{WSP(bf16, WS_XN), WSP(bf16, WS_WPG), 1024, 1024, 1024, 0}; pg8::PanelSched S{panel, 4, 99, 0, 0}; pg8::EpiGate E{kargs()->out, WSP(bf16, WS_MG)};
              pg8::gemm_phase<pg8::EpiGate, pg8::PanelSched, true, true>(lds, g, S, E, wid0); }
            LOCAL_SEAM();
        }
        if (MK_PH_HI > 11) {
            const int tid = otid(wid0), lane = tid & 63, wid = __builtin_amdgcn_readfirstlane(tid >> 6);
            for (int r = wid; r < 256; r += NWAVES) {
                GAS f32x4* xr = (GAS f32x4*)(kargs()->out + (prow + r) * DM) + lane; const GAS f32x4* gr = (const GAS f32x4*)kargs()->norm_final + lane;
                f32x4 v[4]; float s = 0.f;
#pragma unroll
                for (int j = 0; j < 4; ++j) { v[j] = xr[64 * j]; s += (v[j].x * v[j].x + v[j].y * v[j].y) + (v[j].z * v[j].z + v[j].w * v[j].w); }
                const float rr = 1.f / sqrtf(wave_sum(s) * (1.f / DM) + RMS_EPS);
#pragma unroll
                for (int j = 0; j < 4; ++j) xr[64 * j] = v[j] * rr * gr[64 * j];
            }
        }
    }
#undef LOCAL_SEAM
}


#if MK_PH_HI < 99
namespace ref {
constexpr int D = 1024, NB = 8, S = 8192, T = NB * S;
constexpr int INW = 4096;
constexpr int NKEYS = 128, TOPK = 16, PH = 8;
constexpr float EPS = 1e-6f;

__device__ __forceinline__ float wave_sum(float v) {
#pragma unroll
    for (int o = 32; o > 0; o >>= 1) v += __shfl_xor(v, o);
    return v;
}
__device__ __forceinline__ float sigmoidf_(float x) { return 1.f / (1.f + expf(-x)); }

__global__ void __launch_bounds__(256) k_rms(const float* x, const float* g, float* out) {
    __shared__ float red[4];
    const size_t row = blockIdx.x;
    const float4 v = ((const float4*)(x + row * D))[threadIdx.x];
    float s = v.x * v.x + v.y * v.y + v.z * v.z + v.w * v.w;
    s = wave_sum(s);
    if ((threadIdx.x & 63) == 0) red[threadIdx.x >> 6] = s;
    __syncthreads();
    const float tot = red[0] + red[1] + red[2] + red[3];
    const float r = rsqrtf(tot * (1.f / D) + EPS);
    const float4 gg = ((const float4*)g)[threadIdx.x];
    float4 o; o.x = v.x * r * gg.x; o.y = v.y * r * gg.y; o.z = v.z * r * gg.z; o.w = v.w * r * gg.w;
    ((float4*)(out + row * D))[threadIdx.x] = o;
}

struct EpiStore { float* C; int ldc; int pad; __device__ void operator()(int r, int c, float v) const { C[(size_t)r * ldc + c] = v; } };
struct EpiResAdd { const float* R; float* C; int ldc; int pad; __device__ void operator()(int r, int c, float v) const { C[(size_t)r * ldc + c] = R[(size_t)r * ldc + c] + v; } };
struct EpiGate { const float* X; const float* E; float* C; int ldc; int pad;
    __device__ void operator()(int r, int c, float v) const { const size_t o = (size_t)r * ldc + c; C[o] = X[o] + sigmoidf_(v) * E[o]; } };

template <class Epi>
__global__ void __launch_bounds__(256) k_gemm(const float* __restrict__ A, const float* __restrict__ Bm, Epi epi, int lda, int ldb, int K, int pad_) {
    __shared__ float As[8][128 + 4];
    __shared__ float Bs[8][128 + 4];
    const int tid = threadIdx.x, tx = tid & 15, ty = tid >> 4;
    const int m0 = blockIdx.y * 128, n0 = blockIdx.x * 128;
    float acc[8][8];
#pragma unroll
    for (int i = 0; i < 8; ++i)
#pragma unroll
        for (int j = 0; j < 8; ++j) acc[i][j] = 0.f;
    const int ar = tid >> 1, ak = (tid & 1) * 4;
    const int bk = tid >> 5, bn = (tid & 31) * 4;
    for (int k0 = 0; k0 < K; k0 += 8) {
        const float4 av = *(const float4*)(A + (size_t)(m0 + ar) * lda + k0 + ak);
        const float4 bv = *(const float4*)(Bm + (size_t)(k0 + bk) * ldb + n0 + bn);
        As[ak + 0][ar] = av.x; As[ak + 1][ar] = av.y; As[ak + 2][ar] = av.z; As[ak + 3][ar] = av.w;
        *(float4*)&Bs[bk][bn] = bv;
        __syncthreads();
#pragma unroll
        for (int k = 0; k < 8; ++k) {
            const float4 a0 = *(const float4*)&As[k][ty * 8], a1 = *(const float4*)&As[k][ty * 8 + 4];
            const float4 b0 = *(const float4*)&Bs[k][tx * 8], b1 = *(const float4*)&Bs[k][tx * 8 + 4];
            const float a[8] = {a0.x, a0.y, a0.z, a0.w, a1.x, a1.y, a1.z, a1.w};
            const float b[8] = {b0.x, b0.y, b0.z, b0.w, b1.x, b1.y, b1.z, b1.w};
#pragma unroll
            for (int i = 0; i < 8; ++i)
#pragma unroll
                for (int j = 0; j < 8; ++j) acc[i][j] = fmaf(a[i], b[j], acc[i][j]);
        }
        __syncthreads();
    }
#pragma unroll
    for (int i = 0; i < 8; ++i)
#pragma unroll
        for (int j = 0; j < 8; ++j) epi(m0 + ty * 8 + i, n0 + tx * 8 + j, acc[i][j]);
}

__global__ void __launch_bounds__(64) k_attn(const float* __restrict__ proj, float* __restrict__ yatt) {
    const int t = blockIdx.x * 64 + threadIdx.x;
    const int h = blockIdx.y;
    float q[64], acc[64];
    const float* qp = proj + (size_t)t * INW + h * 64;
#pragma unroll
    for (int d = 0; d < 64; ++d) { q[d] = qp[d] * 0.125f; acc[d] = 0.f; }
    float surv = 1.f;
    for (int s = t - 1; s >= 0; --s) {
        const float* kp = proj + (size_t)s * INW + 512 + h * 64;
        float z = 0.f;
#pragma unroll
        for (int d = 0; d < 64; ++d) z = fmaf(q[d], kp[d], z);
        const float beta = 1.f / (1.f + expf(-z));
        const float w = beta * surv;
        const float* vp = kp + 512;
#pragma unroll
        for (int d = 0; d < 64; ++d) acc[d] = fmaf(w, vp[d], acc[d]);
        surv -= w;
        if (surv < 5.4e-20f) break;
    }
    float* o = yatt + (size_t)t * 512 + h * 64;
#pragma unroll
    for (int d = 0; d < 64; ++d) o[d] = acc[d];
}

__global__ void __launch_bounds__(256) k_pool(const float* __restrict__ proj, float* __restrict__ ypool) {
    const int i = blockIdx.x * 256 + threadIdx.x;
    const int t = i >> 9, c = i & 511, g = c >> 7, w = 2 << g;
    const int cnt = (t + 1 < w) ? (t + 1) : w;
    float s = 0.f;
    for (int j = 0; j < cnt; ++j) s += proj[(size_t)(t - j) * INW + 1536 + c];
    ypool[i] = s / (float)cnt - proj[(size_t)t * INW + 1536 + c];
}

__global__ void __launch_bounds__(256) k_merge(const float* __restrict__ proj, const float* __restrict__ yatt, const float* __restrict__ ypool,
                                               const float* __restrict__ wa, const float* __restrict__ wp, const float* __restrict__ pscale, float* __restrict__ merged) {
    const int t = blockIdx.x, tid = threadIdx.x;
    __shared__ float sa[512], sp[512];
    sa[tid] = yatt[(size_t)t * 512 + tid]; sa[tid + 256] = yatt[(size_t)t * 512 + tid + 256];
    sp[tid] = ypool[(size_t)t * 512 + tid]; sp[tid + 256] = ypool[(size_t)t * 512 + tid + 256];
    __syncthreads();
    for (int e = tid; e < D; e += 256) {
        const int h = e >> 7, ea = e & 127, g = e >> 8, ep = e & 255;
        float a = 0.f, p = 0.f;
        for (int d = 0; d < 64; ++d) a = fmaf(sa[h * 64 + d], wa[((size_t)h * 64 + d) * 128 + ea], a);
        for (int c = 0; c < 128; ++c) p = fmaf(sp[g * 128 + c], wp[((size_t)g * 128 + c) * 256 + ep], p);
        p *= pscale[e];
        const float ga = proj[(size_t)t * INW + 2048 + e], gp = proj[(size_t)t * INW + 3072 + e];
        merged[(size_t)t * D + e] = sigmoidf_(ga) * a + sigmoidf_(gp) * p;
    }
}

__global__ void __launch_bounds__(256) k_scores(const float* __restrict__ qp, const float* __restrict__ sk, float* __restrict__ sc) {
    const int t0 = blockIdx.x * 4, tid = threadIdx.x;
    __shared__ float sq[4][2048];
    for (int i = tid; i < 4 * 2048; i += 256) sq[i >> 11][i & 2047] = qp[(size_t)t0 * 2048 + i];
    __syncthreads();
    for (int j = tid; j < 2048; j += 256) {
        const int g = j >> 7;
        const float4* kr = (const float4*)(sk + (size_t)j * 128);
        float a0 = 0.f, a1 = 0.f, a2 = 0.f, a3 = 0.f;
        for (int d = 0; d < 32; ++d) {
            const float4 kv = kr[d];
            const float4 q0 = *(const float4*)&sq[0][g * 128 + d * 4], q1 = *(const float4*)&sq[1][g * 128 + d * 4];
            const float4 q2 = *(const float4*)&sq[2][g * 128 + d * 4], q3 = *(const float4*)&sq[3][g * 128 + d * 4];
            a0 = fmaf(q0.x, kv.x, a0); a0 = fmaf(q0.y, kv.y, a0); a0 = fmaf(q0.z, kv.z, a0); a0 = fmaf(q0.w, kv.w, a0);
            a1 = fmaf(q1.x, kv.x, a1); a1 = fmaf(q1.y, kv.y, a1); a1 = fmaf(q1.z, kv.z, a1); a1 = fmaf(q1.w, kv.w, a1);
            a2 = fmaf(q2.x, kv.x, a2); a2 = fmaf(q2.y, kv.y, a2); a2 = fmaf(q2.z, kv.z, a2); a2 = fmaf(q2.w, kv.w, a2);
            a3 = fmaf(q3.x, kv.x, a3); a3 = fmaf(q3.y, kv.y, a3); a3 = fmaf(q3.z, kv.z, a3); a3 = fmaf(q3.w, kv.w, a3);
        }
        sc[(size_t)(t0 + 0) * 2048 + j] = a0; sc[(size_t)(t0 + 1) * 2048 + j] = a1;
        sc[(size_t)(t0 + 2) * 2048 + j] = a2; sc[(size_t)(t0 + 3) * 2048 + j] = a3;
    }
}

__device__ __forceinline__ void wave_argmax(float& v, int& i) {
#pragma unroll
    for (int o = 32; o > 0; o >>= 1) {
        const float ov = __shfl_xor(v, o); const int oi = __shfl_xor(i, o);
        if (ov > v || (ov == v && oi < i)) { v = ov; i = oi; }
    }
}

__global__ void __launch_bounds__(256) k_topk(const float* __restrict__ sc, int* __restrict__ idx, float* __restrict__ gates) {
    const int wv = threadIdx.x >> 6, lane = threadIdx.x & 63;
    const int pair = blockIdx.x * 4 + wv;
    const int t = pair >> 3, h = pair & 7;
    __shared__ float stop[4][2][16];
    __shared__ int itop[4][2][16];
    for (int c = 0; c < 2; ++c) {
        const float* sr = sc + (size_t)t * 2048 + (h * 2 + c) * 128;
        float v0 = sr[lane], v1 = sr[lane + 64];
        for (int k = 0; k < TOPK; ++k) {
            float bv; int bi;
            if (v1 > v0) { bv = v1; bi = lane + 64; } else { bv = v0; bi = lane; }
            wave_argmax(bv, bi);
            if (lane == 0) { stop[wv][c][k] = bv; itop[wv][c][k] = bi; }
            if (bi == lane) v0 = -INFINITY;
            if (bi == lane + 64) v1 = -INFINITY;
        }
    }
    __syncthreads();
    float cv[4];
#pragma unroll
    for (int j = 0; j < 4; ++j) { const int p = lane + 64 * j; cv[j] = stop[wv][0][p >> 4] + stop[wv][1][p & 15]; }
    __shared__ float sbs[4][16];
    __shared__ int sbp[4][16];
    for (int k = 0; k < TOPK; ++k) {
        float bv = cv[0]; int bi = lane;
#pragma unroll
        for (int j = 1; j < 4; ++j) if (cv[j] > bv) { bv = cv[j]; bi = lane + 64 * j; }
        wave_argmax(bv, bi);
        if (lane == 0) { sbs[wv][k] = bv; sbp[wv][k] = bi; }
#pragma unroll
        for (int j = 0; j < 4; ++j) if (bi == lane + 64 * j) cv[j] = -INFINITY;
    }
    __syncthreads();
    const float mx = sbs[wv][0];
    const float myv = (lane < TOPK) ? sbs[wv][lane] : -INFINITY;
    const float ex = (lane < TOPK) ? expf(myv - mx) : 0.f;
    const float den = wave_sum(ex);
    if (lane < TOPK) {
        const int myp = sbp[wv][lane];
        const int e = itop[wv][0][myp >> 4] * NKEYS + itop[wv][1][myp & 15];
        idx[(size_t)t * 128 + h * 16 + lane] = e;
        gates[(size_t)t * 128 + h * 16 + lane] = ex / den;
    }
}

__global__ void __launch_bounds__(256) k_peer(const float* __restrict__ hn, const int* __restrict__ idx, const float* __restrict__ gates,
                                              const float* __restrict__ eu, const float* __restrict__ ev, float* xio) {
    const int t = blockIdx.x, tid = threadIdx.x, wv = tid >> 6, lane = tid & 63;
    __shared__ float coef[128];
    __shared__ int sidx[128];
    const float4* hr = (const float4*)(hn + (size_t)t * D);
    float4 hv[4];
#pragma unroll
    for (int j = 0; j < 4; ++j) hv[j] = hr[lane + 64 * j];
    if (tid < 128) sidx[tid] = idx[(size_t)t * 128 + tid];
    __syncthreads();
    for (int p = wv; p < 128; p += 4) {
        const float4* ur = (const float4*)(eu + (size_t)sidx[p] * D);
        float s = 0.f;
#pragma unroll
        for (int j = 0; j < 4; ++j) { const float4 u = ur[lane + 64 * j]; s += u.x * hv[j].x + u.y * hv[j].y + u.z * hv[j].z + u.w * hv[j].w; }
        s = wave_sum(s);
        const float act = 0.5f * s * (1.f + erff(s * 0.70710678118654752f));
        if (lane == 0) coef[p] = gates[(size_t)t * 128 + p] * act;
    }
    __syncthreads();
    float4 o = ((const float4*)(xio + (size_t)t * D))[tid];
    for (int p = 0; p < 128; ++p) {
        const float c = coef[p];
        const float4 v = ((const float4*)(ev + (size_t)sidx[p] * D))[tid];
        o.x = fmaf(c, v.x, o.x); o.y = fmaf(c, v.y, o.y); o.z = fmaf(c, v.z, o.z); o.w = fmaf(c, v.w, o.w);
    }
    ((float4*)(xio + (size_t)t * D))[tid] = o;
}

__global__ void __launch_bounds__(256) k_bf16_to_f32(const unsigned short* __restrict__ src, float* __restrict__ dst) {
    const size_t i = (size_t)blockIdx.x * 256 + threadIdx.x; dst[i] = __uint_as_float((unsigned)src[i] << 16);
}
__global__ void __launch_bounds__(128) k_gather_idx(const unsigned char* __restrict__ ya, int row0, int* __restrict__ idx, float* __restrict__ gates) {
    const int r = blockIdx.x, grow = row0 + r, panel = grow >> 8, lrow = grow & 255;
    const int* ip = (const int*)(ya + (size_t)panel * 262144); const float* gp = (const float*)(ya + (size_t)panel * 262144 + 131072);
    idx[(size_t)r * 128 + threadIdx.x] = ip[lrow * 128 + threadIdx.x]; gates[(size_t)r * 128 + threadIdx.x] = gp[lrow * 128 + threadIdx.x];
}
}
#endif

extern "C" void kernel_launch(void* const* d_in, const int* in_sizes, int n_in, void* d_out, int out_size, void* d_ws, size_t ws_size, hipStream_t stream) {
    static int grid = 0;
    if (grid == 0) {
        if (n_in != 17 || in_sizes[0] != TOK * DM || out_size != TOK * DM || ws_size < WS_END) { fprintf(stderr, "kernel_launch: unexpected shapes (n_in %d, in0 %d, out %d, ws %zu); nothing launched\n", n_in, n_in > 0 ? in_sizes[0] : -1, out_size, ws_size); grid = -1; return; }
        int dev = 0, cus = 0;
        if (hipGetDevice(&dev) != hipSuccess || hipDeviceGetAttribute(&cus, hipDeviceAttributeMultiprocessorCount, dev) != hipSuccess) { fprintf(stderr, "kernel_launch: device query failed\n"); grid = -1; return; }
        if (hipFuncSetAttribute((const void*)mega_fwd, hipFuncAttributeMaxDynamicSharedMemorySize, LDS_BYTES) != hipSuccess) { fprintf(stderr, "kernel_launch: hipFuncSetAttribute failed\n"); grid = -1; return; }
        int per_cu = 0;
        if (hipOccupancyMaxActiveBlocksPerMultiprocessor(&per_cu, (const void*)mega_fwd, NTHR, LDS_BYTES) != hipSuccess || per_cu < 1) fprintf(stderr, "kernel_launch: note: occupancy query reports %d workgroups per CU\n", per_cu);
        (void)hipGetLastError();
        if (cus != NPANEL) fprintf(stderr, "kernel_launch: note: %d CUs; this kernel is built for one 256-token panel per CU on a 256-CU device\n", cus);
        grid = NPANEL;
    }
    if (grid < 0) return;
    if (hipMemsetAsync((char*)d_ws + WS_CTL, 0, CTL_ZERO_BYTES, stream) != hipSuccess) { fprintf(stderr, "kernel_launch: memset failed\n"); return; }
    Args a{};
    a.x = (const float*)d_in[0]; a.p = (const float*)d_in[1]; a.norm_mix = (const float*)d_in[2]; a.w_in = (const float*)d_in[3]; a.w_att_up = (const float*)d_in[4];
    a.w_pool_group = (const float*)d_in[5]; a.pool_scale = (const float*)d_in[6]; a.w_out = (const float*)d_in[7]; a.norm_ffn = (const float*)d_in[8]; a.w_query = (const float*)d_in[9];
    a.sub_keys = (const float*)d_in[10]; a.expert_u = (const float*)d_in[11]; a.expert_v = (const float*)d_in[12]; a.norm_ple = (const float*)d_in[13]; a.w_ple_gate = (const float*)d_in[14];
    a.w_ple = (const float*)d_in[15]; a.norm_final = (const float*)d_in[16];
    a.out = (float*)d_out; a.ws = (unsigned char*)d_ws; a.ph_hi = MK_PH_HI; a.pad = 0;
    hipLaunchKernelGGL(mega_fwd, dim3(grid), dim3(NTHR), LDS_BYTES, stream, a);
    { const hipError_t le = hipPeekAtLastError(); if (le != hipSuccess) fprintf(stderr, "kernel_launch: launch failed: %s\n", hipGetErrorName(le)); }
#if MK_PH_HI < 99
    {
        using namespace ref;
        char* ws = (char*)d_ws; float* out = (float*)d_out;
        float* hbuf = (float*)(ws + 0 * MiB); float* qp = (float*)(ws + 32 * MiB); float* sc = (float*)(ws + 96 * MiB);
        int* idx = (int*)(ws + 160 * MiB); float* gates = (float*)(ws + 164 * MiB); float* ebuf = (float*)(ws + 168 * MiB);
        for (int b = 0; b < NB; ++b) {
            const float* pb = a.p + (size_t)b * S * 256; float* ob = out + (size_t)b * S * D;
#if MK_PH_HI == 5
            k_rms<<<S, 256, 0, stream>>>(ob, a.norm_ffn, hbuf);
            k_gemm<EpiStore><<<dim3(2048 / 128, S / 128), 256, 0, stream>>>(hbuf, a.w_query, EpiStore{qp, 2048}, D, 2048, D, 0);
            k_scores<<<S / 4, 256, 0, stream>>>(qp, a.sub_keys, sc);
            k_topk<<<S * 8 / 4, 256, 0, stream>>>(sc, idx, gates);
            k_peer<<<S, 256, 0, stream>>>(hbuf, idx, gates, a.expert_u, a.expert_v, ob);
#elif MK_PH_HI == 7
            k_rms<<<S, 256, 0, stream>>>(ob, a.norm_ffn, hbuf);
            k_bf16_to_f32<<<S * 2048 / 256, 256, 0, stream>>>((const unsigned short*)(ws + WS_PG) + (size_t)b * S * 2048, qp);
            k_scores<<<S / 4, 256, 0, stream>>>(qp, a.sub_keys, sc);
            k_topk<<<S * 8 / 4, 256, 0, stream>>>(sc, idx, gates);
            k_peer<<<S, 256, 0, stream>>>(hbuf, idx, gates, a.expert_u, a.expert_v, ob);
#elif MK_PH_HI == 8
            k_rms<<<S, 256, 0, stream>>>(ob, a.norm_ffn, hbuf);
            k_gather_idx<<<S, 128, 0, stream>>>((const unsigned char*)(ws + WS_YA), b * S, idx, gates);
            k_peer<<<S, 256, 0, stream>>>(hbuf, idx, gates, a.expert_u, a.expert_v, ob);
#endif
            k_rms<<<S, 256, 0, stream>>>(ob, a.norm_ple, hbuf);
            k_gemm<EpiStore><<<dim3(D / 128, S / 128), 256, 0, stream>>>(pb, a.w_ple, EpiStore{ebuf, D}, 256, D, 256, 0);
            k_gemm<EpiGate><<<dim3(D / 128, S / 128), 256, 0, stream>>>(hbuf, a.w_ple_gate, EpiGate{ob, ebuf, ob, D}, D, D, D, 0);
            k_rms<<<S, 256, 0, stream>>>(ob, a.norm_final, ob);
        }
    }
#endif
}
```

```cpp
#include <hip/hip_runtime.h>
#include <cstdio>
#include <cstdint>
#include <math.h>
__device__ __forceinline__ int lane_id() { int l; asm volatile("v_mbcnt_lo_u32_b32 %0, -1, 0\n\tv_mbcnt_hi_u32_b32 %0, -1, %0" : "=v"(l)); return l; }
__device__ __forceinline__ int otid(int wid0) { return (wid0 << 6) | lane_id(); }

namespace pg8 {
#define PG8_LAS __attribute__((address_space(3)))
typedef unsigned short bf16_t;
typedef short bf16x8 __attribute__((ext_vector_type(8)));
typedef float f32x4 __attribute__((ext_vector_type(4)));
typedef unsigned u32x4 __attribute__((ext_vector_type(4)));
constexpr int BM = 256, BK = 64, HALF = 128, HTB = HALF * BK * 2  , STAGE_BYTES = 8 * HTB, NXCD = 8, WGM = 8;

__host__ __device__ __forceinline__ int lds_byte(int r, int c) { const int st = (r >> 4) * 2 + (c >> 5), rr = r & 15, cc = c & 31, ob = rr * 64 + cc * 2; return st * 1024 + (ob ^ (((ob >> 9) & 1) << 5)); }
__host__ __device__ __forceinline__ void stage_rc(int b, int& R, int& C) { const int st = b / 1024, sb = b % 1024, swz = sb ^ (((sb >> 9) & 1) << 5); R = (st >> 1) * 16 + swz / 64; C = (st & 1) * 32 + (swz % 64) / 2; }
__host__ __device__ __forceinline__ int perm32(int rho) { const int n = rho >> 4, i = rho & 15; return 8 * (i >> 2) + 4 * n + (i & 3); }

struct Unit { int pm, pn; };
struct Gemm { const bf16_t* A; const bf16_t* Bt; int K, lda, ldb, akoff; };

struct StaticOrder {
    int nM, nN, nwg, G, c;
    __host__ __device__ void init(int M, int N, int G_, int c_) { nM = M / BM; nN = N / BM; nwg = nM * nN; G = G_; c = c_; }
    __host__ __device__ bool next(int i, Unit& u) const {
        const long L = (long)i * G + c; if (L >= nwg) return false;
        int wgid = (int)L; { const int q = nwg / NXCD, r = nwg % NXCD, xcd = wgid % NXCD, off = wgid / NXCD; wgid = (xcd < r ? xcd * (q + 1) : r * (q + 1) + (xcd - r) * q) + off; }
        const int nig = WGM * nN, gid = wgid / nig, fm = gid * WGM, gsz = (nM - fm) < WGM ? (nM - fm) : WGM;
        u.pm = fm + ((wgid % nig) % gsz); u.pn = (wgid % nig) / gsz; return true;
    }
    __device__ __forceinline__ void a_ready(const Unit&) const {}
    __device__ __forceinline__ void done(const Unit&) const {}
};

template <class Epi, class Sched, bool ALIGN_EPI = false, bool SP2 = false>
__device__ __forceinline__ void gemm_phase(PG8_LAS unsigned char* lds, const Gemm g, const Sched& S, const Epi& E, const int wid0) {
    const int tid = otid(wid0), wid = __builtin_amdgcn_readfirstlane(tid >> 6), lane = tid & 63, wr = wid >> 2, wc = wid & 3, fr = lane & 15, fq = lane >> 4;
    const int K = g.K, nt = K / BK;
    unsigned voffA[2], voffB[2];
#pragma unroll
    for (int i = 0; i < 2; ++i) { int R, C; stage_rc(tid * 16 + i * 8192, R, C); const int Rb = Epi::PERM ? ((R & ~31) + perm32(R & 31)) : R;
        voffA[i] = (unsigned)(R * g.lda + C) * 2u; voffB[i] = (unsigned)(Rb * g.ldb + C) * 2u; }
    const size_t kstep = (size_t)(BK * 2);
    const size_t hstepA = (size_t)HALF * g.lda * 2, hstepB = (size_t)HALF * g.ldb * 2;
    const size_t tstepA = 2 * hstepA, tstepB = 2 * hstepB, akb = (size_t)g.akoff * 2;
    const unsigned ldsw = (unsigned)wid * 1024u;
    const int aoff = lds_byte(wr * 64 + fr, fq * 8), boff = lds_byte(wc * 32 + fr, fq * 8);
#define PG8_SA(b, h) (((b) * 2 + (h)) * HTB)
#define PG8_SB(b, h) ((4 + (b) * 2 + (h)) * HTB)
#define PG8_STAGE(bufoff, gbase, voff) do { _Pragma("unroll") for (int _i = 0; _i < 2; ++_i) \
        __builtin_amdgcn_global_load_lds((const unsigned*)((const char*)(gbase) + (voff)[_i]), (PG8_LAS unsigned*)(lds + (bufoff) + ldsw + _i * 8192), 16, 0, 0); } while (0)
#define PG8_LDA(dst, b, h) do { _Pragma("unroll") for (int m = 0; m < 4; ++m) _Pragma("unroll") for (int k = 0; k < 2; ++k) dst[m][k] = *(const PG8_LAS bf16x8*)(lds + PG8_SA(b, h) + aoff + m * 2048 + k * 1024); } while (0)
#define PG8_LDB(dst, b, h) do { _Pragma("unroll") for (int n = 0; n < 2; ++n) _Pragma("unroll") for (int k = 0; k < 2; ++k) dst[n][k] = *(const PG8_LAS bf16x8*)(lds + PG8_SB(b, h) + boff + n * 2048 + k * 1024); } while (0)
#define PG8_MMA(ai, bj, At, Bt) do { __builtin_amdgcn_s_setprio(1); _Pragma("unroll") for (int m = 0; m < 4; ++m) _Pragma("unroll") for (int n = 0; n < 2; ++n) _Pragma("unroll") for (int k = 0; k < 2; ++k) \
        acc[ai][bj][m][n] = __builtin_amdgcn_mfma_f32_16x16x32_bf16(Bt[n][k], At[m][k], acc[ai][bj][m][n], 0, 0, 0); __builtin_amdgcn_s_setprio(0); } while (0)
#define PG8_WAIT_V(n) asm volatile("s_waitcnt vmcnt(" #n ")" ::: "memory")
#define PG8_WAIT_L(n) asm volatile("s_waitcnt lgkmcnt(" #n ")" ::: "memory")
#define PG8_BAR __builtin_amdgcn_s_barrier()
#define PG8_SCHED __builtin_amdgcn_sched_barrier(0)
    Unit cur, nxt; int ui = 0;
    if (!S.next(0, cur)) return;
    f32x4 acc[2][2][4][2];
#pragma unroll
    for (int a = 0; a < 2; ++a)
#pragma unroll
        for (int b = 0; b < 2; ++b)
#pragma unroll
            for (int m = 0; m < 4; ++m)
#pragma unroll
                for (int n = 0; n < 2; ++n) acc[a][b][m][n] = (f32x4){0.f, 0.f, 0.f, 0.f};
    bf16x8 At[4][2], B0[2][2], B1[2][2];
    const char* cA = (const char*)g.A + (size_t)cur.pm * tstepA + (size_t)cur.pn * akb; const char* cB = (const char*)g.Bt + (size_t)cur.pn * tstepB;
    S.a_ready(cur);
    if constexpr (SP2) {
        PG8_STAGE(PG8_SB(0, 0), cB, voffB); PG8_STAGE(PG8_SB(0, 1), cB + hstepB, voffB); PG8_STAGE(PG8_SA(0, 0), cA, voffA); PG8_STAGE(PG8_SA(0, 1), cA + hstepA, voffA);
        if (wr == 1) PG8_BAR;
        PG8_WAIT_V(2); PG8_BAR;
        PG8_STAGE(PG8_SB(1, 0), cB + kstep, voffB); PG8_STAGE(PG8_SA(1, 0), cA + kstep, voffA); PG8_STAGE(PG8_SB(1, 1), cB + hstepB + kstep, voffB);
        PG8_WAIT_V(6); PG8_BAR;
    } else {
        PG8_STAGE(PG8_SB(0, 0), cB, voffB); PG8_STAGE(PG8_SA(0, 0), cA, voffA); PG8_STAGE(PG8_SB(0, 1), cB + hstepB, voffB); PG8_STAGE(PG8_SA(0, 1), cA + hstepA, voffA);
        if (wr == 1) PG8_BAR;
        PG8_WAIT_V(4); PG8_BAR;
        PG8_STAGE(PG8_SB(1, 0), cB + kstep, voffB); PG8_STAGE(PG8_SA(1, 0), cA + kstep, voffA); PG8_STAGE(PG8_SB(1, 1), cB + hstepB + kstep, voffB);
        PG8_WAIT_V(6); PG8_BAR;
    }
    for (;;) {
        const bool has_next = S.next(ui + 1, nxt);
        const char* nA = has_next ? (const char*)g.A + (size_t)nxt.pm * tstepA + (size_t)nxt.pn * akb : cA; const char* nB = has_next ? (const char*)g.Bt + (size_t)nxt.pn * tstepB : cB;
        for (int t = 0; t < nt; t += 2) {
            const bool last = (t == nt - 2);
            const char* a1 = cA + (size_t)(t + 1) * kstep;
            const char* a2 = last ? nA : cA + (size_t)(t + 2) * kstep; const char* b2 = last ? nB : cB + (size_t)(t + 2) * kstep;
            const char* a3 = a2 + kstep; const char* b3 = b2 + kstep;
            if (last && has_next) S.a_ready(nxt);
            if constexpr (SP2) {
            PG8_LDB(B0, 0, 0); PG8_LDB(B1, 0, 1); PG8_SCHED; PG8_LDA(At, 0, 0); PG8_STAGE(PG8_SA(1, 1), a1 + hstepA, voffA);
            PG8_WAIT_V(8); PG8_WAIT_L(0); PG8_BAR; PG8_MMA(0, 0, At, B0); PG8_MMA(0, 1, At, B1); PG8_BAR; PG8_SCHED;
            PG8_LDA(At, 0, 1); PG8_STAGE(PG8_SB(0, 0), b2, voffB); PG8_STAGE(PG8_SB(0, 1), b2 + hstepB, voffB); PG8_STAGE(PG8_SA(0, 0), a2, voffA);
            PG8_WAIT_V(8); PG8_WAIT_L(0); PG8_BAR; PG8_MMA(1, 0, At, B0); PG8_MMA(1, 1, At, B1); PG8_BAR; PG8_SCHED;
            PG8_LDB(B0, 1, 0); PG8_LDB(B1, 1, 1); PG8_SCHED; PG8_LDA(At, 1, 0); PG8_STAGE(PG8_SA(0, 1), a2 + hstepA, voffA);
            PG8_WAIT_V(8); PG8_WAIT_L(0); PG8_BAR; PG8_MMA(0, 0, At, B0); PG8_MMA(0, 1, At, B1); PG8_BAR; PG8_SCHED;
            PG8_LDA(At, 1, 1); PG8_STAGE(PG8_SB(1, 0), b3, voffB); PG8_STAGE(PG8_SB(1, 1), b3 + hstepB, voffB); PG8_STAGE(PG8_SA(1, 0), a3, voffA);
            PG8_WAIT_V(8); PG8_WAIT_L(0); PG8_BAR; PG8_MMA(1, 0, At, B0); PG8_MMA(1, 1, At, B1); PG8_BAR; PG8_SCHED;
            } else {
            PG8_LDB(B0, 0, 0); PG8_SCHED; PG8_LDA(At, 0, 0); PG8_STAGE(PG8_SA(1, 1), a1 + hstepA, voffA);
            PG8_WAIT_L(8); PG8_BAR; PG8_WAIT_L(0); PG8_MMA(0, 0, At, B0); PG8_BAR; PG8_SCHED;
            PG8_LDB(B1, 0, 1); PG8_STAGE(PG8_SB(0, 0), b2, voffB);
            PG8_BAR; PG8_WAIT_L(0); PG8_MMA(0, 1, At, B1); PG8_BAR;
            PG8_LDA(At, 0, 1); PG8_STAGE(PG8_SA(0, 0), a2, voffA);
            PG8_BAR; PG8_WAIT_L(0); PG8_MMA(1, 0, At, B0); PG8_BAR; PG8_SCHED;
            PG8_STAGE(PG8_SB(0, 1), b2 + hstepB, voffB);
            PG8_WAIT_V(6); PG8_BAR; PG8_MMA(1, 1, At, B1); PG8_BAR;
            PG8_LDB(B0, 1, 0); PG8_SCHED; PG8_LDA(At, 1, 0); PG8_STAGE(PG8_SA(0, 1), a2 + hstepA, voffA);
            PG8_WAIT_L(8); PG8_BAR; PG8_WAIT_L(0); PG8_MMA(0, 0, At, B0); PG8_BAR; PG8_SCHED;
            PG8_LDB(B1, 1, 1); PG8_STAGE(PG8_SB(1, 0), b3, voffB);
            PG8_BAR; PG8_WAIT_L(0); PG8_MMA(0, 1, At, B1); PG8_BAR;
            PG8_LDA(At, 1, 1); PG8_STAGE(PG8_SA(1, 0), a3, voffA);
            PG8_BAR; PG8_WAIT_L(0); PG8_MMA(1, 0, At, B0); PG8_BAR; PG8_SCHED;
            PG8_STAGE(PG8_SB(1, 1), b3 + hstepB, voffB);
            PG8_WAIT_V(6); PG8_BAR; PG8_MMA(1, 1, At, B1); PG8_BAR;
            }
        }
        if constexpr (ALIGN_EPI) { if (wr == 0) PG8_BAR; }
        if constexpr (!Epi::AFTER_DRAIN) { E(acc, cur, wr, wc, fr, fq); S.done(cur); }
        if (!has_next) break;
#pragma unroll
        for (int a = 0; a < 2; ++a)
#pragma unroll
            for (int b = 0; b < 2; ++b)
#pragma unroll
                for (int m = 0; m < 4; ++m)
#pragma unroll
                    for (int n = 0; n < 2; ++n) acc[a][b][m][n] = (f32x4){0.f, 0.f, 0.f, 0.f};
        cur = nxt; cA = nA; cB = nB; ++ui;
        if constexpr (ALIGN_EPI) { if (wr == 1) PG8_BAR; }
    }
    PG8_WAIT_V(0);
    if constexpr (!ALIGN_EPI) { if (wr == 0) PG8_BAR; }
    PG8_BAR;
    if constexpr (Epi::AFTER_DRAIN) { E.fused(acc, cur, wr, wc, fr, fq, lds, wid, lane); S.done(cur); }
#undef PG8_SA
#undef PG8_SB
#undef PG8_STAGE
#undef PG8_LDA
#undef PG8_LDB
#undef PG8_MMA
#undef PG8_WAIT_V
#undef PG8_WAIT_L
#undef PG8_BAR
#undef PG8_SCHED
}
}


namespace pg8 {
typedef unsigned u32x2 __attribute__((ext_vector_type(2)));
__device__ __forceinline__ unsigned cvt_pk_bf16(float lo, float hi) { unsigned r; asm volatile("v_cvt_pk_bf16_f32 %0, %1, %2" : "=v"(r) : "v"(lo), "v"(hi)); return r; }
__device__ __forceinline__ float sigm(float x) { return __builtin_amdgcn_rcpf(1.0f + __builtin_amdgcn_exp2f(-1.4426950408889634f * x)); }
__device__ __forceinline__ float bf_lo(unsigned w) { return __uint_as_float(w << 16); }
__device__ __forceinline__ float bf_hi(unsigned w) { return __uint_as_float(w & 0xffff0000u); }

struct PanelSched {
    int panel, n, skip_lo, skip_n, mode;
    __device__ __forceinline__ bool next(int i, Unit& u) const {
        if (i >= n) return false;
        if (mode == 0) { u.pm = panel; u.pn = i + (i >= skip_lo ? skip_n : 0); } else { u.pm = i; u.pn = panel; }
        return true;
    }
    __device__ __forceinline__ void a_ready(const Unit&) const {}
    __device__ __forceinline__ void done(const Unit&) const {}
};

struct EpiProj {
    static constexpr bool PERM = true, AFTER_DRAIN = false;
    bf16_t *PQ, *PK, *PU, *PG;
    __device__ __forceinline__ void operator()(const f32x4 (&acc)[2][2][4][2], const Unit& u, int wr, int wc, int fr, int fq) const {
        const int pn = u.pn; bf16_t* base; int ld, colt; bool sg = false;
        if (pn < 2) { base = PQ; ld = 512; colt = pn * 256; }
        else if (pn < 4) { base = PK; ld = 512; colt = (pn - 2) * 256; }
        else if (pn < 8) { base = PU; ld = 512; colt = (pn - 6) * 256; }
        else { base = PG; ld = 2048; colt = (pn - 8) * 256; sg = true; }
        const int row0 = u.pm * BM + wr * 64 + fr, col0 = colt + wc * 32 + 8 * fq;
#pragma unroll
        for (int ai = 0; ai < 2; ++ai)
#pragma unroll
            for (int m = 0; m < 4; ++m) { bf16_t* rowp = base + (size_t)(row0 + ai * HALF + m * 16) * ld + col0;
#pragma unroll
                for (int bj = 0; bj < 2; ++bj) { f32x4 v0 = acc[ai][bj][m][0], v1 = acc[ai][bj][m][1];
                    if (sg) { v0 = (f32x4){sigm(v0[0]), sigm(v0[1]), sigm(v0[2]), sigm(v0[3])}; v1 = (f32x4){sigm(v1[0]), sigm(v1[1]), sigm(v1[2]), sigm(v1[3])}; }
                    u32x4 w; w.x = cvt_pk_bf16(v0[0], v0[1]); w.y = cvt_pk_bf16(v0[2], v0[3]); w.z = cvt_pk_bf16(v1[0], v1[1]); w.w = cvt_pk_bf16(v1[2], v1[3]);
                    *(u32x4*)(rowp + bj * HALF) = w; } }
    }
};
struct EpiPlain {
    static constexpr bool PERM = true, AFTER_DRAIN = false;
    bf16_t* O; int ldc;
    __device__ __forceinline__ void operator()(const f32x4 (&acc)[2][2][4][2], const Unit& u, int wr, int wc, int fr, int fq) const {
        const int row0 = u.pm * BM + wr * 64 + fr, col0 = u.pn * BM + wc * 32 + 8 * fq;
#pragma unroll
        for (int ai = 0; ai < 2; ++ai)
#pragma unroll
            for (int m = 0; m < 4; ++m) { bf16_t* rowp = O + (size_t)(row0 + ai * HALF + m * 16) * ldc + col0;
#pragma unroll
                for (int bj = 0; bj < 2; ++bj) { const f32x4 v0 = acc[ai][bj][m][0], v1 = acc[ai][bj][m][1];
                    u32x4 w; w.x = cvt_pk_bf16(v0[0], v0[1]); w.y = cvt_pk_bf16(v0[2], v0[3]); w.z = cvt_pk_bf16(v1[0], v1[1]); w.w = cvt_pk_bf16(v1[2], v1[3]);
                    *(u32x4*)(rowp + bj * HALF) = w; } }
    }
};
template <bool ADD> struct EpiMerge {
    static constexpr bool PERM = true, AFTER_DRAIN = false;
    const bf16_t* G; bf16_t* MG; int goff;
    __device__ __forceinline__ void operator()(const f32x4 (&acc)[2][2][4][2], const Unit& u, int wr, int wc, int fr, int fq) const {
        const int row0 = u.pm * BM + wr * 64 + fr, col0 = u.pn * BM + wc * 32 + 8 * fq;
#pragma unroll
        for (int ai = 0; ai < 2; ++ai)
#pragma unroll
            for (int m = 0; m < 4; ++m) { const size_t row = (size_t)(row0 + ai * HALF + m * 16);
#pragma unroll
                for (int bj = 0; bj < 2; ++bj) { const f32x4 v0 = acc[ai][bj][m][0], v1 = acc[ai][bj][m][1];
                    const u32x4 gw = *(const u32x4*)(G + row * 2048 + goff + col0 + bj * HALF);
                    float r0 = bf_lo(gw.x) * v0[0], r1 = bf_hi(gw.x) * v0[1], r2 = bf_lo(gw.y) * v0[2], r3 = bf_hi(gw.y) * v0[3];
                    float r4 = bf_lo(gw.z) * v1[0], r5 = bf_hi(gw.z) * v1[1], r6 = bf_lo(gw.w) * v1[2], r7 = bf_hi(gw.w) * v1[3];
                    bf16_t* mp = MG + row * 1024 + col0 + bj * HALF;
                    if (ADD) { const u32x4 pw = *(const u32x4*)mp;
                        r0 += bf_lo(pw.x); r1 += bf_hi(pw.x); r2 += bf_lo(pw.y); r3 += bf_hi(pw.y); r4 += bf_lo(pw.z); r5 += bf_hi(pw.z); r6 += bf_lo(pw.w); r7 += bf_hi(pw.w); }
                    u32x4 w; w.x = cvt_pk_bf16(r0, r1); w.y = cvt_pk_bf16(r2, r3); w.z = cvt_pk_bf16(r4, r5); w.w = cvt_pk_bf16(r6, r7);
                    *(u32x4*)mp = w; }
                asm volatile("" ::: "memory"); }
    }
};
struct EpiRes {
    static constexpr bool PERM = false, AFTER_DRAIN = false;
    const float* X; float* OUT;
    __device__ __forceinline__ void operator()(const f32x4 (&acc)[2][2][4][2], const Unit& u, int wr, int wc, int fr, int fq) const {
        const int col0 = u.pn * BM + wc * 32 + 4 * fq;
#pragma unroll
        for (int ai = 0; ai < 2; ++ai)
#pragma unroll
            for (int m = 0; m < 4; ++m) { const size_t off = (size_t)(u.pm * BM + ai * HALF + wr * 64 + m * 16 + fr) * 1024 + col0;
#pragma unroll
                for (int bj = 0; bj < 2; ++bj)
#pragma unroll
                    for (int n = 0; n < 2; ++n) { const f32x4 xs = *(const f32x4*)(X + off + bj * HALF + n * 16); *(f32x4*)(OUT + off + bj * HALF + n * 16) = xs + acc[ai][bj][m][n]; }
                asm volatile("" ::: "memory"); }
    }
};
struct EpiGate {
    static constexpr bool PERM = false, AFTER_DRAIN = false;
    float* OUT; const bf16_t* E;
    __device__ __forceinline__ void operator()(const f32x4 (&acc)[2][2][4][2], const Unit& u, int wr, int wc, int fr, int fq) const {
        const int col0 = u.pn * BM + wc * 32 + 4 * fq;
#pragma unroll
        for (int ai = 0; ai < 2; ++ai)
#pragma unroll
            for (int m = 0; m < 4; ++m) { const size_t off = (size_t)(u.pm * BM + ai * HALF + wr * 64 + m * 16 + fr) * 1024 + col0;
#pragma unroll
                for (int bj = 0; bj < 2; ++bj)
#pragma unroll
                    for (int n = 0; n < 2; ++n) { const size_t o2 = off + bj * HALF + n * 16; const f32x4 xs = *(const f32x4*)(OUT + o2); const u32x2 ew = *(const u32x2*)(E + o2); const f32x4 a = acc[ai][bj][m][n];
                        f32x4 r; r[0] = xs[0] + sigm(a[0]) * bf_lo(ew.x); r[1] = xs[1] + sigm(a[1]) * bf_hi(ew.x); r[2] = xs[2] + sigm(a[2]) * bf_lo(ew.y); r[3] = xs[3] + sigm(a[3]) * bf_hi(ew.y);
                        *(f32x4*)(OUT + o2) = r; }
                asm volatile("" ::: "memory"); }
    }
};
}

#define GAS __attribute__((address_space(1)))
#define LAS __attribute__((address_space(3)))
typedef unsigned short bf16;
typedef unsigned v4u __attribute__((ext_vector_type(4)));
typedef float f32x4 __attribute__((ext_vector_type(4)));
typedef short bf16x8 __attribute__((ext_vector_type(8)));
typedef GAS unsigned gu32;
typedef GAS unsigned long long gu64;
#define RLX_AGENT __ATOMIC_RELAXED, __HIP_MEMORY_SCOPE_AGENT
#define LDS_WAIT() asm volatile("s_waitcnt lgkmcnt(0)" ::: "memory")
#define VM_WAIT() asm volatile("s_waitcnt vmcnt(0)" ::: "memory")
__device__ __forceinline__ unsigned long long rt() { return __builtin_amdgcn_s_memrealtime(); }
__device__ __forceinline__ unsigned f2bf(float f) { unsigned u = __builtin_bit_cast(unsigned, f); return (u + 0x7fffu + ((u >> 16) & 1u)) >> 16; }
__device__ __forceinline__ unsigned pk2(float lo, float hi) { return f2bf(lo) | (f2bf(hi) << 16); }

#define XB_TMO      128
#define XB_XCNT(j)  (256  + 64 * (j))
#define XB_XSUB(j)  (1280 + 64 * (j))
#define XB_XGEN(j)  (2304 + 64 * (j))
#define XB_TOP      3328
#define XB_TOPGEN   3392
#define XCD_BAR_WORDS 3456
#define XB_SPIN_CAP (1u << 18)

__device__ __forceinline__ unsigned xb_ld(unsigned* p)              { return __hip_atomic_load(p, __ATOMIC_RELAXED, __HIP_MEMORY_SCOPE_AGENT); }
__device__ __forceinline__ unsigned xb_add(unsigned* p, unsigned v) { return __hip_atomic_fetch_add(p, v, __ATOMIC_RELAXED, __HIP_MEMORY_SCOPE_AGENT); }
__device__ __forceinline__ unsigned xb_xcc_id() { return (unsigned)__builtin_amdgcn_s_getreg((3 << 11) | 20) & 0xFu; }
#define XB_SPIN(cond, bar) do { unsigned _sp = 0; while (cond) { __builtin_amdgcn_s_sleep(1); \
    if ((++_sp & 255u) == 0u) { if (xb_ld(&(bar)[XB_TMO])) break; if (_sp > XB_SPIN_CAP) { atomicAdd(&(bar)[XB_TMO], 1u); break; } } } } while (0)

struct XcdBarrier {
    unsigned* bar; unsigned x;
    volatile LAS unsigned* st;
};

__device__ __forceinline__ XcdBarrier xcd_barrier_post(unsigned* bar, volatile LAS unsigned* st, const bool is_t0) {
    XcdBarrier b; b.bar = bar; b.x = xb_xcc_id(); b.st = st;
    if (is_t0) (void)xb_add(&bar[XB_XCNT(b.x)], 1u);
    return b;
}
__device__ __forceinline__ void xcd_barrier_complete(unsigned* bar, unsigned x, unsigned& nloc, unsigned& nx) {
    const unsigned G = gridDim.x * gridDim.y * gridDim.z;
    unsigned sum, cnt, mine, sp = 0u;
    for (;;) {
        sum = 0u; cnt = 0u; mine = 0u;
#pragma unroll
        for (unsigned j = 0; j < 16; ++j) { const unsigned c = xb_ld(&bar[XB_XCNT(j)]); sum += c; cnt += (c > 0u) ? 1u : 0u; mine = (j == x) ? c : mine; }
        if (sum == G) break;
        __builtin_amdgcn_s_sleep(1);
        if ((++sp & 255u) == 0u) { if (xb_ld(&bar[XB_TMO])) break; if (sp > XB_SPIN_CAP) { atomicAdd(&bar[XB_TMO], 1u); break; } }
    }
    nloc = mine > 0u ? mine : 1u; nx = cnt > 0u ? cnt : 1u;
}

__device__ __forceinline__ void xcd_barrier(const XcdBarrier& b, const bool is_t0) {
    asm volatile("s_waitcnt vmcnt(0)" ::: "memory");
    __syncthreads();
    if (is_t0) {
        unsigned* bar = b.bar;
        __builtin_amdgcn_s_waitcnt(0);
        unsigned nloc = b.st[0], nx = b.st[1];
        if (nloc == 0u) { xcd_barrier_complete(bar, b.x, nloc, nx); b.st[0] = nloc; b.st[1] = nx; }
        const unsigned old = xb_add(&bar[XB_XSUB(b.x)], 1u);
        const unsigned gen = old / nloc;
        if (old + 1u == (gen + 1u) * nloc) {
            __builtin_amdgcn_fence(__ATOMIC_RELEASE, "agent");
            asm volatile("s_waitcnt vmcnt(0)" ::: "memory");
            const unsigned og = xb_add(&bar[XB_TOP], 1u);
            const unsigned tg = og / nx;
            if (og + 1u == (tg + 1u) * nx) xb_add(&bar[XB_TOPGEN], 1u);
            else XB_SPIN(xb_ld(&bar[XB_TOPGEN]) == tg, bar);
            __builtin_amdgcn_fence(__ATOMIC_ACQUIRE, "agent");
            xb_add(&bar[XB_XGEN(b.x)], 1u);
            asm volatile("s_waitcnt vmcnt(0)" ::: "memory");
        } else {
            XB_SPIN(xb_ld(&bar[XB_XGEN(b.x)]) == gen, bar);
            __builtin_amdgcn_fence(__ATOMIC_ACQUIRE, "agent");
            asm volatile("s_waitcnt vmcnt(0)" ::: "memory");
        }
    }
    __syncthreads();
}


constexpr int NWAVES = 8, NTHR = 512;
constexpr int TOK = 65536, DM = 1024, SEQ = 8192, NPANEL = 256;
constexpr float RMS_EPS = 1e-6f;
constexpr float C2 = 0.125f * 1.4426950408889634f;
constexpr float SURV_THR = 5.4210108624275222e-20f;
constexpr size_t MiB = 1u << 20;
constexpr size_t WS_CTL = 0, CTL_ZERO_BYTES = 64 * 1024;
constexpr size_t WS_WIN = 2 * MiB, WS_WOUT = 10 * MiB, WS_WQ = 12 * MiB, WS_WPG = 16 * MiB, WS_WPLE = 18 * MiB;
constexpr size_t WS_BDA = 18 * MiB + 512 * 1024, WS_BDP = 18 * MiB + 768 * 1024, WS_SK = 19 * MiB;
constexpr size_t WS_EU = 32 * MiB, WS_EV = 64 * MiB, WS_SU = 20 * MiB, WS_SV = 20 * MiB + 65536;
constexpr size_t WS_XN = 96 * MiB;
constexpr size_t WS_PQ = 224 * MiB, WS_PK = 288 * MiB, WS_PVT = 352 * MiB, WS_PU = 416 * MiB;
constexpr size_t WS_PG = 480 * MiB;
constexpr size_t WS_YA = 736 * MiB, WS_YP = 800 * MiB;
constexpr size_t WS_MG = 864 * MiB, WS_END = 992 * MiB;
constexpr int CW_BAR = 1024;
constexpr int RING_BYTES = 131072, LDSCTL_OFF = RING_BYTES, MISC_OFF = LDSCTL_OFF + 320, LDS_BYTES = 147456;

typedef float f32x16 __attribute__((ext_vector_type(16)));
typedef float f32x2 __attribute__((ext_vector_type(2)));
typedef __bf16 bf16x2v __attribute__((ext_vector_type(2)));

__device__ __forceinline__ float wave_sum(float v) {
#pragma unroll
    for (int o = 1; o < 64; o <<= 1) v += __shfl_xor(v, o);
    return v;
}
__device__ __forceinline__ float bflo(unsigned w) { return __uint_as_float(w << 16); }
__device__ __forceinline__ float bfhi(unsigned w) { return __uint_as_float(w & 0xffff0000u); }
__device__ __forceinline__ unsigned cvtpk(float lo, float hi) { return pg8::cvt_pk_bf16(lo, hi); }

__device__ __forceinline__ void p0_transpose_item(const float* W, int K, int N, bf16* WT, const float* kscale, int nlo, float nls, LAS float* scr, int item, int lane) {
    const int nblk = N / 32, kb = item / nblk, nb = item % nblk, k0 = 64 * kb, n0 = 32 * nb;
    const float ns = (n0 + (lane & 31)) < nlo ? nls : 1.0f;
#pragma unroll 8
    for (int i = 0; i < 32; ++i) { const int kk = 2 * i + (lane >> 5); float v = W[(size_t)(k0 + kk) * N + n0 + (lane & 31)] * ns; if (kscale) v *= kscale[k0 + kk]; scr[kk * 33 + (lane & 31)] = v; }
    LDS_WAIT(); asm volatile("" ::: "memory");
    const int c = lane & 7;
#pragma unroll
    for (int j = 0; j < 4; ++j) { const int n = (lane >> 3) + 8 * j; const LAS float* s = scr + (8 * c) * 33 + n;
        v4u o; o.x = pk2(s[0 * 33], s[1 * 33]); o.y = pk2(s[2 * 33], s[3 * 33]); o.z = pk2(s[4 * 33], s[5 * 33]); o.w = pk2(s[6 * 33], s[7 * 33]);
        *(GAS v4u*)(WT + (size_t)(n0 + n) * K + k0 + 8 * c) = o; }
    LDS_WAIT(); asm volatile("" ::: "memory");
}
__device__ __forceinline__ void rms_row_to_bf16(const float* xrow, bf16* orow, int lane) {
    const GAS f32x4* xr = (const GAS f32x4*)xrow + lane;
    f32x4 v[4]; float s = 0.f;
#pragma unroll
    for (int j = 0; j < 4; ++j) { v[j] = xr[64 * j]; s += (v[j].x * v[j].x + v[j].y * v[j].y) + (v[j].z * v[j].z + v[j].w * v[j].w); }
    const float r = 1.f / sqrtf(wave_sum(s) * (1.f / DM) + RMS_EPS);
    GAS unsigned long long* o8 = (GAS unsigned long long*)orow + lane;
#pragma unroll
    for (int j = 0; j < 4; ++j) o8[64 * j] = (unsigned long long)pk2(v[j].x * r, v[j].y * r) | ((unsigned long long)pk2(v[j].z * r, v[j].w * r) << 32);
}
__device__ __forceinline__ void cvt8_store(const float* src, bf16* dst) {
    const f32x4 a = *(const GAS f32x4*)src, b = *(const GAS f32x4*)(src + 4);
    v4u o; o.x = pk2(a.x, a.y); o.y = pk2(a.z, a.w); o.z = pk2(b.x, b.y); o.w = pk2(b.z, b.w);
    *(GAS v4u*)dst = o;
}

__device__ __forceinline__ void attn_panel(int panel, const bf16* PQ, const bf16* PK, const bf16* PVT, bf16* YA, const int wid0) {
    const int tid = otid(wid0), lane = tid & 63, wid = __builtin_amdgcn_readfirstlane(tid >> 6);
    const int r32 = lane & 31, hh = lane >> 5;
    const size_t seq0 = (size_t)(panel >> 5) * SEQ;
    const int pos0 = (panel & 31) * 256 + wid * 32;
    const int kap = 16 * ((r32 >> 2) & 1) + (r32 & 3) + 4 * (r32 >> 3);
    for (int h = 0; h < 8; ++h) {
        bf16x8 qf[4];
        { const bf16* qrow = PQ + (seq0 + pos0 + r32) * 512 + h * 64 + 8 * hh;
#pragma unroll
          for (int s = 0; s < 4; ++s) qf[s] = *(const GAS bf16x8*)(qrow + 16 * s); }
        f32x16 o0 = {}, o1 = {};
        float Sin = 1.f;
        for (int kb = pos0; kb >= 0; kb -= 32) {
            const bf16* krow = PK + (seq0 + kb + kap) * 512 + h * 64 + 8 * hh;
            const bf16* vrow = PVT + (size_t)(h * 64 + kap) * TOK + seq0 + kb + 16 * hh;
            bf16x8 kf[4], vf[2][2];
#pragma unroll
            for (int s = 0; s < 4; ++s) kf[s] = *(const GAS bf16x8*)(krow + 16 * s);
#pragma unroll
            for (int db = 0; db < 2; ++db)
#pragma unroll
                for (int s = 0; s < 2; ++s) vf[db][s] = *(const GAS bf16x8*)(vrow + (size_t)db * 32 * TOK + 8 * s);
            f32x16 z = {};
#pragma unroll
            for (int s = 0; s < 4; ++s) z = __builtin_amdgcn_mfma_f32_32x32x16_bf16(kf[s], qf[s], z, 0, 0, 0);
            const bool diag = (kb == pos0);
            float w[16]; float Sl = 1.f;
#pragma unroll
            for (int reg = 15; reg >= 0; --reg) {
                float beta = __builtin_amdgcn_rcpf(1.0f + __builtin_amdgcn_exp2f(-z[reg]));
                if (diag && (16 * hh + reg >= r32)) beta = 0.f;
                const float wl = beta * Sl; Sl -= wl; w[reg] = wl;
            }
            const float Pp = __shfl_xor(Sl, 32);
            const float scale = hh ? Sin : Sin * Pp;
            Sin = Sin * Sl * Pp;
            v4u pw0, pw1;
            pw0.x = cvtpk(w[0] * scale, w[1] * scale); pw0.y = cvtpk(w[2] * scale, w[3] * scale); pw0.z = cvtpk(w[4] * scale, w[5] * scale); pw0.w = cvtpk(w[6] * scale, w[7] * scale);
            pw1.x = cvtpk(w[8] * scale, w[9] * scale); pw1.y = cvtpk(w[10] * scale, w[11] * scale); pw1.z = cvtpk(w[12] * scale, w[13] * scale); pw1.w = cvtpk(w[14] * scale, w[15] * scale);
            const bf16x8 p0 = __builtin_bit_cast(bf16x8, pw0), p1 = __builtin_bit_cast(bf16x8, pw1);
            o0 = __builtin_amdgcn_mfma_f32_32x32x16_bf16(vf[0][0], p0, o0, 0, 0, 0);
            o0 = __builtin_amdgcn_mfma_f32_32x32x16_bf16(vf[0][1], p1, o0, 0, 0, 0);
            o1 = __builtin_amdgcn_mfma_f32_32x32x16_bf16(vf[1][0], p0, o1, 0, 0, 0);
            o1 = __builtin_amdgcn_mfma_f32_32x32x16_bf16(vf[1][1], p1, o1, 0, 0, 0);
            if (__all(Sin < SURV_THR)) break;
        }
        bf16* orow = YA + (seq0 + pos0 + r32) * 512 + h * 64 + 16 * hh;
        v4u a, b2;
        a.x = cvtpk(o0[0], o0[1]); a.y = cvtpk(o0[2], o0[3]); a.z = cvtpk(o0[4], o0[5]); a.w = cvtpk(o0[6], o0[7]);
        b2.x = cvtpk(o0[8], o0[9]); b2.y = cvtpk(o0[10], o0[11]); b2.z = cvtpk(o0[12], o0[13]); b2.w = cvtpk(o0[14], o0[15]);
        *(GAS v4u*)orow = a; *(GAS v4u*)(orow + 8) = b2;
        a.x = cvtpk(o1[0], o1[1]); a.y = cvtpk(o1[2], o1[3]); a.z = cvtpk(o1[4], o1[5]); a.w = cvtpk(o1[6], o1[7]);
        b2.x = cvtpk(o1[8], o1[9]); b2.y = cvtpk(o1[10], o1[11]); b2.z = cvtpk(o1[12], o1[13]); b2.w = cvtpk(o1[14], o1[15]);
        *(GAS v4u*)(orow + 32) = a; *(GAS v4u*)(orow + 40) = b2;
    }
}

__device__ __forceinline__ void pool_panel(int panel, const bf16* PU, bf16* YP, const int wid0) {
    const int tid = otid(wid0);
    const int chunk = tid & 63, tg = tid >> 6, w = 2 << (chunk >> 4);
    const int posb = (panel & 31) * 256; const size_t row0 = (size_t)panel * 256;
    for (int i = 0; i < 32; ++i) {
        const int t = tg * 32 + i, pos = posb + t, cnt = (pos + 1 < w) ? (pos + 1) : w;
        float s[8];
#pragma unroll
        for (int k = 0; k < 8; ++k) s[k] = 0.f;
        v4u cur = {0u, 0u, 0u, 0u};
        for (int j = 0; j < cnt; ++j) {
            const v4u v = *(const GAS v4u*)(PU + (row0 + t - j) * 512 + chunk * 8);
            if (j == 0) cur = v;
            s[0] += bflo(v.x); s[1] += bfhi(v.x); s[2] += bflo(v.y); s[3] += bfhi(v.y); s[4] += bflo(v.z); s[5] += bfhi(v.z); s[6] += bflo(v.w); s[7] += bfhi(v.w);
        }
        const float ic = 1.0f / (float)cnt;
        v4u o;
        o.x = cvtpk(s[0] * ic - bflo(cur.x), s[1] * ic - bfhi(cur.x)); o.y = cvtpk(s[2] * ic - bflo(cur.y), s[3] * ic - bfhi(cur.y));
        o.z = cvtpk(s[4] * ic - bflo(cur.z), s[5] * ic - bfhi(cur.z)); o.w = cvtpk(s[6] * ic - bflo(cur.w), s[7] * ic - bfhi(cur.w));
        *(GAS v4u*)(YP + (row0 + t) * 512 + chunk * 8) = o;
    }
}

#define HD __host__ __device__ __forceinline__
HD int f2s(float f) { int i = __builtin_bit_cast(int, f); return i ^ ((i >> 31) & 0x7fffffff); }
HD float s2f(int i) { i ^= ((i >> 31) & 0x7fffffff); return __builtin_bit_cast(float, i); }
HD void ce_desc(int& a, int& b) { const int mx = a > b ? a : b, mn = a > b ? b : a; a = mx; b = mn; }
template <int J, int K> HD void bpass16(int (&v)[16]) {
#pragma unroll
    for (int i = 0; i < 16; ++i) { const int l = i ^ J; if (l > i) { if ((i & K) == 0) ce_desc(v[i], v[l]); else ce_desc(v[l], v[i]); } }
}
HD void bitonic_sort16_desc(int (&v)[16]) {
    bpass16<1, 2>(v); bpass16<2, 4>(v); bpass16<1, 4>(v); bpass16<4, 8>(v); bpass16<2, 8>(v); bpass16<1, 8>(v);
    bpass16<8, 16>(v); bpass16<4, 16>(v); bpass16<2, 16>(v); bpass16<1, 16>(v);
}
HD void bitonic_merge16_desc(int (&v)[16]) {
    bpass16<8, 16>(v); bpass16<4, 16>(v); bpass16<2, 16>(v); bpass16<1, 16>(v);
}
HD void merge_prune16(int (&x)[16], const int (&y)[16]) {
#pragma unroll
    for (int i = 0; i < 16; ++i) x[i] = x[i] > y[15 - i] ? x[i] : y[15 - i];
    bitonic_merge16_desc(x);
}
HD int cx_i(int hf, int t) { if (hf == 0) return 0; return t < 5 ? 2 : t < 9 ? 3 : t < 12 ? 4 : t < 14 ? 5 : 6; }
HD int cx_j(int hf, int t) { if (hf == 0) return t; return t < 5 ? t : t < 9 ? t - 5 : t < 12 ? t - 9 : t < 14 ? t - 12 : t - 14; }
HD int cy_i(int hf, int t) { if (hf == 0) return t < 8 ? 1 : 23 - t; return 7; }
HD int cy_j(int hf, int t) { if (hf == 0) return t < 8 ? t : 0; return t; }

__device__ __forceinline__ void top16_of_group(const bf16* qrow  , const bf16* skg  , int hh, int (&res)[16]) {
    bf16x8 qf[8];
#pragma unroll
    for (int s = 0; s < 8; ++s) qf[s] = *(const GAS bf16x8*)(qrow + 16 * s);
    int v[4][16];
#pragma unroll
    for (int kb = 0; kb < 4; ++kb) {
        f32x16 acc = {};
#pragma unroll
        for (int s = 0; s < 8; ++s) { const bf16x8 af = *(const GAS bf16x8*)(skg + (size_t)kb * 32 * 128 + 16 * s); acc = __builtin_amdgcn_mfma_f32_32x32x16_bf16(af, qf[s], acc, 0, 0, 0); }
#pragma unroll
        for (int reg = 0; reg < 16; ++reg) { const int keyid = 32 * kb + (reg & 3) + 8 * (reg >> 2) + 4 * hh; v[kb][reg] = (f2s(acc[reg]) & ~127) | keyid; }
    }
    bitonic_sort16_desc(v[0]); bitonic_sort16_desc(v[1]); bitonic_sort16_desc(v[2]); bitonic_sort16_desc(v[3]);
    merge_prune16(v[0], v[1]); merge_prune16(v[2], v[3]); merge_prune16(v[0], v[2]);
    int y[16];
#pragma unroll
    for (int i = 0; i < 16; ++i) y[i] = __shfl_xor(v[0][i], 32);
    merge_prune16(v[0], y);
#pragma unroll
    for (int i = 0; i < 16; ++i) res[i] = v[0][i];
}

__device__ __forceinline__ void topk_panel(int panel, const bf16* QP, const bf16* SK, int* IDXp, float* GTp  , LAS int* lut  , const int wid0) {
    const int tid = otid(wid0), lane = tid & 63, wid = __builtin_amdgcn_readfirstlane(tid >> 6);
    const int r32 = lane & 31, hh = lane >> 5;
    const int lrow = wid * 32 + r32;
    const size_t row = (size_t)panel * 256 + lrow;
    for (int h = 0; h < 8; ++h) {
        int a[16], b[16];
        top16_of_group(QP + row * 2048 + (2 * h) * 128 + 8 * hh, SK + ((size_t)(2 * h) * 128 + r32) * 128 + 8 * hh, hh, a);
        top16_of_group(QP + row * 2048 + (2 * h + 1) * 128 + 8 * hh, SK + ((size_t)(2 * h + 1) * 128 + r32) * 128 + 8 * hh, hh, b);
        float fa[16], fb[16];
#pragma unroll
        for (int i = 0; i < 16; ++i) { fa[i] = s2f(a[i] & ~127); fb[i] = s2f(b[i] & ~127); lut[i * 512 + tid] = a[i] & 127; lut[(16 + i) * 512 + tid] = b[i] & 127; }
        int X[16], Y[16];
#pragma unroll
        for (int t = 0; t < 16; ++t) {
            const float s0 = fa[cx_i(0, t)] + fb[cx_j(0, t)], s1 = fa[cx_i(1, t)] + fb[cx_j(1, t)];
            const int c0 = cx_i(0, t) * 16 + cx_j(0, t), c1 = cx_i(1, t) * 16 + cx_j(1, t);
            X[t] = hh ? ((f2s(s1) & ~255) | c1) : ((f2s(s0) & ~255) | c0);
            const float u0 = fa[cy_i(0, t)] + fb[cy_j(0, t)];
            const int d0 = cy_i(0, t) * 16 + cy_j(0, t);
            int y1 = (int)0x80000000;
            if (t < 2) { const float u1 = fa[cy_i(1, t)] + fb[cy_j(1, t)]; y1 = (f2s(u1) & ~255) | (cy_i(1, t) * 16 + cy_j(1, t)); }
            Y[t] = hh ? y1 : ((f2s(u0) & ~255) | d0);
        }
        bitonic_sort16_desc(X); bitonic_merge16_desc(Y); merge_prune16(X, Y);
#pragma unroll
        for (int i = 0; i < 16; ++i) Y[i] = __shfl_xor(X[i], 32);
        merge_prune16(X, Y);
        const float mx = s2f(X[0] & ~255);
        float ex[16], den = 0.f;
#pragma unroll
        for (int i = 0; i < 16; ++i) { ex[i] = __builtin_amdgcn_exp2f((s2f(X[i] & ~255) - mx) * 1.4426950408889634f); den += ex[i]; }
        const float rden = 1.0f / den;
        int oi[8]; float og[8];
#pragma unroll
        for (int t = 0; t < 8; ++t) {
            const int msk = -hh;
            const int code = (X[t] ^ ((X[t] ^ X[8 + t]) & msk)) & 255;
            const int e1 = lut[(code >> 4) * 512 + tid], e2 = lut[(16 + (code & 15)) * 512 + tid];
            const int exl = __builtin_bit_cast(int, ex[t]), exh = __builtin_bit_cast(int, ex[8 + t]);
            oi[t] = e1 * 128 + e2; og[t] = __builtin_bit_cast(float, exl ^ ((exl ^ exh) & msk)) * rden;
        }
        int* ip = IDXp + lrow * 128 + h * 16 + 8 * hh; float* gp = GTp + lrow * 128 + h * 16 + 8 * hh;
        *(GAS v4u*)ip = (v4u){(unsigned)oi[0], (unsigned)oi[1], (unsigned)oi[2], (unsigned)oi[3]}; *(GAS v4u*)(ip + 4) = (v4u){(unsigned)oi[4], (unsigned)oi[5], (unsigned)oi[6], (unsigned)oi[7]};
        *(GAS f32x4*)gp = (f32x4){og[0], og[1], og[2], og[3]}; *(GAS f32x4*)(gp + 4) = (f32x4){og[4], og[5], og[6], og[7]};
    }
}

typedef float f32x2v __attribute__((ext_vector_type(2)));
__device__ __forceinline__ void quant_row_fp8(const float* src, unsigned char* dst, float* sc_out, int lane) {
    const GAS f32x4* s = (const GAS f32x4*)src + 4 * lane;
    f32x4 v[4]; float m = 0.f;
#pragma unroll
    for (int j = 0; j < 4; ++j) { v[j] = s[j]; m = fmaxf(m, fmaxf(fmaxf(fabsf(v[j].x), fabsf(v[j].y)), fmaxf(fabsf(v[j].z), fabsf(v[j].w)))); }
#pragma unroll
    for (int o = 1; o < 64; o <<= 1) m = fmaxf(m, __shfl_xor(m, o));
    const float sc = m > 0.f ? 224.0f / m : 1.0f;
    v4u w;
    { int t = 0; t = __builtin_amdgcn_cvt_pk_fp8_f32(v[0].x * sc, v[0].y * sc, t, false); t = __builtin_amdgcn_cvt_pk_fp8_f32(v[0].z * sc, v[0].w * sc, t, true); w.x = (unsigned)t; }
    { int t = 0; t = __builtin_amdgcn_cvt_pk_fp8_f32(v[1].x * sc, v[1].y * sc, t, false); t = __builtin_amdgcn_cvt_pk_fp8_f32(v[1].z * sc, v[1].w * sc, t, true); w.y = (unsigned)t; }
    { int t = 0; t = __builtin_amdgcn_cvt_pk_fp8_f32(v[2].x * sc, v[2].y * sc, t, false); t = __builtin_amdgcn_cvt_pk_fp8_f32(v[2].z * sc, v[2].w * sc, t, true); w.z = (unsigned)t; }
    { int t = 0; t = __builtin_amdgcn_cvt_pk_fp8_f32(v[3].x * sc, v[3].y * sc, t, false); t = __builtin_amdgcn_cvt_pk_fp8_f32(v[3].z * sc, v[3].w * sc, t, true); w.w = (unsigned)t; }
    *(GAS v4u*)(dst + 16 * lane) = w;
    if (lane == 0) *sc_out = m > 0.f ? m * (1.0f / 224.0f) : 1.0f;
}
__device__ __forceinline__ void dq4(unsigned w, float (&f)[4]) {
    const f32x2v lo = __builtin_amdgcn_cvt_pk_f32_fp8((int)w, false), hi = __builtin_amdgcn_cvt_pk_f32_fp8((int)w, true);
    f[0] = lo.x; f[1] = lo.y; f[2] = hi.x; f[3] = hi.y;
}
__device__ __forceinline__ float dot16_fp8(const v4u u, const float (&h)[16]) {
    float f0[4], f1[4], f2[4], f3[4]; dq4(u.x, f0); dq4(u.y, f1); dq4(u.z, f2); dq4(u.w, f3);
    float a = f0[0] * h[0], b = f1[0] * h[4], c = f2[0] * h[8], d = f3[0] * h[12];
    a = fmaf(f0[1], h[1], a); b = fmaf(f1[1], h[5], b); c = fmaf(f2[1], h[9], c); d = fmaf(f3[1], h[13], d);
    a = fmaf(f0[2], h[2], a); b = fmaf(f1[2], h[6], b); c = fmaf(f2[2], h[10], c); d = fmaf(f3[2], h[14], d);
    a = fmaf(f0[3], h[3], a); b = fmaf(f1[3], h[7], b); c = fmaf(f2[3], h[11], c); d = fmaf(f3[3], h[15], d);
    return (a + b) + (c + d);
}
__device__ __forceinline__ void fma16_fp8(float (&o)[16], float cf, const v4u v) {
    float f0[4], f1[4], f2[4], f3[4]; dq4(v.x, f0); dq4(v.y, f1); dq4(v.z, f2); dq4(v.w, f3);
#pragma unroll
    for (int k = 0; k < 4; ++k) { o[k] = fmaf(cf, f0[k], o[k]); o[4 + k] = fmaf(cf, f1[k], o[4 + k]); o[8 + k] = fmaf(cf, f2[k], o[8 + k]); o[12 + k] = fmaf(cf, f3[k], o[12 + k]); }
}
#define RS_LEVEL(v, n, m) do { _Pragma("unroll") for (int _e = 0; _e < (n); ++_e) { const bool _up = (lane & (m)) != 0; const float _send = _up ? v[_e] : v[_e + (n)]; const float _keep = _up ? v[_e + (n)] : v[_e]; v[_e] = _keep + __shfl_xor(_send, (m)); } } while (0)
__device__ __forceinline__ void peer_panel(int panel, bf16* XN, const int* IDXp, const float* GTp, const unsigned char* EU8, const unsigned char* EV8, const float* SU, const float* SV, float* XIO, const int wid0) {
    const int tid = otid(wid0), lane = tid & 63, wid = __builtin_amdgcn_readfirstlane(tid >> 6);
    for (int ti = 0; ti < 32; ++ti) {
        const int lrow = wid * 32 + ti;
        const size_t row = (size_t)panel * 256 + lrow;
        const int i0 = IDXp[lrow * 128 + lane], i1 = IDXp[lrow * 128 + 64 + lane];
        const float g0 = GTp[lrow * 128 + lane], g1 = GTp[lrow * 128 + 64 + lane];
        const float su0 = SU[i0], su1 = SU[i1], sv0 = SV[i0], sv1 = SV[i1];
        float h[16];
        { const v4u hA = *(const GAS v4u*)(XN + row * DM + 16 * lane), hB = *(const GAS v4u*)(XN + row * DM + 16 * lane + 8);
          h[0] = bflo(hA.x); h[1] = bfhi(hA.x); h[2] = bflo(hA.y); h[3] = bfhi(hA.y); h[4] = bflo(hA.z); h[5] = bfhi(hA.z); h[6] = bflo(hA.w); h[7] = bfhi(hA.w);
          h[8] = bflo(hB.x); h[9] = bfhi(hB.x); h[10] = bflo(hB.y); h[11] = bfhi(hB.y); h[12] = bflo(hB.z); h[13] = bfhi(hB.z); h[14] = bflo(hB.w); h[15] = bfhi(hB.w); }
        float coef[2];
#pragma unroll
        for (int hf = 0; hf < 2; ++hf) {
            const int iv = hf ? i1 : i0;
            float q[4];
#pragma unroll
            for (int k = 0; k < 4; ++k) q[k] = 0.f;
#pragma unroll
            for (int c = 0; c < 4; ++c) {
                v4u ua[16];
#pragma unroll
                for (int j = 0; j < 16; ++j) { const int ex = __builtin_amdgcn_readlane(iv, c * 16 + j); ua[j] = *((const GAS v4u*)(EU8 + (size_t)ex * DM) + lane); }
                float p[16];
#pragma unroll
                for (int j = 0; j < 16; ++j) p[j] = dot16_fp8(ua[j], h);
                RS_LEVEL(p, 8, 8); RS_LEVEL(p, 4, 4); RS_LEVEL(p, 2, 2); RS_LEVEL(p, 1, 1);
                q[c] = p[0];
            }
            RS_LEVEL(q, 2, 32); RS_LEVEL(q, 1, 16);
            const float s = q[0] * (hf ? su1 : su0);
            const float act = 0.5f * s * (1.0f + erff(s * 0.70710678118654752f));
            coef[hf] = (hf ? g1 : g0) * act * (hf ? sv1 : sv0);
        }
        float o[16];
        { const GAS f32x4* xp = (const GAS f32x4*)(XIO + row * DM + 16 * lane);
#pragma unroll
          for (int k = 0; k < 4; ++k) { const f32x4 x = xp[k]; o[4 * k] = x.x; o[4 * k + 1] = x.y; o[4 * k + 2] = x.z; o[4 * k + 3] = x.w; } }
#pragma unroll
        for (int hf = 0; hf < 2; ++hf) {
            const int iv = hf ? i1 : i0; const float cv = coef[hf];
#pragma unroll
            for (int c = 0; c < 4; ++c) {
                v4u va[16];
#pragma unroll
                for (int j = 0; j < 16; ++j) { const int ex = __builtin_amdgcn_readlane(iv, c * 16 + j); va[j] = *((const GAS v4u*)(EV8 + (size_t)ex * DM) + lane); }
#pragma unroll
                for (int j = 0; j < 16; ++j) { const float cf = __builtin_bit_cast(float, __builtin_amdgcn_readlane(__builtin_bit_cast(int, cv), c * 16 + j)); fma16_fp8(o, cf, va[j]); }
            }
        }
        float ss = 0.f;
#pragma unroll
        for (int k = 0; k < 16; ++k) ss += o[k] * o[k];
        const float r = 1.f / sqrtf(wave_sum(ss) * (1.f / DM) + RMS_EPS);
        { GAS f32x4* xp = (GAS f32x4*)(XIO + row * DM + 16 * lane);
#pragma unroll
          for (int k = 0; k < 4; ++k) xp[k] = (f32x4){o[4 * k], o[4 * k + 1], o[4 * k + 2], o[4 * k + 3]}; }
        v4u ha, hb;
        ha.x = cvtpk(o[0] * r, o[1] * r); ha.y = cvtpk(o[2] * r, o[3] * r); ha.z = cvtpk(o[4] * r, o[5] * r); ha.w = cvtpk(o[6] * r, o[7] * r);
        hb.x = cvtpk(o[8] * r, o[9] * r); hb.y = cvtpk(o[10] * r, o[11] * r); hb.z = cvtpk(o[12] * r, o[13] * r); hb.w = cvtpk(o[14] * r, o[15] * r);
        *(GAS v4u*)(XN + row * DM + 16 * lane) = ha; *(GAS v4u*)(XN + row * DM + 16 * lane + 8) = hb;
    }
}

#define BS_STAGE(K, J) do { const bool lower_ = (lane & (J)) == 0; \
    { const int p_ = __shfl_xor(k0, (J)); const bool asc_ = ((lane & (K)) == 0); const int mn_ = k0 < p_ ? k0 : p_, mx_ = k0 < p_ ? p_ : k0; k0 = (lower_ == asc_) ? mn_ : mx_; } \
    { const int p_ = __shfl_xor(k1, (J)); const bool asc_ = (((lane + 64) & (K)) == 0); const int mn_ = k1 < p_ ? k1 : p_, mx_ = k1 < p_ ? p_ : k1; k1 = (lower_ == asc_) ? mn_ : mx_; } } while (0)
#ifndef PEER_BSHIFT
#define PEER_BSHIFT 11
#endif
constexpr int PEER_NB = 16384 >> PEER_BSHIFT;
__device__ __forceinline__ void peer_sort_panel(int* IDXp, float* GTp, float* SUp, unsigned char* STp, const float* SU, const float* SV, const int wid0) {
    const int tid = otid(wid0), lane = tid & 63, wid = __builtin_amdgcn_readfirstlane(tid >> 6);
    int ni0 = IDXp[wid * 32 * 128 + lane], ni1 = IDXp[wid * 32 * 128 + 64 + lane];
    float ng0 = GTp[wid * 32 * 128 + lane], ng1 = GTp[wid * 32 * 128 + 64 + lane];
    for (int ti = 0; ti < 32; ++ti) {
        const int lrow = wid * 32 + ti;
        const int i0 = ni0, i1 = ni1; const float g0 = ng0, g1 = ng1;
        if (ti < 31) { ni0 = IDXp[(lrow + 1) * 128 + lane]; ni1 = IDXp[(lrow + 1) * 128 + 64 + lane]; ng0 = GTp[(lrow + 1) * 128 + lane]; ng1 = GTp[(lrow + 1) * 128 + 64 + lane]; }
        const float u0 = SU[i0], u1 = SU[i1], w0 = SV[i0] * g0, w1 = SV[i1] * g1;
        int k0 = (i0 << 7) | lane, k1 = (i1 << 7) | (64 + lane);
        BS_STAGE(2, 1);
        BS_STAGE(4, 2); BS_STAGE(4, 1);
        BS_STAGE(8, 4); BS_STAGE(8, 2); BS_STAGE(8, 1);
        BS_STAGE(16, 8); BS_STAGE(16, 4); BS_STAGE(16, 2); BS_STAGE(16, 1);
        BS_STAGE(32, 16); BS_STAGE(32, 8); BS_STAGE(32, 4); BS_STAGE(32, 2); BS_STAGE(32, 1);
        BS_STAGE(64, 32); BS_STAGE(64, 16); BS_STAGE(64, 8); BS_STAGE(64, 4); BS_STAGE(64, 2); BS_STAGE(64, 1);
        { const int mn_ = k0 < k1 ? k0 : k1, mx_ = k0 < k1 ? k1 : k0; k0 = mn_; k1 = mx_; }
        BS_STAGE(128, 32); BS_STAGE(128, 16); BS_STAGE(128, 8); BS_STAGE(128, 4); BS_STAGE(128, 2); BS_STAGE(128, 1);
        const int s0 = k0 & 127, s1 = k1 & 127, e0 = k0 >> 7, e1 = k1 >> 7;
        const float ua0 = __shfl(u0, s0 & 63), ub0 = __shfl(u1, s0 & 63), ua1 = __shfl(u0, s1 & 63), ub1 = __shfl(u1, s1 & 63);
        const float wa0 = __shfl(w0, s0 & 63), wb0 = __shfl(w1, s0 & 63), wa1 = __shfl(w0, s1 & 63), wb1 = __shfl(w1, s1 & 63);
        IDXp[lrow * 128 + lane] = e0; IDXp[lrow * 128 + 64 + lane] = e1;
        SUp[lrow * 128 + lane] = (s0 < 64) ? ua0 : ub0; SUp[lrow * 128 + 64 + lane] = (s1 < 64) ? ua1 : ub1;
        GTp[lrow * 128 + lane] = (s0 < 64) ? wa0 : wb0; GTp[lrow * 128 + 64 + lane] = (s1 < 64) ? wa1 : wb1;
        int stv = 0;
#pragma unroll
        for (int r = 1; r < PEER_NB; ++r) { const int c = __builtin_popcountll(__ballot(e0 < (r << PEER_BSHIFT))) + __builtin_popcountll(__ballot(e1 < (r << PEER_BSHIFT))); stv = (lane == r) ? c : stv; }
        stv = (lane == PEER_NB) ? 128 : stv;
        if (lane < 32) STp[lrow * 32 + lane] = (unsigned char)stv;
    }
}
__device__ __forceinline__ void peer_usweep_panel(int panel, const bf16* XN, const int* IDXp, const float* GMp, const float* SUp, float* CFp, const unsigned char* EU8, const int wid0) {
    const int tid = otid(wid0), lane = tid & 63, wid = __builtin_amdgcn_readfirstlane(tid >> 6);
    const int tq = (lane >> 3) & 1, pj = lane & 7;
    const size_t prow = (size_t)panel * 256;
    int ix_n; float gm_n, su_n; v4u hA0_n, hB0_n, hA1_n, hB1_n;
#define US_META(s_) do { const int c_ = (s_) >> 4, tp_ = (s_) & 15; const int lr_ = wid * 32 + 2 * tp_; const int off_ = (lr_ + tq) * 128 + 8 * c_ + pj; \
        ix_n = IDXp[off_]; gm_n = GMp[off_]; su_n = SUp[off_]; \
        const bf16* h0_ = XN + (prow + lr_) * DM + 16 * lane; hA0_n = *(const GAS v4u*)h0_; hB0_n = *(const GAS v4u*)(h0_ + 8); hA1_n = *(const GAS v4u*)(h0_ + DM); hB1_n = *(const GAS v4u*)(h0_ + DM + 8); } while (0)
    US_META(0);
    for (int s = 0; s < 256; ++s) {
        const int ix = ix_n; const float gm = gm_n, su = su_n; const v4u hA0 = hA0_n, hB0 = hB0_n, hA1 = hA1_n, hB1 = hB1_n;
        v4u ua[16];
#pragma unroll
        for (int j = 0; j < 16; ++j) { const int ex = __builtin_amdgcn_readlane(ix, j); ua[j] = *((const GAS v4u*)(EU8 + (size_t)ex * DM) + lane); }
        if (s < 255) US_META(s + 1);
        float h[16], p[16];
        h[0] = bflo(hA0.x); h[1] = bfhi(hA0.x); h[2] = bflo(hA0.y); h[3] = bfhi(hA0.y); h[4] = bflo(hA0.z); h[5] = bfhi(hA0.z); h[6] = bflo(hA0.w); h[7] = bfhi(hA0.w);
        h[8] = bflo(hB0.x); h[9] = bfhi(hB0.x); h[10] = bflo(hB0.y); h[11] = bfhi(hB0.y); h[12] = bflo(hB0.z); h[13] = bfhi(hB0.z); h[14] = bflo(hB0.w); h[15] = bfhi(hB0.w);
#pragma unroll
        for (int j = 0; j < 8; ++j) p[j] = dot16_fp8(ua[j], h);
        h[0] = bflo(hA1.x); h[1] = bfhi(hA1.x); h[2] = bflo(hA1.y); h[3] = bfhi(hA1.y); h[4] = bflo(hA1.z); h[5] = bfhi(hA1.z); h[6] = bflo(hA1.w); h[7] = bfhi(hA1.w);
        h[8] = bflo(hB1.x); h[9] = bfhi(hB1.x); h[10] = bflo(hB1.y); h[11] = bfhi(hB1.y); h[12] = bflo(hB1.z); h[13] = bfhi(hB1.z); h[14] = bflo(hB1.w); h[15] = bfhi(hB1.w);
#pragma unroll
        for (int j = 8; j < 16; ++j) p[j] = dot16_fp8(ua[j], h);
        RS_LEVEL(p, 8, 8); RS_LEVEL(p, 4, 4); RS_LEVEL(p, 2, 2); RS_LEVEL(p, 1, 1);
        float d = p[0]; d += __shfl_xor(d, 16); d += __shfl_xor(d, 32);
        const float sx = d * su;
        const float act = 0.5f * sx * (1.0f + erff(sx * 0.70710678118654752f));
        const int c = s >> 4, tp = s & 15;
        if (lane < 16) CFp[(wid * 32 + 2 * tp + tq) * 128 + 8 * c + pj] = gm * act;
    }
#undef US_META
}
__device__ __forceinline__ void peer_v_panel(int panel, bf16* XN, const int* IDXp, const float* CFp, const unsigned char* EV8, float* XIO, const int wid0) {
    const int tid = otid(wid0), lane = tid & 63, wid = __builtin_amdgcn_readfirstlane(tid >> 6);
    for (int ti = 0; ti < 32; ++ti) {
        const int lrow = wid * 32 + ti;
        const size_t row = (size_t)panel * 256 + lrow;
        const int i0 = IDXp[lrow * 128 + lane], i1 = IDXp[lrow * 128 + 64 + lane];
        const float c0 = CFp[lrow * 128 + lane], c1 = CFp[lrow * 128 + 64 + lane];
        float o[16];
        { const GAS f32x4* xp = (const GAS f32x4*)(XIO + row * DM + 16 * lane);
#pragma unroll
          for (int k = 0; k < 4; ++k) { const f32x4 x = xp[k]; o[4 * k] = x.x; o[4 * k + 1] = x.y; o[4 * k + 2] = x.z; o[4 * k + 3] = x.w; } }
#pragma unroll
        for (int hf = 0; hf < 2; ++hf) {
            const int iv = hf ? i1 : i0; const float cv = hf ? c1 : c0;
#pragma nounroll
            for (int c = 0; c < 4; ++c) {
                v4u va[16];
#pragma unroll
                for (int j = 0; j < 16; ++j) { const int ex = __builtin_amdgcn_readlane(iv, c * 16 + j); va[j] = *((const GAS v4u*)(EV8 + (size_t)ex * DM) + lane); }
#pragma unroll
                for (int j = 0; j < 16; ++j) { const float cf = __builtin_bit_cast(float, __builtin_amdgcn_readlane(__builtin_bit_cast(int, cv), c * 16 + j)); fma16_fp8(o, cf, va[j]); }
            }
        }
        float ss = 0.f;
#pragma unroll
        for (int k = 0; k < 16; ++k) ss += o[k] * o[k];
        const float r = 1.f / sqrtf(wave_sum(ss) * (1.f / DM) + RMS_EPS);
        { GAS f32x4* xp = (GAS f32x4*)(XIO + row * DM + 16 * lane);
#pragma unroll
          for (int k = 0; k < 4; ++k) xp[k] = (f32x4){o[4 * k], o[4 * k + 1], o[4 * k + 2], o[4 * k + 3]}; }
        v4u ha, hb;
        ha.x = cvtpk(o[0] * r, o[1] * r); ha.y = cvtpk(o[2] * r, o[3] * r); ha.z = cvtpk(o[4] * r, o[5] * r); ha.w = cvtpk(o[6] * r, o[7] * r);
        hb.x = cvtpk(o[8] * r, o[9] * r); hb.y = cvtpk(o[10] * r, o[11] * r); hb.z = cvtpk(o[12] * r, o[13] * r); hb.w = cvtpk(o[14] * r, o[15] * r);
        *(GAS v4u*)(XN + row * DM + 16 * lane) = ha; *(GAS v4u*)(XN + row * DM + 16 * lane + 8) = hb;
    }
}


struct Args {
    const float *x, *p, *norm_mix, *w_in, *w_att_up, *w_pool_group, *pool_scale, *w_out, *norm_ffn, *w_query, *sub_keys, *expert_u, *expert_v, *norm_ple, *w_ple_gate, *w_ple, *norm_final;
    float* out; unsigned char* ws; int ph_hi, pad;
};

#ifndef REP_P0
#define REP_P0 1
#endif
#ifndef REP_P1
#define REP_P1 1
#endif
#ifndef REP_P23
#define REP_P23 1
#endif
#ifndef REP_P4
#define REP_P4 1
#endif
#ifndef REP_P567
#define REP_P567 1
#endif
#ifndef REP_P9
#define REP_P9 1
#endif
#ifndef REP_ATT
#define REP_ATT 1
#endif
#ifndef REP_TOPK
#define REP_TOPK 1
#endif
#ifndef REP_MRG
#define REP_MRG 1
#endif
#ifndef MK_PH_HI
#define MK_PH_HI 99
#endif

typedef const __attribute__((address_space(4))) Args* CArgs;
__device__ __forceinline__ CArgs kargs() { CArgs p = (CArgs)__builtin_amdgcn_kernarg_segment_ptr(); asm volatile("" : "+s"(p)); return p; }
#define WSP(T, off) ((T*)(kargs()->ws + (off)))
__global__ void __launch_bounds__(NTHR, 2) mega_fwd(Args a_unused) {
    extern __shared__ __attribute__((aligned(16))) unsigned char lds_raw[];
    LAS unsigned char* lds = (LAS unsigned char*)lds_raw;
    volatile LAS unsigned* MISC = (volatile LAS unsigned*)(lds + MISC_OFF);
    const int G = gridDim.x; const int bx = blockIdx.x;
    const int vcu = (G % 8 == 0) ? (bx % 8) * (G / 8) + bx / 8 : bx;
    gu32* ctl = (gu32*)(kargs()->ws + WS_CTL);
    const int wid0 = __builtin_amdgcn_readfirstlane((int)threadIdx.x >> 6);
#define IS_T0 (otid(wid0) == 0)
    for (int u = otid(wid0); u < (LDS_BYTES - LDSCTL_OFF) / 4; u += NTHR) ((LAS unsigned*)(lds + LDSCTL_OFF))[u] = 0u;
    __syncthreads();
    (void)xcd_barrier_post((unsigned*)(ctl + CW_BAR), MISC + 8, IS_T0);
#define GRID_BAR() do { XcdBarrier _b; _b.bar = (unsigned*)((gu32*)(kargs()->ws + WS_CTL) + CW_BAR); _b.x = xb_xcc_id(); _b.st = (volatile LAS unsigned*)(lds + MISC_OFF) + 8; xcd_barrier(_b, IS_T0); } while (0)
#define LOCAL_SEAM() do { VM_WAIT(); __syncthreads(); if (IS_T0) { __builtin_amdgcn_fence(__ATOMIC_ACQUIRE, "agent"); VM_WAIT(); } __syncthreads(); } while (0)

    for (int rep_ = 0; rep_ < REP_P0; ++rep_) {
        const int tid = otid(wid0), lane = tid & 63, wid = __builtin_amdgcn_readfirstlane(tid >> 6);
        const CArgs a = kargs(); unsigned char* ws = a->ws;
        bf16 *WIN = (bf16*)(ws + WS_WIN), *WOUT = (bf16*)(ws + WS_WOUT), *WQ = (bf16*)(ws + WS_WQ), *WPG = (bf16*)(ws + WS_WPG), *WPLE = (bf16*)(ws + WS_WPLE);
        bf16 *BDA = (bf16*)(ws + WS_BDA), *BDP = (bf16*)(ws + WS_BDP), *SK = (bf16*)(ws + WS_SK), *XN = (bf16*)(ws + WS_XN);
        LAS float* scr = (LAS float*)(lds + wid * 16384);
        const int gw = vcu * NWAVES + wid, NGW = G * NWAVES;
        constexpr int I_IN = (1024 / 64) * (4096 / 32), I_OUT = (1024 / 64) * (1024 / 32), I_Q = (1024 / 64) * (2048 / 32), I_PG = I_OUT, I_PLE = (256 / 64) * (1024 / 32);
        constexpr int NITEMS = I_IN + I_OUT + I_Q + I_PG + I_PLE;
        for (int it = gw; it < NITEMS; it += NGW) {
            int r = it;
            if (r < I_IN) { p0_transpose_item(a->w_in, 1024, 4096, WIN, a->norm_mix, 512, C2, scr, r, lane); continue; } r -= I_IN;
            if (r < I_OUT) { p0_transpose_item(a->w_out, 1024, 1024, WOUT, nullptr, 0, 1.f, scr, r, lane); continue; } r -= I_OUT;
            if (r < I_Q) { p0_transpose_item(a->w_query, 1024, 2048, WQ, a->norm_ffn, 0, 1.f, scr, r, lane); continue; } r -= I_Q;
            if (r < I_PG) { p0_transpose_item(a->w_ple_gate, 1024, 1024, WPG, a->norm_ple, 0, 1.f, scr, r, lane); continue; } r -= I_PG;
            p0_transpose_item(a->w_ple, 256, 1024, WPLE, nullptr, 0, 1.f, scr, r, lane);
        }
        const int gt = vcu * NTHR + tid, NGT = G * NTHR;
        for (int it = gt; it < 1024 * 16; it += NGT) {
            const int n = it >> 4, k8 = (it & 15) * 8, head = n >> 7, g = n >> 8;
            float va[8], vp[8]; const float ps = a->pool_scale[n];
#pragma unroll
            for (int j = 0; j < 8; ++j) {
                const int k = k8 + j;
                va[j] = ((k >> 6) == (head & 1)) ? a->w_att_up[((size_t)head * 64 + (k & 63)) * 128 + (n & 127)] : 0.f;
                vp[j] = a->w_pool_group[((size_t)g * 128 + k) * 256 + (n & 255)] * ps;
            }
            v4u o; o.x = pk2(va[0], va[1]); o.y = pk2(va[2], va[3]); o.z = pk2(va[4], va[5]); o.w = pk2(va[6], va[7]);
            *(GAS v4u*)(BDA + (size_t)n * 128 + k8) = o;
            o.x = pk2(vp[0], vp[1]); o.y = pk2(vp[2], vp[3]); o.z = pk2(vp[4], vp[5]); o.w = pk2(vp[6], vp[7]);
            *(GAS v4u*)(BDP + (size_t)n * 128 + k8) = o;
        }
        for (int it = gt; it < 16 * 128 * 128 / 8; it += NGT) cvt8_store(a->sub_keys + (size_t)it * 8, SK + (size_t)it * 8);
        for (int rr = gw; rr < 2 * 16384; rr += NGW) { const int e = rr >> 1;
            if (rr & 1) quant_row_fp8(a->expert_v + (size_t)e * DM, ws + WS_EV + (size_t)e * DM, (float*)(ws + WS_SV) + e, lane);
            else quant_row_fp8(a->expert_u + (size_t)e * DM, ws + WS_EU + (size_t)e * DM, (float*)(ws + WS_SU) + e, lane); }
        { const int panel = bx;
            for (int r = wid; r < 256; r += NWAVES) { const size_t row = (size_t)panel * 256 + r; rms_row_to_bf16(a->x + row * DM, XN + row * DM, lane); } }
    }
    GRID_BAR();

    for (int rep_ = 0; rep_ < REP_P1; ++rep_) {
        { const int panel = bx;
            { pg8::Gemm g{WSP(bf16, WS_XN), WSP(bf16, WS_WIN), 1024, 1024, 1024, 0}; pg8::PanelSched S{panel, 14, 4, 2, 0}; pg8::EpiProj E{WSP(bf16, WS_PQ), WSP(bf16, WS_PK), WSP(bf16, WS_PU), WSP(bf16, WS_PG)};
              pg8::gemm_phase<pg8::EpiProj, pg8::PanelSched, true, true>(lds, g, S, E, wid0); }
            { pg8::Gemm g{WSP(bf16, WS_WIN) + (size_t)1024 * 1024, WSP(bf16, WS_XN), 1024, 1024, 1024, 0}; pg8::PanelSched S{panel, 2, 99, 0, 1}; pg8::EpiPlain E{WSP(bf16, WS_PVT), TOK};
              pg8::gemm_phase<pg8::EpiPlain, pg8::PanelSched, true, true>(lds, g, S, E, wid0); }
        }
    }
    GRID_BAR();

    { const int panel = bx;
        const size_t prow = (size_t)panel * 256;
        for (int rep_ = 0; rep_ < REP_P23; ++rep_) {
        if (MK_PH_HI > 2) { for (int r2_ = 0; r2_ < REP_ATT; ++r2_) attn_panel(panel, WSP(bf16, WS_PQ), WSP(bf16, WS_PK), WSP(bf16, WS_PVT), WSP(bf16, WS_YA), wid0); pool_panel(panel, WSP(bf16, WS_PU), WSP(bf16, WS_YP), wid0); LOCAL_SEAM(); }
        for (int r2_ = 0; r2_ < REP_MRG; ++r2_)
        if (MK_PH_HI > 3) {
            { pg8::Gemm g{WSP(bf16, WS_YA), WSP(bf16, WS_BDA), 128, 512, 128, 128}; pg8::PanelSched S{panel, 4, 99, 0, 0}; pg8::EpiMerge<false> E{WSP(bf16, WS_PG), WSP(bf16, WS_MG), 0};
              pg8::gemm_phase<pg8::EpiMerge<false>, pg8::PanelSched, true, true>(lds, g, S, E, wid0); }
            { pg8::Gemm g{WSP(bf16, WS_YP), WSP(bf16, WS_BDP), 128, 512, 128, 128}; pg8::PanelSched S{panel, 4, 99, 0, 0}; pg8::EpiMerge<true> E{WSP(bf16, WS_PG), WSP(bf16, WS_MG), 1024};
              pg8::gemm_phase<pg8::EpiMerge<true>, pg8::PanelSched, true, true>(lds, g, S, E, wid0); }
            LOCAL_SEAM();
        }
        }
        for (int rep_ = 0; rep_ < REP_P4; ++rep_)
        if (MK_PH_HI > 4) {
            { pg8::Gemm g{WSP(bf16, WS_MG), WSP(bf16, WS_WOUT), 1024, 1024, 1024, 0}; pg8::PanelSched S{panel, 4, 99, 0, 0}; pg8::EpiRes E{kargs()->x, kargs()->out};
              pg8::gemm_phase<pg8::EpiRes, pg8::PanelSched, true, true>(lds, g, S, E, wid0); }
            LOCAL_SEAM();
        }
        for (int rep_ = 0; rep_ < REP_P567; ++rep_) {
        if (MK_PH_HI > 5) {
            { const int tid = otid(wid0), lane = tid & 63, wid = __builtin_amdgcn_readfirstlane(tid >> 6); const float* xo = kargs()->out; bf16* XN = WSP(bf16, WS_XN); for (int r = wid; r < 256; r += NWAVES) rms_row_to_bf16(xo + (prow + r) * DM, XN + (prow + r) * DM, lane); }
            LOCAL_SEAM();
        }
        if (MK_PH_HI > 6) {
            { pg8::Gemm g{WSP(bf16, WS_XN), WSP(bf16, WS_WQ), 1024, 1024, 1024, 0}; pg8::PanelSched S{panel, 8, 99, 0, 0}; pg8::EpiPlain E{WSP(bf16, WS_PG), 2048};
              pg8::gemm_phase<pg8::EpiPlain, pg8::PanelSched, true, true>(lds, g, S, E, wid0); }
            LOCAL_SEAM();
        }
        #define IDXP ((int*)(kargs()->ws + WS_YA + (size_t)panel * 262144))
#define GTP ((float*)(kargs()->ws + WS_YA + (size_t)panel * 262144 + 131072))
        if (MK_PH_HI > 7) { for (int r2_ = 0; r2_ < REP_TOPK; ++r2_) topk_panel(panel, WSP(bf16, WS_PG), WSP(bf16, WS_SK), IDXP, GTP, (LAS int*)lds, wid0); LOCAL_SEAM(); }
        }
#ifndef PEER_SWEEP
#define PEER_SWEEP 1
#endif
#define STP ((unsigned char*)(kargs()->ws + WS_YP + (size_t)panel * 262144))
#define CFP ((float*)(kargs()->ws + WS_YP + (size_t)panel * 262144 + 131072))
#define SUSP ((float*)(kargs()->ws + WS_MG + (size_t)panel * 524288))
        if (MK_PH_HI > 8) {
            if (PEER_SWEEP) {
                peer_sort_panel(IDXP, GTP, SUSP, STP, WSP(float, WS_SU), WSP(float, WS_SV), wid0); LOCAL_SEAM();
                peer_usweep_panel(panel, WSP(bf16, WS_XN), IDXP, GTP, SUSP, CFP, WSP(unsigned char, WS_EU), wid0); LOCAL_SEAM();
                peer_v_panel(panel, WSP(bf16, WS_XN), IDXP, CFP, WSP(unsigned char, WS_EV), kargs()->out, wid0); LOCAL_SEAM();
            } else { peer_panel(panel, WSP(bf16, WS_XN), IDXP, GTP, WSP(unsigned char, WS_EU), WSP(unsigned char, WS_EV), WSP(float, WS_SU), WSP(float, WS_SV), kargs()->out, wid0); LOCAL_SEAM(); }
        }
        for (int rep_ = 0; rep_ < REP_P9; ++rep_)
        if (MK_PH_HI > 9) {
            { const int tid = otid(wid0); const float* pp = kargs()->p; bf16* YP = WSP(bf16, WS_YP); for (int it = tid; it < 256 * 256 / 8; it += NTHR) { const int r = it >> 5, c8 = (it & 31) * 8; cvt8_store(pp + (prow + r) * 256 + c8, YP + (prow + r) * 512 + c8); } }
            LOCAL_SEAM();
            { pg8::Gemm g{WSP(bf16, WS_YP), WSP(bf16, WS_WPLE), 256, 512, 256, 0}; pg8::PanelSched S{panel, 4, 99, 0, 0}; pg8::EpiPlain E{WSP(bf16, WS_MG), 1024};
              pg8::gemm_phase<pg8::EpiPlain, pg8::PanelSched, true, true>(lds, g, S, E, wid0); }
            LOCAL_SEAM();
        }
        if (MK_PH_HI > 10) {
            { pg8::Gemm g{WSP(bf16, WS_XN), WSP(bf16, WS_WPG), 1024, 1024, 1024, 0}; pg8::PanelSched S{panel, 4, 99, 0, 0}; pg8::EpiGate E{kargs()->out, WSP(bf16, WS_MG)};
              pg8::gemm_phase<pg8::EpiGate, pg8::PanelSched, true, true>(lds, g, S, E, wid0); }
            LOCAL_SEAM();
        }
        if (MK_PH_HI > 11) {
            const int tid = otid(wid0), lane = tid & 63, wid = __builtin_amdgcn_readfirstlane(tid >> 6);
            for (int r = wid; r < 256; r += NWAVES) {
                GAS f32x4* xr = (GAS f32x4*)(kargs()->out + (prow + r) * DM) + lane; const GAS f32x4* gr = (const GAS f32x4*)kargs()->norm_final + lane;
                f32x4 v[4]; float s = 0.f;
#pragma unroll
                for (int j = 0; j < 4; ++j) { v[j] = xr[64 * j]; s += (v[j].x * v[j].x + v[j].y * v[j].y) + (v[j].z * v[j].z + v[j].w * v[j].w); }
                const float rr = 1.f / sqrtf(wave_sum(s) * (1.f / DM) + RMS_EPS);
#pragma unroll
                for (int j = 0; j < 4; ++j) xr[64 * j] = v[j] * rr * gr[64 * j];
            }
        }
    }
#undef LOCAL_SEAM
}


#if MK_PH_HI < 99
namespace ref {
constexpr int D = 1024, NB = 8, S = 8192, T = NB * S;
constexpr int INW = 4096;
constexpr int NKEYS = 128, TOPK = 16, PH = 8;
constexpr float EPS = 1e-6f;

__device__ __forceinline__ float wave_sum(float v) {
#pragma unroll
    for (int o = 32; o > 0; o >>= 1) v += __shfl_xor(v, o);
    return v;
}
__device__ __forceinline__ float sigmoidf_(float x) { return 1.f / (1.f + expf(-x)); }

__global__ void __launch_bounds__(256) k_rms(const float* x, const float* g, float* out) {
    __shared__ float red[4];
    const size_t row = blockIdx.x;
    const float4 v = ((const float4*)(x + row * D))[threadIdx.x];
    float s = v.x * v.x + v.y * v.y + v.z * v.z + v.w * v.w;
    s = wave_sum(s);
    if ((threadIdx.x & 63) == 0) red[threadIdx.x >> 6] = s;
    __syncthreads();
    const float tot = red[0] + red[1] + red[2] + red[3];
    const float r = rsqrtf(tot * (1.f / D) + EPS);
    const float4 gg = ((const float4*)g)[threadIdx.x];
    float4 o; o.x = v.x * r * gg.x; o.y = v.y * r * gg.y; o.z = v.z * r * gg.z; o.w = v.w * r * gg.w;
    ((float4*)(out + row * D))[threadIdx.x] = o;
}

struct EpiStore { float* C; int ldc; int pad; __device__ void operator()(int r, int c, float v) const { C[(size_t)r * ldc + c] = v; } };
struct EpiResAdd { const float* R; float* C; int ldc; int pad; __device__ void operator()(int r, int c, float v) const { C[(size_t)r * ldc + c] = R[(size_t)r * ldc + c] + v; } };
struct EpiGate { const float* X; const float* E; float* C; int ldc; int pad;
    __device__ void operator()(int r, int c, float v) const { const size_t o = (size_t)r * ldc + c; C[o] = X[o] + sigmoidf_(v) * E[o]; } };

template <class Epi>
__global__ void __launch_bounds__(256) k_gemm(const float* __restrict__ A, const float* __restrict__ Bm, Epi epi, int lda, int ldb, int K, int pad_) {
    __shared__ float As[8][128 + 4];
    __shared__ float Bs[8][128 + 4];
    const int tid = threadIdx.x, tx = tid & 15, ty = tid >> 4;
    const int m0 = blockIdx.y * 128, n0 = blockIdx.x * 128;
    float acc[8][8];
#pragma unroll
    for (int i = 0; i < 8; ++i)
#pragma unroll
        for (int j = 0; j < 8; ++j) acc[i][j] = 0.f;
    const int ar = tid >> 1, ak = (tid & 1) * 4;
    const int bk = tid >> 5, bn = (tid & 31) * 4;
    for (int k0 = 0; k0 < K; k0 += 8) {
        const float4 av = *(const float4*)(A + (size_t)(m0 + ar) * lda + k0 + ak);
        const float4 bv = *(const float4*)(Bm + (size_t)(k0 + bk) * ldb + n0 + bn);
        As[ak + 0][ar] = av.x; As[ak + 1][ar] = av.y; As[ak + 2][ar] = av.z; As[ak + 3][ar] = av.w;
        *(float4*)&Bs[bk][bn] = bv;
        __syncthreads();
#pragma unroll
        for (int k = 0; k < 8; ++k) {
            const float4 a0 = *(const float4*)&As[k][ty * 8], a1 = *(const float4*)&As[k][ty * 8 + 4];
            const float4 b0 = *(const float4*)&Bs[k][tx * 8], b1 = *(const float4*)&Bs[k][tx * 8 + 4];
            const float a[8] = {a0.x, a0.y, a0.z, a0.w, a1.x, a1.y, a1.z, a1.w};
            const float b[8] = {b0.x, b0.y, b0.z, b0.w, b1.x, b1.y, b1.z, b1.w};
#pragma unroll
            for (int i = 0; i < 8; ++i)
#pragma unroll
                for (int j = 0; j < 8; ++j) acc[i][j] = fmaf(a[i], b[j], acc[i][j]);
        }
        __syncthreads();
    }
#pragma unroll
    for (int i = 0; i < 8; ++i)
#pragma unroll
        for (int j = 0; j < 8; ++j) epi(m0 + ty * 8 + i, n0 + tx * 8 + j, acc[i][j]);
}

__global__ void __launch_bounds__(64) k_attn(const float* __restrict__ proj, float* __restrict__ yatt) {
    const int t = blockIdx.x * 64 + threadIdx.x;
    const int h = blockIdx.y;
    float q[64], acc[64];
    const float* qp = proj + (size_t)t * INW + h * 64;
#pragma unroll
    for (int d = 0; d < 64; ++d) { q[d] = qp[d] * 0.125f; acc[d] = 0.f; }
    float surv = 1.f;
    for (int s = t - 1; s >= 0; --s) {
        const float* kp = proj + (size_t)s * INW + 512 + h * 64;
        float z = 0.f;
#pragma unroll
        for (int d = 0; d < 64; ++d) z = fmaf(q[d], kp[d], z);
        const float beta = 1.f / (1.f + expf(-z));
        const float w = beta * surv;
        const float* vp = kp + 512;
#pragma unroll
        for (int d = 0; d < 64; ++d) acc[d] = fmaf(w, vp[d], acc[d]);
        surv -= w;
        if (surv < 5.4e-20f) break;
    }
    float* o = yatt + (size_t)t * 512 + h * 64;
#pragma unroll
    for (int d = 0; d < 64; ++d) o[d] = acc[d];
}

__global__ void __launch_bounds__(256) k_pool(const float* __restrict__ proj, float* __restrict__ ypool) {
    const int i = blockIdx.x * 256 + threadIdx.x;
    const int t = i >> 9, c = i & 511, g = c >> 7, w = 2 << g;
    const int cnt = (t + 1 < w) ? (t + 1) : w;
    float s = 0.f;
    for (int j = 0; j < cnt; ++j) s += proj[(size_t)(t - j) * INW + 1536 + c];
    ypool[i] = s / (float)cnt - proj[(size_t)t * INW + 1536 + c];
}

__global__ void __launch_bounds__(256) k_merge(const float* __restrict__ proj, const float* __restrict__ yatt, const float* __restrict__ ypool,
                                               const float* __restrict__ wa, const float* __restrict__ wp, const float* __restrict__ pscale, float* __restrict__ merged) {
    const int t = blockIdx.x, tid = threadIdx.x;
    __shared__ float sa[512], sp[512];
    sa[tid] = yatt[(size_t)t * 512 + tid]; sa[tid + 256] = yatt[(size_t)t * 512 + tid + 256];
    sp[tid] = ypool[(size_t)t * 512 + tid]; sp[tid + 256] = ypool[(size_t)t * 512 + tid + 256];
    __syncthreads();
    for (int e = tid; e < D; e += 256) {
        const int h = e >> 7, ea = e & 127, g = e >> 8, ep = e & 255;
        float a = 0.f, p = 0.f;
        for (int d = 0; d < 64; ++d) a = fmaf(sa[h * 64 + d], wa[((size_t)h * 64 + d) * 128 + ea], a);
        for (int c = 0; c < 128; ++c) p = fmaf(sp[g * 128 + c], wp[((size_t)g * 128 + c) * 256 + ep], p);
        p *= pscale[e];
        const float ga = proj[(size_t)t * INW + 2048 + e], gp = proj[(size_t)t * INW + 3072 + e];
        merged[(size_t)t * D + e] = sigmoidf_(ga) * a + sigmoidf_(gp) * p;
    }
}

__global__ void __launch_bounds__(256) k_scores(const float* __restrict__ qp, const float* __restrict__ sk, float* __restrict__ sc) {
    const int t0 = blockIdx.x * 4, tid = threadIdx.x;
    __shared__ float sq[4][2048];
    for (int i = tid; i < 4 * 2048; i += 256) sq[i >> 11][i & 2047] = qp[(size_t)t0 * 2048 + i];
    __syncthreads();
    for (int j = tid; j < 2048; j += 256) {
        const int g = j >> 7;
        const float4* kr = (const float4*)(sk + (size_t)j * 128);
        float a0 = 0.f, a1 = 0.f, a2 = 0.f, a3 = 0.f;
        for (int d = 0; d < 32; ++d) {
            const float4 kv = kr[d];
            const float4 q0 = *(const float4*)&sq[0][g * 128 + d * 4], q1 = *(const float4*)&sq[1][g * 128 + d * 4];
            const float4 q2 = *(const float4*)&sq[2][g * 128 + d * 4], q3 = *(const float4*)&sq[3][g * 128 + d * 4];
            a0 = fmaf(q0.x, kv.x, a0); a0 = fmaf(q0.y, kv.y, a0); a0 = fmaf(q0.z, kv.z, a0); a0 = fmaf(q0.w, kv.w, a0);
            a1 = fmaf(q1.x, kv.x, a1); a1 = fmaf(q1.y, kv.y, a1); a1 = fmaf(q1.z, kv.z, a1); a1 = fmaf(q1.w, kv.w, a1);
            a2 = fmaf(q2.x, kv.x, a2); a2 = fmaf(q2.y, kv.y, a2); a2 = fmaf(q2.z, kv.z, a2); a2 = fmaf(q2.w, kv.w, a2);
            a3 = fmaf(q3.x, kv.x, a3); a3 = fmaf(q3.y, kv.y, a3); a3 = fmaf(q3.z, kv.z, a3); a3 = fmaf(q3.w, kv.w, a3);
        }
        sc[(size_t)(t0 + 0) * 2048 + j] = a0; sc[(size_t)(t0 + 1) * 2048 + j] = a1;
        sc[(size_t)(t0 + 2) * 2048 + j] = a2; sc[(size_t)(t0 + 3) * 2048 + j] = a3;
    }
}

__device__ __forceinline__ void wave_argmax(float& v, int& i) {
#pragma unroll
    for (int o = 32; o > 0; o >>= 1) {
        const float ov = __shfl_xor(v, o); const int oi = __shfl_xor(i, o);
        if (ov > v || (ov == v && oi < i)) { v = ov; i = oi; }
    }
}

__global__ void __launch_bounds__(256) k_topk(const float* __restrict__ sc, int* __restrict__ idx, float* __restrict__ gates) {
    const int wv = threadIdx.x >> 6, lane = threadIdx.x & 63;
    const int pair = blockIdx.x * 4 + wv;
    const int t = pair >> 3, h = pair & 7;
    __shared__ float stop[4][2][16];
    __shared__ int itop[4][2][16];
    for (int c = 0; c < 2; ++c) {
        const float* sr = sc + (size_t)t * 2048 + (h * 2 + c) * 128;
        float v0 = sr[lane], v1 = sr[lane + 64];
        for (int k = 0; k < TOPK; ++k) {
            float bv; int bi;
            if (v1 > v0) { bv = v1; bi = lane + 64; } else { bv = v0; bi = lane; }
            wave_argmax(bv, bi);
            if (lane == 0) { stop[wv][c][k] = bv; itop[wv][c][k] = bi; }
            if (bi == lane) v0 = -INFINITY;
            if (bi == lane + 64) v1 = -INFINITY;
        }
    }
    __syncthreads();
    float cv[4];
#pragma unroll
    for (int j = 0; j < 4; ++j) { const int p = lane + 64 * j; cv[j] = stop[wv][0][p >> 4] + stop[wv][1][p & 15]; }
    __shared__ float sbs[4][16];
    __shared__ int sbp[4][16];
    for (int k = 0; k < TOPK; ++k) {
        float bv = cv[0]; int bi = lane;
#pragma unroll
        for (int j = 1; j < 4; ++j) if (cv[j] > bv) { bv = cv[j]; bi = lane + 64 * j; }
        wave_argmax(bv, bi);
        if (lane == 0) { sbs[wv][k] = bv; sbp[wv][k] = bi; }
#pragma unroll
        for (int j = 0; j < 4; ++j) if (bi == lane + 64 * j) cv[j] = -INFINITY;
    }
    __syncthreads();
    const float mx = sbs[wv][0];
    const float myv = (lane < TOPK) ? sbs[wv][lane] : -INFINITY;
    const float ex = (lane < TOPK) ? expf(myv - mx) : 0.f;
    const float den = wave_sum(ex);
    if (lane < TOPK) {
        const int myp = sbp[wv][lane];
        const int e = itop[wv][0][myp >> 4] * NKEYS + itop[wv][1][myp & 15];
        idx[(size_t)t * 128 + h * 16 + lane] = e;
        gates[(size_t)t * 128 + h * 16 + lane] = ex / den;
    }
}

__global__ void __launch_bounds__(256) k_peer(const float* __restrict__ hn, const int* __restrict__ idx, const float* __restrict__ gates,
                                              const float* __restrict__ eu, const float* __restrict__ ev, float* xio) {
    const int t = blockIdx.x, tid = threadIdx.x, wv = tid >> 6, lane = tid & 63;
    __shared__ float coef[128];
    __shared__ int sidx[128];
    const float4* hr = (const float4*)(hn + (size_t)t * D);
    float4 hv[4];
#pragma unroll
    for (int j = 0; j < 4; ++j) hv[j] = hr[lane + 64 * j];
    if (tid < 128) sidx[tid] = idx[(size_t)t * 128 + tid];
    __syncthreads();
    for (int p = wv; p < 128; p += 4) {
        const float4* ur = (const float4*)(eu + (size_t)sidx[p] * D);
        float s = 0.f;
#pragma unroll
        for (int j = 0; j < 4; ++j) { const float4 u = ur[lane + 64 * j]; s += u.x * hv[j].x + u.y * hv[j].y + u.z * hv[j].z + u.w * hv[j].w; }
        s = wave_sum(s);
        const float act = 0.5f * s * (1.f + erff(s * 0.70710678118654752f));
        if (lane == 0) coef[p] = gates[(size_t)t * 128 + p] * act;
    }
    __syncthreads();
    float4 o = ((const float4*)(xio + (size_t)t * D))[tid];
    for (int p = 0; p < 128; ++p) {
        const float c = coef[p];
        const float4 v = ((const float4*)(ev + (size_t)sidx[p] * D))[tid];
        o.x = fmaf(c, v.x, o.x); o.y = fmaf(c, v.y, o.y); o.z = fmaf(c, v.z, o.z); o.w = fmaf(c, v.w, o.w);
    }
    ((float4*)(xio + (size_t)t * D))[tid] = o;
}

__global__ void __launch_bounds__(256) k_bf16_to_f32(const unsigned short* __restrict__ src, float* __restrict__ dst) {
    const size_t i = (size_t)blockIdx.x * 256 + threadIdx.x; dst[i] = __uint_as_float((unsigned)src[i] << 16);
}
__global__ void __launch_bounds__(128) k_gather_idx(const unsigned char* __restrict__ ya, int row0, int* __restrict__ idx, float* __restrict__ gates) {
    const int r = blockIdx.x, grow = row0 + r, panel = grow >> 8, lrow = grow & 255;
    const int* ip = (const int*)(ya + (size_t)panel * 262144); const float* gp = (const float*)(ya + (size_t)panel * 262144 + 131072);
    idx[(size_t)r * 128 + threadIdx.x] = ip[lrow * 128 + threadIdx.x]; gates[(size_t)r * 128 + threadIdx.x] = gp[lrow * 128 + threadIdx.x];
}
}
#endif

extern "C" void kernel_launch(void* const* d_in, const int* in_sizes, int n_in, void* d_out, int out_size, void* d_ws, size_t ws_size, hipStream_t stream) {
    static int grid = 0;
    if (grid == 0) {
        if (n_in != 17 || in_sizes[0] != TOK * DM || out_size != TOK * DM || ws_size < WS_END) { fprintf(stderr, "kernel_launch: unexpected shapes (n_in %d, in0 %d, out %d, ws %zu); nothing launched\n", n_in, n_in > 0 ? in_sizes[0] : -1, out_size, ws_size); grid = -1; return; }
        int dev = 0, cus = 0;
        if (hipGetDevice(&dev) != hipSuccess || hipDeviceGetAttribute(&cus, hipDeviceAttributeMultiprocessorCount, dev) != hipSuccess) { fprintf(stderr, "kernel_launch: device query failed\n"); grid = -1; return; }
        if (hipFuncSetAttribute((const void*)mega_fwd, hipFuncAttributeMaxDynamicSharedMemorySize, LDS_BYTES) != hipSuccess) { fprintf(stderr, "kernel_launch: hipFuncSetAttribute failed\n"); grid = -1; return; }
        int per_cu = 0;
        if (hipOccupancyMaxActiveBlocksPerMultiprocessor(&per_cu, (const void*)mega_fwd, NTHR, LDS_BYTES) != hipSuccess || per_cu < 1) fprintf(stderr, "kernel_launch: note: occupancy query reports %d workgroups per CU\n", per_cu);
        (void)hipGetLastError();
        if (cus != NPANEL) fprintf(stderr, "kernel_launch: note: %d CUs; this kernel is built for one 256-token panel per CU on a 256-CU device\n", cus);
        grid = NPANEL;
    }
    if (grid < 0) return;
    if (hipMemsetAsync((char*)d_ws + WS_CTL, 0, CTL_ZERO_BYTES, stream) != hipSuccess) { fprintf(stderr, "kernel_launch: memset failed\n"); return; }
    Args a{};
    a.x = (const float*)d_in[0]; a.p = (const float*)d_in[1]; a.norm_mix = (const float*)d_in[2]; a.w_in = (const float*)d_in[3]; a.w_att_up = (const float*)d_in[4];
    a.w_pool_group = (const float*)d_in[5]; a.pool_scale = (const float*)d_in[6]; a.w_out = (const float*)d_in[7]; a.norm_ffn = (const float*)d_in[8]; a.w_query = (const float*)d_in[9];
    a.sub_keys = (const float*)d_in[10]; a.expert_u = (const float*)d_in[11]; a.expert_v = (const float*)d_in[12]; a.norm_ple = (const float*)d_in[13]; a.w_ple_gate = (const float*)d_in[14];
    a.w_ple = (const float*)d_in[15]; a.norm_final = (const float*)d_in[16];
    a.out = (float*)d_out; a.ws = (unsigned char*)d_ws; a.ph_hi = MK_PH_HI; a.pad = 0;
    hipLaunchKernelGGL(mega_fwd, dim3(grid), dim3(NTHR), LDS_BYTES, stream, a);
    { const hipError_t le = hipPeekAtLastError(); if (le != hipSuccess) fprintf(stderr, "kernel_launch: launch failed: %s\n", hipGetErrorName(le)); }
#if MK_PH_HI < 99
    {
        using namespace ref;
        char* ws = (char*)d_ws; float* out = (float*)d_out;
        float* hbuf = (float*)(ws + 0 * MiB); float* qp = (float*)(ws + 32 * MiB); float* sc = (float*)(ws + 96 * MiB);
        int* idx = (int*)(ws + 160 * MiB); float* gates = (float*)(ws + 164 * MiB); float* ebuf = (float*)(ws + 168 * MiB);
        for (int b = 0; b < NB; ++b) {
            const float* pb = a.p + (size_t)b * S * 256; float* ob = out + (size_t)b * S * D;
#if MK_PH_HI == 5
            k_rms<<<S, 256, 0, stream>>>(ob, a.norm_ffn, hbuf);
            k_gemm<EpiStore><<<dim3(2048 / 128, S / 128), 256, 0, stream>>>(hbuf, a.w_query, EpiStore{qp, 2048}, D, 2048, D, 0);
            k_scores<<<S / 4, 256, 0, stream>>>(qp, a.sub_keys, sc);
            k_topk<<<S * 8 / 4, 256, 0, stream>>>(sc, idx, gates);
            k_peer<<<S, 256, 0, stream>>>(hbuf, idx, gates, a.expert_u, a.expert_v, ob);
#elif MK_PH_HI == 7
            k_rms<<<S, 256, 0, stream>>>(ob, a.norm_ffn, hbuf);
            k_bf16_to_f32<<<S * 2048 / 256, 256, 0, stream>>>((const unsigned short*)(ws + WS_PG) + (size_t)b * S * 2048, qp);
            k_scores<<<S / 4, 256, 0, stream>>>(qp, a.sub_keys, sc);
            k_topk<<<S * 8 / 4, 256, 0, stream>>>(sc, idx, gates);
            k_peer<<<S, 256, 0, stream>>>(hbuf, idx, gates, a.expert_u, a.expert_v, ob);
#elif MK_PH_HI == 8
            k_rms<<<S, 256, 0, stream>>>(ob, a.norm_ffn, hbuf);
            k_gather_idx<<<S, 128, 0, stream>>>((const unsigned char*)(ws + WS_YA), b * S, idx, gates);
            k_peer<<<S, 256, 0, stream>>>(hbuf, idx, gates, a.expert_u, a.expert_v, ob);
#endif
            k_rms<<<S, 256, 0, stream>>>(ob, a.norm_ple, hbuf);
            k_gemm<EpiStore><<<dim3(D / 128, S / 128), 256, 0, stream>>>(pb, a.w_ple, EpiStore{ebuf, D}, 256, D, 256, 0);
            k_gemm<EpiGate><<<dim3(D / 128, S / 128), 256, 0, stream>>>(hbuf, a.w_ple_gate, EpiGate{ob, ebuf, ob, D}, D, D, D, 0);
            k_rms<<<S, 256, 0, stream>>>(ob, a.norm_final, ob);
        }
    }
#endif
}
```

```cpp
#include <hip/hip_runtime.h>
#include <cstdio>
#include <cstdint>
#include <math.h>
__device__ __forceinline__ int lane_id() { int l; asm volatile("v_mbcnt_lo_u32_b32 %0, -1, 0\n\tv_mbcnt_hi_u32_b32 %0, -1, %0" : "=v"(l)); return l; }
__device__ __forceinline__ int otid(int wid0) { return (wid0 << 6) | lane_id(); }

namespace pg8 {
#define PG8_LAS __attribute__((address_space(3)))
typedef unsigned short bf16_t;
typedef short bf16x8 __attribute__((ext_vector_type(8)));
typedef float f32x4 __attribute__((ext_vector_type(4)));
typedef unsigned u32x4 __attribute__((ext_vector_type(4)));
constexpr int BM = 256, BK = 64, HALF = 128, HTB = HALF * BK * 2  , STAGE_BYTES = 8 * HTB, NXCD = 8, WGM = 8;

__host__ __device__ __forceinline__ int lds_byte(int r, int c) { const int st = (r >> 4) * 2 + (c >> 5), rr = r & 15, cc = c & 31, ob = rr * 64 + cc * 2; return st * 1024 + (ob ^ (((ob >> 9) & 1) << 5)); }
__host__ __device__ __forceinline__ void stage_rc(int b, int& R, int& C) { const int st = b / 1024, sb = b % 1024, swz = sb ^ (((sb >> 9) & 1) << 5); R = (st >> 1) * 16 + swz / 64; C = (st & 1) * 32 + (swz % 64) / 2; }
__host__ __device__ __forceinline__ int perm32(int rho) { const int n = rho >> 4, i = rho & 15; return 8 * (i >> 2) + 4 * n + (i & 3); }

struct Unit { int pm, pn; };
struct Gemm { const bf16_t* A; const bf16_t* Bt; int K, lda, ldb, akoff; };

struct StaticOrder {
    int nM, nN, nwg, G, c;
    __host__ __device__ void init(int M, int N, int G_, int c_) { nM = M / BM; nN = N / BM; nwg = nM * nN; G = G_; c = c_; }
    __host__ __device__ bool next(int i, Unit& u) const {
        const long L = (long)i * G + c; if (L >= nwg) return false;
        int wgid = (int)L; { const int q = nwg / NXCD, r = nwg % NXCD, xcd = wgid % NXCD, off = wgid / NXCD; wgid = (xcd < r ? xcd * (q + 1) : r * (q + 1) + (xcd - r) * q) + off; }
        const int nig = WGM * nN, gid = wgid / nig, fm = gid * WGM, gsz = (nM - fm) < WGM ? (nM - fm) : WGM;
        u.pm = fm + ((wgid % nig) % gsz); u.pn = (wgid % nig) / gsz; return true;
    }
    __device__ __forceinline__ void a_ready(const Unit&) const {}
    __device__ __forceinline__ void done(const Unit&) const {}
};

template <class Epi, class Sched, bool ALIGN_EPI = false, bool SP2 = false>
__device__ __forceinline__ void gemm_phase(PG8_LAS unsigned char* lds, const Gemm g, const Sched& S, const Epi& E, const int wid0) {
    const int tid = otid(wid0), wid = __builtin_amdgcn_readfirstlane(tid >> 6), lane = tid & 63, wr = wid >> 2, wc = wid & 3, fr = lane & 15, fq = lane >> 4;
    const int K = g.K, nt = K / BK;
    unsigned voffA[2], voffB[2];
#pragma unroll
    for (int i = 0; i < 2; ++i) { int R, C; stage_rc(tid * 16 + i * 8192, R, C); const int Rb = Epi::PERM ? ((R & ~31) + perm32(R & 31)) : R;
        voffA[i] = (unsigned)(R * g.lda + C) * 2u; voffB[i] = (unsigned)(Rb * g.ldb + C) * 2u; }
    const size_t kstep = (size_t)(BK * 2);
    const size_t hstepA = (size_t)HALF * g.lda * 2, hstepB = (size_t)HALF * g.ldb * 2;
    const size_t tstepA = 2 * hstepA, tstepB = 2 * hstepB, akb = (size_t)g.akoff * 2;
    const unsigned ldsw = (unsigned)wid * 1024u;
    const int aoff = lds_byte(wr * 64 + fr, fq * 8), boff = lds_byte(wc * 32 + fr, fq * 8);
#define PG8_SA(b, h) (((b) * 2 + (h)) * HTB)
#define PG8_SB(b, h) ((4 + (b) * 2 + (h)) * HTB)
#define PG8_STAGE(bufoff, gbase, voff) do { _Pragma("unroll") for (int _i = 0; _i < 2; ++_i) \
        __builtin_amdgcn_global_load_lds((const unsigned*)((const char*)(gbase) + (voff)[_i]), (PG8_LAS unsigned*)(lds + (bufoff) + ldsw + _i * 8192), 16, 0, 0); } while (0)
#define PG8_LDA(dst, b, h) do { _Pragma("unroll") for (int m = 0; m < 4; ++m) _Pragma("unroll") for (int k = 0; k < 2; ++k) dst[m][k] = *(const PG8_LAS bf16x8*)(lds + PG8_SA(b, h) + aoff + m * 2048 + k * 1024); } while (0)
#define PG8_LDB(dst, b, h) do { _Pragma("unroll") for (int n = 0; n < 2; ++n) _Pragma("unroll") for (int k = 0; k < 2; ++k) dst[n][k] = *(const PG8_LAS bf16x8*)(lds + PG8_SB(b, h) + boff + n * 2048 + k * 1024); } while (0)
#define PG8_MMA(ai, bj, At, Bt) do { __builtin_amdgcn_s_setprio(1); _Pragma("unroll") for (int m = 0; m < 4; ++m) _Pragma("unroll") for (int n = 0; n < 2; ++n) _Pragma("unroll") for (int k = 0; k < 2; ++k) \
        acc[ai][bj][m][n] = __builtin_amdgcn_mfma_f32_16x16x32_bf16(Bt[n][k], At[m][k], acc[ai][bj][m][n], 0, 0, 0); __builtin_amdgcn_s_setprio(0); } while (0)
#define PG8_WAIT_V(n) asm volatile("s_waitcnt vmcnt(" #n ")" ::: "memory")
#define PG8_WAIT_L(n) asm volatile("s_waitcnt lgkmcnt(" #n ")" ::: "memory")
#define PG8_BAR __builtin_amdgcn_s_barrier()
#define PG8_SCHED __builtin_amdgcn_sched_barrier(0)
    Unit cur, nxt; int ui = 0;
    if (!S.next(0, cur)) return;
    f32x4 acc[2][2][4][2];
#pragma unroll
    for (int a = 0; a < 2; ++a)
#pragma unroll
        for (int b = 0; b < 2; ++b)
#pragma unroll
            for (int m = 0; m < 4; ++m)
#pragma unroll
                for (int n = 0; n < 2; ++n) acc[a][b][m][n] = (f32x4){0.f, 0.f, 0.f, 0.f};
    bf16x8 At[4][2], B0[2][2], B1[2][2];
    const char* cA = (const char*)g.A + (size_t)cur.pm * tstepA + (size_t)cur.pn * akb; const char* cB = (const char*)g.Bt + (size_t)cur.pn * tstepB;
    S.a_ready(cur);
    if constexpr (SP2) {
        PG8_STAGE(PG8_SB(0, 0), cB, voffB); PG8_STAGE(PG8_SB(0, 1), cB + hstepB, voffB); PG8_STAGE(PG8_SA(0, 0), cA, voffA); PG8_STAGE(PG8_SA(0, 1), cA + hstepA, voffA);
        if (wr == 1) PG8_BAR;
        PG8_WAIT_V(2); PG8_BAR;
        PG8_STAGE(PG8_SB(1, 0), cB + kstep, voffB); PG8_STAGE(PG8_SA(1, 0), cA + kstep, voffA); PG8_STAGE(PG8_SB(1, 1), cB + hstepB + kstep, voffB);
        PG8_WAIT_V(6); PG8_BAR;
    } else {
        PG8_STAGE(PG8_SB(0, 0), cB, voffB); PG8_STAGE(PG8_SA(0, 0), cA, voffA); PG8_STAGE(PG8_SB(0, 1), cB + hstepB, voffB); PG8_STAGE(PG8_SA(0, 1), cA + hstepA, voffA);
        if (wr == 1) PG8_BAR;
        PG8_WAIT_V(4); PG8_BAR;
        PG8_STAGE(PG8_SB(1, 0), cB + kstep, voffB); PG8_STAGE(PG8_SA(1, 0), cA + kstep, voffA); PG8_STAGE(PG8_SB(1, 1), cB + hstepB + kstep, voffB);
        PG8_WAIT_V(6); PG8_BAR;
    }
    for (;;) {
        const bool has_next = S.next(ui + 1, nxt);
        const char* nA = has_next ? (const char*)g.A + (size_t)nxt.pm * tstepA + (size_t)nxt.pn * akb : cA; const char* nB = has_next ? (const char*)g.Bt + (size_t)nxt.pn * tstepB : cB;
        for (int t = 0; t < nt; t += 2) {
            const bool last = (t == nt - 2);
            const char* a1 = cA + (size_t)(t + 1) * kstep;
            const char* a2 = last ? nA : cA + (size_t)(t + 2) * kstep; const char* b2 = last ? nB : cB + (size_t)(t + 2) * kstep;
            const char* a3 = a2 + kstep; const char* b3 = b2 + kstep;
            if (last && has_next) S.a_ready(nxt);
            if constexpr (SP2) {
            PG8_LDB(B0, 0, 0); PG8_LDB(B1, 0, 1); PG8_SCHED; PG8_LDA(At, 0, 0); PG8_STAGE(PG8_SA(1, 1), a1 + hstepA, voffA);
            PG8_WAIT_V(8); PG8_WAIT_L(0); PG8_BAR; PG8_MMA(0, 0, At, B0); PG8_MMA(0, 1, At, B1); PG8_BAR; PG8_SCHED;
            PG8_LDA(At, 0, 1); PG8_STAGE(PG8_SB(0, 0), b2, voffB); PG8_STAGE(PG8_SB(0, 1), b2 + hstepB, voffB); PG8_STAGE(PG8_SA(0, 0), a2, voffA);
            PG8_WAIT_V(8); PG8_WAIT_L(0); PG8_BAR; PG8_MMA(1, 0, At, B0); PG8_MMA(1, 1, At, B1); PG8_BAR; PG8_SCHED;
            PG8_LDB(B0, 1, 0); PG8_LDB(B1, 1, 1); PG8_SCHED; PG8_LDA(At, 1, 0); PG8_STAGE(PG8_SA(0, 1), a2 + hstepA, voffA);
            PG8_WAIT_V(8); PG8_WAIT_L(0); PG8_BAR; PG8_MMA(0, 0, At, B0); PG8_MMA(0, 1, At, B1); PG8_BAR; PG8_SCHED;
            PG8_LDA(At, 1, 1); PG8_STAGE(PG8_SB(1, 0), b3, voffB); PG8_STAGE(PG8_SB(1, 1), b3 + hstepB, voffB); PG8_STAGE(PG8_SA(1, 0), a3, voffA);
            PG8_WAIT_V(8); PG8_WAIT_L(0); PG8_BAR; PG8_MMA(1, 0, At, B0); PG8_MMA(1, 1, At, B1); PG8_BAR; PG8_SCHED;
            } else {
            PG8_LDB(B0, 0, 0); PG8_SCHED; PG8_LDA(At, 0, 0); PG8_STAGE(PG8_SA(1, 1), a1 + hstepA, voffA);
            PG8_WAIT_L(8); PG8_BAR; PG8_WAIT_L(0); PG8_MMA(0, 0, At, B0); PG8_BAR; PG8_SCHED;
            PG8_LDB(B1, 0, 1); PG8_STAGE(PG8_SB(0, 0), b2, voffB);
            PG8_BAR; PG8_WAIT_L(0); PG8_MMA(0, 1, At, B1); PG8_BAR;
            PG8_LDA(At, 0, 1); PG8_STAGE(PG8_SA(0, 0), a2, voffA);
            PG8_BAR; PG8_WAIT_L(0); PG8_MMA(1, 0, At, B0); PG8_BAR; PG8_SCHED;
            PG8_STAGE(PG8_SB(0, 1), b2 + hstepB, voffB);
            PG8_WAIT_V(6); PG8_BAR; PG8_MMA(1, 1, At, B1); PG8_BAR;
            PG8_LDB(B0, 1, 0); PG8_SCHED; PG8_LDA(At, 1, 0); PG8_STAGE(PG8_SA(0, 1), a2 + hstepA, voffA);
            PG8_WAIT_L(8); PG8_BAR; PG8_WAIT_L(0); PG8_MMA(0, 0, At, B0); PG8_BAR; PG8_SCHED;
            PG8_LDB(B1, 1, 1); PG8_STAGE(PG8_SB(1, 0), b3, voffB);
            PG8_BAR; PG8_WAIT_L(0); PG8_MMA(0, 1, At, B1); PG8_BAR;
            PG8_LDA(At, 1, 1); PG8_STAGE(PG8_SA(1, 0), a3, voffA);
            PG8_BAR; PG8_WAIT_L(0); PG8_MMA(1, 0, At, B0); PG8_BAR; PG8_SCHED;
            PG8_STAGE(PG8_SB(1, 1), b3 + hstepB, voffB);
            PG8_WAIT_V(6); PG8_BAR; PG8_MMA(1, 1, At, B1); PG8_BAR;
            }
        }
        if constexpr (ALIGN_EPI) { if (wr == 0) PG8_BAR; }
        if constexpr (!Epi::AFTER_DRAIN) { E(acc, cur, wr, wc, fr, fq); S.done(cur); }
        if (!has_next) break;
#pragma unroll
        for (int a = 0; a < 2; ++a)
#pragma unroll
            for (int b = 0; b < 2; ++b)
#pragma unroll
                for (int m = 0; m < 4; ++m)
#pragma unroll
                    for (int n = 0; n < 2; ++n) acc[a][b][m][n] = (f32x4){0.f, 0.f, 0.f, 0.f};
        cur = nxt; cA = nA; cB = nB; ++ui;
        if constexpr (ALIGN_EPI) { if (wr == 1) PG8_BAR; }
    }
    PG8_WAIT_V(0);
    if constexpr (!ALIGN_EPI) { if (wr == 0) PG8_BAR; }
    PG8_BAR;
    if constexpr (Epi::AFTER_DRAIN) { E.fused(acc, cur, wr, wc, fr, fq, lds, wid, lane); S.done(cur); }
#undef PG8_SA
#undef PG8_SB
#undef PG8_STAGE
#undef PG8_LDA
#undef PG8_LDB
#undef PG8_MMA
#undef PG8_WAIT_V
#undef PG8_WAIT_L
#undef PG8_BAR
#undef PG8_SCHED
}
}


namespace pg8 {
typedef unsigned u32x2 __attribute__((ext_vector_type(2)));
__device__ __forceinline__ unsigned cvt_pk_bf16(float lo, float hi) { unsigned r; asm volatile("v_cvt_pk_bf16_f32 %0, %1, %2" : "=v"(r) : "v"(lo), "v"(hi)); return r; }
__device__ __forceinline__ float sigm(float x) { return __builtin_amdgcn_rcpf(1.0f + __builtin_amdgcn_exp2f(-1.4426950408889634f * x)); }
__device__ __forceinline__ float bf_lo(unsigned w) { return __uint_as_float(w << 16); }
__device__ __forceinline__ float bf_hi(unsigned w) { return __uint_as_float(w & 0xffff0000u); }

struct PanelSched {
    int panel, n, skip_lo, skip_n, mode;
    __device__ __forceinline__ bool next(int i, Unit& u) const {
        if (i >= n) return false;
        if (mode == 0) { u.pm = panel; u.pn = i + (i >= skip_lo ? skip_n : 0); } else { u.pm = i; u.pn = panel; }
        return true;
    }
    __device__ __forceinline__ void a_ready(const Unit&) const {}
    __device__ __forceinline__ void done(const Unit&) const {}
};

struct EpiProj {
    static constexpr bool PERM = true, AFTER_DRAIN = false;
    bf16_t *PQ, *PK, *PU, *PG;
    __device__ __forceinline__ void operator()(const f32x4 (&acc)[2][2][4][2], const Unit& u, int wr, int wc, int fr, int fq) const {
        const int pn = u.pn; bf16_t* base; int ld, colt; bool sg = false;
        if (pn < 2) { base = PQ; ld = 512; colt = pn * 256; }
        else if (pn < 4) { base = PK; ld = 512; colt = (pn - 2) * 256; }
        else if (pn < 8) { base = PU; ld = 512; colt = (pn - 6) * 256; }
        else { base = PG; ld = 2048; colt = (pn - 8) * 256; sg = true; }
        const int row0 = u.pm * BM + wr * 64 + fr, col0 = colt + wc * 32 + 8 * fq;
#pragma unroll
        for (int ai = 0; ai < 2; ++ai)
#pragma unroll
            for (int m = 0; m < 4; ++m) { bf16_t* rowp = base + (size_t)(row0 + ai * HALF + m * 16) * ld + col0;
#pragma unroll
                for (int bj = 0; bj < 2; ++bj) { f32x4 v0 = acc[ai][bj][m][0], v1 = acc[ai][bj][m][1];
                    if (sg) { v0 = (f32x4){sigm(v0[0]), sigm(v0[1]), sigm(v0[2]), sigm(v0[3])}; v1 = (f32x4){sigm(v1[0]), sigm(v1[1]), sigm(v1[2]), sigm(v1[3])}; }
                    u32x4 w; w.x = cvt_pk_bf16(v0[0], v0[1]); w.y = cvt_pk_bf16(v0[2], v0[3]); w.z = cvt_pk_bf16(v1[0], v1[1]); w.w = cvt_pk_bf16(v1[2], v1[3]);
                    *(u32x4*)(rowp + bj * HALF) = w; } }
    }
};
struct EpiPlain {
    static constexpr bool PERM = true, AFTER_DRAIN = false;
    bf16_t* O; int ldc;
    __device__ __forceinline__ void operator()(const f32x4 (&acc)[2][2][4][2], const Unit& u, int wr, int wc, int fr, int fq) const {
        const int row0 = u.pm * BM + wr * 64 + fr, col0 = u.pn * BM + wc * 32 + 8 * fq;
#pragma unroll
        for (int ai = 0; ai < 2; ++ai)
#pragma unroll
            for (int m = 0; m < 4; ++m) { bf16_t* rowp = O + (size_t)(row0 + ai * HALF + m * 16) * ldc + col0;
#pragma unroll
                for (int bj = 0; bj < 2; ++bj) { const f32x4 v0 = acc[ai][bj][m][0], v1 = acc[ai][bj][m][1];
                    u32x4 w; w.x = cvt_pk_bf16(v0[0], v0[1]); w.y = cvt_pk_bf16(v0[2], v0[3]); w.z = cvt_pk_bf16(v1[0], v1[1]); w.w = cvt_pk_bf16(v1[2], v1[3]);
                    *(u32x4*)(rowp + bj * HALF) = w; } }
    }
};
template <bool ADD> struct EpiMerge {
    static constexpr bool PERM = true, AFTER_DRAIN = false;
    const bf16_t* G; bf16_t* MG; int goff;
    __device__ __forceinline__ void operator()(const f32x4 (&acc)[2][2][4][2], const Unit& u, int wr, int wc, int fr, int fq) const {
        const int row0 = u.pm * BM + wr * 64 + fr, col0 = u.pn * BM + wc * 32 + 8 * fq;
#pragma unroll
        for (int ai = 0; ai < 2; ++ai)
#pragma unroll
            for (int m = 0; m < 4; ++m) { const size_t row = (size_t)(row0 + ai * HALF + m * 16);
#pragma unroll
                for (int bj = 0; bj < 2; ++bj) { const f32x4 v0 = acc[ai][bj][m][0], v1 = acc[ai][bj][m][1];
                    const u32x4 gw = *(const u32x4*)(G + row * 2048 + goff + col0 + bj * HALF);
                    float r0 = bf_lo(gw.x) * v0[0], r1 = bf_hi(gw.x) * v0[1], r2 = bf_lo(gw.y) * v0[2], r3 = bf_hi(gw.y) * v0[3];
                    float r4 = bf_lo(gw.z) * v1[0], r5 = bf_hi(gw.z) * v1[1], r6 = bf_lo(gw.w) * v1[2], r7 = bf_hi(gw.w) * v1[3];
                    bf16_t* mp = MG + row * 1024 + col0 + bj * HALF;
                    if (ADD) { const u32x4 pw = *(const u32x4*)mp;
                        r0 += bf_lo(pw.x); r1 += bf_hi(pw.x); r2 += bf_lo(pw.y); r3 += bf_hi(pw.y); r4 += bf_lo(pw.z); r5 += bf_hi(pw.z); r6 += bf_lo(pw.w); r7 += bf_hi(pw.w); }
                    u32x4 w; w.x = cvt_pk_bf16(r0, r1); w.y = cvt_pk_bf16(r2, r3); w.z = cvt_pk_bf16(r4, r5); w.w = cvt_pk_bf16(r6, r7);
                    *(u32x4*)mp = w; }
                asm volatile("" ::: "memory"); }
    }
};
struct EpiRes {
    static constexpr bool PERM = false, AFTER_DRAIN = false;
    const float* X; float* OUT;
    __device__ __forceinline__ void operator()(const f32x4 (&acc)[2][2][4][2], const Unit& u, int wr, int wc, int fr, int fq) const {
        const int col0 = u.pn * BM + wc * 32 + 4 * fq;
#pragma unroll
        for (int ai = 0; ai < 2; ++ai)
#pragma unroll
            for (int m = 0; m < 4; ++m) { const size_t off = (size_t)(u.pm * BM + ai * HALF + wr * 64 + m * 16 + fr) * 1024 + col0;
#pragma unroll
                for (int bj = 0; bj < 2; ++bj)
#pragma unroll
                    for (int n = 0; n < 2; ++n) { const f32x4 xs = *(const f32x4*)(X + off + bj * HALF + n * 16); *(f32x4*)(OUT + off + bj * HALF + n * 16) = xs + acc[ai][bj][m][n]; }
                asm volatile("" ::: "memory"); }
    }
};
struct EpiGate {
    static constexpr bool PERM = false, AFTER_DRAIN = false;
    float* OUT; const bf16_t* E;
    __device__ __forceinline__ void operator()(const f32x4 (&acc)[2][2][4][2], const Unit& u, int wr, int wc, int fr, int fq) const {
        const int col0 = u.pn * BM + wc * 32 + 4 * fq;
#pragma unroll
        for (int ai = 0; ai < 2; ++ai)
#pragma unroll
            for (int m = 0; m < 4; ++m) { const size_t off = (size_t)(u.pm * BM + ai * HALF + wr * 64 + m * 16 + fr) * 1024 + col0;
#pragma unroll
                for (int bj = 0; bj < 2; ++bj)
#pragma unroll
                    for (int n = 0; n < 2; ++n) { const size_t o2 = off + bj * HALF + n * 16; const f32x4 xs = *(const f32x4*)(OUT + o2); const u32x2 ew = *(const u32x2*)(E + o2); const f32x4 a = acc[ai][bj][m][n];
                        f32x4 r; r[0] = xs[0] + sigm(a[0]) * bf_lo(ew.x); r[1] = xs[1] + sigm(a[1]) * bf_hi(ew.x); r[2] = xs[2] + sigm(a[2]) * bf_lo(ew.y); r[3] = xs[3] + sigm(a[3]) * bf_hi(ew.y);
                        *(f32x4*)(OUT + o2) = r; }
                asm volatile("" ::: "memory"); }
    }
};
}

#define GAS __attribute__((address_space(1)))
#define LAS __attribute__((address_space(3)))
typedef unsigned short bf16;
typedef unsigned v4u __attribute__((ext_vector_type(4)));
typedef float f32x4 __attribute__((ext_vector_type(4)));
typedef short bf16x8 __attribute__((ext_vector_type(8)));
typedef GAS unsigned gu32;
typedef GAS unsigned long long gu64;
#define RLX_AGENT __ATOMIC_RELAXED, __HIP_MEMORY_SCOPE_AGENT
#define LDS_WAIT() asm volatile("s_waitcnt lgkmcnt(0)" ::: "memory")
#define VM_WAIT() asm volatile("s_waitcnt vmcnt(0)" ::: "memory")
__device__ __forceinline__ unsigned long long rt() { return __builtin_amdgcn_s_memrealtime(); }
__device__ __forceinline__ unsigned f2bf(float f) { unsigned u = __builtin_bit_cast(unsigned, f); return (u + 0x7fffu + ((u >> 16) & 1u)) >> 16; }
__device__ __forceinline__ unsigned pk2(float lo, float hi) { return f2bf(lo) | (f2bf(hi) << 16); }

#define XB_TMO      128
#define XB_XCNT(j)  (256  + 64 * (j))
#define XB_XSUB(j)  (1280 + 64 * (j))
#define XB_XGEN(j)  (2304 + 64 * (j))
#define XB_TOP      3328
#define XB_TOPGEN   3392
#define XCD_BAR_WORDS 3456
#define XB_SPIN_CAP (1u << 18)

__device__ __forceinline__ unsigned xb_ld(unsigned* p)              { return __hip_atomic_load(p, __ATOMIC_RELAXED, __HIP_MEMORY_SCOPE_AGENT); }
__device__ __forceinline__ unsigned xb_add(unsigned* p, unsigned v) { return __hip_atomic_fetch_add(p, v, __ATOMIC_RELAXED, __HIP_MEMORY_SCOPE_AGENT); }
__device__ __forceinline__ unsigned xb_xcc_id() { return (unsigned)__builtin_amdgcn_s_getreg((3 << 11) | 20) & 0xFu; }
#define XB_SPIN(cond, bar) do { unsigned _sp = 0; while (cond) { __builtin_amdgcn_s_sleep(1); \
    if ((++_sp & 255u) == 0u) { if (xb_ld(&(bar)[XB_TMO])) break; if (_sp > XB_SPIN_CAP) { atomicAdd(&(bar)[XB_TMO], 1u); break; } } } } while (0)

struct XcdBarrier {
    unsigned* bar; unsigned x;
    volatile LAS unsigned* st;
};

__device__ __forceinline__ XcdBarrier xcd_barrier_post(unsigned* bar, volatile LAS unsigned* st, const bool is_t0) {
    XcdBarrier b; b.bar = bar; b.x = xb_xcc_id(); b.st = st;
    if (is_t0) (void)xb_add(&bar[XB_XCNT(b.x)], 1u);
    return b;
}
__device__ __forceinline__ void xcd_barrier_complete(unsigned* bar, unsigned x, unsigned& nloc, unsigned& nx) {
    const unsigned G = gridDim.x * gridDim.y * gridDim.z;
    unsigned sum, cnt, mine, sp = 0u;
    for (;;) {
        sum = 0u; cnt = 0u; mine = 0u;
#pragma unroll
        for (unsigned j = 0; j < 16; ++j) { const unsigned c = xb_ld(&bar[XB_XCNT(j)]); sum += c; cnt += (c > 0u) ? 1u : 0u; mine = (j == x) ? c : mine; }
        if (sum == G) break;
        __builtin_amdgcn_s_sleep(1);
        if ((++sp & 255u) == 0u) { if (xb_ld(&bar[XB_TMO])) break; if (sp > XB_SPIN_CAP) { atomicAdd(&bar[XB_TMO], 1u); break; } }
    }
    nloc = mine > 0u ? mine : 1u; nx = cnt > 0u ? cnt : 1u;
}

__device__ __forceinline__ void xcd_barrier(const XcdBarrier& b, const bool is_t0) {
    asm volatile("s_waitcnt vmcnt(0)" ::: "memory");
    __syncthreads();
    if (is_t0) {
        unsigned* bar = b.bar;
        __builtin_amdgcn_s_waitcnt(0);
        unsigned nloc = b.st[0], nx = b.st[1];
        if (nloc == 0u) { xcd_barrier_complete(bar, b.x, nloc, nx); b.st[0] = nloc; b.st[1] = nx; }
        const unsigned old = xb_add(&bar[XB_XSUB(b.x)], 1u);
        const unsigned gen = old / nloc;
        if (old + 1u == (gen + 1u) * nloc) {
            __builtin_amdgcn_fence(__ATOMIC_RELEASE, "agent");
            asm volatile("s_waitcnt vmcnt(0)" ::: "memory");
            const unsigned og = xb_add(&bar[XB_TOP], 1u);
            const unsigned tg = og / nx;
            if (og + 1u == (tg + 1u) * nx) xb_add(&bar[XB_TOPGEN], 1u);
            else XB_SPIN(xb_ld(&bar[XB_TOPGEN]) == tg, bar);
            __builtin_amdgcn_fence(__ATOMIC_ACQUIRE, "agent");
            xb_add(&bar[XB_XGEN(b.x)], 1u);
            asm volatile("s_waitcnt vmcnt(0)" ::: "memory");
        } else {
            XB_SPIN(xb_ld(&bar[XB_XGEN(b.x)]) == gen, bar);
            __builtin_amdgcn_fence(__ATOMIC_ACQUIRE, "agent");
            asm volatile("s_waitcnt vmcnt(0)" ::: "memory");
        }
    }
    __syncthreads();
}


constexpr int NWAVES = 8, NTHR = 512;
constexpr int TOK = 65536, DM = 1024, SEQ = 8192, NPANEL = 256;
constexpr float RMS_EPS = 1e-6f;
constexpr float C2 = 0.125f * 1.4426950408889634f;
constexpr float SURV_THR = 5.4210108624275222e-20f;
constexpr size_t MiB = 1u << 20;
constexpr size_t WS_CTL = 0, CTL_ZERO_BYTES = 64 * 1024;
constexpr size_t WS_WIN = 2 * MiB, WS_WOUT = 10 * MiB, WS_WQ = 12 * MiB, WS_WPG = 16 * MiB, WS_WPLE = 18 * MiB;
constexpr size_t WS_BDA = 18 * MiB + 512 * 1024, WS_BDP = 18 * MiB + 768 * 1024, WS_SK = 19 * MiB;
constexpr size_t WS_EU = 32 * MiB, WS_EV = 64 * MiB, WS_SU = 20 * MiB, WS_SV = 20 * MiB + 65536;
constexpr size_t WS_XN = 96 * MiB;
constexpr size_t WS_PQ = 224 * MiB, WS_PK = 288 * MiB, WS_PVT = 352 * MiB, WS_PU = 416 * MiB;
constexpr size_t WS_PG = 480 * MiB;
constexpr size_t WS_YA = 736 * MiB, WS_YP = 800 * MiB;
constexpr size_t WS_MG = 864 * MiB, WS_END = 992 * MiB;
constexpr int CW_BAR = 1024;
constexpr int RING_BYTES = 131072, LDSCTL_OFF = RING_BYTES, MISC_OFF = LDSCTL_OFF + 320, LDS_BYTES = 147456;

typedef float f32x16 __attribute__((ext_vector_type(16)));
typedef float f32x2 __attribute__((ext_vector_type(2)));
typedef __bf16 bf16x2v __attribute__((ext_vector_type(2)));

__device__ __forceinline__ int shx(int v, int m, int lane) { return __builtin_amdgcn_ds_bpermute((lane ^ m) << 2, v); }
__device__ __forceinline__ float shx(float v, int m, int lane) { return __builtin_bit_cast(float, __builtin_amdgcn_ds_bpermute((lane ^ m) << 2, __builtin_bit_cast(int, v))); }
__device__ __forceinline__ float shl_(float v, int src) { return __builtin_bit_cast(float, __builtin_amdgcn_ds_bpermute(src << 2, __builtin_bit_cast(int, v))); }
__device__ __forceinline__ float wave_sum(float v, int lane) {
#pragma unroll
    for (int o = 1; o < 64; o <<= 1) v += shx(v, o, lane);
    return v;
}
__device__ __forceinline__ float bflo(unsigned w) { return __uint_as_float(w << 16); }
__device__ __forceinline__ float bfhi(unsigned w) { return __uint_as_float(w & 0xffff0000u); }
__device__ __forceinline__ unsigned cvtpk(float lo, float hi) { return pg8::cvt_pk_bf16(lo, hi); }

__device__ __forceinline__ void p0_transpose_item(const float* W, int K, int N, bf16* WT, const float* kscale, int nlo, float nls, LAS float* scr, int item, int lane) {
    const int nblk = N / 32, kb = item / nblk, nb = item % nblk, k0 = 64 * kb, n0 = 32 * nb;
    const float ns = (n0 + (lane & 31)) < nlo ? nls : 1.0f;
#pragma unroll 8
    for (int i = 0; i < 32; ++i) { const int kk = 2 * i + (lane >> 5); float v = W[(size_t)(k0 + kk) * N + n0 + (lane & 31)] * ns; if (kscale) v *= kscale[k0 + kk]; scr[kk * 33 + (lane & 31)] = v; }
    LDS_WAIT(); asm volatile("" ::: "memory");
    const int c = lane & 7;
#pragma unroll
    for (int j = 0; j < 4; ++j) { const int n = (lane >> 3) + 8 * j; const LAS float* s = scr + (8 * c) * 33 + n;
        v4u o; o.x = pk2(s[0 * 33], s[1 * 33]); o.y = pk2(s[2 * 33], s[3 * 33]); o.z = pk2(s[4 * 33], s[5 * 33]); o.w = pk2(s[6 * 33], s[7 * 33]);
        *(GAS v4u*)(WT + (size_t)(n0 + n) * K + k0 + 8 * c) = o; }
    LDS_WAIT(); asm volatile("" ::: "memory");
}
__device__ __forceinline__ void rms_row_to_bf16(const float* xrow, bf16* orow, int lane) {
    const GAS f32x4* xr = (const GAS f32x4*)xrow + lane;
    f32x4 v[4]; float s = 0.f;
#pragma unroll
    for (int j = 0; j < 4; ++j) { v[j] = xr[64 * j]; s += (v[j].x * v[j].x + v[j].y * v[j].y) + (v[j].z * v[j].z + v[j].w * v[j].w); }
    const float r = 1.f / sqrtf(wave_sum(s, lane) * (1.f / DM) + RMS_EPS);
    GAS unsigned long long* o8 = (GAS unsigned long long*)orow + lane;
#pragma unroll
    for (int j = 0; j < 4; ++j) o8[64 * j] = (unsigned long long)pk2(v[j].x * r, v[j].y * r) | ((unsigned long long)pk2(v[j].z * r, v[j].w * r) << 32);
}
__device__ __forceinline__ void cvt8_store(const float* src, bf16* dst) {
    const f32x4 a = *(const GAS f32x4*)src, b = *(const GAS f32x4*)(src + 4);
    v4u o; o.x = pk2(a.x, a.y); o.y = pk2(a.z, a.w); o.z = pk2(b.x, b.y); o.w = pk2(b.z, b.w);
    *(GAS v4u*)dst = o;
}

__device__ __forceinline__ void attn_panel(int panel, const bf16* PQ, const bf16* PK, const bf16* PVT, bf16* YA, const int wid0) {
    const int tid = otid(wid0), lane = tid & 63, wid = __builtin_amdgcn_readfirstlane(tid >> 6);
    const int r32 = lane & 31, hh = lane >> 5;
    const size_t seq0 = (size_t)(panel >> 5) * SEQ;
    const int pos0 = (panel & 31) * 256 + wid * 32;
    const int kap = 16 * ((r32 >> 2) & 1) + (r32 & 3) + 4 * (r32 >> 3);
    for (int h = 0; h < 8; ++h) {
        bf16x8 qf[4];
        { const bf16* qrow = PQ + (seq0 + pos0 + r32) * 512 + h * 64 + 8 * hh;
#pragma unroll
          for (int s = 0; s < 4; ++s) qf[s] = *(const GAS bf16x8*)(qrow + 16 * s); }
        f32x16 o0 = {}, o1 = {};
        float Sin = 1.f;
        for (int kb = pos0; kb >= 0; kb -= 32) {
            const bf16* krow = PK + (seq0 + kb + kap) * 512 + h * 64 + 8 * hh;
            const bf16* vrow = PVT + (size_t)(h * 64 + kap) * TOK + seq0 + kb + 16 * hh;
            bf16x8 kf[4], vf[2][2];
#pragma unroll
            for (int s = 0; s < 4; ++s) kf[s] = *(const GAS bf16x8*)(krow + 16 * s);
#pragma unroll
            for (int db = 0; db < 2; ++db)
#pragma unroll
                for (int s = 0; s < 2; ++s) vf[db][s] = *(const GAS bf16x8*)(vrow + (size_t)db * 32 * TOK + 8 * s);
            f32x16 z = {};
#pragma unroll
            for (int s = 0; s < 4; ++s) z = __builtin_amdgcn_mfma_f32_32x32x16_bf16(kf[s], qf[s], z, 0, 0, 0);
            const bool diag = (kb == pos0);
            float w[16]; float Sl = 1.f;
#pragma unroll
            for (int reg = 15; reg >= 0; --reg) {
                float beta = __builtin_amdgcn_rcpf(1.0f + __builtin_amdgcn_exp2f(-z[reg]));
                if (diag && (16 * hh + reg >= r32)) beta = 0.f;
                const float wl = beta * Sl; Sl -= wl; w[reg] = wl;
            }
            const float Pp = shx(Sl, 32, lane);
            const float scale = hh ? Sin : Sin * Pp;
            Sin = Sin * Sl * Pp;
            v4u pw0, pw1;
            pw0.x = cvtpk(w[0] * scale, w[1] * scale); pw0.y = cvtpk(w[2] * scale, w[3] * scale); pw0.z = cvtpk(w[4] * scale, w[5] * scale); pw0.w = cvtpk(w[6] * scale, w[7] * scale);
            pw1.x = cvtpk(w[8] * scale, w[9] * scale); pw1.y = cvtpk(w[10] * scale, w[11] * scale); pw1.z = cvtpk(w[12] * scale, w[13] * scale); pw1.w = cvtpk(w[14] * scale, w[15] * scale);
            const bf16x8 p0 = __builtin_bit_cast(bf16x8, pw0), p1 = __builtin_bit_cast(bf16x8, pw1);
            o0 = __builtin_amdgcn_mfma_f32_32x32x16_bf16(vf[0][0], p0, o0, 0, 0, 0);
            o0 = __builtin_amdgcn_mfma_f32_32x32x16_bf16(vf[0][1], p1, o0, 0, 0, 0);
            o1 = __builtin_amdgcn_mfma_f32_32x32x16_bf16(vf[1][0], p0, o1, 0, 0, 0);
            o1 = __builtin_amdgcn_mfma_f32_32x32x16_bf16(vf[1][1], p1, o1, 0, 0, 0);
            if (__all(Sin < SURV_THR)) break;
        }
        bf16* orow = YA + (seq0 + pos0 + r32) * 512 + h * 64 + 16 * hh;
        v4u a, b2;
        a.x = cvtpk(o0[0], o0[1]); a.y = cvtpk(o0[2], o0[3]); a.z = cvtpk(o0[4], o0[5]); a.w = cvtpk(o0[6], o0[7]);
        b2.x = cvtpk(o0[8], o0[9]); b2.y = cvtpk(o0[10], o0[11]); b2.z = cvtpk(o0[12], o0[13]); b2.w = cvtpk(o0[14], o0[15]);
        *(GAS v4u*)orow = a; *(GAS v4u*)(orow + 8) = b2;
        a.x = cvtpk(o1[0], o1[1]); a.y = cvtpk(o1[2], o1[3]); a.z = cvtpk(o1[4], o1[5]); a.w = cvtpk(o1[6], o1[7]);
        b2.x = cvtpk(o1[8], o1[9]); b2.y = cvtpk(o1[10], o1[11]); b2.z = cvtpk(o1[12], o1[13]); b2.w = cvtpk(o1[14], o1[15]);
        *(GAS v4u*)(orow + 32) = a; *(GAS v4u*)(orow + 40) = b2;
    }
}

__device__ __forceinline__ void pool_panel(int panel, const bf16* PU, bf16* YP, const int wid0) {
    const int tid = otid(wid0);
    const int chunk = tid & 63, tg = tid >> 6, w = 2 << (chunk >> 4);
    const int posb = (panel & 31) * 256; const size_t row0 = (size_t)panel * 256;
    for (int i = 0; i < 32; ++i) {
        const int t = tg * 32 + i, pos = posb + t, cnt = (pos + 1 < w) ? (pos + 1) : w;
        float s[8];
#pragma unroll
        for (int k = 0; k < 8; ++k) s[k] = 0.f;
        v4u cur = {0u, 0u, 0u, 0u};
        for (int j = 0; j < cnt; ++j) {
            const v4u v = *(const GAS v4u*)(PU + (row0 + t - j) * 512 + chunk * 8);
            if (j == 0) cur = v;
            s[0] += bflo(v.x); s[1] += bfhi(v.x); s[2] += bflo(v.y); s[3] += bfhi(v.y); s[4] += bflo(v.z); s[5] += bfhi(v.z); s[6] += bflo(v.w); s[7] += bfhi(v.w);
        }
        const float ic = 1.0f / (float)cnt;
        v4u o;
        o.x = cvtpk(s[0] * ic - bflo(cur.x), s[1] * ic - bfhi(cur.x)); o.y = cvtpk(s[2] * ic - bflo(cur.y), s[3] * ic - bfhi(cur.y));
        o.z = cvtpk(s[4] * ic - bflo(cur.z), s[5] * ic - bfhi(cur.z)); o.w = cvtpk(s[6] * ic - bflo(cur.w), s[7] * ic - bfhi(cur.w));
        *(GAS v4u*)(YP + (row0 + t) * 512 + chunk * 8) = o;
    }
}

#define HD __host__ __device__ __forceinline__
HD int f2s(float f) { int i = __builtin_bit_cast(int, f); return i ^ ((i >> 31) & 0x7fffffff); }
HD float s2f(int i) { i ^= ((i >> 31) & 0x7fffffff); return __builtin_bit_cast(float, i); }
HD void ce_desc(int& a, int& b) { const int mx = a > b ? a : b, mn = a > b ? b : a; a = mx; b = mn; }
template <int J, int K> HD void bpass16(int (&v)[16]) {
#pragma unroll
    for (int i = 0; i < 16; ++i) { const int l = i ^ J; if (l > i) { if ((i & K) == 0) ce_desc(v[i], v[l]); else ce_desc(v[l], v[i]); } }
}
HD void bitonic_sort16_desc(int (&v)[16]) {
    bpass16<1, 2>(v); bpass16<2, 4>(v); bpass16<1, 4>(v); bpass16<4, 8>(v); bpass16<2, 8>(v); bpass16<1, 8>(v);
    bpass16<8, 16>(v); bpass16<4, 16>(v); bpass16<2, 16>(v); bpass16<1, 16>(v);
}
HD void bitonic_merge16_desc(int (&v)[16]) {
    bpass16<8, 16>(v); bpass16<4, 16>(v); bpass16<2, 16>(v); bpass16<1, 16>(v);
}
HD void merge_prune16(int (&x)[16], const int (&y)[16]) {
#pragma unroll
    for (int i = 0; i < 16; ++i) x[i] = x[i] > y[15 - i] ? x[i] : y[15 - i];
    bitonic_merge16_desc(x);
}
HD int cx_i(int hf, int t) { if (hf == 0) return 0; return t < 5 ? 2 : t < 9 ? 3 : t < 12 ? 4 : t < 14 ? 5 : 6; }
HD int cx_j(int hf, int t) { if (hf == 0) return t; return t < 5 ? t : t < 9 ? t - 5 : t < 12 ? t - 9 : t < 14 ? t - 12 : t - 14; }
HD int cy_i(int hf, int t) { if (hf == 0) return t < 8 ? 1 : 23 - t; return 7; }
HD int cy_j(int hf, int t) { if (hf == 0) return t < 8 ? t : 0; return t; }

__device__ __forceinline__ void top16_of_group(const bf16* qrow  , const bf16* skg  , int hh, int lane, int (&res)[16]) {
    bf16x8 qf[8];
#pragma unroll
    for (int s = 0; s < 8; ++s) qf[s] = *(const GAS bf16x8*)(qrow + 16 * s);
    int v[4][16];
#pragma unroll
    for (int kb = 0; kb < 4; ++kb) {
        f32x16 acc = {};
#pragma unroll
        for (int s = 0; s < 8; ++s) { const bf16x8 af = *(const GAS bf16x8*)(skg + (size_t)kb * 32 * 128 + 16 * s); acc = __builtin_amdgcn_mfma_f32_32x32x16_bf16(af, qf[s], acc, 0, 0, 0); }
#pragma unroll
        for (int reg = 0; reg < 16; ++reg) { const int keyid = 32 * kb + (reg & 3) + 8 * (reg >> 2) + 4 * hh; v[kb][reg] = (f2s(acc[reg]) & ~127) | keyid; }
    }
    bitonic_sort16_desc(v[0]); bitonic_sort16_desc(v[1]); bitonic_sort16_desc(v[2]); bitonic_sort16_desc(v[3]);
    merge_prune16(v[0], v[1]); merge_prune16(v[2], v[3]); merge_prune16(v[0], v[2]);
    int y[16];
#pragma unroll
    for (int i = 0; i < 16; ++i) y[i] = shx(v[0][i], 32, lane);
    merge_prune16(v[0], y);
#pragma unroll
    for (int i = 0; i < 16; ++i) res[i] = v[0][i];
}

__device__ __forceinline__ void topk_panel(int panel, const bf16* QP, const bf16* SK, int* IDXp, float* GTp  , LAS int* lut  , const int wid0) {
    const int tid = otid(wid0), lane = tid & 63, wid = __builtin_amdgcn_readfirstlane(tid >> 6);
    const int r32 = lane & 31, hh = lane >> 5;
    const int lrow = wid * 32 + r32;
    const size_t row = (size_t)panel * 256 + lrow;
    for (int h = 0; h < 8; ++h) {
        int a[16], b[16];
        top16_of_group(QP + row * 2048 + (2 * h) * 128 + 8 * hh, SK + ((size_t)(2 * h) * 128 + r32) * 128 + 8 * hh, hh, lane, a);
        top16_of_group(QP + row * 2048 + (2 * h + 1) * 128 + 8 * hh, SK + ((size_t)(2 * h + 1) * 128 + r32) * 128 + 8 * hh, hh, lane, b);
        float fa[16], fb[16];
#pragma unroll
        for (int i = 0; i < 16; ++i) { fa[i] = s2f(a[i] & ~127); fb[i] = s2f(b[i] & ~127); lut[i * 512 + tid] = a[i] & 127; lut[(16 + i) * 512 + tid] = b[i] & 127; }
        int X[16], Y[16];
#pragma unroll
        for (int t = 0; t < 16; ++t) {
            const float s0 = fa[cx_i(0, t)] + fb[cx_j(0, t)], s1 = fa[cx_i(1, t)] + fb[cx_j(1, t)];
            const int c0 = cx_i(0, t) * 16 + cx_j(0, t), c1 = cx_i(1, t) * 16 + cx_j(1, t);
            X[t] = hh ? ((f2s(s1) & ~255) | c1) : ((f2s(s0) & ~255) | c0);
            const float u0 = fa[cy_i(0, t)] + fb[cy_j(0, t)];
            const int d0 = cy_i(0, t) * 16 + cy_j(0, t);
            int y1 = (int)0x80000000;
            if (t < 2) { const float u1 = fa[cy_i(1, t)] + fb[cy_j(1, t)]; y1 = (f2s(u1) & ~255) | (cy_i(1, t) * 16 + cy_j(1, t)); }
            Y[t] = hh ? y1 : ((f2s(u0) & ~255) | d0);
        }
        bitonic_sort16_desc(X); bitonic_merge16_desc(Y); merge_prune16(X, Y);
#pragma unroll
        for (int i = 0; i < 16; ++i) Y[i] = shx(X[i], 32, lane);
        merge_prune16(X, Y);
        const float mx = s2f(X[0] & ~255);
        float ex[16], den = 0.f;
#pragma unroll
        for (int i = 0; i < 16; ++i) { ex[i] = __builtin_amdgcn_exp2f((s2f(X[i] & ~255) - mx) * 1.4426950408889634f); den += ex[i]; }
        const float rden = 1.0f / den;
        int oi[8]; float og[8];
#pragma unroll
        for (int t = 0; t < 8; ++t) {
            const int msk = -hh;
            const int code = (X[t] ^ ((X[t] ^ X[8 + t]) & msk)) & 255;
            const int e1 = lut[(code >> 4) * 512 + tid], e2 = lut[(16 + (code & 15)) * 512 + tid];
            const int exl = __builtin_bit_cast(int, ex[t]), exh = __builtin_bit_cast(int, ex[8 + t]);
            oi[t] = e1 * 128 + e2; og[t] = __builtin_bit_cast(float, exl ^ ((exl ^ exh) & msk)) * rden;
        }
        int* ip = IDXp + lrow * 128 + h * 16 + 8 * hh; float* gp = GTp + lrow * 128 + h * 16 + 8 * hh;
        *(GAS v4u*)ip = (v4u){(unsigned)oi[0], (unsigned)oi[1], (unsigned)oi[2], (unsigned)oi[3]}; *(GAS v4u*)(ip + 4) = (v4u){(unsigned)oi[4], (unsigned)oi[5], (unsigned)oi[6], (unsigned)oi[7]};
        *(GAS f32x4*)gp = (f32x4){og[0], og[1], og[2], og[3]}; *(GAS f32x4*)(gp + 4) = (f32x4){og[4], og[5], og[6], og[7]};
    }
}

typedef float f32x2v __attribute__((ext_vector_type(2)));
__device__ __forceinline__ void quant_row_fp8(const float* src, unsigned char* dst, float* sc_out, int lane) {
    const GAS f32x4* s = (const GAS f32x4*)src + 4 * lane;
    f32x4 v[4]; float m = 0.f;
#pragma unroll
    for (int j = 0; j < 4; ++j) { v[j] = s[j]; m = fmaxf(m, fmaxf(fmaxf(fabsf(v[j].x), fabsf(v[j].y)), fmaxf(fabsf(v[j].z), fabsf(v[j].w)))); }
#pragma unroll
    for (int o = 1; o < 64; o <<= 1) m = fmaxf(m, shx(m, o, lane));
    const float sc = m > 0.f ? 224.0f / m : 1.0f;
    v4u w;
    { int t = 0; t = __builtin_amdgcn_cvt_pk_fp8_f32(v[0].x * sc, v[0].y * sc, t, false); t = __builtin_amdgcn_cvt_pk_fp8_f32(v[0].z * sc, v[0].w * sc, t, true); w.x = (unsigned)t; }
    { int t = 0; t = __builtin_amdgcn_cvt_pk_fp8_f32(v[1].x * sc, v[1].y * sc, t, false); t = __builtin_amdgcn_cvt_pk_fp8_f32(v[1].z * sc, v[1].w * sc, t, true); w.y = (unsigned)t; }
    { int t = 0; t = __builtin_amdgcn_cvt_pk_fp8_f32(v[2].x * sc, v[2].y * sc, t, false); t = __builtin_amdgcn_cvt_pk_fp8_f32(v[2].z * sc, v[2].w * sc, t, true); w.z = (unsigned)t; }
    { int t = 0; t = __builtin_amdgcn_cvt_pk_fp8_f32(v[3].x * sc, v[3].y * sc, t, false); t = __builtin_amdgcn_cvt_pk_fp8_f32(v[3].z * sc, v[3].w * sc, t, true); w.w = (unsigned)t; }
    *(GAS v4u*)(dst + 16 * lane) = w;
    if (lane == 0) *sc_out = m > 0.f ? m * (1.0f / 224.0f) : 1.0f;
}
__device__ __forceinline__ void dq4(unsigned w, float (&f)[4]) {
    const f32x2v lo = __builtin_amdgcn_cvt_pk_f32_fp8((int)w, false), hi = __builtin_amdgcn_cvt_pk_f32_fp8((int)w, true);
    f[0] = lo.x; f[1] = lo.y; f[2] = hi.x; f[3] = hi.y;
}
__device__ __forceinline__ float dot16_fp8(const v4u u, const float (&h)[16]) {
    float f0[4], f1[4], f2[4], f3[4]; dq4(u.x, f0); dq4(u.y, f1); dq4(u.z, f2); dq4(u.w, f3);
    float a = f0[0] * h[0], b = f1[0] * h[4], c = f2[0] * h[8], d = f3[0] * h[12];
    a = fmaf(f0[1], h[1], a); b = fmaf(f1[1], h[5], b); c = fmaf(f2[1], h[9], c); d = fmaf(f3[1], h[13], d);
    a = fmaf(f0[2], h[2], a); b = fmaf(f1[2], h[6], b); c = fmaf(f2[2], h[10], c); d = fmaf(f3[2], h[14], d);
    a = fmaf(f0[3], h[3], a); b = fmaf(f1[3], h[7], b); c = fmaf(f2[3], h[11], c); d = fmaf(f3[3], h[15], d);
    return (a + b) + (c + d);
}
__device__ __forceinline__ void fma16_fp8(float (&o)[16], float cf, const v4u v) {
    float f0[4], f1[4], f2[4], f3[4]; dq4(v.x, f0); dq4(v.y, f1); dq4(v.z, f2); dq4(v.w, f3);
#pragma unroll
    for (int k = 0; k < 4; ++k) { o[k] = fmaf(cf, f0[k], o[k]); o[4 + k] = fmaf(cf, f1[k], o[4 + k]); o[8 + k] = fmaf(cf, f2[k], o[8 + k]); o[12 + k] = fmaf(cf, f3[k], o[12 + k]); }
}
#define RS_LEVEL(v, n, m) do { _Pragma("unroll") for (int _e = 0; _e < (n); ++_e) { const bool _up = (lane & (m)) != 0; const float _send = _up ? v[_e] : v[_e + (n)]; const float _keep = _up ? v[_e + (n)] : v[_e]; v[_e] = _keep + shx(_send, m, lane); } } while (0)
__device__ __forceinline__ void peer_panel(int panel, bf16* XN, const int* IDXp, const float* GTp, const unsigned char* EU8, const unsigned char* EV8, const float* SU, const float* SV, float* XIO, const int wid0) {
    const int tid = otid(wid0), lane = tid & 63, wid = __builtin_amdgcn_readfirstlane(tid >> 6);
    for (int ti = 0; ti < 32; ++ti) {
        const int lrow = wid * 32 + ti;
        const size_t row = (size_t)panel * 256 + lrow;
        const int i0 = IDXp[lrow * 128 + lane], i1 = IDXp[lrow * 128 + 64 + lane];
        const float g0 = GTp[lrow * 128 + lane], g1 = GTp[lrow * 128 + 64 + lane];
        const float su0 = SU[i0], su1 = SU[i1], sv0 = SV[i0], sv1 = SV[i1];
        float h[16];
        { const v4u hA = *(const GAS v4u*)(XN + row * DM + 16 * lane), hB = *(const GAS v4u*)(XN + row * DM + 16 * lane + 8);
          h[0] = bflo(hA.x); h[1] = bfhi(hA.x); h[2] = bflo(hA.y); h[3] = bfhi(hA.y); h[4] = bflo(hA.z); h[5] = bfhi(hA.z); h[6] = bflo(hA.w); h[7] = bfhi(hA.w);
          h[8] = bflo(hB.x); h[9] = bfhi(hB.x); h[10] = bflo(hB.y); h[11] = bfhi(hB.y); h[12] = bflo(hB.z); h[13] = bfhi(hB.z); h[14] = bflo(hB.w); h[15] = bfhi(hB.w); }
        float coef[2];
#pragma unroll
        for (int hf = 0; hf < 2; ++hf) {
            const int iv = hf ? i1 : i0;
            float q[4];
#pragma unroll
            for (int k = 0; k < 4; ++k) q[k] = 0.f;
#pragma unroll
            for (int c = 0; c < 4; ++c) {
                v4u ua[16];
#pragma unroll
                for (int j = 0; j < 16; ++j) { const int ex = __builtin_amdgcn_readlane(iv, c * 16 + j); ua[j] = *((const GAS v4u*)(EU8 + (size_t)ex * DM) + lane); }
                float p[16];
#pragma unroll
                for (int j = 0; j < 16; ++j) p[j] = dot16_fp8(ua[j], h);
                RS_LEVEL(p, 8, 8); RS_LEVEL(p, 4, 4); RS_LEVEL(p, 2, 2); RS_LEVEL(p, 1, 1);
                q[c] = p[0];
            }
            RS_LEVEL(q, 2, 32); RS_LEVEL(q, 1, 16);
            const float s = q[0] * (hf ? su1 : su0);
            const float act = 0.5f * s * (1.0f + erff(s * 0.70710678118654752f));
            coef[hf] = (hf ? g1 : g0) * act * (hf ? sv1 : sv0);
        }
        float o[16];
        { const GAS f32x4* xp = (const GAS f32x4*)(XIO + row * DM + 16 * lane);
#pragma unroll
          for (int k = 0; k < 4; ++k) { const f32x4 x = xp[k]; o[4 * k] = x.x; o[4 * k + 1] = x.y; o[4 * k + 2] = x.z; o[4 * k + 3] = x.w; } }
#pragma unroll
        for (int hf = 0; hf < 2; ++hf) {
            const int iv = hf ? i1 : i0; const float cv = coef[hf];
#pragma unroll
            for (int c = 0; c < 4; ++c) {
                v4u va[16];
#pragma unroll
                for (int j = 0; j < 16; ++j) { const int ex = __builtin_amdgcn_readlane(iv, c * 16 + j); va[j] = *((const GAS v4u*)(EV8 + (size_t)ex * DM) + lane); }
#pragma unroll
                for (int j = 0; j < 16; ++j) { const float cf = __builtin_bit_cast(float, __builtin_amdgcn_readlane(__builtin_bit_cast(int, cv), c * 16 + j)); fma16_fp8(o, cf, va[j]); }
            }
        }
        float ss = 0.f;
#pragma unroll
        for (int k = 0; k < 16; ++k) ss += o[k] * o[k];
        const float r = 1.f / sqrtf(wave_sum(ss, lane) * (1.f / DM) + RMS_EPS);
        { GAS f32x4* xp = (GAS f32x4*)(XIO + row * DM + 16 * lane);
#pragma unroll
          for (int k = 0; k < 4; ++k) xp[k] = (f32x4){o[4 * k], o[4 * k + 1], o[4 * k + 2], o[4 * k + 3]}; }
        v4u ha, hb;
        ha.x = cvtpk(o[0] * r, o[1] * r); ha.y = cvtpk(o[2] * r, o[3] * r); ha.z = cvtpk(o[4] * r, o[5] * r); ha.w = cvtpk(o[6] * r, o[7] * r);
        hb.x = cvtpk(o[8] * r, o[9] * r); hb.y = cvtpk(o[10] * r, o[11] * r); hb.z = cvtpk(o[12] * r, o[13] * r); hb.w = cvtpk(o[14] * r, o[15] * r);
        *(GAS v4u*)(XN + row * DM + 16 * lane) = ha; *(GAS v4u*)(XN + row * DM + 16 * lane + 8) = hb;
    }
}

#define BS_STAGE(K, J) do { const bool lower_ = (lane & (J)) == 0; \
    { const int p_ = shx(k0, J, lane); const bool asc_ = ((lane & (K)) == 0); const int mn_ = k0 < p_ ? k0 : p_, mx_ = k0 < p_ ? p_ : k0; k0 = (lower_ == asc_) ? mn_ : mx_; } \
    { const int p_ = shx(k1, J, lane); const bool asc_ = (((lane + 64) & (K)) == 0); const int mn_ = k1 < p_ ? k1 : p_, mx_ = k1 < p_ ? p_ : k1; k1 = (lower_ == asc_) ? mn_ : mx_; } } while (0)
#ifndef PEER_BSHIFT
#define PEER_BSHIFT 11
#endif
constexpr int PEER_NB = 16384 >> PEER_BSHIFT;
__device__ __forceinline__ void peer_sort_panel(int* IDXp, float* GTp, float* SUp, unsigned char* STp, const float* SU, const float* SV, const int wid0) {
    const int tid = otid(wid0), lane = tid & 63, wid = __builtin_amdgcn_readfirstlane(tid >> 6);
    int ni0 = IDXp[wid * 32 * 128 + lane], ni1 = IDXp[wid * 32 * 128 + 64 + lane];
    float ng0 = GTp[wid * 32 * 128 + lane], ng1 = GTp[wid * 32 * 128 + 64 + lane];
    for (int ti = 0; ti < 32; ++ti) {
        const int lrow = wid * 32 + ti;
        const int i0 = ni0, i1 = ni1; const float g0 = ng0, g1 = ng1;
        if (ti < 31) { ni0 = IDXp[(lrow + 1) * 128 + lane]; ni1 = IDXp[(lrow + 1) * 128 + 64 + lane]; ng0 = GTp[(lrow + 1) * 128 + lane]; ng1 = GTp[(lrow + 1) * 128 + 64 + lane]; }
        const float u0 = SU[i0], u1 = SU[i1], w0 = SV[i0] * g0, w1 = SV[i1] * g1;
        int k0 = (i0 << 7) | lane, k1 = (i1 << 7) | (64 + lane);
        BS_STAGE(2, 1);
        BS_STAGE(4, 2); BS_STAGE(4, 1);
        BS_STAGE(8, 4); BS_STAGE(8, 2); BS_STAGE(8, 1);
        BS_STAGE(16, 8); BS_STAGE(16, 4); BS_STAGE(16, 2); BS_STAGE(16, 1);
        BS_STAGE(32, 16); BS_STAGE(32, 8); BS_STAGE(32, 4); BS_STAGE(32, 2); BS_STAGE(32, 1);
        BS_STAGE(64, 32); BS_STAGE(64, 16); BS_STAGE(64, 8); BS_STAGE(64, 4); BS_STAGE(64, 2); BS_STAGE(64, 1);
        { const int mn_ = k0 < k1 ? k0 : k1, mx_ = k0 < k1 ? k1 : k0; k0 = mn_; k1 = mx_; }
        BS_STAGE(128, 32); BS_STAGE(128, 16); BS_STAGE(128, 8); BS_STAGE(128, 4); BS_STAGE(128, 2); BS_STAGE(128, 1);
        const int s0 = k0 & 127, s1 = k1 & 127, e0 = k0 >> 7, e1 = k1 >> 7;
        const float ua0 = shl_(u0, s0 & 63), ub0 = shl_(u1, s0 & 63), ua1 = shl_(u0, s1 & 63), ub1 = shl_(u1, s1 & 63);
        const float wa0 = shl_(w0, s0 & 63), wb0 = shl_(w1, s0 & 63), wa1 = shl_(w0, s1 & 63), wb1 = shl_(w1, s1 & 63);
        IDXp[lrow * 128 + lane] = e0; IDXp[lrow * 128 + 64 + lane] = e1;
        SUp[lrow * 128 + lane] = (s0 < 64) ? ua0 : ub0; SUp[lrow * 128 + 64 + lane] = (s1 < 64) ? ua1 : ub1;
        GTp[lrow * 128 + lane] = (s0 < 64) ? wa0 : wb0; GTp[lrow * 128 + 64 + lane] = (s1 < 64) ? wa1 : wb1;
        int stv = 0;
#pragma unroll
        for (int r = 1; r < PEER_NB; ++r) { const int c = __builtin_popcountll(__ballot(e0 < (r << PEER_BSHIFT))) + __builtin_popcountll(__ballot(e1 < (r << PEER_BSHIFT))); stv = (lane == r) ? c : stv; }
        stv = (lane == PEER_NB) ? 128 : stv;
        if (lane < 32) STp[lrow * 32 + lane] = (unsigned char)stv;
    }
}
__device__ __forceinline__ void peer_usweep_panel(int panel, const bf16* XN, const int* IDXp, const float* GMp, const float* SUp, float* CFp, const unsigned char* EU8, const int wid0) {
    const int tid = otid(wid0), lane = tid & 63, wid = __builtin_amdgcn_readfirstlane(tid >> 6);
    const int tq = (lane >> 3) & 1, pj = lane & 7;
    const size_t prow = (size_t)panel * 256;
    int ix_n; float gm_n, su_n; v4u hA0_n, hB0_n, hA1_n, hB1_n;
#define US_META(s_) do { const int c_ = (s_) >> 4, tp_ = (s_) & 15; const int lr_ = wid * 32 + 2 * tp_; const int off_ = (lr_ + tq) * 128 + 8 * c_ + pj; \
        ix_n = IDXp[off_]; gm_n = GMp[off_]; su_n = SUp[off_]; \
        const bf16* h0_ = XN + (prow + lr_) * DM + 16 * lane; hA0_n = *(const GAS v4u*)h0_; hB0_n = *(const GAS v4u*)(h0_ + 8); hA1_n = *(const GAS v4u*)(h0_ + DM); hB1_n = *(const GAS v4u*)(h0_ + DM + 8); } while (0)
    US_META(0);
    for (int s = 0; s < 256; ++s) {
        const int ix = ix_n; const float gm = gm_n, su = su_n; const v4u hA0 = hA0_n, hB0 = hB0_n, hA1 = hA1_n, hB1 = hB1_n;
        v4u ua[16];
#pragma unroll
        for (int j = 0; j < 16; ++j) { const int ex = __builtin_amdgcn_readlane(ix, j); ua[j] = *((const GAS v4u*)(EU8 + (size_t)ex * DM) + lane); }
        if (s < 255) US_META(s + 1);
        float h[16], p[16];
        h[0] = bflo(hA0.x); h[1] = bfhi(hA0.x); h[2] = bflo(hA0.y); h[3] = bfhi(hA0.y); h[4] = bflo(hA0.z); h[5] = bfhi(hA0.z); h[6] = bflo(hA0.w); h[7] = bfhi(hA0.w);
        h[8] = bflo(hB0.x); h[9] = bfhi(hB0.x); h[10] = bflo(hB0.y); h[11] = bfhi(hB0.y); h[12] = bflo(hB0.z); h[13] = bfhi(hB0.z); h[14] = bflo(hB0.w); h[15] = bfhi(hB0.w);
#pragma unroll
        for (int j = 0; j < 8; ++j) p[j] = dot16_fp8(ua[j], h);
        h[0] = bflo(hA1.x); h[1] = bfhi(hA1.x); h[2] = bflo(hA1.y); h[3] = bfhi(hA1.y); h[4] = bflo(hA1.z); h[5] = bfhi(hA1.z); h[6] = bflo(hA1.w); h[7] = bfhi(hA1.w);
        h[8] = bflo(hB1.x); h[9] = bfhi(hB1.x); h[10] = bflo(hB1.y); h[11] = bfhi(hB1.y); h[12] = bflo(hB1.z); h[13] = bfhi(hB1.z); h[14] = bflo(hB1.w); h[15] = bfhi(hB1.w);
#pragma unroll
        for (int j = 8; j < 16; ++j) p[j] = dot16_fp8(ua[j], h);
        RS_LEVEL(p, 8, 8); RS_LEVEL(p, 4, 4); RS_LEVEL(p, 2, 2); RS_LEVEL(p, 1, 1);
        float d = p[0]; d += shx(d, 16, lane); d += shx(d, 32, lane);
        const float sx = d * su;
        const float act = 0.5f * sx * (1.0f + erff(sx * 0.70710678118654752f));
        const int c = s >> 4, tp = s & 15;
        if (lane < 16) CFp[(wid * 32 + 2 * tp + tq) * 128 + 8 * c + pj] = gm * act;
    }
#undef US_META
}
__device__ __forceinline__ void peer_v_panel(int panel, bf16* XN, const int* IDXp, const float* CFp, const unsigned char* EV8, float* XIO, const int wid0) {
    const int tid = otid(wid0), lane = tid & 63, wid = __builtin_amdgcn_readfirstlane(tid >> 6);
    for (int ti = 0; ti < 32; ++ti) {
        const int lrow = wid * 32 + ti;
        const size_t row = (size_t)panel * 256 + lrow;
        const int i0 = IDXp[lrow * 128 + lane], i1 = IDXp[lrow * 128 + 64 + lane];
        const float c0 = CFp[lrow * 128 + lane], c1 = CFp[lrow * 128 + 64 + lane];
        float o[16];
        { const GAS f32x4* xp = (const GAS f32x4*)(XIO + row * DM + 16 * lane);
#pragma unroll
          for (int k = 0; k < 4; ++k) { const f32x4 x = xp[k]; o[4 * k] = x.x; o[4 * k + 1] = x.y; o[4 * k + 2] = x.z; o[4 * k + 3] = x.w; } }
#pragma unroll
        for (int hf = 0; hf < 2; ++hf) {
            const int iv = hf ? i1 : i0; const float cv = hf ? c1 : c0;
#pragma nounroll
            for (int c = 0; c < 4; ++c) {
                v4u va[16];
#pragma unroll
                for (int j = 0; j < 16; ++j) { const int ex = __builtin_amdgcn_readlane(iv, c * 16 + j); va[j] = *((const GAS v4u*)(EV8 + (size_t)ex * DM) + lane); }
#pragma unroll
                for (int j = 0; j < 16; ++j) { const float cf = __builtin_bit_cast(float, __builtin_amdgcn_readlane(__builtin_bit_cast(int, cv), c * 16 + j)); fma16_fp8(o, cf, va[j]); }
            }
        }
        float ss = 0.f;
#pragma unroll
        for (int k = 0; k < 16; ++k) ss += o[k] * o[k];
        const float r = 1.f / sqrtf(wave_sum(ss, lane) * (1.f / DM) + RMS_EPS);
        { GAS f32x4* xp = (GAS f32x4*)(XIO + row * DM + 16 * lane);
#pragma unroll
          for (int k = 0; k < 4; ++k) xp[k] = (f32x4){o[4 * k], o[4 * k + 1], o[4 * k + 2], o[4 * k + 3]}; }
        v4u ha, hb;
        ha.x = cvtpk(o[0] * r, o[1] * r); ha.y = cvtpk(o[2] * r, o[3] * r); ha.z = cvtpk(o[4] * r, o[5] * r); ha.w = cvtpk(o[6] * r, o[7] * r);
        hb.x = cvtpk(o[8] * r, o[9] * r); hb.y = cvtpk(o[10] * r, o[11] * r); hb.z = cvtpk(o[12] * r, o[13] * r); hb.w = cvtpk(o[14] * r, o[15] * r);
        *(GAS v4u*)(XN + row * DM + 16 * lane) = ha; *(GAS v4u*)(XN + row * DM + 16 * lane + 8) = hb;
    }
}

__device__ __forceinline__ void peer_vsweep_panel(int panel, bf16* XN, const int* IDXp, const float* CFp, const unsigned char* EV8, float* XIO, const int wid0) {
    const int wid = wid0;
    const size_t prow = (size_t)panel * 256;
#pragma nounroll
    for (int g = 0; g < 4; ++g) {
        const int lane = lane_id();
        const int lr0 = wid * 32 + 8 * g;
        float o[8][16];
#pragma unroll
        for (int t = 0; t < 8; ++t) { const GAS f32x4* xp = (const GAS f32x4*)(XIO + (prow + lr0 + t) * DM + 16 * lane);
#pragma unroll
            for (int k = 0; k < 4; ++k) { const f32x4 x = xp[k]; o[t][4 * k] = x.x; o[t][4 * k + 1] = x.y; o[t][4 * k + 2] = x.z; o[t][4 * k + 3] = x.w; } }
        const int moff = (lr0 + (lane >> 3)) * 128 + (lane & 7);
        int ix_n = IDXp[moff]; float cf_n = CFp[moff];
#pragma nounroll
        for (int c = 0; c < 16; ++c) {
            const int ix = ix_n; const float cf = cf_n;
            if (c < 15) { ix_n = IDXp[moff + 8 * (c + 1)]; cf_n = CFp[moff + 8 * (c + 1)]; }
#pragma unroll
            for (int b = 0; b < 8; ++b) {
                v4u va[8];
#pragma unroll
                for (int j = 0; j < 8; ++j) { const int ex = __builtin_amdgcn_readlane(ix, 8 * b + j); va[j] = *((const GAS v4u*)(EV8 + (size_t)ex * DM) + lane); }
#pragma unroll
                for (int j = 0; j < 8; ++j) { const float cfi = __builtin_bit_cast(float, __builtin_amdgcn_readlane(__builtin_bit_cast(int, cf), 8 * b + j)); fma16_fp8(o[b], cfi, va[j]); }
            }
        }
        const int lane2 = lane_id();
#pragma unroll
        for (int t = 0; t < 8; ++t) {
            const size_t row = prow + lr0 + t;
            float ss = 0.f;
#pragma unroll
            for (int k = 0; k < 16; ++k) ss += o[t][k] * o[t][k];
            const float r = 1.f / sqrtf(wave_sum(ss, lane2) * (1.f / DM) + RMS_EPS);
            GAS f32x4* xp = (GAS f32x4*)(XIO + row * DM + 16 * lane2);
#pragma unroll
            for (int k = 0; k < 4; ++k) xp[k] = (f32x4){o[t][4 * k], o[t][4 * k + 1], o[t][4 * k + 2], o[t][4 * k + 3]};
            v4u ha, hb;
            ha.x = cvtpk(o[t][0] * r, o[t][1] * r); ha.y = cvtpk(o[t][2] * r, o[t][3] * r); ha.z = cvtpk(o[t][4] * r, o[t][5] * r); ha.w = cvtpk(o[t][6] * r, o[t][7] * r);
            hb.x = cvtpk(o[t][8] * r, o[t][9] * r); hb.y = cvtpk(o[t][10] * r, o[t][11] * r); hb.z = cvtpk(o[t][12] * r, o[t][13] * r); hb.w = cvtpk(o[t][14] * r, o[t][15] * r);
            *(GAS v4u*)(XN + row * DM + 16 * lane2) = ha; *(GAS v4u*)(XN + row * DM + 16 * lane2 + 8) = hb;
        }
    }
}


struct Args {
    const float *x, *p, *norm_mix, *w_in, *w_att_up, *w_pool_group, *pool_scale, *w_out, *norm_ffn, *w_query, *sub_keys, *expert_u, *expert_v, *norm_ple, *w_ple_gate, *w_ple, *norm_final;
    float* out; unsigned char* ws; int ph_hi, pad;
};

#ifndef REP_P0
#define REP_P0 1
#endif
#ifndef REP_P1
#define REP_P1 1
#endif
#ifndef REP_P23
#define REP_P23 1
#endif
#ifndef REP_P4
#define REP_P4 1
#endif
#ifndef REP_P567
#define REP_P567 1
#endif
#ifndef REP_P9
#define REP_P9 1
#endif
#ifndef REP_ATT
#define REP_ATT 1
#endif
#ifndef REP_TOPK
#define REP_TOPK 1
#endif
#ifndef REP_MRG
#define REP_MRG 1
#endif
#ifndef MK_PH_HI
#define MK_PH_HI 99
#endif

typedef const __attribute__((address_space(4))) Args* CArgs;
__device__ __forceinline__ CArgs kargs() { CArgs p = (CArgs)__builtin_amdgcn_kernarg_segment_ptr(); asm volatile("" : "+s"(p)); return p; }
#define WSP(T, off) ((T*)(kargs()->ws + (off)))
__global__ void __launch_bounds__(NTHR, 2) mega_fwd(Args a_unused) {
    extern __shared__ __attribute__((aligned(16))) unsigned char lds_raw[];
    LAS unsigned char* lds = (LAS unsigned char*)lds_raw;
    volatile LAS unsigned* MISC = (volatile LAS unsigned*)(lds + MISC_OFF);
    const int G = gridDim.x; const int bx = blockIdx.x;
    const int vcu = (G % 8 == 0) ? (bx % 8) * (G / 8) + bx / 8 : bx;
    gu32* ctl = (gu32*)(kargs()->ws + WS_CTL);
    const int wid0 = __builtin_amdgcn_readfirstlane((int)threadIdx.x >> 6);
#define IS_T0 (otid(wid0) == 0)
    for (int u = otid(wid0); u < (LDS_BYTES - LDSCTL_OFF) / 4; u += NTHR) ((LAS unsigned*)(lds + LDSCTL_OFF))[u] = 0u;
    __syncthreads();
    (void)xcd_barrier_post((unsigned*)(ctl + CW_BAR), MISC + 8, IS_T0);
#define GRID_BAR() do { XcdBarrier _b; _b.bar = (unsigned*)((gu32*)(kargs()->ws + WS_CTL) + CW_BAR); _b.x = xb_xcc_id(); _b.st = (volatile LAS unsigned*)(lds + MISC_OFF) + 8; xcd_barrier(_b, IS_T0); } while (0)
#define LOCAL_SEAM() do { VM_WAIT(); __syncthreads(); if (IS_T0) { __builtin_amdgcn_fence(__ATOMIC_ACQUIRE, "agent"); VM_WAIT(); } __syncthreads(); } while (0)

    for (int rep_ = 0; rep_ < REP_P0; ++rep_) {
        const int tid = otid(wid0), lane = tid & 63, wid = __builtin_amdgcn_readfirstlane(tid >> 6);
        const CArgs a = kargs(); unsigned char* ws = a->ws;
        bf16 *WIN = (bf16*)(ws + WS_WIN), *WOUT = (bf16*)(ws + WS_WOUT), *WQ = (bf16*)(ws + WS_WQ), *WPG = (bf16*)(ws + WS_WPG), *WPLE = (bf16*)(ws + WS_WPLE);
        bf16 *BDA = (bf16*)(ws + WS_BDA), *BDP = (bf16*)(ws + WS_BDP), *SK = (bf16*)(ws + WS_SK), *XN = (bf16*)(ws + WS_XN);
        LAS float* scr = (LAS float*)(lds + wid * 16384);
        const int gw = vcu * NWAVES + wid, NGW = G * NWAVES;
        constexpr int I_IN = (1024 / 64) * (4096 / 32), I_OUT = (1024 / 64) * (1024 / 32), I_Q = (1024 / 64) * (2048 / 32), I_PG = I_OUT, I_PLE = (256 / 64) * (1024 / 32);
        constexpr int NITEMS = I_IN + I_OUT + I_Q + I_PG + I_PLE;
        for (int it = gw; it < NITEMS; it += NGW) {
            int r = it;
            if (r < I_IN) { p0_transpose_item(a->w_in, 1024, 4096, WIN, a->norm_mix, 512, C2, scr, r, lane); continue; } r -= I_IN;
            if (r < I_OUT) { p0_transpose_item(a->w_out, 1024, 1024, WOUT, nullptr, 0, 1.f, scr, r, lane); continue; } r -= I_OUT;
            if (r < I_Q) { p0_transpose_item(a->w_query, 1024, 2048, WQ, a->norm_ffn, 0, 1.f, scr, r, lane); continue; } r -= I_Q;
            if (r < I_PG) { p0_transpose_item(a->w_ple_gate, 1024, 1024, WPG, a->norm_ple, 0, 1.f, scr, r, lane); continue; } r -= I_PG;
            p0_transpose_item(a->w_ple, 256, 1024, WPLE, nullptr, 0, 1.f, scr, r, lane);
        }
        const int gt = vcu * NTHR + tid, NGT = G * NTHR;
        for (int it = gt; it < 1024 * 16; it += NGT) {
            const int n = it >> 4, k8 = (it & 15) * 8, head = n >> 7, g = n >> 8;
            float va[8], vp[8]; const float ps = a->pool_scale[n];
#pragma unroll
            for (int j = 0; j < 8; ++j) {
                const int k = k8 + j;
                va[j] = ((k >> 6) == (head & 1)) ? a->w_att_up[((size_t)head * 64 + (k & 63)) * 128 + (n & 127)] : 0.f;
                vp[j] = a->w_pool_group[((size_t)g * 128 + k) * 256 + (n & 255)] * ps;
            }
            v4u o; o.x = pk2(va[0], va[1]); o.y = pk2(va[2], va[3]); o.z = pk2(va[4], va[5]); o.w = pk2(va[6], va[7]);
            *(GAS v4u*)(BDA + (size_t)n * 128 + k8) = o;
            o.x = pk2(vp[0], vp[1]); o.y = pk2(vp[2], vp[3]); o.z = pk2(vp[4], vp[5]); o.w = pk2(vp[6], vp[7]);
            *(GAS v4u*)(BDP + (size_t)n * 128 + k8) = o;
        }
        for (int it = gt; it < 16 * 128 * 128 / 8; it += NGT) cvt8_store(a->sub_keys + (size_t)it * 8, SK + (size_t)it * 8);
        for (int rr = gw; rr < 2 * 16384; rr += NGW) { const int e = rr >> 1;
            if (rr & 1) quant_row_fp8(a->expert_v + (size_t)e * DM, ws + WS_EV + (size_t)e * DM, (float*)(ws + WS_SV) + e, lane);
            else quant_row_fp8(a->expert_u + (size_t)e * DM, ws + WS_EU + (size_t)e * DM, (float*)(ws + WS_SU) + e, lane); }
        { const int panel = bx;
            for (int r = wid; r < 256; r += NWAVES) { const size_t row = (size_t)panel * 256 + r; rms_row_to_bf16(a->x + row * DM, XN + row * DM, lane); } }
    }
    GRID_BAR();

    for (int rep_ = 0; rep_ < REP_P1; ++rep_) {
        { const int panel = bx;
            { pg8::Gemm g{WSP(bf16, WS_XN), WSP(bf16, WS_WIN), 1024, 1024, 1024, 0}; pg8::PanelSched S{panel, 14, 4, 2, 0}; pg8::EpiProj E{WSP(bf16, WS_PQ), WSP(bf16, WS_PK), WSP(bf16, WS_PU), WSP(bf16, WS_PG)};
              pg8::gemm_phase<pg8::EpiProj, pg8::PanelSched, true, true>(lds, g, S, E, wid0); }
            { pg8::Gemm g{WSP(bf16, WS_WIN) + (size_t)1024 * 1024, WSP(bf16, WS_XN), 1024, 1024, 1024, 0}; pg8::PanelSched S{panel, 2, 99, 0, 1}; pg8::EpiPlain E{WSP(bf16, WS_PVT), TOK};
              pg8::gemm_phase<pg8::EpiPlain, pg8::PanelSched, true, true>(lds, g, S, E, wid0); }
        }
    }
    GRID_BAR();

    { const int panel = bx;
        const size_t prow = (size_t)panel * 256;
        for (int rep_ = 0; rep_ < REP_P23; ++rep_) {
        if (MK_PH_HI > 2) { for (int r2_ = 0; r2_ < REP_ATT; ++r2_) attn_panel(panel, WSP(bf16, WS_PQ), WSP(bf16, WS_PK), WSP(bf16, WS_PVT), WSP(bf16, WS_YA), wid0); pool_panel(panel, WSP(bf16, WS_PU), WSP(bf16, WS_YP), wid0); LOCAL_SEAM(); }
        for (int r2_ = 0; r2_ < REP_MRG; ++r2_)
        if (MK_PH_HI > 3) {
            { pg8::Gemm g{WSP(bf16, WS_YA), WSP(bf16, WS_BDA), 128, 512, 128, 128}; pg8::PanelSched S{panel, 4, 99, 0, 0}; pg8::EpiMerge<false> E{WSP(bf16, WS_PG), WSP(bf16, WS_MG), 0};
              pg8::gemm_phase<pg8::EpiMerge<false>, pg8::PanelSched, true, true>(lds, g, S, E, wid0); }
            { pg8::Gemm g{WSP(bf16, WS_YP), WSP(bf16, WS_BDP), 128, 512, 128, 128}; pg8::PanelSched S{panel, 4, 99, 0, 0}; pg8::EpiMerge<true> E{WSP(bf16, WS_PG), WSP(bf16, WS_MG), 1024};
              pg8::gemm_phase<pg8::EpiMerge<true>, pg8::PanelSched, true, true>(lds, g, S, E, wid0); }
            LOCAL_SEAM();
        }
        }
        for (int rep_ = 0; rep_ < REP_P4; ++rep_)
        if (MK_PH_HI > 4) {
            { pg8::Gemm g{WSP(bf16, WS_MG), WSP(bf16, WS_WOUT), 1024, 1024, 1024, 0}; pg8::PanelSched S{panel, 4, 99, 0, 0}; pg8::EpiRes E{kargs()->x, kargs()->out};
              pg8::gemm_phase<pg8::EpiRes, pg8::PanelSched, true, true>(lds, g, S, E, wid0); }
            LOCAL_SEAM();
        }
        for (int rep_ = 0; rep_ < REP_P567; ++rep_) {
        if (MK_PH_HI > 5) {
            { const int tid = otid(wid0), lane = tid & 63, wid = __builtin_amdgcn_readfirstlane(tid >> 6); const float* xo = kargs()->out; bf16* XN = WSP(bf16, WS_XN); for (int r = wid; r < 256; r += NWAVES) rms_row_to_bf16(xo + (prow + r) * DM, XN + (prow + r) * DM, lane); }
            LOCAL_SEAM();
        }
        if (MK_PH_HI > 6) {
            { pg8::Gemm g{WSP(bf16, WS_XN), WSP(bf16, WS_WQ), 1024, 1024, 1024, 0}; pg8::PanelSched S{panel, 8, 99, 0, 0}; pg8::EpiPlain E{WSP(bf16, WS_PG), 2048};
              pg8::gemm_phase<pg8::EpiPlain, pg8::PanelSched, true, true>(lds, g, S, E, wid0); }
            LOCAL_SEAM();
        }
        #define IDXP ((int*)(kargs()->ws + WS_YA + (size_t)panel * 262144))
#define GTP ((float*)(kargs()->ws + WS_YA + (size_t)panel * 262144 + 131072))
        if (MK_PH_HI > 7) { for (int r2_ = 0; r2_ < REP_TOPK; ++r2_) topk_panel(panel, WSP(bf16, WS_PG), WSP(bf16, WS_SK), IDXP, GTP, (LAS int*)lds, wid0); LOCAL_SEAM(); }
        }
#ifndef PEER_SWEEP
#define PEER_SWEEP 1
#endif
#define STP ((unsigned char*)(kargs()->ws + WS_YP + (size_t)panel * 262144))
#define CFP ((float*)(kargs()->ws + WS_YP + (size_t)panel * 262144 + 131072))
#define SUSP ((float*)(kargs()->ws + WS_MG + (size_t)panel * 524288))
        if (MK_PH_HI > 8) {
            if (PEER_SWEEP) {
                peer_sort_panel(IDXP, GTP, SUSP, STP, WSP(float, WS_SU), WSP(float, WS_SV), wid0); LOCAL_SEAM();
                peer_usweep_panel(panel, WSP(bf16, WS_XN), IDXP, GTP, SUSP, CFP, WSP(unsigned char, WS_EU), wid0); LOCAL_SEAM();
#ifndef PEER_VSWEEP
#define PEER_VSWEEP 1
#endif
                if (PEER_VSWEEP) peer_vsweep_panel(panel, WSP(bf16, WS_XN), IDXP, CFP, WSP(unsigned char, WS_EV), kargs()->out, wid0);
                else peer_v_panel(panel, WSP(bf16, WS_XN), IDXP, CFP, WSP(unsigned char, WS_EV), kargs()->out, wid0);
                LOCAL_SEAM();
            } else { peer_panel(panel, WSP(bf16, WS_XN), IDXP, GTP, WSP(unsigned char, WS_EU), WSP(unsigned char, WS_EV), WSP(float, WS_SU), WSP(float, WS_SV), kargs()->out, wid0); LOCAL_SEAM(); }
        }
        for (int rep_ = 0; rep_ < REP_P9; ++rep_)
        if (MK_PH_HI > 9) {
            { const int tid = otid(wid0); const float* pp = kargs()->p; bf16* YP = WSP(bf16, WS_YP); for (int it = tid; it < 256 * 256 / 8; it += NTHR) { const int r = it >> 5, c8 = (it & 31) * 8; cvt8_store(pp + (prow + r) * 256 + c8, YP + (prow + r) * 512 + c8); } }
            LOCAL_SEAM();
            { pg8::Gemm g{WSP(bf16, WS_YP), WSP(bf16, WS_WPLE), 256, 512, 256, 0}; pg8::PanelSched S{panel, 4, 99, 0, 0}; pg8::EpiPlain E{WSP(bf16, WS_MG), 1024};
              pg8::gemm_phase<pg8::EpiPlain, pg8::PanelSched, true, true>(lds, g, S, E, wid0); }
            LOCAL_SEAM();
        }
        if (MK_PH_HI > 10) {
            { pg8::Gemm g{WSP(bf16, WS_XN), WSP(bf16, WS_WPG), 1024, 1024, 1024, 0}; pg8::PanelSched S{panel, 4, 99, 0, 0}; pg8::EpiGate E{kargs()->out, WSP(bf16, WS_MG)};
              pg8::gemm_phase<pg8::EpiGate, pg8::PanelSched, true, true>(lds, g, S, E, wid0); }
            LOCAL_SEAM();
        }
        if (MK_PH_HI > 11) {
            const int tid = otid(wid0), lane = tid & 63, wid = __builtin_amdgcn_readfirstlane(tid >> 6);
            for (int r = wid; r < 256; r += NWAVES) {
                GAS f32x4* xr = (GAS f32x4*)(kargs()->out + (prow + r) * DM) + lane; const GAS f32x4* gr = (const GAS f32x4*)kargs()->norm_final + lane;
                f32x4 v[4]; float s = 0.f;
#pragma unroll
                for (int j = 0; j < 4; ++j) { v[j] = xr[64 * j]; s += (v[j].x * v[j].x + v[j].y * v[j].y) + (v[j].z * v[j].z + v[j].w * v[j].w); }
                const float rr = 1.f / sqrtf(wave_sum(s, lane) * (1.f / DM) + RMS_EPS);
#pragma unroll
                for (int j = 0; j < 4; ++j) xr[64 * j] = v[j] * rr * gr[64 * j];
            }
        }
    }
#undef LOCAL_SEAM
}


#if MK_PH_HI < 99
namespace ref {
constexpr int D = 1024, NB = 8, S = 8192, T = NB * S;
constexpr int INW = 4096;
constexpr int NKEYS = 128, TOPK = 16, PH = 8;
constexpr float EPS = 1e-6f;

__device__ __forceinline__ float wave_sum(float v) {
#pragma unroll
    for (int o = 32; o > 0; o >>= 1) v += __shfl_xor(v, o);
    return v;
}
__device__ __forceinline__ float sigmoidf_(float x) { return 1.f / (1.f + expf(-x)); }

__global__ void __launch_bounds__(256) k_rms(const float* x, const float* g, float* out) {
    __shared__ float red[4];
    const size_t row = blockIdx.x;
    const float4 v = ((const float4*)(x + row * D))[threadIdx.x];
    float s = v.x * v.x + v.y * v.y + v.z * v.z + v.w * v.w;
    s = wave_sum(s);
    if ((threadIdx.x & 63) == 0) red[threadIdx.x >> 6] = s;
    __syncthreads();
    const float tot = red[0] + red[1] + red[2] + red[3];
    const float r = rsqrtf(tot * (1.f / D) + EPS);
    const float4 gg = ((const float4*)g)[threadIdx.x];
    float4 o; o.x = v.x * r * gg.x; o.y = v.y * r * gg.y; o.z = v.z * r * gg.z; o.w = v.w * r * gg.w;
    ((float4*)(out + row * D))[threadIdx.x] = o;
}

struct EpiStore { float* C; int ldc; int pad; __device__ void operator()(int r, int c, float v) const { C[(size_t)r * ldc + c] = v; } };
struct EpiResAdd { const float* R; float* C; int ldc; int pad; __device__ void operator()(int r, int c, float v) const { C[(size_t)r * ldc + c] = R[(size_t)r * ldc + c] + v; } };
struct EpiGate { const float* X; const float* E; float* C; int ldc; int pad;
    __device__ void operator()(int r, int c, float v) const { const size_t o = (size_t)r * ldc + c; C[o] = X[o] + sigmoidf_(v) * E[o]; } };

template <class Epi>
__global__ void __launch_bounds__(256) k_gemm(const float* __restrict__ A, const float* __restrict__ Bm, Epi epi, int lda, int ldb, int K, int pad_) {
    __shared__ float As[8][128 + 4];
    __shared__ float Bs[8][128 + 4];
    const int tid = threadIdx.x, tx = tid & 15, ty = tid >> 4;
    const int m0 = blockIdx.y * 128, n0 = blockIdx.x * 128;
    float acc[8][8];
#pragma unroll
    for (int i = 0; i < 8; ++i)
#pragma unroll
        for (int j = 0; j < 8; ++j) acc[i][j] = 0.f;
    const int ar = tid >> 1, ak = (tid & 1) * 4;
    const int bk = tid >> 5, bn = (tid & 31) * 4;
    for (int k0 = 0; k0 < K; k0 += 8) {
        const float4 av = *(const float4*)(A + (size_t)(m0 + ar) * lda + k0 + ak);
        const float4 bv = *(const float4*)(Bm + (size_t)(k0 + bk) * ldb + n0 + bn);
        As[ak + 0][ar] = av.x; As[ak + 1][ar] = av.y; As[ak + 2][ar] = av.z; As[ak + 3][ar] = av.w;
        *(float4*)&Bs[bk][bn] = bv;
        __syncthreads();
#pragma unroll
        for (int k = 0; k < 8; ++k) {
            const float4 a0 = *(const float4*)&As[k][ty * 8], a1 = *(const float4*)&As[k][ty * 8 + 4];
            const float4 b0 = *(const float4*)&Bs[k][tx * 8], b1 = *(const float4*)&Bs[k][tx * 8 + 4];
            const float a[8] = {a0.x, a0.y, a0.z, a0.w, a1.x, a1.y, a1.z, a1.w};
            const float b[8] = {b0.x, b0.y, b0.z, b0.w, b1.x, b1.y, b1.z, b1.w};
#pragma unroll
            for (int i = 0; i < 8; ++i)
#pragma unroll
                for (int j = 0; j < 8; ++j) acc[i][j] = fmaf(a[i], b[j], acc[i][j]);
        }
        __syncthreads();
    }
#pragma unroll
    for (int i = 0; i < 8; ++i)
#pragma unroll
        for (int j = 0; j < 8; ++j) epi(m0 + ty * 8 + i, n0 + tx * 8 + j, acc[i][j]);
}

__global__ void __launch_bounds__(64) k_attn(const float* __restrict__ proj, float* __restrict__ yatt) {
    const int t = blockIdx.x * 64 + threadIdx.x;
    const int h = blockIdx.y;
    float q[64], acc[64];
    const float* qp = proj + (size_t)t * INW + h * 64;
#pragma unroll
    for (int d = 0; d < 64; ++d) { q[d] = qp[d] * 0.125f; acc[d] = 0.f; }
    float surv = 1.f;
    for (int s = t - 1; s >= 0; --s) {
        const float* kp = proj + (size_t)s * INW + 512 + h * 64;
        float z = 0.f;
#pragma unroll
        for (int d = 0; d < 64; ++d) z = fmaf(q[d], kp[d], z);
        const float beta = 1.f / (1.f + expf(-z));
        const float w = beta * surv;
        const float* vp = kp + 512;
#pragma unroll
        for (int d = 0; d < 64; ++d) acc[d] = fmaf(w, vp[d], acc[d]);
        surv -= w;
        if (surv < 5.4e-20f) break;
    }
    float* o = yatt + (size_t)t * 512 + h * 64;
#pragma unroll
    for (int d = 0; d < 64; ++d) o[d] = acc[d];
}

__global__ void __launch_bounds__(256) k_pool(const float* __restrict__ proj, float* __restrict__ ypool) {
    const int i = blockIdx.x * 256 + threadIdx.x;
    const int t = i >> 9, c = i & 511, g = c >> 7, w = 2 << g;
    const int cnt = (t + 1 < w) ? (t + 1) : w;
    float s = 0.f;
    for (int j = 0; j < cnt; ++j) s += proj[(size_t)(t - j) * INW + 1536 + c];
    ypool[i] = s / (float)cnt - proj[(size_t)t * INW + 1536 + c];
}

__global__ void __launch_bounds__(256) k_merge(const float* __restrict__ proj, const float* __restrict__ yatt, const float* __restrict__ ypool,
                                               const float* __restrict__ wa, const float* __restrict__ wp, const float* __restrict__ pscale, float* __restrict__ merged) {
    const int t = blockIdx.x, tid = threadIdx.x;
    __shared__ float sa[512], sp[512];
    sa[tid] = yatt[(size_t)t * 512 + tid]; sa[tid + 256] = yatt[(size_t)t * 512 + tid + 256];
    sp[tid] = ypool[(size_t)t * 512 + tid]; sp[tid + 256] = ypool[(size_t)t * 512 + tid + 256];
    __syncthreads();
    for (int e = tid; e < D; e += 256) {
        const int h = e >> 7, ea = e & 127, g = e >> 8, ep = e & 255;
        float a = 0.f, p = 0.f;
        for (int d = 0; d < 64; ++d) a = fmaf(sa[h * 64 + d], wa[((size_t)h * 64 + d) * 128 + ea], a);
        for (int c = 0; c < 128; ++c) p = fmaf(sp[g * 128 + c], wp[((size_t)g * 128 + c) * 256 + ep], p);
        p *= pscale[e];
        const float ga = proj[(size_t)t * INW + 2048 + e], gp = proj[(size_t)t * INW + 3072 + e];
        merged[(size_t)t * D + e] = sigmoidf_(ga) * a + sigmoidf_(gp) * p;
    }
}

__global__ void __launch_bounds__(256) k_scores(const float* __restrict__ qp, const float* __restrict__ sk, float* __restrict__ sc) {
    const int t0 = blockIdx.x * 4, tid = threadIdx.x;
    __shared__ float sq[4][2048];
    for (int i = tid; i < 4 * 2048; i += 256) sq[i >> 11][i & 2047] = qp[(size_t)t0 * 2048 + i];
    __syncthreads();
    for (int j = tid; j < 2048; j += 256) {
        const int g = j >> 7;
        const float4* kr = (const float4*)(sk + (size_t)j * 128);
        float a0 = 0.f, a1 = 0.f, a2 = 0.f, a3 = 0.f;
        for (int d = 0; d < 32; ++d) {
            const float4 kv = kr[d];
            const float4 q0 = *(const float4*)&sq[0][g * 128 + d * 4], q1 = *(const float4*)&sq[1][g * 128 + d * 4];
            const float4 q2 = *(const float4*)&sq[2][g * 128 + d * 4], q3 = *(const float4*)&sq[3][g * 128 + d * 4];
            a0 = fmaf(q0.x, kv.x, a0); a0 = fmaf(q0.y, kv.y, a0); a0 = fmaf(q0.z, kv.z, a0); a0 = fmaf(q0.w, kv.w, a0);
            a1 = fmaf(q1.x, kv.x, a1); a1 = fmaf(q1.y, kv.y, a1); a1 = fmaf(q1.z, kv.z, a1); a1 = fmaf(q1.w, kv.w, a1);
            a2 = fmaf(q2.x, kv.x, a2); a2 = fmaf(q2.y, kv.y, a2); a2 = fmaf(q2.z, kv.z, a2); a2 = fmaf(q2.w, kv.w, a2);
            a3 = fmaf(q3.x, kv.x, a3); a3 = fmaf(q3.y, kv.y, a3); a3 = fmaf(q3.z, kv.z, a3); a3 = fmaf(q3.w, kv.w, a3);
        }
        sc[(size_t)(t0 + 0) * 2048 + j] = a0; sc[(size_t)(t0 + 1) * 2048 + j] = a1;
        sc[(size_t)(t0 + 2) * 2048 + j] = a2; sc[(size_t)(t0 + 3) * 2048 + j] = a3;
    }
}

__device__ __forceinline__ void wave_argmax(float& v, int& i) {
#pragma unroll
    for (int o = 32; o > 0; o >>= 1) {
        const float ov = __shfl_xor(v, o); const int oi = __shfl_xor(i, o);
        if (ov > v || (ov == v && oi < i)) { v = ov; i = oi; }
    }
}

__global__ void __launch_bounds__(256) k_topk(const float* __restrict__ sc, int* __restrict__ idx, float* __restrict__ gates) {
    const int wv = threadIdx.x >> 6, lane = threadIdx.x & 63;
    const int pair = blockIdx.x * 4 + wv;
    const int t = pair >> 3, h = pair & 7;
    __shared__ float stop[4][2][16];
    __shared__ int itop[4][2][16];
    for (int c = 0; c < 2; ++c) {
        const float* sr = sc + (size_t)t * 2048 + (h * 2 + c) * 128;
        float v0 = sr[lane], v1 = sr[lane + 64];
        for (int k = 0; k < TOPK; ++k) {
            float bv; int bi;
            if (v1 > v0) { bv = v1; bi = lane + 64; } else { bv = v0; bi = lane; }
            wave_argmax(bv, bi);
            if (lane == 0) { stop[wv][c][k] = bv; itop[wv][c][k] = bi; }
            if (bi == lane) v0 = -INFINITY;
            if (bi == lane + 64) v1 = -INFINITY;
        }
    }
    __syncthreads();
    float cv[4];
#pragma unroll
    for (int j = 0; j < 4; ++j) { const int p = lane + 64 * j; cv[j] = stop[wv][0][p >> 4] + stop[wv][1][p & 15]; }
    __shared__ float sbs[4][16];
    __shared__ int sbp[4][16];
    for (int k = 0; k < TOPK; ++k) {
        float bv = cv[0]; int bi = lane;
#pragma unroll
        for (int j = 1; j < 4; ++j) if (cv[j] > bv) { bv = cv[j]; bi = lane + 64 * j; }
        wave_argmax(bv, bi);
        if (lane == 0) { sbs[wv][k] = bv; sbp[wv][k] = bi; }
#pragma unroll
        for (int j = 0; j < 4; ++j) if (bi == lane + 64 * j) cv[j] = -INFINITY;
    }
    __syncthreads();
    const float mx = sbs[wv][0];
    const float myv = (lane < TOPK) ? sbs[wv][lane] : -INFINITY;
    const float ex = (lane < TOPK) ? expf(myv - mx) : 0.f;
    const float den = wave_sum(ex);
    if (lane < TOPK) {
        const int myp = sbp[wv][lane];
        const int e = itop[wv][0][myp >> 4] * NKEYS + itop[wv][1][myp & 15];
        idx[(size_t)t * 128 + h * 16 + lane] = e;
        gates[(size_t)t * 128 + h * 16 + lane] = ex / den;
    }
}

__global__ void __launch_bounds__(256) k_peer(const float* __restrict__ hn, const int* __restrict__ idx, const float* __restrict__ gates,
                                              const float* __restrict__ eu, const float* __restrict__ ev, float* xio) {
    const int t = blockIdx.x, tid = threadIdx.x, wv = tid >> 6, lane = tid & 63;
    __shared__ float coef[128];
    __shared__ int sidx[128];
    const float4* hr = (const float4*)(hn + (size_t)t * D);
    float4 hv[4];
#pragma unroll
    for (int j = 0; j < 4; ++j) hv[j] = hr[lane + 64 * j];
    if (tid < 128) sidx[tid] = idx[(size_t)t * 128 + tid];
    __syncthreads();
    for (int p = wv; p < 128; p += 4) {
        const float4* ur = (const float4*)(eu + (size_t)sidx[p] * D);
        float s = 0.f;
#pragma unroll
        for (int j = 0; j < 4; ++j) { const float4 u = ur[lane + 64 * j]; s += u.x * hv[j].x + u.y * hv[j].y + u.z * hv[j].z + u.w * hv[j].w; }
        s = wave_sum(s);
        const float act = 0.5f * s * (1.f + erff(s * 0.70710678118654752f));
        if (lane == 0) coef[p] = gates[(size_t)t * 128 + p] * act;
    }
    __syncthreads();
    float4 o = ((const float4*)(xio + (size_t)t * D))[tid];
    for (int p = 0; p < 128; ++p) {
        const float c = coef[p];
        const float4 v = ((const float4*)(ev + (size_t)sidx[p] * D))[tid];
        o.x = fmaf(c, v.x, o.x); o.y = fmaf(c, v.y, o.y); o.z = fmaf(c, v.z, o.z); o.w = fmaf(c, v.w, o.w);
    }
    ((float4*)(xio + (size_t)t * D))[tid] = o;
}

__global__ void __launch_bounds__(256) k_bf16_to_f32(const unsigned short* __restrict__ src, float* __restrict__ dst) {
    const size_t i = (size_t)blockIdx.x * 256 + threadIdx.x; dst[i] = __uint_as_float((unsigned)src[i] << 16);
}
__global__ void __launch_bounds__(128) k_gather_idx(const unsigned char* __restrict__ ya, int row0, int* __restrict__ idx, float* __restrict__ gates) {
    const int r = blockIdx.x, grow = row0 + r, panel = grow >> 8, lrow = grow & 255;
    const int* ip = (const int*)(ya + (size_t)panel * 262144); const float* gp = (const float*)(ya + (size_t)panel * 262144 + 131072);
    idx[(size_t)r * 128 + threadIdx.x] = ip[lrow * 128 + threadIdx.x]; gates[(size_t)r * 128 + threadIdx.x] = gp[lrow * 128 + threadIdx.x];
}
}
#endif

extern "C" void kernel_launch(void* const* d_in, const int* in_sizes, int n_in, void* d_out, int out_size, void* d_ws, size_t ws_size, hipStream_t stream) {
    static int grid = 0;
    if (grid == 0) {
        if (n_in != 17 || in_sizes[0] != TOK * DM || out_size != TOK * DM || ws_size < WS_END) { fprintf(stderr, "kernel_launch: unexpected shapes (n_in %d, in0 %d, out %d, ws %zu); nothing launched\n", n_in, n_in > 0 ? in_sizes[0] : -1, out_size, ws_size); grid = -1; return; }
        int dev = 0, cus = 0;
        if (hipGetDevice(&dev) != hipSuccess || hipDeviceGetAttribute(&cus, hipDeviceAttributeMultiprocessorCount, dev) != hipSuccess) { fprintf(stderr, "kernel_launch: device query failed\n"); grid = -1; return; }
        if (hipFuncSetAttribute((const void*)mega_fwd, hipFuncAttributeMaxDynamicSharedMemorySize, LDS_BYTES) != hipSuccess) { fprintf(stderr, "kernel_launch: hipFuncSetAttribute failed\n"); grid = -1; return; }
        int per_cu = 0;
        if (hipOccupancyMaxActiveBlocksPerMultiprocessor(&per_cu, (const void*)mega_fwd, NTHR, LDS_BYTES) != hipSuccess || per_cu < 1) fprintf(stderr, "kernel_launch: note: occupancy query reports %d workgroups per CU\n", per_cu);
        (void)hipGetLastError();
        if (cus != NPANEL) fprintf(stderr, "kernel_launch: note: %d CUs; this kernel is built for one 256-token panel per CU on a 256-CU device\n", cus);
        grid = NPANEL;
    }
    if (grid < 0) return;
    if (hipMemsetAsync((char*)d_ws + WS_CTL, 0, CTL_ZERO_BYTES, stream) != hipSuccess) { fprintf(stderr, "kernel_launch: memset failed\n"); return; }
    Args a{};
    a.x = (const float*)d_in[0]; a.p = (const float*)d_in[1]; a.norm_mix = (const float*)d_in[2]; a.w_in = (const float*)d_in[3]; a.w_att_up = (const float*)d_in[4];
    a.w_pool_group = (const float*)d_in[5]; a.pool_scale = (const float*)d_in[6]; a.w_out = (const float*)d_in[7]; a.norm_ffn = (const float*)d_in[8]; a.w_query = (const float*)d_in[9];
    a.sub_keys = (const float*)d_in[10]; a.expert_u = (const float*)d_in[11]; a.expert_v = (const float*)d_in[12]; a.norm_ple = (const float*)d_in[13]; a.w_ple_gate = (const float*)d_in[14];
    a.w_ple = (const float*)d_in[15]; a.norm_final = (const float*)d_in[16];
    a.out = (float*)d_out; a.ws = (unsigned char*)d_ws; a.ph_hi = MK_PH_HI; a.pad = 0;
    hipLaunchKernelGGL(mega_fwd, dim3(grid), dim3(NTHR), LDS_BYTES, stream, a);
    { const hipError_t le = hipPeekAtLastError(); if (le != hipSuccess) fprintf(stderr, "kernel_launch: launch failed: %s\n", hipGetErrorName(le)); }
#if MK_PH_HI < 99
    {
        using namespace ref;
        char* ws = (char*)d_ws; float* out = (float*)d_out;
        float* hbuf = (float*)(ws + 0 * MiB); float* qp = (float*)(ws + 32 * MiB); float* sc = (float*)(ws + 96 * MiB);
        int* idx = (int*)(ws + 160 * MiB); float* gates = (float*)(ws + 164 * MiB); float* ebuf = (float*)(ws + 168 * MiB);
        for (int b = 0; b < NB; ++b) {
            const float* pb = a.p + (size_t)b * S * 256; float* ob = out + (size_t)b * S * D;
#if MK_PH_HI == 5
            k_rms<<<S, 256, 0, stream>>>(ob, a.norm_ffn, hbuf);
            k_gemm<EpiStore><<<dim3(2048 / 128, S / 128), 256, 0, stream>>>(hbuf, a.w_query, EpiStore{qp, 2048}, D, 2048, D, 0);
            k_scores<<<S / 4, 256, 0, stream>>>(qp, a.sub_keys, sc);
            k_topk<<<S * 8 / 4, 256, 0, stream>>>(sc, idx, gates);
            k_peer<<<S, 256, 0, stream>>>(hbuf, idx, gates, a.expert_u, a.expert_v, ob);
#elif MK_PH_HI == 7
            k_rms<<<S, 256, 0, stream>>>(ob, a.norm_ffn, hbuf);
            k_bf16_to_f32<<<S * 2048 / 256, 256, 0, stream>>>((const unsigned short*)(ws + WS_PG) + (size_t)b * S * 2048, qp);
            k_scores<<<S / 4, 256, 0, stream>>>(qp, a.sub_keys, sc);
            k_topk<<<S * 8 / 4, 256, 0, stream>>>(sc, idx, gates);
            k_peer<<<S, 256, 0, stream>>>(hbuf, idx, gates, a.expert_u, a.expert_v, ob);
#elif MK_PH_HI == 8
            k_rms<<<S, 256, 0, stream>>>(ob, a.norm_ffn, hbuf);
            k_gather_idx<<<S, 128, 0, stream>>>((const unsigned char*)(ws + WS_YA), b * S, idx, gates);
            k_peer<<<S, 256, 0, stream>>>(hbuf, idx, gates, a.expert_u, a.expert_v, ob);
#endif
            k_rms<<<S, 256, 0, stream>>>(ob, a.norm_ple, hbuf);
            k_gemm<EpiStore><<<dim3(D / 128, S / 128), 256, 0, stream>>>(pb, a.w_ple, EpiStore{ebuf, D}, 256, D, 256, 0);
            k_gemm<EpiGate><<<dim3(D / 128, S / 128), 256, 0, stream>>>(hbuf, a.w_ple_gate, EpiGate{ob, ebuf, ob, D}, D, D, D, 0);
            k_rms<<<S, 256, 0, stream>>>(ob, a.norm_final, ob);
        }
    }
#endif
}
```

```cpp
#include <hip/hip_runtime.h>
#include <cstdio>
#include <cstdint>
#include <math.h>
__device__ __forceinline__ int lane_id() { int l; asm volatile("v_mbcnt_lo_u32_b32 %0, -1, 0\n\tv_mbcnt_hi_u32_b32 %0, -1, %0" : "=v"(l)); return l; }
__device__ __forceinline__ int otid(int wid0) { return (wid0 << 6) | lane_id(); }

namespace pg8 {
#define PG8_LAS __attribute__((address_space(3)))
typedef unsigned short bf16_t;
typedef short bf16x8 __attribute__((ext_vector_type(8)));
typedef float f32x4 __attribute__((ext_vector_type(4)));
typedef unsigned u32x4 __attribute__((ext_vector_type(4)));
constexpr int BM = 256, BK = 64, HALF = 128, HTB = HALF * BK * 2  , STAGE_BYTES = 8 * HTB, NXCD = 8, WGM = 8;

__host__ __device__ __forceinline__ int lds_byte(int r, int c) { const int st = (r >> 4) * 2 + (c >> 5), rr = r & 15, cc = c & 31, ob = rr * 64 + cc * 2; return st * 1024 + (ob ^ (((ob >> 9) & 1) << 5)); }
__host__ __device__ __forceinline__ void stage_rc(int b, int& R, int& C) { const int st = b / 1024, sb = b % 1024, swz = sb ^ (((sb >> 9) & 1) << 5); R = (st >> 1) * 16 + swz / 64; C = (st & 1) * 32 + (swz % 64) / 2; }
__host__ __device__ __forceinline__ int perm32(int rho) { const int n = rho >> 4, i = rho & 15; return 8 * (i >> 2) + 4 * n + (i & 3); }

struct Unit { int pm, pn; };
struct Gemm { const bf16_t* A; const bf16_t* Bt; int K, lda, ldb, akoff; long a2off; };

struct StaticOrder {
    int nM, nN, nwg, G, c;
    __host__ __device__ void init(int M, int N, int G_, int c_) { nM = M / BM; nN = N / BM; nwg = nM * nN; G = G_; c = c_; }
    __host__ __device__ bool next(int i, Unit& u) const {
        const long L = (long)i * G + c; if (L >= nwg) return false;
        int wgid = (int)L; { const int q = nwg / NXCD, r = nwg % NXCD, xcd = wgid % NXCD, off = wgid / NXCD; wgid = (xcd < r ? xcd * (q + 1) : r * (q + 1) + (xcd - r) * q) + off; }
        const int nig = WGM * nN, gid = wgid / nig, fm = gid * WGM, gsz = (nM - fm) < WGM ? (nM - fm) : WGM;
        u.pm = fm + ((wgid % nig) % gsz); u.pn = (wgid % nig) / gsz; return true;
    }
    __device__ __forceinline__ void a_ready(const Unit&) const {}
    __device__ __forceinline__ void done(const Unit&) const {}
};

template <class Epi, class Sched, bool ALIGN_EPI = false, bool SP2 = false>
__device__ __forceinline__ void gemm_phase(PG8_LAS unsigned char* lds, const Gemm g, const Sched& S, const Epi& E, const int wid0) {
    const int tid = otid(wid0), wid = __builtin_amdgcn_readfirstlane(tid >> 6), lane = tid & 63, wr = wid >> 2, wc = wid & 3, fr = lane & 15, fq = lane >> 4;
    const int K = g.K, nt = K / BK;
    unsigned voffA[2], voffB[2];
#pragma unroll
    for (int i = 0; i < 2; ++i) { int R, C; stage_rc(tid * 16 + i * 8192, R, C); const int Rb = Epi::PERM ? ((R & ~31) + perm32(R & 31)) : R;
        voffA[i] = (unsigned)(R * g.lda + C) * 2u; voffB[i] = (unsigned)(Rb * g.ldb + C) * 2u; }
    const size_t kstep = (size_t)(BK * 2);
    const size_t hstepA = (size_t)HALF * g.lda * 2, hstepB = (size_t)HALF * g.ldb * 2;
    const size_t tstepA = 2 * hstepA, tstepB = 2 * hstepB, akb = (size_t)g.akoff * 2, a2b = (size_t)g.a2off * 2;
    const unsigned ldsw = (unsigned)wid * 1024u;
    const int aoff = lds_byte(wr * 64 + fr, fq * 8), boff = lds_byte(wc * 32 + fr, fq * 8);
#define PG8_SA(b, h) (((b) * 2 + (h)) * HTB)
#define PG8_SB(b, h) ((4 + (b) * 2 + (h)) * HTB)
#define PG8_STAGE(bufoff, gbase, voff) do { _Pragma("unroll") for (int _i = 0; _i < 2; ++_i) \
        __builtin_amdgcn_global_load_lds((const unsigned*)((const char*)(gbase) + (voff)[_i]), (PG8_LAS unsigned*)(lds + (bufoff) + ldsw + _i * 8192), 16, 0, 0); } while (0)
#define PG8_LDA(dst, b, h) do { _Pragma("unroll") for (int m = 0; m < 4; ++m) _Pragma("unroll") for (int k = 0; k < 2; ++k) dst[m][k] = *(const PG8_LAS bf16x8*)(lds + PG8_SA(b, h) + aoff + m * 2048 + k * 1024); } while (0)
#define PG8_LDB(dst, b, h) do { _Pragma("unroll") for (int n = 0; n < 2; ++n) _Pragma("unroll") for (int k = 0; k < 2; ++k) dst[n][k] = *(const PG8_LAS bf16x8*)(lds + PG8_SB(b, h) + boff + n * 2048 + k * 1024); } while (0)
#define PG8_MMA(ai, bj, At, Bt) do { __builtin_amdgcn_s_setprio(1); _Pragma("unroll") for (int m = 0; m < 4; ++m) _Pragma("unroll") for (int n = 0; n < 2; ++n) _Pragma("unroll") for (int k = 0; k < 2; ++k) \
        acc[ai][bj][m][n] = __builtin_amdgcn_mfma_f32_16x16x32_bf16(Bt[n][k], At[m][k], acc[ai][bj][m][n], 0, 0, 0); __builtin_amdgcn_s_setprio(0); } while (0)
#define PG8_WAIT_V(n) asm volatile("s_waitcnt vmcnt(" #n ")" ::: "memory")
#define PG8_WAIT_L(n) asm volatile("s_waitcnt lgkmcnt(" #n ")" ::: "memory")
#define PG8_BAR __builtin_amdgcn_s_barrier()
#define PG8_SCHED __builtin_amdgcn_sched_barrier(0)
    Unit cur, nxt; int ui = 0;
    if (!S.next(0, cur)) return;
    f32x4 acc[2][2][4][2];
#pragma unroll
    for (int a = 0; a < 2; ++a)
#pragma unroll
        for (int b = 0; b < 2; ++b)
#pragma unroll
            for (int m = 0; m < 4; ++m)
#pragma unroll
                for (int n = 0; n < 2; ++n) acc[a][b][m][n] = (f32x4){0.f, 0.f, 0.f, 0.f};
    bf16x8 At[4][2], B0[2][2], B1[2][2];
    const char* cA = (const char*)g.A + (size_t)cur.pm * tstepA + (size_t)(cur.pn & 3) * akb + (size_t)(cur.pn >> 2) * a2b; const char* cB = (const char*)g.Bt + (size_t)cur.pn * tstepB;
    S.a_ready(cur);
    if constexpr (SP2) {
        PG8_STAGE(PG8_SB(0, 0), cB, voffB); PG8_STAGE(PG8_SB(0, 1), cB + hstepB, voffB); PG8_STAGE(PG8_SA(0, 0), cA, voffA); PG8_STAGE(PG8_SA(0, 1), cA + hstepA, voffA);
        if (wr == 1) PG8_BAR;
        PG8_WAIT_V(2); PG8_BAR;
        PG8_STAGE(PG8_SB(1, 0), cB + kstep, voffB); PG8_STAGE(PG8_SA(1, 0), cA + kstep, voffA); PG8_STAGE(PG8_SB(1, 1), cB + hstepB + kstep, voffB);
        PG8_WAIT_V(6); PG8_BAR;
    } else {
        PG8_STAGE(PG8_SB(0, 0), cB, voffB); PG8_STAGE(PG8_SA(0, 0), cA, voffA); PG8_STAGE(PG8_SB(0, 1), cB + hstepB, voffB); PG8_STAGE(PG8_SA(0, 1), cA + hstepA, voffA);
        if (wr == 1) PG8_BAR;
        PG8_WAIT_V(4); PG8_BAR;
        PG8_STAGE(PG8_SB(1, 0), cB + kstep, voffB); PG8_STAGE(PG8_SA(1, 0), cA + kstep, voffA); PG8_STAGE(PG8_SB(1, 1), cB + hstepB + kstep, voffB);
        PG8_WAIT_V(6); PG8_BAR;
    }
    for (;;) {
        const bool has_next = S.next(ui + 1, nxt);
        const char* nA = has_next ? (const char*)g.A + (size_t)nxt.pm * tstepA + (size_t)(nxt.pn & 3) * akb + (size_t)(nxt.pn >> 2) * a2b : cA; const char* nB = has_next ? (const char*)g.Bt + (size_t)nxt.pn * tstepB : cB;
        for (int t = 0; t < nt; t += 2) {
            const bool last = (t == nt - 2);
            const char* a1 = cA + (size_t)(t + 1) * kstep;
            const char* a2 = last ? nA : cA + (size_t)(t + 2) * kstep; const char* b2 = last ? nB : cB + (size_t)(t + 2) * kstep;
            const char* a3 = a2 + kstep; const char* b3 = b2 + kstep;
            if (last && has_next) S.a_ready(nxt);
            if constexpr (SP2) {
            PG8_LDB(B0, 0, 0); PG8_LDB(B1, 0, 1); PG8_SCHED; PG8_LDA(At, 0, 0); PG8_STAGE(PG8_SA(1, 1), a1 + hstepA, voffA);
            PG8_WAIT_V(8); PG8_WAIT_L(0); PG8_BAR; PG8_MMA(0, 0, At, B0); PG8_MMA(0, 1, At, B1); PG8_BAR; PG8_SCHED;
            PG8_LDA(At, 0, 1); PG8_STAGE(PG8_SB(0, 0), b2, voffB); PG8_STAGE(PG8_SB(0, 1), b2 + hstepB, voffB); PG8_STAGE(PG8_SA(0, 0), a2, voffA);
            PG8_WAIT_V(8); PG8_WAIT_L(0); PG8_BAR; PG8_MMA(1, 0, At, B0); PG8_MMA(1, 1, At, B1); PG8_BAR; PG8_SCHED;
            PG8_LDB(B0, 1, 0); PG8_LDB(B1, 1, 1); PG8_SCHED; PG8_LDA(At, 1, 0); PG8_STAGE(PG8_SA(0, 1), a2 + hstepA, voffA);
            PG8_WAIT_V(8); PG8_WAIT_L(0); PG8_BAR; PG8_MMA(0, 0, At, B0); PG8_MMA(0, 1, At, B1); PG8_BAR; PG8_SCHED;
            PG8_LDA(At, 1, 1); PG8_STAGE(PG8_SB(1, 0), b3, voffB); PG8_STAGE(PG8_SB(1, 1), b3 + hstepB, voffB); PG8_STAGE(PG8_SA(1, 0), a3, voffA);
            PG8_WAIT_V(8); PG8_WAIT_L(0); PG8_BAR; PG8_MMA(1, 0, At, B0); PG8_MMA(1, 1, At, B1); PG8_BAR; PG8_SCHED;
            } else {
            PG8_LDB(B0, 0, 0); PG8_SCHED; PG8_LDA(At, 0, 0); PG8_STAGE(PG8_SA(1, 1), a1 + hstepA, voffA);
            PG8_WAIT_L(8); PG8_BAR; PG8_WAIT_L(0); PG8_MMA(0, 0, At, B0); PG8_BAR; PG8_SCHED;
            PG8_LDB(B1, 0, 1); PG8_STAGE(PG8_SB(0, 0), b2, voffB);
            PG8_BAR; PG8_WAIT_L(0); PG8_MMA(0, 1, At, B1); PG8_BAR;
            PG8_LDA(At, 0, 1); PG8_STAGE(PG8_SA(0, 0), a2, voffA);
            PG8_BAR; PG8_WAIT_L(0); PG8_MMA(1, 0, At, B0); PG8_BAR; PG8_SCHED;
            PG8_STAGE(PG8_SB(0, 1), b2 + hstepB, voffB);
            PG8_WAIT_V(6); PG8_BAR; PG8_MMA(1, 1, At, B1); PG8_BAR;
            PG8_LDB(B0, 1, 0); PG8_SCHED; PG8_LDA(At, 1, 0); PG8_STAGE(PG8_SA(0, 1), a2 + hstepA, voffA);
            PG8_WAIT_L(8); PG8_BAR; PG8_WAIT_L(0); PG8_MMA(0, 0, At, B0); PG8_BAR; PG8_SCHED;
            PG8_LDB(B1, 1, 1); PG8_STAGE(PG8_SB(1, 0), b3, voffB);
            PG8_BAR; PG8_WAIT_L(0); PG8_MMA(0, 1, At, B1); PG8_BAR;
            PG8_LDA(At, 1, 1); PG8_STAGE(PG8_SA(1, 0), a3, voffA);
            PG8_BAR; PG8_WAIT_L(0); PG8_MMA(1, 0, At, B0); PG8_BAR; PG8_SCHED;
            PG8_STAGE(PG8_SB(1, 1), b3 + hstepB, voffB);
            PG8_WAIT_V(6); PG8_BAR; PG8_MMA(1, 1, At, B1); PG8_BAR;
            }
        }
        if constexpr (ALIGN_EPI) { if (wr == 0) PG8_BAR; }
        if constexpr (!Epi::AFTER_DRAIN) { E(acc, cur, wr, wc, fr, fq); S.done(cur); }
        if (!has_next) break;
#pragma unroll
        for (int a = 0; a < 2; ++a)
#pragma unroll
            for (int b = 0; b < 2; ++b)
#pragma unroll
                for (int m = 0; m < 4; ++m)
#pragma unroll
                    for (int n = 0; n < 2; ++n) acc[a][b][m][n] = (f32x4){0.f, 0.f, 0.f, 0.f};
        cur = nxt; cA = nA; cB = nB; ++ui;
        if constexpr (ALIGN_EPI) { if (wr == 1) PG8_BAR; }
    }
    PG8_WAIT_V(0);
    if constexpr (!ALIGN_EPI) { if (wr == 0) PG8_BAR; }
    PG8_BAR;
    if constexpr (Epi::AFTER_DRAIN) { E.fused(acc, cur, wr, wc, fr, fq, lds, wid, lane); S.done(cur); }
#undef PG8_SA
#undef PG8_SB
#undef PG8_STAGE
#undef PG8_LDA
#undef PG8_LDB
#undef PG8_MMA
#undef PG8_WAIT_V
#undef PG8_WAIT_L
#undef PG8_BAR
#undef PG8_SCHED
}
}


namespace pg8 {
typedef unsigned u32x2 __attribute__((ext_vector_type(2)));
__device__ __forceinline__ unsigned cvt_pk_bf16(float lo, float hi) { unsigned r; asm volatile("v_cvt_pk_bf16_f32 %0, %1, %2" : "=v"(r) : "v"(lo), "v"(hi)); return r; }
__device__ __forceinline__ float sigm(float x) { return __builtin_amdgcn_rcpf(1.0f + __builtin_amdgcn_exp2f(-1.4426950408889634f * x)); }
__device__ __forceinline__ float bf_lo(unsigned w) { return __uint_as_float(w << 16); }
__device__ __forceinline__ float bf_hi(unsigned w) { return __uint_as_float(w & 0xffff0000u); }

struct PanelSched {
    int panel, n, skip_lo, skip_n, mode;
    __device__ __forceinline__ bool next(int i, Unit& u) const {
        if (i >= n) return false;
        if (mode == 0) { u.pm = panel; u.pn = i + (i >= skip_lo ? skip_n : 0); } else { u.pm = i; u.pn = panel; }
        return true;
    }
    __device__ __forceinline__ void a_ready(const Unit&) const {}
    __device__ __forceinline__ void done(const Unit&) const {}
};

struct EpiProj {
    static constexpr bool PERM = true, AFTER_DRAIN = false;
    bf16_t *PQ, *PK, *PU, *PG;
    __device__ __forceinline__ void operator()(const f32x4 (&acc)[2][2][4][2], const Unit& u, int wr, int wc, int fr, int fq) const {
        const int pn = u.pn; bf16_t* base; int ld, colt; bool sg = false;
        if (pn < 2) { base = PQ; ld = 512; colt = pn * 256; }
        else if (pn < 4) { base = PK; ld = 512; colt = (pn - 2) * 256; }
        else if (pn < 8) { base = PU; ld = 512; colt = (pn - 6) * 256; }
        else { base = PG; ld = 2048; colt = (pn - 8) * 256; sg = true; }
        const int row0 = u.pm * BM + wr * 64 + fr, col0 = colt + wc * 32 + 8 * fq;
#pragma unroll
        for (int ai = 0; ai < 2; ++ai)
#pragma unroll
            for (int m = 0; m < 4; ++m) { bf16_t* rowp = base + (size_t)(row0 + ai * HALF + m * 16) * ld + col0;
#pragma unroll
                for (int bj = 0; bj < 2; ++bj) { f32x4 v0 = acc[ai][bj][m][0], v1 = acc[ai][bj][m][1];
                    if (sg) { v0 = (f32x4){sigm(v0[0]), sigm(v0[1]), sigm(v0[2]), sigm(v0[3])}; v1 = (f32x4){sigm(v1[0]), sigm(v1[1]), sigm(v1[2]), sigm(v1[3])}; }
                    u32x4 w; w.x = cvt_pk_bf16(v0[0], v0[1]); w.y = cvt_pk_bf16(v0[2], v0[3]); w.z = cvt_pk_bf16(v1[0], v1[1]); w.w = cvt_pk_bf16(v1[2], v1[3]);
                    *(u32x4*)(rowp + bj * HALF) = w; } }
    }
};
struct EpiPlain {
    static constexpr bool PERM = true, AFTER_DRAIN = false;
    bf16_t* O; int ldc;
    __device__ __forceinline__ void operator()(const f32x4 (&acc)[2][2][4][2], const Unit& u, int wr, int wc, int fr, int fq) const {
        const int row0 = u.pm * BM + wr * 64 + fr, col0 = u.pn * BM + wc * 32 + 8 * fq;
#pragma unroll
        for (int ai = 0; ai < 2; ++ai)
#pragma unroll
            for (int m = 0; m < 4; ++m) { bf16_t* rowp = O + (size_t)(row0 + ai * HALF + m * 16) * ldc + col0;
#pragma unroll
                for (int bj = 0; bj < 2; ++bj) { const f32x4 v0 = acc[ai][bj][m][0], v1 = acc[ai][bj][m][1];
                    u32x4 w; w.x = cvt_pk_bf16(v0[0], v0[1]); w.y = cvt_pk_bf16(v0[2], v0[3]); w.z = cvt_pk_bf16(v1[0], v1[1]); w.w = cvt_pk_bf16(v1[2], v1[3]);
                    *(u32x4*)(rowp + bj * HALF) = w; } }
    }
};
struct EpiMergeChain {
    static constexpr bool PERM = true, AFTER_DRAIN = false;
    const bf16_t* G; bf16_t* MG;
    __device__ __forceinline__ void operator()(const f32x4 (&acc)[2][2][4][2], const Unit& u, int wr, int wc, int fr, int fq) const {
        const bool add = u.pn >= 4; const int goff = add ? 1024 : 0;
        const int row0 = u.pm * BM + wr * 64 + fr, col0 = (u.pn & 3) * BM + wc * 32 + 8 * fq;
        if (add) asm volatile("s_waitcnt vmcnt(0)" ::: "memory");
#pragma unroll
        for (int ai = 0; ai < 2; ++ai)
#pragma unroll
            for (int m = 0; m < 4; ++m) { const size_t row = (size_t)(row0 + ai * HALF + m * 16);
#pragma unroll
                for (int bj = 0; bj < 2; ++bj) { const f32x4 v0 = acc[ai][bj][m][0], v1 = acc[ai][bj][m][1];
                    const u32x4 gw = *(const u32x4*)(G + row * 2048 + goff + col0 + bj * HALF);
                    float r0 = bf_lo(gw.x) * v0[0], r1 = bf_hi(gw.x) * v0[1], r2 = bf_lo(gw.y) * v0[2], r3 = bf_hi(gw.y) * v0[3];
                    float r4 = bf_lo(gw.z) * v1[0], r5 = bf_hi(gw.z) * v1[1], r6 = bf_lo(gw.w) * v1[2], r7 = bf_hi(gw.w) * v1[3];
                    bf16_t* mp = MG + row * 1024 + col0 + bj * HALF;
                    if (add) { const u32x4 pw = *(const u32x4*)mp;
                        r0 += bf_lo(pw.x); r1 += bf_hi(pw.x); r2 += bf_lo(pw.y); r3 += bf_hi(pw.y); r4 += bf_lo(pw.z); r5 += bf_hi(pw.z); r6 += bf_lo(pw.w); r7 += bf_hi(pw.w); }
                    u32x4 w; w.x = cvt_pk_bf16(r0, r1); w.y = cvt_pk_bf16(r2, r3); w.z = cvt_pk_bf16(r4, r5); w.w = cvt_pk_bf16(r6, r7);
                    *(u32x4*)mp = w; }
                asm volatile("" ::: "memory"); }
    }
};
struct EpiRes {
    static constexpr bool PERM = false, AFTER_DRAIN = false;
    const float* X; float* OUT;
    __device__ __forceinline__ void operator()(const f32x4 (&acc)[2][2][4][2], const Unit& u, int wr, int wc, int fr, int fq) const {
        const int col0 = u.pn * BM + wc * 32 + 4 * fq;
#pragma unroll
        for (int ai = 0; ai < 2; ++ai)
#pragma unroll
            for (int m = 0; m < 4; ++m) { const size_t off = (size_t)(u.pm * BM + ai * HALF + wr * 64 + m * 16 + fr) * 1024 + col0;
#pragma unroll
                for (int bj = 0; bj < 2; ++bj)
#pragma unroll
                    for (int n = 0; n < 2; ++n) { const f32x4 xs = *(const f32x4*)(X + off + bj * HALF + n * 16); *(f32x4*)(OUT + off + bj * HALF + n * 16) = xs + acc[ai][bj][m][n]; }
                asm volatile("" ::: "memory"); }
    }
};
struct EpiGate {
    static constexpr bool PERM = false, AFTER_DRAIN = false;
    float* OUT; const bf16_t* E;
    __device__ __forceinline__ void operator()(const f32x4 (&acc)[2][2][4][2], const Unit& u, int wr, int wc, int fr, int fq) const {
        const int col0 = u.pn * BM + wc * 32 + 4 * fq;
#pragma unroll
        for (int ai = 0; ai < 2; ++ai)
#pragma unroll
            for (int m = 0; m < 4; ++m) { const size_t off = (size_t)(u.pm * BM + ai * HALF + wr * 64 + m * 16 + fr) * 1024 + col0;
#pragma unroll
                for (int bj = 0; bj < 2; ++bj)
#pragma unroll
                    for (int n = 0; n < 2; ++n) { const size_t o2 = off + bj * HALF + n * 16; const f32x4 xs = *(const f32x4*)(OUT + o2); const u32x2 ew = *(const u32x2*)(E + o2); const f32x4 a = acc[ai][bj][m][n];
                        f32x4 r; r[0] = xs[0] + sigm(a[0]) * bf_lo(ew.x); r[1] = xs[1] + sigm(a[1]) * bf_hi(ew.x); r[2] = xs[2] + sigm(a[2]) * bf_lo(ew.y); r[3] = xs[3] + sigm(a[3]) * bf_hi(ew.y);
                        *(f32x4*)(OUT + o2) = r; }
                asm volatile("" ::: "memory"); }
    }
};
}

#define GAS __attribute__((address_space(1)))
#define LAS __attribute__((address_space(3)))
typedef unsigned short bf16;
typedef unsigned v4u __attribute__((ext_vector_type(4)));
typedef float f32x4 __attribute__((ext_vector_type(4)));
typedef short bf16x8 __attribute__((ext_vector_type(8)));
typedef GAS unsigned gu32;
typedef GAS unsigned long long gu64;
#define RLX_AGENT __ATOMIC_RELAXED, __HIP_MEMORY_SCOPE_AGENT
#define LDS_WAIT() asm volatile("s_waitcnt lgkmcnt(0)" ::: "memory")
#define VM_WAIT() asm volatile("s_waitcnt vmcnt(0)" ::: "memory")
__device__ __forceinline__ unsigned long long rt() { return __builtin_amdgcn_s_memrealtime(); }
__device__ __forceinline__ unsigned f2bf(float f) { unsigned u = __builtin_bit_cast(unsigned, f); return (u + 0x7fffu + ((u >> 16) & 1u)) >> 16; }
__device__ __forceinline__ unsigned pk2(float lo, float hi) { return f2bf(lo) | (f2bf(hi) << 16); }

#define XB_TMO      128
#define XB_XCNT(j)  (256  + 64 * (j))
#define XB_XSUB(j)  (1280 + 64 * (j))
#define XB_XGEN(j)  (2304 + 64 * (j))
#define XB_TOP      3328
#define XB_TOPGEN   3392
#define XCD_BAR_WORDS 3456
#define XB_SPIN_CAP (1u << 18)

__device__ __forceinline__ unsigned xb_ld(unsigned* p)              { return __hip_atomic_load(p, __ATOMIC_RELAXED, __HIP_MEMORY_SCOPE_AGENT); }
__device__ __forceinline__ unsigned xb_add(unsigned* p, unsigned v) { return __hip_atomic_fetch_add(p, v, __ATOMIC_RELAXED, __HIP_MEMORY_SCOPE_AGENT); }
__device__ __forceinline__ unsigned xb_xcc_id() { return (unsigned)__builtin_amdgcn_s_getreg((3 << 11) | 20) & 0xFu; }
#define XB_SPIN(cond, bar) do { unsigned _sp = 0; while (cond) { __builtin_amdgcn_s_sleep(1); \
    if ((++_sp & 255u) == 0u) { if (xb_ld(&(bar)[XB_TMO])) break; if (_sp > XB_SPIN_CAP) { atomicAdd(&(bar)[XB_TMO], 1u); break; } } } } while (0)

struct XcdBarrier {
    unsigned* bar; unsigned x;
    volatile LAS unsigned* st;
};

__device__ __forceinline__ XcdBarrier xcd_barrier_post(unsigned* bar, volatile LAS unsigned* st, const bool is_t0) {
    XcdBarrier b; b.bar = bar; b.x = xb_xcc_id(); b.st = st;
    if (is_t0) (void)xb_add(&bar[XB_XCNT(b.x)], 1u);
    return b;
}
__device__ __forceinline__ void xcd_barrier_complete(unsigned* bar, unsigned x, unsigned& nloc, unsigned& nx) {
    const unsigned G = gridDim.x * gridDim.y * gridDim.z;
    unsigned sum, cnt, mine, sp = 0u;
    for (;;) {
        sum = 0u; cnt = 0u; mine = 0u;
#pragma unroll
        for (unsigned j = 0; j < 16; ++j) { const unsigned c = xb_ld(&bar[XB_XCNT(j)]); sum += c; cnt += (c > 0u) ? 1u : 0u; mine = (j == x) ? c : mine; }
        if (sum == G) break;
        __builtin_amdgcn_s_sleep(1);
        if ((++sp & 255u) == 0u) { if (xb_ld(&bar[XB_TMO])) break; if (sp > XB_SPIN_CAP) { atomicAdd(&bar[XB_TMO], 1u); break; } }
    }
    nloc = mine > 0u ? mine : 1u; nx = cnt > 0u ? cnt : 1u;
}

__device__ __forceinline__ void xcd_barrier(const XcdBarrier& b, const bool is_t0) {
    asm volatile("s_waitcnt vmcnt(0)" ::: "memory");
    __syncthreads();
    if (is_t0) {
        unsigned* bar = b.bar;
        __builtin_amdgcn_s_waitcnt(0);
        unsigned nloc = b.st[0], nx = b.st[1];
        if (nloc == 0u) { xcd_barrier_complete(bar, b.x, nloc, nx); b.st[0] = nloc; b.st[1] = nx; }
        const unsigned old = xb_add(&bar[XB_XSUB(b.x)], 1u);
        const unsigned gen = old / nloc;
        if (old + 1u == (gen + 1u) * nloc) {
            __builtin_amdgcn_fence(__ATOMIC_RELEASE, "agent");
            asm volatile("s_waitcnt vmcnt(0)" ::: "memory");
            const unsigned og = xb_add(&bar[XB_TOP], 1u);
            const unsigned tg = og / nx;
            if (og + 1u == (tg + 1u) * nx) xb_add(&bar[XB_TOPGEN], 1u);
            else XB_SPIN(xb_ld(&bar[XB_TOPGEN]) == tg, bar);
            __builtin_amdgcn_fence(__ATOMIC_ACQUIRE, "agent");
            xb_add(&bar[XB_XGEN(b.x)], 1u);
            asm volatile("s_waitcnt vmcnt(0)" ::: "memory");
        } else {
            XB_SPIN(xb_ld(&bar[XB_XGEN(b.x)]) == gen, bar);
            __builtin_amdgcn_fence(__ATOMIC_ACQUIRE, "agent");
            asm volatile("s_waitcnt vmcnt(0)" ::: "memory");
        }
    }
    __syncthreads();
}


constexpr int NWAVES = 8, NTHR = 512;
constexpr int TOK = 65536, DM = 1024, SEQ = 8192, NPANEL = 256;
constexpr float RMS_EPS = 1e-6f;
constexpr float C2 = 0.125f * 1.4426950408889634f;
constexpr float SURV_THR = 5.4210108624275222e-20f;
constexpr size_t MiB = 1u << 20;
constexpr size_t WS_CTL = 0, CTL_ZERO_BYTES = 64 * 1024;
constexpr size_t WS_WIN = 2 * MiB, WS_WOUT = 10 * MiB, WS_WQ = 12 * MiB, WS_WPG = 16 * MiB, WS_WPLE = 18 * MiB;
constexpr size_t WS_BDA = 18 * MiB + 512 * 1024, WS_BDP = 18 * MiB + 768 * 1024, WS_SK = 19 * MiB;
constexpr size_t WS_EU = 32 * MiB, WS_EV = 64 * MiB, WS_SU = 20 * MiB, WS_SV = 20 * MiB + 65536;
constexpr size_t WS_XN = 96 * MiB;
constexpr size_t WS_PQ = 224 * MiB, WS_PK = 288 * MiB, WS_PVT = 352 * MiB, WS_PU = 416 * MiB;
constexpr size_t WS_PG = 480 * MiB;
constexpr size_t WS_YA = 736 * MiB, WS_YP = 800 * MiB;
constexpr size_t WS_MG = 864 * MiB, WS_END = 992 * MiB;
constexpr int CW_BAR = 1024;
constexpr int RING_BYTES = 131072, LDSCTL_OFF = RING_BYTES, MISC_OFF = LDSCTL_OFF + 320, LDS_BYTES = 147456;

typedef float f32x16 __attribute__((ext_vector_type(16)));
typedef float f32x2 __attribute__((ext_vector_type(2)));
typedef __bf16 bf16x2v __attribute__((ext_vector_type(2)));

__device__ __forceinline__ int shx(int v, int m, int lane) { return __builtin_amdgcn_ds_bpermute((lane ^ m) << 2, v); }
__device__ __forceinline__ float shx(float v, int m, int lane) { return __builtin_bit_cast(float, __builtin_amdgcn_ds_bpermute((lane ^ m) << 2, __builtin_bit_cast(int, v))); }
__device__ __forceinline__ float shl_(float v, int src) { return __builtin_bit_cast(float, __builtin_amdgcn_ds_bpermute(src << 2, __builtin_bit_cast(int, v))); }
__device__ __forceinline__ float wave_sum(float v, int lane) {
#pragma unroll
    for (int o = 1; o < 64; o <<= 1) v += shx(v, o, lane);
    return v;
}
__device__ __forceinline__ float bflo(unsigned w) { return __uint_as_float(w << 16); }
__device__ __forceinline__ float bfhi(unsigned w) { return __uint_as_float(w & 0xffff0000u); }
__device__ __forceinline__ unsigned cvtpk(float lo, float hi) { return pg8::cvt_pk_bf16(lo, hi); }

__device__ __forceinline__ void p0_transpose_item(const float* W, int K, int N, bf16* WT, const float* kscale, int nlo, float nls, LAS float* scr, int item, int lane) {
    const int nblk = N / 32, kb = item / nblk, nb = item % nblk, k0 = 64 * kb, n0 = 32 * nb;
    const float ns = (n0 + (lane & 31)) < nlo ? nls : 1.0f;
#pragma unroll 8
    for (int i = 0; i < 32; ++i) { const int kk = 2 * i + (lane >> 5); float v = W[(size_t)(k0 + kk) * N + n0 + (lane & 31)] * ns; if (kscale) v *= kscale[k0 + kk]; scr[kk * 33 + (lane & 31)] = v; }
    LDS_WAIT(); asm volatile("" ::: "memory");
    const int c = lane & 7;
#pragma unroll
    for (int j = 0; j < 4; ++j) { const int n = (lane >> 3) + 8 * j; const LAS float* s = scr + (8 * c) * 33 + n;
        v4u o; o.x = pk2(s[0 * 33], s[1 * 33]); o.y = pk2(s[2 * 33], s[3 * 33]); o.z = pk2(s[4 * 33], s[5 * 33]); o.w = pk2(s[6 * 33], s[7 * 33]);
        *(GAS v4u*)(WT + (size_t)(n0 + n) * K + k0 + 8 * c) = o; }
    LDS_WAIT(); asm volatile("" ::: "memory");
}
__device__ __forceinline__ void rms_row_to_bf16(const float* xrow, bf16* orow, int lane) {
    const GAS f32x4* xr = (const GAS f32x4*)xrow + lane;
    f32x4 v[4]; float s = 0.f;
#pragma unroll
    for (int j = 0; j < 4; ++j) { v[j] = xr[64 * j]; s += (v[j].x * v[j].x + v[j].y * v[j].y) + (v[j].z * v[j].z + v[j].w * v[j].w); }
    const float r = 1.f / sqrtf(wave_sum(s, lane) * (1.f / DM) + RMS_EPS);
    GAS unsigned long long* o8 = (GAS unsigned long long*)orow + lane;
#pragma unroll
    for (int j = 0; j < 4; ++j) o8[64 * j] = (unsigned long long)pk2(v[j].x * r, v[j].y * r) | ((unsigned long long)pk2(v[j].z * r, v[j].w * r) << 32);
}
__device__ __forceinline__ void cvt8_store(const float* src, bf16* dst) {
    const f32x4 a = *(const GAS f32x4*)src, b = *(const GAS f32x4*)(src + 4);
    v4u o; o.x = pk2(a.x, a.y); o.y = pk2(a.z, a.w); o.z = pk2(b.x, b.y); o.w = pk2(b.z, b.w);
    *(GAS v4u*)dst = o;
}

__device__ __forceinline__ void attn_panel(int panel, const bf16* PQ, const bf16* PK, const bf16* PVT, bf16* YA, const int wid0) {
    const int tid = otid(wid0), lane = tid & 63, wid = __builtin_amdgcn_readfirstlane(tid >> 6);
    const int r32 = lane & 31, hh = lane >> 5;
    const size_t seq0 = (size_t)(panel >> 5) * SEQ;
    const int pos0 = (panel & 31) * 256 + wid * 32;
    const int kap = 16 * ((r32 >> 2) & 1) + (r32 & 3) + 4 * (r32 >> 3);
    for (int h = 0; h < 8; ++h) {
        bf16x8 qf[4];
        { const bf16* qrow = PQ + (seq0 + pos0 + r32) * 512 + h * 64 + 8 * hh;
#pragma unroll
          for (int s = 0; s < 4; ++s) qf[s] = *(const GAS bf16x8*)(qrow + 16 * s); }
        f32x16 o0 = {}, o1 = {};
        float Sin = 1.f;
        for (int kb = pos0; kb >= 0; kb -= 32) {
            const bf16* krow = PK + (seq0 + kb + kap) * 512 + h * 64 + 8 * hh;
            const bf16* vrow = PVT + (size_t)(h * 64 + kap) * TOK + seq0 + kb + 16 * hh;
            bf16x8 kf[4], vf[2][2];
#pragma unroll
            for (int s = 0; s < 4; ++s) kf[s] = *(const GAS bf16x8*)(krow + 16 * s);
#pragma unroll
            for (int db = 0; db < 2; ++db)
#pragma unroll
                for (int s = 0; s < 2; ++s) vf[db][s] = *(const GAS bf16x8*)(vrow + (size_t)db * 32 * TOK + 8 * s);
            f32x16 z = {};
#pragma unroll
            for (int s = 0; s < 4; ++s) z = __builtin_amdgcn_mfma_f32_32x32x16_bf16(kf[s], qf[s], z, 0, 0, 0);
            const bool diag = (kb == pos0);
            float w[16]; float Sl = 1.f;
#pragma unroll
            for (int reg = 15; reg >= 0; --reg) {
                float beta = __builtin_amdgcn_rcpf(1.0f + __builtin_amdgcn_exp2f(-z[reg]));
                if (diag && (16 * hh + reg >= r32)) beta = 0.f;
                const float wl = beta * Sl; Sl -= wl; w[reg] = wl;
            }
            const float Pp = shx(Sl, 32, lane);
            const float scale = hh ? Sin : Sin * Pp;
            Sin = Sin * Sl * Pp;
            v4u pw0, pw1;
            pw0.x = cvtpk(w[0] * scale, w[1] * scale); pw0.y = cvtpk(w[2] * scale, w[3] * scale); pw0.z = cvtpk(w[4] * scale, w[5] * scale); pw0.w = cvtpk(w[6] * scale, w[7] * scale);
            pw1.x = cvtpk(w[8] * scale, w[9] * scale); pw1.y = cvtpk(w[10] * scale, w[11] * scale); pw1.z = cvtpk(w[12] * scale, w[13] * scale); pw1.w = cvtpk(w[14] * scale, w[15] * scale);
            const bf16x8 p0 = __builtin_bit_cast(bf16x8, pw0), p1 = __builtin_bit_cast(bf16x8, pw1);
            o0 = __builtin_amdgcn_mfma_f32_32x32x16_bf16(vf[0][0], p0, o0, 0, 0, 0);
            o0 = __builtin_amdgcn_mfma_f32_32x32x16_bf16(vf[0][1], p1, o0, 0, 0, 0);
            o1 = __builtin_amdgcn_mfma_f32_32x32x16_bf16(vf[1][0], p0, o1, 0, 0, 0);
            o1 = __builtin_amdgcn_mfma_f32_32x32x16_bf16(vf[1][1], p1, o1, 0, 0, 0);
            if (__all(Sin < SURV_THR)) break;
        }
        bf16* orow = YA + (seq0 + pos0 + r32) * 512 + h * 64 + 16 * hh;
        v4u a, b2;
        a.x = cvtpk(o0[0], o0[1]); a.y = cvtpk(o0[2], o0[3]); a.z = cvtpk(o0[4], o0[5]); a.w = cvtpk(o0[6], o0[7]);
        b2.x = cvtpk(o0[8], o0[9]); b2.y = cvtpk(o0[10], o0[11]); b2.z = cvtpk(o0[12], o0[13]); b2.w = cvtpk(o0[14], o0[15]);
        *(GAS v4u*)orow = a; *(GAS v4u*)(orow + 8) = b2;
        a.x = cvtpk(o1[0], o1[1]); a.y = cvtpk(o1[2], o1[3]); a.z = cvtpk(o1[4], o1[5]); a.w = cvtpk(o1[6], o1[7]);
        b2.x = cvtpk(o1[8], o1[9]); b2.y = cvtpk(o1[10], o1[11]); b2.z = cvtpk(o1[12], o1[13]); b2.w = cvtpk(o1[14], o1[15]);
        *(GAS v4u*)(orow + 32) = a; *(GAS v4u*)(orow + 40) = b2;
    }
}

__device__ __forceinline__ void pool_panel(int panel, const bf16* PU, bf16* YP, const int wid0) {
    const int tid = otid(wid0);
    const int chunk = tid & 63, tg = tid >> 6, w = 2 << (chunk >> 4);
    const int posb = (panel & 31) * 256; const size_t row0 = (size_t)panel * 256;
    for (int i = 0; i < 32; ++i) {
        const int t = tg * 32 + i, pos = posb + t, cnt = (pos + 1 < w) ? (pos + 1) : w;
        float s[8];
#pragma unroll
        for (int k = 0; k < 8; ++k) s[k] = 0.f;
        v4u cur = {0u, 0u, 0u, 0u};
        for (int j = 0; j < cnt; ++j) {
            const v4u v = *(const GAS v4u*)(PU + (row0 + t - j) * 512 + chunk * 8);
            if (j == 0) cur = v;
            s[0] += bflo(v.x); s[1] += bfhi(v.x); s[2] += bflo(v.y); s[3] += bfhi(v.y); s[4] += bflo(v.z); s[5] += bfhi(v.z); s[6] += bflo(v.w); s[7] += bfhi(v.w);
        }
        const float ic = 1.0f / (float)cnt;
        v4u o;
        o.x = cvtpk(s[0] * ic - bflo(cur.x), s[1] * ic - bfhi(cur.x)); o.y = cvtpk(s[2] * ic - bflo(cur.y), s[3] * ic - bfhi(cur.y));
        o.z = cvtpk(s[4] * ic - bflo(cur.z), s[5] * ic - bfhi(cur.z)); o.w = cvtpk(s[6] * ic - bflo(cur.w), s[7] * ic - bfhi(cur.w));
        *(GAS v4u*)(YP + (row0 + t) * 512 + chunk * 8) = o;
    }
}

#define HD __host__ __device__ __forceinline__
HD int f2s(float f) { int i = __builtin_bit_cast(int, f); return i ^ ((i >> 31) & 0x7fffffff); }
HD float s2f(int i) { i ^= ((i >> 31) & 0x7fffffff); return __builtin_bit_cast(float, i); }
HD void ce_desc(int& a, int& b) { const int mx = a > b ? a : b, mn = a > b ? b : a; a = mx; b = mn; }
template <int J, int K> HD void bpass16(int (&v)[16]) {
#pragma unroll
    for (int i = 0; i < 16; ++i) { const int l = i ^ J; if (l > i) { if ((i & K) == 0) ce_desc(v[i], v[l]); else ce_desc(v[l], v[i]); } }
}
HD void bitonic_sort16_desc(int (&v)[16]) {
    bpass16<1, 2>(v); bpass16<2, 4>(v); bpass16<1, 4>(v); bpass16<4, 8>(v); bpass16<2, 8>(v); bpass16<1, 8>(v);
    bpass16<8, 16>(v); bpass16<4, 16>(v); bpass16<2, 16>(v); bpass16<1, 16>(v);
}
HD void bitonic_merge16_desc(int (&v)[16]) {
    bpass16<8, 16>(v); bpass16<4, 16>(v); bpass16<2, 16>(v); bpass16<1, 16>(v);
}
HD void merge_prune16(int (&x)[16], const int (&y)[16]) {
#pragma unroll
    for (int i = 0; i < 16; ++i) x[i] = x[i] > y[15 - i] ? x[i] : y[15 - i];
    bitonic_merge16_desc(x);
}
HD int cx_i(int hf, int t) { if (hf == 0) return 0; return t < 5 ? 2 : t < 9 ? 3 : t < 12 ? 4 : t < 14 ? 5 : 6; }
HD int cx_j(int hf, int t) { if (hf == 0) return t; return t < 5 ? t : t < 9 ? t - 5 : t < 12 ? t - 9 : t < 14 ? t - 12 : t - 14; }
HD int cy_i(int hf, int t) { if (hf == 0) return t < 8 ? 1 : 23 - t; return 7; }
HD int cy_j(int hf, int t) { if (hf == 0) return t < 8 ? t : 0; return t; }

__device__ __forceinline__ void top16_of_group(const bf16x8 (&qf)[8], LAS const unsigned char* skl, int r32, int hh, int lane, int (&res)[16]) {
    int v[4][16];
#pragma unroll
    for (int kb = 0; kb < 4; ++kb) {
        f32x16 acc = {};
#pragma unroll
        for (int s = 0; s < 8; ++s) { const bf16x8 af = *(LAS const bf16x8*)(skl + (32 * kb + r32) * 272 + 32 * s + 16 * hh); acc = __builtin_amdgcn_mfma_f32_32x32x16_bf16(af, qf[s], acc, 0, 0, 0); }
#pragma unroll
        for (int reg = 0; reg < 16; ++reg) { const int keyid = 32 * kb + (reg & 3) + 8 * (reg >> 2) + 4 * hh; v[kb][reg] = (f2s(acc[reg]) & ~127) | keyid; }
    }
    bitonic_sort16_desc(v[0]); bitonic_sort16_desc(v[1]); bitonic_sort16_desc(v[2]); bitonic_sort16_desc(v[3]);
    merge_prune16(v[0], v[1]); merge_prune16(v[2], v[3]); merge_prune16(v[0], v[2]);
    int y[16];
#pragma unroll
    for (int i = 0; i < 16; ++i) y[i] = shx(v[0][i], 32, lane);
    merge_prune16(v[0], y);
#pragma unroll
    for (int i = 0; i < 16; ++i) res[i] = v[0][i];
}

__device__ __forceinline__ void topk_panel(int panel, const bf16* QP, const bf16* SK, int* IDXp, float* GTp  , LAS unsigned char* ldsb  , const int wid0) {
    const int tid = otid(wid0), lane = tid & 63, wid = __builtin_amdgcn_readfirstlane(tid >> 6);
    const int r32 = lane & 31, hh = lane >> 5;
    const int lrow = wid * 32 + r32;
    const size_t row = (size_t)panel * 256 + lrow;
    LAS int* lut = (LAS int*)ldsb; LAS unsigned char* skl = ldsb + 65536;
    v4u skr[4];
#define SK_FETCH(g_) do { _Pragma("unroll") for (int i = 0; i < 4; ++i) skr[i] = *((const GAS v4u*)(SK + (size_t)(g_) * 128 * 128) + i * 512 + tid); } while (0)
#define SK_STAGE() do { _Pragma("unroll") for (int i = 0; i < 4; ++i) { const int p = i * 512 + tid; *(LAS v4u*)(skl + (p >> 4) * 272 + (p & 15) * 16) = skr[i]; } } while (0)
    bf16x8 qn[8];
#define Q_FETCH(g_) do { const bf16* qrow_ = QP + row * 2048 + (g_) * 128 + 8 * hh; _Pragma("unroll") for (int s = 0; s < 8; ++s) qn[s] = *(const GAS bf16x8*)(qrow_ + 16 * s); } while (0)
    SK_FETCH(0); Q_FETCH(0);
    for (int h = 0; h < 8; ++h) {
        int a[16], b[16];
#pragma unroll
        for (int c = 0; c < 2; ++c) {
            const int g = 2 * h + c;
            bf16x8 qf[8];
#pragma unroll
            for (int s = 0; s < 8; ++s) qf[s] = qn[s];
            __syncthreads();
            SK_STAGE();
            __syncthreads();
            if (g < 15) { SK_FETCH(g + 1); Q_FETCH(g + 1); }
            if (c == 0) top16_of_group(qf, skl, r32, hh, lane, a); else top16_of_group(qf, skl, r32, hh, lane, b);
        }
        float fa[16], fb[16];
#pragma unroll
        for (int i = 0; i < 16; ++i) { fa[i] = s2f(a[i] & ~127); fb[i] = s2f(b[i] & ~127); lut[i * 512 + tid] = a[i] & 127; lut[(16 + i) * 512 + tid] = b[i] & 127; }
        int X[16], Y[16];
#pragma unroll
        for (int t = 0; t < 16; ++t) {
            const float s0 = fa[cx_i(0, t)] + fb[cx_j(0, t)], s1 = fa[cx_i(1, t)] + fb[cx_j(1, t)];
            const int c0 = cx_i(0, t) * 16 + cx_j(0, t), c1 = cx_i(1, t) * 16 + cx_j(1, t);
            X[t] = hh ? ((f2s(s1) & ~255) | c1) : ((f2s(s0) & ~255) | c0);
            const float u0 = fa[cy_i(0, t)] + fb[cy_j(0, t)];
            const int d0 = cy_i(0, t) * 16 + cy_j(0, t);
            int y1 = (int)0x80000000;
            if (t < 2) { const float u1 = fa[cy_i(1, t)] + fb[cy_j(1, t)]; y1 = (f2s(u1) & ~255) | (cy_i(1, t) * 16 + cy_j(1, t)); }
            Y[t] = hh ? y1 : ((f2s(u0) & ~255) | d0);
        }
        bitonic_sort16_desc(X); bitonic_merge16_desc(Y); merge_prune16(X, Y);
#pragma unroll
        for (int i = 0; i < 16; ++i) Y[i] = shx(X[i], 32, lane);
        merge_prune16(X, Y);
        const float mx = s2f(X[0] & ~255);
        float ex[16], den = 0.f;
#pragma unroll
        for (int i = 0; i < 16; ++i) { ex[i] = __builtin_amdgcn_exp2f((s2f(X[i] & ~255) - mx) * 1.4426950408889634f); den += ex[i]; }
        const float rden = 1.0f / den;
        int oi[8]; float og[8];
#pragma unroll
        for (int t = 0; t < 8; ++t) {
            const int msk = -hh;
            const int code = (X[t] ^ ((X[t] ^ X[8 + t]) & msk)) & 255;
            const int e1 = lut[(code >> 4) * 512 + tid], e2 = lut[(16 + (code & 15)) * 512 + tid];
            const int exl = __builtin_bit_cast(int, ex[t]), exh = __builtin_bit_cast(int, ex[8 + t]);
            oi[t] = e1 * 128 + e2; og[t] = __builtin_bit_cast(float, exl ^ ((exl ^ exh) & msk)) * rden;
        }
        int* ip = IDXp + lrow * 128 + h * 16 + 8 * hh; float* gp = GTp + lrow * 128 + h * 16 + 8 * hh;
        *(GAS v4u*)ip = (v4u){(unsigned)oi[0], (unsigned)oi[1], (unsigned)oi[2], (unsigned)oi[3]}; *(GAS v4u*)(ip + 4) = (v4u){(unsigned)oi[4], (unsigned)oi[5], (unsigned)oi[6], (unsigned)oi[7]};
        *(GAS f32x4*)gp = (f32x4){og[0], og[1], og[2], og[3]}; *(GAS f32x4*)(gp + 4) = (f32x4){og[4], og[5], og[6], og[7]};
    }
#undef SK_FETCH
#undef SK_STAGE
#undef Q_FETCH
}

typedef float f32x2v __attribute__((ext_vector_type(2)));
__device__ __forceinline__ void quant_row_fp8(const float* src, unsigned char* dst, float* sc_out, int lane) {
    const GAS f32x4* s = (const GAS f32x4*)src + 4 * lane;
    f32x4 v[4]; float m = 0.f;
#pragma unroll
    for (int j = 0; j < 4; ++j) { v[j] = s[j]; m = fmaxf(m, fmaxf(fmaxf(fabsf(v[j].x), fabsf(v[j].y)), fmaxf(fabsf(v[j].z), fabsf(v[j].w)))); }
#pragma unroll
    for (int o = 1; o < 64; o <<= 1) m = fmaxf(m, shx(m, o, lane));
    const float sc = m > 0.f ? 224.0f / m : 1.0f;
    v4u w;
    { int t = 0; t = __builtin_amdgcn_cvt_pk_fp8_f32(v[0].x * sc, v[0].y * sc, t, false); t = __builtin_amdgcn_cvt_pk_fp8_f32(v[0].z * sc, v[0].w * sc, t, true); w.x = (unsigned)t; }
    { int t = 0; t = __builtin_amdgcn_cvt_pk_fp8_f32(v[1].x * sc, v[1].y * sc, t, false); t = __builtin_amdgcn_cvt_pk_fp8_f32(v[1].z * sc, v[1].w * sc, t, true); w.y = (unsigned)t; }
    { int t = 0; t = __builtin_amdgcn_cvt_pk_fp8_f32(v[2].x * sc, v[2].y * sc, t, false); t = __builtin_amdgcn_cvt_pk_fp8_f32(v[2].z * sc, v[2].w * sc, t, true); w.z = (unsigned)t; }
    { int t = 0; t = __builtin_amdgcn_cvt_pk_fp8_f32(v[3].x * sc, v[3].y * sc, t, false); t = __builtin_amdgcn_cvt_pk_fp8_f32(v[3].z * sc, v[3].w * sc, t, true); w.w = (unsigned)t; }
    *(GAS v4u*)(dst + 16 * lane) = w;
    if (lane == 0) *sc_out = m > 0.f ? m * (1.0f / 224.0f) : 1.0f;
}
__device__ __forceinline__ void dq4(unsigned w, float (&f)[4]) {
    const f32x2v lo = __builtin_amdgcn_cvt_pk_f32_fp8((int)w, false), hi = __builtin_amdgcn_cvt_pk_f32_fp8((int)w, true);
    f[0] = lo.x; f[1] = lo.y; f[2] = hi.x; f[3] = hi.y;
}
__device__ __forceinline__ float dot16_fp8(const v4u u, const float (&h)[16]) {
    float f0[4], f1[4], f2[4], f3[4]; dq4(u.x, f0); dq4(u.y, f1); dq4(u.z, f2); dq4(u.w, f3);
    float a = f0[0] * h[0], b = f1[0] * h[4], c = f2[0] * h[8], d = f3[0] * h[12];
    a = fmaf(f0[1], h[1], a); b = fmaf(f1[1], h[5], b); c = fmaf(f2[1], h[9], c); d = fmaf(f3[1], h[13], d);
    a = fmaf(f0[2], h[2], a); b = fmaf(f1[2], h[6], b); c = fmaf(f2[2], h[10], c); d = fmaf(f3[2], h[14], d);
    a = fmaf(f0[3], h[3], a); b = fmaf(f1[3], h[7], b); c = fmaf(f2[3], h[11], c); d = fmaf(f3[3], h[15], d);
    return (a + b) + (c + d);
}
__device__ __forceinline__ void fma16_fp8(float (&o)[16], float cf, const v4u v) {
    float f0[4], f1[4], f2[4], f3[4]; dq4(v.x, f0); dq4(v.y, f1); dq4(v.z, f2); dq4(v.w, f3);
#pragma unroll
    for (int k = 0; k < 4; ++k) { o[k] = fmaf(cf, f0[k], o[k]); o[4 + k] = fmaf(cf, f1[k], o[4 + k]); o[8 + k] = fmaf(cf, f2[k], o[8 + k]); o[12 + k] = fmaf(cf, f3[k], o[12 + k]); }
}
#define RS_LEVEL(v, n, m) do { _Pragma("unroll") for (int _e = 0; _e < (n); ++_e) { const bool _up = (lane & (m)) != 0; const float _send = _up ? v[_e] : v[_e + (n)]; const float _keep = _up ? v[_e + (n)] : v[_e]; v[_e] = _keep + shx(_send, m, lane); } } while (0)
__device__ __forceinline__ void peer_panel(int panel, bf16* XN, const int* IDXp, const float* GTp, const unsigned char* EU8, const unsigned char* EV8, const float* SU, const float* SV, float* XIO, const int wid0) {
    const int tid = otid(wid0), lane = tid & 63, wid = __builtin_amdgcn_readfirstlane(tid >> 6);
    for (int ti = 0; ti < 32; ++ti) {
        const int lrow = wid * 32 + ti;
        const size_t row = (size_t)panel * 256 + lrow;
        const int i0 = IDXp[lrow * 128 + lane], i1 = IDXp[lrow * 128 + 64 + lane];
        const float g0 = GTp[lrow * 128 + lane], g1 = GTp[lrow * 128 + 64 + lane];
        const float su0 = SU[i0], su1 = SU[i1], sv0 = SV[i0], sv1 = SV[i1];
        float h[16];
        { const v4u hA = *(const GAS v4u*)(XN + row * DM + 16 * lane), hB = *(const GAS v4u*)(XN + row * DM + 16 * lane + 8);
          h[0] = bflo(hA.x); h[1] = bfhi(hA.x); h[2] = bflo(hA.y); h[3] = bfhi(hA.y); h[4] = bflo(hA.z); h[5] = bfhi(hA.z); h[6] = bflo(hA.w); h[7] = bfhi(hA.w);
          h[8] = bflo(hB.x); h[9] = bfhi(hB.x); h[10] = bflo(hB.y); h[11] = bfhi(hB.y); h[12] = bflo(hB.z); h[13] = bfhi(hB.z); h[14] = bflo(hB.w); h[15] = bfhi(hB.w); }
        float coef[2];
#pragma unroll
        for (int hf = 0; hf < 2; ++hf) {
            const int iv = hf ? i1 : i0;
            float q[4];
#pragma unroll
            for (int k = 0; k < 4; ++k) q[k] = 0.f;
#pragma unroll
            for (int c = 0; c < 4; ++c) {
                v4u ua[16];
#pragma unroll
                for (int j = 0; j < 16; ++j) { const int ex = __builtin_amdgcn_readlane(iv, c * 16 + j); ua[j] = *((const GAS v4u*)(EU8 + (size_t)ex * DM) + lane); }
                float p[16];
#pragma unroll
                for (int j = 0; j < 16; ++j) p[j] = dot16_fp8(ua[j], h);
                RS_LEVEL(p, 8, 8); RS_LEVEL(p, 4, 4); RS_LEVEL(p, 2, 2); RS_LEVEL(p, 1, 1);
                q[c] = p[0];
            }
            RS_LEVEL(q, 2, 32); RS_LEVEL(q, 1, 16);
            const float s = q[0] * (hf ? su1 : su0);
            const float act = 0.5f * s * (1.0f + erff(s * 0.70710678118654752f));
            coef[hf] = (hf ? g1 : g0) * act * (hf ? sv1 : sv0);
        }
        float o[16];
        { const GAS f32x4* xp = (const GAS f32x4*)(XIO + row * DM + 16 * lane);
#pragma unroll
          for (int k = 0; k < 4; ++k) { const f32x4 x = xp[k]; o[4 * k] = x.x; o[4 * k + 1] = x.y; o[4 * k + 2] = x.z; o[4 * k + 3] = x.w; } }
#pragma unroll
        for (int hf = 0; hf < 2; ++hf) {
            const int iv = hf ? i1 : i0; const float cv = coef[hf];
#pragma unroll
            for (int c = 0; c < 4; ++c) {
                v4u va[16];
#pragma unroll
                for (int j = 0; j < 16; ++j) { const int ex = __builtin_amdgcn_readlane(iv, c * 16 + j); va[j] = *((const GAS v4u*)(EV8 + (size_t)ex * DM) + lane); }
#pragma unroll
                for (int j = 0; j < 16; ++j) { const float cf = __builtin_bit_cast(float, __builtin_amdgcn_readlane(__builtin_bit_cast(int, cv), c * 16 + j)); fma16_fp8(o, cf, va[j]); }
            }
        }
        float ss = 0.f;
#pragma unroll
        for (int k = 0; k < 16; ++k) ss += o[k] * o[k];
        const float r = 1.f / sqrtf(wave_sum(ss, lane) * (1.f / DM) + RMS_EPS);
        { GAS f32x4* xp = (GAS f32x4*)(XIO + row * DM + 16 * lane);
#pragma unroll
          for (int k = 0; k < 4; ++k) xp[k] = (f32x4){o[4 * k], o[4 * k + 1], o[4 * k + 2], o[4 * k + 3]}; }
        v4u ha, hb;
        ha.x = cvtpk(o[0] * r, o[1] * r); ha.y = cvtpk(o[2] * r, o[3] * r); ha.z = cvtpk(o[4] * r, o[5] * r); ha.w = cvtpk(o[6] * r, o[7] * r);
        hb.x = cvtpk(o[8] * r, o[9] * r); hb.y = cvtpk(o[10] * r, o[11] * r); hb.z = cvtpk(o[12] * r, o[13] * r); hb.w = cvtpk(o[14] * r, o[15] * r);
        *(GAS v4u*)(XN + row * DM + 16 * lane) = ha; *(GAS v4u*)(XN + row * DM + 16 * lane + 8) = hb;
    }
}

#define BS_STAGE(K, J) do { const bool lower_ = (lane & (J)) == 0; \
    { const int p_ = shx(k0, J, lane); const bool asc_ = ((lane & (K)) == 0); const int mn_ = k0 < p_ ? k0 : p_, mx_ = k0 < p_ ? p_ : k0; k0 = (lower_ == asc_) ? mn_ : mx_; } \
    { const int p_ = shx(k1, J, lane); const bool asc_ = (((lane + 64) & (K)) == 0); const int mn_ = k1 < p_ ? k1 : p_, mx_ = k1 < p_ ? p_ : k1; k1 = (lower_ == asc_) ? mn_ : mx_; } } while (0)
#ifndef PEER_BSHIFT
#define PEER_BSHIFT 11
#endif
constexpr int PEER_NB = 16384 >> PEER_BSHIFT;
__device__ __forceinline__ void peer_sort_panel(int* IDXp, float* GTp, float* SUp, unsigned char* STp, const float* SU, const float* SV, const int wid0) {
    const int tid = otid(wid0), lane = tid & 63, wid = __builtin_amdgcn_readfirstlane(tid >> 6);
    int ni0 = IDXp[wid * 32 * 128 + lane], ni1 = IDXp[wid * 32 * 128 + 64 + lane];
    float ng0 = GTp[wid * 32 * 128 + lane], ng1 = GTp[wid * 32 * 128 + 64 + lane];
    for (int ti = 0; ti < 32; ++ti) {
        const int lrow = wid * 32 + ti;
        const int i0 = ni0, i1 = ni1; const float g0 = ng0, g1 = ng1;
        if (ti < 31) { ni0 = IDXp[(lrow + 1) * 128 + lane]; ni1 = IDXp[(lrow + 1) * 128 + 64 + lane]; ng0 = GTp[(lrow + 1) * 128 + lane]; ng1 = GTp[(lrow + 1) * 128 + 64 + lane]; }
        const float u0 = SU[i0], u1 = SU[i1], w0 = SV[i0] * g0, w1 = SV[i1] * g1;
        int k0 = (i0 << 7) | lane, k1 = (i1 << 7) | (64 + lane);
        BS_STAGE(2, 1);
        BS_STAGE(4, 2); BS_STAGE(4, 1);
        BS_STAGE(8, 4); BS_STAGE(8, 2); BS_STAGE(8, 1);
        BS_STAGE(16, 8); BS_STAGE(16, 4); BS_STAGE(16, 2); BS_STAGE(16, 1);
        BS_STAGE(32, 16); BS_STAGE(32, 8); BS_STAGE(32, 4); BS_STAGE(32, 2); BS_STAGE(32, 1);
        BS_STAGE(64, 32); BS_STAGE(64, 16); BS_STAGE(64, 8); BS_STAGE(64, 4); BS_STAGE(64, 2); BS_STAGE(64, 1);
        { const int mn_ = k0 < k1 ? k0 : k1, mx_ = k0 < k1 ? k1 : k0; k0 = mn_; k1 = mx_; }
        BS_STAGE(128, 32); BS_STAGE(128, 16); BS_STAGE(128, 8); BS_STAGE(128, 4); BS_STAGE(128, 2); BS_STAGE(128, 1);
        const int s0 = k0 & 127, s1 = k1 & 127, e0 = k0 >> 7, e1 = k1 >> 7;
        const float ua0 = shl_(u0, s0 & 63), ub0 = shl_(u1, s0 & 63), ua1 = shl_(u0, s1 & 63), ub1 = shl_(u1, s1 & 63);
        const float wa0 = shl_(w0, s0 & 63), wb0 = shl_(w1, s0 & 63), wa1 = shl_(w0, s1 & 63), wb1 = shl_(w1, s1 & 63);
        IDXp[lrow * 128 + lane] = e0; IDXp[lrow * 128 + 64 + lane] = e1;
        SUp[lrow * 128 + lane] = (s0 < 64) ? ua0 : ub0; SUp[lrow * 128 + 64 + lane] = (s1 < 64) ? ua1 : ub1;
        GTp[lrow * 128 + lane] = (s0 < 64) ? wa0 : wb0; GTp[lrow * 128 + 64 + lane] = (s1 < 64) ? wa1 : wb1;
        int stv = 0;
#pragma unroll
        for (int r = 1; r < PEER_NB; ++r) { const int c = __builtin_popcountll(__ballot(e0 < (r << PEER_BSHIFT))) + __builtin_popcountll(__ballot(e1 < (r << PEER_BSHIFT))); stv = (lane == r) ? c : stv; }
        stv = (lane == PEER_NB) ? 128 : stv;
        if (lane < 32) STp[lrow * 32 + lane] = (unsigned char)stv;
    }
}
__device__ __forceinline__ void peer_usweep_panel(int panel, const bf16* XN, const int* IDXp, const float* GMp, const float* SUp, float* CFp, const unsigned char* EU8, const int wid0) {
    const int tid = otid(wid0), lane = tid & 63, wid = __builtin_amdgcn_readfirstlane(tid >> 6);
    const int tq = (lane >> 3) & 1, pj = lane & 7;
    const size_t prow = (size_t)panel * 256;
    int ix_n; float gm_n, su_n; v4u hA0_n, hB0_n, hA1_n, hB1_n;
#define US_META(s_) do { const int c_ = (s_) >> 4, tp_ = (s_) & 15; const int lr_ = wid * 32 + 2 * tp_; const int off_ = (lr_ + tq) * 128 + 8 * c_ + pj; \
        ix_n = IDXp[off_]; gm_n = GMp[off_]; su_n = SUp[off_]; \
        const bf16* h0_ = XN + (prow + lr_) * DM + 16 * lane; hA0_n = *(const GAS v4u*)h0_; hB0_n = *(const GAS v4u*)(h0_ + 8); hA1_n = *(const GAS v4u*)(h0_ + DM); hB1_n = *(const GAS v4u*)(h0_ + DM + 8); } while (0)
    US_META(0);
    for (int s = 0; s < 256; ++s) {
        const int ix = ix_n; const float gm = gm_n, su = su_n; const v4u hA0 = hA0_n, hB0 = hB0_n, hA1 = hA1_n, hB1 = hB1_n;
        v4u ua[16];
#pragma unroll
        for (int j = 0; j < 16; ++j) { const int ex = __builtin_amdgcn_readlane(ix, j); ua[j] = *((const GAS v4u*)(EU8 + (size_t)ex * DM) + lane); }
        if (s < 255) US_META(s + 1);
        float h[16], p[16];
        h[0] = bflo(hA0.x); h[1] = bfhi(hA0.x); h[2] = bflo(hA0.y); h[3] = bfhi(hA0.y); h[4] = bflo(hA0.z); h[5] = bfhi(hA0.z); h[6] = bflo(hA0.w); h[7] = bfhi(hA0.w);
        h[8] = bflo(hB0.x); h[9] = bfhi(hB0.x); h[10] = bflo(hB0.y); h[11] = bfhi(hB0.y); h[12] = bflo(hB0.z); h[13] = bfhi(hB0.z); h[14] = bflo(hB0.w); h[15] = bfhi(hB0.w);
#pragma unroll
        for (int j = 0; j < 8; ++j) p[j] = dot16_fp8(ua[j], h);
        h[0] = bflo(hA1.x); h[1] = bfhi(hA1.x); h[2] = bflo(hA1.y); h[3] = bfhi(hA1.y); h[4] = bflo(hA1.z); h[5] = bfhi(hA1.z); h[6] = bflo(hA1.w); h[7] = bfhi(hA1.w);
        h[8] = bflo(hB1.x); h[9] = bfhi(hB1.x); h[10] = bflo(hB1.y); h[11] = bfhi(hB1.y); h[12] = bflo(hB1.z); h[13] = bfhi(hB1.z); h[14] = bflo(hB1.w); h[15] = bfhi(hB1.w);
#pragma unroll
        for (int j = 8; j < 16; ++j) p[j] = dot16_fp8(ua[j], h);
        RS_LEVEL(p, 8, 8); RS_LEVEL(p, 4, 4); RS_LEVEL(p, 2, 2); RS_LEVEL(p, 1, 1);
        float d = p[0]; d += shx(d, 16, lane); d += shx(d, 32, lane);
        const float sx = d * su;
        const float act = 0.5f * sx * (1.0f + erff(sx * 0.70710678118654752f));
        const int c = s >> 4, tp = s & 15;
        if (lane < 16) CFp[(wid * 32 + 2 * tp + tq) * 128 + 8 * c + pj] = gm * act;
    }
#undef US_META
}
__device__ __forceinline__ void peer_v_panel(int panel, bf16* XN, const int* IDXp, const float* CFp, const unsigned char* EV8, float* XIO, const int wid0) {
    const int tid = otid(wid0), lane = tid & 63, wid = __builtin_amdgcn_readfirstlane(tid >> 6);
    for (int ti = 0; ti < 32; ++ti) {
        const int lrow = wid * 32 + ti;
        const size_t row = (size_t)panel * 256 + lrow;
        const int i0 = IDXp[lrow * 128 + lane], i1 = IDXp[lrow * 128 + 64 + lane];
        const float c0 = CFp[lrow * 128 + lane], c1 = CFp[lrow * 128 + 64 + lane];
        float o[16];
        { const GAS f32x4* xp = (const GAS f32x4*)(XIO + row * DM + 16 * lane);
#pragma unroll
          for (int k = 0; k < 4; ++k) { const f32x4 x = xp[k]; o[4 * k] = x.x; o[4 * k + 1] = x.y; o[4 * k + 2] = x.z; o[4 * k + 3] = x.w; } }
#pragma unroll
        for (int hf = 0; hf < 2; ++hf) {
            const int iv = hf ? i1 : i0; const float cv = hf ? c1 : c0;
#pragma nounroll
            for (int c = 0; c < 4; ++c) {
                v4u va[16];
#pragma unroll
                for (int j = 0; j < 16; ++j) { const int ex = __builtin_amdgcn_readlane(iv, c * 16 + j); va[j] = *((const GAS v4u*)(EV8 + (size_t)ex * DM) + lane); }
#pragma unroll
                for (int j = 0; j < 16; ++j) { const float cf = __builtin_bit_cast(float, __builtin_amdgcn_readlane(__builtin_bit_cast(int, cv), c * 16 + j)); fma16_fp8(o, cf, va[j]); }
            }
        }
        float ss = 0.f;
#pragma unroll
        for (int k = 0; k < 16; ++k) ss += o[k] * o[k];
        const float r = 1.f / sqrtf(wave_sum(ss, lane) * (1.f / DM) + RMS_EPS);
        { GAS f32x4* xp = (GAS f32x4*)(XIO + row * DM + 16 * lane);
#pragma unroll
          for (int k = 0; k < 4; ++k) xp[k] = (f32x4){o[4 * k], o[4 * k + 1], o[4 * k + 2], o[4 * k + 3]}; }
        v4u ha, hb;
        ha.x = cvtpk(o[0] * r, o[1] * r); ha.y = cvtpk(o[2] * r, o[3] * r); ha.z = cvtpk(o[4] * r, o[5] * r); ha.w = cvtpk(o[6] * r, o[7] * r);
        hb.x = cvtpk(o[8] * r, o[9] * r); hb.y = cvtpk(o[10] * r, o[11] * r); hb.z = cvtpk(o[12] * r, o[13] * r); hb.w = cvtpk(o[14] * r, o[15] * r);
        *(GAS v4u*)(XN + row * DM + 16 * lane) = ha; *(GAS v4u*)(XN + row * DM + 16 * lane + 8) = hb;
    }
}

__device__ __forceinline__ void peer_vsweep_panel(int panel, bf16* XN, const int* IDXp, const float* CFp, const unsigned char* EV8, float* XIO, const int wid0) {
    const int wid = wid0;
    const size_t prow = (size_t)panel * 256;
#pragma nounroll
    for (int g = 0; g < 4; ++g) {
        const int lane = lane_id();
        const int lr0 = wid * 32 + 8 * g;
        float o[8][16];
#pragma unroll
        for (int t = 0; t < 8; ++t) { const GAS f32x4* xp = (const GAS f32x4*)(XIO + (prow + lr0 + t) * DM + 16 * lane);
#pragma unroll
            for (int k = 0; k < 4; ++k) { const f32x4 x = xp[k]; o[t][4 * k] = x.x; o[t][4 * k + 1] = x.y; o[t][4 * k + 2] = x.z; o[t][4 * k + 3] = x.w; } }
        const int moff = (lr0 + (lane >> 3)) * 128 + (lane & 7);
        int ix_n = IDXp[moff]; float cf_n = CFp[moff];
#pragma nounroll
        for (int c = 0; c < 16; ++c) {
            const int ix = ix_n; const float cf = cf_n;
            if (c < 15) { ix_n = IDXp[moff + 8 * (c + 1)]; cf_n = CFp[moff + 8 * (c + 1)]; }
#pragma unroll
            for (int b = 0; b < 8; ++b) {
                v4u va[8];
#pragma unroll
                for (int j = 0; j < 8; ++j) { const int ex = __builtin_amdgcn_readlane(ix, 8 * b + j); va[j] = *((const GAS v4u*)(EV8 + (size_t)ex * DM) + lane); }
#pragma unroll
                for (int j = 0; j < 8; ++j) { const float cfi = __builtin_bit_cast(float, __builtin_amdgcn_readlane(__builtin_bit_cast(int, cf), 8 * b + j)); fma16_fp8(o[b], cfi, va[j]); }
            }
        }
        const int lane2 = lane_id();
#pragma unroll
        for (int t = 0; t < 8; ++t) {
            const size_t row = prow + lr0 + t;
            float ss = 0.f;
#pragma unroll
            for (int k = 0; k < 16; ++k) ss += o[t][k] * o[t][k];
            const float r = 1.f / sqrtf(wave_sum(ss, lane2) * (1.f / DM) + RMS_EPS);
            GAS f32x4* xp = (GAS f32x4*)(XIO + row * DM + 16 * lane2);
#pragma unroll
            for (int k = 0; k < 4; ++k) xp[k] = (f32x4){o[t][4 * k], o[t][4 * k + 1], o[t][4 * k + 2], o[t][4 * k + 3]};
            v4u ha, hb;
            ha.x = cvtpk(o[t][0] * r, o[t][1] * r); ha.y = cvtpk(o[t][2] * r, o[t][3] * r); ha.z = cvtpk(o[t][4] * r, o[t][5] * r); ha.w = cvtpk(o[t][6] * r, o[t][7] * r);
            hb.x = cvtpk(o[t][8] * r, o[t][9] * r); hb.y = cvtpk(o[t][10] * r, o[t][11] * r); hb.z = cvtpk(o[t][12] * r, o[t][13] * r); hb.w = cvtpk(o[t][14] * r, o[t][15] * r);
            *(GAS v4u*)(XN + row * DM + 16 * lane2) = ha; *(GAS v4u*)(XN + row * DM + 16 * lane2 + 8) = hb;
        }
    }
}

template <int K, int J> __device__ __forceinline__ void s1k_stage(int (&r)[16], int lane) {
    if (J >= 64) {
#pragma unroll
        for (int q = 0; q < 16; ++q) { const int pq = q ^ (J >> 6); if (pq > q) { const bool asc = ((q * 64) & K) == 0; const int a = r[q], b = r[pq]; const int mn = a < b ? a : b, mx = a < b ? b : a; r[q] = asc ? mn : mx; r[pq] = asc ? mx : mn; } }
    } else {
        const bool lower = (lane & J) == 0;
#pragma unroll
        for (int q = 0; q < 16; ++q) { const int p = shx(r[q], J, lane); const bool asc = (((q * 64) | lane) & K) == 0; const int a = r[q]; const int mn = a < p ? a : p, mx = a < p ? p : a; r[q] = (lower == asc) ? mn : mx; }
    }
}
#define H_UNPACK(H, A, B) do { H[0] = bflo(A.x); H[1] = bfhi(A.x); H[2] = bflo(A.y); H[3] = bfhi(A.y); H[4] = bflo(A.z); H[5] = bfhi(A.z); H[6] = bflo(A.w); H[7] = bfhi(A.w); \
        H[8] = bflo(B.x); H[9] = bfhi(B.x); H[10] = bflo(B.y); H[11] = bfhi(B.y); H[12] = bflo(B.z); H[13] = bfhi(B.z); H[14] = bflo(B.w); H[15] = bfhi(B.w); } while (0)
__device__ __forceinline__ void peer_vmerged_panel(int panel, bf16* XN, const int* IDXp, const float* CFp, unsigned char* SCRp, const unsigned char* EV8, float* XIO, const int wid0) {
    const int wid = wid0;
    const size_t prow = (size_t)panel * 256;
    int* MK = (int*)(SCRp + wid * 8192); float* MCF = (float*)(MK + 1024);
#pragma nounroll
    for (int g = 0; g < 4; ++g) {
        const int lr0 = wid * 32 + 8 * g;
        {
            const int lane = lane_id();
            int key[16];
#pragma unroll
            for (int q = 0; q < 16; ++q) { const int tkn = q >> 1, pos0 = (q & 1) * 64 + lane; key[q] = (IDXp[(lr0 + tkn) * 128 + pos0] << 10) | (tkn << 7) | pos0; }
            s1k_stage<2, 1>(key, lane); s1k_stage<4, 2>(key, lane); s1k_stage<4, 1>(key, lane); s1k_stage<8, 4>(key, lane); s1k_stage<8, 2>(key, lane); s1k_stage<8, 1>(key, lane); s1k_stage<16, 8>(key, lane); s1k_stage<16, 4>(key, lane); s1k_stage<16, 2>(key, lane); s1k_stage<16, 1>(key, lane); s1k_stage<32, 16>(key, lane); s1k_stage<32, 8>(key, lane); s1k_stage<32, 4>(key, lane); s1k_stage<32, 2>(key, lane); s1k_stage<32, 1>(key, lane); s1k_stage<64, 32>(key, lane); s1k_stage<64, 16>(key, lane); s1k_stage<64, 8>(key, lane); s1k_stage<64, 4>(key, lane); s1k_stage<64, 2>(key, lane); s1k_stage<64, 1>(key, lane); s1k_stage<128, 64>(key, lane); s1k_stage<128, 32>(key, lane); s1k_stage<128, 16>(key, lane); s1k_stage<128, 8>(key, lane); s1k_stage<128, 4>(key, lane); s1k_stage<128, 2>(key, lane); s1k_stage<128, 1>(key, lane); s1k_stage<256, 128>(key, lane); s1k_stage<256, 64>(key, lane); s1k_stage<256, 32>(key, lane); s1k_stage<256, 16>(key, lane); s1k_stage<256, 8>(key, lane); s1k_stage<256, 4>(key, lane); s1k_stage<256, 2>(key, lane); s1k_stage<256, 1>(key, lane); s1k_stage<512, 256>(key, lane); s1k_stage<512, 128>(key, lane); s1k_stage<512, 64>(key, lane); s1k_stage<512, 32>(key, lane); s1k_stage<512, 16>(key, lane); s1k_stage<512, 8>(key, lane); s1k_stage<512, 4>(key, lane); s1k_stage<512, 2>(key, lane); s1k_stage<512, 1>(key, lane); s1k_stage<1024, 512>(key, lane); s1k_stage<1024, 256>(key, lane); s1k_stage<1024, 128>(key, lane); s1k_stage<1024, 64>(key, lane); s1k_stage<1024, 32>(key, lane); s1k_stage<1024, 16>(key, lane); s1k_stage<1024, 8>(key, lane); s1k_stage<1024, 4>(key, lane); s1k_stage<1024, 2>(key, lane); s1k_stage<1024, 1>(key, lane);
#pragma unroll
            for (int q = 0; q < 16; ++q) { const int tk = (key[q] >> 7) & 7, ps = key[q] & 127; MK[q * 64 + lane] = key[q]; MCF[q * 64 + lane] = CFp[(lr0 + tk) * 128 + ps]; }
            asm volatile("s_waitcnt vmcnt(0)" ::: "memory");
        }
        {
            const int lane = lane_id();
            float o[8][16];
#pragma unroll
            for (int t = 0; t < 8; ++t) { const GAS f32x4* xp = (const GAS f32x4*)(XIO + (prow + lr0 + t) * DM + 16 * lane);
#pragma unroll
                for (int k = 0; k < 4; ++k) { const f32x4 x = xp[k]; o[t][4 * k] = x.x; o[t][4 * k + 1] = x.y; o[t][4 * k + 2] = x.z; o[t][4 * k + 3] = x.w; } }
            int kx_n = MK[lane]; float cf_n = MCF[lane];
#define VM_LOAD(VA, gq) do { _Pragma("unroll") for (int j = 0; j < 8; ++j) { const int kj = __builtin_amdgcn_readlane(kx, 8 * (gq) + j); VA[j] = *((const GAS v4u*)(EV8 + (size_t)(kj >> 10) * DM) + lane); } } while (0)
#define VM_FMA(VA, gq) do { _Pragma("unroll") for (int j = 0; j < 8; ++j) { const int tk = (__builtin_amdgcn_readlane(kx, 8 * (gq) + j) >> 7) & 7; const float cfe = __builtin_bit_cast(float, __builtin_amdgcn_readlane(__builtin_bit_cast(int, cf), 8 * (gq) + j)); \
                switch (tk) { case 0: fma16_fp8(o[0], cfe, VA[j]); break; case 1: fma16_fp8(o[1], cfe, VA[j]); break; case 2: fma16_fp8(o[2], cfe, VA[j]); break; case 3: fma16_fp8(o[3], cfe, VA[j]); break; \
                              case 4: fma16_fp8(o[4], cfe, VA[j]); break; case 5: fma16_fp8(o[5], cfe, VA[j]); break; case 6: fma16_fp8(o[6], cfe, VA[j]); break; default: fma16_fp8(o[7], cfe, VA[j]); break; } } } while (0)
#pragma nounroll
            for (int c = 0; c < 16; ++c) {
                const int kx = kx_n; const float cf = cf_n;
                if (c < 15) { kx_n = MK[64 * (c + 1) + lane]; cf_n = MCF[64 * (c + 1) + lane]; }
#ifdef VM_DOUBLE
                v4u vA[8], vB[8];
                VM_LOAD(vA, 0);
                VM_LOAD(vB, 1); VM_FMA(vA, 0);
                VM_LOAD(vA, 2); VM_FMA(vB, 1);
                VM_LOAD(vB, 3); VM_FMA(vA, 2);
                VM_LOAD(vA, 4); VM_FMA(vB, 3);
                VM_LOAD(vB, 5); VM_FMA(vA, 4);
                VM_LOAD(vA, 6); VM_FMA(vB, 5);
                VM_LOAD(vB, 7); VM_FMA(vA, 6);
                VM_FMA(vB, 7);
#else
#pragma unroll
                for (int gq = 0; gq < 8; ++gq) { v4u vA[8]; VM_LOAD(vA, gq); VM_FMA(vA, gq); }
#endif
            }
#undef VM_LOAD
#undef VM_FMA
            const int lane2 = lane_id();
#pragma unroll
            for (int t = 0; t < 8; ++t) {
                const size_t row = prow + lr0 + t;
                float ss = 0.f;
#pragma unroll
                for (int k = 0; k < 16; ++k) ss += o[t][k] * o[t][k];
                const float r = 1.f / sqrtf(wave_sum(ss, lane2) * (1.f / DM) + RMS_EPS);
                GAS f32x4* xp = (GAS f32x4*)(XIO + row * DM + 16 * lane2);
#pragma unroll
                for (int k = 0; k < 4; ++k) xp[k] = (f32x4){o[t][4 * k], o[t][4 * k + 1], o[t][4 * k + 2], o[t][4 * k + 3]};
                v4u ha, hb;
                ha.x = cvtpk(o[t][0] * r, o[t][1] * r); ha.y = cvtpk(o[t][2] * r, o[t][3] * r); ha.z = cvtpk(o[t][4] * r, o[t][5] * r); ha.w = cvtpk(o[t][6] * r, o[t][7] * r);
                hb.x = cvtpk(o[t][8] * r, o[t][9] * r); hb.y = cvtpk(o[t][10] * r, o[t][11] * r); hb.z = cvtpk(o[t][12] * r, o[t][13] * r); hb.w = cvtpk(o[t][14] * r, o[t][15] * r);
                *(GAS v4u*)(XN + row * DM + 16 * lane2) = ha; *(GAS v4u*)(XN + row * DM + 16 * lane2 + 8) = hb;
            }
        }
    }
}


struct Args {
    const float *x, *p, *norm_mix, *w_in, *w_att_up, *w_pool_group, *pool_scale, *w_out, *norm_ffn, *w_query, *sub_keys, *expert_u, *expert_v, *norm_ple, *w_ple_gate, *w_ple, *norm_final;
    float* out; unsigned char* ws; int ph_hi, pad;
};

#ifndef REP_P0
#define REP_P0 1
#endif
#ifndef REP_P1
#define REP_P1 1
#endif
#ifndef REP_P23
#define REP_P23 1
#endif
#ifndef REP_P4
#define REP_P4 1
#endif
#ifndef REP_P567
#define REP_P567 1
#endif
#ifndef REP_P9
#define REP_P9 1
#endif
#ifndef REP_ATT
#define REP_ATT 1
#endif
#ifndef REP_TOPK
#define REP_TOPK 1
#endif
#ifndef REP_MRG
#define REP_MRG 1
#endif
#ifndef MK_PH_HI
#define MK_PH_HI 99
#endif

typedef const __attribute__((address_space(4))) Args* CArgs;
__device__ __forceinline__ CArgs kargs() { CArgs p = (CArgs)__builtin_amdgcn_kernarg_segment_ptr(); asm volatile("" : "+s"(p)); return p; }
#define WSP(T, off) ((T*)(kargs()->ws + (off)))
__global__ void __launch_bounds__(NTHR, 2) mega_fwd(Args a_unused) {
    extern __shared__ __attribute__((aligned(16))) unsigned char lds_raw[];
    LAS unsigned char* lds = (LAS unsigned char*)lds_raw;
    volatile LAS unsigned* MISC = (volatile LAS unsigned*)(lds + MISC_OFF);
    const int G = gridDim.x; const int bx = blockIdx.x;
    const int vcu = (G % 8 == 0) ? (bx % 8) * (G / 8) + bx / 8 : bx;
    gu32* ctl = (gu32*)(kargs()->ws + WS_CTL);
    const int wid0 = __builtin_amdgcn_readfirstlane((int)threadIdx.x >> 6);
#define IS_T0 (otid(wid0) == 0)
    for (int u = otid(wid0); u < (LDS_BYTES - LDSCTL_OFF) / 4; u += NTHR) ((LAS unsigned*)(lds + LDSCTL_OFF))[u] = 0u;
    __syncthreads();
    (void)xcd_barrier_post((unsigned*)(ctl + CW_BAR), MISC + 8, IS_T0);
#define GRID_BAR() do { XcdBarrier _b; _b.bar = (unsigned*)((gu32*)(kargs()->ws + WS_CTL) + CW_BAR); _b.x = xb_xcc_id(); _b.st = (volatile LAS unsigned*)(lds + MISC_OFF) + 8; xcd_barrier(_b, IS_T0); } while (0)
#define LOCAL_SEAM() do { VM_WAIT(); __syncthreads(); if (IS_T0) { __builtin_amdgcn_fence(__ATOMIC_ACQUIRE, "agent"); VM_WAIT(); } __syncthreads(); } while (0)

    for (int rep_ = 0; rep_ < REP_P0; ++rep_) {
        const int tid = otid(wid0), lane = tid & 63, wid = __builtin_amdgcn_readfirstlane(tid >> 6);
        const CArgs a = kargs(); unsigned char* ws = a->ws;
        bf16 *WIN = (bf16*)(ws + WS_WIN), *WOUT = (bf16*)(ws + WS_WOUT), *WQ = (bf16*)(ws + WS_WQ), *WPG = (bf16*)(ws + WS_WPG), *WPLE = (bf16*)(ws + WS_WPLE);
        bf16 *BDA = (bf16*)(ws + WS_BDA), *BDP = (bf16*)(ws + WS_BDP), *SK = (bf16*)(ws + WS_SK), *XN = (bf16*)(ws + WS_XN);
        LAS float* scr = (LAS float*)(lds + wid * 16384);
        const int gw = vcu * NWAVES + wid, NGW = G * NWAVES;
        constexpr int I_IN = (1024 / 64) * (4096 / 32), I_OUT = (1024 / 64) * (1024 / 32), I_Q = (1024 / 64) * (2048 / 32), I_PG = I_OUT, I_PLE = (256 / 64) * (1024 / 32);
        constexpr int NITEMS = I_IN + I_OUT + I_Q + I_PG + I_PLE;
        for (int it = gw; it < NITEMS; it += NGW) {
            int r = it;
            if (r < I_IN) { p0_transpose_item(a->w_in, 1024, 4096, WIN, a->norm_mix, 512, C2, scr, r, lane); continue; } r -= I_IN;
            if (r < I_OUT) { p0_transpose_item(a->w_out, 1024, 1024, WOUT, nullptr, 0, 1.f, scr, r, lane); continue; } r -= I_OUT;
            if (r < I_Q) { p0_transpose_item(a->w_query, 1024, 2048, WQ, a->norm_ffn, 0, 1.f, scr, r, lane); continue; } r -= I_Q;
            if (r < I_PG) { p0_transpose_item(a->w_ple_gate, 1024, 1024, WPG, a->norm_ple, 0, 1.f, scr, r, lane); continue; } r -= I_PG;
            p0_transpose_item(a->w_ple, 256, 1024, WPLE, nullptr, 0, 1.f, scr, r, lane);
        }
        const int gt = vcu * NTHR + tid, NGT = G * NTHR;
        for (int it = gt; it < 1024 * 16; it += NGT) {
            const int n = it >> 4, k8 = (it & 15) * 8, head = n >> 7, g = n >> 8;
            float va[8], vp[8]; const float ps = a->pool_scale[n];
#pragma unroll
            for (int j = 0; j < 8; ++j) {
                const int k = k8 + j;
                va[j] = ((k >> 6) == (head & 1)) ? a->w_att_up[((size_t)head * 64 + (k & 63)) * 128 + (n & 127)] : 0.f;
                vp[j] = a->w_pool_group[((size_t)g * 128 + k) * 256 + (n & 255)] * ps;
            }
            v4u o; o.x = pk2(va[0], va[1]); o.y = pk2(va[2], va[3]); o.z = pk2(va[4], va[5]); o.w = pk2(va[6], va[7]);
            *(GAS v4u*)(BDA + (size_t)n * 128 + k8) = o;
            o.x = pk2(vp[0], vp[1]); o.y = pk2(vp[2], vp[3]); o.z = pk2(vp[4], vp[5]); o.w = pk2(vp[6], vp[7]);
            *(GAS v4u*)(BDP + (size_t)n * 128 + k8) = o;
        }
        for (int it = gt; it < 16 * 128 * 128 / 8; it += NGT) cvt8_store(a->sub_keys + (size_t)it * 8, SK + (size_t)it * 8);
        for (int rr = gw; rr < 2 * 16384; rr += NGW) { const int e = rr >> 1;
            if (rr & 1) quant_row_fp8(a->expert_v + (size_t)e * DM, ws + WS_EV + (size_t)e * DM, (float*)(ws + WS_SV) + e, lane);
            else quant_row_fp8(a->expert_u + (size_t)e * DM, ws + WS_EU + (size_t)e * DM, (float*)(ws + WS_SU) + e, lane); }
        { const int panel = bx;
            for (int r = wid; r < 256; r += NWAVES) { const size_t row = (size_t)panel * 256 + r; rms_row_to_bf16(a->x + row * DM, XN + row * DM, lane); } }
    }
    GRID_BAR();

    for (int rep_ = 0; rep_ < REP_P1; ++rep_) {
        { const int panel = bx;
            { pg8::Gemm g{WSP(bf16, WS_XN), WSP(bf16, WS_WIN), 1024, 1024, 1024, 0, 0}; pg8::PanelSched S{panel, 14, 4, 2, 0}; pg8::EpiProj E{WSP(bf16, WS_PQ), WSP(bf16, WS_PK), WSP(bf16, WS_PU), WSP(bf16, WS_PG)};
              pg8::gemm_phase<pg8::EpiProj, pg8::PanelSched, true, true>(lds, g, S, E, wid0); }
            { pg8::Gemm g{WSP(bf16, WS_WIN) + (size_t)1024 * 1024, WSP(bf16, WS_XN), 1024, 1024, 1024, 0, 0}; pg8::PanelSched S{panel, 2, 99, 0, 1}; pg8::EpiPlain E{WSP(bf16, WS_PVT), TOK};
              pg8::gemm_phase<pg8::EpiPlain, pg8::PanelSched, true, true>(lds, g, S, E, wid0); }
        }
    }
    GRID_BAR();

    { const int panel = bx;
        const size_t prow = (size_t)panel * 256;
        for (int rep_ = 0; rep_ < REP_P23; ++rep_) {
        if (MK_PH_HI > 2) { for (int r2_ = 0; r2_ < REP_ATT; ++r2_) attn_panel(panel, WSP(bf16, WS_PQ), WSP(bf16, WS_PK), WSP(bf16, WS_PVT), WSP(bf16, WS_YA), wid0); pool_panel(panel, WSP(bf16, WS_PU), WSP(bf16, WS_YP), wid0); LOCAL_SEAM(); }
        for (int r2_ = 0; r2_ < REP_MRG; ++r2_)
        if (MK_PH_HI > 3) {
            { pg8::Gemm g{WSP(bf16, WS_YA), WSP(bf16, WS_BDA), 128, 512, 128, 128, (long)((WS_YP - WS_YA) / 2)}; pg8::PanelSched S{panel, 8, 99, 0, 0}; pg8::EpiMergeChain E{WSP(bf16, WS_PG), WSP(bf16, WS_MG)};
              pg8::gemm_phase<pg8::EpiMergeChain, pg8::PanelSched, true, true>(lds, g, S, E, wid0); }
            LOCAL_SEAM();
        }
        }
        for (int rep_ = 0; rep_ < REP_P4; ++rep_)
        if (MK_PH_HI > 4) {
            { pg8::Gemm g{WSP(bf16, WS_MG), WSP(bf16, WS_WOUT), 1024, 1024, 1024, 0, 0}; pg8::PanelSched S{panel, 4, 99, 0, 0}; pg8::EpiRes E{kargs()->x, kargs()->out};
              pg8::gemm_phase<pg8::EpiRes, pg8::PanelSched, true, true>(lds, g, S, E, wid0); }
            LOCAL_SEAM();
        }
        for (int rep_ = 0; rep_ < REP_P567; ++rep_) {
        if (MK_PH_HI > 5) {
            { const int tid = otid(wid0), lane = tid & 63, wid = __builtin_amdgcn_readfirstlane(tid >> 6); const float* xo = kargs()->out; bf16* XN = WSP(bf16, WS_XN); for (int r = wid; r < 256; r += NWAVES) rms_row_to_bf16(xo + (prow + r) * DM, XN + (prow + r) * DM, lane); }
            LOCAL_SEAM();
        }
        if (MK_PH_HI > 6) {
            { pg8::Gemm g{WSP(bf16, WS_XN), WSP(bf16, WS_WQ), 1024, 1024, 1024, 0, 0}; pg8::PanelSched S{panel, 8, 99, 0, 0}; pg8::EpiPlain E{WSP(bf16, WS_PG), 2048};
              pg8::gemm_phase<pg8::EpiPlain, pg8::PanelSched, true, true>(lds, g, S, E, wid0); }
            LOCAL_SEAM();
        }
        #define IDXP ((int*)(kargs()->ws + WS_YA + (size_t)panel * 262144))
#define GTP ((float*)(kargs()->ws + WS_YA + (size_t)panel * 262144 + 131072))
        if (MK_PH_HI > 7) { for (int r2_ = 0; r2_ < REP_TOPK; ++r2_) topk_panel(panel, WSP(bf16, WS_PG), WSP(bf16, WS_SK), IDXP, GTP, lds, wid0); LOCAL_SEAM(); }
        }
#ifndef PEER_SWEEP
#define PEER_SWEEP 1
#endif
#define STP ((unsigned char*)(kargs()->ws + WS_YP + (size_t)panel * 262144))
#define CFP ((float*)(kargs()->ws + WS_YP + (size_t)panel * 262144 + 131072))
#define SLOTP ((int*)(kargs()->ws + WS_MG + (size_t)panel * 524288 + 131072))
#define IDXPADP ((int*)(kargs()->ws + WS_PG + (size_t)panel * 1048576))
#define CFPADP ((float*)(kargs()->ws + WS_PG + (size_t)panel * 1048576 + 393216))
#define SUSP ((float*)(kargs()->ws + WS_MG + (size_t)panel * 524288))
        if (MK_PH_HI > 8) {
            if (PEER_SWEEP) {
                peer_sort_panel(IDXP, GTP, SUSP, STP, WSP(float, WS_SU), WSP(float, WS_SV), wid0); LOCAL_SEAM();
                peer_usweep_panel(panel, WSP(bf16, WS_XN), IDXP, GTP, SUSP, CFP, WSP(unsigned char, WS_EU), wid0); LOCAL_SEAM();
#ifndef PEER_VSWEEP
#define PEER_VSWEEP 1
#endif
                if (PEER_VSWEEP == 2) peer_vmerged_panel(panel, WSP(bf16, WS_XN), IDXP, CFP, WSP(unsigned char, WS_PG) + (size_t)panel * 1048576, WSP(unsigned char, WS_EV), kargs()->out, wid0);
                else if (PEER_VSWEEP) peer_vsweep_panel(panel, WSP(bf16, WS_XN), IDXP, CFP, WSP(unsigned char, WS_EV), kargs()->out, wid0);
                else peer_v_panel(panel, WSP(bf16, WS_XN), IDXP, CFP, WSP(unsigned char, WS_EV), kargs()->out, wid0);
                LOCAL_SEAM();
            } else { peer_panel(panel, WSP(bf16, WS_XN), IDXP, GTP, WSP(unsigned char, WS_EU), WSP(unsigned char, WS_EV), WSP(float, WS_SU), WSP(float, WS_SV), kargs()->out, wid0); LOCAL_SEAM(); }
        }
        for (int rep_ = 0; rep_ < REP_P9; ++rep_)
        if (MK_PH_HI > 9) {
            { const int tid = otid(wid0); const float* pp = kargs()->p; bf16* YP = WSP(bf16, WS_YP); for (int it = tid; it < 256 * 256 / 8; it += NTHR) { const int r = it >> 5, c8 = (it & 31) * 8; cvt8_store(pp + (prow + r) * 256 + c8, YP + (prow + r) * 512 + c8); } }
            LOCAL_SEAM();
            { pg8::Gemm g{WSP(bf16, WS_YP), WSP(bf16, WS_WPLE), 256, 512, 256, 0, 0}; pg8::PanelSched S{panel, 4, 99, 0, 0}; pg8::EpiPlain E{WSP(bf16, WS_MG), 1024};
              pg8::gemm_phase<pg8::EpiPlain, pg8::PanelSched, true, true>(lds, g, S, E, wid0); }
            LOCAL_SEAM();
        }
        if (MK_PH_HI > 10) {
            { pg8::Gemm g{WSP(bf16, WS_XN), WSP(bf16, WS_WPG), 1024, 1024, 1024, 0, 0}; pg8::PanelSched S{panel, 4, 99, 0, 0}; pg8::EpiGate E{kargs()->out, WSP(bf16, WS_MG)};
              pg8::gemm_phase<pg8::EpiGate, pg8::PanelSched, true, true>(lds, g, S, E, wid0); }
            LOCAL_SEAM();
        }
        if (MK_PH_HI > 11) {
            const int tid = otid(wid0), lane = tid & 63, wid = __builtin_amdgcn_readfirstlane(tid >> 6);
            for (int r = wid; r < 256; r += NWAVES) {
                GAS f32x4* xr = (GAS f32x4*)(kargs()->out + (prow + r) * DM) + lane; const GAS f32x4* gr = (const GAS f32x4*)kargs()->norm_final + lane;
                f32x4 v[4]; float s = 0.f;
#pragma unroll
                for (int j = 0; j < 4; ++j) { v[j] = xr[64 * j]; s += (v[j].x * v[j].x + v[j].y * v[j].y) + (v[j].z * v[j].z + v[j].w * v[j].w); }
                const float rr = 1.f / sqrtf(wave_sum(s, lane) * (1.f / DM) + RMS_EPS);
#pragma unroll
                for (int j = 0; j < 4; ++j) xr[64 * j] = v[j] * rr * gr[64 * j];
            }
        }
    }
#undef LOCAL_SEAM
}


#if MK_PH_HI < 99
namespace ref {
constexpr int D = 1024, NB = 8, S = 8192, T = NB * S;
constexpr int INW = 4096;
constexpr int NKEYS = 128, TOPK = 16, PH = 8;
constexpr float EPS = 1e-6f;

__device__ __forceinline__ float wave_sum(float v) {
#pragma unroll
    for (int o = 32; o > 0; o >>= 1) v += __shfl_xor(v, o);
    return v;
}
__device__ __forceinline__ float sigmoidf_(float x) { return 1.f / (1.f + expf(-x)); }

__global__ void __launch_bounds__(256) k_rms(const float* x, const float* g, float* out) {
    __shared__ float red[4];
    const size_t row = blockIdx.x;
    const float4 v = ((const float4*)(x + row * D))[threadIdx.x];
    float s = v.x * v.x + v.y * v.y + v.z * v.z + v.w * v.w;
    s = wave_sum(s);
    if ((threadIdx.x & 63) == 0) red[threadIdx.x >> 6] = s;
    __syncthreads();
    const float tot = red[0] + red[1] + red[2] + red[3];
    const float r = rsqrtf(tot * (1.f / D) + EPS);
    const float4 gg = ((const float4*)g)[threadIdx.x];
    float4 o; o.x = v.x * r * gg.x; o.y = v.y * r * gg.y; o.z = v.z * r * gg.z; o.w = v.w * r * gg.w;
    ((float4*)(out + row * D))[threadIdx.x] = o;
}

struct EpiStore { float* C; int ldc; int pad; __device__ void operator()(int r, int c, float v) const { C[(size_t)r * ldc + c] = v; } };
struct EpiResAdd { const float* R; float* C; int ldc; int pad; __device__ void operator()(int r, int c, float v) const { C[(size_t)r * ldc + c] = R[(size_t)r * ldc + c] + v; } };
struct EpiGate { const float* X; const float* E; float* C; int ldc; int pad;
    __device__ void operator()(int r, int c, float v) const { const size_t o = (size_t)r * ldc + c; C[o] = X[o] + sigmoidf_(v) * E[o]; } };

template <class Epi>
__global__ void __launch_bounds__(256) k_gemm(const float* __restrict__ A, const float* __restrict__ Bm, Epi epi, int lda, int ldb, int K, int pad_) {
    __shared__ float As[8][128 + 4];
    __shared__ float Bs[8][128 + 4];
    const int tid = threadIdx.x, tx = tid & 15, ty = tid >> 4;
    const int m0 = blockIdx.y * 128, n0 = blockIdx.x * 128;
    float acc[8][8];
#pragma unroll
    for (int i = 0; i < 8; ++i)
#pragma unroll
        for (int j = 0; j < 8; ++j) acc[i][j] = 0.f;
    const int ar = tid >> 1, ak = (tid & 1) * 4;
    const int bk = tid >> 5, bn = (tid & 31) * 4;
    for (int k0 = 0; k0 < K; k0 += 8) {
        const float4 av = *(const float4*)(A + (size_t)(m0 + ar) * lda + k0 + ak);
        const float4 bv = *(const float4*)(Bm + (size_t)(k0 + bk) * ldb + n0 + bn);
        As[ak + 0][ar] = av.x; As[ak + 1][ar] = av.y; As[ak + 2][ar] = av.z; As[ak + 3][ar] = av.w;
        *(float4*)&Bs[bk][bn] = bv;
        __syncthreads();
#pragma unroll
        for (int k = 0; k < 8; ++k) {
            const float4 a0 = *(const float4*)&As[k][ty * 8], a1 = *(const float4*)&As[k][ty * 8 + 4];
            const float4 b0 = *(const float4*)&Bs[k][tx * 8], b1 = *(const float4*)&Bs[k][tx * 8 + 4];
            const float a[8] = {a0.x, a0.y, a0.z, a0.w, a1.x, a1.y, a1.z, a1.w};
            const float b[8] = {b0.x, b0.y, b0.z, b0.w, b1.x, b1.y, b1.z, b1.w};
#pragma unroll
            for (int i = 0; i < 8; ++i)
#pragma unroll
                for (int j = 0; j < 8; ++j) acc[i][j] = fmaf(a[i], b[j], acc[i][j]);
        }
        __syncthreads();
    }
#pragma unroll
    for (int i = 0; i < 8; ++i)
#pragma unroll
        for (int j = 0; j < 8; ++j) epi(m0 + ty * 8 + i, n0 + tx * 8 + j, acc[i][j]);
}

__global__ void __launch_bounds__(64) k_attn(const float* __restrict__ proj, float* __restrict__ yatt) {
    const int t = blockIdx.x * 64 + threadIdx.x;
    const int h = blockIdx.y;
    float q[64], acc[64];
    const float* qp = proj + (size_t)t * INW + h * 64;
#pragma unroll
    for (int d = 0; d < 64; ++d) { q[d] = qp[d] * 0.125f; acc[d] = 0.f; }
    float surv = 1.f;
    for (int s = t - 1; s >= 0; --s) {
        const float* kp = proj + (size_t)s * INW + 512 + h * 64;
        float z = 0.f;
#pragma unroll
        for (int d = 0; d < 64; ++d) z = fmaf(q[d], kp[d], z);
        const float beta = 1.f / (1.f + expf(-z));
        const float w = beta * surv;
        const float* vp = kp + 512;
#pragma unroll
        for (int d = 0; d < 64; ++d) acc[d] = fmaf(w, vp[d], acc[d]);
        surv -= w;
        if (surv < 5.4e-20f) break;
    }
    float* o = yatt + (size_t)t * 512 + h * 64;
#pragma unroll
    for (int d = 0; d < 64; ++d) o[d] = acc[d];
}

__global__ void __launch_bounds__(256) k_pool(const float* __restrict__ proj, float* __restrict__ ypool) {
    const int i = blockIdx.x * 256 + threadIdx.x;
    const int t = i >> 9, c = i & 511, g = c >> 7, w = 2 << g;
    const int cnt = (t + 1 < w) ? (t + 1) : w;
    float s = 0.f;
    for (int j = 0; j < cnt; ++j) s += proj[(size_t)(t - j) * INW + 1536 + c];
    ypool[i] = s / (float)cnt - proj[(size_t)t * INW + 1536 + c];
}

__global__ void __launch_bounds__(256) k_merge(const float* __restrict__ proj, const float* __restrict__ yatt, const float* __restrict__ ypool,
                                               const float* __restrict__ wa, const float* __restrict__ wp, const float* __restrict__ pscale, float* __restrict__ merged) {
    const int t = blockIdx.x, tid = threadIdx.x;
    __shared__ float sa[512], sp[512];
    sa[tid] = yatt[(size_t)t * 512 + tid]; sa[tid + 256] = yatt[(size_t)t * 512 + tid + 256];
    sp[tid] = ypool[(size_t)t * 512 + tid]; sp[tid + 256] = ypool[(size_t)t * 512 + tid + 256];
    __syncthreads();
    for (int e = tid; e < D; e += 256) {
        const int h = e >> 7, ea = e & 127, g = e >> 8, ep = e & 255;
        float a = 0.f, p = 0.f;
        for (int d = 0; d < 64; ++d) a = fmaf(sa[h * 64 + d], wa[((size_t)h * 64 + d) * 128 + ea], a);
        for (int c = 0; c < 128; ++c) p = fmaf(sp[g * 128 + c], wp[((size_t)g * 128 + c) * 256 + ep], p);
        p *= pscale[e];
        const float ga = proj[(size_t)t * INW + 2048 + e], gp = proj[(size_t)t * INW + 3072 + e];
        merged[(size_t)t * D + e] = sigmoidf_(ga) * a + sigmoidf_(gp) * p;
    }
}

__global__ void __launch_bounds__(256) k_scores(const float* __restrict__ qp, const float* __restrict__ sk, float* __restrict__ sc) {
    const int t0 = blockIdx.x * 4, tid = threadIdx.x;
    __shared__ float sq[4][2048];
    for (int i = tid; i < 4 * 2048; i += 256) sq[i >> 11][i & 2047] = qp[(size_t)t0 * 2048 + i];
    __syncthreads();
    for (int j = tid; j < 2048; j += 256) {
        const int g = j >> 7;
        const float4* kr = (const float4*)(sk + (size_t)j * 128);
        float a0 = 0.f, a1 = 0.f, a2 = 0.f, a3 = 0.f;
        for (int d = 0; d < 32; ++d) {
            const float4 kv = kr[d];
            const float4 q0 = *(const float4*)&sq[0][g * 128 + d * 4], q1 = *(const float4*)&sq[1][g * 128 + d * 4];
            const float4 q2 = *(const float4*)&sq[2][g * 128 + d * 4], q3 = *(const float4*)&sq[3][g * 128 + d * 4];
            a0 = fmaf(q0.x, kv.x, a0); a0 = fmaf(q0.y, kv.y, a0); a0 = fmaf(q0.z, kv.z, a0); a0 = fmaf(q0.w, kv.w, a0);
            a1 = fmaf(q1.x, kv.x, a1); a1 = fmaf(q1.y, kv.y, a1); a1 = fmaf(q1.z, kv.z, a1); a1 = fmaf(q1.w, kv.w, a1);
            a2 = fmaf(q2.x, kv.x, a2); a2 = fmaf(q2.y, kv.y, a2); a2 = fmaf(q2.z, kv.z, a2); a2 = fmaf(q2.w, kv.w, a2);
            a3 = fmaf(q3.x, kv.x, a3); a3 = fmaf(q3.y, kv.y, a3); a3 = fmaf(q3.z, kv.z, a3); a3 = fmaf(q3.w, kv.w, a3);
        }
        sc[(size_t)(t0 + 0) * 2048 + j] = a0; sc[(size_t)(t0 + 1) * 2048 + j] = a1;
        sc[(size_t)(t0 + 2) * 2048 + j] = a2; sc[(size_t)(t0 + 3) * 2048 + j] = a3;
    }
}

__device__ __forceinline__ void wave_argmax(float& v, int& i) {
#pragma unroll
    for (int o = 32; o > 0; o >>= 1) {
        const float ov = __shfl_xor(v, o); const int oi = __shfl_xor(i, o);
        if (ov > v || (ov == v && oi < i)) { v = ov; i = oi; }
    }
}

__global__ void __launch_bounds__(256) k_topk(const float* __restrict__ sc, int* __restrict__ idx, float* __restrict__ gates) {
    const int wv = threadIdx.x >> 6, lane = threadIdx.x & 63;
    const int pair = blockIdx.x * 4 + wv;
    const int t = pair >> 3, h = pair & 7;
    __shared__ float stop[4][2][16];
    __shared__ int itop[4][2][16];
    for (int c = 0; c < 2; ++c) {
        const float* sr = sc + (size_t)t * 2048 + (h * 2 + c) * 128;
        float v0 = sr[lane], v1 = sr[lane + 64];
        for (int k = 0; k < TOPK; ++k) {
            float bv; int bi;
            if (v1 > v0) { bv = v1; bi = lane + 64; } else { bv = v0; bi = lane; }
            wave_argmax(bv, bi);
            if (lane == 0) { stop[wv][c][k] = bv; itop[wv][c][k] = bi; }
            if (bi == lane) v0 = -INFINITY;
            if (bi == lane + 64) v1 = -INFINITY;
        }
    }
    __syncthreads();
    float cv[4];
#pragma unroll
    for (int j = 0; j < 4; ++j) { const int p = lane + 64 * j; cv[j] = stop[wv][0][p >> 4] + stop[wv][1][p & 15]; }
    __shared__ float sbs[4][16];
    __shared__ int sbp[4][16];
    for (int k = 0; k < TOPK; ++k) {
        float bv = cv[0]; int bi = lane;
#pragma unroll
        for (int j = 1; j < 4; ++j) if (cv[j] > bv) { bv = cv[j]; bi = lane + 64 * j; }
        wave_argmax(bv, bi);
        if (lane == 0) { sbs[wv][k] = bv; sbp[wv][k] = bi; }
#pragma unroll
        for (int j = 0; j < 4; ++j) if (bi == lane + 64 * j) cv[j] = -INFINITY;
    }
    __syncthreads();
    const float mx = sbs[wv][0];
    const float myv = (lane < TOPK) ? sbs[wv][lane] : -INFINITY;
    const float ex = (lane < TOPK) ? expf(myv - mx) : 0.f;
    const float den = wave_sum(ex);
    if (lane < TOPK) {
        const int myp = sbp[wv][lane];
        const int e = itop[wv][0][myp >> 4] * NKEYS + itop[wv][1][myp & 15];
        idx[(size_t)t * 128 + h * 16 + lane] = e;
        gates[(size_t)t * 128 + h * 16 + lane] = ex / den;
    }
}

__global__ void __launch_bounds__(256) k_peer(const float* __restrict__ hn, const int* __restrict__ idx, const float* __restrict__ gates,
                                              const float* __restrict__ eu, const float* __restrict__ ev, float* xio) {
    const int t = blockIdx.x, tid = threadIdx.x, wv = tid >> 6, lane = tid & 63;
    __shared__ float coef[128];
    __shared__ int sidx[128];
    const float4* hr = (const float4*)(hn + (size_t)t * D);
    float4 hv[4];
#pragma unroll
    for (int j = 0; j < 4; ++j) hv[j] = hr[lane + 64 * j];
    if (tid < 128) sidx[tid] = idx[(size_t)t * 128 + tid];
    __syncthreads();
    for (int p = wv; p < 128; p += 4) {
        const float4* ur = (const float4*)(eu + (size_t)sidx[p] * D);
        float s = 0.f;
#pragma unroll
        for (int j = 0; j < 4; ++j) { const float4 u = ur[lane + 64 * j]; s += u.x * hv[j].x + u.y * hv[j].y + u.z * hv[j].z + u.w * hv[j].w; }
        s = wave_sum(s);
        const float act = 0.5f * s * (1.f + erff(s * 0.70710678118654752f));
        if (lane == 0) coef[p] = gates[(size_t)t * 128 + p] * act;
    }
    __syncthreads();
    float4 o = ((const float4*)(xio + (size_t)t * D))[tid];
    for (int p = 0; p < 128; ++p) {
        const float c = coef[p];
        const float4 v = ((const float4*)(ev + (size_t)sidx[p] * D))[tid];
        o.x = fmaf(c, v.x, o.x); o.y = fmaf(c, v.y, o.y); o.z = fmaf(c, v.z, o.z); o.w = fmaf(c, v.w, o.w);
    }
    ((float4*)(xio + (size_t)t * D))[tid] = o;
}

__global__ void __launch_bounds__(256) k_bf16_to_f32(const unsigned short* __restrict__ src, float* __restrict__ dst) {
    const size_t i = (size_t)blockIdx.x * 256 + threadIdx.x; dst[i] = __uint_as_float((unsigned)src[i] << 16);
}
__global__ void __launch_bounds__(128) k_gather_idx(const unsigned char* __restrict__ ya, int row0, int* __restrict__ idx, float* __restrict__ gates) {
    const int r = blockIdx.x, grow = row0 + r, panel = grow >> 8, lrow = grow & 255;
    const int* ip = (const int*)(ya + (size_t)panel * 262144); const float* gp = (const float*)(ya + (size_t)panel * 262144 + 131072);
    idx[(size_t)r * 128 + threadIdx.x] = ip[lrow * 128 + threadIdx.x]; gates[(size_t)r * 128 + threadIdx.x] = gp[lrow * 128 + threadIdx.x];
}
}
#endif

extern "C" void kernel_launch(void* const* d_in, const int* in_sizes, int n_in, void* d_out, int out_size, void* d_ws, size_t ws_size, hipStream_t stream) {
    static int grid = 0;
    if (grid == 0) {
        if (n_in != 17 || in_sizes[0] != TOK * DM || out_size != TOK * DM || ws_size < WS_END) { fprintf(stderr, "kernel_launch: unexpected shapes (n_in %d, in0 %d, out %d, ws %zu); nothing launched\n", n_in, n_in > 0 ? in_sizes[0] : -1, out_size, ws_size); grid = -1; return; }
        int dev = 0, cus = 0;
        if (hipGetDevice(&dev) != hipSuccess || hipDeviceGetAttribute(&cus, hipDeviceAttributeMultiprocessorCount, dev) != hipSuccess) { fprintf(stderr, "kernel_launch: device query failed\n"); grid = -1; return; }
        if (hipFuncSetAttribute((const void*)mega_fwd, hipFuncAttributeMaxDynamicSharedMemorySize, LDS_BYTES) != hipSuccess) { fprintf(stderr, "kernel_launch: hipFuncSetAttribute failed\n"); grid = -1; return; }
        int per_cu = 0;
        if (hipOccupancyMaxActiveBlocksPerMultiprocessor(&per_cu, (const void*)mega_fwd, NTHR, LDS_BYTES) != hipSuccess || per_cu < 1) fprintf(stderr, "kernel_launch: note: occupancy query reports %d workgroups per CU\n", per_cu);
        (void)hipGetLastError();
        if (cus != NPANEL) fprintf(stderr, "kernel_launch: note: %d CUs; this kernel is built for one 256-token panel per CU on a 256-CU device\n", cus);
        grid = NPANEL;
    }
    if (grid < 0) return;
    if (hipMemsetAsync((char*)d_ws + WS_CTL, 0, CTL_ZERO_BYTES, stream) != hipSuccess) { fprintf(stderr, "kernel_launch: memset failed\n"); return; }
    Args a{};
    a.x = (const float*)d_in[0]; a.p = (const float*)d_in[1]; a.norm_mix = (const float*)d_in[2]; a.w_in = (const float*)d_in[3]; a.w_att_up = (const float*)d_in[4];
    a.w_pool_group = (const float*)d_in[5]; a.pool_scale = (const float*)d_in[6]; a.w_out = (const float*)d_in[7]; a.norm_ffn = (const float*)d_in[8]; a.w_query = (const float*)d_in[9];
    a.sub_keys = (const float*)d_in[10]; a.expert_u = (const float*)d_in[11]; a.expert_v = (const float*)d_in[12]; a.norm_ple = (const float*)d_in[13]; a.w_ple_gate = (const float*)d_in[14];
    a.w_ple = (const float*)d_in[15]; a.norm_final = (const float*)d_in[16];
    a.out = (float*)d_out; a.ws = (unsigned char*)d_ws; a.ph_hi = MK_PH_HI; a.pad = 0;
    hipLaunchKernelGGL(mega_fwd, dim3(grid), dim3(NTHR), LDS_BYTES, stream, a);
    { const hipError_t le = hipPeekAtLastError(); if (le != hipSuccess) fprintf(stderr, "kernel_launch: launch failed: %s\n", hipGetErrorName(le)); }
#if MK_PH_HI < 99
    {
        using namespace ref;
        char* ws = (char*)d_ws; float* out = (float*)d_out;
        float* hbuf = (float*)(ws + 0 * MiB); float* qp = (float*)(ws + 32 * MiB); float* sc = (float*)(ws + 96 * MiB);
        int* idx = (int*)(ws + 160 * MiB); float* gates = (float*)(ws + 164 * MiB); float* ebuf = (float*)(ws + 168 * MiB);
        for (int b = 0; b < NB; ++b) {
            const float* pb = a.p + (size_t)b * S * 256; float* ob = out + (size_t)b * S * D;
#if MK_PH_HI == 5
            k_rms<<<S, 256, 0, stream>>>(ob, a.norm_ffn, hbuf);
            k_gemm<EpiStore><<<dim3(2048 / 128, S / 128), 256, 0, stream>>>(hbuf, a.w_query, EpiStore{qp, 2048}, D, 2048, D, 0);
            k_scores<<<S / 4, 256, 0, stream>>>(qp, a.sub_keys, sc);
            k_topk<<<S * 8 / 4, 256, 0, stream>>>(sc, idx, gates);
            k_peer<<<S, 256, 0, stream>>>(hbuf, idx, gates, a.expert_u, a.expert_v, ob);
#elif MK_PH_HI == 7
            k_rms<<<S, 256, 0, stream>>>(ob, a.norm_ffn, hbuf);
            k_bf16_to_f32<<<S * 2048 / 256, 256, 0, stream>>>((const unsigned short*)(ws + WS_PG) + (size_t)b * S * 2048, qp);
            k_scores<<<S / 4, 256, 0, stream>>>(qp, a.sub_keys, sc);
            k_topk<<<S * 8 / 4, 256, 0, stream>>>(sc, idx, gates);
            k_peer<<<S, 256, 0, stream>>>(hbuf, idx, gates, a.expert_u, a.expert_v, ob);
#elif MK_PH_HI == 8
            k_rms<<<S, 256, 0, stream>>>(ob, a.norm_ffn, hbuf);
            k_gather_idx<<<S, 128, 0, stream>>>((const unsigned char*)(ws + WS_YA), b * S, idx, gates);
            k_peer<<<S, 256, 0, stream>>>(hbuf, idx, gates, a.expert_u, a.expert_v, ob);
#endif
            k_rms<<<S, 256, 0, stream>>>(ob, a.norm_ple, hbuf);
            k_gemm<EpiStore><<<dim3(D / 128, S / 128), 256, 0, stream>>>(pb, a.w_ple, EpiStore{ebuf, D}, 256, D, 256, 0);
            k_gemm<EpiGate><<<dim3(D / 128, S / 128), 256, 0, stream>>>(hbuf, a.w_ple_gate, EpiGate{ob, ebuf, ob, D}, D, D, D, 0);
            k_rms<<<S, 256, 0, stream>>>(ob, a.norm_final, ob);
        }
    }
#endif
}
```

```cpp
#include <hip/hip_runtime.h>
#include <cstdio>
#include <cstdint>
#include <math.h>
__device__ __forceinline__ int lane_id() { int l; asm volatile("v_mbcnt_lo_u32_b32 %0, -1, 0\n\tv_mbcnt_hi_u32_b32 %0, -1, %0" : "=v"(l)); return l; }
__device__ __forceinline__ int otid(int wid0) { return (wid0 << 6) | lane_id(); }

namespace pg8 {
#define PG8_LAS __attribute__((address_space(3)))
typedef unsigned short bf16_t;
typedef short bf16x8 __attribute__((ext_vector_type(8)));
typedef float f32x4 __attribute__((ext_vector_type(4)));
typedef unsigned u32x4 __attribute__((ext_vector_type(4)));
constexpr int BM = 256, BK = 64, HALF = 128, HTB = HALF * BK * 2  , STAGE_BYTES = 8 * HTB, NXCD = 8, WGM = 8;

__host__ __device__ __forceinline__ int lds_byte(int r, int c) { const int st = (r >> 4) * 2 + (c >> 5), rr = r & 15, cc = c & 31, ob = rr * 64 + cc * 2; return st * 1024 + (ob ^ (((ob >> 9) & 1) << 5)); }
__host__ __device__ __forceinline__ void stage_rc(int b, int& R, int& C) { const int st = b / 1024, sb = b % 1024, swz = sb ^ (((sb >> 9) & 1) << 5); R = (st >> 1) * 16 + swz / 64; C = (st & 1) * 32 + (swz % 64) / 2; }
__host__ __device__ __forceinline__ int perm32(int rho) { const int n = rho >> 4, i = rho & 15; return 8 * (i >> 2) + 4 * n + (i & 3); }

struct Unit { int pm, pn; };
struct Gemm { const bf16_t* A; const bf16_t* Bt; int K, lda, ldb, akoff; long a2off; int am, pad_; };

struct StaticOrder {
    int nM, nN, nwg, G, c;
    __host__ __device__ void init(int M, int N, int G_, int c_) { nM = M / BM; nN = N / BM; nwg = nM * nN; G = G_; c = c_; }
    __host__ __device__ bool next(int i, Unit& u) const {
        const long L = (long)i * G + c; if (L >= nwg) return false;
        int wgid = (int)L; { const int q = nwg / NXCD, r = nwg % NXCD, xcd = wgid % NXCD, off = wgid / NXCD; wgid = (xcd < r ? xcd * (q + 1) : r * (q + 1) + (xcd - r) * q) + off; }
        const int nig = WGM * nN, gid = wgid / nig, fm = gid * WGM, gsz = (nM - fm) < WGM ? (nM - fm) : WGM;
        u.pm = fm + ((wgid % nig) % gsz); u.pn = (wgid % nig) / gsz; return true;
    }
    __device__ __forceinline__ void a_ready(const Unit&) const {}
    __device__ __forceinline__ void done(const Unit&) const {}
};

template <class Epi, class Sched, bool ALIGN_EPI = false, bool SP2 = false>
__device__ __forceinline__ void gemm_phase(PG8_LAS unsigned char* lds, const Gemm g, const Sched& S, const Epi& E, const int wid0) {
    const int tid = otid(wid0), wid = __builtin_amdgcn_readfirstlane(tid >> 6), lane = tid & 63, wr = wid >> 2, wc = wid & 3, fr = lane & 15, fq = lane >> 4;
    const int K = g.K, nt = K / BK;
    unsigned voffA[2], voffB[2];
#pragma unroll
    for (int i = 0; i < 2; ++i) { int R, C; stage_rc(tid * 16 + i * 8192, R, C); const int Rb = Epi::PERM ? ((R & ~31) + perm32(R & 31)) : R;
        voffA[i] = (unsigned)(R * g.lda + C) * 2u; voffB[i] = (unsigned)(Rb * g.ldb + C) * 2u; }
    const size_t kstep = (size_t)(BK * 2);
    const size_t hstepA = (size_t)HALF * g.lda * 2, hstepB = (size_t)HALF * g.ldb * 2;
    const size_t tstepA = 2 * hstepA, tstepB = 2 * hstepB, akb = (size_t)g.akoff * 2, a2b = (size_t)g.a2off * 2;
    const unsigned ldsw = (unsigned)wid * 1024u;
    const int aoff = lds_byte(wr * 64 + fr, fq * 8), boff = lds_byte(wc * 32 + fr, fq * 8);
#define PG8_SA(b, h) (((b) * 2 + (h)) * HTB)
#define PG8_SB(b, h) ((4 + (b) * 2 + (h)) * HTB)
#define PG8_STAGE(bufoff, gbase, voff) do { _Pragma("unroll") for (int _i = 0; _i < 2; ++_i) \
        __builtin_amdgcn_global_load_lds((const unsigned*)((const char*)(gbase) + (voff)[_i]), (PG8_LAS unsigned*)(lds + (bufoff) + ldsw + _i * 8192), 16, 0, 0); } while (0)
#define PG8_LDA(dst, b, h) do { _Pragma("unroll") for (int m = 0; m < 4; ++m) _Pragma("unroll") for (int k = 0; k < 2; ++k) dst[m][k] = *(const PG8_LAS bf16x8*)(lds + PG8_SA(b, h) + aoff + m * 2048 + k * 1024); } while (0)
#define PG8_LDB(dst, b, h) do { _Pragma("unroll") for (int n = 0; n < 2; ++n) _Pragma("unroll") for (int k = 0; k < 2; ++k) dst[n][k] = *(const PG8_LAS bf16x8*)(lds + PG8_SB(b, h) + boff + n * 2048 + k * 1024); } while (0)
#define PG8_MMA(ai, bj, At, Bt) do { __builtin_amdgcn_s_setprio(1); _Pragma("unroll") for (int m = 0; m < 4; ++m) _Pragma("unroll") for (int n = 0; n < 2; ++n) _Pragma("unroll") for (int k = 0; k < 2; ++k) \
        acc[ai][bj][m][n] = __builtin_amdgcn_mfma_f32_16x16x32_bf16(Bt[n][k], At[m][k], acc[ai][bj][m][n], 0, 0, 0); __builtin_amdgcn_s_setprio(0); } while (0)
#define PG8_WAIT_V(n) asm volatile("s_waitcnt vmcnt(" #n ")" ::: "memory")
#define PG8_WAIT_L(n) asm volatile("s_waitcnt lgkmcnt(" #n ")" ::: "memory")
#define PG8_BAR __builtin_amdgcn_s_barrier()
#define PG8_SCHED __builtin_amdgcn_sched_barrier(0)
    Unit cur, nxt; int ui = 0;
    if (!S.next(0, cur)) return;
    f32x4 acc[2][2][4][2];
#pragma unroll
    for (int a = 0; a < 2; ++a)
#pragma unroll
        for (int b = 0; b < 2; ++b)
#pragma unroll
            for (int m = 0; m < 4; ++m)
#pragma unroll
                for (int n = 0; n < 2; ++n) acc[a][b][m][n] = (f32x4){0.f, 0.f, 0.f, 0.f};
    bf16x8 At[4][2], B0[2][2], B1[2][2];
    const char* cA = (const char*)g.A + (size_t)(cur.pm * g.am) * tstepA + (size_t)(cur.pn & 3) * akb + (size_t)(cur.pn >> 2) * a2b; const char* cB = (const char*)g.Bt + (size_t)cur.pn * tstepB;
    S.a_ready(cur);
    if constexpr (SP2) {
        PG8_STAGE(PG8_SB(0, 0), cB, voffB); PG8_STAGE(PG8_SB(0, 1), cB + hstepB, voffB); PG8_STAGE(PG8_SA(0, 0), cA, voffA); PG8_STAGE(PG8_SA(0, 1), cA + hstepA, voffA);
        if (wr == 1) PG8_BAR;
        PG8_WAIT_V(2); PG8_BAR;
        PG8_STAGE(PG8_SB(1, 0), cB + kstep, voffB); PG8_STAGE(PG8_SA(1, 0), cA + kstep, voffA); PG8_STAGE(PG8_SB(1, 1), cB + hstepB + kstep, voffB);
        PG8_WAIT_V(6); PG8_BAR;
    } else {
        PG8_STAGE(PG8_SB(0, 0), cB, voffB); PG8_STAGE(PG8_SA(0, 0), cA, voffA); PG8_STAGE(PG8_SB(0, 1), cB + hstepB, voffB); PG8_STAGE(PG8_SA(0, 1), cA + hstepA, voffA);
        if (wr == 1) PG8_BAR;
        PG8_WAIT_V(4); PG8_BAR;
        PG8_STAGE(PG8_SB(1, 0), cB + kstep, voffB); PG8_STAGE(PG8_SA(1, 0), cA + kstep, voffA); PG8_STAGE(PG8_SB(1, 1), cB + hstepB + kstep, voffB);
        PG8_WAIT_V(6); PG8_BAR;
    }
    for (;;) {
        const bool has_next = S.next(ui + 1, nxt);
        const char* nA = has_next ? (const char*)g.A + (size_t)(nxt.pm * g.am) * tstepA + (size_t)(nxt.pn & 3) * akb + (size_t)(nxt.pn >> 2) * a2b : cA; const char* nB = has_next ? (const char*)g.Bt + (size_t)nxt.pn * tstepB : cB;
        for (int t = 0; t < nt; t += 2) {
            const bool last = (t == nt - 2);
            const char* a1 = cA + (size_t)(t + 1) * kstep;
            const char* a2 = last ? nA : cA + (size_t)(t + 2) * kstep; const char* b2 = last ? nB : cB + (size_t)(t + 2) * kstep;
            const char* a3 = a2 + kstep; const char* b3 = b2 + kstep;
            if (last && has_next) S.a_ready(nxt);
            if constexpr (SP2) {
            PG8_LDB(B0, 0, 0); PG8_LDB(B1, 0, 1); PG8_SCHED; PG8_LDA(At, 0, 0); PG8_STAGE(PG8_SA(1, 1), a1 + hstepA, voffA);
            PG8_WAIT_V(8); PG8_WAIT_L(0); PG8_BAR; PG8_MMA(0, 0, At, B0); PG8_MMA(0, 1, At, B1); PG8_BAR; PG8_SCHED;
            PG8_LDA(At, 0, 1); PG8_STAGE(PG8_SB(0, 0), b2, voffB); PG8_STAGE(PG8_SB(0, 1), b2 + hstepB, voffB); PG8_STAGE(PG8_SA(0, 0), a2, voffA);
            PG8_WAIT_V(8); PG8_WAIT_L(0); PG8_BAR; PG8_MMA(1, 0, At, B0); PG8_MMA(1, 1, At, B1); PG8_BAR; PG8_SCHED;
            PG8_LDB(B0, 1, 0); PG8_LDB(B1, 1, 1); PG8_SCHED; PG8_LDA(At, 1, 0); PG8_STAGE(PG8_SA(0, 1), a2 + hstepA, voffA);
            PG8_WAIT_V(8); PG8_WAIT_L(0); PG8_BAR; PG8_MMA(0, 0, At, B0); PG8_MMA(0, 1, At, B1); PG8_BAR; PG8_SCHED;
            PG8_LDA(At, 1, 1); PG8_STAGE(PG8_SB(1, 0), b3, voffB); PG8_STAGE(PG8_SB(1, 1), b3 + hstepB, voffB); PG8_STAGE(PG8_SA(1, 0), a3, voffA);
            PG8_WAIT_V(8); PG8_WAIT_L(0); PG8_BAR; PG8_MMA(1, 0, At, B0); PG8_MMA(1, 1, At, B1); PG8_BAR; PG8_SCHED;
            } else {
            PG8_LDB(B0, 0, 0); PG8_SCHED; PG8_LDA(At, 0, 0); PG8_STAGE(PG8_SA(1, 1), a1 + hstepA, voffA);
            PG8_WAIT_L(8); PG8_BAR; PG8_WAIT_L(0); PG8_MMA(0, 0, At, B0); PG8_BAR; PG8_SCHED;
            PG8_LDB(B1, 0, 1); PG8_STAGE(PG8_SB(0, 0), b2, voffB);
            PG8_BAR; PG8_WAIT_L(0); PG8_MMA(0, 1, At, B1); PG8_BAR;
            PG8_LDA(At, 0, 1); PG8_STAGE(PG8_SA(0, 0), a2, voffA);
            PG8_BAR; PG8_WAIT_L(0); PG8_MMA(1, 0, At, B0); PG8_BAR; PG8_SCHED;
            PG8_STAGE(PG8_SB(0, 1), b2 + hstepB, voffB);
            PG8_WAIT_V(6); PG8_BAR; PG8_MMA(1, 1, At, B1); PG8_BAR;
            PG8_LDB(B0, 1, 0); PG8_SCHED; PG8_LDA(At, 1, 0); PG8_STAGE(PG8_SA(0, 1), a2 + hstepA, voffA);
            PG8_WAIT_L(8); PG8_BAR; PG8_WAIT_L(0); PG8_MMA(0, 0, At, B0); PG8_BAR; PG8_SCHED;
            PG8_LDB(B1, 1, 1); PG8_STAGE(PG8_SB(1, 0), b3, voffB);
            PG8_BAR; PG8_WAIT_L(0); PG8_MMA(0, 1, At, B1); PG8_BAR;
            PG8_LDA(At, 1, 1); PG8_STAGE(PG8_SA(1, 0), a3, voffA);
            PG8_BAR; PG8_WAIT_L(0); PG8_MMA(1, 0, At, B0); PG8_BAR; PG8_SCHED;
            PG8_STAGE(PG8_SB(1, 1), b3 + hstepB, voffB);
            PG8_WAIT_V(6); PG8_BAR; PG8_MMA(1, 1, At, B1); PG8_BAR;
            }
        }
        if constexpr (ALIGN_EPI) { if (wr == 0) PG8_BAR; }
        if constexpr (!Epi::AFTER_DRAIN) { E(acc, cur, wr, wc, fr, fq); S.done(cur); }
        if (!has_next) break;
#pragma unroll
        for (int a = 0; a < 2; ++a)
#pragma unroll
            for (int b = 0; b < 2; ++b)
#pragma unroll
                for (int m = 0; m < 4; ++m)
#pragma unroll
                    for (int n = 0; n < 2; ++n) acc[a][b][m][n] = (f32x4){0.f, 0.f, 0.f, 0.f};
        cur = nxt; cA = nA; cB = nB; ++ui;
        if constexpr (ALIGN_EPI) { if (wr == 1) PG8_BAR; }
    }
    PG8_WAIT_V(0);
    if constexpr (!ALIGN_EPI) { if (wr == 0) PG8_BAR; }
    PG8_BAR;
    if constexpr (Epi::AFTER_DRAIN) { E.fused(acc, cur, wr, wc, fr, fq, lds, wid, lane); S.done(cur); }
#undef PG8_SA
#undef PG8_SB
#undef PG8_STAGE
#undef PG8_LDA
#undef PG8_LDB
#undef PG8_MMA
#undef PG8_WAIT_V
#undef PG8_WAIT_L
#undef PG8_BAR
#undef PG8_SCHED
}
}


namespace pg8 {
typedef unsigned u32x2 __attribute__((ext_vector_type(2)));
__device__ __forceinline__ unsigned cvt_pk_bf16(float lo, float hi) { unsigned r; asm volatile("v_cvt_pk_bf16_f32 %0, %1, %2" : "=v"(r) : "v"(lo), "v"(hi)); return r; }
__device__ __forceinline__ float sigm(float x) { return __builtin_amdgcn_rcpf(1.0f + __builtin_amdgcn_exp2f(-1.4426950408889634f * x)); }
__device__ __forceinline__ float bf_lo(unsigned w) { return __uint_as_float(w << 16); }
__device__ __forceinline__ float bf_hi(unsigned w) { return __uint_as_float(w & 0xffff0000u); }

struct PanelSched {
    int panel, n, skip_lo, skip_n, mode;
    __device__ __forceinline__ bool next(int i, Unit& u) const {
        if (i >= n) return false;
        if (mode == 0) { u.pm = panel; u.pn = i + (i >= skip_lo ? skip_n : 0); } else { u.pm = i; u.pn = panel; }
        return true;
    }
    __device__ __forceinline__ void a_ready(const Unit&) const {}
    __device__ __forceinline__ void done(const Unit&) const {}
};

struct EpiProj {
    static constexpr bool PERM = true, AFTER_DRAIN = false;
    bf16_t *PQ, *PK, *PU, *PG;
    __device__ __forceinline__ void operator()(const f32x4 (&acc)[2][2][4][2], const Unit& u, int wr, int wc, int fr, int fq) const {
        const int pn = u.pn; bf16_t* base; int ld, colt; bool sg = false;
        if (pn < 2) { base = PQ; ld = 512; colt = pn * 256; }
        else if (pn < 4) { base = PK; ld = 512; colt = (pn - 2) * 256; }
        else if (pn < 8) { base = PU; ld = 512; colt = (pn - 6) * 256; }
        else { base = PG; ld = 2048; colt = (pn - 8) * 256; sg = true; }
        const int row0 = u.pm * BM + wr * 64 + fr, col0 = colt + wc * 32 + 8 * fq;
#pragma unroll
        for (int ai = 0; ai < 2; ++ai)
#pragma unroll
            for (int m = 0; m < 4; ++m) { bf16_t* rowp = base + (size_t)(row0 + ai * HALF + m * 16) * ld + col0;
#pragma unroll
                for (int bj = 0; bj < 2; ++bj) { f32x4 v0 = acc[ai][bj][m][0], v1 = acc[ai][bj][m][1];
                    if (sg) { v0 = (f32x4){sigm(v0[0]), sigm(v0[1]), sigm(v0[2]), sigm(v0[3])}; v1 = (f32x4){sigm(v1[0]), sigm(v1[1]), sigm(v1[2]), sigm(v1[3])}; }
                    u32x4 w; w.x = cvt_pk_bf16(v0[0], v0[1]); w.y = cvt_pk_bf16(v0[2], v0[3]); w.z = cvt_pk_bf16(v1[0], v1[1]); w.w = cvt_pk_bf16(v1[2], v1[3]);
                    *(u32x4*)(rowp + bj * HALF) = w; } }
    }
};
struct EpiPlain {
    static constexpr bool PERM = true, AFTER_DRAIN = false;
    bf16_t* O; int ldc;
    __device__ __forceinline__ void operator()(const f32x4 (&acc)[2][2][4][2], const Unit& u, int wr, int wc, int fr, int fq) const {
        const int row0 = u.pm * BM + wr * 64 + fr, col0 = u.pn * BM + wc * 32 + 8 * fq;
#pragma unroll
        for (int ai = 0; ai < 2; ++ai)
#pragma unroll
            for (int m = 0; m < 4; ++m) { bf16_t* rowp = O + (size_t)(row0 + ai * HALF + m * 16) * ldc + col0;
#pragma unroll
                for (int bj = 0; bj < 2; ++bj) { const f32x4 v0 = acc[ai][bj][m][0], v1 = acc[ai][bj][m][1];
                    u32x4 w; w.x = cvt_pk_bf16(v0[0], v0[1]); w.y = cvt_pk_bf16(v0[2], v0[3]); w.z = cvt_pk_bf16(v1[0], v1[1]); w.w = cvt_pk_bf16(v1[2], v1[3]);
                    *(u32x4*)(rowp + bj * HALF) = w; } }
    }
};
struct EpiMergeChain {
    static constexpr bool PERM = true, AFTER_DRAIN = false;
    const bf16_t* G; bf16_t* MG;
    __device__ __forceinline__ void operator()(const f32x4 (&acc)[2][2][4][2], const Unit& u, int wr, int wc, int fr, int fq) const {
        const bool add = u.pn >= 4; const int goff = add ? 1024 : 0;
        const int row0 = u.pm * BM + wr * 64 + fr, col0 = (u.pn & 3) * BM + wc * 32 + 8 * fq;
        if (add) asm volatile("s_waitcnt vmcnt(0)" ::: "memory");
#pragma unroll
        for (int ai = 0; ai < 2; ++ai)
#pragma unroll
            for (int m = 0; m < 4; ++m) { const size_t row = (size_t)(row0 + ai * HALF + m * 16);
#pragma unroll
                for (int bj = 0; bj < 2; ++bj) { const f32x4 v0 = acc[ai][bj][m][0], v1 = acc[ai][bj][m][1];
                    const u32x4 gw = *(const u32x4*)(G + row * 2048 + goff + col0 + bj * HALF);
                    float r0 = bf_lo(gw.x) * v0[0], r1 = bf_hi(gw.x) * v0[1], r2 = bf_lo(gw.y) * v0[2], r3 = bf_hi(gw.y) * v0[3];
                    float r4 = bf_lo(gw.z) * v1[0], r5 = bf_hi(gw.z) * v1[1], r6 = bf_lo(gw.w) * v1[2], r7 = bf_hi(gw.w) * v1[3];
                    bf16_t* mp = MG + row * 1024 + col0 + bj * HALF;
                    if (add) { const u32x4 pw = *(const u32x4*)mp;
                        r0 += bf_lo(pw.x); r1 += bf_hi(pw.x); r2 += bf_lo(pw.y); r3 += bf_hi(pw.y); r4 += bf_lo(pw.z); r5 += bf_hi(pw.z); r6 += bf_lo(pw.w); r7 += bf_hi(pw.w); }
                    u32x4 w; w.x = cvt_pk_bf16(r0, r1); w.y = cvt_pk_bf16(r2, r3); w.z = cvt_pk_bf16(r4, r5); w.w = cvt_pk_bf16(r6, r7);
                    *(u32x4*)mp = w; }
                asm volatile("" ::: "memory"); }
    }
};
__device__ __forceinline__ void lds_addf(PG8_LAS float* p, float v) { __hip_atomic_fetch_add(p, v, __ATOMIC_RELAXED, __HIP_MEMORY_SCOPE_WORKGROUP); }
__device__ __forceinline__ float quad_row_sum(float s, int lane) {
    s += __builtin_bit_cast(float, __builtin_amdgcn_ds_bpermute((lane ^ 16) << 2, __builtin_bit_cast(int, s)));
    s += __builtin_bit_cast(float, __builtin_amdgcn_ds_bpermute((lane ^ 32) << 2, __builtin_bit_cast(int, s)));
    return s;
}
struct EpiRes {
    static constexpr bool PERM = true, AFTER_DRAIN = false;
    const float* X; bf16_t* OB; PG8_LAS float* ss;
    __device__ __forceinline__ void operator()(const f32x4 (&acc)[2][2][4][2], const Unit& u, int wr, int wc, int fr, int fq) const {
        asm volatile("" : "+v"(fr), "+v"(fq));
        const int col0 = u.pn * BM + wc * 32 + 8 * fq; const int lane = fq * 16 + fr;
#pragma unroll
        for (int ai = 0; ai < 2; ++ai)
#pragma unroll
            for (int m = 0; m < 4; ++m) { const int lr = ai * HALF + wr * 64 + m * 16 + fr; const size_t xoff = (size_t)(u.pm * BM + lr) * 1024 + col0; bf16_t* op = OB + ((size_t)(2 * u.pm) * BM + lr) * 1024 + col0;
                float s = 0.f;
#pragma unroll
                for (int bj = 0; bj < 2; ++bj) { const f32x4 x0 = *(const f32x4*)(X + xoff + bj * HALF), x1 = *(const f32x4*)(X + xoff + bj * HALF + 4);
                    const f32x4 v0 = x0 + acc[ai][bj][m][0], v1 = x1 + acc[ai][bj][m][1];
                    s += (v0[0] * v0[0] + v0[1] * v0[1]) + (v0[2] * v0[2] + v0[3] * v0[3]) + (v1[0] * v1[0] + v1[1] * v1[1]) + (v1[2] * v1[2] + v1[3] * v1[3]);
                    u32x4 w; w.x = cvt_pk_bf16(v0[0], v0[1]); w.y = cvt_pk_bf16(v0[2], v0[3]); w.z = cvt_pk_bf16(v1[0], v1[1]); w.w = cvt_pk_bf16(v1[2], v1[3]);
                    *(u32x4*)(op + bj * HALF) = w; }
                s = quad_row_sum(s, lane); if (fq == 0) lds_addf(ss + lr, s);
                asm volatile("" ::: "memory"); }
    }
};
struct EpiPlainScale {
    static constexpr bool PERM = true, AFTER_DRAIN = false;
    bf16_t* O; int ldc; PG8_LAS const float* rs;
    __device__ __forceinline__ void operator()(const f32x4 (&acc)[2][2][4][2], const Unit& u, int wr, int wc, int fr, int fq) const {
        asm volatile("" : "+v"(fr), "+v"(fq));
        const int col0 = u.pn * BM + wc * 32 + 8 * fq;
#pragma unroll
        for (int ai = 0; ai < 2; ++ai)
#pragma unroll
            for (int m = 0; m < 4; ++m) { const int lr = ai * HALF + wr * 64 + m * 16 + fr; const float r = rs[lr]; bf16_t* rowp = O + (size_t)(u.pm * BM + lr) * ldc + col0;
#pragma unroll
                for (int bj = 0; bj < 2; ++bj) { const f32x4 v0 = acc[ai][bj][m][0] * r, v1 = acc[ai][bj][m][1] * r;
                    u32x4 w; w.x = cvt_pk_bf16(v0[0], v0[1]); w.y = cvt_pk_bf16(v0[2], v0[3]); w.z = cvt_pk_bf16(v1[0], v1[1]); w.w = cvt_pk_bf16(v1[2], v1[3]);
                    *(u32x4*)(rowp + bj * HALF) = w; } }
    }
};
struct EpiGate {
    static constexpr bool PERM = false, AFTER_DRAIN = false;
    float* OUT; const bf16_t* X2; const bf16_t* E; PG8_LAS const float* rs; PG8_LAS float* ss;
    __device__ __forceinline__ void operator()(const f32x4 (&acc)[2][2][4][2], const Unit& u, int wr, int wc, int fr, int fq) const {
        asm volatile("" : "+v"(fr), "+v"(fq));
        const int col0 = u.pn * BM + wc * 32 + 4 * fq; const int lane = fq * 16 + fr;
#pragma unroll
        for (int ai = 0; ai < 2; ++ai)
#pragma unroll
            for (int m = 0; m < 4; ++m) { const int lr = ai * HALF + wr * 64 + m * 16 + fr; const float r = rs[lr];
                const size_t off = (size_t)(u.pm * BM + lr) * 1024 + col0, xo = ((size_t)(2 * u.pm) * BM + lr) * 1024 + col0; float s = 0.f;
#pragma unroll
                for (int bj = 0; bj < 2; ++bj)
#pragma unroll
                    for (int n = 0; n < 2; ++n) { const int co = bj * HALF + n * 16; const u32x2 xw = *(const u32x2*)(X2 + xo + co); const u32x2 ew = *(const u32x2*)(E + off + co); const f32x4 a = acc[ai][bj][m][n] * r;
                        f32x4 v; v[0] = bf_lo(xw.x) + sigm(a[0]) * bf_lo(ew.x); v[1] = bf_hi(xw.x) + sigm(a[1]) * bf_hi(ew.x); v[2] = bf_lo(xw.y) + sigm(a[2]) * bf_lo(ew.y); v[3] = bf_hi(xw.y) + sigm(a[3]) * bf_hi(ew.y);
                        s += (v[0] * v[0] + v[1] * v[1]) + (v[2] * v[2] + v[3] * v[3]);
                        *(f32x4*)(OUT + off + co) = v; }
                s = quad_row_sum(s, lane); if (fq == 0) lds_addf(ss + lr, s);
                asm volatile("" ::: "memory"); }
    }
};
}

#define GAS __attribute__((address_space(1)))
#define LAS __attribute__((address_space(3)))
typedef unsigned short bf16;
typedef unsigned v4u __attribute__((ext_vector_type(4)));
typedef float f32x4 __attribute__((ext_vector_type(4)));
typedef short bf16x8 __attribute__((ext_vector_type(8)));
typedef GAS unsigned gu32;
typedef GAS unsigned long long gu64;
#define RLX_AGENT __ATOMIC_RELAXED, __HIP_MEMORY_SCOPE_AGENT
#define LDS_WAIT() asm volatile("s_waitcnt lgkmcnt(0)" ::: "memory")
#define VM_WAIT() asm volatile("s_waitcnt vmcnt(0)" ::: "memory")
__device__ __forceinline__ unsigned long long rt() { return __builtin_amdgcn_s_memrealtime(); }
__device__ __forceinline__ unsigned f2bf(float f) { unsigned u = __builtin_bit_cast(unsigned, f); return (u + 0x7fffu + ((u >> 16) & 1u)) >> 16; }
__device__ __forceinline__ unsigned pk2(float lo, float hi) { return f2bf(lo) | (f2bf(hi) << 16); }

#define XB_TMO      128
#define XB_XCNT(j)  (256  + 64 * (j))
#define XB_XSUB(j)  (1280 + 64 * (j))
#define XB_XGEN(j)  (2304 + 64 * (j))
#define XB_TOP      3328
#define XB_TOPGEN   3392
#define XCD_BAR_WORDS 3456
#define XB_SPIN_CAP (1u << 18)

__device__ __forceinline__ unsigned xb_ld(unsigned* p)              { return __hip_atomic_load(p, __ATOMIC_RELAXED, __HIP_MEMORY_SCOPE_AGENT); }
__device__ __forceinline__ unsigned xb_add(unsigned* p, unsigned v) { return __hip_atomic_fetch_add(p, v, __ATOMIC_RELAXED, __HIP_MEMORY_SCOPE_AGENT); }
__device__ __forceinline__ unsigned xb_xcc_id() { return (unsigned)__builtin_amdgcn_s_getreg((3 << 11) | 20) & 0xFu; }
#define XB_SPIN(cond, bar) do { unsigned _sp = 0; while (cond) { __builtin_amdgcn_s_sleep(1); \
    if ((++_sp & 255u) == 0u) { if (xb_ld(&(bar)[XB_TMO])) break; if (_sp > XB_SPIN_CAP) { atomicAdd(&(bar)[XB_TMO], 1u); break; } } } } while (0)

struct XcdBarrier {
    unsigned* bar; unsigned x;
    volatile LAS unsigned* st;
};

__device__ __forceinline__ XcdBarrier xcd_barrier_post(unsigned* bar, volatile LAS unsigned* st, const bool is_t0) {
    XcdBarrier b; b.bar = bar; b.x = xb_xcc_id(); b.st = st;
    if (is_t0) (void)xb_add(&bar[XB_XCNT(b.x)], 1u);
    return b;
}
__device__ __forceinline__ void xcd_barrier_complete(unsigned* bar, unsigned x, unsigned& nloc, unsigned& nx) {
    const unsigned G = gridDim.x * gridDim.y * gridDim.z;
    unsigned sum, cnt, mine, sp = 0u;
    for (;;) {
        sum = 0u; cnt = 0u; mine = 0u;
#pragma unroll
        for (unsigned j = 0; j < 16; ++j) { const unsigned c = xb_ld(&bar[XB_XCNT(j)]); sum += c; cnt += (c > 0u) ? 1u : 0u; mine = (j == x) ? c : mine; }
        if (sum == G) break;
        __builtin_amdgcn_s_sleep(1);
        if ((++sp & 255u) == 0u) { if (xb_ld(&bar[XB_TMO])) break; if (sp > XB_SPIN_CAP) { atomicAdd(&bar[XB_TMO], 1u); break; } }
    }
    nloc = mine > 0u ? mine : 1u; nx = cnt > 0u ? cnt : 1u;
}

__device__ __forceinline__ void xcd_barrier(const XcdBarrier& b, const bool is_t0) {
    asm volatile("s_waitcnt vmcnt(0)" ::: "memory");
    __syncthreads();
    if (is_t0) {
        unsigned* bar = b.bar;
        __builtin_amdgcn_s_waitcnt(0);
        unsigned nloc = b.st[0], nx = b.st[1];
        if (nloc == 0u) { xcd_barrier_complete(bar, b.x, nloc, nx); b.st[0] = nloc; b.st[1] = nx; }
        const unsigned old = xb_add(&bar[XB_XSUB(b.x)], 1u);
        const unsigned gen = old / nloc;
        if (old + 1u == (gen + 1u) * nloc) {
            __builtin_amdgcn_fence(__ATOMIC_RELEASE, "agent");
            asm volatile("s_waitcnt vmcnt(0)" ::: "memory");
            const unsigned og = xb_add(&bar[XB_TOP], 1u);
            const unsigned tg = og / nx;
            if (og + 1u == (tg + 1u) * nx) xb_add(&bar[XB_TOPGEN], 1u);
            else XB_SPIN(xb_ld(&bar[XB_TOPGEN]) == tg, bar);
            __builtin_amdgcn_fence(__ATOMIC_ACQUIRE, "agent");
            xb_add(&bar[XB_XGEN(b.x)], 1u);
            asm volatile("s_waitcnt vmcnt(0)" ::: "memory");
        } else {
            XB_SPIN(xb_ld(&bar[XB_XGEN(b.x)]) == gen, bar);
            __builtin_amdgcn_fence(__ATOMIC_ACQUIRE, "agent");
            asm volatile("s_waitcnt vmcnt(0)" ::: "memory");
        }
    }
    __syncthreads();
}


constexpr int NWAVES = 8, NTHR = 512;
constexpr int TOK = 65536, DM = 1024, SEQ = 8192, NPANEL = 256;
constexpr float RMS_EPS = 1e-6f;
constexpr float C2 = 0.125f * 1.4426950408889634f;
constexpr float SURV_THR = 5.4210108624275222e-20f;
constexpr size_t MiB = 1u << 20;
constexpr size_t WS_CTL = 0, CTL_ZERO_BYTES = 64 * 1024;
constexpr size_t WS_WIN = 2 * MiB, WS_WOUT = 10 * MiB, WS_WQ = 12 * MiB, WS_WPG = 16 * MiB, WS_WPLE = 18 * MiB;
constexpr size_t WS_BDA = 18 * MiB + 512 * 1024, WS_BDP = 18 * MiB + 768 * 1024, WS_SK = 19 * MiB;
constexpr size_t WS_EU = 32 * MiB, WS_EV = 64 * MiB, WS_SU = 20 * MiB, WS_SV = 20 * MiB + 65536;
constexpr size_t WS_XN = 96 * MiB;
constexpr size_t WS_PQ = 224 * MiB, WS_PK = 288 * MiB, WS_PVT = 352 * MiB, WS_PU = 416 * MiB;
constexpr size_t WS_PG = 480 * MiB;
constexpr size_t WS_YA = 736 * MiB, WS_YP = 800 * MiB;
constexpr size_t WS_MG = 864 * MiB, WS_END = 992 * MiB;
constexpr int CW_BAR = 1024;
constexpr int RING_BYTES = 131072, LDSCTL_OFF = RING_BYTES, MISC_OFF = LDSCTL_OFF + 320, LDS_BYTES = 147456;

typedef float f32x16 __attribute__((ext_vector_type(16)));
typedef float f32x2 __attribute__((ext_vector_type(2)));
typedef __bf16 bf16x2v __attribute__((ext_vector_type(2)));

__device__ __forceinline__ int shx(int v, int m, int lane) { return __builtin_amdgcn_ds_bpermute((lane ^ m) << 2, v); }
__device__ __forceinline__ float shx(float v, int m, int lane) { return __builtin_bit_cast(float, __builtin_amdgcn_ds_bpermute((lane ^ m) << 2, __builtin_bit_cast(int, v))); }
__device__ __forceinline__ float shl_(float v, int src) { return __builtin_bit_cast(float, __builtin_amdgcn_ds_bpermute(src << 2, __builtin_bit_cast(int, v))); }
__device__ __forceinline__ float wave_sum(float v, int lane) {
#pragma unroll
    for (int o = 1; o < 64; o <<= 1) v += shx(v, o, lane);
    return v;
}
__device__ __forceinline__ float bflo(unsigned w) { return __uint_as_float(w << 16); }
__device__ __forceinline__ float bfhi(unsigned w) { return __uint_as_float(w & 0xffff0000u); }
__device__ __forceinline__ unsigned cvtpk(float lo, float hi) { return pg8::cvt_pk_bf16(lo, hi); }

#define H_UNPACK(H, A, B) do { H[0] = bflo(A.x); H[1] = bfhi(A.x); H[2] = bflo(A.y); H[3] = bfhi(A.y); H[4] = bflo(A.z); H[5] = bfhi(A.z); H[6] = bflo(A.w); H[7] = bfhi(A.w); \
        H[8] = bflo(B.x); H[9] = bfhi(B.x); H[10] = bflo(B.y); H[11] = bfhi(B.y); H[12] = bflo(B.z); H[13] = bfhi(B.z); H[14] = bflo(B.w); H[15] = bfhi(B.w); } while (0)
__device__ __forceinline__ void p0_transpose_item(const float* W, int K, int N, bf16* WT, const float* kscale, int nlo, float nls, LAS float* scr, int item, int lane) {
    const int nblk = N / 32, kb = item / nblk, nb = item % nblk, k0 = 64 * kb, n0 = 32 * nb;
    const float ns = (n0 + (lane & 31)) < nlo ? nls : 1.0f;
#pragma unroll 8
    for (int i = 0; i < 32; ++i) { const int kk = 2 * i + (lane >> 5); float v = W[(size_t)(k0 + kk) * N + n0 + (lane & 31)] * ns; if (kscale) v *= kscale[k0 + kk]; scr[kk * 33 + (lane & 31)] = v; }
    LDS_WAIT(); asm volatile("" ::: "memory");
    const int c = lane & 7;
#pragma unroll
    for (int j = 0; j < 4; ++j) { const int n = (lane >> 3) + 8 * j; const LAS float* s = scr + (8 * c) * 33 + n;
        v4u o; o.x = pk2(s[0 * 33], s[1 * 33]); o.y = pk2(s[2 * 33], s[3 * 33]); o.z = pk2(s[4 * 33], s[5 * 33]); o.w = pk2(s[6 * 33], s[7 * 33]);
        *(GAS v4u*)(WT + (size_t)(n0 + n) * K + k0 + 8 * c) = o; }
    LDS_WAIT(); asm volatile("" ::: "memory");
}
__device__ __forceinline__ void rms_row_to_bf16(const float* xrow, bf16* orow, int lane) {
    const GAS f32x4* xr = (const GAS f32x4*)xrow + lane;
    f32x4 v[4]; float s = 0.f;
#pragma unroll
    for (int j = 0; j < 4; ++j) { v[j] = xr[64 * j]; s += (v[j].x * v[j].x + v[j].y * v[j].y) + (v[j].z * v[j].z + v[j].w * v[j].w); }
    const float r = 1.f / sqrtf(wave_sum(s, lane) * (1.f / DM) + RMS_EPS);
    GAS unsigned long long* o8 = (GAS unsigned long long*)orow + lane;
#pragma unroll
    for (int j = 0; j < 4; ++j) o8[64 * j] = (unsigned long long)pk2(v[j].x * r, v[j].y * r) | ((unsigned long long)pk2(v[j].z * r, v[j].w * r) << 32);
}
__device__ __forceinline__ void cvt8_store(const float* src, bf16* dst) {
    const f32x4 a = *(const GAS f32x4*)src, b = *(const GAS f32x4*)(src + 4);
    v4u o; o.x = pk2(a.x, a.y); o.y = pk2(a.z, a.w); o.z = pk2(b.x, b.y); o.w = pk2(b.z, b.w);
    *(GAS v4u*)dst = o;
}

__device__ __forceinline__ void attn_panel(int panel, const bf16* PQ, const bf16* PK, const bf16* PVT, bf16* YA, const int wid0) {
    const int tid = otid(wid0), lane = tid & 63, wid = __builtin_amdgcn_readfirstlane(tid >> 6);
    const int r32 = lane & 31, hh = lane >> 5;
    const size_t seq0 = (size_t)(panel >> 5) * SEQ;
    const int pos0 = (panel & 31) * 256 + wid * 32;
    const int kap = 16 * ((r32 >> 2) & 1) + (r32 & 3) + 4 * (r32 >> 3);
    for (int h = 0; h < 8; ++h) {
        bf16x8 qf[4];
        { const bf16* qrow = PQ + (seq0 + pos0 + r32) * 512 + h * 64 + 8 * hh;
#pragma unroll
          for (int s = 0; s < 4; ++s) qf[s] = *(const GAS bf16x8*)(qrow + 16 * s); }
        f32x16 o0 = {}, o1 = {};
        float Sin = 1.f;
        for (int kb = pos0; kb >= 0; kb -= 32) {
            const bf16* krow = PK + (seq0 + kb + kap) * 512 + h * 64 + 8 * hh;
            const bf16* vrow = PVT + (size_t)(h * 64 + kap) * TOK + seq0 + kb + 16 * hh;
            bf16x8 kf[4], vf[2][2];
#pragma unroll
            for (int s = 0; s < 4; ++s) kf[s] = *(const GAS bf16x8*)(krow + 16 * s);
#pragma unroll
            for (int db = 0; db < 2; ++db)
#pragma unroll
                for (int s = 0; s < 2; ++s) vf[db][s] = *(const GAS bf16x8*)(vrow + (size_t)db * 32 * TOK + 8 * s);
            f32x16 z = {};
#pragma unroll
            for (int s = 0; s < 4; ++s) z = __builtin_amdgcn_mfma_f32_32x32x16_bf16(kf[s], qf[s], z, 0, 0, 0);
            const bool diag = (kb == pos0);
            float w[16]; float Sl = 1.f;
#pragma unroll
            for (int reg = 15; reg >= 0; --reg) {
                float beta = __builtin_amdgcn_rcpf(1.0f + __builtin_amdgcn_exp2f(-z[reg]));
                if (diag && (16 * hh + reg >= r32)) beta = 0.f;
                const float wl = beta * Sl; Sl -= wl; w[reg] = wl;
            }
            const float Pp = shx(Sl, 32, lane);
            const float scale = hh ? Sin : Sin * Pp;
            Sin = Sin * Sl * Pp;
            v4u pw0, pw1;
            pw0.x = cvtpk(w[0] * scale, w[1] * scale); pw0.y = cvtpk(w[2] * scale, w[3] * scale); pw0.z = cvtpk(w[4] * scale, w[5] * scale); pw0.w = cvtpk(w[6] * scale, w[7] * scale);
            pw1.x = cvtpk(w[8] * scale, w[9] * scale); pw1.y = cvtpk(w[10] * scale, w[11] * scale); pw1.z = cvtpk(w[12] * scale, w[13] * scale); pw1.w = cvtpk(w[14] * scale, w[15] * scale);
            const bf16x8 p0 = __builtin_bit_cast(bf16x8, pw0), p1 = __builtin_bit_cast(bf16x8, pw1);
            o0 = __builtin_amdgcn_mfma_f32_32x32x16_bf16(vf[0][0], p0, o0, 0, 0, 0);
            o0 = __builtin_amdgcn_mfma_f32_32x32x16_bf16(vf[0][1], p1, o0, 0, 0, 0);
            o1 = __builtin_amdgcn_mfma_f32_32x32x16_bf16(vf[1][0], p0, o1, 0, 0, 0);
            o1 = __builtin_amdgcn_mfma_f32_32x32x16_bf16(vf[1][1], p1, o1, 0, 0, 0);
            if (__all(Sin < SURV_THR)) break;
        }
        bf16* orow = YA + (seq0 + pos0 + r32) * 512 + h * 64 + 16 * hh;
        v4u a, b2;
        a.x = cvtpk(o0[0], o0[1]); a.y = cvtpk(o0[2], o0[3]); a.z = cvtpk(o0[4], o0[5]); a.w = cvtpk(o0[6], o0[7]);
        b2.x = cvtpk(o0[8], o0[9]); b2.y = cvtpk(o0[10], o0[11]); b2.z = cvtpk(o0[12], o0[13]); b2.w = cvtpk(o0[14], o0[15]);
        *(GAS v4u*)orow = a; *(GAS v4u*)(orow + 8) = b2;
        a.x = cvtpk(o1[0], o1[1]); a.y = cvtpk(o1[2], o1[3]); a.z = cvtpk(o1[4], o1[5]); a.w = cvtpk(o1[6], o1[7]);
        b2.x = cvtpk(o1[8], o1[9]); b2.y = cvtpk(o1[10], o1[11]); b2.z = cvtpk(o1[12], o1[13]); b2.w = cvtpk(o1[14], o1[15]);
        *(GAS v4u*)(orow + 32) = a; *(GAS v4u*)(orow + 40) = b2;
    }
}

__device__ __forceinline__ void pool_panel(int panel, const bf16* PU, bf16* YP, const int wid0) {
    const int tid = otid(wid0);
    const int chunk = tid & 63, tg = tid >> 6, w = 2 << (chunk >> 4);
    const int posb = (panel & 31) * 256; const size_t row0 = (size_t)panel * 256;
    for (int i = 0; i < 32; ++i) {
        const int t = tg * 32 + i, pos = posb + t, cnt = (pos + 1 < w) ? (pos + 1) : w;
        float s[8];
#pragma unroll
        for (int k = 0; k < 8; ++k) s[k] = 0.f;
        v4u cur = {0u, 0u, 0u, 0u};
        for (int j = 0; j < cnt; ++j) {
            const v4u v = *(const GAS v4u*)(PU + (row0 + t - j) * 512 + chunk * 8);
            if (j == 0) cur = v;
            s[0] += bflo(v.x); s[1] += bfhi(v.x); s[2] += bflo(v.y); s[3] += bfhi(v.y); s[4] += bflo(v.z); s[5] += bfhi(v.z); s[6] += bflo(v.w); s[7] += bfhi(v.w);
        }
        const float ic = 1.0f / (float)cnt;
        v4u o;
        o.x = cvtpk(s[0] * ic - bflo(cur.x), s[1] * ic - bfhi(cur.x)); o.y = cvtpk(s[2] * ic - bflo(cur.y), s[3] * ic - bfhi(cur.y));
        o.z = cvtpk(s[4] * ic - bflo(cur.z), s[5] * ic - bfhi(cur.z)); o.w = cvtpk(s[6] * ic - bflo(cur.w), s[7] * ic - bfhi(cur.w));
        *(GAS v4u*)(YP + (row0 + t) * 512 + chunk * 8) = o;
    }
}

#define HD __host__ __device__ __forceinline__
HD int f2s(float f) { int i = __builtin_bit_cast(int, f); return i ^ ((i >> 31) & 0x7fffffff); }
HD float s2f(int i) { i ^= ((i >> 31) & 0x7fffffff); return __builtin_bit_cast(float, i); }
HD void ce_desc(int& a, int& b) { const int mx = a > b ? a : b, mn = a > b ? b : a; a = mx; b = mn; }
template <int J, int K> HD void bpass16(int (&v)[16]) {
#pragma unroll
    for (int i = 0; i < 16; ++i) { const int l = i ^ J; if (l > i) { if ((i & K) == 0) ce_desc(v[i], v[l]); else ce_desc(v[l], v[i]); } }
}
HD void bitonic_sort16_desc(int (&v)[16]) {
    bpass16<1, 2>(v); bpass16<2, 4>(v); bpass16<1, 4>(v); bpass16<4, 8>(v); bpass16<2, 8>(v); bpass16<1, 8>(v);
    bpass16<8, 16>(v); bpass16<4, 16>(v); bpass16<2, 16>(v); bpass16<1, 16>(v);
}
HD void bitonic_merge16_desc(int (&v)[16]) {
    bpass16<8, 16>(v); bpass16<4, 16>(v); bpass16<2, 16>(v); bpass16<1, 16>(v);
}
HD void merge_prune16(int (&x)[16], const int (&y)[16]) {
#pragma unroll
    for (int i = 0; i < 16; ++i) x[i] = x[i] > y[15 - i] ? x[i] : y[15 - i];
    bitonic_merge16_desc(x);
}
HD int cx_i(int hf, int t) { if (hf == 0) return 0; return t < 5 ? 2 : t < 9 ? 3 : t < 12 ? 4 : t < 14 ? 5 : 6; }
HD int cx_j(int hf, int t) { if (hf == 0) return t; return t < 5 ? t : t < 9 ? t - 5 : t < 12 ? t - 9 : t < 14 ? t - 12 : t - 14; }
HD int cy_i(int hf, int t) { if (hf == 0) return t < 8 ? 1 : 23 - t; return 7; }
HD int cy_j(int hf, int t) { if (hf == 0) return t < 8 ? t : 0; return t; }

__device__ __forceinline__ void top16_of_group(const bf16x8 (&qf)[8], LAS const unsigned char* skl, int r32, int hh, int lane, int (&res)[16]) {
    int v[4][16];
#pragma unroll
    for (int kb = 0; kb < 4; ++kb) {
        f32x16 acc = {};
#pragma unroll
        for (int s = 0; s < 8; ++s) { const bf16x8 af = *(LAS const bf16x8*)(skl + (32 * kb + r32) * 272 + 32 * s + 16 * hh); acc = __builtin_amdgcn_mfma_f32_32x32x16_bf16(af, qf[s], acc, 0, 0, 0); }
#pragma unroll
        for (int reg = 0; reg < 16; ++reg) { const int keyid = 32 * kb + (reg & 3) + 8 * (reg >> 2) + 4 * hh; v[kb][reg] = (f2s(acc[reg]) & ~127) | keyid; }
    }
    bitonic_sort16_desc(v[0]); bitonic_sort16_desc(v[1]); bitonic_sort16_desc(v[2]); bitonic_sort16_desc(v[3]);
    merge_prune16(v[0], v[1]); merge_prune16(v[2], v[3]); merge_prune16(v[0], v[2]);
    int y[16];
#pragma unroll
    for (int i = 0; i < 16; ++i) y[i] = shx(v[0][i], 32, lane);
    merge_prune16(v[0], y);
#pragma unroll
    for (int i = 0; i < 16; ++i) res[i] = v[0][i];
}

__device__ __forceinline__ void topk_panel(int panel, const bf16* QP, const bf16* SK, int* IDXp, float* GTp  , LAS unsigned char* ldsb  , const int wid0) {
    const int tid = otid(wid0), lane = tid & 63, wid = __builtin_amdgcn_readfirstlane(tid >> 6);
    const int r32 = lane & 31, hh = lane >> 5;
    const int lrow = wid * 32 + r32;
    const size_t row = (size_t)panel * 256 + lrow;
    LAS int* lut = (LAS int*)ldsb; LAS unsigned char* skl = ldsb + 65536;
    v4u skr[4];
#define SK_FETCH(g_) do { _Pragma("unroll") for (int i = 0; i < 4; ++i) skr[i] = *((const GAS v4u*)(SK + (size_t)(g_) * 128 * 128) + i * 512 + tid); } while (0)
#define SK_STAGE() do { _Pragma("unroll") for (int i = 0; i < 4; ++i) { const int p = i * 512 + tid; *(LAS v4u*)(skl + (p >> 4) * 272 + (p & 15) * 16) = skr[i]; } } while (0)
    bf16x8 qn[8];
#define Q_FETCH(g_) do { const bf16* qrow_ = QP + row * 2048 + (g_) * 128 + 8 * hh; _Pragma("unroll") for (int s = 0; s < 8; ++s) qn[s] = *(const GAS bf16x8*)(qrow_ + 16 * s); } while (0)
    SK_FETCH(0); Q_FETCH(0);
    for (int h = 0; h < 8; ++h) {
        int a[16], b[16];
#pragma unroll
        for (int c = 0; c < 2; ++c) {
            const int g = 2 * h + c;
            bf16x8 qf[8];
#pragma unroll
            for (int s = 0; s < 8; ++s) qf[s] = qn[s];
            __syncthreads();
            SK_STAGE();
            __syncthreads();
            if (g < 15) { SK_FETCH(g + 1); Q_FETCH(g + 1); }
            if (c == 0) top16_of_group(qf, skl, r32, hh, lane, a); else top16_of_group(qf, skl, r32, hh, lane, b);
        }
        float fa[16], fb[16];
#pragma unroll
        for (int i = 0; i < 16; ++i) { fa[i] = s2f(a[i] & ~127); fb[i] = s2f(b[i] & ~127); lut[i * 512 + tid] = a[i] & 127; lut[(16 + i) * 512 + tid] = b[i] & 127; }
        int X[16], Y[16];
#pragma unroll
        for (int t = 0; t < 16; ++t) {
            const float s0 = fa[cx_i(0, t)] + fb[cx_j(0, t)], s1 = fa[cx_i(1, t)] + fb[cx_j(1, t)];
            const int c0 = cx_i(0, t) * 16 + cx_j(0, t), c1 = cx_i(1, t) * 16 + cx_j(1, t);
            X[t] = hh ? ((f2s(s1) & ~255) | c1) : ((f2s(s0) & ~255) | c0);
            const float u0 = fa[cy_i(0, t)] + fb[cy_j(0, t)];
            const int d0 = cy_i(0, t) * 16 + cy_j(0, t);
            int y1 = (int)0x80000000;
            if (t < 2) { const float u1 = fa[cy_i(1, t)] + fb[cy_j(1, t)]; y1 = (f2s(u1) & ~255) | (cy_i(1, t) * 16 + cy_j(1, t)); }
            Y[t] = hh ? y1 : ((f2s(u0) & ~255) | d0);
        }
        bitonic_sort16_desc(X); bitonic_merge16_desc(Y); merge_prune16(X, Y);
#pragma unroll
        for (int i = 0; i < 16; ++i) Y[i] = shx(X[i], 32, lane);
        merge_prune16(X, Y);
        const float mx = s2f(X[0] & ~255);
        float ex[16], den = 0.f;
#pragma unroll
        for (int i = 0; i < 16; ++i) { ex[i] = __builtin_amdgcn_exp2f((s2f(X[i] & ~255) - mx) * 1.4426950408889634f); den += ex[i]; }
        const float rden = 1.0f / den;
        int oi[8]; float og[8];
#pragma unroll
        for (int t = 0; t < 8; ++t) {
            const int msk = -hh;
            const int code = (X[t] ^ ((X[t] ^ X[8 + t]) & msk)) & 255;
            const int e1 = lut[(code >> 4) * 512 + tid], e2 = lut[(16 + (code & 15)) * 512 + tid];
            const int exl = __builtin_bit_cast(int, ex[t]), exh = __builtin_bit_cast(int, ex[8 + t]);
            oi[t] = e1 * 128 + e2; og[t] = __builtin_bit_cast(float, exl ^ ((exl ^ exh) & msk)) * rden;
        }
        int* ip = IDXp + lrow * 128 + h * 16 + 8 * hh; float* gp = GTp + lrow * 128 + h * 16 + 8 * hh;
        *(GAS v4u*)ip = (v4u){(unsigned)oi[0], (unsigned)oi[1], (unsigned)oi[2], (unsigned)oi[3]}; *(GAS v4u*)(ip + 4) = (v4u){(unsigned)oi[4], (unsigned)oi[5], (unsigned)oi[6], (unsigned)oi[7]};
        *(GAS f32x4*)gp = (f32x4){og[0], og[1], og[2], og[3]}; *(GAS f32x4*)(gp + 4) = (f32x4){og[4], og[5], og[6], og[7]};
    }
#undef SK_FETCH
#undef SK_STAGE
#undef Q_FETCH
}

typedef float f32x2v __attribute__((ext_vector_type(2)));
__device__ __forceinline__ void quant_row_fp8(const float* src, const float* colgain, unsigned char* dst, float* sc_out, int lane) {
    const GAS f32x4* s = (const GAS f32x4*)src + 4 * lane;
    f32x4 v[4]; float m = 0.f;
#pragma unroll
    for (int j = 0; j < 4; ++j) { v[j] = s[j]; if (colgain) v[j] = v[j] * ((const GAS f32x4*)colgain + 4 * lane)[j]; m = fmaxf(m, fmaxf(fmaxf(fabsf(v[j].x), fabsf(v[j].y)), fmaxf(fabsf(v[j].z), fabsf(v[j].w)))); }
#pragma unroll
    for (int o = 1; o < 64; o <<= 1) m = fmaxf(m, shx(m, o, lane));
    const float sc = m > 0.f ? 224.0f / m : 1.0f;
    v4u w;
    { int t = 0; t = __builtin_amdgcn_cvt_pk_fp8_f32(v[0].x * sc, v[0].y * sc, t, false); t = __builtin_amdgcn_cvt_pk_fp8_f32(v[0].z * sc, v[0].w * sc, t, true); w.x = (unsigned)t; }
    { int t = 0; t = __builtin_amdgcn_cvt_pk_fp8_f32(v[1].x * sc, v[1].y * sc, t, false); t = __builtin_amdgcn_cvt_pk_fp8_f32(v[1].z * sc, v[1].w * sc, t, true); w.y = (unsigned)t; }
    { int t = 0; t = __builtin_amdgcn_cvt_pk_fp8_f32(v[2].x * sc, v[2].y * sc, t, false); t = __builtin_amdgcn_cvt_pk_fp8_f32(v[2].z * sc, v[2].w * sc, t, true); w.z = (unsigned)t; }
    { int t = 0; t = __builtin_amdgcn_cvt_pk_fp8_f32(v[3].x * sc, v[3].y * sc, t, false); t = __builtin_amdgcn_cvt_pk_fp8_f32(v[3].z * sc, v[3].w * sc, t, true); w.w = (unsigned)t; }
    *(GAS v4u*)(dst + 16 * lane) = w;
    if (lane == 0) *sc_out = m > 0.f ? m * (1.0f / 224.0f) : 1.0f;
}
__device__ __forceinline__ void dq4(unsigned w, float (&f)[4]) {
    const f32x2v lo = __builtin_amdgcn_cvt_pk_f32_fp8((int)w, false), hi = __builtin_amdgcn_cvt_pk_f32_fp8((int)w, true);
    f[0] = lo.x; f[1] = lo.y; f[2] = hi.x; f[3] = hi.y;
}
__device__ __forceinline__ float dot16_fp8(const v4u u, const float (&h)[16]) {
    float f0[4], f1[4], f2[4], f3[4]; dq4(u.x, f0); dq4(u.y, f1); dq4(u.z, f2); dq4(u.w, f3);
    float a = f0[0] * h[0], b = f1[0] * h[4], c = f2[0] * h[8], d = f3[0] * h[12];
    a = fmaf(f0[1], h[1], a); b = fmaf(f1[1], h[5], b); c = fmaf(f2[1], h[9], c); d = fmaf(f3[1], h[13], d);
    a = fmaf(f0[2], h[2], a); b = fmaf(f1[2], h[6], b); c = fmaf(f2[2], h[10], c); d = fmaf(f3[2], h[14], d);
    a = fmaf(f0[3], h[3], a); b = fmaf(f1[3], h[7], b); c = fmaf(f2[3], h[11], c); d = fmaf(f3[3], h[15], d);
    return (a + b) + (c + d);
}
__device__ __forceinline__ void fma16_fp8(float (&o)[16], float cf, const v4u v) {
    float f0[4], f1[4], f2[4], f3[4]; dq4(v.x, f0); dq4(v.y, f1); dq4(v.z, f2); dq4(v.w, f3);
#pragma unroll
    for (int k = 0; k < 4; ++k) { o[k] = fmaf(cf, f0[k], o[k]); o[4 + k] = fmaf(cf, f1[k], o[4 + k]); o[8 + k] = fmaf(cf, f2[k], o[8 + k]); o[12 + k] = fmaf(cf, f3[k], o[12 + k]); }
}
#define RS_LEVEL(v, n, m) do { _Pragma("unroll") for (int _e = 0; _e < (n); ++_e) { const bool _up = (lane & (m)) != 0; const float _send = _up ? v[_e] : v[_e + (n)]; const float _keep = _up ? v[_e + (n)] : v[_e]; v[_e] = _keep + shx(_send, m, lane); } } while (0)
__device__ __forceinline__ void peer_panel(int panel, bf16* XN, const int* IDXp, const float* GTp, const unsigned char* EU8, const unsigned char* EV8, const float* SU, const float* SV, float* XIO, const int wid0) {
    const int tid = otid(wid0), lane = tid & 63, wid = __builtin_amdgcn_readfirstlane(tid >> 6);
    for (int ti = 0; ti < 32; ++ti) {
        const int lrow = wid * 32 + ti;
        const size_t row = (size_t)panel * 256 + lrow;
        const int i0 = IDXp[lrow * 128 + lane], i1 = IDXp[lrow * 128 + 64 + lane];
        const float g0 = GTp[lrow * 128 + lane], g1 = GTp[lrow * 128 + 64 + lane];
        const float su0 = SU[i0], su1 = SU[i1], sv0 = SV[i0], sv1 = SV[i1];
        float h[16];
        { const v4u hA = *(const GAS v4u*)(XN + row * DM + 16 * lane), hB = *(const GAS v4u*)(XN + row * DM + 16 * lane + 8);
          h[0] = bflo(hA.x); h[1] = bfhi(hA.x); h[2] = bflo(hA.y); h[3] = bfhi(hA.y); h[4] = bflo(hA.z); h[5] = bfhi(hA.z); h[6] = bflo(hA.w); h[7] = bfhi(hA.w);
          h[8] = bflo(hB.x); h[9] = bfhi(hB.x); h[10] = bflo(hB.y); h[11] = bfhi(hB.y); h[12] = bflo(hB.z); h[13] = bfhi(hB.z); h[14] = bflo(hB.w); h[15] = bfhi(hB.w); }
        float coef[2];
#pragma unroll
        for (int hf = 0; hf < 2; ++hf) {
            const int iv = hf ? i1 : i0;
            float q[4];
#pragma unroll
            for (int k = 0; k < 4; ++k) q[k] = 0.f;
#pragma unroll
            for (int c = 0; c < 4; ++c) {
                v4u ua[16];
#pragma unroll
                for (int j = 0; j < 16; ++j) { const int ex = __builtin_amdgcn_readlane(iv, c * 16 + j); ua[j] = *((const GAS v4u*)(EU8 + (size_t)ex * DM) + lane); }
                float p[16];
#pragma unroll
                for (int j = 0; j < 16; ++j) p[j] = dot16_fp8(ua[j], h);
                RS_LEVEL(p, 8, 8); RS_LEVEL(p, 4, 4); RS_LEVEL(p, 2, 2); RS_LEVEL(p, 1, 1);
                q[c] = p[0];
            }
            RS_LEVEL(q, 2, 32); RS_LEVEL(q, 1, 16);
            const float s = q[0] * (hf ? su1 : su0);
            const float act = 0.5f * s * (1.0f + erff(s * 0.70710678118654752f));
            coef[hf] = (hf ? g1 : g0) * act * (hf ? sv1 : sv0);
        }
        float o[16];
        { const GAS f32x4* xp = (const GAS f32x4*)(XIO + row * DM + 16 * lane);
#pragma unroll
          for (int k = 0; k < 4; ++k) { const f32x4 x = xp[k]; o[4 * k] = x.x; o[4 * k + 1] = x.y; o[4 * k + 2] = x.z; o[4 * k + 3] = x.w; } }
#pragma unroll
        for (int hf = 0; hf < 2; ++hf) {
            const int iv = hf ? i1 : i0; const float cv = coef[hf];
#pragma unroll
            for (int c = 0; c < 4; ++c) {
                v4u va[16];
#pragma unroll
                for (int j = 0; j < 16; ++j) { const int ex = __builtin_amdgcn_readlane(iv, c * 16 + j); va[j] = *((const GAS v4u*)(EV8 + (size_t)ex * DM) + lane); }
#pragma unroll
                for (int j = 0; j < 16; ++j) { const float cf = __builtin_bit_cast(float, __builtin_amdgcn_readlane(__builtin_bit_cast(int, cv), c * 16 + j)); fma16_fp8(o, cf, va[j]); }
            }
        }
        float ss = 0.f;
#pragma unroll
        for (int k = 0; k < 16; ++k) ss += o[k] * o[k];
        const float r = 1.f / sqrtf(wave_sum(ss, lane) * (1.f / DM) + RMS_EPS);
        { GAS f32x4* xp = (GAS f32x4*)(XIO + row * DM + 16 * lane);
#pragma unroll
          for (int k = 0; k < 4; ++k) xp[k] = (f32x4){o[4 * k], o[4 * k + 1], o[4 * k + 2], o[4 * k + 3]}; }
        v4u ha, hb;
        ha.x = cvtpk(o[0] * r, o[1] * r); ha.y = cvtpk(o[2] * r, o[3] * r); ha.z = cvtpk(o[4] * r, o[5] * r); ha.w = cvtpk(o[6] * r, o[7] * r);
        hb.x = cvtpk(o[8] * r, o[9] * r); hb.y = cvtpk(o[10] * r, o[11] * r); hb.z = cvtpk(o[12] * r, o[13] * r); hb.w = cvtpk(o[14] * r, o[15] * r);
        *(GAS v4u*)(XN + row * DM + 16 * lane) = ha; *(GAS v4u*)(XN + row * DM + 16 * lane + 8) = hb;
    }
}

#define BS_STAGE(K, J) do { const bool lower_ = (lane & (J)) == 0; \
    { const int p_ = shx(k0, J, lane); const bool asc_ = ((lane & (K)) == 0); const int mn_ = k0 < p_ ? k0 : p_, mx_ = k0 < p_ ? p_ : k0; k0 = (lower_ == asc_) ? mn_ : mx_; } \
    { const int p_ = shx(k1, J, lane); const bool asc_ = (((lane + 64) & (K)) == 0); const int mn_ = k1 < p_ ? k1 : p_, mx_ = k1 < p_ ? p_ : k1; k1 = (lower_ == asc_) ? mn_ : mx_; } } while (0)
#ifndef PEER_BSHIFT
#define PEER_BSHIFT 11
#endif
constexpr int PEER_NB = 16384 >> PEER_BSHIFT;
__device__ __forceinline__ void peer_sort_panel(int* IDXp, float* GTp, float* SUp, unsigned char* STp, const float* SU, const float* SV, const int wid0) {
    const int tid = otid(wid0), lane = tid & 63, wid = __builtin_amdgcn_readfirstlane(tid >> 6);
    int ni0 = IDXp[wid * 32 * 128 + lane], ni1 = IDXp[wid * 32 * 128 + 64 + lane];
    float ng0 = GTp[wid * 32 * 128 + lane], ng1 = GTp[wid * 32 * 128 + 64 + lane];
    for (int ti = 0; ti < 32; ++ti) {
        const int lrow = wid * 32 + ti;
        const int i0 = ni0, i1 = ni1; const float g0 = ng0, g1 = ng1;
        if (ti < 31) { ni0 = IDXp[(lrow + 1) * 128 + lane]; ni1 = IDXp[(lrow + 1) * 128 + 64 + lane]; ng0 = GTp[(lrow + 1) * 128 + lane]; ng1 = GTp[(lrow + 1) * 128 + 64 + lane]; }
        const float u0 = SU[i0], u1 = SU[i1], w0 = SV[i0] * g0, w1 = SV[i1] * g1;
        int k0 = (i0 << 7) | lane, k1 = (i1 << 7) | (64 + lane);
        BS_STAGE(2, 1);
        BS_STAGE(4, 2); BS_STAGE(4, 1);
        BS_STAGE(8, 4); BS_STAGE(8, 2); BS_STAGE(8, 1);
        BS_STAGE(16, 8); BS_STAGE(16, 4); BS_STAGE(16, 2); BS_STAGE(16, 1);
        BS_STAGE(32, 16); BS_STAGE(32, 8); BS_STAGE(32, 4); BS_STAGE(32, 2); BS_STAGE(32, 1);
        BS_STAGE(64, 32); BS_STAGE(64, 16); BS_STAGE(64, 8); BS_STAGE(64, 4); BS_STAGE(64, 2); BS_STAGE(64, 1);
        { const int mn_ = k0 < k1 ? k0 : k1, mx_ = k0 < k1 ? k1 : k0; k0 = mn_; k1 = mx_; }
        BS_STAGE(128, 32); BS_STAGE(128, 16); BS_STAGE(128, 8); BS_STAGE(128, 4); BS_STAGE(128, 2); BS_STAGE(128, 1);
        const int s0 = k0 & 127, s1 = k1 & 127, e0 = k0 >> 7, e1 = k1 >> 7;
        const float ua0 = shl_(u0, s0 & 63), ub0 = shl_(u1, s0 & 63), ua1 = shl_(u0, s1 & 63), ub1 = shl_(u1, s1 & 63);
        const float wa0 = shl_(w0, s0 & 63), wb0 = shl_(w1, s0 & 63), wa1 = shl_(w0, s1 & 63), wb1 = shl_(w1, s1 & 63);
        IDXp[lrow * 128 + lane] = e0; IDXp[lrow * 128 + 64 + lane] = e1;
        SUp[lrow * 128 + lane] = (s0 < 64) ? ua0 : ub0; SUp[lrow * 128 + 64 + lane] = (s1 < 64) ? ua1 : ub1;
        GTp[lrow * 128 + lane] = (s0 < 64) ? wa0 : wb0; GTp[lrow * 128 + 64 + lane] = (s1 < 64) ? wa1 : wb1;
        int stv = 0;
#pragma unroll
        for (int r = 1; r < PEER_NB; ++r) { const int c = __builtin_popcountll(__ballot(e0 < (r << PEER_BSHIFT))) + __builtin_popcountll(__ballot(e1 < (r << PEER_BSHIFT))); stv = (lane == r) ? c : stv; }
        stv = (lane == PEER_NB) ? 128 : stv;
        if (lane < 32) STp[lrow * 32 + lane] = (unsigned char)stv;
    }
}
__device__ __forceinline__ void peer_usweep_panel(int panel, const bf16* X1B  , LAS const float* r1, const int* IDXp, const float* GMp, const float* SUp, float* CFp, const unsigned char* EU8, const int wid0) {
    const int tid = otid(wid0), lane = tid & 63, wid = __builtin_amdgcn_readfirstlane(tid >> 6);
    const int tq = (lane >> 3) & 1, pj = lane & 7;
    int ix_n; float gm_n, su_n; v4u hA0_n, hB0_n, hA1_n, hB1_n;
#define US_META(s_) do { const int c_ = (s_) >> 4, tp_ = (s_) & 15; const int lr_ = wid * 32 + 2 * tp_; const int off_ = (lr_ + tq) * 128 + 8 * c_ + pj; \
        ix_n = IDXp[off_]; gm_n = GMp[off_]; su_n = SUp[off_] * r1[lr_ + tq]; \
        const bf16* h0_ = X1B + (size_t)lr_ * DM + 16 * lane; hA0_n = *(const GAS v4u*)h0_; hB0_n = *(const GAS v4u*)(h0_ + 8); hA1_n = *(const GAS v4u*)(h0_ + DM); hB1_n = *(const GAS v4u*)(h0_ + DM + 8); } while (0)
    US_META(0);
    for (int s = 0; s < 256; ++s) {
        const int ix = ix_n; const float gm = gm_n, su = su_n; const v4u hA0 = hA0_n, hB0 = hB0_n, hA1 = hA1_n, hB1 = hB1_n;
        v4u ua[16];
#pragma unroll
        for (int j = 0; j < 16; ++j) { const int ex = __builtin_amdgcn_readlane(ix, j); ua[j] = *((const GAS v4u*)(EU8 + (size_t)ex * DM) + lane); }
        if (s < 255) US_META(s + 1);
        float h[16], p[16];
        h[0] = bflo(hA0.x); h[1] = bfhi(hA0.x); h[2] = bflo(hA0.y); h[3] = bfhi(hA0.y); h[4] = bflo(hA0.z); h[5] = bfhi(hA0.z); h[6] = bflo(hA0.w); h[7] = bfhi(hA0.w);
        h[8] = bflo(hB0.x); h[9] = bfhi(hB0.x); h[10] = bflo(hB0.y); h[11] = bfhi(hB0.y); h[12] = bflo(hB0.z); h[13] = bfhi(hB0.z); h[14] = bflo(hB0.w); h[15] = bfhi(hB0.w);
#pragma unroll
        for (int j = 0; j < 8; ++j) p[j] = dot16_fp8(ua[j], h);
        h[0] = bflo(hA1.x); h[1] = bfhi(hA1.x); h[2] = bflo(hA1.y); h[3] = bfhi(hA1.y); h[4] = bflo(hA1.z); h[5] = bfhi(hA1.z); h[6] = bflo(hA1.w); h[7] = bfhi(hA1.w);
        h[8] = bflo(hB1.x); h[9] = bfhi(hB1.x); h[10] = bflo(hB1.y); h[11] = bfhi(hB1.y); h[12] = bflo(hB1.z); h[13] = bfhi(hB1.z); h[14] = bflo(hB1.w); h[15] = bfhi(hB1.w);
#pragma unroll
        for (int j = 8; j < 16; ++j) p[j] = dot16_fp8(ua[j], h);
        RS_LEVEL(p, 8, 8); RS_LEVEL(p, 4, 4); RS_LEVEL(p, 2, 2); RS_LEVEL(p, 1, 1);
        float d = p[0]; d += shx(d, 16, lane); d += shx(d, 32, lane);
        const float sx = d * su;
        const float act = 0.5f * sx * (1.0f + erff(sx * 0.70710678118654752f));
        const int c = s >> 4, tp = s & 15;
        if (lane < 16) CFp[(wid * 32 + 2 * tp + tq) * 128 + 8 * c + pj] = gm * act;
    }
#undef US_META
}
__device__ __forceinline__ void peer_v_panel(int panel, bf16* XN, const int* IDXp, const float* CFp, const unsigned char* EV8, float* XIO, const int wid0) {
    const int tid = otid(wid0), lane = tid & 63, wid = __builtin_amdgcn_readfirstlane(tid >> 6);
    for (int ti = 0; ti < 32; ++ti) {
        const int lrow = wid * 32 + ti;
        const size_t row = (size_t)panel * 256 + lrow;
        const int i0 = IDXp[lrow * 128 + lane], i1 = IDXp[lrow * 128 + 64 + lane];
        const float c0 = CFp[lrow * 128 + lane], c1 = CFp[lrow * 128 + 64 + lane];
        float o[16];
        { const GAS f32x4* xp = (const GAS f32x4*)(XIO + row * DM + 16 * lane);
#pragma unroll
          for (int k = 0; k < 4; ++k) { const f32x4 x = xp[k]; o[4 * k] = x.x; o[4 * k + 1] = x.y; o[4 * k + 2] = x.z; o[4 * k + 3] = x.w; } }
#pragma unroll
        for (int hf = 0; hf < 2; ++hf) {
            const int iv = hf ? i1 : i0; const float cv = hf ? c1 : c0;
#pragma nounroll
            for (int c = 0; c < 4; ++c) {
                v4u va[16];
#pragma unroll
                for (int j = 0; j < 16; ++j) { const int ex = __builtin_amdgcn_readlane(iv, c * 16 + j); va[j] = *((const GAS v4u*)(EV8 + (size_t)ex * DM) + lane); }
#pragma unroll
                for (int j = 0; j < 16; ++j) { const float cf = __builtin_bit_cast(float, __builtin_amdgcn_readlane(__builtin_bit_cast(int, cv), c * 16 + j)); fma16_fp8(o, cf, va[j]); }
            }
        }
        float ss = 0.f;
#pragma unroll
        for (int k = 0; k < 16; ++k) ss += o[k] * o[k];
        const float r = 1.f / sqrtf(wave_sum(ss, lane) * (1.f / DM) + RMS_EPS);
        { GAS f32x4* xp = (GAS f32x4*)(XIO + row * DM + 16 * lane);
#pragma unroll
          for (int k = 0; k < 4; ++k) xp[k] = (f32x4){o[4 * k], o[4 * k + 1], o[4 * k + 2], o[4 * k + 3]}; }
        v4u ha, hb;
        ha.x = cvtpk(o[0] * r, o[1] * r); ha.y = cvtpk(o[2] * r, o[3] * r); ha.z = cvtpk(o[4] * r, o[5] * r); ha.w = cvtpk(o[6] * r, o[7] * r);
        hb.x = cvtpk(o[8] * r, o[9] * r); hb.y = cvtpk(o[10] * r, o[11] * r); hb.z = cvtpk(o[12] * r, o[13] * r); hb.w = cvtpk(o[14] * r, o[15] * r);
        *(GAS v4u*)(XN + row * DM + 16 * lane) = ha; *(GAS v4u*)(XN + row * DM + 16 * lane + 8) = hb;
    }
}

__device__ __forceinline__ void peer_vsweep_panel(int panel, const bf16* X1B, bf16* X2B  , LAS float* r3, const int* IDXp, const float* CFp, const unsigned char* EV8, const int wid0) {
    const int wid = wid0;
#pragma nounroll
    for (int g = 0; g < 4; ++g) {
        const int lane = lane_id();
        const int lr0 = wid * 32 + 8 * g;
        float o[8][16];
#pragma unroll
        for (int t = 0; t < 8; ++t) { const bf16* xp = X1B + (size_t)(lr0 + t) * DM + 16 * lane; const v4u a = *(const GAS v4u*)xp, b2 = *(const GAS v4u*)(xp + 8); H_UNPACK(o[t], a, b2); }
        const int moff = (lr0 + (lane >> 3)) * 128 + (lane & 7);
        int ix_n = IDXp[moff]; float cf_n = CFp[moff];
#pragma nounroll
        for (int c = 0; c < 16; ++c) {
            const int ix = ix_n; const float cf = cf_n;
            if (c < 15) { ix_n = IDXp[moff + 8 * (c + 1)]; cf_n = CFp[moff + 8 * (c + 1)]; }
#pragma unroll
            for (int b = 0; b < 8; ++b) {
                v4u va[8];
#pragma unroll
                for (int j = 0; j < 8; ++j) { const int ex = __builtin_amdgcn_readlane(ix, 8 * b + j); va[j] = *((const GAS v4u*)(EV8 + (size_t)ex * DM) + lane); }
#pragma unroll
                for (int j = 0; j < 8; ++j) { const float cfi = __builtin_bit_cast(float, __builtin_amdgcn_readlane(__builtin_bit_cast(int, cf), 8 * b + j)); fma16_fp8(o[b], cfi, va[j]); }
            }
        }
        const int lane2 = lane_id();
#pragma unroll
        for (int t = 0; t < 8; ++t) {
            float ss = 0.f;
#pragma unroll
            for (int k = 0; k < 16; ++k) ss += o[t][k] * o[t][k];
            const float r = 1.f / sqrtf(wave_sum(ss, lane2) * (1.f / DM) + RMS_EPS);
            if (lane2 == 0) r3[lr0 + t] = r;
            v4u ha, hb;
            ha.x = cvtpk(o[t][0], o[t][1]); ha.y = cvtpk(o[t][2], o[t][3]); ha.z = cvtpk(o[t][4], o[t][5]); ha.w = cvtpk(o[t][6], o[t][7]);
            hb.x = cvtpk(o[t][8], o[t][9]); hb.y = cvtpk(o[t][10], o[t][11]); hb.z = cvtpk(o[t][12], o[t][13]); hb.w = cvtpk(o[t][14], o[t][15]);
            bf16* xo = X2B + (size_t)(lr0 + t) * DM + 16 * lane2;
            *(GAS v4u*)xo = ha; *(GAS v4u*)(xo + 8) = hb;
        }
    }
}


struct Args {
    const float *x, *p, *norm_mix, *w_in, *w_att_up, *w_pool_group, *pool_scale, *w_out, *norm_ffn, *w_query, *sub_keys, *expert_u, *expert_v, *norm_ple, *w_ple_gate, *w_ple, *norm_final;
    float* out; unsigned char* ws; int ph_hi, pad;
};

#ifndef REP_P0
#define REP_P0 1
#endif
#ifndef REP_P1
#define REP_P1 1
#endif
#ifndef REP_P23
#define REP_P23 1
#endif
#ifndef REP_P4
#define REP_P4 1
#endif
#ifndef REP_P567
#define REP_P567 1
#endif
#ifndef REP_P9
#define REP_P9 1
#endif
#ifndef REP_ATT
#define REP_ATT 1
#endif
#ifndef REP_TOPK
#define REP_TOPK 1
#endif
#ifndef REP_MRG
#define REP_MRG 1
#endif
#ifndef MK_PH_HI
#define MK_PH_HI 99
#endif

typedef const __attribute__((address_space(4))) Args* CArgs;
__device__ __forceinline__ CArgs kargs() { CArgs p = (CArgs)__builtin_amdgcn_kernarg_segment_ptr(); asm volatile("" : "+s"(p)); return p; }
#define WSP(T, off) ((T*)(kargs()->ws + (off)))
__global__ void __launch_bounds__(NTHR, 2) mega_fwd(Args a_unused) {
    extern __shared__ __attribute__((aligned(16))) unsigned char lds_raw[];
    LAS unsigned char* lds = (LAS unsigned char*)lds_raw;
    volatile LAS unsigned* MISC = (volatile LAS unsigned*)(lds + MISC_OFF);
    const int G = gridDim.x; const int bx = blockIdx.x;
    const int vcu = (G % 8 == 0) ? (bx % 8) * (G / 8) + bx / 8 : bx;
    gu32* ctl = (gu32*)(kargs()->ws + WS_CTL);
    const int wid0 = __builtin_amdgcn_readfirstlane((int)threadIdx.x >> 6);
#define IS_T0 (otid(wid0) == 0)
    for (int u = otid(wid0); u < (LDS_BYTES - LDSCTL_OFF) / 4; u += NTHR) ((LAS unsigned*)(lds + LDSCTL_OFF))[u] = 0u;
    __syncthreads();
    (void)xcd_barrier_post((unsigned*)(ctl + CW_BAR), MISC + 8, IS_T0);
#define GRID_BAR() do { XcdBarrier _b; _b.bar = (unsigned*)((gu32*)(kargs()->ws + WS_CTL) + CW_BAR); _b.x = xb_xcc_id(); _b.st = (volatile LAS unsigned*)(lds + MISC_OFF) + 8; xcd_barrier(_b, IS_T0); } while (0)
    LAS float* const SS1 = (LAS float*)(lds + LDSCTL_OFF + 1024);
    LAS float* const R3 = (LAS float*)(lds + LDSCTL_OFF + 2048);
    LAS float* const SSF = (LAS float*)(lds + LDSCTL_OFF + 3072);
#define LOCAL_SEAM() do { VM_WAIT(); __syncthreads(); if (IS_T0) { __builtin_amdgcn_fence(__ATOMIC_ACQUIRE, "agent"); VM_WAIT(); } __syncthreads(); } while (0)

    for (int rep_ = 0; rep_ < REP_P0; ++rep_) {
        const int tid = otid(wid0), lane = tid & 63, wid = __builtin_amdgcn_readfirstlane(tid >> 6);
        const CArgs a = kargs(); unsigned char* ws = a->ws;
        bf16 *WIN = (bf16*)(ws + WS_WIN), *WOUT = (bf16*)(ws + WS_WOUT), *WQ = (bf16*)(ws + WS_WQ), *WPG = (bf16*)(ws + WS_WPG), *WPLE = (bf16*)(ws + WS_WPLE);
        bf16 *BDA = (bf16*)(ws + WS_BDA), *BDP = (bf16*)(ws + WS_BDP), *SK = (bf16*)(ws + WS_SK), *XN = (bf16*)(ws + WS_XN);
        LAS float* scr = (LAS float*)(lds + wid * 16384);
        const int gw = vcu * NWAVES + wid, NGW = G * NWAVES;
        constexpr int I_IN = (1024 / 64) * (4096 / 32), I_OUT = (1024 / 64) * (1024 / 32), I_Q = (1024 / 64) * (2048 / 32), I_PG = I_OUT, I_PLE = (256 / 64) * (1024 / 32);
        constexpr int NITEMS = I_IN + I_OUT + I_Q + I_PG + I_PLE;
        for (int it = gw; it < NITEMS; it += NGW) {
            int r = it;
            if (r < I_IN) { p0_transpose_item(a->w_in, 1024, 4096, WIN, a->norm_mix, 512, C2, scr, r, lane); continue; } r -= I_IN;
            if (r < I_OUT) { p0_transpose_item(a->w_out, 1024, 1024, WOUT, nullptr, 0, 1.f, scr, r, lane); continue; } r -= I_OUT;
            if (r < I_Q) { p0_transpose_item(a->w_query, 1024, 2048, WQ, a->norm_ffn, 0, 1.f, scr, r, lane); continue; } r -= I_Q;
            if (r < I_PG) { p0_transpose_item(a->w_ple_gate, 1024, 1024, WPG, a->norm_ple, 0, 1.f, scr, r, lane); continue; } r -= I_PG;
            p0_transpose_item(a->w_ple, 256, 1024, WPLE, nullptr, 0, 1.f, scr, r, lane);
        }
        const int gt = vcu * NTHR + tid, NGT = G * NTHR;
        for (int it = gt; it < 1024 * 16; it += NGT) {
            const int n = it >> 4, k8 = (it & 15) * 8, head = n >> 7, g = n >> 8;
            float va[8], vp[8]; const float ps = a->pool_scale[n];
#pragma unroll
            for (int j = 0; j < 8; ++j) {
                const int k = k8 + j;
                va[j] = ((k >> 6) == (head & 1)) ? a->w_att_up[((size_t)head * 64 + (k & 63)) * 128 + (n & 127)] : 0.f;
                vp[j] = a->w_pool_group[((size_t)g * 128 + k) * 256 + (n & 255)] * ps;
            }
            v4u o; o.x = pk2(va[0], va[1]); o.y = pk2(va[2], va[3]); o.z = pk2(va[4], va[5]); o.w = pk2(va[6], va[7]);
            *(GAS v4u*)(BDA + (size_t)n * 128 + k8) = o;
            o.x = pk2(vp[0], vp[1]); o.y = pk2(vp[2], vp[3]); o.z = pk2(vp[4], vp[5]); o.w = pk2(vp[6], vp[7]);
            *(GAS v4u*)(BDP + (size_t)n * 128 + k8) = o;
        }
        for (int it = gt; it < 16 * 128 * 128 / 8; it += NGT) cvt8_store(a->sub_keys + (size_t)it * 8, SK + (size_t)it * 8);
        for (int rr = gw; rr < 2 * 16384; rr += NGW) { const int e = rr >> 1;
            if (rr & 1) quant_row_fp8(a->expert_v + (size_t)e * DM, nullptr, ws + WS_EV + (size_t)e * DM, (float*)(ws + WS_SV) + e, lane);
            else quant_row_fp8(a->expert_u + (size_t)e * DM, a->norm_ffn, ws + WS_EU + (size_t)e * DM, (float*)(ws + WS_SU) + e, lane); }
        { const int panel = bx;
            for (int r = wid; r < 256; r += NWAVES) { const size_t row = (size_t)panel * 256 + r; rms_row_to_bf16(a->x + row * DM, XN + row * DM, lane); } }
    }
    GRID_BAR();

    for (int rep_ = 0; rep_ < REP_P1; ++rep_) {
        { const int panel = bx;
            { pg8::Gemm g{WSP(bf16, WS_XN), WSP(bf16, WS_WIN), 1024, 1024, 1024, 0, 0, 1, 0}; pg8::PanelSched S{panel, 14, 4, 2, 0}; pg8::EpiProj E{WSP(bf16, WS_PQ), WSP(bf16, WS_PK), WSP(bf16, WS_PU), WSP(bf16, WS_PG)};
              pg8::gemm_phase<pg8::EpiProj, pg8::PanelSched, true, true>(lds, g, S, E, wid0); }
            { pg8::Gemm g{WSP(bf16, WS_WIN) + (size_t)1024 * 1024, WSP(bf16, WS_XN), 1024, 1024, 1024, 0, 0, 1, 0}; pg8::PanelSched S{panel, 2, 99, 0, 1}; pg8::EpiPlain E{WSP(bf16, WS_PVT), TOK};
              pg8::gemm_phase<pg8::EpiPlain, pg8::PanelSched, true, true>(lds, g, S, E, wid0); }
        }
    }
    GRID_BAR();

    { const int panel = bx;
        const size_t prow = (size_t)panel * 256;
        for (int rep_ = 0; rep_ < REP_P23; ++rep_) {
        if (MK_PH_HI > 2) { for (int r2_ = 0; r2_ < REP_ATT; ++r2_) attn_panel(panel, WSP(bf16, WS_PQ), WSP(bf16, WS_PK), WSP(bf16, WS_PVT), WSP(bf16, WS_YA), wid0); pool_panel(panel, WSP(bf16, WS_PU), WSP(bf16, WS_YP), wid0); LOCAL_SEAM(); }
        for (int r2_ = 0; r2_ < REP_MRG; ++r2_)
        if (MK_PH_HI > 3) {
            { pg8::Gemm g{WSP(bf16, WS_YA), WSP(bf16, WS_BDA), 128, 512, 128, 128, (long)((WS_YP - WS_YA) / 2), 1, 0}; pg8::PanelSched S{panel, 8, 99, 0, 0}; pg8::EpiMergeChain E{WSP(bf16, WS_PG), WSP(bf16, WS_MG)};
              pg8::gemm_phase<pg8::EpiMergeChain, pg8::PanelSched, true, true>(lds, g, S, E, wid0); }
            LOCAL_SEAM();
        }
        }
        for (int rep_ = 0; rep_ < REP_P4; ++rep_)
        if (MK_PH_HI > 4) {
            { pg8::Gemm g{WSP(bf16, WS_MG), WSP(bf16, WS_WOUT), 1024, 1024, 1024, 0, 0, 1, 0}; pg8::PanelSched S{panel, 4, 99, 0, 0}; pg8::EpiRes E{kargs()->x, (bf16*)kargs()->out, SS1};
              pg8::gemm_phase<pg8::EpiRes, pg8::PanelSched, true, true>(lds, g, S, E, wid0); }
            LOCAL_SEAM();
        }
        { { const int t_ = otid(wid0); if (t_ < 256) SS1[t_] = 1.f / sqrtf(SS1[t_] * (1.f / DM) + RMS_EPS); } __syncthreads(); }
        {
        if (MK_PH_HI > 6) {
            { pg8::Gemm g{(const bf16*)kargs()->out, WSP(bf16, WS_WQ), 1024, 1024, 1024, 0, 0, 2, 0}; pg8::PanelSched S{panel, 8, 99, 0, 0}; pg8::EpiPlainScale E{WSP(bf16, WS_PG), 2048, SS1};
              pg8::gemm_phase<pg8::EpiPlainScale, pg8::PanelSched, true, true>(lds, g, S, E, wid0); }
            LOCAL_SEAM();
        }
        #define IDXP ((int*)(kargs()->ws + WS_YA + (size_t)panel * 262144))
#define GTP ((float*)(kargs()->ws + WS_YA + (size_t)panel * 262144 + 131072))
        if (MK_PH_HI > 7) { for (int r2_ = 0; r2_ < REP_TOPK; ++r2_) topk_panel(panel, WSP(bf16, WS_PG), WSP(bf16, WS_SK), IDXP, GTP, lds, wid0); LOCAL_SEAM(); }
        }
#ifndef PEER_SWEEP
#define PEER_SWEEP 1
#endif
#define STP ((unsigned char*)(kargs()->ws + WS_YP + (size_t)panel * 262144))
#define CFP ((float*)(kargs()->ws + WS_YP + (size_t)panel * 262144 + 131072))
#define SLOTP ((int*)(kargs()->ws + WS_MG + (size_t)panel * 524288 + 131072))
#define IDXPADP ((int*)(kargs()->ws + WS_PG + (size_t)panel * 1048576))
#define CFPADP ((float*)(kargs()->ws + WS_PG + (size_t)panel * 1048576 + 393216))
#define SUSP ((float*)(kargs()->ws + WS_MG + (size_t)panel * 524288))
        if (MK_PH_HI > 8) {
            if (PEER_SWEEP) {
                peer_sort_panel(IDXP, GTP, SUSP, STP, WSP(float, WS_SU), WSP(float, WS_SV), wid0); LOCAL_SEAM();
                peer_usweep_panel(panel, (const bf16*)kargs()->out + (size_t)panel * 524288, SS1, IDXP, GTP, SUSP, CFP, WSP(unsigned char, WS_EU), wid0); LOCAL_SEAM();
#ifndef PEER_VSWEEP
#define PEER_VSWEEP 1
#endif
                peer_vsweep_panel(panel, (const bf16*)kargs()->out + (size_t)panel * 524288, WSP(bf16, WS_PG) + (size_t)panel * 524288, R3, IDXP, CFP, WSP(unsigned char, WS_EV), wid0);
                LOCAL_SEAM();
            }
        }
        for (int rep_ = 0; rep_ < REP_P9; ++rep_)
        if (MK_PH_HI > 9) {
            { const int tid = otid(wid0); const float* pp = kargs()->p; bf16* YP = WSP(bf16, WS_YP); for (int it = tid; it < 256 * 256 / 8; it += NTHR) { const int r = it >> 5, c8 = (it & 31) * 8; cvt8_store(pp + (prow + r) * 256 + c8, YP + (prow + r) * 512 + c8); } }
            LOCAL_SEAM();
            { pg8::Gemm g{WSP(bf16, WS_YP), WSP(bf16, WS_WPLE), 256, 512, 256, 0, 0, 1, 0}; pg8::PanelSched S{panel, 4, 99, 0, 0}; pg8::EpiPlain E{WSP(bf16, WS_MG), 1024};
              pg8::gemm_phase<pg8::EpiPlain, pg8::PanelSched, true, true>(lds, g, S, E, wid0); }
            LOCAL_SEAM();
        }
        if (MK_PH_HI > 10) {
            { pg8::Gemm g{WSP(bf16, WS_PG), WSP(bf16, WS_WPG), 1024, 1024, 1024, 0, 0, 2, 0}; pg8::PanelSched S{panel, 4, 99, 0, 0}; pg8::EpiGate E{kargs()->out, WSP(bf16, WS_PG), WSP(bf16, WS_MG), R3, SSF};
              pg8::gemm_phase<pg8::EpiGate, pg8::PanelSched, true, true>(lds, g, S, E, wid0); }
            LOCAL_SEAM();
        }
        if (MK_PH_HI > 11) {
            const int tid = otid(wid0), lane = tid & 63, wid = __builtin_amdgcn_readfirstlane(tid >> 6);
            for (int r = wid; r < 256; r += NWAVES) {
                GAS f32x4* xr = (GAS f32x4*)(kargs()->out + (prow + r) * DM) + lane; const GAS f32x4* gr = (const GAS f32x4*)kargs()->norm_final + lane;
                const float rr = 1.f / sqrtf(SSF[r] * (1.f / DM) + RMS_EPS);
#pragma unroll
                for (int j = 0; j < 4; ++j) xr[64 * j] = xr[64 * j] * rr * gr[64 * j];
            }
        }
    }
#undef LOCAL_SEAM
}


extern "C" void kernel_launch(void* const* d_in, const int* in_sizes, int n_in, void* d_out, int out_size, void* d_ws, size_t ws_size, hipStream_t stream) {
    static int grid = 0;
    if (grid == 0) {
        if (n_in != 17 || in_sizes[0] != TOK * DM || out_size != TOK * DM || ws_size < WS_END) { fprintf(stderr, "kernel_launch: unexpected shapes (n_in %d, in0 %d, out %d, ws %zu); nothing launched\n", n_in, n_in > 0 ? in_sizes[0] : -1, out_size, ws_size); grid = -1; return; }
        int dev = 0, cus = 0;
        if (hipGetDevice(&dev) != hipSuccess || hipDeviceGetAttribute(&cus, hipDeviceAttributeMultiprocessorCount, dev) != hipSuccess) { fprintf(stderr, "kernel_launch: device query failed\n"); grid = -1; return; }
        if (hipFuncSetAttribute((const void*)mega_fwd, hipFuncAttributeMaxDynamicSharedMemorySize, LDS_BYTES) != hipSuccess) { fprintf(stderr, "kernel_launch: hipFuncSetAttribute failed\n"); grid = -1; return; }
        int per_cu = 0;
        if (hipOccupancyMaxActiveBlocksPerMultiprocessor(&per_cu, (const void*)mega_fwd, NTHR, LDS_BYTES) != hipSuccess || per_cu < 1) fprintf(stderr, "kernel_launch: note: occupancy query reports %d workgroups per CU\n", per_cu);
        (void)hipGetLastError();
        if (cus != NPANEL) fprintf(stderr, "kernel_launch: note: %d CUs; this kernel is built for one 256-token panel per CU on a 256-CU device\n", cus);
        grid = NPANEL;
    }
    if (grid < 0) return;
    if (hipMemsetAsync((char*)d_ws + WS_CTL, 0, CTL_ZERO_BYTES, stream) != hipSuccess) { fprintf(stderr, "kernel_launch: memset failed\n"); return; }
    Args a{};
    a.x = (const float*)d_in[0]; a.p = (const float*)d_in[1]; a.norm_mix = (const float*)d_in[2]; a.w_in = (const float*)d_in[3]; a.w_att_up = (const float*)d_in[4];
    a.w_pool_group = (const float*)d_in[5]; a.pool_scale = (const float*)d_in[6]; a.w_out = (const float*)d_in[7]; a.norm_ffn = (const float*)d_in[8]; a.w_query = (const float*)d_in[9];
    a.sub_keys = (const float*)d_in[10]; a.expert_u = (const float*)d_in[11]; a.expert_v = (const float*)d_in[12]; a.norm_ple = (const float*)d_in[13]; a.w_ple_gate = (const float*)d_in[14];
    a.w_ple = (const float*)d_in[15]; a.norm_final = (const float*)d_in[16];
    a.out = (float*)d_out; a.ws = (unsigned char*)d_ws; a.ph_hi = MK_PH_HI; a.pad = 0;
    hipLaunchKernelGGL(mega_fwd, dim3(grid), dim3(NTHR), LDS_BYTES, stream, a);
    { const hipError_t le = hipPeekAtLastError(); if (le != hipSuccess) fprintf(stderr, "kernel_launch: launch failed: %s\n", hipGetErrorName(le)); }
}
```

```cpp
#include <hip/hip_runtime.h>
#include <cstdio>
#include <cstdint>
#include <math.h>
__device__ __forceinline__ int lane_id() { int l; asm volatile("v_mbcnt_lo_u32_b32 %0, -1, 0\n\tv_mbcnt_hi_u32_b32 %0, -1, %0" : "=v"(l)); return l; }
__device__ __forceinline__ int otid(int wid0) { return (wid0 << 6) | lane_id(); }

namespace pg8 {
#define PG8_LAS __attribute__((address_space(3)))
typedef unsigned short bf16_t;
typedef short bf16x8 __attribute__((ext_vector_type(8)));
typedef float f32x4 __attribute__((ext_vector_type(4)));
typedef unsigned u32x4 __attribute__((ext_vector_type(4)));
constexpr int BM = 256, BK = 64, HALF = 128, HTB = HALF * BK * 2  , STAGE_BYTES = 8 * HTB, NXCD = 8, WGM = 8;

__host__ __device__ __forceinline__ int lds_byte(int r, int c) { const int st = (r >> 4) * 2 + (c >> 5), rr = r & 15, cc = c & 31, ob = rr * 64 + cc * 2; return st * 1024 + (ob ^ (((ob >> 9) & 1) << 5)); }
__host__ __device__ __forceinline__ void stage_rc(int b, int& R, int& C) { const int st = b / 1024, sb = b % 1024, swz = sb ^ (((sb >> 9) & 1) << 5); R = (st >> 1) * 16 + swz / 64; C = (st & 1) * 32 + (swz % 64) / 2; }
__host__ __device__ __forceinline__ int perm32(int rho) { const int n = rho >> 4, i = rho & 15; return 8 * (i >> 2) + 4 * n + (i & 3); }

struct Unit { int pm, pn; };
struct Gemm { const bf16_t* A; const bf16_t* Bt; int K, lda, ldb, akoff; long a2off; int am, pad_; };

struct StaticOrder {
    int nM, nN, nwg, G, c;
    __host__ __device__ void init(int M, int N, int G_, int c_) { nM = M / BM; nN = N / BM; nwg = nM * nN; G = G_; c = c_; }
    __host__ __device__ bool next(int i, Unit& u) const {
        const long L = (long)i * G + c; if (L >= nwg) return false;
        int wgid = (int)L; { const int q = nwg / NXCD, r = nwg % NXCD, xcd = wgid % NXCD, off = wgid / NXCD; wgid = (xcd < r ? xcd * (q + 1) : r * (q + 1) + (xcd - r) * q) + off; }
        const int nig = WGM * nN, gid = wgid / nig, fm = gid * WGM, gsz = (nM - fm) < WGM ? (nM - fm) : WGM;
        u.pm = fm + ((wgid % nig) % gsz); u.pn = (wgid % nig) / gsz; return true;
    }
    __device__ __forceinline__ void a_ready(const Unit&) const {}
    __device__ __forceinline__ void done(const Unit&) const {}
};

template <class Epi, class Sched, bool ALIGN_EPI = false, bool SP2 = false>
__device__ __forceinline__ void gemm_phase(PG8_LAS unsigned char* lds, const Gemm g, const Sched& S, const Epi& E, const int wid0) {
    const int tid = otid(wid0), wid = __builtin_amdgcn_readfirstlane(tid >> 6), lane = tid & 63, wr = wid >> 2, wc = wid & 3, fr = lane & 15, fq = lane >> 4;
    const int K = g.K, nt = K / BK;
    unsigned voffA[2], voffB[2];
#pragma unroll
    for (int i = 0; i < 2; ++i) { int R, C; stage_rc(tid * 16 + i * 8192, R, C); const int Rb = Epi::PERM ? ((R & ~31) + perm32(R & 31)) : R;
        voffA[i] = (unsigned)(R * g.lda + C) * 2u; voffB[i] = (unsigned)(Rb * g.ldb + C) * 2u; }
    const size_t kstep = (size_t)(BK * 2);
    const size_t hstepA = (size_t)HALF * g.lda * 2, hstepB = (size_t)HALF * g.ldb * 2;
    const size_t tstepA = 2 * hstepA, tstepB = 2 * hstepB, akb = (size_t)g.akoff * 2, a2b = (size_t)g.a2off * 2;
    const unsigned ldsw = (unsigned)wid * 1024u;
    const int aoff = lds_byte(wr * 64 + fr, fq * 8), boff = lds_byte(wc * 32 + fr, fq * 8);
#define PG8_SA(b, h) (((b) * 2 + (h)) * HTB)
#define PG8_SB(b, h) ((4 + (b) * 2 + (h)) * HTB)
#define PG8_STAGE(bufoff, gbase, voff) do { _Pragma("unroll") for (int _i = 0; _i < 2; ++_i) \
        __builtin_amdgcn_global_load_lds((const unsigned*)((const char*)(gbase) + (voff)[_i]), (PG8_LAS unsigned*)(lds + (bufoff) + ldsw + _i * 8192), 16, 0, 0); } while (0)
#define PG8_LDA(dst, b, h) do { _Pragma("unroll") for (int m = 0; m < 4; ++m) _Pragma("unroll") for (int k = 0; k < 2; ++k) dst[m][k] = *(const PG8_LAS bf16x8*)(lds + PG8_SA(b, h) + aoff + m * 2048 + k * 1024); } while (0)
#define PG8_LDB(dst, b, h) do { _Pragma("unroll") for (int n = 0; n < 2; ++n) _Pragma("unroll") for (int k = 0; k < 2; ++k) dst[n][k] = *(const PG8_LAS bf16x8*)(lds + PG8_SB(b, h) + boff + n * 2048 + k * 1024); } while (0)
#define PG8_MMA(ai, bj, At, Bt) do { __builtin_amdgcn_s_setprio(1); _Pragma("unroll") for (int m = 0; m < 4; ++m) _Pragma("unroll") for (int n = 0; n < 2; ++n) _Pragma("unroll") for (int k = 0; k < 2; ++k) \
        acc[ai][bj][m][n] = __builtin_amdgcn_mfma_f32_16x16x32_bf16(Bt[n][k], At[m][k], acc[ai][bj][m][n], 0, 0, 0); __builtin_amdgcn_s_setprio(0); } while (0)
#define PG8_WAIT_V(n) asm volatile("s_waitcnt vmcnt(" #n ")" ::: "memory")
#define PG8_WAIT_L(n) asm volatile("s_waitcnt lgkmcnt(" #n ")" ::: "memory")
#define PG8_BAR __builtin_amdgcn_s_barrier()
#define PG8_SCHED __builtin_amdgcn_sched_barrier(0)
    Unit cur, nxt; int ui = 0;
    if (!S.next(0, cur)) return;
    f32x4 acc[2][2][4][2];
#pragma unroll
    for (int a = 0; a < 2; ++a)
#pragma unroll
        for (int b = 0; b < 2; ++b)
#pragma unroll
            for (int m = 0; m < 4; ++m)
#pragma unroll
                for (int n = 0; n < 2; ++n) acc[a][b][m][n] = (f32x4){0.f, 0.f, 0.f, 0.f};
    bf16x8 At[4][2], B0[2][2], B1[2][2];
    const char* cA = (const char*)g.A + (size_t)(cur.pm * g.am) * tstepA + (size_t)(cur.pn & 3) * akb + (size_t)(cur.pn >> 2) * a2b; const char* cB = (const char*)g.Bt + (size_t)cur.pn * tstepB;
    S.a_ready(cur);
    if constexpr (SP2) {
        PG8_STAGE(PG8_SB(0, 0), cB, voffB); PG8_STAGE(PG8_SB(0, 1), cB + hstepB, voffB); PG8_STAGE(PG8_SA(0, 0), cA, voffA); PG8_STAGE(PG8_SA(0, 1), cA + hstepA, voffA);
        if (wr == 1) PG8_BAR;
        PG8_WAIT_V(2); PG8_BAR;
        PG8_STAGE(PG8_SB(1, 0), cB + kstep, voffB); PG8_STAGE(PG8_SA(1, 0), cA + kstep, voffA); PG8_STAGE(PG8_SB(1, 1), cB + hstepB + kstep, voffB);
        PG8_WAIT_V(6); PG8_BAR;
    } else {
        PG8_STAGE(PG8_SB(0, 0), cB, voffB); PG8_STAGE(PG8_SA(0, 0), cA, voffA); PG8_STAGE(PG8_SB(0, 1), cB + hstepB, voffB); PG8_STAGE(PG8_SA(0, 1), cA + hstepA, voffA);
        if (wr == 1) PG8_BAR;
        PG8_WAIT_V(4); PG8_BAR;
        PG8_STAGE(PG8_SB(1, 0), cB + kstep, voffB); PG8_STAGE(PG8_SA(1, 0), cA + kstep, voffA); PG8_STAGE(PG8_SB(1, 1), cB + hstepB + kstep, voffB);
        PG8_WAIT_V(6); PG8_BAR;
    }
    for (;;) {
        const bool has_next = S.next(ui + 1, nxt);
        const char* nA = has_next ? (const char*)g.A + (size_t)(nxt.pm * g.am) * tstepA + (size_t)(nxt.pn & 3) * akb + (size_t)(nxt.pn >> 2) * a2b : cA; const char* nB = has_next ? (const char*)g.Bt + (size_t)nxt.pn * tstepB : cB;
        for (int t = 0; t < nt; t += 2) {
            const bool last = (t == nt - 2);
            const char* a1 = cA + (size_t)(t + 1) * kstep;
            const char* a2 = last ? nA : cA + (size_t)(t + 2) * kstep; const char* b2 = last ? nB : cB + (size_t)(t + 2) * kstep;
            const char* a3 = a2 + kstep; const char* b3 = b2 + kstep;
            if (last && has_next) S.a_ready(nxt);
            if constexpr (SP2) {
            PG8_LDB(B0, 0, 0); PG8_LDB(B1, 0, 1); PG8_SCHED; PG8_LDA(At, 0, 0); PG8_STAGE(PG8_SA(1, 1), a1 + hstepA, voffA);
            PG8_WAIT_V(8); PG8_WAIT_L(0); PG8_BAR; PG8_MMA(0, 0, At, B0); PG8_MMA(0, 1, At, B1); PG8_BAR; PG8_SCHED;
            PG8_LDA(At, 0, 1); PG8_STAGE(PG8_SB(0, 0), b2, voffB); PG8_STAGE(PG8_SB(0, 1), b2 + hstepB, voffB); PG8_STAGE(PG8_SA(0, 0), a2, voffA);
            PG8_WAIT_V(8); PG8_WAIT_L(0); PG8_BAR; PG8_MMA(1, 0, At, B0); PG8_MMA(1, 1, At, B1); PG8_BAR; PG8_SCHED;
            PG8_LDB(B0, 1, 0); PG8_LDB(B1, 1, 1); PG8_SCHED; PG8_LDA(At, 1, 0); PG8_STAGE(PG8_SA(0, 1), a2 + hstepA, voffA);
            PG8_WAIT_V(8); PG8_WAIT_L(0); PG8_BAR; PG8_MMA(0, 0, At, B0); PG8_MMA(0, 1, At, B1); PG8_BAR; PG8_SCHED;
            PG8_LDA(At, 1, 1); PG8_STAGE(PG8_SB(1, 0), b3, voffB); PG8_STAGE(PG8_SB(1, 1), b3 + hstepB, voffB); PG8_STAGE(PG8_SA(1, 0), a3, voffA);
            PG8_WAIT_V(8); PG8_WAIT_L(0); PG8_BAR; PG8_MMA(1, 0, At, B0); PG8_MMA(1, 1, At, B1); PG8_BAR; PG8_SCHED;
            } else {
            PG8_LDB(B0, 0, 0); PG8_SCHED; PG8_LDA(At, 0, 0); PG8_STAGE(PG8_SA(1, 1), a1 + hstepA, voffA);
            PG8_WAIT_L(8); PG8_BAR; PG8_WAIT_L(0); PG8_MMA(0, 0, At, B0); PG8_BAR; PG8_SCHED;
            PG8_LDB(B1, 0, 1); PG8_STAGE(PG8_SB(0, 0), b2, voffB);
            PG8_BAR; PG8_WAIT_L(0); PG8_MMA(0, 1, At, B1); PG8_BAR;
            PG8_LDA(At, 0, 1); PG8_STAGE(PG8_SA(0, 0), a2, voffA);
            PG8_BAR; PG8_WAIT_L(0); PG8_MMA(1, 0, At, B0); PG8_BAR; PG8_SCHED;
            PG8_STAGE(PG8_SB(0, 1), b2 + hstepB, voffB);
            PG8_WAIT_V(6); PG8_BAR; PG8_MMA(1, 1, At, B1); PG8_BAR;
            PG8_LDB(B0, 1, 0); PG8_SCHED; PG8_LDA(At, 1, 0); PG8_STAGE(PG8_SA(0, 1), a2 + hstepA, voffA);
            PG8_WAIT_L(8); PG8_BAR; PG8_WAIT_L(0); PG8_MMA(0, 0, At, B0); PG8_BAR; PG8_SCHED;
            PG8_LDB(B1, 1, 1); PG8_STAGE(PG8_SB(1, 0), b3, voffB);
            PG8_BAR; PG8_WAIT_L(0); PG8_MMA(0, 1, At, B1); PG8_BAR;
            PG8_LDA(At, 1, 1); PG8_STAGE(PG8_SA(1, 0), a3, voffA);
            PG8_BAR; PG8_WAIT_L(0); PG8_MMA(1, 0, At, B0); PG8_BAR; PG8_SCHED;
            PG8_STAGE(PG8_SB(1, 1), b3 + hstepB, voffB);
            PG8_WAIT_V(6); PG8_BAR; PG8_MMA(1, 1, At, B1); PG8_BAR;
            }
        }
        if constexpr (ALIGN_EPI) { if (wr == 0) PG8_BAR; }
        if constexpr (!Epi::AFTER_DRAIN) { E(acc, cur, wr, wc, fr, fq); S.done(cur); }
        if (!has_next) break;
#pragma unroll
        for (int a = 0; a < 2; ++a)
#pragma unroll
            for (int b = 0; b < 2; ++b)
#pragma unroll
                for (int m = 0; m < 4; ++m)
#pragma unroll
                    for (int n = 0; n < 2; ++n) acc[a][b][m][n] = (f32x4){0.f, 0.f, 0.f, 0.f};
        cur = nxt; cA = nA; cB = nB; ++ui;
        if constexpr (ALIGN_EPI) { if (wr == 1) PG8_BAR; }
    }
    PG8_WAIT_V(0);
    if constexpr (!ALIGN_EPI) { if (wr == 0) PG8_BAR; }
    PG8_BAR;
    if constexpr (Epi::AFTER_DRAIN) { E.fused(acc, cur, wr, wc, fr, fq, lds, wid, lane); S.done(cur); }
#undef PG8_SA
#undef PG8_SB
#undef PG8_STAGE
#undef PG8_LDA
#undef PG8_LDB
#undef PG8_MMA
#undef PG8_WAIT_V
#undef PG8_WAIT_L
#undef PG8_BAR
#undef PG8_SCHED
}
}


namespace pg8 {
typedef unsigned u32x2 __attribute__((ext_vector_type(2)));
__device__ __forceinline__ unsigned cvt_pk_bf16(float lo, float hi) { unsigned r; asm volatile("v_cvt_pk_bf16_f32 %0, %1, %2" : "=v"(r) : "v"(lo), "v"(hi)); return r; }
__device__ __forceinline__ float sigm(float x) { return __builtin_amdgcn_rcpf(1.0f + __builtin_amdgcn_exp2f(-1.4426950408889634f * x)); }
__device__ __forceinline__ float bf_lo(unsigned w) { return __uint_as_float(w << 16); }
__device__ __forceinline__ float bf_hi(unsigned w) { return __uint_as_float(w & 0xffff0000u); }

struct PanelSched {
    int panel, n, skip_lo, skip_n, mode;
    __device__ __forceinline__ bool next(int i, Unit& u) const {
        if (i >= n) return false;
        if (mode == 0) { u.pm = panel; u.pn = i + (i >= skip_lo ? skip_n : 0); } else { u.pm = i; u.pn = panel; }
        return true;
    }
    __device__ __forceinline__ void a_ready(const Unit&) const {}
    __device__ __forceinline__ void done(const Unit&) const {}
};

struct EpiProj {
    static constexpr bool PERM = true, AFTER_DRAIN = false;
    bf16_t *PQ, *PK, *PU, *PG;
    __device__ __forceinline__ void operator()(const f32x4 (&acc)[2][2][4][2], const Unit& u, int wr, int wc, int fr, int fq) const {
        const int pn = u.pn; bf16_t* base; int ld, colt; bool sg = false;
        if (pn < 2) { base = PQ; ld = 512; colt = pn * 256; }
        else if (pn < 4) { base = PK; ld = 512; colt = (pn - 2) * 256; }
        else if (pn < 8) { base = PU; ld = 512; colt = (pn - 6) * 256; }
        else { base = PG; ld = 2048; colt = (pn - 8) * 256; sg = true; }
        const int row0 = u.pm * BM + wr * 64 + fr, col0 = colt + wc * 32 + 8 * fq;
#pragma unroll
        for (int ai = 0; ai < 2; ++ai)
#pragma unroll
            for (int m = 0; m < 4; ++m) { bf16_t* rowp = base + (size_t)(row0 + ai * HALF + m * 16) * ld + col0;
#pragma unroll
                for (int bj = 0; bj < 2; ++bj) { f32x4 v0 = acc[ai][bj][m][0], v1 = acc[ai][bj][m][1];
                    if (sg) { v0 = (f32x4){sigm(v0[0]), sigm(v0[1]), sigm(v0[2]), sigm(v0[3])}; v1 = (f32x4){sigm(v1[0]), sigm(v1[1]), sigm(v1[2]), sigm(v1[3])}; }
                    u32x4 w; w.x = cvt_pk_bf16(v0[0], v0[1]); w.y = cvt_pk_bf16(v0[2], v0[3]); w.z = cvt_pk_bf16(v1[0], v1[1]); w.w = cvt_pk_bf16(v1[2], v1[3]);
                    *(u32x4*)(rowp + bj * HALF) = w; } }
    }
};
struct EpiPlain {
    static constexpr bool PERM = true, AFTER_DRAIN = false;
    bf16_t* O; int ldc;
    __device__ __forceinline__ void operator()(const f32x4 (&acc)[2][2][4][2], const Unit& u, int wr, int wc, int fr, int fq) const {
        const int row0 = u.pm * BM + wr * 64 + fr, col0 = u.pn * BM + wc * 32 + 8 * fq;
#pragma unroll
        for (int ai = 0; ai < 2; ++ai)
#pragma unroll
            for (int m = 0; m < 4; ++m) { bf16_t* rowp = O + (size_t)(row0 + ai * HALF + m * 16) * ldc + col0;
#pragma unroll
                for (int bj = 0; bj < 2; ++bj) { const f32x4 v0 = acc[ai][bj][m][0], v1 = acc[ai][bj][m][1];
                    u32x4 w; w.x = cvt_pk_bf16(v0[0], v0[1]); w.y = cvt_pk_bf16(v0[2], v0[3]); w.z = cvt_pk_bf16(v1[0], v1[1]); w.w = cvt_pk_bf16(v1[2], v1[3]);
                    *(u32x4*)(rowp + bj * HALF) = w; } }
    }
};
struct EpiMergeChain {
    static constexpr bool PERM = true, AFTER_DRAIN = false;
    const bf16_t* G; bf16_t* MG;
    __device__ __forceinline__ void operator()(const f32x4 (&acc)[2][2][4][2], const Unit& u, int wr, int wc, int fr, int fq) const {
        const bool add = u.pn >= 4; const int goff = add ? 1024 : 0;
        const int row0 = u.pm * BM + wr * 64 + fr, col0 = (u.pn & 3) * BM + wc * 32 + 8 * fq;
        if (add) asm volatile("s_waitcnt vmcnt(0)" ::: "memory");
#pragma unroll
        for (int ai = 0; ai < 2; ++ai)
#pragma unroll
            for (int m = 0; m < 4; ++m) { const size_t row = (size_t)(row0 + ai * HALF + m * 16);
#pragma unroll
                for (int bj = 0; bj < 2; ++bj) { const f32x4 v0 = acc[ai][bj][m][0], v1 = acc[ai][bj][m][1];
                    const u32x4 gw = *(const u32x4*)(G + row * 2048 + goff + col0 + bj * HALF);
                    float r0 = bf_lo(gw.x) * v0[0], r1 = bf_hi(gw.x) * v0[1], r2 = bf_lo(gw.y) * v0[2], r3 = bf_hi(gw.y) * v0[3];
                    float r4 = bf_lo(gw.z) * v1[0], r5 = bf_hi(gw.z) * v1[1], r6 = bf_lo(gw.w) * v1[2], r7 = bf_hi(gw.w) * v1[3];
                    bf16_t* mp = MG + row * 1024 + col0 + bj * HALF;
                    if (add) { const u32x4 pw = *(const u32x4*)mp;
                        r0 += bf_lo(pw.x); r1 += bf_hi(pw.x); r2 += bf_lo(pw.y); r3 += bf_hi(pw.y); r4 += bf_lo(pw.z); r5 += bf_hi(pw.z); r6 += bf_lo(pw.w); r7 += bf_hi(pw.w); }
                    u32x4 w; w.x = cvt_pk_bf16(r0, r1); w.y = cvt_pk_bf16(r2, r3); w.z = cvt_pk_bf16(r4, r5); w.w = cvt_pk_bf16(r6, r7);
                    *(u32x4*)mp = w; }
                asm volatile("" ::: "memory"); }
    }
};
__device__ __forceinline__ void lds_addf(PG8_LAS float* p, float v) { __hip_atomic_fetch_add(p, v, __ATOMIC_RELAXED, __HIP_MEMORY_SCOPE_WORKGROUP); }
__device__ __forceinline__ float quad_row_sum(float s, int lane) {
    s += __builtin_bit_cast(float, __builtin_amdgcn_ds_bpermute((lane ^ 16) << 2, __builtin_bit_cast(int, s)));
    s += __builtin_bit_cast(float, __builtin_amdgcn_ds_bpermute((lane ^ 32) << 2, __builtin_bit_cast(int, s)));
    return s;
}
struct EpiRes {
    static constexpr bool PERM = true, AFTER_DRAIN = false;
    const float* X; bf16_t* OB; PG8_LAS float* ss;
    __device__ __forceinline__ void operator()(const f32x4 (&acc)[2][2][4][2], const Unit& u, int wr, int wc, int fr, int fq) const {
        asm volatile("" : "+v"(fr), "+v"(fq));
        const int col0 = u.pn * BM + wc * 32 + 8 * fq; const int lane = fq * 16 + fr;
#pragma unroll
        for (int ai = 0; ai < 2; ++ai)
#pragma unroll
            for (int m = 0; m < 4; ++m) { const int lr = ai * HALF + wr * 64 + m * 16 + fr; const size_t xoff = (size_t)(u.pm * BM + lr) * 1024 + col0; bf16_t* op = OB + ((size_t)(2 * u.pm) * BM + lr) * 1024 + col0;
                float s = 0.f;
#pragma unroll
                for (int bj = 0; bj < 2; ++bj) { const f32x4 x0 = *(const f32x4*)(X + xoff + bj * HALF), x1 = *(const f32x4*)(X + xoff + bj * HALF + 4);
                    const f32x4 v0 = x0 + acc[ai][bj][m][0], v1 = x1 + acc[ai][bj][m][1];
                    s += (v0[0] * v0[0] + v0[1] * v0[1]) + (v0[2] * v0[2] + v0[3] * v0[3]) + (v1[0] * v1[0] + v1[1] * v1[1]) + (v1[2] * v1[2] + v1[3] * v1[3]);
                    u32x4 w; w.x = cvt_pk_bf16(v0[0], v0[1]); w.y = cvt_pk_bf16(v0[2], v0[3]); w.z = cvt_pk_bf16(v1[0], v1[1]); w.w = cvt_pk_bf16(v1[2], v1[3]);
                    *(u32x4*)(op + bj * HALF) = w; }
                s = quad_row_sum(s, lane); if (fq == 0) lds_addf(ss + lr, s);
                asm volatile("" ::: "memory"); }
    }
};
struct EpiPlainScale {
    static constexpr bool PERM = true, AFTER_DRAIN = false;
    bf16_t* O; int ldc; PG8_LAS const float* rs;
    __device__ __forceinline__ void operator()(const f32x4 (&acc)[2][2][4][2], const Unit& u, int wr, int wc, int fr, int fq) const {
        asm volatile("" : "+v"(fr), "+v"(fq));
        const int col0 = u.pn * BM + wc * 32 + 8 * fq;
#pragma unroll
        for (int ai = 0; ai < 2; ++ai)
#pragma unroll
            for (int m = 0; m < 4; ++m) { const int lr = ai * HALF + wr * 64 + m * 16 + fr; const float r = rs[lr]; bf16_t* rowp = O + (size_t)(u.pm * BM + lr) * ldc + col0;
#pragma unroll
                for (int bj = 0; bj < 2; ++bj) { const f32x4 v0 = acc[ai][bj][m][0] * r, v1 = acc[ai][bj][m][1] * r;
                    u32x4 w; w.x = cvt_pk_bf16(v0[0], v0[1]); w.y = cvt_pk_bf16(v0[2], v0[3]); w.z = cvt_pk_bf16(v1[0], v1[1]); w.w = cvt_pk_bf16(v1[2], v1[3]);
                    *(u32x4*)(rowp + bj * HALF) = w; } }
    }
};
struct EpiGate {
    static constexpr bool PERM = false, AFTER_DRAIN = false;
    float* OUT; const bf16_t* X2; const bf16_t* E; PG8_LAS const float* rs; PG8_LAS float* ss;
    __device__ __forceinline__ void operator()(const f32x4 (&acc)[2][2][4][2], const Unit& u, int wr, int wc, int fr, int fq) const {
        asm volatile("" : "+v"(fr), "+v"(fq));
        const int col0 = u.pn * BM + wc * 32 + 4 * fq; const int lane = fq * 16 + fr;
#pragma unroll
        for (int ai = 0; ai < 2; ++ai)
#pragma unroll
            for (int m = 0; m < 4; ++m) { const int lr = ai * HALF + wr * 64 + m * 16 + fr; const float r = rs[lr];
                const size_t off = (size_t)(u.pm * BM + lr) * 1024 + col0, xo = ((size_t)(2 * u.pm) * BM + lr) * 1024 + col0; float s = 0.f;
#pragma unroll
                for (int bj = 0; bj < 2; ++bj)
#pragma unroll
                    for (int n = 0; n < 2; ++n) { const int co = bj * HALF + n * 16; const u32x2 xw = *(const u32x2*)(X2 + xo + co); const u32x2 ew = *(const u32x2*)(E + off + co); const f32x4 a = acc[ai][bj][m][n] * r;
                        f32x4 v; v[0] = bf_lo(xw.x) + sigm(a[0]) * bf_lo(ew.x); v[1] = bf_hi(xw.x) + sigm(a[1]) * bf_hi(ew.x); v[2] = bf_lo(xw.y) + sigm(a[2]) * bf_lo(ew.y); v[3] = bf_hi(xw.y) + sigm(a[3]) * bf_hi(ew.y);
                        s += (v[0] * v[0] + v[1] * v[1]) + (v[2] * v[2] + v[3] * v[3]);
                        *(f32x4*)(OUT + off + co) = v; }
                s = quad_row_sum(s, lane); if (fq == 0) lds_addf(ss + lr, s);
                asm volatile("" ::: "memory"); }
    }
};
}

#define GAS __attribute__((address_space(1)))
#define LAS __attribute__((address_space(3)))
typedef unsigned short bf16;
typedef unsigned v4u __attribute__((ext_vector_type(4)));
typedef float f32x4 __attribute__((ext_vector_type(4)));
typedef short bf16x8 __attribute__((ext_vector_type(8)));
typedef GAS unsigned gu32;
typedef GAS unsigned long long gu64;
#define RLX_AGENT __ATOMIC_RELAXED, __HIP_MEMORY_SCOPE_AGENT
#define LDS_WAIT() asm volatile("s_waitcnt lgkmcnt(0)" ::: "memory")
#define VM_WAIT() asm volatile("s_waitcnt vmcnt(0)" ::: "memory")
__device__ __forceinline__ unsigned long long rt() { return __builtin_amdgcn_s_memrealtime(); }
__device__ __forceinline__ unsigned f2bf(float f) { unsigned u = __builtin_bit_cast(unsigned, f); return (u + 0x7fffu + ((u >> 16) & 1u)) >> 16; }
__device__ __forceinline__ unsigned pk2(float lo, float hi) { return f2bf(lo) | (f2bf(hi) << 16); }

#define XB_TMO      128
#define XB_XCNT(j)  (256  + 64 * (j))
#define XB_XSUB(j)  (1280 + 64 * (j))
#define XB_XGEN(j)  (2304 + 64 * (j))
#define XB_TOP      3328
#define XB_TOPGEN   3392
#define XCD_BAR_WORDS 3456
#define XB_SPIN_CAP (1u << 18)

__device__ __forceinline__ unsigned xb_ld(unsigned* p)              { return __hip_atomic_load(p, __ATOMIC_RELAXED, __HIP_MEMORY_SCOPE_AGENT); }
__device__ __forceinline__ unsigned xb_add(unsigned* p, unsigned v) { return __hip_atomic_fetch_add(p, v, __ATOMIC_RELAXED, __HIP_MEMORY_SCOPE_AGENT); }
__device__ __forceinline__ unsigned xb_xcc_id() { return (unsigned)__builtin_amdgcn_s_getreg((3 << 11) | 20) & 0xFu; }
#define XB_SPIN(cond, bar) do { unsigned _sp = 0; while (cond) { __builtin_amdgcn_s_sleep(1); \
    if ((++_sp & 255u) == 0u) { if (xb_ld(&(bar)[XB_TMO])) break; if (_sp > XB_SPIN_CAP) { atomicAdd(&(bar)[XB_TMO], 1u); break; } } } } while (0)

struct XcdBarrier {
    unsigned* bar; unsigned x;
    volatile LAS unsigned* st;
};

__device__ __forceinline__ XcdBarrier xcd_barrier_post(unsigned* bar, volatile LAS unsigned* st, const bool is_t0) {
    XcdBarrier b; b.bar = bar; b.x = xb_xcc_id(); b.st = st;
    if (is_t0) (void)xb_add(&bar[XB_XCNT(b.x)], 1u);
    return b;
}
__device__ __forceinline__ void xcd_barrier_complete(unsigned* bar, unsigned x, unsigned& nloc, unsigned& nx) {
    const unsigned G = gridDim.x * gridDim.y * gridDim.z;
    unsigned sum, cnt, mine, sp = 0u;
    for (;;) {
        sum = 0u; cnt = 0u; mine = 0u;
#pragma unroll
        for (unsigned j = 0; j < 16; ++j) { const unsigned c = xb_ld(&bar[XB_XCNT(j)]); sum += c; cnt += (c > 0u) ? 1u : 0u; mine = (j == x) ? c : mine; }
        if (sum == G) break;
        __builtin_amdgcn_s_sleep(1);
        if ((++sp & 255u) == 0u) { if (xb_ld(&bar[XB_TMO])) break; if (sp > XB_SPIN_CAP) { atomicAdd(&bar[XB_TMO], 1u); break; } }
    }
    nloc = mine > 0u ? mine : 1u; nx = cnt > 0u ? cnt : 1u;
}

__device__ __forceinline__ void xcd_barrier(const XcdBarrier& b, const bool is_t0) {
    asm volatile("s_waitcnt vmcnt(0)" ::: "memory");
    __syncthreads();
    if (is_t0) {
        unsigned* bar = b.bar;
        __builtin_amdgcn_s_waitcnt(0);
        unsigned nloc = b.st[0], nx = b.st[1];
        if (nloc == 0u) { xcd_barrier_complete(bar, b.x, nloc, nx); b.st[0] = nloc; b.st[1] = nx; }
        const unsigned old = xb_add(&bar[XB_XSUB(b.x)], 1u);
        const unsigned gen = old / nloc;
        if (old + 1u == (gen + 1u) * nloc) {
            __builtin_amdgcn_fence(__ATOMIC_RELEASE, "agent");
            asm volatile("s_waitcnt vmcnt(0)" ::: "memory");
            const unsigned og = xb_add(&bar[XB_TOP], 1u);
            const unsigned tg = og / nx;
            if (og + 1u == (tg + 1u) * nx) xb_add(&bar[XB_TOPGEN], 1u);
            else XB_SPIN(xb_ld(&bar[XB_TOPGEN]) == tg, bar);
            __builtin_amdgcn_fence(__ATOMIC_ACQUIRE, "agent");
            xb_add(&bar[XB_XGEN(b.x)], 1u);
            asm volatile("s_waitcnt vmcnt(0)" ::: "memory");
        } else {
            XB_SPIN(xb_ld(&bar[XB_XGEN(b.x)]) == gen, bar);
            __builtin_amdgcn_fence(__ATOMIC_ACQUIRE, "agent");
            asm volatile("s_waitcnt vmcnt(0)" ::: "memory");
        }
    }
    __syncthreads();
}


constexpr int NWAVES = 8, NTHR = 512;
constexpr int TOK = 65536, DM = 1024, SEQ = 8192, NPANEL = 256;
constexpr float RMS_EPS = 1e-6f;
constexpr float C2 = 0.125f * 1.4426950408889634f;
constexpr float SURV_THR = 5.4210108624275222e-20f;
constexpr size_t MiB = 1u << 20;
constexpr size_t WS_CTL = 0, CTL_ZERO_BYTES = 64 * 1024;
constexpr size_t WS_WIN = 2 * MiB, WS_WOUT = 10 * MiB, WS_WQ = 12 * MiB, WS_WPG = 16 * MiB, WS_WPLE = 18 * MiB;
constexpr size_t WS_BDA = 18 * MiB + 512 * 1024, WS_BDP = 18 * MiB + 768 * 1024, WS_SK = 19 * MiB;
constexpr size_t WS_EU = 32 * MiB, WS_EV = 64 * MiB, WS_SU = 20 * MiB, WS_SV = 20 * MiB + 65536;
constexpr size_t WS_XN = 96 * MiB;
constexpr size_t WS_PQ = 224 * MiB, WS_PK = 288 * MiB, WS_PVT = 352 * MiB, WS_PU = 416 * MiB;
constexpr size_t WS_PG = 480 * MiB;
constexpr size_t WS_YA = 736 * MiB, WS_YP = 800 * MiB;
constexpr size_t WS_MG = 864 * MiB, WS_END = 992 * MiB;
constexpr int CW_BAR = 1024;
constexpr int RING_BYTES = 131072, LDSCTL_OFF = RING_BYTES, MISC_OFF = LDSCTL_OFF + 320, LDS_BYTES = 147456;

typedef float f32x16 __attribute__((ext_vector_type(16)));
typedef float f32x2 __attribute__((ext_vector_type(2)));
typedef __bf16 bf16x2v __attribute__((ext_vector_type(2)));

__device__ __forceinline__ int shx(int v, int m, int lane) { return __builtin_amdgcn_ds_bpermute((lane ^ m) << 2, v); }
__device__ __forceinline__ float shx(float v, int m, int lane) { return __builtin_bit_cast(float, __builtin_amdgcn_ds_bpermute((lane ^ m) << 2, __builtin_bit_cast(int, v))); }
__device__ __forceinline__ float shl_(float v, int src) { return __builtin_bit_cast(float, __builtin_amdgcn_ds_bpermute(src << 2, __builtin_bit_cast(int, v))); }
__device__ __forceinline__ float wave_sum(float v, int lane) {
#pragma unroll
    for (int o = 1; o < 64; o <<= 1) v += shx(v, o, lane);
    return v;
}
__device__ __forceinline__ float bflo(unsigned w) { return __uint_as_float(w << 16); }
__device__ __forceinline__ float bfhi(unsigned w) { return __uint_as_float(w & 0xffff0000u); }
__device__ __forceinline__ unsigned cvtpk(float lo, float hi) { return pg8::cvt_pk_bf16(lo, hi); }

#define H_UNPACK(H, A, B) do { H[0] = bflo(A.x); H[1] = bfhi(A.x); H[2] = bflo(A.y); H[3] = bfhi(A.y); H[4] = bflo(A.z); H[5] = bfhi(A.z); H[6] = bflo(A.w); H[7] = bfhi(A.w); \
        H[8] = bflo(B.x); H[9] = bfhi(B.x); H[10] = bflo(B.y); H[11] = bfhi(B.y); H[12] = bflo(B.z); H[13] = bfhi(B.z); H[14] = bflo(B.w); H[15] = bfhi(B.w); } while (0)
__device__ __forceinline__ void p0_transpose_item(const float* W, int K, int N, bf16* WT, const float* kscale, int nlo, float nls, LAS float* scr, int item, int lane) {
    const int nblk = N / 32, kb = item / nblk, nb = item % nblk, k0 = 64 * kb, n0 = 32 * nb;
    const float ns = (n0 + (lane & 31)) < nlo ? nls : 1.0f;
#pragma unroll 8
    for (int i = 0; i < 32; ++i) { const int kk = 2 * i + (lane >> 5); float v = W[(size_t)(k0 + kk) * N + n0 + (lane & 31)] * ns; if (kscale) v *= kscale[k0 + kk]; scr[kk * 33 + (lane & 31)] = v; }
    LDS_WAIT(); asm volatile("" ::: "memory");
    const int c = lane & 7;
#pragma unroll
    for (int j = 0; j < 4; ++j) { const int n = (lane >> 3) + 8 * j; const LAS float* s = scr + (8 * c) * 33 + n;
        v4u o; o.x = pk2(s[0 * 33], s[1 * 33]); o.y = pk2(s[2 * 33], s[3 * 33]); o.z = pk2(s[4 * 33], s[5 * 33]); o.w = pk2(s[6 * 33], s[7 * 33]);
        *(GAS v4u*)(WT + (size_t)(n0 + n) * K + k0 + 8 * c) = o; }
    LDS_WAIT(); asm volatile("" ::: "memory");
}
__device__ __forceinline__ void rms_row_to_bf16(const float* xrow, bf16* orow, int lane) {
    const GAS f32x4* xr = (const GAS f32x4*)xrow + lane;
    f32x4 v[4]; float s = 0.f;
#pragma unroll
    for (int j = 0; j < 4; ++j) { v[j] = xr[64 * j]; s += (v[j].x * v[j].x + v[j].y * v[j].y) + (v[j].z * v[j].z + v[j].w * v[j].w); }
    const float r = 1.f / sqrtf(wave_sum(s, lane) * (1.f / DM) + RMS_EPS);
    GAS unsigned long long* o8 = (GAS unsigned long long*)orow + lane;
#pragma unroll
    for (int j = 0; j < 4; ++j) o8[64 * j] = (unsigned long long)pk2(v[j].x * r, v[j].y * r) | ((unsigned long long)pk2(v[j].z * r, v[j].w * r) << 32);
}
__device__ __forceinline__ void cvt8_store(const float* src, bf16* dst) {
    const f32x4 a = *(const GAS f32x4*)src, b = *(const GAS f32x4*)(src + 4);
    v4u o; o.x = pk2(a.x, a.y); o.y = pk2(a.z, a.w); o.z = pk2(b.x, b.y); o.w = pk2(b.z, b.w);
    *(GAS v4u*)dst = o;
}

__device__ __forceinline__ void attn_panel(int panel, const bf16* PQ, const bf16* PK, const bf16* PVT, bf16* YA, const int wid0) {
    const int tid = otid(wid0), lane = tid & 63, wid = __builtin_amdgcn_readfirstlane(tid >> 6);
    const int r32 = lane & 31, hh = lane >> 5;
    const size_t seq0 = (size_t)(panel >> 5) * SEQ;
    const int pos0 = (panel & 31) * 256 + wid * 32;
    const int kap = 16 * ((r32 >> 2) & 1) + (r32 & 3) + 4 * (r32 >> 3);
    for (int h = 0; h < 8; ++h) {
        bf16x8 qf[4];
        { const bf16* qrow = PQ + (seq0 + pos0 + r32) * 512 + h * 64 + 8 * hh;
#pragma unroll
          for (int s = 0; s < 4; ++s) qf[s] = *(const GAS bf16x8*)(qrow + 16 * s); }
        f32x16 o0 = {}, o1 = {};
        float Sin = 1.f;
        for (int kb = pos0; kb >= 0; kb -= 32) {
            const bf16* krow = PK + (seq0 + kb + kap) * 512 + h * 64 + 8 * hh;
            const bf16* vrow = PVT + (size_t)(h * 64 + kap) * TOK + seq0 + kb + 16 * hh;
            bf16x8 kf[4], vf[2][2];
#pragma unroll
            for (int s = 0; s < 4; ++s) kf[s] = *(const GAS bf16x8*)(krow + 16 * s);
#pragma unroll
            for (int db = 0; db < 2; ++db)
#pragma unroll
                for (int s = 0; s < 2; ++s) vf[db][s] = *(const GAS bf16x8*)(vrow + (size_t)db * 32 * TOK + 8 * s);
            f32x16 z = {};
#pragma unroll
            for (int s = 0; s < 4; ++s) z = __builtin_amdgcn_mfma_f32_32x32x16_bf16(kf[s], qf[s], z, 0, 0, 0);
            const bool diag = (kb == pos0);
            float w[16]; float Sl = 1.f;
#pragma unroll
            for (int reg = 15; reg >= 0; --reg) {
                float beta = __builtin_amdgcn_rcpf(1.0f + __builtin_amdgcn_exp2f(-z[reg]));
                if (diag && (16 * hh + reg >= r32)) beta = 0.f;
                const float wl = beta * Sl; Sl -= wl; w[reg] = wl;
            }
            const float Pp = shx(Sl, 32, lane);
            const float scale = hh ? Sin : Sin * Pp;
            Sin = Sin * Sl * Pp;
            v4u pw0, pw1;
            pw0.x = cvtpk(w[0] * scale, w[1] * scale); pw0.y = cvtpk(w[2] * scale, w[3] * scale); pw0.z = cvtpk(w[4] * scale, w[5] * scale); pw0.w = cvtpk(w[6] * scale, w[7] * scale);
            pw1.x = cvtpk(w[8] * scale, w[9] * scale); pw1.y = cvtpk(w[10] * scale, w[11] * scale); pw1.z = cvtpk(w[12] * scale, w[13] * scale); pw1.w = cvtpk(w[14] * scale, w[15] * scale);
            const bf16x8 p0 = __builtin_bit_cast(bf16x8, pw0), p1 = __builtin_bit_cast(bf16x8, pw1);
            o0 = __builtin_amdgcn_mfma_f32_32x32x16_bf16(vf[0][0], p0, o0, 0, 0, 0);
            o0 = __builtin_amdgcn_mfma_f32_32x32x16_bf16(vf[0][1], p1, o0, 0, 0, 0);
            o1 = __builtin_amdgcn_mfma_f32_32x32x16_bf16(vf[1][0], p0, o1, 0, 0, 0);
            o1 = __builtin_amdgcn_mfma_f32_32x32x16_bf16(vf[1][1], p1, o1, 0, 0, 0);
            if (__all(Sin < SURV_THR)) break;
        }
        bf16* orow = YA + (seq0 + pos0 + r32) * 512 + h * 64 + 16 * hh;
        v4u a, b2;
        a.x = cvtpk(o0[0], o0[1]); a.y = cvtpk(o0[2], o0[3]); a.z = cvtpk(o0[4], o0[5]); a.w = cvtpk(o0[6], o0[7]);
        b2.x = cvtpk(o0[8], o0[9]); b2.y = cvtpk(o0[10], o0[11]); b2.z = cvtpk(o0[12], o0[13]); b2.w = cvtpk(o0[14], o0[15]);
        *(GAS v4u*)orow = a; *(GAS v4u*)(orow + 8) = b2;
        a.x = cvtpk(o1[0], o1[1]); a.y = cvtpk(o1[2], o1[3]); a.z = cvtpk(o1[4], o1[5]); a.w = cvtpk(o1[6], o1[7]);
        b2.x = cvtpk(o1[8], o1[9]); b2.y = cvtpk(o1[10], o1[11]); b2.z = cvtpk(o1[12], o1[13]); b2.w = cvtpk(o1[14], o1[15]);
        *(GAS v4u*)(orow + 32) = a; *(GAS v4u*)(orow + 40) = b2;
    }
}

__device__ __forceinline__ void pool_panel(int panel, const bf16* PU, bf16* YP, const int wid0) {
    const int tid = otid(wid0);
    const int chunk = tid & 63, tg = tid >> 6, w = 2 << (chunk >> 4);
    const int posb = (panel & 31) * 256; const size_t row0 = (size_t)panel * 256;
    for (int i = 0; i < 32; ++i) {
        const int t = tg * 32 + i, pos = posb + t, cnt = (pos + 1 < w) ? (pos + 1) : w;
        float s[8];
#pragma unroll
        for (int k = 0; k < 8; ++k) s[k] = 0.f;
        v4u cur = {0u, 0u, 0u, 0u};
        for (int j = 0; j < cnt; ++j) {
            const v4u v = *(const GAS v4u*)(PU + (row0 + t - j) * 512 + chunk * 8);
            if (j == 0) cur = v;
            s[0] += bflo(v.x); s[1] += bfhi(v.x); s[2] += bflo(v.y); s[3] += bfhi(v.y); s[4] += bflo(v.z); s[5] += bfhi(v.z); s[6] += bflo(v.w); s[7] += bfhi(v.w);
        }
        const float ic = 1.0f / (float)cnt;
        v4u o;
        o.x = cvtpk(s[0] * ic - bflo(cur.x), s[1] * ic - bfhi(cur.x)); o.y = cvtpk(s[2] * ic - bflo(cur.y), s[3] * ic - bfhi(cur.y));
        o.z = cvtpk(s[4] * ic - bflo(cur.z), s[5] * ic - bfhi(cur.z)); o.w = cvtpk(s[6] * ic - bflo(cur.w), s[7] * ic - bfhi(cur.w));
        *(GAS v4u*)(YP + (row0 + t) * 512 + chunk * 8) = o;
    }
}

#define HD __host__ __device__ __forceinline__
HD int f2s(float f) { int i = __builtin_bit_cast(int, f); return i ^ ((i >> 31) & 0x7fffffff); }
HD float s2f(int i) { i ^= ((i >> 31) & 0x7fffffff); return __builtin_bit_cast(float, i); }
HD void ce_desc(int& a, int& b) { const int mx = a > b ? a : b, mn = a > b ? b : a; a = mx; b = mn; }
template <int J, int K> HD void bpass16(int (&v)[16]) {
#pragma unroll
    for (int i = 0; i < 16; ++i) { const int l = i ^ J; if (l > i) { if ((i & K) == 0) ce_desc(v[i], v[l]); else ce_desc(v[l], v[i]); } }
}
HD void bitonic_sort16_desc(int (&v)[16]) {
    bpass16<1, 2>(v); bpass16<2, 4>(v); bpass16<1, 4>(v); bpass16<4, 8>(v); bpass16<2, 8>(v); bpass16<1, 8>(v);
    bpass16<8, 16>(v); bpass16<4, 16>(v); bpass16<2, 16>(v); bpass16<1, 16>(v);
}
HD void bitonic_merge16_desc(int (&v)[16]) {
    bpass16<8, 16>(v); bpass16<4, 16>(v); bpass16<2, 16>(v); bpass16<1, 16>(v);
}
HD void merge_prune16(int (&x)[16], const int (&y)[16]) {
#pragma unroll
    for (int i = 0; i < 16; ++i) x[i] = x[i] > y[15 - i] ? x[i] : y[15 - i];
    bitonic_merge16_desc(x);
}
HD int cx_i(int hf, int t) { if (hf == 0) return 0; return t < 5 ? 2 : t < 9 ? 3 : t < 12 ? 4 : t < 14 ? 5 : 6; }
HD int cx_j(int hf, int t) { if (hf == 0) return t; return t < 5 ? t : t < 9 ? t - 5 : t < 12 ? t - 9 : t < 14 ? t - 12 : t - 14; }
HD int cy_i(int hf, int t) { if (hf == 0) return t < 8 ? 1 : 23 - t; return 7; }
HD int cy_j(int hf, int t) { if (hf == 0) return t < 8 ? t : 0; return t; }

__device__ __forceinline__ void top16_of_group(const bf16x8 (&qf)[8], LAS const unsigned char* skl, int r32, int hh, int lane, int (&res)[16]) {
    int v[4][16];
#pragma unroll
    for (int kb = 0; kb < 4; ++kb) {
        f32x16 acc = {};
#pragma unroll
        for (int s = 0; s < 8; ++s) { const bf16x8 af = *(LAS const bf16x8*)(skl + (32 * kb + r32) * 272 + 32 * s + 16 * hh); acc = __builtin_amdgcn_mfma_f32_32x32x16_bf16(af, qf[s], acc, 0, 0, 0); }
#pragma unroll
        for (int reg = 0; reg < 16; ++reg) { const int keyid = 32 * kb + (reg & 3) + 8 * (reg >> 2) + 4 * hh; v[kb][reg] = (f2s(acc[reg]) & ~127) | keyid; }
    }
    bitonic_sort16_desc(v[0]); bitonic_sort16_desc(v[1]); bitonic_sort16_desc(v[2]); bitonic_sort16_desc(v[3]);
    merge_prune16(v[0], v[1]); merge_prune16(v[2], v[3]); merge_prune16(v[0], v[2]);
    int y[16];
#pragma unroll
    for (int i = 0; i < 16; ++i) y[i] = shx(v[0][i], 32, lane);
    merge_prune16(v[0], y);
#pragma unroll
    for (int i = 0; i < 16; ++i) res[i] = v[0][i];
}

__device__ __forceinline__ void topk_panel(int panel, const bf16* QP, const bf16* SK, int* IDXp, float* GTp  , LAS unsigned char* ldsb  , const int wid0) {
    const int tid = otid(wid0), lane = tid & 63, wid = __builtin_amdgcn_readfirstlane(tid >> 6);
    const int r32 = lane & 31, hh = lane >> 5;
    const int lrow = wid * 32 + r32;
    const size_t row = (size_t)panel * 256 + lrow;
    LAS int* lut = (LAS int*)ldsb; LAS unsigned char* skl = ldsb + 65536;
    v4u skr[4];
#define SK_FETCH(g_) do { _Pragma("unroll") for (int i = 0; i < 4; ++i) skr[i] = *((const GAS v4u*)(SK + (size_t)(g_) * 128 * 128) + i * 512 + tid); } while (0)
#define SK_STAGE() do { _Pragma("unroll") for (int i = 0; i < 4; ++i) { const int p = i * 512 + tid; *(LAS v4u*)(skl + (p >> 4) * 272 + (p & 15) * 16) = skr[i]; } } while (0)
    bf16x8 qn[8];
#define Q_FETCH(g_) do { const bf16* qrow_ = QP + row * 2048 + (g_) * 128 + 8 * hh; _Pragma("unroll") for (int s = 0; s < 8; ++s) qn[s] = *(const GAS bf16x8*)(qrow_ + 16 * s); } while (0)
    SK_FETCH(0); Q_FETCH(0);
    for (int h = 0; h < 8; ++h) {
        int a[16], b[16];
#pragma unroll
        for (int c = 0; c < 2; ++c) {
            const int g = 2 * h + c;
            bf16x8 qf[8];
#pragma unroll
            for (int s = 0; s < 8; ++s) qf[s] = qn[s];
            __syncthreads();
            SK_STAGE();
            __syncthreads();
            if (g < 15) { SK_FETCH(g + 1); Q_FETCH(g + 1); }
            if (c == 0) top16_of_group(qf, skl, r32, hh, lane, a); else top16_of_group(qf, skl, r32, hh, lane, b);
        }
        float fa[16], fb[16];
#pragma unroll
        for (int i = 0; i < 16; ++i) { fa[i] = s2f(a[i] & ~127); fb[i] = s2f(b[i] & ~127); lut[i * 512 + tid] = a[i] & 127; lut[(16 + i) * 512 + tid] = b[i] & 127; }
        int X[16], Y[16];
#pragma unroll
        for (int t = 0; t < 16; ++t) {
            const float s0 = fa[cx_i(0, t)] + fb[cx_j(0, t)], s1 = fa[cx_i(1, t)] + fb[cx_j(1, t)];
            const int c0 = cx_i(0, t) * 16 + cx_j(0, t), c1 = cx_i(1, t) * 16 + cx_j(1, t);
            X[t] = hh ? ((f2s(s1) & ~255) | c1) : ((f2s(s0) & ~255) | c0);
            const float u0 = fa[cy_i(0, t)] + fb[cy_j(0, t)];
            const int d0 = cy_i(0, t) * 16 + cy_j(0, t);
            int y1 = (int)0x80000000;
            if (t < 2) { const float u1 = fa[cy_i(1, t)] + fb[cy_j(1, t)]; y1 = (f2s(u1) & ~255) | (cy_i(1, t) * 16 + cy_j(1, t)); }
            Y[t] = hh ? y1 : ((f2s(u0) & ~255) | d0);
        }
        bitonic_sort16_desc(X); bitonic_merge16_desc(Y); merge_prune16(X, Y);
#pragma unroll
        for (int i = 0; i < 16; ++i) Y[i] = shx(X[i], 32, lane);
        merge_prune16(X, Y);
        const float mx = s2f(X[0] & ~255);
        float ex[16], den = 0.f;
#pragma unroll
        for (int i = 0; i < 16; ++i) { ex[i] = __builtin_amdgcn_exp2f((s2f(X[i] & ~255) - mx) * 1.4426950408889634f); den += ex[i]; }
        const float rden = 1.0f / den;
        int oi[8]; float og[8];
#pragma unroll
        for (int t = 0; t < 8; ++t) {
            const int msk = -hh;
            const int code = (X[t] ^ ((X[t] ^ X[8 + t]) & msk)) & 255;
            const int e1 = lut[(code >> 4) * 512 + tid], e2 = lut[(16 + (code & 15)) * 512 + tid];
            const int exl = __builtin_bit_cast(int, ex[t]), exh = __builtin_bit_cast(int, ex[8 + t]);
            oi[t] = e1 * 128 + e2; og[t] = __builtin_bit_cast(float, exl ^ ((exl ^ exh) & msk)) * rden;
        }
        int* ip = IDXp + lrow * 128 + h * 16 + 8 * hh; float* gp = GTp + lrow * 128 + h * 16 + 8 * hh;
        *(GAS v4u*)ip = (v4u){(unsigned)oi[0], (unsigned)oi[1], (unsigned)oi[2], (unsigned)oi[3]}; *(GAS v4u*)(ip + 4) = (v4u){(unsigned)oi[4], (unsigned)oi[5], (unsigned)oi[6], (unsigned)oi[7]};
        *(GAS f32x4*)gp = (f32x4){og[0], og[1], og[2], og[3]}; *(GAS f32x4*)(gp + 4) = (f32x4){og[4], og[5], og[6], og[7]};
    }
#undef SK_FETCH
#undef SK_STAGE
#undef Q_FETCH
}

typedef float f32x2v __attribute__((ext_vector_type(2)));
__device__ __forceinline__ void quant_row_fp8(const float* src, const float* colgain, unsigned char* dst, float* sc_out, int lane) {
    const GAS f32x4* s = (const GAS f32x4*)src + 4 * lane;
    f32x4 v[4]; float m = 0.f;
#pragma unroll
    for (int j = 0; j < 4; ++j) { v[j] = s[j]; if (colgain) v[j] = v[j] * ((const GAS f32x4*)colgain + 4 * lane)[j]; m = fmaxf(m, fmaxf(fmaxf(fabsf(v[j].x), fabsf(v[j].y)), fmaxf(fabsf(v[j].z), fabsf(v[j].w)))); }
#pragma unroll
    for (int o = 1; o < 64; o <<= 1) m = fmaxf(m, shx(m, o, lane));
    const float sc = m > 0.f ? 224.0f / m : 1.0f;
    v4u w;
    { int t = 0; t = __builtin_amdgcn_cvt_pk_fp8_f32(v[0].x * sc, v[0].y * sc, t, false); t = __builtin_amdgcn_cvt_pk_fp8_f32(v[0].z * sc, v[0].w * sc, t, true); w.x = (unsigned)t; }
    { int t = 0; t = __builtin_amdgcn_cvt_pk_fp8_f32(v[1].x * sc, v[1].y * sc, t, false); t = __builtin_amdgcn_cvt_pk_fp8_f32(v[1].z * sc, v[1].w * sc, t, true); w.y = (unsigned)t; }
    { int t = 0; t = __builtin_amdgcn_cvt_pk_fp8_f32(v[2].x * sc, v[2].y * sc, t, false); t = __builtin_amdgcn_cvt_pk_fp8_f32(v[2].z * sc, v[2].w * sc, t, true); w.z = (unsigned)t; }
    { int t = 0; t = __builtin_amdgcn_cvt_pk_fp8_f32(v[3].x * sc, v[3].y * sc, t, false); t = __builtin_amdgcn_cvt_pk_fp8_f32(v[3].z * sc, v[3].w * sc, t, true); w.w = (unsigned)t; }
    *(GAS v4u*)(dst + 16 * lane) = w;
    if (lane == 0) *sc_out = m > 0.f ? m * (1.0f / 224.0f) : 1.0f;
}
__device__ __forceinline__ void dq4(unsigned w, float (&f)[4]) {
    const f32x2v lo = __builtin_amdgcn_cvt_pk_f32_fp8((int)w, false), hi = __builtin_amdgcn_cvt_pk_f32_fp8((int)w, true);
    f[0] = lo.x; f[1] = lo.y; f[2] = hi.x; f[3] = hi.y;
}
__device__ __forceinline__ float dot16_fp8(const v4u u, const float (&h)[16]) {
    const f32x2v x0 = __builtin_amdgcn_cvt_pk_f32_fp8((int)u.x, false), x1 = __builtin_amdgcn_cvt_pk_f32_fp8((int)u.x, true);
    const f32x2v y0 = __builtin_amdgcn_cvt_pk_f32_fp8((int)u.y, false), y1 = __builtin_amdgcn_cvt_pk_f32_fp8((int)u.y, true);
    const f32x2v z0 = __builtin_amdgcn_cvt_pk_f32_fp8((int)u.z, false), z1 = __builtin_amdgcn_cvt_pk_f32_fp8((int)u.z, true);
    const f32x2v w0 = __builtin_amdgcn_cvt_pk_f32_fp8((int)u.w, false), w1 = __builtin_amdgcn_cvt_pk_f32_fp8((int)u.w, true);
    f32x2v a = x0 * (f32x2v){h[0], h[1]}, b = x1 * (f32x2v){h[2], h[3]};
    a = __builtin_elementwise_fma(y0, (f32x2v){h[4], h[5]}, a); b = __builtin_elementwise_fma(y1, (f32x2v){h[6], h[7]}, b);
    a = __builtin_elementwise_fma(z0, (f32x2v){h[8], h[9]}, a); b = __builtin_elementwise_fma(z1, (f32x2v){h[10], h[11]}, b);
    a = __builtin_elementwise_fma(w0, (f32x2v){h[12], h[13]}, a); b = __builtin_elementwise_fma(w1, (f32x2v){h[14], h[15]}, b);
    const f32x2v s = a + b;
    return s.x + s.y;
}
__device__ __forceinline__ void fma16_fp8(float (&o)[16], float cf, const v4u v) {
    float f0[4], f1[4], f2[4], f3[4]; dq4(v.x, f0); dq4(v.y, f1); dq4(v.z, f2); dq4(v.w, f3);
#pragma unroll
    for (int k = 0; k < 4; ++k) { o[k] = fmaf(cf, f0[k], o[k]); o[4 + k] = fmaf(cf, f1[k], o[4 + k]); o[8 + k] = fmaf(cf, f2[k], o[8 + k]); o[12 + k] = fmaf(cf, f3[k], o[12 + k]); }
}
#define RS_LEVEL(v, n, m) do { _Pragma("unroll") for (int _e = 0; _e < (n); ++_e) { const bool _up = (lane & (m)) != 0; const float _send = _up ? v[_e] : v[_e + (n)]; const float _keep = _up ? v[_e + (n)] : v[_e]; v[_e] = _keep + shx(_send, m, lane); } } while (0)
__device__ __forceinline__ void peer_panel(int panel, bf16* XN, const int* IDXp, const float* GTp, const unsigned char* EU8, const unsigned char* EV8, const float* SU, const float* SV, float* XIO, const int wid0) {
    const int tid = otid(wid0), lane = tid & 63, wid = __builtin_amdgcn_readfirstlane(tid >> 6);
    for (int ti = 0; ti < 32; ++ti) {
        const int lrow = wid * 32 + ti;
        const size_t row = (size_t)panel * 256 + lrow;
        const int i0 = IDXp[lrow * 128 + lane], i1 = IDXp[lrow * 128 + 64 + lane];
        const float g0 = GTp[lrow * 128 + lane], g1 = GTp[lrow * 128 + 64 + lane];
        const float su0 = SU[i0], su1 = SU[i1], sv0 = SV[i0], sv1 = SV[i1];
        float h[16];
        { const v4u hA = *(const GAS v4u*)(XN + row * DM + 16 * lane), hB = *(const GAS v4u*)(XN + row * DM + 16 * lane + 8);
          h[0] = bflo(hA.x); h[1] = bfhi(hA.x); h[2] = bflo(hA.y); h[3] = bfhi(hA.y); h[4] = bflo(hA.z); h[5] = bfhi(hA.z); h[6] = bflo(hA.w); h[7] = bfhi(hA.w);
          h[8] = bflo(hB.x); h[9] = bfhi(hB.x); h[10] = bflo(hB.y); h[11] = bfhi(hB.y); h[12] = bflo(hB.z); h[13] = bfhi(hB.z); h[14] = bflo(hB.w); h[15] = bfhi(hB.w); }
        float coef[2];
#pragma unroll
        for (int hf = 0; hf < 2; ++hf) {
            const int iv = hf ? i1 : i0;
            float q[4];
#pragma unroll
            for (int k = 0; k < 4; ++k) q[k] = 0.f;
#pragma unroll
            for (int c = 0; c < 4; ++c) {
                v4u ua[16];
#pragma unroll
                for (int j = 0; j < 16; ++j) { const int ex = __builtin_amdgcn_readlane(iv, c * 16 + j); ua[j] = *((const GAS v4u*)(EU8 + (size_t)ex * DM) + lane); }
                float p[16];
#pragma unroll
                for (int j = 0; j < 16; ++j) p[j] = dot16_fp8(ua[j], h);
                RS_LEVEL(p, 8, 8); RS_LEVEL(p, 4, 4); RS_LEVEL(p, 2, 2); RS_LEVEL(p, 1, 1);
                q[c] = p[0];
            }
            RS_LEVEL(q, 2, 32); RS_LEVEL(q, 1, 16);
            const float s = q[0] * (hf ? su1 : su0);
            const float act = 0.5f * s * (1.0f + erff(s * 0.70710678118654752f));
            coef[hf] = (hf ? g1 : g0) * act * (hf ? sv1 : sv0);
        }
        float o[16];
        { const GAS f32x4* xp = (const GAS f32x4*)(XIO + row * DM + 16 * lane);
#pragma unroll
          for (int k = 0; k < 4; ++k) { const f32x4 x = xp[k]; o[4 * k] = x.x; o[4 * k + 1] = x.y; o[4 * k + 2] = x.z; o[4 * k + 3] = x.w; } }
#pragma unroll
        for (int hf = 0; hf < 2; ++hf) {
            const int iv = hf ? i1 : i0; const float cv = coef[hf];
#pragma unroll
            for (int c = 0; c < 4; ++c) {
                v4u va[16];
#pragma unroll
                for (int j = 0; j < 16; ++j) { const int ex = __builtin_amdgcn_readlane(iv, c * 16 + j); va[j] = *((const GAS v4u*)(EV8 + (size_t)ex * DM) + lane); }
#pragma unroll
                for (int j = 0; j < 16; ++j) { const float cf = __builtin_bit_cast(float, __builtin_amdgcn_readlane(__builtin_bit_cast(int, cv), c * 16 + j)); fma16_fp8(o, cf, va[j]); }
            }
        }
        float ss = 0.f;
#pragma unroll
        for (int k = 0; k < 16; ++k) ss += o[k] * o[k];
        const float r = 1.f / sqrtf(wave_sum(ss, lane) * (1.f / DM) + RMS_EPS);
        { GAS f32x4* xp = (GAS f32x4*)(XIO + row * DM + 16 * lane);
#pragma unroll
          for (int k = 0; k < 4; ++k) xp[k] = (f32x4){o[4 * k], o[4 * k + 1], o[4 * k + 2], o[4 * k + 3]}; }
        v4u ha, hb;
        ha.x = cvtpk(o[0] * r, o[1] * r); ha.y = cvtpk(o[2] * r, o[3] * r); ha.z = cvtpk(o[4] * r, o[5] * r); ha.w = cvtpk(o[6] * r, o[7] * r);
        hb.x = cvtpk(o[8] * r, o[9] * r); hb.y = cvtpk(o[10] * r, o[11] * r); hb.z = cvtpk(o[12] * r, o[13] * r); hb.w = cvtpk(o[14] * r, o[15] * r);
        *(GAS v4u*)(XN + row * DM + 16 * lane) = ha; *(GAS v4u*)(XN + row * DM + 16 * lane + 8) = hb;
    }
}

#define BS_STAGE(K, J) do { const bool lower_ = (lane & (J)) == 0; \
    { const int p_ = shx(k0, J, lane); const bool asc_ = ((lane & (K)) == 0); const int mn_ = k0 < p_ ? k0 : p_, mx_ = k0 < p_ ? p_ : k0; k0 = (lower_ == asc_) ? mn_ : mx_; } \
    { const int p_ = shx(k1, J, lane); const bool asc_ = (((lane + 64) & (K)) == 0); const int mn_ = k1 < p_ ? k1 : p_, mx_ = k1 < p_ ? p_ : k1; k1 = (lower_ == asc_) ? mn_ : mx_; } } while (0)
#ifndef PEER_BSHIFT
#define PEER_BSHIFT 11
#endif
constexpr int PEER_NB = 16384 >> PEER_BSHIFT;
__device__ __forceinline__ void peer_sort_panel(int* IDXp, float* GTp, float* SUp, unsigned char* STp, const float* SU, const float* SV, const int wid0) {
    const int tid = otid(wid0), lane = tid & 63, wid = __builtin_amdgcn_readfirstlane(tid >> 6);
    int ni0 = IDXp[wid * 32 * 128 + lane], ni1 = IDXp[wid * 32 * 128 + 64 + lane];
    float ng0 = GTp[wid * 32 * 128 + lane], ng1 = GTp[wid * 32 * 128 + 64 + lane];
    for (int ti = 0; ti < 32; ++ti) {
        const int lrow = wid * 32 + ti;
        const int i0 = ni0, i1 = ni1; const float g0 = ng0, g1 = ng1;
        if (ti < 31) { ni0 = IDXp[(lrow + 1) * 128 + lane]; ni1 = IDXp[(lrow + 1) * 128 + 64 + lane]; ng0 = GTp[(lrow + 1) * 128 + lane]; ng1 = GTp[(lrow + 1) * 128 + 64 + lane]; }
        const float u0 = SU[i0], u1 = SU[i1], w0 = SV[i0] * g0, w1 = SV[i1] * g1;
        int k0 = (i0 << 7) | lane, k1 = (i1 << 7) | (64 + lane);
        BS_STAGE(2, 1);
        BS_STAGE(4, 2); BS_STAGE(4, 1);
        BS_STAGE(8, 4); BS_STAGE(8, 2); BS_STAGE(8, 1);
        BS_STAGE(16, 8); BS_STAGE(16, 4); BS_STAGE(16, 2); BS_STAGE(16, 1);
        BS_STAGE(32, 16); BS_STAGE(32, 8); BS_STAGE(32, 4); BS_STAGE(32, 2); BS_STAGE(32, 1);
        BS_STAGE(64, 32); BS_STAGE(64, 16); BS_STAGE(64, 8); BS_STAGE(64, 4); BS_STAGE(64, 2); BS_STAGE(64, 1);
        { const int mn_ = k0 < k1 ? k0 : k1, mx_ = k0 < k1 ? k1 : k0; k0 = mn_; k1 = mx_; }
        BS_STAGE(128, 32); BS_STAGE(128, 16); BS_STAGE(128, 8); BS_STAGE(128, 4); BS_STAGE(128, 2); BS_STAGE(128, 1);
        const int s0 = k0 & 127, s1 = k1 & 127, e0 = k0 >> 7, e1 = k1 >> 7;
        const float ua0 = shl_(u0, s0 & 63), ub0 = shl_(u1, s0 & 63), ua1 = shl_(u0, s1 & 63), ub1 = shl_(u1, s1 & 63);
        const float wa0 = shl_(w0, s0 & 63), wb0 = shl_(w1, s0 & 63), wa1 = shl_(w0, s1 & 63), wb1 = shl_(w1, s1 & 63);
        IDXp[lrow * 128 + lane] = e0; IDXp[lrow * 128 + 64 + lane] = e1;
        SUp[lrow * 128 + lane] = (s0 < 64) ? ua0 : ub0; SUp[lrow * 128 + 64 + lane] = (s1 < 64) ? ua1 : ub1;
        GTp[lrow * 128 + lane] = (s0 < 64) ? wa0 : wb0; GTp[lrow * 128 + 64 + lane] = (s1 < 64) ? wa1 : wb1;
        int stv = 0;
#pragma unroll
        for (int r = 1; r < PEER_NB; ++r) { const int c = __builtin_popcountll(__ballot(e0 < (r << PEER_BSHIFT))) + __builtin_popcountll(__ballot(e1 < (r << PEER_BSHIFT))); stv = (lane == r) ? c : stv; }
        stv = (lane == PEER_NB) ? 128 : stv;
        if (lane < 32) STp[lrow * 32 + lane] = (unsigned char)stv;
    }
}
__device__ __forceinline__ void peer_usweep_panel(int panel, const bf16* X1B  , LAS const float* r1, const int* IDXp, const float* GMp, const float* SUp, float* CFp, const unsigned char* EU8, const int wid0) {
    const int tid = otid(wid0), lane = tid & 63, wid = __builtin_amdgcn_readfirstlane(tid >> 6);
    const int tq = (lane >> 3) & 1, pj = lane & 7;
    int ix_n; float gm_n, su_n; v4u hA0_n, hB0_n, hA1_n, hB1_n;
#define US_META(s_) do { const int c_ = (s_) >> 4, tp_ = (s_) & 15; const int lr_ = wid * 32 + 2 * tp_; const int off_ = (lr_ + tq) * 128 + 8 * c_ + pj; \
        ix_n = IDXp[off_]; gm_n = GMp[off_]; su_n = SUp[off_] * r1[lr_ + tq]; \
        const bf16* h0_ = X1B + (size_t)lr_ * DM + 16 * lane; hA0_n = *(const GAS v4u*)h0_; hB0_n = *(const GAS v4u*)(h0_ + 8); hA1_n = *(const GAS v4u*)(h0_ + DM); hB1_n = *(const GAS v4u*)(h0_ + DM + 8); } while (0)
    US_META(0);
    for (int s = 0; s < 256; ++s) {
        const int ix = ix_n; const float gm = gm_n, su = su_n; const v4u hA0 = hA0_n, hB0 = hB0_n, hA1 = hA1_n, hB1 = hB1_n;
        v4u ua[16];
#pragma unroll
        for (int j = 0; j < 16; ++j) { const int ex = __builtin_amdgcn_readlane(ix, j); ua[j] = *((const GAS v4u*)(EU8 + (size_t)ex * DM) + lane); }
        if (s < 255) US_META(s + 1);
        float h[16], p[16];
        h[0] = bflo(hA0.x); h[1] = bfhi(hA0.x); h[2] = bflo(hA0.y); h[3] = bfhi(hA0.y); h[4] = bflo(hA0.z); h[5] = bfhi(hA0.z); h[6] = bflo(hA0.w); h[7] = bfhi(hA0.w);
        h[8] = bflo(hB0.x); h[9] = bfhi(hB0.x); h[10] = bflo(hB0.y); h[11] = bfhi(hB0.y); h[12] = bflo(hB0.z); h[13] = bfhi(hB0.z); h[14] = bflo(hB0.w); h[15] = bfhi(hB0.w);
#pragma unroll
        for (int j = 0; j < 8; ++j) p[j] = dot16_fp8(ua[j], h);
        h[0] = bflo(hA1.x); h[1] = bfhi(hA1.x); h[2] = bflo(hA1.y); h[3] = bfhi(hA1.y); h[4] = bflo(hA1.z); h[5] = bfhi(hA1.z); h[6] = bflo(hA1.w); h[7] = bfhi(hA1.w);
        h[8] = bflo(hB1.x); h[9] = bfhi(hB1.x); h[10] = bflo(hB1.y); h[11] = bfhi(hB1.y); h[12] = bflo(hB1.z); h[13] = bfhi(hB1.z); h[14] = bflo(hB1.w); h[15] = bfhi(hB1.w);
#pragma unroll
        for (int j = 8; j < 16; ++j) p[j] = dot16_fp8(ua[j], h);
        RS_LEVEL(p, 8, 8); RS_LEVEL(p, 4, 4); RS_LEVEL(p, 2, 2); RS_LEVEL(p, 1, 1);
        float d = p[0]; d += shx(d, 16, lane); d += shx(d, 32, lane);
        const float sx = d * su;
        const float act = 0.5f * sx * (1.0f + erff(sx * 0.70710678118654752f));
        const int c = s >> 4, tp = s & 15;
        if (lane < 16) CFp[(wid * 32 + 2 * tp + tq) * 128 + 8 * c + pj] = gm * act;
    }
#undef US_META
}
__device__ __forceinline__ void peer_v_panel(int panel, bf16* XN, const int* IDXp, const float* CFp, const unsigned char* EV8, float* XIO, const int wid0) {
    const int tid = otid(wid0), lane = tid & 63, wid = __builtin_amdgcn_readfirstlane(tid >> 6);
    for (int ti = 0; ti < 32; ++ti) {
        const int lrow = wid * 32 + ti;
        const size_t row = (size_t)panel * 256 + lrow;
        const int i0 = IDXp[lrow * 128 + lane], i1 = IDXp[lrow * 128 + 64 + lane];
        const float c0 = CFp[lrow * 128 + lane], c1 = CFp[lrow * 128 + 64 + lane];
        float o[16];
        { const GAS f32x4* xp = (const GAS f32x4*)(XIO + row * DM + 16 * lane);
#pragma unroll
          for (int k = 0; k < 4; ++k) { const f32x4 x = xp[k]; o[4 * k] = x.x; o[4 * k + 1] = x.y; o[4 * k + 2] = x.z; o[4 * k + 3] = x.w; } }
#pragma unroll
        for (int hf = 0; hf < 2; ++hf) {
            const int iv = hf ? i1 : i0; const float cv = hf ? c1 : c0;
#pragma nounroll
            for (int c = 0; c < 4; ++c) {
                v4u va[16];
#pragma unroll
                for (int j = 0; j < 16; ++j) { const int ex = __builtin_amdgcn_readlane(iv, c * 16 + j); va[j] = *((const GAS v4u*)(EV8 + (size_t)ex * DM) + lane); }
#pragma unroll
                for (int j = 0; j < 16; ++j) { const float cf = __builtin_bit_cast(float, __builtin_amdgcn_readlane(__builtin_bit_cast(int, cv), c * 16 + j)); fma16_fp8(o, cf, va[j]); }
            }
        }
        float ss = 0.f;
#pragma unroll
        for (int k = 0; k < 16; ++k) ss += o[k] * o[k];
        const float r = 1.f / sqrtf(wave_sum(ss, lane) * (1.f / DM) + RMS_EPS);
        { GAS f32x4* xp = (GAS f32x4*)(XIO + row * DM + 16 * lane);
#pragma unroll
          for (int k = 0; k < 4; ++k) xp[k] = (f32x4){o[4 * k], o[4 * k + 1], o[4 * k + 2], o[4 * k + 3]}; }
        v4u ha, hb;
        ha.x = cvtpk(o[0] * r, o[1] * r); ha.y = cvtpk(o[2] * r, o[3] * r); ha.z = cvtpk(o[4] * r, o[5] * r); ha.w = cvtpk(o[6] * r, o[7] * r);
        hb.x = cvtpk(o[8] * r, o[9] * r); hb.y = cvtpk(o[10] * r, o[11] * r); hb.z = cvtpk(o[12] * r, o[13] * r); hb.w = cvtpk(o[14] * r, o[15] * r);
        *(GAS v4u*)(XN + row * DM + 16 * lane) = ha; *(GAS v4u*)(XN + row * DM + 16 * lane + 8) = hb;
    }
}

__device__ __forceinline__ void peer_vsweep_panel(int panel, const bf16* X1B, bf16* X2B  , LAS float* r3, const int* IDXp, const float* CFp, const unsigned char* EV8, const int wid0) {
    const int wid = wid0;
#pragma nounroll
    for (int g = 0; g < 4; ++g) {
        const int lane = lane_id();
        const int lr0 = wid * 32 + 8 * g;
        float o[8][16];
#pragma unroll
        for (int t = 0; t < 8; ++t) { const bf16* xp = X1B + (size_t)(lr0 + t) * DM + 16 * lane; const v4u a = *(const GAS v4u*)xp, b2 = *(const GAS v4u*)(xp + 8); H_UNPACK(o[t], a, b2); }
        const int moff = (lr0 + (lane >> 3)) * 128 + (lane & 7);
        int ix_n = IDXp[moff]; float cf_n = CFp[moff];
#pragma nounroll
        for (int c = 0; c < 16; ++c) {
            const int ix = ix_n; const float cf = cf_n;
            if (c < 15) { ix_n = IDXp[moff + 8 * (c + 1)]; cf_n = CFp[moff + 8 * (c + 1)]; }
#pragma unroll
            for (int b = 0; b < 8; ++b) {
                v4u va[8];
#pragma unroll
                for (int j = 0; j < 8; ++j) { const int ex = __builtin_amdgcn_readlane(ix, 8 * b + j); va[j] = *((const GAS v4u*)(EV8 + (size_t)ex * DM) + lane); }
#pragma unroll
                for (int j = 0; j < 8; ++j) { const float cfi = __builtin_bit_cast(float, __builtin_amdgcn_readlane(__builtin_bit_cast(int, cf), 8 * b + j)); fma16_fp8(o[b], cfi, va[j]); }
            }
        }
        const int lane2 = lane_id();
#pragma unroll
        for (int t = 0; t < 8; ++t) {
            float ss = 0.f;
#pragma unroll
            for (int k = 0; k < 16; ++k) ss += o[t][k] * o[t][k];
            const float r = 1.f / sqrtf(wave_sum(ss, lane2) * (1.f / DM) + RMS_EPS);
            if (lane2 == 0) r3[lr0 + t] = r;
            v4u ha, hb;
            ha.x = cvtpk(o[t][0], o[t][1]); ha.y = cvtpk(o[t][2], o[t][3]); ha.z = cvtpk(o[t][4], o[t][5]); ha.w = cvtpk(o[t][6], o[t][7]);
            hb.x = cvtpk(o[t][8], o[t][9]); hb.y = cvtpk(o[t][10], o[t][11]); hb.z = cvtpk(o[t][12], o[t][13]); hb.w = cvtpk(o[t][14], o[t][15]);
            bf16* xo = X2B + (size_t)(lr0 + t) * DM + 16 * lane2;
            *(GAS v4u*)xo = ha; *(GAS v4u*)(xo + 8) = hb;
        }
    }
}


struct Args {
    const float *x, *p, *norm_mix, *w_in, *w_att_up, *w_pool_group, *pool_scale, *w_out, *norm_ffn, *w_query, *sub_keys, *expert_u, *expert_v, *norm_ple, *w_ple_gate, *w_ple, *norm_final;
    float* out; unsigned char* ws; int ph_hi, pad;
};

#ifndef REP_P0
#define REP_P0 1
#endif
#ifndef REP_P1
#define REP_P1 1
#endif
#ifndef REP_P23
#define REP_P23 1
#endif
#ifndef REP_P4
#define REP_P4 1
#endif
#ifndef REP_P567
#define REP_P567 1
#endif
#ifndef REP_P9
#define REP_P9 1
#endif
#ifndef REP_ATT
#define REP_ATT 1
#endif
#ifndef REP_TOPK
#define REP_TOPK 1
#endif
#ifndef REP_MRG
#define REP_MRG 1
#endif
#ifndef MK_PH_HI
#define MK_PH_HI 99
#endif

typedef const __attribute__((address_space(4))) Args* CArgs;
__device__ __forceinline__ CArgs kargs() { CArgs p = (CArgs)__builtin_amdgcn_kernarg_segment_ptr(); asm volatile("" : "+s"(p)); return p; }
#define WSP(T, off) ((T*)(kargs()->ws + (off)))
__global__ void __launch_bounds__(NTHR, 2) mega_fwd(Args a_unused) {
    extern __shared__ __attribute__((aligned(16))) unsigned char lds_raw[];
    LAS unsigned char* lds = (LAS unsigned char*)lds_raw;
    volatile LAS unsigned* MISC = (volatile LAS unsigned*)(lds + MISC_OFF);
    const int G = gridDim.x; const int bx = blockIdx.x;
    const int vcu = (G % 8 == 0) ? (bx % 8) * (G / 8) + bx / 8 : bx;
    gu32* ctl = (gu32*)(kargs()->ws + WS_CTL);
    const int wid0 = __builtin_amdgcn_readfirstlane((int)threadIdx.x >> 6);
#define IS_T0 (otid(wid0) == 0)
    for (int u = otid(wid0); u < (LDS_BYTES - LDSCTL_OFF) / 4; u += NTHR) ((LAS unsigned*)(lds + LDSCTL_OFF))[u] = 0u;
    __syncthreads();
    (void)xcd_barrier_post((unsigned*)(ctl + CW_BAR), MISC + 8, IS_T0);
#define GRID_BAR() do { XcdBarrier _b; _b.bar = (unsigned*)((gu32*)(kargs()->ws + WS_CTL) + CW_BAR); _b.x = xb_xcc_id(); _b.st = (volatile LAS unsigned*)(lds + MISC_OFF) + 8; xcd_barrier(_b, IS_T0); } while (0)
    LAS float* const SS1 = (LAS float*)(lds + LDSCTL_OFF + 1024);
    LAS float* const R3 = (LAS float*)(lds + LDSCTL_OFF + 2048);
    LAS float* const SSF = (LAS float*)(lds + LDSCTL_OFF + 3072);
#define LOCAL_SEAM() do { VM_WAIT(); __syncthreads(); if (IS_T0) { __builtin_amdgcn_fence(__ATOMIC_ACQUIRE, "agent"); VM_WAIT(); } __syncthreads(); } while (0)

    for (int rep_ = 0; rep_ < REP_P0; ++rep_) {
        const int tid = otid(wid0), lane = tid & 63, wid = __builtin_amdgcn_readfirstlane(tid >> 6);
        const CArgs a = kargs(); unsigned char* ws = a->ws;
        bf16 *WIN = (bf16*)(ws + WS_WIN), *WOUT = (bf16*)(ws + WS_WOUT), *WQ = (bf16*)(ws + WS_WQ), *WPG = (bf16*)(ws + WS_WPG), *WPLE = (bf16*)(ws + WS_WPLE);
        bf16 *BDA = (bf16*)(ws + WS_BDA), *BDP = (bf16*)(ws + WS_BDP), *SK = (bf16*)(ws + WS_SK), *XN = (bf16*)(ws + WS_XN);
        LAS float* scr = (LAS float*)(lds + wid * 16384);
        const int gw = vcu * NWAVES + wid, NGW = G * NWAVES;
        constexpr int I_IN = (1024 / 64) * (4096 / 32), I_OUT = (1024 / 64) * (1024 / 32), I_Q = (1024 / 64) * (2048 / 32), I_PG = I_OUT, I_PLE = (256 / 64) * (1024 / 32);
        constexpr int NITEMS = I_IN + I_OUT + I_Q + I_PG + I_PLE;
        for (int it = gw; it < NITEMS; it += NGW) {
            int r = it;
            if (r < I_IN) { p0_transpose_item(a->w_in, 1024, 4096, WIN, a->norm_mix, 512, C2, scr, r, lane); continue; } r -= I_IN;
            if (r < I_OUT) { p0_transpose_item(a->w_out, 1024, 1024, WOUT, nullptr, 0, 1.f, scr, r, lane); continue; } r -= I_OUT;
            if (r < I_Q) { p0_transpose_item(a->w_query, 1024, 2048, WQ, a->norm_ffn, 0, 1.f, scr, r, lane); continue; } r -= I_Q;
            if (r < I_PG) { p0_transpose_item(a->w_ple_gate, 1024, 1024, WPG, a->norm_ple, 0, 1.f, scr, r, lane); continue; } r -= I_PG;
            p0_transpose_item(a->w_ple, 256, 1024, WPLE, nullptr, 0, 1.f, scr, r, lane);
        }
        const int gt = vcu * NTHR + tid, NGT = G * NTHR;
        for (int it = gt; it < 1024 * 16; it += NGT) {
            const int n = it >> 4, k8 = (it & 15) * 8, head = n >> 7, g = n >> 8;
            float va[8], vp[8]; const float ps = a->pool_scale[n];
#pragma unroll
            for (int j = 0; j < 8; ++j) {
                const int k = k8 + j;
                va[j] = ((k >> 6) == (head & 1)) ? a->w_att_up[((size_t)head * 64 + (k & 63)) * 128 + (n & 127)] : 0.f;
                vp[j] = a->w_pool_group[((size_t)g * 128 + k) * 256 + (n & 255)] * ps;
            }
            v4u o; o.x = pk2(va[0], va[1]); o.y = pk2(va[2], va[3]); o.z = pk2(va[4], va[5]); o.w = pk2(va[6], va[7]);
            *(GAS v4u*)(BDA + (size_t)n * 128 + k8) = o;
            o.x = pk2(vp[0], vp[1]); o.y = pk2(vp[2], vp[3]); o.z = pk2(vp[4], vp[5]); o.w = pk2(vp[6], vp[7]);
            *(GAS v4u*)(BDP + (size_t)n * 128 + k8) = o;
        }
        for (int it = gt; it < 16 * 128 * 128 / 8; it += NGT) cvt8_store(a->sub_keys + (size_t)it * 8, SK + (size_t)it * 8);
        for (int rr = gw; rr < 2 * 16384; rr += NGW) { const int e = rr >> 1;
            if (rr & 1) quant_row_fp8(a->expert_v + (size_t)e * DM, nullptr, ws + WS_EV + (size_t)e * DM, (float*)(ws + WS_SV) + e, lane);
            else quant_row_fp8(a->expert_u + (size_t)e * DM, a->norm_ffn, ws + WS_EU + (size_t)e * DM, (float*)(ws + WS_SU) + e, lane); }
        { const int panel = bx;
            for (int r = wid; r < 256; r += NWAVES) { const size_t row = (size_t)panel * 256 + r; rms_row_to_bf16(a->x + row * DM, XN + row * DM, lane); } }
    }
    GRID_BAR();

    for (int rep_ = 0; rep_ < REP_P1; ++rep_) {
        { const int panel = bx;
            { pg8::Gemm g{WSP(bf16, WS_XN), WSP(bf16, WS_WIN), 1024, 1024, 1024, 0, 0, 1, 0}; pg8::PanelSched S{panel, 14, 4, 2, 0}; pg8::EpiProj E{WSP(bf16, WS_PQ), WSP(bf16, WS_PK), WSP(bf16, WS_PU), WSP(bf16, WS_PG)};
              pg8::gemm_phase<pg8::EpiProj, pg8::PanelSched, true, true>(lds, g, S, E, wid0); }
            { pg8::Gemm g{WSP(bf16, WS_WIN) + (size_t)1024 * 1024, WSP(bf16, WS_XN), 1024, 1024, 1024, 0, 0, 1, 0}; pg8::PanelSched S{panel, 2, 99, 0, 1}; pg8::EpiPlain E{WSP(bf16, WS_PVT), TOK};
              pg8::gemm_phase<pg8::EpiPlain, pg8::PanelSched, true, true>(lds, g, S, E, wid0); }
        }
    }
    GRID_BAR();

    { const int panel = bx;
        const size_t prow = (size_t)panel * 256;
        for (int rep_ = 0; rep_ < REP_P23; ++rep_) {
        if (MK_PH_HI > 2) { for (int r2_ = 0; r2_ < REP_ATT; ++r2_) attn_panel(panel, WSP(bf16, WS_PQ), WSP(bf16, WS_PK), WSP(bf16, WS_PVT), WSP(bf16, WS_YA), wid0); pool_panel(panel, WSP(bf16, WS_PU), WSP(bf16, WS_YP), wid0); LOCAL_SEAM(); }
        for (int r2_ = 0; r2_ < REP_MRG; ++r2_)
        if (MK_PH_HI > 3) {
            { pg8::Gemm g{WSP(bf16, WS_YA), WSP(bf16, WS_BDA), 128, 512, 128, 128, (long)((WS_YP - WS_YA) / 2), 1, 0}; pg8::PanelSched S{panel, 8, 99, 0, 0}; pg8::EpiMergeChain E{WSP(bf16, WS_PG), WSP(bf16, WS_MG)};
              pg8::gemm_phase<pg8::EpiMergeChain, pg8::PanelSched, true, true>(lds, g, S, E, wid0); }
            LOCAL_SEAM();
        }
        }
        for (int rep_ = 0; rep_ < REP_P4; ++rep_)
        if (MK_PH_HI > 4) {
            { pg8::Gemm g{WSP(bf16, WS_MG), WSP(bf16, WS_WOUT), 1024, 1024, 1024, 0, 0, 1, 0}; pg8::PanelSched S{panel, 4, 99, 0, 0}; pg8::EpiRes E{kargs()->x, (bf16*)kargs()->out, SS1};
              pg8::gemm_phase<pg8::EpiRes, pg8::PanelSched, true, true>(lds, g, S, E, wid0); }
            LOCAL_SEAM();
        }
        { { const int t_ = otid(wid0); if (t_ < 256) SS1[t_] = 1.f / sqrtf(SS1[t_] * (1.f / DM) + RMS_EPS); } __syncthreads(); }
        {
        if (MK_PH_HI > 6) {
            { pg8::Gemm g{(const bf16*)kargs()->out, WSP(bf16, WS_WQ), 1024, 1024, 1024, 0, 0, 2, 0}; pg8::PanelSched S{panel, 8, 99, 0, 0}; pg8::EpiPlainScale E{WSP(bf16, WS_PG), 2048, SS1};
              pg8::gemm_phase<pg8::EpiPlainScale, pg8::PanelSched, true, true>(lds, g, S, E, wid0); }
            LOCAL_SEAM();
        }
        #define IDXP ((int*)(kargs()->ws + WS_YA + (size_t)panel * 262144))
#define GTP ((float*)(kargs()->ws + WS_YA + (size_t)panel * 262144 + 131072))
        if (MK_PH_HI > 7) { for (int r2_ = 0; r2_ < REP_TOPK; ++r2_) topk_panel(panel, WSP(bf16, WS_PG), WSP(bf16, WS_SK), IDXP, GTP, lds, wid0); LOCAL_SEAM(); }
        }
#ifndef PEER_SWEEP
#define PEER_SWEEP 1
#endif
#define STP ((unsigned char*)(kargs()->ws + WS_YP + (size_t)panel * 262144))
#define CFP ((float*)(kargs()->ws + WS_YP + (size_t)panel * 262144 + 131072))
#define SLOTP ((int*)(kargs()->ws + WS_MG + (size_t)panel * 524288 + 131072))
#define IDXPADP ((int*)(kargs()->ws + WS_PG + (size_t)panel * 1048576))
#define CFPADP ((float*)(kargs()->ws + WS_PG + (size_t)panel * 1048576 + 393216))
#define SUSP ((float*)(kargs()->ws + WS_MG + (size_t)panel * 524288))
        if (MK_PH_HI > 8) {
            if (PEER_SWEEP) {
                peer_sort_panel(IDXP, GTP, SUSP, STP, WSP(float, WS_SU), WSP(float, WS_SV), wid0); LOCAL_SEAM();
                peer_usweep_panel(panel, (const bf16*)kargs()->out + (size_t)panel * 524288, SS1, IDXP, GTP, SUSP, CFP, WSP(unsigned char, WS_EU), wid0); LOCAL_SEAM();
#ifndef PEER_VSWEEP
#define PEER_VSWEEP 1
#endif
                peer_vsweep_panel(panel, (const bf16*)kargs()->out + (size_t)panel * 524288, WSP(bf16, WS_PG) + (size_t)panel * 524288, R3, IDXP, CFP, WSP(unsigned char, WS_EV), wid0);
                LOCAL_SEAM();
            }
        }
        for (int rep_ = 0; rep_ < REP_P9; ++rep_)
        if (MK_PH_HI > 9) {
            { const int tid = otid(wid0); const float* pp = kargs()->p; bf16* YP = WSP(bf16, WS_YP); for (int it = tid; it < 256 * 256 / 8; it += NTHR) { const int r = it >> 5, c8 = (it & 31) * 8; cvt8_store(pp + (prow + r) * 256 + c8, YP + (prow + r) * 512 + c8); } }
            LOCAL_SEAM();
            { pg8::Gemm g{WSP(bf16, WS_YP), WSP(bf16, WS_WPLE), 256, 512, 256, 0, 0, 1, 0}; pg8::PanelSched S{panel, 4, 99, 0, 0}; pg8::EpiPlain E{WSP(bf16, WS_MG), 1024};
              pg8::gemm_phase<pg8::EpiPlain, pg8::PanelSched, true, true>(lds, g, S, E, wid0); }
            LOCAL_SEAM();
        }
        if (MK_PH_HI > 10) {
            { pg8::Gemm g{WSP(bf16, WS_PG), WSP(bf16, WS_WPG), 1024, 1024, 1024, 0, 0, 2, 0}; pg8::PanelSched S{panel, 4, 99, 0, 0}; pg8::EpiGate E{kargs()->out, WSP(bf16, WS_PG), WSP(bf16, WS_MG), R3, SSF};
              pg8::gemm_phase<pg8::EpiGate, pg8::PanelSched, true, true>(lds, g, S, E, wid0); }
            LOCAL_SEAM();
        }
        if (MK_PH_HI > 11) {
            const int tid = otid(wid0), lane = tid & 63, wid = __builtin_amdgcn_readfirstlane(tid >> 6);
            for (int r = wid; r < 256; r += NWAVES) {
                GAS f32x4* xr = (GAS f32x4*)(kargs()->out + (prow + r) * DM) + lane; const GAS f32x4* gr = (const GAS f32x4*)kargs()->norm_final + lane;
                const float rr = 1.f / sqrtf(SSF[r] * (1.f / DM) + RMS_EPS);
#pragma unroll
                for (int j = 0; j < 4; ++j) xr[64 * j] = xr[64 * j] * rr * gr[64 * j];
            }
        }
    }
#undef LOCAL_SEAM
}


extern "C" void kernel_launch(void* const* d_in, const int* in_sizes, int n_in, void* d_out, int out_size, void* d_ws, size_t ws_size, hipStream_t stream) {
    static int grid = 0;
    if (grid == 0) {
        if (n_in != 17 || in_sizes[0] != TOK * DM || out_size != TOK * DM || ws_size < WS_END) { fprintf(stderr, "kernel_launch: unexpected shapes (n_in %d, in0 %d, out %d, ws %zu); nothing launched\n", n_in, n_in > 0 ? in_sizes[0] : -1, out_size, ws_size); grid = -1; return; }
        int dev = 0, cus = 0;
        if (hipGetDevice(&dev) != hipSuccess || hipDeviceGetAttribute(&cus, hipDeviceAttributeMultiprocessorCount, dev) != hipSuccess) { fprintf(stderr, "kernel_launch: device query failed\n"); grid = -1; return; }
        if (hipFuncSetAttribute((const void*)mega_fwd, hipFuncAttributeMaxDynamicSharedMemorySize, LDS_BYTES) != hipSuccess) { fprintf(stderr, "kernel_launch: hipFuncSetAttribute failed\n"); grid = -1; return; }
        int per_cu = 0;
        if (hipOccupancyMaxActiveBlocksPerMultiprocessor(&per_cu, (const void*)mega_fwd, NTHR, LDS_BYTES) != hipSuccess || per_cu < 1) fprintf(stderr, "kernel_launch: note: occupancy query reports %d workgroups per CU\n", per_cu);
        (void)hipGetLastError();
        if (cus != NPANEL) fprintf(stderr, "kernel_launch: note: %d CUs; this kernel is built for one 256-token panel per CU on a 256-CU device\n", cus);
        grid = NPANEL;
    }
    if (grid < 0) return;
    if (hipMemsetAsync((char*)d_ws + WS_CTL, 0, CTL_ZERO_BYTES, stream) != hipSuccess) { fprintf(stderr, "kernel_launch: memset failed\n"); return; }
    Args a{};
    a.x = (const float*)d_in[0]; a.p = (const float*)d_in[1]; a.norm_mix = (const float*)d_in[2]; a.w_in = (const float*)d_in[3]; a.w_att_up = (const float*)d_in[4];
    a.w_pool_group = (const float*)d_in[5]; a.pool_scale = (const float*)d_in[6]; a.w_out = (const float*)d_in[7]; a.norm_ffn = (const float*)d_in[8]; a.w_query = (const float*)d_in[9];
    a.sub_keys = (const float*)d_in[10]; a.expert_u = (const float*)d_in[11]; a.expert_v = (const float*)d_in[12]; a.norm_ple = (const float*)d_in[13]; a.w_ple_gate = (const float*)d_in[14];
    a.w_ple = (const float*)d_in[15]; a.norm_final = (const float*)d_in[16];
    a.out = (float*)d_out; a.ws = (unsigned char*)d_ws; a.ph_hi = MK_PH_HI; a.pad = 0;
    hipLaunchKernelGGL(mega_fwd, dim3(grid), dim3(NTHR), LDS_BYTES, stream, a);
    { const hipError_t le = hipPeekAtLastError(); if (le != hipSuccess) fprintf(stderr, "kernel_launch: launch failed: %s\n", hipGetErrorName(le)); }
}
```

```cpp
#include <hip/hip_runtime.h>
#include <cstdio>
#include <cstdint>
#include <math.h>
__device__ __forceinline__ int lane_id() { int l; asm volatile("v_mbcnt_lo_u32_b32 %0, -1, 0\n\tv_mbcnt_hi_u32_b32 %0, -1, %0" : "=v"(l)); return l; }
__device__ __forceinline__ int otid(int wid0) { return (wid0 << 6) | lane_id(); }

namespace pg8 {
#define PG8_LAS __attribute__((address_space(3)))
typedef unsigned short bf16_t;
typedef short bf16x8 __attribute__((ext_vector_type(8)));
typedef float f32x4 __attribute__((ext_vector_type(4)));
typedef unsigned u32x4 __attribute__((ext_vector_type(4)));
constexpr int BM = 256, BK = 64, HALF = 128, HTB = HALF * BK * 2  , STAGE_BYTES = 8 * HTB, NXCD = 8, WGM = 8;

__host__ __device__ __forceinline__ int lds_byte(int r, int c) { const int st = (r >> 4) * 2 + (c >> 5), rr = r & 15, cc = c & 31, ob = rr * 64 + cc * 2; return st * 1024 + (ob ^ (((ob >> 9) & 1) << 5)); }
__host__ __device__ __forceinline__ void stage_rc(int b, int& R, int& C) { const int st = b / 1024, sb = b % 1024, swz = sb ^ (((sb >> 9) & 1) << 5); R = (st >> 1) * 16 + swz / 64; C = (st & 1) * 32 + (swz % 64) / 2; }
__host__ __device__ __forceinline__ int perm32(int rho) { const int n = rho >> 4, i = rho & 15; return 8 * (i >> 2) + 4 * n + (i & 3); }

struct Unit { int pm, pn; };
struct Gemm { const bf16_t* A; const bf16_t* Bt; int K, lda, ldb, akoff; long a2off; int am, pad_; };

struct StaticOrder {
    int nM, nN, nwg, G, c;
    __host__ __device__ void init(int M, int N, int G_, int c_) { nM = M / BM; nN = N / BM; nwg = nM * nN; G = G_; c = c_; }
    __host__ __device__ bool next(int i, Unit& u) const {
        const long L = (long)i * G + c; if (L >= nwg) return false;
        int wgid = (int)L; { const int q = nwg / NXCD, r = nwg % NXCD, xcd = wgid % NXCD, off = wgid / NXCD; wgid = (xcd < r ? xcd * (q + 1) : r * (q + 1) + (xcd - r) * q) + off; }
        const int nig = WGM * nN, gid = wgid / nig, fm = gid * WGM, gsz = (nM - fm) < WGM ? (nM - fm) : WGM;
        u.pm = fm + ((wgid % nig) % gsz); u.pn = (wgid % nig) / gsz; return true;
    }
    __device__ __forceinline__ void a_ready(const Unit&) const {}
    __device__ __forceinline__ void done(const Unit&) const {}
};

template <class Epi, class Sched, bool ALIGN_EPI = false, bool SP2 = false>
__device__ __forceinline__ void gemm_phase(PG8_LAS unsigned char* lds, const Gemm g, const Sched& S, const Epi& E, const int wid0) {
    const int tid = otid(wid0), wid = __builtin_amdgcn_readfirstlane(tid >> 6), lane = tid & 63, wr = wid >> 2, wc = wid & 3, fr = lane & 15, fq = lane >> 4;
    const int K = g.K, nt = K / BK;
    unsigned voffA[2], voffB[2];
#pragma unroll
    for (int i = 0; i < 2; ++i) { int R, C; stage_rc(tid * 16 + i * 8192, R, C); const int Rb = Epi::PERM ? ((R & ~31) + perm32(R & 31)) : R;
        voffA[i] = (unsigned)(R * g.lda + C) * 2u; voffB[i] = (unsigned)(Rb * g.ldb + C) * 2u; }
    const size_t kstep = (size_t)(BK * 2);
    const size_t hstepA = (size_t)HALF * g.lda * 2, hstepB = (size_t)HALF * g.ldb * 2;
    const size_t tstepA = 2 * hstepA, tstepB = 2 * hstepB, akb = (size_t)g.akoff * 2, a2b = (size_t)g.a2off * 2;
    const unsigned ldsw = (unsigned)wid * 1024u;
    const int aoff = lds_byte(wr * 64 + fr, fq * 8), boff = lds_byte(wc * 32 + fr, fq * 8);
#define PG8_SA(b, h) (((b) * 2 + (h)) * HTB)
#define PG8_SB(b, h) ((4 + (b) * 2 + (h)) * HTB)
#define PG8_STAGE(bufoff, gbase, voff) do { _Pragma("unroll") for (int _i = 0; _i < 2; ++_i) \
        __builtin_amdgcn_global_load_lds((const unsigned*)((const char*)(gbase) + (voff)[_i]), (PG8_LAS unsigned*)(lds + (bufoff) + ldsw + _i * 8192), 16, 0, 0); } while (0)
#define PG8_LDA(dst, b, h) do { _Pragma("unroll") for (int m = 0; m < 4; ++m) _Pragma("unroll") for (int k = 0; k < 2; ++k) dst[m][k] = *(const PG8_LAS bf16x8*)(lds + PG8_SA(b, h) + aoff + m * 2048 + k * 1024); } while (0)
#define PG8_LDB(dst, b, h) do { _Pragma("unroll") for (int n = 0; n < 2; ++n) _Pragma("unroll") for (int k = 0; k < 2; ++k) dst[n][k] = *(const PG8_LAS bf16x8*)(lds + PG8_SB(b, h) + boff + n * 2048 + k * 1024); } while (0)
#define PG8_MMA(ai, bj, At, Bt) do { __builtin_amdgcn_s_setprio(1); _Pragma("unroll") for (int m = 0; m < 4; ++m) _Pragma("unroll") for (int n = 0; n < 2; ++n) _Pragma("unroll") for (int k = 0; k < 2; ++k) \
        acc[ai][bj][m][n] = __builtin_amdgcn_mfma_f32_16x16x32_bf16(Bt[n][k], At[m][k], acc[ai][bj][m][n], 0, 0, 0); __builtin_amdgcn_s_setprio(0); } while (0)
#define PG8_WAIT_V(n) asm volatile("s_waitcnt vmcnt(" #n ")" ::: "memory")
#define PG8_WAIT_L(n) asm volatile("s_waitcnt lgkmcnt(" #n ")" ::: "memory")
#define PG8_BAR __builtin_amdgcn_s_barrier()
#define PG8_SCHED __builtin_amdgcn_sched_barrier(0)
    Unit cur, nxt; int ui = 0;
    if (!S.next(0, cur)) return;
    f32x4 acc[2][2][4][2];
#pragma unroll
    for (int a = 0; a < 2; ++a)
#pragma unroll
        for (int b = 0; b < 2; ++b)
#pragma unroll
            for (int m = 0; m < 4; ++m)
#pragma unroll
                for (int n = 0; n < 2; ++n) acc[a][b][m][n] = (f32x4){0.f, 0.f, 0.f, 0.f};
    bf16x8 At[4][2], B0[2][2], B1[2][2];
    const char* cA = (const char*)g.A + (size_t)(cur.pm * g.am) * tstepA + (size_t)(cur.pn & 3) * akb + (size_t)(cur.pn >> 2) * a2b; const char* cB = (const char*)g.Bt + (size_t)cur.pn * tstepB;
    S.a_ready(cur);
    if constexpr (SP2) {
        PG8_STAGE(PG8_SB(0, 0), cB, voffB); PG8_STAGE(PG8_SB(0, 1), cB + hstepB, voffB); PG8_STAGE(PG8_SA(0, 0), cA, voffA); PG8_STAGE(PG8_SA(0, 1), cA + hstepA, voffA);
        if (wr == 1) PG8_BAR;
        PG8_WAIT_V(2); PG8_BAR;
        PG8_STAGE(PG8_SB(1, 0), cB + kstep, voffB); PG8_STAGE(PG8_SA(1, 0), cA + kstep, voffA); PG8_STAGE(PG8_SB(1, 1), cB + hstepB + kstep, voffB);
        PG8_WAIT_V(6); PG8_BAR;
    } else {
        PG8_STAGE(PG8_SB(0, 0), cB, voffB); PG8_STAGE(PG8_SA(0, 0), cA, voffA); PG8_STAGE(PG8_SB(0, 1), cB + hstepB, voffB); PG8_STAGE(PG8_SA(0, 1), cA + hstepA, voffA);
        if (wr == 1) PG8_BAR;
        PG8_WAIT_V(4); PG8_BAR;
        PG8_STAGE(PG8_SB(1, 0), cB + kstep, voffB); PG8_STAGE(PG8_SA(1, 0), cA + kstep, voffA); PG8_STAGE(PG8_SB(1, 1), cB + hstepB + kstep, voffB);
        PG8_WAIT_V(6); PG8_BAR;
    }
    for (;;) {
        const bool has_next = S.next(ui + 1, nxt);
        const char* nA = has_next ? (const char*)g.A + (size_t)(nxt.pm * g.am) * tstepA + (size_t)(nxt.pn & 3) * akb + (size_t)(nxt.pn >> 2) * a2b : cA; const char* nB = has_next ? (const char*)g.Bt + (size_t)nxt.pn * tstepB : cB;
        for (int t = 0; t < nt; t += 2) {
            const bool last = (t == nt - 2);
            const char* a1 = cA + (size_t)(t + 1) * kstep;
            const char* a2 = last ? nA : cA + (size_t)(t + 2) * kstep; const char* b2 = last ? nB : cB + (size_t)(t + 2) * kstep;
            const char* a3 = a2 + kstep; const char* b3 = b2 + kstep;
            if (last && has_next) S.a_ready(nxt);
            if constexpr (SP2) {
            PG8_LDB(B0, 0, 0); PG8_LDB(B1, 0, 1); PG8_SCHED; PG8_LDA(At, 0, 0); PG8_STAGE(PG8_SA(1, 1), a1 + hstepA, voffA);
            PG8_WAIT_V(8); PG8_WAIT_L(0); PG8_BAR; PG8_MMA(0, 0, At, B0); PG8_MMA(0, 1, At, B1); PG8_BAR; PG8_SCHED;
            PG8_LDA(At, 0, 1); PG8_STAGE(PG8_SB(0, 0), b2, voffB); PG8_STAGE(PG8_SB(0, 1), b2 + hstepB, voffB); PG8_STAGE(PG8_SA(0, 0), a2, voffA);
            PG8_WAIT_V(8); PG8_WAIT_L(0); PG8_BAR; PG8_MMA(1, 0, At, B0); PG8_MMA(1, 1, At, B1); PG8_BAR; PG8_SCHED;
            PG8_LDB(B0, 1, 0); PG8_LDB(B1, 1, 1); PG8_SCHED; PG8_LDA(At, 1, 0); PG8_STAGE(PG8_SA(0, 1), a2 + hstepA, voffA);
            PG8_WAIT_V(8); PG8_WAIT_L(0); PG8_BAR; PG8_MMA(0, 0, At, B0); PG8_MMA(0, 1, At, B1); PG8_BAR; PG8_SCHED;
            PG8_LDA(At, 1, 1); PG8_STAGE(PG8_SB(1, 0), b3, voffB); PG8_STAGE(PG8_SB(1, 1), b3 + hstepB, voffB); PG8_STAGE(PG8_SA(1, 0), a3, voffA);
            PG8_WAIT_V(8); PG8_WAIT_L(0); PG8_BAR; PG8_MMA(1, 0, At, B0); PG8_MMA(1, 1, At, B1); PG8_BAR; PG8_SCHED;
            } else {
            PG8_LDB(B0, 0, 0); PG8_SCHED; PG8_LDA(At, 0, 0); PG8_STAGE(PG8_SA(1, 1), a1 + hstepA, voffA);
            PG8_WAIT_L(8); PG8_BAR; PG8_WAIT_L(0); PG8_MMA(0, 0, At, B0); PG8_BAR; PG8_SCHED;
            PG8_LDB(B1, 0, 1); PG8_STAGE(PG8_SB(0, 0), b2, voffB);
            PG8_BAR; PG8_WAIT_L(0); PG8_MMA(0, 1, At, B1); PG8_BAR;
            PG8_LDA(At, 0, 1); PG8_STAGE(PG8_SA(0, 0), a2, voffA);
            PG8_BAR; PG8_WAIT_L(0); PG8_MMA(1, 0, At, B0); PG8_BAR; PG8_SCHED;
            PG8_STAGE(PG8_SB(0, 1), b2 + hstepB, voffB);
            PG8_WAIT_V(6); PG8_BAR; PG8_MMA(1, 1, At, B1); PG8_BAR;
            PG8_LDB(B0, 1, 0); PG8_SCHED; PG8_LDA(At, 1, 0); PG8_STAGE(PG8_SA(0, 1), a2 + hstepA, voffA);
            PG8_WAIT_L(8); PG8_BAR; PG8_WAIT_L(0); PG8_MMA(0, 0, At, B0); PG8_BAR; PG8_SCHED;
            PG8_LDB(B1, 1, 1); PG8_STAGE(PG8_SB(1, 0), b3, voffB);
            PG8_BAR; PG8_WAIT_L(0); PG8_MMA(0, 1, At, B1); PG8_BAR;
            PG8_LDA(At, 1, 1); PG8_STAGE(PG8_SA(1, 0), a3, voffA);
            PG8_BAR; PG8_WAIT_L(0); PG8_MMA(1, 0, At, B0); PG8_BAR; PG8_SCHED;
            PG8_STAGE(PG8_SB(1, 1), b3 + hstepB, voffB);
            PG8_WAIT_V(6); PG8_BAR; PG8_MMA(1, 1, At, B1); PG8_BAR;
            }
        }
        if constexpr (ALIGN_EPI) { if (wr == 0) PG8_BAR; }
        if constexpr (!Epi::AFTER_DRAIN) { E(acc, cur, wr, wc, fr, fq); S.done(cur); }
        if (!has_next) break;
#pragma unroll
        for (int a = 0; a < 2; ++a)
#pragma unroll
            for (int b = 0; b < 2; ++b)
#pragma unroll
                for (int m = 0; m < 4; ++m)
#pragma unroll
                    for (int n = 0; n < 2; ++n) acc[a][b][m][n] = (f32x4){0.f, 0.f, 0.f, 0.f};
        cur = nxt; cA = nA; cB = nB; ++ui;
        if constexpr (ALIGN_EPI) { if (wr == 1) PG8_BAR; }
    }
    PG8_WAIT_V(0);
    if constexpr (!ALIGN_EPI) { if (wr == 0) PG8_BAR; }
    PG8_BAR;
    if constexpr (Epi::AFTER_DRAIN) { E.fused(acc, cur, wr, wc, fr, fq, lds, wid, lane); S.done(cur); }
#undef PG8_SA
#undef PG8_SB
#undef PG8_STAGE
#undef PG8_LDA
#undef PG8_LDB
#undef PG8_MMA
#undef PG8_WAIT_V
#undef PG8_WAIT_L
#undef PG8_BAR
#undef PG8_SCHED
}
}


namespace pg8 {
typedef unsigned u32x2 __attribute__((ext_vector_type(2)));
__device__ __forceinline__ unsigned cvt_pk_bf16(float lo, float hi) { unsigned r; asm volatile("v_cvt_pk_bf16_f32 %0, %1, %2" : "=v"(r) : "v"(lo), "v"(hi)); return r; }
__device__ __forceinline__ float sigm(float x) { return __builtin_amdgcn_rcpf(1.0f + __builtin_amdgcn_exp2f(-1.4426950408889634f * x)); }
__device__ __forceinline__ float bf_lo(unsigned w) { return __uint_as_float(w << 16); }
__device__ __forceinline__ float bf_hi(unsigned w) { return __uint_as_float(w & 0xffff0000u); }

struct PanelSched {
    int panel, n, skip_lo, skip_n, mode;
    __device__ __forceinline__ bool next(int i, Unit& u) const {
        if (i >= n) return false;
        if (mode == 0) { u.pm = panel; u.pn = i + (i >= skip_lo ? skip_n : 0); } else { u.pm = i; u.pn = panel; }
        return true;
    }
    __device__ __forceinline__ void a_ready(const Unit&) const {}
    __device__ __forceinline__ void done(const Unit&) const {}
};

struct EpiProj {
    static constexpr bool PERM = true, AFTER_DRAIN = false;
    bf16_t *PQ, *PK, *PU, *PG;
    __device__ __forceinline__ void operator()(const f32x4 (&acc)[2][2][4][2], const Unit& u, int wr, int wc, int fr, int fq) const {
        const int pn = u.pn; bf16_t* base; int ld, colt; bool sg = false;
        if (pn < 2) { base = PQ; ld = 512; colt = pn * 256; }
        else if (pn < 4) { base = PK; ld = 512; colt = (pn - 2) * 256; }
        else if (pn < 8) { base = PU; ld = 512; colt = (pn - 6) * 256; }
        else { base = PG; ld = 2048; colt = (pn - 8) * 256; sg = true; }
        const int row0 = u.pm * BM + wr * 64 + fr, col0 = colt + wc * 32 + 8 * fq;
#pragma unroll
        for (int ai = 0; ai < 2; ++ai)
#pragma unroll
            for (int m = 0; m < 4; ++m) { bf16_t* rowp = base + (size_t)(row0 + ai * HALF + m * 16) * ld + col0;
#pragma unroll
                for (int bj = 0; bj < 2; ++bj) { f32x4 v0 = acc[ai][bj][m][0], v1 = acc[ai][bj][m][1];
                    if (sg) { v0 = (f32x4){sigm(v0[0]), sigm(v0[1]), sigm(v0[2]), sigm(v0[3])}; v1 = (f32x4){sigm(v1[0]), sigm(v1[1]), sigm(v1[2]), sigm(v1[3])}; }
                    u32x4 w; w.x = cvt_pk_bf16(v0[0], v0[1]); w.y = cvt_pk_bf16(v0[2], v0[3]); w.z = cvt_pk_bf16(v1[0], v1[1]); w.w = cvt_pk_bf16(v1[2], v1[3]);
                    *(u32x4*)(rowp + bj * HALF) = w; } }
    }
};
struct EpiPlain {
    static constexpr bool PERM = true, AFTER_DRAIN = false;
    bf16_t* O; int ldc;
    __device__ __forceinline__ void operator()(const f32x4 (&acc)[2][2][4][2], const Unit& u, int wr, int wc, int fr, int fq) const {
        const int row0 = u.pm * BM + wr * 64 + fr, col0 = u.pn * BM + wc * 32 + 8 * fq;
#pragma unroll
        for (int ai = 0; ai < 2; ++ai)
#pragma unroll
            for (int m = 0; m < 4; ++m) { bf16_t* rowp = O + (size_t)(row0 + ai * HALF + m * 16) * ldc + col0;
#pragma unroll
                for (int bj = 0; bj < 2; ++bj) { const f32x4 v0 = acc[ai][bj][m][0], v1 = acc[ai][bj][m][1];
                    u32x4 w; w.x = cvt_pk_bf16(v0[0], v0[1]); w.y = cvt_pk_bf16(v0[2], v0[3]); w.z = cvt_pk_bf16(v1[0], v1[1]); w.w = cvt_pk_bf16(v1[2], v1[3]);
                    *(u32x4*)(rowp + bj * HALF) = w; } }
    }
};
struct EpiMergeChain {
    static constexpr bool PERM = true, AFTER_DRAIN = false;
    const bf16_t* G; bf16_t* MG;
    __device__ __forceinline__ void operator()(const f32x4 (&acc)[2][2][4][2], const Unit& u, int wr, int wc, int fr, int fq) const {
        const bool add = u.pn >= 4; const int goff = add ? 1024 : 0;
        const int row0 = u.pm * BM + wr * 64 + fr, col0 = (u.pn & 3) * BM + wc * 32 + 8 * fq;
        if (add) asm volatile("s_waitcnt vmcnt(0)" ::: "memory");
#pragma unroll
        for (int ai = 0; ai < 2; ++ai)
#pragma unroll
            for (int m = 0; m < 4; ++m) { const size_t row = (size_t)(row0 + ai * HALF + m * 16);
#pragma unroll
                for (int bj = 0; bj < 2; ++bj) { const f32x4 v0 = acc[ai][bj][m][0], v1 = acc[ai][bj][m][1];
                    const u32x4 gw = *(const u32x4*)(G + row * 2048 + goff + col0 + bj * HALF);
                    float r0 = bf_lo(gw.x) * v0[0], r1 = bf_hi(gw.x) * v0[1], r2 = bf_lo(gw.y) * v0[2], r3 = bf_hi(gw.y) * v0[3];
                    float r4 = bf_lo(gw.z) * v1[0], r5 = bf_hi(gw.z) * v1[1], r6 = bf_lo(gw.w) * v1[2], r7 = bf_hi(gw.w) * v1[3];
                    bf16_t* mp = MG + row * 1024 + col0 + bj * HALF;
                    if (add) { const u32x4 pw = *(const u32x4*)mp;
                        r0 += bf_lo(pw.x); r1 += bf_hi(pw.x); r2 += bf_lo(pw.y); r3 += bf_hi(pw.y); r4 += bf_lo(pw.z); r5 += bf_hi(pw.z); r6 += bf_lo(pw.w); r7 += bf_hi(pw.w); }
                    u32x4 w; w.x = cvt_pk_bf16(r0, r1); w.y = cvt_pk_bf16(r2, r3); w.z = cvt_pk_bf16(r4, r5); w.w = cvt_pk_bf16(r6, r7);
                    *(u32x4*)mp = w; }
                asm volatile("" ::: "memory"); }
    }
};
__device__ __forceinline__ void lds_addf(PG8_LAS float* p, float v) { __hip_atomic_fetch_add(p, v, __ATOMIC_RELAXED, __HIP_MEMORY_SCOPE_WORKGROUP); }
__device__ __forceinline__ float quad_row_sum(float s, int lane) {
    s += __builtin_bit_cast(float, __builtin_amdgcn_ds_bpermute((lane ^ 16) << 2, __builtin_bit_cast(int, s)));
    s += __builtin_bit_cast(float, __builtin_amdgcn_ds_bpermute((lane ^ 32) << 2, __builtin_bit_cast(int, s)));
    return s;
}
struct EpiRes {
    static constexpr bool PERM = true, AFTER_DRAIN = false;
    const float* X; bf16_t* OB; PG8_LAS float* ss;
    __device__ __forceinline__ void operator()(const f32x4 (&acc)[2][2][4][2], const Unit& u, int wr, int wc, int fr, int fq) const {
        asm volatile("" : "+v"(fr), "+v"(fq));
        const int col0 = u.pn * BM + wc * 32 + 8 * fq; const int lane = fq * 16 + fr;
#pragma unroll
        for (int ai = 0; ai < 2; ++ai)
#pragma unroll
            for (int m = 0; m < 4; ++m) { const int lr = ai * HALF + wr * 64 + m * 16 + fr; const size_t xoff = (size_t)(u.pm * BM + lr) * 1024 + col0; bf16_t* op = OB + ((size_t)(2 * u.pm) * BM + lr) * 1024 + col0;
                float s = 0.f;
#pragma unroll
                for (int bj = 0; bj < 2; ++bj) { const f32x4 x0 = *(const f32x4*)(X + xoff + bj * HALF), x1 = *(const f32x4*)(X + xoff + bj * HALF + 4);
                    const f32x4 v0 = x0 + acc[ai][bj][m][0], v1 = x1 + acc[ai][bj][m][1];
                    s += (v0[0] * v0[0] + v0[1] * v0[1]) + (v0[2] * v0[2] + v0[3] * v0[3]) + (v1[0] * v1[0] + v1[1] * v1[1]) + (v1[2] * v1[2] + v1[3] * v1[3]);
                    u32x4 w; w.x = cvt_pk_bf16(v0[0], v0[1]); w.y = cvt_pk_bf16(v0[2], v0[3]); w.z = cvt_pk_bf16(v1[0], v1[1]); w.w = cvt_pk_bf16(v1[2], v1[3]);
                    *(u32x4*)(op + bj * HALF) = w; }
                s = quad_row_sum(s, lane); if (fq == 0) lds_addf(ss + lr, s);
                asm volatile("" ::: "memory"); }
    }
};
struct EpiPlainScale {
    static constexpr bool PERM = true, AFTER_DRAIN = false;
    bf16_t* O; int ldc; PG8_LAS const float* rs;
    __device__ __forceinline__ void operator()(const f32x4 (&acc)[2][2][4][2], const Unit& u, int wr, int wc, int fr, int fq) const {
        asm volatile("" : "+v"(fr), "+v"(fq));
        const int col0 = u.pn * BM + wc * 32 + 8 * fq;
#pragma unroll
        for (int ai = 0; ai < 2; ++ai)
#pragma unroll
            for (int m = 0; m < 4; ++m) { const int lr = ai * HALF + wr * 64 + m * 16 + fr; const float r = rs[lr]; bf16_t* rowp = O + (size_t)(u.pm * BM + lr) * ldc + col0;
#pragma unroll
                for (int bj = 0; bj < 2; ++bj) { const f32x4 v0 = acc[ai][bj][m][0] * r, v1 = acc[ai][bj][m][1] * r;
                    u32x4 w; w.x = cvt_pk_bf16(v0[0], v0[1]); w.y = cvt_pk_bf16(v0[2], v0[3]); w.z = cvt_pk_bf16(v1[0], v1[1]); w.w = cvt_pk_bf16(v1[2], v1[3]);
                    *(u32x4*)(rowp + bj * HALF) = w; } }
    }
};
struct EpiGate {
    static constexpr bool PERM = false, AFTER_DRAIN = false;
    float* OUT; const bf16_t* X2; const bf16_t* E; PG8_LAS const float* rs; PG8_LAS float* ss;
    __device__ __forceinline__ void operator()(const f32x4 (&acc)[2][2][4][2], const Unit& u, int wr, int wc, int fr, int fq) const {
        asm volatile("" : "+v"(fr), "+v"(fq));
        const int col0 = u.pn * BM + wc * 32 + 4 * fq; const int lane = fq * 16 + fr;
#pragma unroll
        for (int ai = 0; ai < 2; ++ai)
#pragma unroll
            for (int m = 0; m < 4; ++m) { const int lr = ai * HALF + wr * 64 + m * 16 + fr; const float r = rs[lr];
                const size_t off = (size_t)(u.pm * BM + lr) * 1024 + col0, xo = ((size_t)(2 * u.pm) * BM + lr) * 1024 + col0; float s = 0.f;
#pragma unroll
                for (int bj = 0; bj < 2; ++bj)
#pragma unroll
                    for (int n = 0; n < 2; ++n) { const int co = bj * HALF + n * 16; const u32x2 xw = *(const u32x2*)(X2 + xo + co); const u32x2 ew = *(const u32x2*)(E + off + co); const f32x4 a = acc[ai][bj][m][n] * r;
                        f32x4 v; v[0] = bf_lo(xw.x) + sigm(a[0]) * bf_lo(ew.x); v[1] = bf_hi(xw.x) + sigm(a[1]) * bf_hi(ew.x); v[2] = bf_lo(xw.y) + sigm(a[2]) * bf_lo(ew.y); v[3] = bf_hi(xw.y) + sigm(a[3]) * bf_hi(ew.y);
                        s += (v[0] * v[0] + v[1] * v[1]) + (v[2] * v[2] + v[3] * v[3]);
                        *(f32x4*)(OUT + off + co) = v; }
                s = quad_row_sum(s, lane); if (fq == 0) lds_addf(ss + lr, s);
                asm volatile("" ::: "memory"); }
    }
};
}

#define GAS __attribute__((address_space(1)))
#define LAS __attribute__((address_space(3)))
typedef unsigned short bf16;
typedef unsigned v4u __attribute__((ext_vector_type(4)));
typedef float f32x4 __attribute__((ext_vector_type(4)));
typedef short bf16x8 __attribute__((ext_vector_type(8)));
typedef GAS unsigned gu32;
typedef GAS unsigned long long gu64;
#define RLX_AGENT __ATOMIC_RELAXED, __HIP_MEMORY_SCOPE_AGENT
#define LDS_WAIT() asm volatile("s_waitcnt lgkmcnt(0)" ::: "memory")
#define VM_WAIT() asm volatile("s_waitcnt vmcnt(0)" ::: "memory")
__device__ __forceinline__ unsigned long long rt() { return __builtin_amdgcn_s_memrealtime(); }
__device__ __forceinline__ unsigned f2bf(float f) { unsigned u = __builtin_bit_cast(unsigned, f); return (u + 0x7fffu + ((u >> 16) & 1u)) >> 16; }
__device__ __forceinline__ unsigned pk2(float lo, float hi) { return f2bf(lo) | (f2bf(hi) << 16); }

#define XB_TMO      128
#define XB_XCNT(j)  (256  + 64 * (j))
#define XB_XSUB(j)  (1280 + 64 * (j))
#define XB_XGEN(j)  (2304 + 64 * (j))
#define XB_TOP      3328
#define XB_TOPGEN   3392
#define XCD_BAR_WORDS 3456
#define XB_SPIN_CAP (1u << 18)

__device__ __forceinline__ unsigned xb_ld(unsigned* p)              { return __hip_atomic_load(p, __ATOMIC_RELAXED, __HIP_MEMORY_SCOPE_AGENT); }
__device__ __forceinline__ unsigned xb_add(unsigned* p, unsigned v) { return __hip_atomic_fetch_add(p, v, __ATOMIC_RELAXED, __HIP_MEMORY_SCOPE_AGENT); }
__device__ __forceinline__ unsigned xb_xcc_id() { return (unsigned)__builtin_amdgcn_s_getreg((3 << 11) | 20) & 0xFu; }
#define XB_SPIN(cond, bar) do { unsigned _sp = 0; while (cond) { __builtin_amdgcn_s_sleep(1); \
    if ((++_sp & 255u) == 0u) { if (xb_ld(&(bar)[XB_TMO])) break; if (_sp > XB_SPIN_CAP) { atomicAdd(&(bar)[XB_TMO], 1u); break; } } } } while (0)

struct XcdBarrier {
    unsigned* bar; unsigned x;
    volatile LAS unsigned* st;
};

__device__ __forceinline__ XcdBarrier xcd_barrier_post(unsigned* bar, volatile LAS unsigned* st, const bool is_t0) {
    XcdBarrier b; b.bar = bar; b.x = xb_xcc_id(); b.st = st;
    if (is_t0) (void)xb_add(&bar[XB_XCNT(b.x)], 1u);
    return b;
}
__device__ __forceinline__ void xcd_barrier_complete(unsigned* bar, unsigned x, unsigned& nloc, unsigned& nx) {
    const unsigned G = gridDim.x * gridDim.y * gridDim.z;
    unsigned sum, cnt, mine, sp = 0u;
    for (;;) {
        sum = 0u; cnt = 0u; mine = 0u;
#pragma unroll
        for (unsigned j = 0; j < 16; ++j) { const unsigned c = xb_ld(&bar[XB_XCNT(j)]); sum += c; cnt += (c > 0u) ? 1u : 0u; mine = (j == x) ? c : mine; }
        if (sum == G) break;
        __builtin_amdgcn_s_sleep(1);
        if ((++sp & 255u) == 0u) { if (xb_ld(&bar[XB_TMO])) break; if (sp > XB_SPIN_CAP) { atomicAdd(&bar[XB_TMO], 1u); break; } }
    }
    nloc = mine > 0u ? mine : 1u; nx = cnt > 0u ? cnt : 1u;
}

__device__ __forceinline__ void xcd_barrier(const XcdBarrier& b, const bool is_t0) {
    asm volatile("s_waitcnt vmcnt(0)" ::: "memory");
    __syncthreads();
    if (is_t0) {
        unsigned* bar = b.bar;
        __builtin_amdgcn_s_waitcnt(0);
        unsigned nloc = b.st[0], nx = b.st[1];
        if (nloc == 0u) { xcd_barrier_complete(bar, b.x, nloc, nx); b.st[0] = nloc; b.st[1] = nx; }
        const unsigned old = xb_add(&bar[XB_XSUB(b.x)], 1u);
        const unsigned gen = old / nloc;
        if (old + 1u == (gen + 1u) * nloc) {
            __builtin_amdgcn_fence(__ATOMIC_RELEASE, "agent");
            asm volatile("s_waitcnt vmcnt(0)" ::: "memory");
            const unsigned og = xb_add(&bar[XB_TOP], 1u);
            const unsigned tg = og / nx;
            if (og + 1u == (tg + 1u) * nx) xb_add(&bar[XB_TOPGEN], 1u);
            else XB_SPIN(xb_ld(&bar[XB_TOPGEN]) == tg, bar);
            __builtin_amdgcn_fence(__ATOMIC_ACQUIRE, "agent");
            xb_add(&bar[XB_XGEN(b.x)], 1u);
            asm volatile("s_waitcnt vmcnt(0)" ::: "memory");
        } else {
            XB_SPIN(xb_ld(&bar[XB_XGEN(b.x)]) == gen, bar);
            __builtin_amdgcn_fence(__ATOMIC_ACQUIRE, "agent");
            asm volatile("s_waitcnt vmcnt(0)" ::: "memory");
        }
    }
    __syncthreads();
}


constexpr int NWAVES = 8, NTHR = 512;
constexpr int TOK = 65536, DM = 1024, SEQ = 8192, NPANEL = 256;
constexpr float RMS_EPS = 1e-6f;
constexpr float C2 = 0.125f * 1.4426950408889634f;
constexpr float SURV_THR = 5.4210108624275222e-20f;
constexpr size_t MiB = 1u << 20;
constexpr size_t WS_CTL = 0, CTL_ZERO_BYTES = 64 * 1024;
constexpr size_t WS_WIN = 2 * MiB, WS_WOUT = 10 * MiB, WS_WQ = 12 * MiB, WS_WPG = 16 * MiB, WS_WPLE = 18 * MiB;
constexpr size_t WS_BDA = 18 * MiB + 512 * 1024, WS_BDP = 18 * MiB + 768 * 1024, WS_SK = 19 * MiB;
constexpr size_t WS_EU = 32 * MiB, WS_EV = 64 * MiB, WS_SU = 20 * MiB, WS_SV = 20 * MiB + 65536;
constexpr size_t WS_XN = 96 * MiB;
constexpr size_t WS_PQ = 224 * MiB, WS_PK = 288 * MiB, WS_PVT = 352 * MiB, WS_PU = 416 * MiB;
constexpr size_t WS_PG = 480 * MiB;
constexpr size_t WS_YA = 736 * MiB, WS_YP = 800 * MiB;
constexpr size_t WS_MG = 864 * MiB, WS_END = 992 * MiB;
constexpr int CW_BAR = 1024;
constexpr int RING_BYTES = 131072, LDSCTL_OFF = RING_BYTES, MISC_OFF = LDSCTL_OFF + 320, LDS_BYTES = 147456;

typedef float f32x16 __attribute__((ext_vector_type(16)));
typedef float f32x2 __attribute__((ext_vector_type(2)));
typedef __bf16 bf16x2v __attribute__((ext_vector_type(2)));

__device__ __forceinline__ int shx(int v, int m, int lane) { return __builtin_amdgcn_ds_bpermute((lane ^ m) << 2, v); }
__device__ __forceinline__ float shx(float v, int m, int lane) { return __builtin_bit_cast(float, __builtin_amdgcn_ds_bpermute((lane ^ m) << 2, __builtin_bit_cast(int, v))); }
__device__ __forceinline__ float shl_(float v, int src) { return __builtin_bit_cast(float, __builtin_amdgcn_ds_bpermute(src << 2, __builtin_bit_cast(int, v))); }
__device__ __forceinline__ float wave_sum(float v, int lane) {
#pragma unroll
    for (int o = 1; o < 64; o <<= 1) v += shx(v, o, lane);
    return v;
}
__device__ __forceinline__ float bflo(unsigned w) { return __uint_as_float(w << 16); }
__device__ __forceinline__ float bfhi(unsigned w) { return __uint_as_float(w & 0xffff0000u); }
__device__ __forceinline__ unsigned cvtpk(float lo, float hi) { return pg8::cvt_pk_bf16(lo, hi); }

#define H_UNPACK(H, A, B) do { H[0] = bflo(A.x); H[1] = bfhi(A.x); H[2] = bflo(A.y); H[3] = bfhi(A.y); H[4] = bflo(A.z); H[5] = bfhi(A.z); H[6] = bflo(A.w); H[7] = bfhi(A.w); \
        H[8] = bflo(B.x); H[9] = bfhi(B.x); H[10] = bflo(B.y); H[11] = bfhi(B.y); H[12] = bflo(B.z); H[13] = bfhi(B.z); H[14] = bflo(B.w); H[15] = bfhi(B.w); } while (0)
__device__ __forceinline__ void p0_transpose_item(const float* W, int K, int N, bf16* WT, const float* kscale, int nlo, float nls, LAS float* scr, int item, int lane) {
    const int nblk = N / 32, kb = item / nblk, nb = item % nblk, k0 = 64 * kb, n0 = 32 * nb;
    const float ns = (n0 + (lane & 31)) < nlo ? nls : 1.0f;
#pragma unroll 8
    for (int i = 0; i < 32; ++i) { const int kk = 2 * i + (lane >> 5); float v = W[(size_t)(k0 + kk) * N + n0 + (lane & 31)] * ns; if (kscale) v *= kscale[k0 + kk]; scr[kk * 33 + (lane & 31)] = v; }
    LDS_WAIT(); asm volatile("" ::: "memory");
    const int c = lane & 7;
#pragma unroll
    for (int j = 0; j < 4; ++j) { const int n = (lane >> 3) + 8 * j; const LAS float* s = scr + (8 * c) * 33 + n;
        v4u o; o.x = pk2(s[0 * 33], s[1 * 33]); o.y = pk2(s[2 * 33], s[3 * 33]); o.z = pk2(s[4 * 33], s[5 * 33]); o.w = pk2(s[6 * 33], s[7 * 33]);
        *(GAS v4u*)(WT + (size_t)(n0 + n) * K + k0 + 8 * c) = o; }
    LDS_WAIT(); asm volatile("" ::: "memory");
}
__device__ __forceinline__ void rms_row_to_bf16(const float* xrow, bf16* orow, int lane) {
    const GAS f32x4* xr = (const GAS f32x4*)xrow + lane;
    f32x4 v[4]; float s = 0.f;
#pragma unroll
    for (int j = 0; j < 4; ++j) { v[j] = xr[64 * j]; s += (v[j].x * v[j].x + v[j].y * v[j].y) + (v[j].z * v[j].z + v[j].w * v[j].w); }
    const float r = 1.f / sqrtf(wave_sum(s, lane) * (1.f / DM) + RMS_EPS);
    GAS unsigned long long* o8 = (GAS unsigned long long*)orow + lane;
#pragma unroll
    for (int j = 0; j < 4; ++j) o8[64 * j] = (unsigned long long)pk2(v[j].x * r, v[j].y * r) | ((unsigned long long)pk2(v[j].z * r, v[j].w * r) << 32);
}
__device__ __forceinline__ void cvt8_store(const float* src, bf16* dst) {
    const f32x4 a = *(const GAS f32x4*)src, b = *(const GAS f32x4*)(src + 4);
    v4u o; o.x = pk2(a.x, a.y); o.y = pk2(a.z, a.w); o.z = pk2(b.x, b.y); o.w = pk2(b.z, b.w);
    *(GAS v4u*)dst = o;
}

__device__ __forceinline__ void attn_panel(int panel, const bf16* PQ, const bf16* PK, const bf16* PVT, bf16* YA, const int wid0) {
    const int tid = otid(wid0), lane = tid & 63, wid = __builtin_amdgcn_readfirstlane(tid >> 6);
    const int r32 = lane & 31, hh = lane >> 5;
    const size_t seq0 = (size_t)(panel >> 5) * SEQ;
    const int pos0 = (panel & 31) * 256 + wid * 32;
    const int kap = 16 * ((r32 >> 2) & 1) + (r32 & 3) + 4 * (r32 >> 3);
    for (int h = 0; h < 8; ++h) {
        bf16x8 qf[4];
        { const bf16* qrow = PQ + (seq0 + pos0 + r32) * 512 + h * 64 + 8 * hh;
#pragma unroll
          for (int s = 0; s < 4; ++s) qf[s] = *(const GAS bf16x8*)(qrow + 16 * s); }
        f32x16 o0 = {}, o1 = {};
        float Sin = 1.f;
        for (int kb = pos0; kb >= 0; kb -= 32) {
            const bf16* krow = PK + (seq0 + kb + kap) * 512 + h * 64 + 8 * hh;
            const bf16* vrow = PVT + (size_t)(h * 64 + kap) * TOK + seq0 + kb + 16 * hh;
            bf16x8 kf[4], vf[2][2];
#pragma unroll
            for (int s = 0; s < 4; ++s) kf[s] = *(const GAS bf16x8*)(krow + 16 * s);
#pragma unroll
            for (int db = 0; db < 2; ++db)
#pragma unroll
                for (int s = 0; s < 2; ++s) vf[db][s] = *(const GAS bf16x8*)(vrow + (size_t)db * 32 * TOK + 8 * s);
            f32x16 z = {};
#pragma unroll
            for (int s = 0; s < 4; ++s) z = __builtin_amdgcn_mfma_f32_32x32x16_bf16(kf[s], qf[s], z, 0, 0, 0);
            const bool diag = (kb == pos0);
            float w[16]; float Sl = 1.f;
#pragma unroll
            for (int reg = 15; reg >= 0; --reg) {
                float beta = __builtin_amdgcn_rcpf(1.0f + __builtin_amdgcn_exp2f(-z[reg]));
                if (diag && (16 * hh + reg >= r32)) beta = 0.f;
                const float wl = beta * Sl; Sl -= wl; w[reg] = wl;
            }
            const float Pp = shx(Sl, 32, lane);
            const float scale = hh ? Sin : Sin * Pp;
            Sin = Sin * Sl * Pp;
            v4u pw0, pw1;
            pw0.x = cvtpk(w[0] * scale, w[1] * scale); pw0.y = cvtpk(w[2] * scale, w[3] * scale); pw0.z = cvtpk(w[4] * scale, w[5] * scale); pw0.w = cvtpk(w[6] * scale, w[7] * scale);
            pw1.x = cvtpk(w[8] * scale, w[9] * scale); pw1.y = cvtpk(w[10] * scale, w[11] * scale); pw1.z = cvtpk(w[12] * scale, w[13] * scale); pw1.w = cvtpk(w[14] * scale, w[15] * scale);
            const bf16x8 p0 = __builtin_bit_cast(bf16x8, pw0), p1 = __builtin_bit_cast(bf16x8, pw1);
            o0 = __builtin_amdgcn_mfma_f32_32x32x16_bf16(vf[0][0], p0, o0, 0, 0, 0);
            o0 = __builtin_amdgcn_mfma_f32_32x32x16_bf16(vf[0][1], p1, o0, 0, 0, 0);
            o1 = __builtin_amdgcn_mfma_f32_32x32x16_bf16(vf[1][0], p0, o1, 0, 0, 0);
            o1 = __builtin_amdgcn_mfma_f32_32x32x16_bf16(vf[1][1], p1, o1, 0, 0, 0);
            if (__all(Sin < SURV_THR)) break;
        }
        bf16* orow = YA + (seq0 + pos0 + r32) * 512 + h * 64 + 16 * hh;
        v4u a, b2;
        a.x = cvtpk(o0[0], o0[1]); a.y = cvtpk(o0[2], o0[3]); a.z = cvtpk(o0[4], o0[5]); a.w = cvtpk(o0[6], o0[7]);
        b2.x = cvtpk(o0[8], o0[9]); b2.y = cvtpk(o0[10], o0[11]); b2.z = cvtpk(o0[12], o0[13]); b2.w = cvtpk(o0[14], o0[15]);
        *(GAS v4u*)orow = a; *(GAS v4u*)(orow + 8) = b2;
        a.x = cvtpk(o1[0], o1[1]); a.y = cvtpk(o1[2], o1[3]); a.z = cvtpk(o1[4], o1[5]); a.w = cvtpk(o1[6], o1[7]);
        b2.x = cvtpk(o1[8], o1[9]); b2.y = cvtpk(o1[10], o1[11]); b2.z = cvtpk(o1[12], o1[13]); b2.w = cvtpk(o1[14], o1[15]);
        *(GAS v4u*)(orow + 32) = a; *(GAS v4u*)(orow + 40) = b2;
    }
}

__device__ __forceinline__ void pool_panel(int panel, const bf16* PU, bf16* YP, const int wid0) {
    const int tid = otid(wid0);
    const int chunk = tid & 63, tg = tid >> 6, w = 2 << (chunk >> 4);
    const int posb = (panel & 31) * 256; const size_t row0 = (size_t)panel * 256;
    for (int i = 0; i < 32; ++i) {
        const int t = tg * 32 + i, pos = posb + t, cnt = (pos + 1 < w) ? (pos + 1) : w;
        float s[8];
#pragma unroll
        for (int k = 0; k < 8; ++k) s[k] = 0.f;
        v4u cur = {0u, 0u, 0u, 0u};
        for (int j = 0; j < cnt; ++j) {
            const v4u v = *(const GAS v4u*)(PU + (row0 + t - j) * 512 + chunk * 8);
            if (j == 0) cur = v;
            s[0] += bflo(v.x); s[1] += bfhi(v.x); s[2] += bflo(v.y); s[3] += bfhi(v.y); s[4] += bflo(v.z); s[5] += bfhi(v.z); s[6] += bflo(v.w); s[7] += bfhi(v.w);
        }
        const float ic = 1.0f / (float)cnt;
        v4u o;
        o.x = cvtpk(s[0] * ic - bflo(cur.x), s[1] * ic - bfhi(cur.x)); o.y = cvtpk(s[2] * ic - bflo(cur.y), s[3] * ic - bfhi(cur.y));
        o.z = cvtpk(s[4] * ic - bflo(cur.z), s[5] * ic - bfhi(cur.z)); o.w = cvtpk(s[6] * ic - bflo(cur.w), s[7] * ic - bfhi(cur.w));
        *(GAS v4u*)(YP + (row0 + t) * 512 + chunk * 8) = o;
    }
}

#define HD __host__ __device__ __forceinline__
HD int f2s(float f) { int i = __builtin_bit_cast(int, f); return i ^ ((i >> 31) & 0x7fffffff); }
HD float s2f(int i) { i ^= ((i >> 31) & 0x7fffffff); return __builtin_bit_cast(float, i); }
HD void ce_desc(int& a, int& b) { const int mx = a > b ? a : b, mn = a > b ? b : a; a = mx; b = mn; }
template <int J, int K> HD void bpass16(int (&v)[16]) {
#pragma unroll
    for (int i = 0; i < 16; ++i) { const int l = i ^ J; if (l > i) { if ((i & K) == 0) ce_desc(v[i], v[l]); else ce_desc(v[l], v[i]); } }
}
HD void bitonic_sort16_desc(int (&v)[16]) {
    bpass16<1, 2>(v); bpass16<2, 4>(v); bpass16<1, 4>(v); bpass16<4, 8>(v); bpass16<2, 8>(v); bpass16<1, 8>(v);
    bpass16<8, 16>(v); bpass16<4, 16>(v); bpass16<2, 16>(v); bpass16<1, 16>(v);
}
HD void bitonic_merge16_desc(int (&v)[16]) {
    bpass16<8, 16>(v); bpass16<4, 16>(v); bpass16<2, 16>(v); bpass16<1, 16>(v);
}
HD void merge_prune16(int (&x)[16], const int (&y)[16]) {
#pragma unroll
    for (int i = 0; i < 16; ++i) x[i] = x[i] > y[15 - i] ? x[i] : y[15 - i];
    bitonic_merge16_desc(x);
}
HD int cx_i(int hf, int t) { if (hf == 0) return 0; return t < 5 ? 2 : t < 9 ? 3 : t < 12 ? 4 : t < 14 ? 5 : 6; }
HD int cx_j(int hf, int t) { if (hf == 0) return t; return t < 5 ? t : t < 9 ? t - 5 : t < 12 ? t - 9 : t < 14 ? t - 12 : t - 14; }
HD int cy_i(int hf, int t) { if (hf == 0) return t < 8 ? 1 : 23 - t; return 7; }
HD int cy_j(int hf, int t) { if (hf == 0) return t < 8 ? t : 0; return t; }

__device__ __forceinline__ void top16_of_group(const bf16x8 (&qf)[8], LAS const unsigned char* skl, int r32, int hh, int lane, int (&res)[16]) {
    int v[4][16];
#pragma unroll
    for (int kb = 0; kb < 4; ++kb) {
        f32x16 acc = {};
#pragma unroll
        for (int s = 0; s < 8; ++s) { const bf16x8 af = *(LAS const bf16x8*)(skl + (32 * kb + r32) * 272 + 32 * s + 16 * hh); acc = __builtin_amdgcn_mfma_f32_32x32x16_bf16(af, qf[s], acc, 0, 0, 0); }
#pragma unroll
        for (int reg = 0; reg < 16; ++reg) { const int keyid = 32 * kb + (reg & 3) + 8 * (reg >> 2) + 4 * hh; v[kb][reg] = (f2s(acc[reg]) & ~127) | keyid; }
    }
    bitonic_sort16_desc(v[0]); bitonic_sort16_desc(v[1]); bitonic_sort16_desc(v[2]); bitonic_sort16_desc(v[3]);
    merge_prune16(v[0], v[1]); merge_prune16(v[2], v[3]); merge_prune16(v[0], v[2]);
    int y[16];
#pragma unroll
    for (int i = 0; i < 16; ++i) y[i] = shx(v[0][i], 32, lane);
    merge_prune16(v[0], y);
#pragma unroll
    for (int i = 0; i < 16; ++i) res[i] = v[0][i];
}

__device__ __forceinline__ void topk_panel(int panel, const bf16* QP, const bf16* SK, int* IDXp, float* GTp  , LAS unsigned char* ldsb  , const int wid0) {
    const int tid = otid(wid0), lane = tid & 63, wid = __builtin_amdgcn_readfirstlane(tid >> 6);
    const int r32 = lane & 31, hh = lane >> 5;
    const int lrow = wid * 32 + r32;
    const size_t row = (size_t)panel * 256 + lrow;
    LAS int* lut = (LAS int*)ldsb; LAS unsigned char* skl = ldsb + 65536;
    v4u skr[4];
#define SK_FETCH(g_) do { _Pragma("unroll") for (int i = 0; i < 4; ++i) skr[i] = *((const GAS v4u*)(SK + (size_t)(g_) * 128 * 128) + i * 512 + tid); } while (0)
#define SK_STAGE() do { _Pragma("unroll") for (int i = 0; i < 4; ++i) { const int p = i * 512 + tid; *(LAS v4u*)(skl + (p >> 4) * 272 + (p & 15) * 16) = skr[i]; } } while (0)
    bf16x8 qn[8];
#define Q_FETCH(g_) do { const bf16* qrow_ = QP + row * 2048 + (g_) * 128 + 8 * hh; _Pragma("unroll") for (int s = 0; s < 8; ++s) qn[s] = *(const GAS bf16x8*)(qrow_ + 16 * s); } while (0)
    SK_FETCH(0); Q_FETCH(0);
    for (int h = 0; h < 8; ++h) {
        int a[16], b[16];
#pragma unroll
        for (int c = 0; c < 2; ++c) {
            const int g = 2 * h + c;
            bf16x8 qf[8];
#pragma unroll
            for (int s = 0; s < 8; ++s) qf[s] = qn[s];
            __syncthreads();
            SK_STAGE();
            __syncthreads();
            if (g < 15) { SK_FETCH(g + 1); Q_FETCH(g + 1); }
            if (c == 0) top16_of_group(qf, skl, r32, hh, lane, a); else top16_of_group(qf, skl, r32, hh, lane, b);
        }
        float fa[16], fb[16];
#pragma unroll
        for (int i = 0; i < 16; ++i) { fa[i] = s2f(a[i] & ~127); fb[i] = s2f(b[i] & ~127); lut[i * 512 + tid] = a[i] & 127; lut[(16 + i) * 512 + tid] = b[i] & 127; }
        int X[16], Y[16];
#pragma unroll
        for (int t = 0; t < 16; ++t) {
            const float s0 = fa[cx_i(0, t)] + fb[cx_j(0, t)], s1 = fa[cx_i(1, t)] + fb[cx_j(1, t)];
            const int c0 = cx_i(0, t) * 16 + cx_j(0, t), c1 = cx_i(1, t) * 16 + cx_j(1, t);
            X[t] = hh ? ((f2s(s1) & ~255) | c1) : ((f2s(s0) & ~255) | c0);
            const float u0 = fa[cy_i(0, t)] + fb[cy_j(0, t)];
            const int d0 = cy_i(0, t) * 16 + cy_j(0, t);
            int y1 = (int)0x80000000;
            if (t < 2) { const float u1 = fa[cy_i(1, t)] + fb[cy_j(1, t)]; y1 = (f2s(u1) & ~255) | (cy_i(1, t) * 16 + cy_j(1, t)); }
            Y[t] = hh ? y1 : ((f2s(u0) & ~255) | d0);
        }
        bitonic_sort16_desc(X); bitonic_merge16_desc(Y); merge_prune16(X, Y);
#pragma unroll
        for (int i = 0; i < 16; ++i) Y[i] = shx(X[i], 32, lane);
        merge_prune16(X, Y);
        const float mx = s2f(X[0] & ~255);
        float ex[16], den = 0.f;
#pragma unroll
        for (int i = 0; i < 16; ++i) { ex[i] = __builtin_amdgcn_exp2f((s2f(X[i] & ~255) - mx) * 1.4426950408889634f); den += ex[i]; }
        const float rden = 1.0f / den;
        int oi[8]; float og[8];
#pragma unroll
        for (int t = 0; t < 8; ++t) {
            const int msk = -hh;
            const int code = (X[t] ^ ((X[t] ^ X[8 + t]) & msk)) & 255;
            const int e1 = lut[(code >> 4) * 512 + tid], e2 = lut[(16 + (code & 15)) * 512 + tid];
            const int exl = __builtin_bit_cast(int, ex[t]), exh = __builtin_bit_cast(int, ex[8 + t]);
            oi[t] = e1 * 128 + e2; og[t] = __builtin_bit_cast(float, exl ^ ((exl ^ exh) & msk)) * rden;
        }
        int* ip = IDXp + lrow * 128 + h * 16 + 8 * hh; float* gp = GTp + lrow * 128 + h * 16 + 8 * hh;
        *(GAS v4u*)ip = (v4u){(unsigned)oi[0], (unsigned)oi[1], (unsigned)oi[2], (unsigned)oi[3]}; *(GAS v4u*)(ip + 4) = (v4u){(unsigned)oi[4], (unsigned)oi[5], (unsigned)oi[6], (unsigned)oi[7]};
        *(GAS f32x4*)gp = (f32x4){og[0], og[1], og[2], og[3]}; *(GAS f32x4*)(gp + 4) = (f32x4){og[4], og[5], og[6], og[7]};
    }
#undef SK_FETCH
#undef SK_STAGE
#undef Q_FETCH
}

typedef float f32x2v __attribute__((ext_vector_type(2)));
__device__ __forceinline__ void quant_row_fp8(const float* src, const float* colgain, unsigned char* dst, float* sc_out, int lane) {
    const GAS f32x4* s = (const GAS f32x4*)src + 4 * lane;
    f32x4 v[4]; float m = 0.f;
#pragma unroll
    for (int j = 0; j < 4; ++j) { v[j] = s[j]; if (colgain) v[j] = v[j] * ((const GAS f32x4*)colgain + 4 * lane)[j]; m = fmaxf(m, fmaxf(fmaxf(fabsf(v[j].x), fabsf(v[j].y)), fmaxf(fabsf(v[j].z), fabsf(v[j].w)))); }
#pragma unroll
    for (int o = 1; o < 64; o <<= 1) m = fmaxf(m, shx(m, o, lane));
    const float sc = m > 0.f ? 224.0f / m : 1.0f;
    v4u w;
    { int t = 0; t = __builtin_amdgcn_cvt_pk_fp8_f32(v[0].x * sc, v[0].y * sc, t, false); t = __builtin_amdgcn_cvt_pk_fp8_f32(v[0].z * sc, v[0].w * sc, t, true); w.x = (unsigned)t; }
    { int t = 0; t = __builtin_amdgcn_cvt_pk_fp8_f32(v[1].x * sc, v[1].y * sc, t, false); t = __builtin_amdgcn_cvt_pk_fp8_f32(v[1].z * sc, v[1].w * sc, t, true); w.y = (unsigned)t; }
    { int t = 0; t = __builtin_amdgcn_cvt_pk_fp8_f32(v[2].x * sc, v[2].y * sc, t, false); t = __builtin_amdgcn_cvt_pk_fp8_f32(v[2].z * sc, v[2].w * sc, t, true); w.z = (unsigned)t; }
    { int t = 0; t = __builtin_amdgcn_cvt_pk_fp8_f32(v[3].x * sc, v[3].y * sc, t, false); t = __builtin_amdgcn_cvt_pk_fp8_f32(v[3].z * sc, v[3].w * sc, t, true); w.w = (unsigned)t; }
    *(GAS v4u*)(dst + 16 * lane) = w;
    if (lane == 0) *sc_out = m > 0.f ? m * (1.0f / 224.0f) : 1.0f;
}
__device__ __forceinline__ void dq4(unsigned w, float (&f)[4]) {
    const f32x2v lo = __builtin_amdgcn_cvt_pk_f32_fp8((int)w, false), hi = __builtin_amdgcn_cvt_pk_f32_fp8((int)w, true);
    f[0] = lo.x; f[1] = lo.y; f[2] = hi.x; f[3] = hi.y;
}
__device__ __forceinline__ float dot16_fp8(const v4u u, const float (&h)[16]) {
    const f32x2v x0 = __builtin_amdgcn_cvt_pk_f32_fp8((int)u.x, false), x1 = __builtin_amdgcn_cvt_pk_f32_fp8((int)u.x, true);
    const f32x2v y0 = __builtin_amdgcn_cvt_pk_f32_fp8((int)u.y, false), y1 = __builtin_amdgcn_cvt_pk_f32_fp8((int)u.y, true);
    const f32x2v z0 = __builtin_amdgcn_cvt_pk_f32_fp8((int)u.z, false), z1 = __builtin_amdgcn_cvt_pk_f32_fp8((int)u.z, true);
    const f32x2v w0 = __builtin_amdgcn_cvt_pk_f32_fp8((int)u.w, false), w1 = __builtin_amdgcn_cvt_pk_f32_fp8((int)u.w, true);
    f32x2v a = x0 * (f32x2v){h[0], h[1]}, b = x1 * (f32x2v){h[2], h[3]};
    a = __builtin_elementwise_fma(y0, (f32x2v){h[4], h[5]}, a); b = __builtin_elementwise_fma(y1, (f32x2v){h[6], h[7]}, b);
    a = __builtin_elementwise_fma(z0, (f32x2v){h[8], h[9]}, a); b = __builtin_elementwise_fma(z1, (f32x2v){h[10], h[11]}, b);
    a = __builtin_elementwise_fma(w0, (f32x2v){h[12], h[13]}, a); b = __builtin_elementwise_fma(w1, (f32x2v){h[14], h[15]}, b);
    const f32x2v s = a + b;
    return s.x + s.y;
}
__device__ __forceinline__ void fma16_fp8(float (&o)[16], float cf, const v4u v) {
    float f0[4], f1[4], f2[4], f3[4]; dq4(v.x, f0); dq4(v.y, f1); dq4(v.z, f2); dq4(v.w, f3);
#pragma unroll
    for (int k = 0; k < 4; ++k) { o[k] = fmaf(cf, f0[k], o[k]); o[4 + k] = fmaf(cf, f1[k], o[4 + k]); o[8 + k] = fmaf(cf, f2[k], o[8 + k]); o[12 + k] = fmaf(cf, f3[k], o[12 + k]); }
}
#define RS_LEVEL(v, n, m) do { _Pragma("unroll") for (int _e = 0; _e < (n); ++_e) { const bool _up = (lane & (m)) != 0; const float _send = _up ? v[_e] : v[_e + (n)]; const float _keep = _up ? v[_e + (n)] : v[_e]; v[_e] = _keep + shx(_send, m, lane); } } while (0)
__device__ __forceinline__ void peer_panel(int panel, bf16* XN, const int* IDXp, const float* GTp, const unsigned char* EU8, const unsigned char* EV8, const float* SU, const float* SV, float* XIO, const int wid0) {
    const int tid = otid(wid0), lane = tid & 63, wid = __builtin_amdgcn_readfirstlane(tid >> 6);
    for (int ti = 0; ti < 32; ++ti) {
        const int lrow = wid * 32 + ti;
        const size_t row = (size_t)panel * 256 + lrow;
        const int i0 = IDXp[lrow * 128 + lane], i1 = IDXp[lrow * 128 + 64 + lane];
        const float g0 = GTp[lrow * 128 + lane], g1 = GTp[lrow * 128 + 64 + lane];
        const float su0 = SU[i0], su1 = SU[i1], sv0 = SV[i0], sv1 = SV[i1];
        float h[16];
        { const v4u hA = *(const GAS v4u*)(XN + row * DM + 16 * lane), hB = *(const GAS v4u*)(XN + row * DM + 16 * lane + 8);
          h[0] = bflo(hA.x); h[1] = bfhi(hA.x); h[2] = bflo(hA.y); h[3] = bfhi(hA.y); h[4] = bflo(hA.z); h[5] = bfhi(hA.z); h[6] = bflo(hA.w); h[7] = bfhi(hA.w);
          h[8] = bflo(hB.x); h[9] = bfhi(hB.x); h[10] = bflo(hB.y); h[11] = bfhi(hB.y); h[12] = bflo(hB.z); h[13] = bfhi(hB.z); h[14] = bflo(hB.w); h[15] = bfhi(hB.w); }
        float coef[2];
#pragma unroll
        for (int hf = 0; hf < 2; ++hf) {
            const int iv = hf ? i1 : i0;
            float q[4];
#pragma unroll
            for (int k = 0; k < 4; ++k) q[k] = 0.f;
#pragma unroll
            for (int c = 0; c < 4; ++c) {
                v4u ua[16];
#pragma unroll
                for (int j = 0; j < 16; ++j) { const int ex = __builtin_amdgcn_readlane(iv, c * 16 + j); ua[j] = *((const GAS v4u*)(EU8 + (size_t)ex * DM) + lane); }
                float p[16];
#pragma unroll
                for (int j = 0; j < 16; ++j) p[j] = dot16_fp8(ua[j], h);
                RS_LEVEL(p, 8, 8); RS_LEVEL(p, 4, 4); RS_LEVEL(p, 2, 2); RS_LEVEL(p, 1, 1);
                q[c] = p[0];
            }
            RS_LEVEL(q, 2, 32); RS_LEVEL(q, 1, 16);
            const float s = q[0] * (hf ? su1 : su0);
            const float act = 0.5f * s * (1.0f + erff(s * 0.70710678118654752f));
            coef[hf] = (hf ? g1 : g0) * act * (hf ? sv1 : sv0);
        }
        float o[16];
        { const GAS f32x4* xp = (const GAS f32x4*)(XIO + row * DM + 16 * lane);
#pragma unroll
          for (int k = 0; k < 4; ++k) { const f32x4 x = xp[k]; o[4 * k] = x.x; o[4 * k + 1] = x.y; o[4 * k + 2] = x.z; o[4 * k + 3] = x.w; } }
#pragma unroll
        for (int hf = 0; hf < 2; ++hf) {
            const int iv = hf ? i1 : i0; const float cv = coef[hf];
#pragma unroll
            for (int c = 0; c < 4; ++c) {
                v4u va[16];
#pragma unroll
                for (int j = 0; j < 16; ++j) { const int ex = __builtin_amdgcn_readlane(iv, c * 16 + j); va[j] = *((const GAS v4u*)(EV8 + (size_t)ex * DM) + lane); }
#pragma unroll
                for (int j = 0; j < 16; ++j) { const float cf = __builtin_bit_cast(float, __builtin_amdgcn_readlane(__builtin_bit_cast(int, cv), c * 16 + j)); fma16_fp8(o, cf, va[j]); }
            }
        }
        float ss = 0.f;
#pragma unroll
        for (int k = 0; k < 16; ++k) ss += o[k] * o[k];
        const float r = 1.f / sqrtf(wave_sum(ss, lane) * (1.f / DM) + RMS_EPS);
        { GAS f32x4* xp = (GAS f32x4*)(XIO + row * DM + 16 * lane);
#pragma unroll
          for (int k = 0; k < 4; ++k) xp[k] = (f32x4){o[4 * k], o[4 * k + 1], o[4 * k + 2], o[4 * k + 3]}; }
        v4u ha, hb;
        ha.x = cvtpk(o[0] * r, o[1] * r); ha.y = cvtpk(o[2] * r, o[3] * r); ha.z = cvtpk(o[4] * r, o[5] * r); ha.w = cvtpk(o[6] * r, o[7] * r);
        hb.x = cvtpk(o[8] * r, o[9] * r); hb.y = cvtpk(o[10] * r, o[11] * r); hb.z = cvtpk(o[12] * r, o[13] * r); hb.w = cvtpk(o[14] * r, o[15] * r);
        *(GAS v4u*)(XN + row * DM + 16 * lane) = ha; *(GAS v4u*)(XN + row * DM + 16 * lane + 8) = hb;
    }
}

#define BS_STAGE(K, J) do { const bool lower_ = (lane & (J)) == 0; \
    { const int p_ = shx(k0, J, lane); const bool asc_ = ((lane & (K)) == 0); const int mn_ = k0 < p_ ? k0 : p_, mx_ = k0 < p_ ? p_ : k0; k0 = (lower_ == asc_) ? mn_ : mx_; } \
    { const int p_ = shx(k1, J, lane); const bool asc_ = (((lane + 64) & (K)) == 0); const int mn_ = k1 < p_ ? k1 : p_, mx_ = k1 < p_ ? p_ : k1; k1 = (lower_ == asc_) ? mn_ : mx_; } } while (0)
#ifndef PEER_BSHIFT
#define PEER_BSHIFT 11
#endif
constexpr int PEER_NB = 16384 >> PEER_BSHIFT;
__device__ __forceinline__ void peer_sort_panel(int* IDXp, float* GTp, float* SUp, unsigned char* STp, const float* SU, const float* SV, const int wid0) {
    const int tid = otid(wid0), lane = tid & 63, wid = __builtin_amdgcn_readfirstlane(tid >> 6);
    int ni0 = IDXp[wid * 32 * 128 + lane], ni1 = IDXp[wid * 32 * 128 + 64 + lane];
    float ng0 = GTp[wid * 32 * 128 + lane], ng1 = GTp[wid * 32 * 128 + 64 + lane];
    for (int ti = 0; ti < 32; ++ti) {
        const int lrow = wid * 32 + ti;
        const int i0 = ni0, i1 = ni1; const float g0 = ng0, g1 = ng1;
        if (ti < 31) { ni0 = IDXp[(lrow + 1) * 128 + lane]; ni1 = IDXp[(lrow + 1) * 128 + 64 + lane]; ng0 = GTp[(lrow + 1) * 128 + lane]; ng1 = GTp[(lrow + 1) * 128 + 64 + lane]; }
        const float u0 = SU[i0], u1 = SU[i1], w0 = SV[i0] * g0, w1 = SV[i1] * g1;
        int k0 = (i0 << 7) | lane, k1 = (i1 << 7) | (64 + lane);
        BS_STAGE(2, 1);
        BS_STAGE(4, 2); BS_STAGE(4, 1);
        BS_STAGE(8, 4); BS_STAGE(8, 2); BS_STAGE(8, 1);
        BS_STAGE(16, 8); BS_STAGE(16, 4); BS_STAGE(16, 2); BS_STAGE(16, 1);
        BS_STAGE(32, 16); BS_STAGE(32, 8); BS_STAGE(32, 4); BS_STAGE(32, 2); BS_STAGE(32, 1);
        BS_STAGE(64, 32); BS_STAGE(64, 16); BS_STAGE(64, 8); BS_STAGE(64, 4); BS_STAGE(64, 2); BS_STAGE(64, 1);
        { const int mn_ = k0 < k1 ? k0 : k1, mx_ = k0 < k1 ? k1 : k0; k0 = mn_; k1 = mx_; }
        BS_STAGE(128, 32); BS_STAGE(128, 16); BS_STAGE(128, 8); BS_STAGE(128, 4); BS_STAGE(128, 2); BS_STAGE(128, 1);
        const int s0 = k0 & 127, s1 = k1 & 127, e0 = k0 >> 7, e1 = k1 >> 7;
        const float ua0 = shl_(u0, s0 & 63), ub0 = shl_(u1, s0 & 63), ua1 = shl_(u0, s1 & 63), ub1 = shl_(u1, s1 & 63);
        const float wa0 = shl_(w0, s0 & 63), wb0 = shl_(w1, s0 & 63), wa1 = shl_(w0, s1 & 63), wb1 = shl_(w1, s1 & 63);
        IDXp[lrow * 128 + lane] = e0; IDXp[lrow * 128 + 64 + lane] = e1;
        SUp[lrow * 128 + lane] = (s0 < 64) ? ua0 : ub0; SUp[lrow * 128 + 64 + lane] = (s1 < 64) ? ua1 : ub1;
        GTp[lrow * 128 + lane] = (s0 < 64) ? wa0 : wb0; GTp[lrow * 128 + 64 + lane] = (s1 < 64) ? wa1 : wb1;
        int stv = 0;
#pragma unroll
        for (int r = 1; r < PEER_NB; ++r) { const int c = __builtin_popcountll(__ballot(e0 < (r << PEER_BSHIFT))) + __builtin_popcountll(__ballot(e1 < (r << PEER_BSHIFT))); stv = (lane == r) ? c : stv; }
        stv = (lane == PEER_NB) ? 128 : stv;
        if (lane < 32) STp[lrow * 32 + lane] = (unsigned char)stv;
    }
}
#ifndef PEER_RDV
#define PEER_RDV 0
#endif
constexpr int CW_XSYNC = 8192;
__device__ __forceinline__ void xcc_rendezvous(unsigned* ctlw, volatile LAS unsigned* st, unsigned k, const int wid0) {
    __syncthreads();
    if (otid(wid0) == 0) {
        const unsigned nloc = st[0] ? st[0] : 1u; unsigned* c = ctlw + CW_XSYNC + 64 * xb_xcc_id();
        xb_add(c, 1u); const unsigned want = (k + 1u) * nloc; unsigned sp = 0;
        while (xb_ld(c) < want) { __builtin_amdgcn_s_sleep(1); if (++sp > 4000u) break; }
    }
    __syncthreads();
}

__device__ __forceinline__ void peer_usweep_panel(int panel, const bf16* X1B  , LAS const float* r1, const int* IDXp, const float* GMp, const float* SUp, float* CFp, const unsigned char* EU8, unsigned* ctlw, volatile LAS unsigned* st, const int wid0) {
    const int tid = otid(wid0), lane = tid & 63, wid = __builtin_amdgcn_readfirstlane(tid >> 6);
    const int tq = (lane >> 3) & 1, pj = lane & 7;
    int ix_n; float gm_n, su_n; v4u hA0_n, hB0_n, hA1_n, hB1_n;
#define US_META(s_) do { const int c_ = (s_) >> 4, tp_ = (s_) & 15; const int lr_ = wid * 32 + 2 * tp_; const int off_ = (lr_ + tq) * 128 + 8 * c_ + pj; \
        ix_n = IDXp[off_]; gm_n = GMp[off_]; su_n = SUp[off_] * r1[lr_ + tq]; \
        const bf16* h0_ = X1B + (size_t)lr_ * DM + 16 * lane; hA0_n = *(const GAS v4u*)h0_; hB0_n = *(const GAS v4u*)(h0_ + 8); hA1_n = *(const GAS v4u*)(h0_ + DM); hB1_n = *(const GAS v4u*)(h0_ + DM + 8); } while (0)
    US_META(0);
    for (int s = 0; s < 256; ++s) {
#if PEER_RDV
        if ((s & 15) == 0) xcc_rendezvous(ctlw, st, (unsigned)(s >> 4), wid0);
#endif
        const int ix = ix_n; const float gm = gm_n, su = su_n; const v4u hA0 = hA0_n, hB0 = hB0_n, hA1 = hA1_n, hB1 = hB1_n;
        v4u ua[16];
#pragma unroll
        for (int j = 0; j < 16; ++j) { const int ex = __builtin_amdgcn_readlane(ix, j); ua[j] = *((const GAS v4u*)(EU8 + (size_t)ex * DM) + lane); }
        if (s < 255) US_META(s + 1);
        float h[16], p[16];
        h[0] = bflo(hA0.x); h[1] = bfhi(hA0.x); h[2] = bflo(hA0.y); h[3] = bfhi(hA0.y); h[4] = bflo(hA0.z); h[5] = bfhi(hA0.z); h[6] = bflo(hA0.w); h[7] = bfhi(hA0.w);
        h[8] = bflo(hB0.x); h[9] = bfhi(hB0.x); h[10] = bflo(hB0.y); h[11] = bfhi(hB0.y); h[12] = bflo(hB0.z); h[13] = bfhi(hB0.z); h[14] = bflo(hB0.w); h[15] = bfhi(hB0.w);
#pragma unroll
        for (int j = 0; j < 8; ++j) p[j] = dot16_fp8(ua[j], h);
        h[0] = bflo(hA1.x); h[1] = bfhi(hA1.x); h[2] = bflo(hA1.y); h[3] = bfhi(hA1.y); h[4] = bflo(hA1.z); h[5] = bfhi(hA1.z); h[6] = bflo(hA1.w); h[7] = bfhi(hA1.w);
        h[8] = bflo(hB1.x); h[9] = bfhi(hB1.x); h[10] = bflo(hB1.y); h[11] = bfhi(hB1.y); h[12] = bflo(hB1.z); h[13] = bfhi(hB1.z); h[14] = bflo(hB1.w); h[15] = bfhi(hB1.w);
#pragma unroll
        for (int j = 8; j < 16; ++j) p[j] = dot16_fp8(ua[j], h);
        RS_LEVEL(p, 8, 8); RS_LEVEL(p, 4, 4); RS_LEVEL(p, 2, 2); RS_LEVEL(p, 1, 1);
        float d = p[0]; d += shx(d, 16, lane); d += shx(d, 32, lane);
        const float sx = d * su;
        const float act = 0.5f * sx * (1.0f + erff(sx * 0.70710678118654752f));
        const int c = s >> 4, tp = s & 15;
        if (lane < 16) CFp[(wid * 32 + 2 * tp + tq) * 128 + 8 * c + pj] = gm * act;
    }
#undef US_META
}
__device__ __forceinline__ void peer_v_panel(int panel, bf16* XN, const int* IDXp, const float* CFp, const unsigned char* EV8, float* XIO, const int wid0) {
    const int tid = otid(wid0), lane = tid & 63, wid = __builtin_amdgcn_readfirstlane(tid >> 6);
    for (int ti = 0; ti < 32; ++ti) {
        const int lrow = wid * 32 + ti;
        const size_t row = (size_t)panel * 256 + lrow;
        const int i0 = IDXp[lrow * 128 + lane], i1 = IDXp[lrow * 128 + 64 + lane];
        const float c0 = CFp[lrow * 128 + lane], c1 = CFp[lrow * 128 + 64 + lane];
        float o[16];
        { const GAS f32x4* xp = (const GAS f32x4*)(XIO + row * DM + 16 * lane);
#pragma unroll
          for (int k = 0; k < 4; ++k) { const f32x4 x = xp[k]; o[4 * k] = x.x; o[4 * k + 1] = x.y; o[4 * k + 2] = x.z; o[4 * k + 3] = x.w; } }
#pragma unroll
        for (int hf = 0; hf < 2; ++hf) {
            const int iv = hf ? i1 : i0; const float cv = hf ? c1 : c0;
#pragma nounroll
            for (int c = 0; c < 4; ++c) {
                v4u va[16];
#pragma unroll
                for (int j = 0; j < 16; ++j) { const int ex = __builtin_amdgcn_readlane(iv, c * 16 + j); va[j] = *((const GAS v4u*)(EV8 + (size_t)ex * DM) + lane); }
#pragma unroll
                for (int j = 0; j < 16; ++j) { const float cf = __builtin_bit_cast(float, __builtin_amdgcn_readlane(__builtin_bit_cast(int, cv), c * 16 + j)); fma16_fp8(o, cf, va[j]); }
            }
        }
        float ss = 0.f;
#pragma unroll
        for (int k = 0; k < 16; ++k) ss += o[k] * o[k];
        const float r = 1.f / sqrtf(wave_sum(ss, lane) * (1.f / DM) + RMS_EPS);
        { GAS f32x4* xp = (GAS f32x4*)(XIO + row * DM + 16 * lane);
#pragma unroll
          for (int k = 0; k < 4; ++k) xp[k] = (f32x4){o[4 * k], o[4 * k + 1], o[4 * k + 2], o[4 * k + 3]}; }
        v4u ha, hb;
        ha.x = cvtpk(o[0] * r, o[1] * r); ha.y = cvtpk(o[2] * r, o[3] * r); ha.z = cvtpk(o[4] * r, o[5] * r); ha.w = cvtpk(o[6] * r, o[7] * r);
        hb.x = cvtpk(o[8] * r, o[9] * r); hb.y = cvtpk(o[10] * r, o[11] * r); hb.z = cvtpk(o[12] * r, o[13] * r); hb.w = cvtpk(o[14] * r, o[15] * r);
        *(GAS v4u*)(XN + row * DM + 16 * lane) = ha; *(GAS v4u*)(XN + row * DM + 16 * lane + 8) = hb;
    }
}

__device__ __forceinline__ void peer_vsweep_panel(int panel, const bf16* X1B, bf16* X2B  , LAS float* r3, const int* IDXp, const float* CFp, const unsigned char* EV8, const int wid0) {
    const int wid = wid0;
#pragma nounroll
    for (int g = 0; g < 4; ++g) {
        const int lane = lane_id();
        const int lr0 = wid * 32 + 8 * g;
        float o[8][16];
#pragma unroll
        for (int t = 0; t < 8; ++t) { const bf16* xp = X1B + (size_t)(lr0 + t) * DM + 16 * lane; const v4u a = *(const GAS v4u*)xp, b2 = *(const GAS v4u*)(xp + 8); H_UNPACK(o[t], a, b2); }
        const int moff = (lr0 + (lane >> 3)) * 128 + (lane & 7);
        int ix_n = IDXp[moff]; float cf_n = CFp[moff];
#pragma nounroll
        for (int c = 0; c < 16; ++c) {
            const int ix = ix_n; const float cf = cf_n;
            if (c < 15) { ix_n = IDXp[moff + 8 * (c + 1)]; cf_n = CFp[moff + 8 * (c + 1)]; }
#pragma unroll
            for (int b = 0; b < 8; ++b) {
                v4u va[8];
#pragma unroll
                for (int j = 0; j < 8; ++j) { const int ex = __builtin_amdgcn_readlane(ix, 8 * b + j); va[j] = *((const GAS v4u*)(EV8 + (size_t)ex * DM) + lane); }
#pragma unroll
                for (int j = 0; j < 8; ++j) { const float cfi = __builtin_bit_cast(float, __builtin_amdgcn_readlane(__builtin_bit_cast(int, cf), 8 * b + j)); fma16_fp8(o[b], cfi, va[j]); }
            }
        }
        const int lane2 = lane_id();
#pragma unroll
        for (int t = 0; t < 8; ++t) {
            float ss = 0.f;
#pragma unroll
            for (int k = 0; k < 16; ++k) ss += o[t][k] * o[t][k];
            const float r = 1.f / sqrtf(wave_sum(ss, lane2) * (1.f / DM) + RMS_EPS);
            if (lane2 == 0) r3[lr0 + t] = r;
            v4u ha, hb;
            ha.x = cvtpk(o[t][0], o[t][1]); ha.y = cvtpk(o[t][2], o[t][3]); ha.z = cvtpk(o[t][4], o[t][5]); ha.w = cvtpk(o[t][6], o[t][7]);
            hb.x = cvtpk(o[t][8], o[t][9]); hb.y = cvtpk(o[t][10], o[t][11]); hb.z = cvtpk(o[t][12], o[t][13]); hb.w = cvtpk(o[t][14], o[t][15]);
            bf16* xo = X2B + (size_t)(lr0 + t) * DM + 16 * lane2;
            *(GAS v4u*)xo = ha; *(GAS v4u*)(xo + 8) = hb;
        }
    }
}


__device__ __forceinline__ void peer_vsweep2_panel(int panel, const bf16* X1B, bf16* X2B, LAS float* r3, const int* IDXp, const float* CFp, const unsigned char* EV8, unsigned* ctlw, volatile LAS unsigned* st, const int wid0) {
    const int wid = wid0;
#pragma nounroll
    for (int it = 0; it < 8; ++it) {
        const int dp = it >> 2, g2 = it & 3;
#if PEER_RDV
        xcc_rendezvous(ctlw, st, 16u + (unsigned)it, wid0);
#endif
        const int lane = lane_id(); const int half = lane >> 5, li = lane & 31;
        const int lr0 = wid * 32 + 8 * g2;
        const int colb = 512 * dp + 16 * li;
        float o[4][16];
#pragma unroll
        for (int t = 0; t < 4; ++t) { const bf16* xp = X1B + (size_t)(lr0 + 4 * half + t) * DM + colb; const v4u a = *(const GAS v4u*)xp, b2 = *(const GAS v4u*)(xp + 8); H_UNPACK(o[t], a, b2); }
        const int mA = (lr0 + (lane >> 3)) * 128 + (lane & 7);
        int ix_n = IDXp[mA]; float cf_n = CFp[mA];
#ifndef REP_VS
#define REP_VS 1
#endif
#pragma nounroll
        for (int c = 0; c < 16 * REP_VS; ++c) {
            const int ix = ix_n; const float cf = (c < 16) ? cf_n : 0.f;
            const int lane_c = lane_id(); const int half_c = lane_c >> 5;
            if (c + 1 < 16 * REP_VS) { const int m2 = (lr0 + (lane_c >> 3)) * 128 + (lane_c & 7) + 8 * ((c + 1) & 15); ix_n = IDXp[m2]; cf_n = CFp[m2]; }
            const int evo = 512 * dp + 16 * (lane_c & 31);
#pragma unroll
            for (int tq = 0; tq < 4; ++tq) {
                v4u va[8];
#pragma unroll
                for (int j = 0; j < 8; ++j) { const int exA = __builtin_amdgcn_readlane(ix, 8 * tq + j), exB = __builtin_amdgcn_readlane(ix, 32 + 8 * tq + j); const int ex = half_c ? exB : exA; va[j] = *(const GAS v4u*)(EV8 + (unsigned)(ex * DM + evo)); }
#pragma unroll
                for (int j = 0; j < 8; ++j) { const int cA = __builtin_amdgcn_readlane(__builtin_bit_cast(int, cf), 8 * tq + j), cB = __builtin_amdgcn_readlane(__builtin_bit_cast(int, cf), 32 + 8 * tq + j);
                    const int cs = half_c ? cB : cA; fma16_fp8(o[tq], __builtin_bit_cast(float, cs), va[j]); }
            }
        }
        const int lane2 = lane_id(); const int half2 = lane2 >> 5, li2 = lane2 & 31;
#pragma unroll
        for (int t = 0; t < 4; ++t) {
            const int tok = lr0 + 4 * half2 + t;
            float ss = 0.f;
#pragma unroll
            for (int k = 0; k < 16; ++k) ss += o[t][k] * o[t][k];
#pragma unroll
            for (int m = 1; m < 32; m <<= 1) ss += shx(ss, m, lane2);
            if (li2 == 0) { if (dp == 0) r3[tok] = ss; else r3[tok] = 1.f / sqrtf((r3[tok] + ss) * (1.f / DM) + RMS_EPS); }
            v4u ha, hb;
            ha.x = cvtpk(o[t][0], o[t][1]); ha.y = cvtpk(o[t][2], o[t][3]); ha.z = cvtpk(o[t][4], o[t][5]); ha.w = cvtpk(o[t][6], o[t][7]);
            hb.x = cvtpk(o[t][8], o[t][9]); hb.y = cvtpk(o[t][10], o[t][11]); hb.z = cvtpk(o[t][12], o[t][13]); hb.w = cvtpk(o[t][14], o[t][15]);
            bf16* xo = X2B + (size_t)tok * DM + 512 * dp + 16 * li2;
            *(GAS v4u*)xo = ha; *(GAS v4u*)(xo + 8) = hb;
        }
    }
}


struct Args {
    const float *x, *p, *norm_mix, *w_in, *w_att_up, *w_pool_group, *pool_scale, *w_out, *norm_ffn, *w_query, *sub_keys, *expert_u, *expert_v, *norm_ple, *w_ple_gate, *w_ple, *norm_final;
    float* out; unsigned char* ws; int ph_hi, pad;
};

#ifndef REP_P0
#define REP_P0 1
#endif
#ifndef REP_P1
#define REP_P1 1
#endif
#ifndef REP_P23
#define REP_P23 1
#endif
#ifndef REP_P4
#define REP_P4 1
#endif
#ifndef REP_P567
#define REP_P567 1
#endif
#ifndef REP_P9
#define REP_P9 1
#endif
#ifndef REP_ATT
#define REP_ATT 1
#endif
#ifndef REP_TOPK
#define REP_TOPK 1
#endif
#ifndef REP_MRG
#define REP_MRG 1
#endif
#ifndef MK_PH_HI
#define MK_PH_HI 99
#endif

typedef const __attribute__((address_space(4))) Args* CArgs;
__device__ __forceinline__ CArgs kargs() { CArgs p = (CArgs)__builtin_amdgcn_kernarg_segment_ptr(); asm volatile("" : "+s"(p)); return p; }
#define WSP(T, off) ((T*)(kargs()->ws + (off)))
__global__ void __launch_bounds__(NTHR, 2) mega_fwd(Args a_unused) {
    extern __shared__ __attribute__((aligned(16))) unsigned char lds_raw[];
    LAS unsigned char* lds = (LAS unsigned char*)lds_raw;
    volatile LAS unsigned* MISC = (volatile LAS unsigned*)(lds + MISC_OFF);
    const int G = gridDim.x; const int bx = blockIdx.x;
    const int vcu = (G % 8 == 0) ? (bx % 8) * (G / 8) + bx / 8 : bx;
    gu32* ctl = (gu32*)(kargs()->ws + WS_CTL);
    const int wid0 = __builtin_amdgcn_readfirstlane((int)threadIdx.x >> 6);
#define IS_T0 (otid(wid0) == 0)
    for (int u = otid(wid0); u < (LDS_BYTES - LDSCTL_OFF) / 4; u += NTHR) ((LAS unsigned*)(lds + LDSCTL_OFF))[u] = 0u;
    __syncthreads();
    (void)xcd_barrier_post((unsigned*)(ctl + CW_BAR), MISC + 8, IS_T0);
#define GRID_BAR() do { XcdBarrier _b; _b.bar = (unsigned*)((gu32*)(kargs()->ws + WS_CTL) + CW_BAR); _b.x = xb_xcc_id(); _b.st = (volatile LAS unsigned*)(lds + MISC_OFF) + 8; xcd_barrier(_b, IS_T0); } while (0)
    LAS float* const SS1 = (LAS float*)(lds + LDSCTL_OFF + 1024);
    LAS float* const R3 = (LAS float*)(lds + LDSCTL_OFF + 2048);
    LAS float* const SSF = (LAS float*)(lds + LDSCTL_OFF + 3072);
#define LOCAL_SEAM() do { VM_WAIT(); __syncthreads(); if (IS_T0) { __builtin_amdgcn_fence(__ATOMIC_ACQUIRE, "agent"); VM_WAIT(); } __syncthreads(); } while (0)

    for (int rep_ = 0; rep_ < REP_P0; ++rep_) {
        const int tid = otid(wid0), lane = tid & 63, wid = __builtin_amdgcn_readfirstlane(tid >> 6);
        const CArgs a = kargs(); unsigned char* ws = a->ws;
        bf16 *WIN = (bf16*)(ws + WS_WIN), *WOUT = (bf16*)(ws + WS_WOUT), *WQ = (bf16*)(ws + WS_WQ), *WPG = (bf16*)(ws + WS_WPG), *WPLE = (bf16*)(ws + WS_WPLE);
        bf16 *BDA = (bf16*)(ws + WS_BDA), *BDP = (bf16*)(ws + WS_BDP), *SK = (bf16*)(ws + WS_SK), *XN = (bf16*)(ws + WS_XN);
        LAS float* scr = (LAS float*)(lds + wid * 16384);
        const int gw = vcu * NWAVES + wid, NGW = G * NWAVES;
        constexpr int I_IN = (1024 / 64) * (4096 / 32), I_OUT = (1024 / 64) * (1024 / 32), I_Q = (1024 / 64) * (2048 / 32), I_PG = I_OUT, I_PLE = (256 / 64) * (1024 / 32);
        constexpr int NITEMS = I_IN + I_OUT + I_Q + I_PG + I_PLE;
        for (int it = gw; it < NITEMS; it += NGW) {
            int r = it;
            if (r < I_IN) { p0_transpose_item(a->w_in, 1024, 4096, WIN, a->norm_mix, 512, C2, scr, r, lane); continue; } r -= I_IN;
            if (r < I_OUT) { p0_transpose_item(a->w_out, 1024, 1024, WOUT, nullptr, 0, 1.f, scr, r, lane); continue; } r -= I_OUT;
            if (r < I_Q) { p0_transpose_item(a->w_query, 1024, 2048, WQ, a->norm_ffn, 0, 1.f, scr, r, lane); continue; } r -= I_Q;
            if (r < I_PG) { p0_transpose_item(a->w_ple_gate, 1024, 1024, WPG, a->norm_ple, 0, 1.f, scr, r, lane); continue; } r -= I_PG;
            p0_transpose_item(a->w_ple, 256, 1024, WPLE, nullptr, 0, 1.f, scr, r, lane);
        }
        const int gt = vcu * NTHR + tid, NGT = G * NTHR;
        for (int it = gt; it < 1024 * 16; it += NGT) {
            const int n = it >> 4, k8 = (it & 15) * 8, head = n >> 7, g = n >> 8;
            float va[8], vp[8]; const float ps = a->pool_scale[n];
#pragma unroll
            for (int j = 0; j < 8; ++j) {
                const int k = k8 + j;
                va[j] = ((k >> 6) == (head & 1)) ? a->w_att_up[((size_t)head * 64 + (k & 63)) * 128 + (n & 127)] : 0.f;
                vp[j] = a->w_pool_group[((size_t)g * 128 + k) * 256 + (n & 255)] * ps;
            }
            v4u o; o.x = pk2(va[0], va[1]); o.y = pk2(va[2], va[3]); o.z = pk2(va[4], va[5]); o.w = pk2(va[6], va[7]);
            *(GAS v4u*)(BDA + (size_t)n * 128 + k8) = o;
            o.x = pk2(vp[0], vp[1]); o.y = pk2(vp[2], vp[3]); o.z = pk2(vp[4], vp[5]); o.w = pk2(vp[6], vp[7]);
            *(GAS v4u*)(BDP + (size_t)n * 128 + k8) = o;
        }
        for (int it = gt; it < 16 * 128 * 128 / 8; it += NGT) cvt8_store(a->sub_keys + (size_t)it * 8, SK + (size_t)it * 8);
        for (int rr = gw; rr < 2 * 16384; rr += NGW) { const int e = rr >> 1;
            if (rr & 1) quant_row_fp8(a->expert_v + (size_t)e * DM, nullptr, ws + WS_EV + (size_t)e * DM, (float*)(ws + WS_SV) + e, lane);
            else quant_row_fp8(a->expert_u + (size_t)e * DM, a->norm_ffn, ws + WS_EU + (size_t)e * DM, (float*)(ws + WS_SU) + e, lane); }
        { const int panel = bx;
            for (int r = wid; r < 256; r += NWAVES) { const size_t row = (size_t)panel * 256 + r; rms_row_to_bf16(a->x + row * DM, XN + row * DM, lane); } }
    }
    GRID_BAR();

    for (int rep_ = 0; rep_ < REP_P1; ++rep_) {
        { const int panel = bx;
            { pg8::Gemm g{WSP(bf16, WS_XN), WSP(bf16, WS_WIN), 1024, 1024, 1024, 0, 0, 1, 0}; pg8::PanelSched S{panel, 14, 4, 2, 0}; pg8::EpiProj E{WSP(bf16, WS_PQ), WSP(bf16, WS_PK), WSP(bf16, WS_PU), WSP(bf16, WS_PG)};
              pg8::gemm_phase<pg8::EpiProj, pg8::PanelSched, true, true>(lds, g, S, E, wid0); }
            { pg8::Gemm g{WSP(bf16, WS_WIN) + (size_t)1024 * 1024, WSP(bf16, WS_XN), 1024, 1024, 1024, 0, 0, 1, 0}; pg8::PanelSched S{panel, 2, 99, 0, 1}; pg8::EpiPlain E{WSP(bf16, WS_PVT), TOK};
              pg8::gemm_phase<pg8::EpiPlain, pg8::PanelSched, true, true>(lds, g, S, E, wid0); }
        }
    }
    GRID_BAR();

    { const int panel = bx;
        const size_t prow = (size_t)panel * 256;
        for (int rep_ = 0; rep_ < REP_P23; ++rep_) {
        if (MK_PH_HI > 2) { for (int r2_ = 0; r2_ < REP_ATT; ++r2_) attn_panel(panel, WSP(bf16, WS_PQ), WSP(bf16, WS_PK), WSP(bf16, WS_PVT), WSP(bf16, WS_YA), wid0); pool_panel(panel, WSP(bf16, WS_PU), WSP(bf16, WS_YP), wid0); LOCAL_SEAM(); }
        for (int r2_ = 0; r2_ < REP_MRG; ++r2_)
        if (MK_PH_HI > 3) {
            { pg8::Gemm g{WSP(bf16, WS_YA), WSP(bf16, WS_BDA), 128, 512, 128, 128, (long)((WS_YP - WS_YA) / 2), 1, 0}; pg8::PanelSched S{panel, 8, 99, 0, 0}; pg8::EpiMergeChain E{WSP(bf16, WS_PG), WSP(bf16, WS_MG)};
              pg8::gemm_phase<pg8::EpiMergeChain, pg8::PanelSched, true, true>(lds, g, S, E, wid0); }
            LOCAL_SEAM();
        }
        }
        for (int rep_ = 0; rep_ < REP_P4; ++rep_)
        if (MK_PH_HI > 4) {
            { pg8::Gemm g{WSP(bf16, WS_MG), WSP(bf16, WS_WOUT), 1024, 1024, 1024, 0, 0, 1, 0}; pg8::PanelSched S{panel, 4, 99, 0, 0}; pg8::EpiRes E{kargs()->x, (bf16*)kargs()->out, SS1};
              pg8::gemm_phase<pg8::EpiRes, pg8::PanelSched, true, true>(lds, g, S, E, wid0); }
            LOCAL_SEAM();
        }
        { { const int t_ = otid(wid0); if (t_ < 256) SS1[t_] = 1.f / sqrtf(SS1[t_] * (1.f / DM) + RMS_EPS); } __syncthreads(); }
        {
        if (MK_PH_HI > 6) {
            { pg8::Gemm g{(const bf16*)kargs()->out, WSP(bf16, WS_WQ), 1024, 1024, 1024, 0, 0, 2, 0}; pg8::PanelSched S{panel, 8, 99, 0, 0}; pg8::EpiPlainScale E{WSP(bf16, WS_PG), 2048, SS1};
              pg8::gemm_phase<pg8::EpiPlainScale, pg8::PanelSched, true, true>(lds, g, S, E, wid0); }
            LOCAL_SEAM();
        }
        #define IDXP ((int*)(kargs()->ws + WS_YA + (size_t)panel * 262144))
#define GTP ((float*)(kargs()->ws + WS_YA + (size_t)panel * 262144 + 131072))
        if (MK_PH_HI > 7) { for (int r2_ = 0; r2_ < REP_TOPK; ++r2_) topk_panel(panel, WSP(bf16, WS_PG), WSP(bf16, WS_SK), IDXP, GTP, lds, wid0); LOCAL_SEAM(); }
        }
#ifndef PEER_SWEEP
#define PEER_SWEEP 1
#endif
#define STP ((unsigned char*)(kargs()->ws + WS_YP + (size_t)panel * 262144))
#define CFP ((float*)(kargs()->ws + WS_YP + (size_t)panel * 262144 + 131072))
#define SLOTP ((int*)(kargs()->ws + WS_MG + (size_t)panel * 524288 + 131072))
#define IDXPADP ((int*)(kargs()->ws + WS_PG + (size_t)panel * 1048576))
#define CFPADP ((float*)(kargs()->ws + WS_PG + (size_t)panel * 1048576 + 393216))
#define SUSP ((float*)(kargs()->ws + WS_MG + (size_t)panel * 524288))
        if (MK_PH_HI > 8) {
            if (PEER_SWEEP) {
                peer_sort_panel(IDXP, GTP, SUSP, STP, WSP(float, WS_SU), WSP(float, WS_SV), wid0); LOCAL_SEAM();
                peer_usweep_panel(panel, (const bf16*)kargs()->out + (size_t)panel * 524288, SS1, IDXP, GTP, SUSP, CFP, WSP(unsigned char, WS_EU), (unsigned*)(kargs()->ws + WS_CTL), (volatile LAS unsigned*)(lds + MISC_OFF) + 8, wid0); LOCAL_SEAM();
#ifndef PEER_VSWEEP
#define PEER_VSWEEP 2
#endif
                if (PEER_VSWEEP == 2) peer_vsweep2_panel(panel, (const bf16*)kargs()->out + (size_t)panel * 524288, WSP(bf16, WS_PG) + (size_t)panel * 524288, R3, IDXP, CFP, WSP(unsigned char, WS_EV), (unsigned*)(kargs()->ws + WS_CTL), (volatile LAS unsigned*)(lds + MISC_OFF) + 8, wid0);
                else peer_vsweep_panel(panel, (const bf16*)kargs()->out + (size_t)panel * 524288, WSP(bf16, WS_PG) + (size_t)panel * 524288, R3, IDXP, CFP, WSP(unsigned char, WS_EV), wid0);
                LOCAL_SEAM();
            }
        }
        for (int rep_ = 0; rep_ < REP_P9; ++rep_)
        if (MK_PH_HI > 9) {
            { const int tid = otid(wid0); const float* pp = kargs()->p; bf16* YP = WSP(bf16, WS_YP); for (int it = tid; it < 256 * 256 / 8; it += NTHR) { const int r = it >> 5, c8 = (it & 31) * 8; cvt8_store(pp + (prow + r) * 256 + c8, YP + (prow + r) * 512 + c8); } }
            LOCAL_SEAM();
            { pg8::Gemm g{WSP(bf16, WS_YP), WSP(bf16, WS_WPLE), 256, 512, 256, 0, 0, 1, 0}; pg8::PanelSched S{panel, 4, 99, 0, 0}; pg8::EpiPlain E{WSP(bf16, WS_MG), 1024};
              pg8::gemm_phase<pg8::EpiPlain, pg8::PanelSched, true, true>(lds, g, S, E, wid0); }
            LOCAL_SEAM();
        }
        if (MK_PH_HI > 10) {
            { pg8::Gemm g{WSP(bf16, WS_PG), WSP(bf16, WS_WPG), 1024, 1024, 1024, 0, 0, 2, 0}; pg8::PanelSched S{panel, 4, 99, 0, 0}; pg8::EpiGate E{kargs()->out, WSP(bf16, WS_PG), WSP(bf16, WS_MG), R3, SSF};
              pg8::gemm_phase<pg8::EpiGate, pg8::PanelSched, true, true>(lds, g, S, E, wid0); }
            LOCAL_SEAM();
        }
        if (MK_PH_HI > 11) {
            const int tid = otid(wid0), lane = tid & 63, wid = __builtin_amdgcn_readfirstlane(tid >> 6);
            for (int r = wid; r < 256; r += NWAVES) {
                GAS f32x4* xr = (GAS f32x4*)(kargs()->out + (prow + r) * DM) + lane; const GAS f32x4* gr = (const GAS f32x4*)kargs()->norm_final + lane;
                const float rr = 1.f / sqrtf(SSF[r] * (1.f / DM) + RMS_EPS);
#pragma unroll
                for (int j = 0; j < 4; ++j) xr[64 * j] = xr[64 * j] * rr * gr[64 * j];
            }
        }
    }
#undef LOCAL_SEAM
}


extern "C" void kernel_launch(void* const* d_in, const int* in_sizes, int n_in, void* d_out, int out_size, void* d_ws, size_t ws_size, hipStream_t stream) {
    static int grid = 0;
    if (grid == 0) {
        if (n_in != 17 || in_sizes[0] != TOK * DM || out_size != TOK * DM || ws_size < WS_END) { fprintf(stderr, "kernel_launch: unexpected shapes (n_in %d, in0 %d, out %d, ws %zu); nothing launched\n", n_in, n_in > 0 ? in_sizes[0] : -1, out_size, ws_size); grid = -1; return; }
        int dev = 0, cus = 0;
        if (hipGetDevice(&dev) != hipSuccess || hipDeviceGetAttribute(&cus, hipDeviceAttributeMultiprocessorCount, dev) != hipSuccess) { fprintf(stderr, "kernel_launch: device query failed\n"); grid = -1; return; }
        if (hipFuncSetAttribute((const void*)mega_fwd, hipFuncAttributeMaxDynamicSharedMemorySize, LDS_BYTES) != hipSuccess) { fprintf(stderr, "kernel_launch: hipFuncSetAttribute failed\n"); grid = -1; return; }
        int per_cu = 0;
        if (hipOccupancyMaxActiveBlocksPerMultiprocessor(&per_cu, (const void*)mega_fwd, NTHR, LDS_BYTES) != hipSuccess || per_cu < 1) fprintf(stderr, "kernel_launch: note: occupancy query reports %d workgroups per CU\n", per_cu);
        (void)hipGetLastError();
        if (cus != NPANEL) fprintf(stderr, "kernel_launch: note: %d CUs; this kernel is built for one 256-token panel per CU on a 256-CU device\n", cus);
        grid = NPANEL;
    }
    if (grid < 0) return;
    if (hipMemsetAsync((char*)d_ws + WS_CTL, 0, CTL_ZERO_BYTES, stream) != hipSuccess) { fprintf(stderr, "kernel_launch: memset failed\n"); return; }
    Args a{};
    a.x = (const float*)d_in[0]; a.p = (const float*)d_in[1]; a.norm_mix = (const float*)d_in[2]; a.w_in = (const float*)d_in[3]; a.w_att_up = (const float*)d_in[4];
    a.w_pool_group = (const float*)d_in[5]; a.pool_scale = (const float*)d_in[6]; a.w_out = (const float*)d_in[7]; a.norm_ffn = (const float*)d_in[8]; a.w_query = (const float*)d_in[9];
    a.sub_keys = (const float*)d_in[10]; a.expert_u = (const float*)d_in[11]; a.expert_v = (const float*)d_in[12]; a.norm_ple = (const float*)d_in[13]; a.w_ple_gate = (const float*)d_in[14];
    a.w_ple = (const float*)d_in[15]; a.norm_final = (const float*)d_in[16];
    a.out = (float*)d_out; a.ws = (unsigned char*)d_ws; a.ph_hi = MK_PH_HI; a.pad = 0;
    hipLaunchKernelGGL(mega_fwd, dim3(grid), dim3(NTHR), LDS_BYTES, stream, a);
    { const hipError_t le = hipPeekAtLastError(); if (le != hipSuccess) fprintf(stderr, "kernel_launch: launch failed: %s\n", hipGetErrorName(le)); }
}
```

```cpp
#include <hip/hip_runtime.h>
#include <cstdio>
#include <cstdint>
#include <math.h>
__device__ __forceinline__ int lane_id() { int l; asm volatile("v_mbcnt_lo_u32_b32 %0, -1, 0\n\tv_mbcnt_hi_u32_b32 %0, -1, %0" : "=v"(l)); return l; }
__device__ __forceinline__ int otid(int wid0) { return (wid0 << 6) | lane_id(); }

namespace pg8 {
#define PG8_LAS __attribute__((address_space(3)))
typedef unsigned short bf16_t;
typedef short bf16x8 __attribute__((ext_vector_type(8)));
typedef float f32x4 __attribute__((ext_vector_type(4)));
typedef unsigned u32x4 __attribute__((ext_vector_type(4)));
typedef int i32x4 __attribute__((ext_vector_type(4)));
constexpr int BM = 256, BK = 64, HALF = 128, HTB = HALF * BK * 2  , STAGE_BYTES = 8 * HTB, NXCD = 8, WGM = 8;

__host__ __device__ __forceinline__ int lds_byte(int r, int c) { const int st = (r >> 4) * 2 + (c >> 5), rr = r & 15, cc = c & 31, ob = rr * 64 + cc * 2; return st * 1024 + (ob ^ (((ob >> 9) & 1) << 5)); }
__host__ __device__ __forceinline__ void stage_rc(int b, int& R, int& C) { const int st = b / 1024, sb = b % 1024, swz = sb ^ (((sb >> 9) & 1) << 5); R = (st >> 1) * 16 + swz / 64; C = (st & 1) * 32 + (swz % 64) / 2; }
__host__ __device__ __forceinline__ int perm32(int rho) { const int n = rho >> 4, i = rho & 15; return 8 * (i >> 2) + 4 * n + (i & 3); }

struct Unit { int pm, pn; };
struct Gemm { const bf16_t* A; const bf16_t* Bt; int K, lda, ldb, akoff; long a2off; int am, pad_; };

struct StaticOrder {
    int nM, nN, nwg, G, c;
    __host__ __device__ void init(int M, int N, int G_, int c_) { nM = M / BM; nN = N / BM; nwg = nM * nN; G = G_; c = c_; }
    __host__ __device__ bool next(int i, Unit& u) const {
        const long L = (long)i * G + c; if (L >= nwg) return false;
        int wgid = (int)L; { const int q = nwg / NXCD, r = nwg % NXCD, xcd = wgid % NXCD, off = wgid / NXCD; wgid = (xcd < r ? xcd * (q + 1) : r * (q + 1) + (xcd - r) * q) + off; }
        const int nig = WGM * nN, gid = wgid / nig, fm = gid * WGM, gsz = (nM - fm) < WGM ? (nM - fm) : WGM;
        u.pm = fm + ((wgid % nig) % gsz); u.pn = (wgid % nig) / gsz; return true;
    }
    __device__ __forceinline__ void a_ready(const Unit&) const {}
    __device__ __forceinline__ void done(const Unit&) const {}
};

template <class Epi, class Sched, bool ALIGN_EPI = false, bool SP2 = false>
__device__ __forceinline__ void gemm_phase(PG8_LAS unsigned char* lds, const Gemm g, const Sched& S, const Epi& E, const int wid0) {
    const int tid = otid(wid0), wid = __builtin_amdgcn_readfirstlane(tid >> 6), lane = tid & 63, wr = wid >> 2, wc = wid & 3, fr = lane & 15, fq = lane >> 4;
    const int K = g.K, nt = K / BK;
    unsigned voffA[2], voffB[2];
#pragma unroll
    for (int i = 0; i < 2; ++i) { int R, C; stage_rc(tid * 16 + i * 8192, R, C); const int Rb = Epi::PERM ? ((R & ~31) + perm32(R & 31)) : R;
        voffA[i] = (unsigned)(R * g.lda + C) * 2u; voffB[i] = (unsigned)(Rb * g.ldb + C) * 2u; }
    const size_t kstep = (size_t)(BK * 2);
    const size_t hstepA = (size_t)HALF * g.lda * 2, hstepB = (size_t)HALF * g.ldb * 2;
    const size_t tstepA = 2 * hstepA, tstepB = 2 * hstepB, akb = (size_t)g.akoff * 2, a2b = (size_t)g.a2off * 2;
    const unsigned ldsw = (unsigned)wid * 1024u;
    const int aoff = lds_byte(wr * 64 + fr, fq * 8), boff = lds_byte(wc * 32 + fr, fq * 8);
#define PG8_SA(b, h) (((b) * 2 + (h)) * HTB)
#define PG8_SB(b, h) ((4 + (b) * 2 + (h)) * HTB)
#define PG8_STAGE(bufoff, gbase, voff) do { _Pragma("unroll") for (int _i = 0; _i < 2; ++_i) \
        __builtin_amdgcn_global_load_lds((const unsigned*)((const char*)(gbase) + (voff)[_i]), (PG8_LAS unsigned*)(lds + (bufoff) + ldsw + _i * 8192), 16, 0, 0); } while (0)
#define PG8_LDA(dst, b, h) do { _Pragma("unroll") for (int m = 0; m < 4; ++m) _Pragma("unroll") for (int k = 0; k < 2; ++k) dst[m][k] = *(const PG8_LAS bf16x8*)(lds + PG8_SA(b, h) + aoff + m * 2048 + k * 1024); } while (0)
#define PG8_LDB(dst, b, h) do { _Pragma("unroll") for (int n = 0; n < 2; ++n) _Pragma("unroll") for (int k = 0; k < 2; ++k) dst[n][k] = *(const PG8_LAS bf16x8*)(lds + PG8_SB(b, h) + boff + n * 2048 + k * 1024); } while (0)
#define PG8_MMA(ai, bj, At, Bt) do { __builtin_amdgcn_s_setprio(1); _Pragma("unroll") for (int m = 0; m < 4; ++m) _Pragma("unroll") for (int n = 0; n < 2; ++n) _Pragma("unroll") for (int k = 0; k < 2; ++k) \
        acc[ai][bj][m][n] = __builtin_amdgcn_mfma_f32_16x16x32_bf16(Bt[n][k], At[m][k], acc[ai][bj][m][n], 0, 0, 0); __builtin_amdgcn_s_setprio(0); } while (0)
#define PG8_WAIT_V(n) asm volatile("s_waitcnt vmcnt(" #n ")" ::: "memory")
#define PG8_WAIT_L(n) asm volatile("s_waitcnt lgkmcnt(" #n ")" ::: "memory")
#define PG8_BAR __builtin_amdgcn_s_barrier()
#define PG8_SCHED __builtin_amdgcn_sched_barrier(0)
    Unit cur, nxt; int ui = 0;
    if (!S.next(0, cur)) return;
    f32x4 acc[2][2][4][2];
#pragma unroll
    for (int a = 0; a < 2; ++a)
#pragma unroll
        for (int b = 0; b < 2; ++b)
#pragma unroll
            for (int m = 0; m < 4; ++m)
#pragma unroll
                for (int n = 0; n < 2; ++n) acc[a][b][m][n] = (f32x4){0.f, 0.f, 0.f, 0.f};
    bf16x8 At[4][2], B0[2][2], B1[2][2];
    const char* cA = (const char*)g.A + (size_t)(cur.pm * g.am) * tstepA + (size_t)(cur.pn & 3) * akb + (size_t)(cur.pn >> 2) * a2b; const char* cB = (const char*)g.Bt + (size_t)cur.pn * tstepB;
    S.a_ready(cur);
    if constexpr (SP2) {
        PG8_STAGE(PG8_SB(0, 0), cB, voffB); PG8_STAGE(PG8_SB(0, 1), cB + hstepB, voffB); PG8_STAGE(PG8_SA(0, 0), cA, voffA); PG8_STAGE(PG8_SA(0, 1), cA + hstepA, voffA);
        if (wr == 1) PG8_BAR;
        PG8_WAIT_V(2); PG8_BAR;
        PG8_STAGE(PG8_SB(1, 0), cB + kstep, voffB); PG8_STAGE(PG8_SA(1, 0), cA + kstep, voffA); PG8_STAGE(PG8_SB(1, 1), cB + hstepB + kstep, voffB);
        PG8_WAIT_V(6); PG8_BAR;
    } else {
        PG8_STAGE(PG8_SB(0, 0), cB, voffB); PG8_STAGE(PG8_SA(0, 0), cA, voffA); PG8_STAGE(PG8_SB(0, 1), cB + hstepB, voffB); PG8_STAGE(PG8_SA(0, 1), cA + hstepA, voffA);
        if (wr == 1) PG8_BAR;
        PG8_WAIT_V(4); PG8_BAR;
        PG8_STAGE(PG8_SB(1, 0), cB + kstep, voffB); PG8_STAGE(PG8_SA(1, 0), cA + kstep, voffA); PG8_STAGE(PG8_SB(1, 1), cB + hstepB + kstep, voffB);
        PG8_WAIT_V(6); PG8_BAR;
    }
    for (;;) {
        const bool has_next = S.next(ui + 1, nxt);
        const char* nA = has_next ? (const char*)g.A + (size_t)(nxt.pm * g.am) * tstepA + (size_t)(nxt.pn & 3) * akb + (size_t)(nxt.pn >> 2) * a2b : cA; const char* nB = has_next ? (const char*)g.Bt + (size_t)nxt.pn * tstepB : cB;
        for (int t = 0; t < nt; t += 2) {
            const bool last = (t == nt - 2);
            const char* a1 = cA + (size_t)(t + 1) * kstep;
            const char* a2 = last ? nA : cA + (size_t)(t + 2) * kstep; const char* b2 = last ? nB : cB + (size_t)(t + 2) * kstep;
            const char* a3 = a2 + kstep; const char* b3 = b2 + kstep;
            if (last && has_next) S.a_ready(nxt);
            if constexpr (SP2) {
            PG8_LDB(B0, 0, 0); PG8_LDB(B1, 0, 1); PG8_SCHED; PG8_LDA(At, 0, 0); PG8_STAGE(PG8_SA(1, 1), a1 + hstepA, voffA);
            PG8_WAIT_V(8); PG8_WAIT_L(0); PG8_BAR; PG8_MMA(0, 0, At, B0); PG8_MMA(0, 1, At, B1); PG8_BAR; PG8_SCHED;
            PG8_LDA(At, 0, 1); PG8_STAGE(PG8_SB(0, 0), b2, voffB); PG8_STAGE(PG8_SB(0, 1), b2 + hstepB, voffB); PG8_STAGE(PG8_SA(0, 0), a2, voffA);
            PG8_WAIT_V(8); PG8_WAIT_L(0); PG8_BAR; PG8_MMA(1, 0, At, B0); PG8_MMA(1, 1, At, B1); PG8_BAR; PG8_SCHED;
            PG8_LDB(B0, 1, 0); PG8_LDB(B1, 1, 1); PG8_SCHED; PG8_LDA(At, 1, 0); PG8_STAGE(PG8_SA(0, 1), a2 + hstepA, voffA);
            PG8_WAIT_V(8); PG8_WAIT_L(0); PG8_BAR; PG8_MMA(0, 0, At, B0); PG8_MMA(0, 1, At, B1); PG8_BAR; PG8_SCHED;
            PG8_LDA(At, 1, 1); PG8_STAGE(PG8_SB(1, 0), b3, voffB); PG8_STAGE(PG8_SB(1, 1), b3 + hstepB, voffB); PG8_STAGE(PG8_SA(1, 0), a3, voffA);
            PG8_WAIT_V(8); PG8_WAIT_L(0); PG8_BAR; PG8_MMA(1, 0, At, B0); PG8_MMA(1, 1, At, B1); PG8_BAR; PG8_SCHED;
            } else {
            PG8_LDB(B0, 0, 0); PG8_SCHED; PG8_LDA(At, 0, 0); PG8_STAGE(PG8_SA(1, 1), a1 + hstepA, voffA);
            PG8_WAIT_L(8); PG8_BAR; PG8_WAIT_L(0); PG8_MMA(0, 0, At, B0); PG8_BAR; PG8_SCHED;
            PG8_LDB(B1, 0, 1); PG8_STAGE(PG8_SB(0, 0), b2, voffB);
            PG8_BAR; PG8_WAIT_L(0); PG8_MMA(0, 1, At, B1); PG8_BAR;
            PG8_LDA(At, 0, 1); PG8_STAGE(PG8_SA(0, 0), a2, voffA);
            PG8_BAR; PG8_WAIT_L(0); PG8_MMA(1, 0, At, B0); PG8_BAR; PG8_SCHED;
            PG8_STAGE(PG8_SB(0, 1), b2 + hstepB, voffB);
            PG8_WAIT_V(6); PG8_BAR; PG8_MMA(1, 1, At, B1); PG8_BAR;
            PG8_LDB(B0, 1, 0); PG8_SCHED; PG8_LDA(At, 1, 0); PG8_STAGE(PG8_SA(0, 1), a2 + hstepA, voffA);
            PG8_WAIT_L(8); PG8_BAR; PG8_WAIT_L(0); PG8_MMA(0, 0, At, B0); PG8_BAR; PG8_SCHED;
            PG8_LDB(B1, 1, 1); PG8_STAGE(PG8_SB(1, 0), b3, voffB);
            PG8_BAR; PG8_WAIT_L(0); PG8_MMA(0, 1, At, B1); PG8_BAR;
            PG8_LDA(At, 1, 1); PG8_STAGE(PG8_SA(1, 0), a3, voffA);
            PG8_BAR; PG8_WAIT_L(0); PG8_MMA(1, 0, At, B0); PG8_BAR; PG8_SCHED;
            PG8_STAGE(PG8_SB(1, 1), b3 + hstepB, voffB);
            PG8_WAIT_V(6); PG8_BAR; PG8_MMA(1, 1, At, B1); PG8_BAR;
            }
        }
        if constexpr (ALIGN_EPI) { if (wr == 0) PG8_BAR; }
        if constexpr (!Epi::AFTER_DRAIN) { E(acc, cur, wr, wc, fr, fq); S.done(cur); }
        if (!has_next) break;
#pragma unroll
        for (int a = 0; a < 2; ++a)
#pragma unroll
            for (int b = 0; b < 2; ++b)
#pragma unroll
                for (int m = 0; m < 4; ++m)
#pragma unroll
                    for (int n = 0; n < 2; ++n) acc[a][b][m][n] = (f32x4){0.f, 0.f, 0.f, 0.f};
        cur = nxt; cA = nA; cB = nB; ++ui;
        if constexpr (ALIGN_EPI) { if (wr == 1) PG8_BAR; }
    }
    PG8_WAIT_V(0);
    if constexpr (!ALIGN_EPI) { if (wr == 0) PG8_BAR; }
    PG8_BAR;
    if constexpr (Epi::AFTER_DRAIN) { E.fused(acc, cur, wr, wc, fr, fq, lds, wid, lane); S.done(cur); }
#undef PG8_SA
#undef PG8_SB
#undef PG8_STAGE
#undef PG8_LDA
#undef PG8_LDB
#undef PG8_MMA
#undef PG8_WAIT_V
#undef PG8_WAIT_L
#undef PG8_BAR
#undef PG8_SCHED
}

template <class Epi, class Sched, bool ALIGN_EPI = false, bool SP2 = false>
__device__ __forceinline__ void gemm_phase_i8(PG8_LAS unsigned char* lds, const Gemm g, const Sched& S, const Epi& E, const int wid0) {
    const int tid = otid(wid0), wid = __builtin_amdgcn_readfirstlane(tid >> 6), lane = tid & 63, wr = wid >> 2, wc = wid & 3, fr = lane & 15, fq = lane >> 4;
    const int K = g.K, nt = K / 128;
    unsigned voffA[2], voffB[2];
#pragma unroll
    for (int i = 0; i < 2; ++i) { int R, C; stage_rc(tid * 16 + i * 8192, R, C); const int Rb = Epi::PERM ? ((R & ~31) + perm32(R & 31)) : R;
        voffA[i] = (unsigned)(R * g.lda + C * 2); voffB[i] = (unsigned)(Rb * g.ldb + C * 2); }
    const size_t kstep = (size_t)(BK * 2);
    const size_t hstepA = (size_t)HALF * g.lda, hstepB = (size_t)HALF * g.ldb;
    const size_t tstepA = 2 * hstepA, tstepB = 2 * hstepB, akb = (size_t)g.akoff, a2b = (size_t)g.a2off;
    const unsigned ldsw = (unsigned)wid * 1024u;
    const int aoff = lds_byte(wr * 64 + fr, fq * 8), boff = lds_byte(wc * 32 + fr, fq * 8);
#define PG8_SA(b, h) (((b) * 2 + (h)) * HTB)
#define PG8_SB(b, h) ((4 + (b) * 2 + (h)) * HTB)
#define PG8_STAGE(bufoff, gbase, voff) do { _Pragma("unroll") for (int _i = 0; _i < 2; ++_i) \
        __builtin_amdgcn_global_load_lds((const unsigned*)((const char*)(gbase) + (voff)[_i]), (PG8_LAS unsigned*)(lds + (bufoff) + ldsw + _i * 8192), 16, 0, 0); } while (0)
#define PG8_LDA(dst, b, h) do { _Pragma("unroll") for (int m = 0; m < 4; ++m) _Pragma("unroll") for (int k = 0; k < 2; ++k) dst[m][k] = *(const PG8_LAS i32x4*)(lds + PG8_SA(b, h) + aoff + m * 2048 + k * 1024); } while (0)
#define PG8_LDB(dst, b, h) do { _Pragma("unroll") for (int n = 0; n < 2; ++n) _Pragma("unroll") for (int k = 0; k < 2; ++k) dst[n][k] = *(const PG8_LAS i32x4*)(lds + PG8_SB(b, h) + boff + n * 2048 + k * 1024); } while (0)
#define PG8_MMA(ai, bj, At, Bt) do { __builtin_amdgcn_s_setprio(1); _Pragma("unroll") for (int m = 0; m < 4; ++m) _Pragma("unroll") for (int n = 0; n < 2; ++n) _Pragma("unroll") for (int k = 0; k < 2; ++k) \
        acc[ai][bj][m][n] = __builtin_amdgcn_mfma_i32_16x16x64_i8(Bt[n][k], At[m][k], acc[ai][bj][m][n], 0, 0, 0); __builtin_amdgcn_s_setprio(0); } while (0)
#define PG8_WAIT_V(n) asm volatile("s_waitcnt vmcnt(" #n ")" ::: "memory")
#define PG8_WAIT_L(n) asm volatile("s_waitcnt lgkmcnt(" #n ")" ::: "memory")
#define PG8_BAR __builtin_amdgcn_s_barrier()
#define PG8_SCHED __builtin_amdgcn_sched_barrier(0)
    Unit cur, nxt; int ui = 0;
    if (!S.next(0, cur)) return;
    i32x4 acc[2][2][4][2];
#pragma unroll
    for (int a = 0; a < 2; ++a)
#pragma unroll
        for (int b = 0; b < 2; ++b)
#pragma unroll
            for (int m = 0; m < 4; ++m)
#pragma unroll
                for (int n = 0; n < 2; ++n) acc[a][b][m][n] = (i32x4){0, 0, 0, 0};
    i32x4 At[4][2], B0[2][2], B1[2][2];
    const char* cA = (const char*)g.A + (size_t)(cur.pm * g.am) * tstepA + (size_t)(cur.pn & 3) * akb + (size_t)(cur.pn >> 2) * a2b; const char* cB = (const char*)g.Bt + (size_t)cur.pn * tstepB;
    S.a_ready(cur);
    if constexpr (SP2) {
        PG8_STAGE(PG8_SB(0, 0), cB, voffB); PG8_STAGE(PG8_SB(0, 1), cB + hstepB, voffB); PG8_STAGE(PG8_SA(0, 0), cA, voffA); PG8_STAGE(PG8_SA(0, 1), cA + hstepA, voffA);
        if (wr == 1) PG8_BAR;
        PG8_WAIT_V(2); PG8_BAR;
        PG8_STAGE(PG8_SB(1, 0), cB + kstep, voffB); PG8_STAGE(PG8_SA(1, 0), cA + kstep, voffA); PG8_STAGE(PG8_SB(1, 1), cB + hstepB + kstep, voffB);
        PG8_WAIT_V(6); PG8_BAR;
    } else {
        PG8_STAGE(PG8_SB(0, 0), cB, voffB); PG8_STAGE(PG8_SA(0, 0), cA, voffA); PG8_STAGE(PG8_SB(0, 1), cB + hstepB, voffB); PG8_STAGE(PG8_SA(0, 1), cA + hstepA, voffA);
        if (wr == 1) PG8_BAR;
        PG8_WAIT_V(4); PG8_BAR;
        PG8_STAGE(PG8_SB(1, 0), cB + kstep, voffB); PG8_STAGE(PG8_SA(1, 0), cA + kstep, voffA); PG8_STAGE(PG8_SB(1, 1), cB + hstepB + kstep, voffB);
        PG8_WAIT_V(6); PG8_BAR;
    }
    for (;;) {
        const bool has_next = S.next(ui + 1, nxt);
        const char* nA = has_next ? (const char*)g.A + (size_t)(nxt.pm * g.am) * tstepA + (size_t)(nxt.pn & 3) * akb + (size_t)(nxt.pn >> 2) * a2b : cA; const char* nB = has_next ? (const char*)g.Bt + (size_t)nxt.pn * tstepB : cB;
        for (int t = 0; t < nt; t += 2) {
            const bool last = (t == nt - 2);
            const char* a1 = cA + (size_t)(t + 1) * kstep;
            const char* a2 = last ? nA : cA + (size_t)(t + 2) * kstep; const char* b2 = last ? nB : cB + (size_t)(t + 2) * kstep;
            const char* a3 = a2 + kstep; const char* b3 = b2 + kstep;
            if (last && has_next) S.a_ready(nxt);
            if constexpr (SP2) {
            PG8_LDB(B0, 0, 0); PG8_LDB(B1, 0, 1); PG8_SCHED; PG8_LDA(At, 0, 0); PG8_STAGE(PG8_SA(1, 1), a1 + hstepA, voffA);
            PG8_WAIT_V(8); PG8_WAIT_L(0); PG8_BAR; PG8_MMA(0, 0, At, B0); PG8_MMA(0, 1, At, B1); PG8_BAR; PG8_SCHED;
            PG8_LDA(At, 0, 1); PG8_STAGE(PG8_SB(0, 0), b2, voffB); PG8_STAGE(PG8_SB(0, 1), b2 + hstepB, voffB); PG8_STAGE(PG8_SA(0, 0), a2, voffA);
            PG8_WAIT_V(8); PG8_WAIT_L(0); PG8_BAR; PG8_MMA(1, 0, At, B0); PG8_MMA(1, 1, At, B1); PG8_BAR; PG8_SCHED;
            PG8_LDB(B0, 1, 0); PG8_LDB(B1, 1, 1); PG8_SCHED; PG8_LDA(At, 1, 0); PG8_STAGE(PG8_SA(0, 1), a2 + hstepA, voffA);
            PG8_WAIT_V(8); PG8_WAIT_L(0); PG8_BAR; PG8_MMA(0, 0, At, B0); PG8_MMA(0, 1, At, B1); PG8_BAR; PG8_SCHED;
            PG8_LDA(At, 1, 1); PG8_STAGE(PG8_SB(1, 0), b3, voffB); PG8_STAGE(PG8_SB(1, 1), b3 + hstepB, voffB); PG8_STAGE(PG8_SA(1, 0), a3, voffA);
            PG8_WAIT_V(8); PG8_WAIT_L(0); PG8_BAR; PG8_MMA(1, 0, At, B0); PG8_MMA(1, 1, At, B1); PG8_BAR; PG8_SCHED;
            } else {
            PG8_LDB(B0, 0, 0); PG8_SCHED; PG8_LDA(At, 0, 0); PG8_STAGE(PG8_SA(1, 1), a1 + hstepA, voffA);
            PG8_WAIT_L(8); PG8_BAR; PG8_WAIT_L(0); PG8_MMA(0, 0, At, B0); PG8_BAR; PG8_SCHED;
            PG8_LDB(B1, 0, 1); PG8_STAGE(PG8_SB(0, 0), b2, voffB);
            PG8_BAR; PG8_WAIT_L(0); PG8_MMA(0, 1, At, B1); PG8_BAR;
            PG8_LDA(At, 0, 1); PG8_STAGE(PG8_SA(0, 0), a2, voffA);
            PG8_BAR; PG8_WAIT_L(0); PG8_MMA(1, 0, At, B0); PG8_BAR; PG8_SCHED;
            PG8_STAGE(PG8_SB(0, 1), b2 + hstepB, voffB);
            PG8_WAIT_V(6); PG8_BAR; PG8_MMA(1, 1, At, B1); PG8_BAR;
            PG8_LDB(B0, 1, 0); PG8_SCHED; PG8_LDA(At, 1, 0); PG8_STAGE(PG8_SA(0, 1), a2 + hstepA, voffA);
            PG8_WAIT_L(8); PG8_BAR; PG8_WAIT_L(0); PG8_MMA(0, 0, At, B0); PG8_BAR; PG8_SCHED;
            PG8_LDB(B1, 1, 1); PG8_STAGE(PG8_SB(1, 0), b3, voffB);
            PG8_BAR; PG8_WAIT_L(0); PG8_MMA(0, 1, At, B1); PG8_BAR;
            PG8_LDA(At, 1, 1); PG8_STAGE(PG8_SA(1, 0), a3, voffA);
            PG8_BAR; PG8_WAIT_L(0); PG8_MMA(1, 0, At, B0); PG8_BAR; PG8_SCHED;
            PG8_STAGE(PG8_SB(1, 1), b3 + hstepB, voffB);
            PG8_WAIT_V(6); PG8_BAR; PG8_MMA(1, 1, At, B1); PG8_BAR;
            }
        }
        if constexpr (ALIGN_EPI) { if (wr == 0) PG8_BAR; }
        if constexpr (!Epi::AFTER_DRAIN) { E(acc, cur, wr, wc, fr, fq); S.done(cur); }
        if (!has_next) break;
#pragma unroll
        for (int a = 0; a < 2; ++a)
#pragma unroll
            for (int b = 0; b < 2; ++b)
#pragma unroll
                for (int m = 0; m < 4; ++m)
#pragma unroll
                    for (int n = 0; n < 2; ++n) acc[a][b][m][n] = (i32x4){0, 0, 0, 0};
        cur = nxt; cA = nA; cB = nB; ++ui;
        if constexpr (ALIGN_EPI) { if (wr == 1) PG8_BAR; }
    }
    PG8_WAIT_V(0);
    if constexpr (!ALIGN_EPI) { if (wr == 0) PG8_BAR; }
    PG8_BAR;
    if constexpr (Epi::AFTER_DRAIN) { E.fused(acc, cur, wr, wc, fr, fq, lds, wid, lane); S.done(cur); }
#undef PG8_SA
#undef PG8_SB
#undef PG8_STAGE
#undef PG8_LDA
#undef PG8_LDB
#undef PG8_MMA
#undef PG8_WAIT_V
#undef PG8_WAIT_L
#undef PG8_BAR
#undef PG8_SCHED
}
}


namespace pg8 {
typedef unsigned u32x2 __attribute__((ext_vector_type(2)));
__device__ __forceinline__ unsigned cvt_pk_bf16(float lo, float hi) { unsigned r; asm volatile("v_cvt_pk_bf16_f32 %0, %1, %2" : "=v"(r) : "v"(lo), "v"(hi)); return r; }
__device__ __forceinline__ float sigm(float x) { return __builtin_amdgcn_rcpf(1.0f + __builtin_amdgcn_exp2f(-1.4426950408889634f * x)); }
__device__ __forceinline__ float bf_lo(unsigned w) { return __uint_as_float(w << 16); }
__device__ __forceinline__ float bf_hi(unsigned w) { return __uint_as_float(w & 0xffff0000u); }

struct PanelSched {
    int panel, n, skip_lo, skip_n, mode, first;
    __device__ __forceinline__ bool next(int i, Unit& u) const {
        if (i >= n) return false;
        if (mode == 0) { const int j = first + i; u.pm = panel; u.pn = j + (j >= skip_lo ? skip_n : 0); } else if (mode == 2) { u.pm = panel; u.pn = (i >> 1) + 4 * (i & 1); } else { u.pm = i; u.pn = panel; }
        return true;
    }
    __device__ __forceinline__ void a_ready(const Unit&) const {}
    __device__ __forceinline__ void done(const Unit&) const {}
};

struct EpiProj {
    static constexpr bool PERM = true, AFTER_DRAIN = false;
    bf16_t *PQ, *PK, *PU, *PG;
    __device__ __forceinline__ void operator()(const f32x4 (&acc)[2][2][4][2], const Unit& u, int wr, int wc, int fr, int fq) const {
        const int pn = u.pn; bf16_t* base; int ld, colt; bool sg = false;
        if (pn < 2) { base = PQ; ld = 512; colt = pn * 256; }
        else if (pn < 4) { base = PK; ld = 512; colt = (pn - 2) * 256; }
        else if (pn < 8) { base = PU; ld = 512; colt = (pn - 6) * 256; }
        else { base = PG; ld = 2048; colt = (pn - 8) * 256; sg = true; }
        const int row0 = u.pm * BM + wr * 64 + fr, col0 = colt + wc * 32 + 8 * fq;
#pragma unroll
        for (int ai = 0; ai < 2; ++ai)
#pragma unroll
            for (int m = 0; m < 4; ++m) { bf16_t* rowp = base + (size_t)(row0 + ai * HALF + m * 16) * ld + col0;
#pragma unroll
                for (int bj = 0; bj < 2; ++bj) { f32x4 v0 = acc[ai][bj][m][0], v1 = acc[ai][bj][m][1];
                    if (sg) { v0 = (f32x4){sigm(v0[0]), sigm(v0[1]), sigm(v0[2]), sigm(v0[3])}; v1 = (f32x4){sigm(v1[0]), sigm(v1[1]), sigm(v1[2]), sigm(v1[3])}; }
                    u32x4 w; w.x = cvt_pk_bf16(v0[0], v0[1]); w.y = cvt_pk_bf16(v0[2], v0[3]); w.z = cvt_pk_bf16(v1[0], v1[1]); w.w = cvt_pk_bf16(v1[2], v1[3]);
                    *(u32x4*)(rowp + bj * HALF) = w; } }
    }
};
__device__ __forceinline__ unsigned gate4_u8(float a, float b, float c, float d) {
    const unsigned ua = (unsigned)__builtin_rintf(a * 255.f), ub = (unsigned)__builtin_rintf(b * 255.f), uc = (unsigned)__builtin_rintf(c * 255.f), ud = (unsigned)__builtin_rintf(d * 255.f);
    return ua | (ub << 8) | (uc << 16) | (ud << 24);
}
struct EpiProjI8 {
    static constexpr bool PERM = true, AFTER_DRAIN = false;
    bf16_t *PQ, *PK, *PU, *PG; const float* rs; const float* cs;
    __device__ __forceinline__ void operator()(const i32x4 (&acc)[2][2][4][2], const Unit& u, int wr, int wc, int fr, int fq) const {
        asm volatile("" : "+v"(fr), "+v"(fq));
        const int pn = u.pn; bf16_t* base; int ld, colt; bool sg = false;
        if (pn < 2) { base = PQ; ld = 512; colt = pn * 256; }
        else if (pn < 4) { base = PK; ld = 512; colt = (pn - 2) * 256; }
        else if (pn < 8) { base = PU; ld = 512; colt = (pn - 6) * 256; }
        else { base = PG; ld = 2048; colt = (pn - 8) * 256; sg = true; }
        const int row0 = u.pm * BM + wr * 64 + fr, col0 = colt + wc * 32 + 8 * fq, ccol0 = pn * BM + wc * 32 + 8 * fq;
        f32x4 cv[2][2];
#pragma unroll
        for (int bj = 0; bj < 2; ++bj) { cv[bj][0] = *(const f32x4*)(cs + ccol0 + bj * HALF); cv[bj][1] = *(const f32x4*)(cs + ccol0 + bj * HALF + 4); }
#pragma unroll
        for (int ai = 0; ai < 2; ++ai)
#pragma unroll
            for (int m = 0; m < 4; ++m) { const int row = row0 + ai * HALF + m * 16; const float r = rs[row]; bf16_t* rowp = base + (size_t)row * ld + col0;
#pragma unroll
                for (int bj = 0; bj < 2; ++bj) { const i32x4 a0 = acc[ai][bj][m][0], a1 = acc[ai][bj][m][1];
                    f32x4 v0 = (f32x4){(float)a0[0], (float)a0[1], (float)a0[2], (float)a0[3]} * cv[bj][0] * r, v1 = (f32x4){(float)a1[0], (float)a1[1], (float)a1[2], (float)a1[3]} * cv[bj][1] * r;
                    if (sg) {
                        const unsigned lo = gate4_u8(sigm(v0[0]), sigm(v0[1]), sigm(v0[2]), sigm(v0[3])), hi = gate4_u8(sigm(v1[0]), sigm(v1[1]), sigm(v1[2]), sigm(v1[3]));
                        *(unsigned long long*)((unsigned char*)PG + (size_t)row * 2048 + col0 + bj * HALF) = (unsigned long long)lo | ((unsigned long long)hi << 32); }
                    else { u32x4 w; w.x = cvt_pk_bf16(v0[0], v0[1]); w.y = cvt_pk_bf16(v0[2], v0[3]); w.z = cvt_pk_bf16(v1[0], v1[1]); w.w = cvt_pk_bf16(v1[2], v1[3]);
                        *(u32x4*)(rowp + bj * HALF) = w; } } }
    }
};
struct EpiPlainScaleI8 {
    static constexpr bool PERM = true, AFTER_DRAIN = false;
    bf16_t* O; int ldc; PG8_LAS const float* rs; const float* cs;
    __device__ __forceinline__ void operator()(const i32x4 (&acc)[2][2][4][2], const Unit& u, int wr, int wc, int fr, int fq) const {
        asm volatile("" : "+v"(fr), "+v"(fq));
        const int col0 = u.pn * BM + wc * 32 + 8 * fq;
        f32x4 cv[2][2];
#pragma unroll
        for (int bj = 0; bj < 2; ++bj) { cv[bj][0] = *(const f32x4*)(cs + col0 + bj * HALF); cv[bj][1] = *(const f32x4*)(cs + col0 + bj * HALF + 4); }
#pragma unroll
        for (int ai = 0; ai < 2; ++ai)
#pragma unroll
            for (int m = 0; m < 4; ++m) { const int lr = ai * HALF + wr * 64 + m * 16 + fr; const float r = rs[lr]; bf16_t* rowp = O + (size_t)(u.pm * BM + lr) * ldc + col0;
#pragma unroll
                for (int bj = 0; bj < 2; ++bj) { const i32x4 a0 = acc[ai][bj][m][0], a1 = acc[ai][bj][m][1];
                    const f32x4 v0 = (f32x4){(float)a0[0], (float)a0[1], (float)a0[2], (float)a0[3]} * cv[bj][0] * r, v1 = (f32x4){(float)a1[0], (float)a1[1], (float)a1[2], (float)a1[3]} * cv[bj][1] * r;
                    u32x4 w; w.x = cvt_pk_bf16(v0[0], v0[1]); w.y = cvt_pk_bf16(v0[2], v0[3]); w.z = cvt_pk_bf16(v1[0], v1[1]); w.w = cvt_pk_bf16(v1[2], v1[3]);
                    *(u32x4*)(rowp + bj * HALF) = w; } }
    }
};
struct EpiPlainI8 {
    static constexpr bool PERM = true, AFTER_DRAIN = false;
    bf16_t* O; int ldc; const float* rs; const float* cs;
    __device__ __forceinline__ void operator()(const i32x4 (&acc)[2][2][4][2], const Unit& u, int wr, int wc, int fr, int fq) const {
        asm volatile("" : "+v"(fr), "+v"(fq));
        const int row0 = u.pm * BM + wr * 64 + fr, col0 = u.pn * BM + wc * 32 + 8 * fq;
        f32x4 cv[2][2];
#pragma unroll
        for (int bj = 0; bj < 2; ++bj) { cv[bj][0] = *(const f32x4*)(cs + col0 + bj * HALF); cv[bj][1] = *(const f32x4*)(cs + col0 + bj * HALF + 4); }
#pragma unroll
        for (int ai = 0; ai < 2; ++ai)
#pragma unroll
            for (int m = 0; m < 4; ++m) { const int row = row0 + ai * HALF + m * 16; const float r = rs[row]; bf16_t* rowp = O + (size_t)row * ldc + col0;
#pragma unroll
                for (int bj = 0; bj < 2; ++bj) { const i32x4 a0 = acc[ai][bj][m][0], a1 = acc[ai][bj][m][1];
                    const f32x4 v0 = (f32x4){(float)a0[0], (float)a0[1], (float)a0[2], (float)a0[3]} * cv[bj][0] * r, v1 = (f32x4){(float)a1[0], (float)a1[1], (float)a1[2], (float)a1[3]} * cv[bj][1] * r;
                    u32x4 w; w.x = cvt_pk_bf16(v0[0], v0[1]); w.y = cvt_pk_bf16(v0[2], v0[3]); w.z = cvt_pk_bf16(v1[0], v1[1]); w.w = cvt_pk_bf16(v1[2], v1[3]);
                    *(u32x4*)(rowp + bj * HALF) = w; } }
    }
};
struct EpiPlain {
    static constexpr bool PERM = true, AFTER_DRAIN = false;
    bf16_t* O; int ldc;
    __device__ __forceinline__ void operator()(const f32x4 (&acc)[2][2][4][2], const Unit& u, int wr, int wc, int fr, int fq) const {
        const int row0 = u.pm * BM + wr * 64 + fr, col0 = u.pn * BM + wc * 32 + 8 * fq;
#pragma unroll
        for (int ai = 0; ai < 2; ++ai)
#pragma unroll
            for (int m = 0; m < 4; ++m) { bf16_t* rowp = O + (size_t)(row0 + ai * HALF + m * 16) * ldc + col0;
#pragma unroll
                for (int bj = 0; bj < 2; ++bj) { const f32x4 v0 = acc[ai][bj][m][0], v1 = acc[ai][bj][m][1];
                    u32x4 w; w.x = cvt_pk_bf16(v0[0], v0[1]); w.y = cvt_pk_bf16(v0[2], v0[3]); w.z = cvt_pk_bf16(v1[0], v1[1]); w.w = cvt_pk_bf16(v1[2], v1[3]);
                    *(u32x4*)(rowp + bj * HALF) = w; } }
    }
};
struct EpiMergeChain {
    static constexpr bool PERM = true, AFTER_DRAIN = false;
    const bf16_t* G; bf16_t* MG;
    __device__ __forceinline__ void operator()(const f32x4 (&acc)[2][2][4][2], const Unit& u, int wr, int wc, int fr, int fq) const {
        const bool add = u.pn >= 4; const int goff = add ? 1024 : 0;
        const int row0 = u.pm * BM + wr * 64 + fr, col0 = (u.pn & 3) * BM + wc * 32 + 8 * fq;
        if (add) asm volatile("s_waitcnt vmcnt(0)" ::: "memory");
#pragma unroll
        for (int ai = 0; ai < 2; ++ai)
#pragma unroll
            for (int m = 0; m < 4; ++m) { const size_t row = (size_t)(row0 + ai * HALF + m * 16);
#pragma unroll
                for (int bj = 0; bj < 2; ++bj) { const f32x4 v0 = acc[ai][bj][m][0], v1 = acc[ai][bj][m][1];
                    const unsigned long long gq = *(const unsigned long long*)((const unsigned char*)G + row * 2048 + goff + col0 + bj * HALF);
                    const unsigned g0 = (unsigned)gq, g1 = (unsigned)(gq >> 32); const float k255 = 1.0f / 255.0f;
                    float r0 = (float)(g0 & 255u) * k255 * v0[0], r1 = (float)((g0 >> 8) & 255u) * k255 * v0[1], r2 = (float)((g0 >> 16) & 255u) * k255 * v0[2], r3 = (float)(g0 >> 24) * k255 * v0[3];
                    float r4 = (float)(g1 & 255u) * k255 * v1[0], r5 = (float)((g1 >> 8) & 255u) * k255 * v1[1], r6 = (float)((g1 >> 16) & 255u) * k255 * v1[2], r7 = (float)(g1 >> 24) * k255 * v1[3];
                    bf16_t* mp = MG + row * 1024 + col0 + bj * HALF;
                    if (add) { const u32x4 pw = *(const u32x4*)mp;
                        r0 += bf_lo(pw.x); r1 += bf_hi(pw.x); r2 += bf_lo(pw.y); r3 += bf_hi(pw.y); r4 += bf_lo(pw.z); r5 += bf_hi(pw.z); r6 += bf_lo(pw.w); r7 += bf_hi(pw.w); }
                    u32x4 w; w.x = cvt_pk_bf16(r0, r1); w.y = cvt_pk_bf16(r2, r3); w.z = cvt_pk_bf16(r4, r5); w.w = cvt_pk_bf16(r6, r7);
                    *(u32x4*)mp = w; }
                if (m == 3) asm volatile("" ::: "memory"); }
    }
};
__device__ __forceinline__ void lds_addf(PG8_LAS float* p, float v) { __hip_atomic_fetch_add(p, v, __ATOMIC_RELAXED, __HIP_MEMORY_SCOPE_WORKGROUP); }
__device__ __forceinline__ float quad_row_sum(float s, int lane) {
    s += __builtin_bit_cast(float, __builtin_amdgcn_ds_bpermute((lane ^ 16) << 2, __builtin_bit_cast(int, s)));
    s += __builtin_bit_cast(float, __builtin_amdgcn_ds_bpermute((lane ^ 32) << 2, __builtin_bit_cast(int, s)));
    return s;
}
struct EpiRes {
    static constexpr bool PERM = true, AFTER_DRAIN = false;
    const float* X; bf16_t* OB; PG8_LAS float* ss;
    __device__ __forceinline__ void operator()(const f32x4 (&acc)[2][2][4][2], const Unit& u, int wr, int wc, int fr, int fq) const {
        asm volatile("" : "+v"(fr), "+v"(fq));
        const int col0 = u.pn * BM + wc * 32 + 8 * fq; const int lane = fq * 16 + fr;
#pragma unroll
        for (int ai = 0; ai < 2; ++ai)
#pragma unroll
            for (int m = 0; m < 4; ++m) { const int lr = ai * HALF + wr * 64 + m * 16 + fr; const size_t xoff = (size_t)(u.pm * BM + lr) * 1024 + col0; bf16_t* op = OB + ((size_t)(2 * u.pm) * BM + lr) * 1024 + col0;
                float s = 0.f;
#pragma unroll
                for (int bj = 0; bj < 2; ++bj) { const f32x4 x0 = *(const f32x4*)(X + xoff + bj * HALF), x1 = *(const f32x4*)(X + xoff + bj * HALF + 4);
                    const f32x4 v0 = x0 + acc[ai][bj][m][0], v1 = x1 + acc[ai][bj][m][1];
                    s += (v0[0] * v0[0] + v0[1] * v0[1]) + (v0[2] * v0[2] + v0[3] * v0[3]) + (v1[0] * v1[0] + v1[1] * v1[1]) + (v1[2] * v1[2] + v1[3] * v1[3]);
                    u32x4 w; w.x = cvt_pk_bf16(v0[0], v0[1]); w.y = cvt_pk_bf16(v0[2], v0[3]); w.z = cvt_pk_bf16(v1[0], v1[1]); w.w = cvt_pk_bf16(v1[2], v1[3]);
                    *(u32x4*)(op + bj * HALF) = w; }
                s = quad_row_sum(s, lane); if (fq == 0) lds_addf(ss + lr, s);
                if (m == 3) asm volatile("" ::: "memory"); }
    }
};
struct EpiPlainScale {
    static constexpr bool PERM = true, AFTER_DRAIN = false;
    bf16_t* O; int ldc; PG8_LAS const float* rs;
    __device__ __forceinline__ void operator()(const f32x4 (&acc)[2][2][4][2], const Unit& u, int wr, int wc, int fr, int fq) const {
        asm volatile("" : "+v"(fr), "+v"(fq));
        const int col0 = u.pn * BM + wc * 32 + 8 * fq;
#pragma unroll
        for (int ai = 0; ai < 2; ++ai)
#pragma unroll
            for (int m = 0; m < 4; ++m) { const int lr = ai * HALF + wr * 64 + m * 16 + fr; const float r = rs[lr]; bf16_t* rowp = O + (size_t)(u.pm * BM + lr) * ldc + col0;
#pragma unroll
                for (int bj = 0; bj < 2; ++bj) { const f32x4 v0 = acc[ai][bj][m][0] * r, v1 = acc[ai][bj][m][1] * r;
                    u32x4 w; w.x = cvt_pk_bf16(v0[0], v0[1]); w.y = cvt_pk_bf16(v0[2], v0[3]); w.z = cvt_pk_bf16(v1[0], v1[1]); w.w = cvt_pk_bf16(v1[2], v1[3]);
                    *(u32x4*)(rowp + bj * HALF) = w; } }
    }
};
struct EpiGate {
    static constexpr bool PERM = false, AFTER_DRAIN = false;
    bf16_t* X3; const bf16_t* X2; const bf16_t* E; PG8_LAS const float* rs; PG8_LAS float* ss; long x3h; long pad_;
    __device__ __forceinline__ void operator()(const f32x4 (&acc)[2][2][4][2], const Unit& u, int wr, int wc, int fr, int fq) const {
        asm volatile("" : "+v"(fr), "+v"(fq));
        const int col0 = u.pn * BM + wc * 32 + 4 * fq; const int lane = fq * 16 + fr;
        bf16_t* const x3b = X3 + (u.pn >= 2 ? x3h : 0) + ((u.pn & 1) * BM + wc * 32 + 4 * fq);
#pragma unroll
        for (int ai = 0; ai < 2; ++ai)
#pragma unroll
            for (int m = 0; m < 4; ++m) { const int lr = ai * HALF + wr * 64 + m * 16 + fr; const float r = rs[lr];
                const size_t off = (size_t)(u.pm * BM + lr) * 1024 + col0, xo = ((size_t)(2 * u.pm) * BM + lr) * 1024 + col0; float s = 0.f;
#pragma unroll
                for (int bj = 0; bj < 2; ++bj)
#pragma unroll
                    for (int n = 0; n < 2; ++n) { const int co = bj * HALF + n * 16; const u32x2 xw = *(const u32x2*)(X2 + xo + co); const u32x2 ew = *(const u32x2*)(E + off + co); const f32x4 a = acc[ai][bj][m][n] * r;
                        f32x4 v; v[0] = bf_lo(xw.x) + sigm(a[0]) * bf_lo(ew.x); v[1] = bf_hi(xw.x) + sigm(a[1]) * bf_hi(ew.x); v[2] = bf_lo(xw.y) + sigm(a[2]) * bf_lo(ew.y); v[3] = bf_hi(xw.y) + sigm(a[3]) * bf_hi(ew.y);
                        s += (v[0] * v[0] + v[1] * v[1]) + (v[2] * v[2] + v[3] * v[3]);
                        u32x2 w3; w3.x = cvt_pk_bf16(v[0], v[1]); w3.y = cvt_pk_bf16(v[2], v[3]); *(u32x2*)(x3b + (size_t)(u.pm * BM + lr) * 512 + co) = w3; }
                s = quad_row_sum(s, lane); if (fq == 0) lds_addf(ss + lr, s);
                if (m == 3) asm volatile("" ::: "memory"); }
    }
};
}

#define GAS __attribute__((address_space(1)))
#define LAS __attribute__((address_space(3)))
typedef unsigned short bf16;
typedef unsigned v4u __attribute__((ext_vector_type(4)));
typedef unsigned v2u __attribute__((ext_vector_type(2)));
typedef float f32x4 __attribute__((ext_vector_type(4)));
typedef short bf16x8 __attribute__((ext_vector_type(8)));
typedef GAS unsigned gu32;
typedef GAS unsigned long long gu64;
#define RLX_AGENT __ATOMIC_RELAXED, __HIP_MEMORY_SCOPE_AGENT
#define LDS_WAIT() asm volatile("s_waitcnt lgkmcnt(0)" ::: "memory")
#define VM_WAIT() asm volatile("s_waitcnt vmcnt(0)" ::: "memory")
__device__ __forceinline__ unsigned long long rt() { return __builtin_amdgcn_s_memrealtime(); }
__device__ __forceinline__ unsigned f2bf(float f) { unsigned u = __builtin_bit_cast(unsigned, f); return (u + 0x7fffu + ((u >> 16) & 1u)) >> 16; }
__device__ __forceinline__ unsigned pk2(float lo, float hi) { return f2bf(lo) | (f2bf(hi) << 16); }

#define XB_TMO      128
#define XB_XCNT(j)  (256  + 64 * (j))
#define XB_XSUB(j)  (1280 + 64 * (j))
#define XB_XGEN(j)  (2304 + 64 * (j))
#define XB_TOP      3328
#define XB_TOPGEN   3392
#define XCD_BAR_WORDS 3456
#define XB_SPIN_CAP (1u << 18)

__device__ __forceinline__ unsigned xb_ld(unsigned* p)              { return __hip_atomic_load(p, __ATOMIC_RELAXED, __HIP_MEMORY_SCOPE_AGENT); }
__device__ __forceinline__ unsigned xb_add(unsigned* p, unsigned v) { return __hip_atomic_fetch_add(p, v, __ATOMIC_RELAXED, __HIP_MEMORY_SCOPE_AGENT); }
__device__ __forceinline__ unsigned xb_xcc_id() { return (unsigned)__builtin_amdgcn_s_getreg((3 << 11) | 20) & 0xFu; }
#define XB_SPIN(cond, bar) do { unsigned _sp = 0; while (cond) { __builtin_amdgcn_s_sleep(1); \
    if ((++_sp & 255u) == 0u) { if (xb_ld(&(bar)[XB_TMO])) break; if (_sp > XB_SPIN_CAP) { atomicAdd(&(bar)[XB_TMO], 1u); break; } } } } while (0)

struct XcdBarrier {
    unsigned* bar; unsigned x;
    volatile LAS unsigned* st;
};

__device__ __forceinline__ XcdBarrier xcd_barrier_post(unsigned* bar, volatile LAS unsigned* st, const bool is_t0) {
    XcdBarrier b; b.bar = bar; b.x = xb_xcc_id(); b.st = st;
    if (is_t0) (void)xb_add(&bar[XB_XCNT(b.x)], 1u);
    return b;
}
__device__ __forceinline__ void xcd_barrier_complete(unsigned* bar, unsigned x, unsigned& nloc, unsigned& nx) {
    const unsigned G = gridDim.x * gridDim.y * gridDim.z;
    unsigned sum, cnt, mine, sp = 0u;
    for (;;) {
        sum = 0u; cnt = 0u; mine = 0u;
#pragma unroll
        for (unsigned j = 0; j < 16; ++j) { const unsigned c = xb_ld(&bar[XB_XCNT(j)]); sum += c; cnt += (c > 0u) ? 1u : 0u; mine = (j == x) ? c : mine; }
        if (sum == G) break;
        __builtin_amdgcn_s_sleep(1);
        if ((++sp & 255u) == 0u) { if (xb_ld(&bar[XB_TMO])) break; if (sp > XB_SPIN_CAP) { atomicAdd(&bar[XB_TMO], 1u); break; } }
    }
    nloc = mine > 0u ? mine : 1u; nx = cnt > 0u ? cnt : 1u;
}

__device__ __forceinline__ void xcd_barrier(const XcdBarrier& b, const bool is_t0) {
    asm volatile("s_waitcnt vmcnt(0)" ::: "memory");
    __syncthreads();
    if (is_t0) {
        unsigned* bar = b.bar;
        __builtin_amdgcn_s_waitcnt(0);
        unsigned nloc = b.st[0], nx = b.st[1];
        if (nloc == 0u) { xcd_barrier_complete(bar, b.x, nloc, nx); b.st[0] = nloc; b.st[1] = nx; }
        const unsigned old = xb_add(&bar[XB_XSUB(b.x)], 1u);
        const unsigned gen = old / nloc;
        if (old + 1u == (gen + 1u) * nloc) {
            __builtin_amdgcn_fence(__ATOMIC_RELEASE, "agent");
            asm volatile("s_waitcnt vmcnt(0)" ::: "memory");
            const unsigned og = xb_add(&bar[XB_TOP], 1u);
            const unsigned tg = og / nx;
            if (og + 1u == (tg + 1u) * nx) xb_add(&bar[XB_TOPGEN], 1u);
            else XB_SPIN(xb_ld(&bar[XB_TOPGEN]) == tg, bar);
            __builtin_amdgcn_fence(__ATOMIC_ACQUIRE, "agent");
            xb_add(&bar[XB_XGEN(b.x)], 1u);
            asm volatile("s_waitcnt vmcnt(0)" ::: "memory");
        } else {
            XB_SPIN(xb_ld(&bar[XB_XGEN(b.x)]) == gen, bar);
            __builtin_amdgcn_fence(__ATOMIC_ACQUIRE, "agent");
            asm volatile("s_waitcnt vmcnt(0)" ::: "memory");
        }
    }
    __syncthreads();
}


constexpr int NWAVES = 8, NTHR = 512;
constexpr int TOK = 65536, DM = 1024, SEQ = 8192, NPANEL = 256;
constexpr float RMS_EPS = 1e-6f;
constexpr float C2 = 0.125f * 1.4426950408889634f;
constexpr float SURV_THR = 5.4210108624275222e-20f;
constexpr size_t MiB = 1u << 20;
constexpr size_t WS_CTL = 0, CTL_ZERO_BYTES = 64 * 1024;
constexpr size_t WS_WIN = 2 * MiB, WS_WOUT = 10 * MiB, WS_WQ = 12 * MiB, WS_WPG = 16 * MiB, WS_WPLE = 18 * MiB;
constexpr size_t WS_BDA = 18 * MiB + 512 * 1024, WS_BDP = 18 * MiB + 768 * 1024, WS_SK = 19 * MiB;
constexpr size_t WS_SX = 21 * MiB, WS_SBN = 21 * MiB + 262144, WS_SBQ = 21 * MiB + 262144 + 16384;
constexpr size_t WS_EU = 32 * MiB, WS_EV = 64 * MiB, WS_SU = 20 * MiB, WS_SV = 20 * MiB + 65536;
constexpr size_t WS_XN = 96 * MiB;
constexpr size_t WS_PQ = 224 * MiB, WS_PK = 288 * MiB, WS_PVT = 352 * MiB, WS_PU = 416 * MiB;
constexpr size_t WS_PG = 480 * MiB;
constexpr size_t WS_YA = 736 * MiB, WS_YP = 800 * MiB;
constexpr size_t WS_MG = 864 * MiB, WS_END = 992 * MiB;
constexpr int CW_BAR = 1024, CW_CMAX = 8192;
constexpr int RING_BYTES = 131072, LDSCTL_OFF = RING_BYTES, MISC_OFF = LDSCTL_OFF + 320, LDS_BYTES = 147456;

typedef float f32x16 __attribute__((ext_vector_type(16)));
typedef float f32x2 __attribute__((ext_vector_type(2)));
typedef __bf16 bf16x2v __attribute__((ext_vector_type(2)));

__device__ __forceinline__ int shx(int v, int m, int lane) { return __builtin_amdgcn_ds_bpermute((lane ^ m) << 2, v); }
__device__ __forceinline__ float shx(float v, int m, int lane) { return __builtin_bit_cast(float, __builtin_amdgcn_ds_bpermute((lane ^ m) << 2, __builtin_bit_cast(int, v))); }
__device__ __forceinline__ float shl_(float v, int src) { return __builtin_bit_cast(float, __builtin_amdgcn_ds_bpermute(src << 2, __builtin_bit_cast(int, v))); }
__device__ __forceinline__ float wave_sum(float v, int lane) {
#pragma unroll
    for (int o = 1; o < 64; o <<= 1) v += shx(v, o, lane);
    return v;
}
__device__ __forceinline__ float bflo(unsigned w) { return __uint_as_float(w << 16); }
__device__ __forceinline__ float bfhi(unsigned w) { return __uint_as_float(w & 0xffff0000u); }
__device__ __forceinline__ unsigned cvtpk(float lo, float hi) { return pg8::cvt_pk_bf16(lo, hi); }

#define H_UNPACK(H, A, B) do { H[0] = bflo(A.x); H[1] = bfhi(A.x); H[2] = bflo(A.y); H[3] = bfhi(A.y); H[4] = bflo(A.z); H[5] = bfhi(A.z); H[6] = bflo(A.w); H[7] = bfhi(A.w); \
        H[8] = bflo(B.x); H[9] = bfhi(B.x); H[10] = bflo(B.y); H[11] = bfhi(B.y); H[12] = bflo(B.z); H[13] = bfhi(B.z); H[14] = bflo(B.w); H[15] = bfhi(B.w); } while (0)
__device__ __forceinline__ void p0_transpose_item(const float* W, int K, int N, bf16* WT, const float* kscale, int nlo, float nls, LAS float* scr, int item, int lane) {
    const int nblk = N / 32, kb = item / nblk, nb = item % nblk, k0 = 64 * kb, n0 = 32 * nb;
    const float ns = (n0 + (lane & 31)) < nlo ? nls : 1.0f;
#pragma unroll 8
    for (int i = 0; i < 32; ++i) { const int kk = 2 * i + (lane >> 5); float v = W[(size_t)(k0 + kk) * N + n0 + (lane & 31)] * ns; if (kscale) v *= kscale[k0 + kk]; scr[kk * 33 + (lane & 31)] = v; }
    LDS_WAIT(); asm volatile("" ::: "memory");
    const int c = lane & 7;
#pragma unroll
    for (int j = 0; j < 4; ++j) { const int n = (lane >> 3) + 8 * j; const LAS float* s = scr + (8 * c) * 33 + n;
        v4u o; o.x = pk2(s[0 * 33], s[1 * 33]); o.y = pk2(s[2 * 33], s[3 * 33]); o.z = pk2(s[4 * 33], s[5 * 33]); o.w = pk2(s[6 * 33], s[7 * 33]);
        *(GAS v4u*)(WT + (size_t)(n0 + n) * K + k0 + 8 * c) = o; }
    LDS_WAIT(); asm volatile("" ::: "memory");
}
__device__ __forceinline__ void rms_rows4_to_bf16(const float* xrow, bf16* orow, size_t rstride, int lane) {
    f32x4 v[4][4]; float s[4];
#pragma unroll
    for (int k = 0; k < 4; ++k) { const GAS f32x4* xr = (const GAS f32x4*)(xrow + k * rstride) + lane;
#pragma unroll
        for (int j = 0; j < 4; ++j) v[k][j] = xr[64 * j]; }
#pragma unroll
    for (int k = 0; k < 4; ++k) { s[k] = 0.f;
#pragma unroll
        for (int j = 0; j < 4; ++j) s[k] += (v[k][j].x * v[k][j].x + v[k][j].y * v[k][j].y) + (v[k][j].z * v[k][j].z + v[k][j].w * v[k][j].w); }
#pragma unroll
    for (int o = 1; o < 64; o <<= 1) {
#pragma unroll
        for (int k = 0; k < 4; ++k) s[k] += shx(s[k], o, lane); }
#pragma unroll
    for (int k = 0; k < 4; ++k) { const float r = 1.f / sqrtf(s[k] * (1.f / DM) + RMS_EPS);
        GAS unsigned long long* o8 = (GAS unsigned long long*)(orow + k * rstride) + lane;
#pragma unroll
        for (int j = 0; j < 4; ++j) o8[64 * j] = (unsigned long long)pk2(v[k][j].x * r, v[k][j].y * r) | ((unsigned long long)pk2(v[k][j].z * r, v[k][j].w * r) << 32); }
}
__device__ __forceinline__ unsigned pack4_i8(float a, float b, float c, float d) {
    const int qa = (int)__builtin_rintf(a), qb = (int)__builtin_rintf(b), qc = (int)__builtin_rintf(c), qd = (int)__builtin_rintf(d);
    return (unsigned)(qa & 255) | ((unsigned)(qb & 255) << 8) | ((unsigned)(qc & 255) << 16) | ((unsigned)qd << 24);
}
__device__ __forceinline__ void rms_rows4_to_i8(const float* xrow, unsigned char* orow, float* sc, size_t rstride, size_t sstride, int lane) {
    f32x4 v[4][4]; float s[4], m[4];
#pragma unroll
    for (int k = 0; k < 4; ++k) { const GAS f32x4* xr = (const GAS f32x4*)(xrow + k * rstride) + lane;
#pragma unroll
        for (int j = 0; j < 4; ++j) v[k][j] = xr[64 * j]; }
#pragma unroll
    for (int k = 0; k < 4; ++k) { s[k] = 0.f; m[k] = 0.f;
#pragma unroll
        for (int j = 0; j < 4; ++j) { s[k] += (v[k][j].x * v[k][j].x + v[k][j].y * v[k][j].y) + (v[k][j].z * v[k][j].z + v[k][j].w * v[k][j].w);
            m[k] = fmaxf(m[k], fmaxf(fmaxf(fabsf(v[k][j].x), fabsf(v[k][j].y)), fmaxf(fabsf(v[k][j].z), fabsf(v[k][j].w)))); } }
#pragma unroll
    for (int o = 1; o < 64; o <<= 1) {
#pragma unroll
        for (int k = 0; k < 4; ++k) { s[k] += shx(s[k], o, lane); m[k] = fmaxf(m[k], shx(m[k], o, lane)); } }
#pragma unroll
    for (int k = 0; k < 4; ++k) { const float r = 1.f / sqrtf(s[k] * (1.f / DM) + RMS_EPS); const float qs = m[k] > 0.f ? 127.0f / m[k] : 1.0f;
        GAS unsigned* o4 = (GAS unsigned*)(orow + k * rstride) + lane;
#pragma unroll
        for (int j = 0; j < 4; ++j) o4[64 * j] = pack4_i8(v[k][j].x * qs, v[k][j].y * qs, v[k][j].z * qs, v[k][j].w * qs);
        if (lane == 0) sc[k * sstride] = (m[k] > 0.f ? m[k] * (1.0f / 127.0f) : 1.0f) * r; }
}
__device__ __forceinline__ void p0_colmax_item(const float* W, int N, unsigned* cmax, const float* kscale, int nlo, float nls, int item, int lane) {
    const int nblk = N / 64, ks = item / nblk, nb = item % nblk, n = 64 * nb + lane;
    const float ns = n < nlo ? nls : 1.0f;
    const float* wp = W + (size_t)(32 * ks) * N + n; const float* kp = kscale + 32 * ks;
    float m = 0.f;
#pragma unroll 8
    for (int i = 0; i < 32; ++i) { m = fmaxf(m, fabsf(wp[0] * ns * kp[i])); wp += N; }
    __hip_atomic_fetch_max(cmax + n, __float_as_uint(m), __ATOMIC_RELAXED, __HIP_MEMORY_SCOPE_AGENT);
}
__device__ __forceinline__ void p0_quant_tile_item(const float* W, int N, unsigned char* WT8, float* colsc, const unsigned* cmax, const float* kscale, int nlo, float nls, LAS float* scr, int item, int lane) {
    const int K = 1024; const int nblk = N / 32, kb = item / nblk, nb = item % nblk, k0 = 64 * kb, n0 = 32 * nb;
    const float cm = __uint_as_float(cmax[n0 + (lane & 31)]);
    const float ns = ((n0 + (lane & 31)) < nlo ? nls : 1.0f) * (cm > 0.f ? 127.0f / cm : 1.0f);
    if (kb == 0 && lane < 32) colsc[n0 + lane] = cm > 0.f ? cm * (1.0f / 127.0f) : 1.0f;
#pragma unroll 8
    for (int i = 0; i < 32; ++i) { const int kk = 2 * i + (lane >> 5); scr[kk * 33 + (lane & 31)] = W[(size_t)(k0 + kk) * N + n0 + (lane & 31)] * ns * kscale[k0 + kk]; }
    LDS_WAIT(); asm volatile("" ::: "memory");
    const int c = lane & 7;
#pragma unroll
    for (int j = 0; j < 4; ++j) { const int n = (lane >> 3) + 8 * j; const LAS float* s = scr + (8 * c) * 33 + n;
        const unsigned lo = pack4_i8(s[0 * 33], s[1 * 33], s[2 * 33], s[3 * 33]), hi = pack4_i8(s[4 * 33], s[5 * 33], s[6 * 33], s[7 * 33]);
        *(GAS unsigned long long*)(WT8 + (size_t)(n0 + n) * K + k0 + 8 * c) = (unsigned long long)lo | ((unsigned long long)hi << 32); }
    LDS_WAIT(); asm volatile("" ::: "memory");
}
__device__ __forceinline__ void cvt8_store(const float* src, bf16* dst) {
    const f32x4 a = *(const GAS f32x4*)src, b = *(const GAS f32x4*)(src + 4);
    v4u o; o.x = pk2(a.x, a.y); o.y = pk2(a.z, a.w); o.z = pk2(b.x, b.y); o.w = pk2(b.z, b.w);
    *(GAS v4u*)dst = o;
}

__device__ __forceinline__ void attn_panel(int panel, const bf16* PQ, const bf16* PK, const bf16* PVT, bf16* YA, const int wid0) {
    const int tid = otid(wid0), lane = tid & 63, wid = __builtin_amdgcn_readfirstlane(tid >> 6);
    const int r32 = lane & 31, hh = lane >> 5;
    const size_t seq0 = (size_t)(panel >> 5) * SEQ;
    const int pos0 = (panel & 31) * 256 + wid * 32;
    const int kap = 16 * ((r32 >> 2) & 1) + (r32 & 3) + 4 * (r32 >> 3);
    for (int h = 0; h < 8; ++h) {
        bf16x8 qf[4];
        { const bf16* qrow = PQ + (seq0 + pos0 + r32) * 512 + h * 64 + 8 * hh;
#pragma unroll
          for (int s = 0; s < 4; ++s) qf[s] = *(const GAS bf16x8*)(qrow + 16 * s); }
        f32x16 o0 = {}, o1 = {};
        float Sin = 1.f;
        for (int kb = pos0; kb >= 0; kb -= 32) {
            const bf16* krow = PK + (seq0 + kb + kap) * 512 + h * 64 + 8 * hh;
            const bf16* vrow = PVT + (size_t)(h * 64 + kap) * TOK + seq0 + kb + 16 * hh;
            bf16x8 kf[4], vf[2][2];
#pragma unroll
            for (int s = 0; s < 4; ++s) kf[s] = *(const GAS bf16x8*)(krow + 16 * s);
#pragma unroll
            for (int db = 0; db < 2; ++db)
#pragma unroll
                for (int s = 0; s < 2; ++s) vf[db][s] = *(const GAS bf16x8*)(vrow + (size_t)db * 32 * TOK + 8 * s);
            f32x16 z = {};
#pragma unroll
            for (int s = 0; s < 4; ++s) z = __builtin_amdgcn_mfma_f32_32x32x16_bf16(kf[s], qf[s], z, 0, 0, 0);
            const bool diag = (kb == pos0);
            float w[16]; float Sl = 1.f;
#pragma unroll
            for (int reg = 15; reg >= 0; --reg) {
                float beta = __builtin_amdgcn_rcpf(1.0f + __builtin_amdgcn_exp2f(-z[reg]));
                if (diag && (16 * hh + reg >= r32)) beta = 0.f;
                const float wl = beta * Sl; Sl -= wl; w[reg] = wl;
            }
            const float Pp = shx(Sl, 32, lane);
            const float scale = hh ? Sin : Sin * Pp;
            Sin = Sin * Sl * Pp;
            v4u pw0, pw1;
            pw0.x = cvtpk(w[0] * scale, w[1] * scale); pw0.y = cvtpk(w[2] * scale, w[3] * scale); pw0.z = cvtpk(w[4] * scale, w[5] * scale); pw0.w = cvtpk(w[6] * scale, w[7] * scale);
            pw1.x = cvtpk(w[8] * scale, w[9] * scale); pw1.y = cvtpk(w[10] * scale, w[11] * scale); pw1.z = cvtpk(w[12] * scale, w[13] * scale); pw1.w = cvtpk(w[14] * scale, w[15] * scale);
            const bf16x8 p0 = __builtin_bit_cast(bf16x8, pw0), p1 = __builtin_bit_cast(bf16x8, pw1);
            o0 = __builtin_amdgcn_mfma_f32_32x32x16_bf16(vf[0][0], p0, o0, 0, 0, 0);
            o0 = __builtin_amdgcn_mfma_f32_32x32x16_bf16(vf[0][1], p1, o0, 0, 0, 0);
            o1 = __builtin_amdgcn_mfma_f32_32x32x16_bf16(vf[1][0], p0, o1, 0, 0, 0);
            o1 = __builtin_amdgcn_mfma_f32_32x32x16_bf16(vf[1][1], p1, o1, 0, 0, 0);
            if (__all(Sin < SURV_THR)) break;
        }
        bf16* orow = YA + (seq0 + pos0 + r32) * 512 + h * 64 + 16 * hh;
        v4u a, b2;
        a.x = cvtpk(o0[0], o0[1]); a.y = cvtpk(o0[2], o0[3]); a.z = cvtpk(o0[4], o0[5]); a.w = cvtpk(o0[6], o0[7]);
        b2.x = cvtpk(o0[8], o0[9]); b2.y = cvtpk(o0[10], o0[11]); b2.z = cvtpk(o0[12], o0[13]); b2.w = cvtpk(o0[14], o0[15]);
        *(GAS v4u*)orow = a; *(GAS v4u*)(orow + 8) = b2;
        a.x = cvtpk(o1[0], o1[1]); a.y = cvtpk(o1[2], o1[3]); a.z = cvtpk(o1[4], o1[5]); a.w = cvtpk(o1[6], o1[7]);
        b2.x = cvtpk(o1[8], o1[9]); b2.y = cvtpk(o1[10], o1[11]); b2.z = cvtpk(o1[12], o1[13]); b2.w = cvtpk(o1[14], o1[15]);
        *(GAS v4u*)(orow + 32) = a; *(GAS v4u*)(orow + 40) = b2;
    }
}

__device__ __forceinline__ void pool_panel(int panel, const bf16* PU, bf16* YP, const int wid0) {
    const int tid = otid(wid0);
    const int chunk = tid & 63, tg = tid >> 6, w = 2 << (chunk >> 4);
    const int posb = (panel & 31) * 256; const size_t row0 = (size_t)panel * 256;
    float s[8];
#pragma unroll
    for (int k = 0; k < 8; ++k) s[k] = 0.f;
    { const int t = tg * 32, pos = posb + t, cnt = (pos + 1 < w) ? (pos + 1) : w;
      for (int j = 1; j < cnt; ++j) { const v4u v = *(const GAS v4u*)(PU + (row0 + t - j) * 512 + chunk * 8);
          s[0] += bflo(v.x); s[1] += bfhi(v.x); s[2] += bflo(v.y); s[3] += bfhi(v.y); s[4] += bflo(v.z); s[5] += bfhi(v.z); s[6] += bflo(v.w); s[7] += bfhi(v.w); } }
    for (int i = 0; i < 32; ++i) {
        const int t = tg * 32 + i, pos = posb + t, cnt = (pos + 1 < w) ? (pos + 1) : w;
        const v4u cur = *(const GAS v4u*)(PU + (row0 + t) * 512 + chunk * 8);
        s[0] += bflo(cur.x); s[1] += bfhi(cur.x); s[2] += bflo(cur.y); s[3] += bfhi(cur.y); s[4] += bflo(cur.z); s[5] += bfhi(cur.z); s[6] += bflo(cur.w); s[7] += bfhi(cur.w);
        const float ic = 1.0f / (float)cnt;
        v4u o;
        o.x = cvtpk(s[0] * ic - bflo(cur.x), s[1] * ic - bfhi(cur.x)); o.y = cvtpk(s[2] * ic - bflo(cur.y), s[3] * ic - bfhi(cur.y));
        o.z = cvtpk(s[4] * ic - bflo(cur.z), s[5] * ic - bfhi(cur.z)); o.w = cvtpk(s[6] * ic - bflo(cur.w), s[7] * ic - bfhi(cur.w));
        *(GAS v4u*)(YP + (row0 + t) * 512 + chunk * 8) = o;
        if (pos + 1 >= w) {
            const v4u v = *(const GAS v4u*)(PU + (row0 + t - (w - 1)) * 512 + chunk * 8);
            s[0] -= bflo(v.x); s[1] -= bfhi(v.x); s[2] -= bflo(v.y); s[3] -= bfhi(v.y); s[4] -= bflo(v.z); s[5] -= bfhi(v.z); s[6] -= bflo(v.w); s[7] -= bfhi(v.w);
        }
    }
}

#define HD __host__ __device__ __forceinline__
HD int f2s(float f) { int i = __builtin_bit_cast(int, f); return i ^ ((i >> 31) & 0x7fffffff); }
HD float s2f(int i) { i ^= ((i >> 31) & 0x7fffffff); return __builtin_bit_cast(float, i); }
HD void ce_desc(int& a, int& b) { const int mx = a > b ? a : b, mn = a > b ? b : a; a = mx; b = mn; }
template <int J, int K> HD void bpass16(int (&v)[16]) {
#pragma unroll
    for (int i = 0; i < 16; ++i) { const int l = i ^ J; if (l > i) { if ((i & K) == 0) ce_desc(v[i], v[l]); else ce_desc(v[l], v[i]); } }
}
HD void bitonic_sort16_desc(int (&v)[16]) {
    bpass16<1, 2>(v); bpass16<2, 4>(v); bpass16<1, 4>(v); bpass16<4, 8>(v); bpass16<2, 8>(v); bpass16<1, 8>(v);
    bpass16<8, 16>(v); bpass16<4, 16>(v); bpass16<2, 16>(v); bpass16<1, 16>(v);
}
HD void bitonic_merge16_desc(int (&v)[16]) {
    bpass16<8, 16>(v); bpass16<4, 16>(v); bpass16<2, 16>(v); bpass16<1, 16>(v);
}
HD void merge_prune16(int (&x)[16], const int (&y)[16]) {
#pragma unroll
    for (int i = 0; i < 16; ++i) x[i] = x[i] > y[15 - i] ? x[i] : y[15 - i];
    bitonic_merge16_desc(x);
}
HD int cx_i(int hf, int t) { if (hf == 0) return 0; return t < 5 ? 2 : t < 9 ? 3 : t < 12 ? 4 : t < 14 ? 5 : 6; }
HD int cx_j(int hf, int t) { if (hf == 0) return t; return t < 5 ? t : t < 9 ? t - 5 : t < 12 ? t - 9 : t < 14 ? t - 12 : t - 14; }
HD int cy_i(int hf, int t) { if (hf == 0) return t < 8 ? 1 : 23 - t; return 7; }
HD int cy_j(int hf, int t) { if (hf == 0) return t < 8 ? t : 0; return t; }

__device__ __forceinline__ void top16_of_group(const bf16x8 (&qf)[8], LAS const unsigned char* skl, int r32, int hh, int lane, int (&res)[16]) {
    int v[4][16];
#pragma unroll
    for (int kb = 0; kb < 4; ++kb) {
        f32x16 acc = {};
#pragma unroll
        for (int s = 0; s < 8; ++s) { const bf16x8 af = *(LAS const bf16x8*)(skl + (32 * kb + r32) * 272 + 32 * s + 16 * hh); acc = __builtin_amdgcn_mfma_f32_32x32x16_bf16(af, qf[s], acc, 0, 0, 0); }
#pragma unroll
        for (int reg = 0; reg < 16; ++reg) { const int keyid = 32 * kb + (reg & 3) + 8 * (reg >> 2) + 4 * hh; v[kb][reg] = (f2s(acc[reg]) & ~127) | keyid; }
    }
    bitonic_sort16_desc(v[0]); bitonic_sort16_desc(v[1]); bitonic_sort16_desc(v[2]); bitonic_sort16_desc(v[3]);
    merge_prune16(v[0], v[1]); merge_prune16(v[2], v[3]); merge_prune16(v[0], v[2]);
    int y[16];
#pragma unroll
    for (int i = 0; i < 16; ++i) y[i] = shx(v[0][i], 32, lane);
    merge_prune16(v[0], y);
#pragma unroll
    for (int i = 0; i < 16; ++i) res[i] = v[0][i];
}

__device__ __forceinline__ void topk_panel(int panel, const bf16* QP, const bf16* SK, int* IDXp, float* GTp  , LAS unsigned char* ldsb  , const int wid0) {
    const int tid = otid(wid0), lane = tid & 63, wid = __builtin_amdgcn_readfirstlane(tid >> 6);
    const int r32 = lane & 31, hh = lane >> 5;
    const int lrow = wid * 32 + r32;
    const size_t row = (size_t)panel * 256 + lrow;
    LAS int* lut = (LAS int*)ldsb; LAS unsigned char* skl = ldsb + 65536;
    v4u skr[4];
#define SK_FETCH(g_) do { _Pragma("unroll") for (int i = 0; i < 4; ++i) skr[i] = *((const GAS v4u*)(SK + (size_t)(g_) * 128 * 128) + i * 512 + tid); } while (0)
#define SK_STAGE() do { _Pragma("unroll") for (int i = 0; i < 4; ++i) { const int p = i * 512 + tid; *(LAS v4u*)(skl + (p >> 4) * 272 + (p & 15) * 16) = skr[i]; } } while (0)
    bf16x8 qn[8];
#define Q_FETCH(g_) do { const bf16* qrow_ = QP + row * 2048 + (g_) * 128 + 8 * hh; _Pragma("unroll") for (int s = 0; s < 8; ++s) qn[s] = *(const GAS bf16x8*)(qrow_ + 16 * s); } while (0)
    SK_FETCH(0); Q_FETCH(0);
    for (int h = 0; h < 8; ++h) {
        int a[16], b[16];
#pragma unroll
        for (int c = 0; c < 2; ++c) {
            const int g = 2 * h + c;
            bf16x8 qf[8];
#pragma unroll
            for (int s = 0; s < 8; ++s) qf[s] = qn[s];
            __syncthreads();
            SK_STAGE();
            __syncthreads();
            if (g < 15) { SK_FETCH(g + 1); Q_FETCH(g + 1); }
            if (c == 0) top16_of_group(qf, skl, r32, hh, lane, a); else top16_of_group(qf, skl, r32, hh, lane, b);
        }
        float fa[16], fb[16];
#pragma unroll
        for (int i = 0; i < 16; ++i) { fa[i] = s2f(a[i] & ~127); fb[i] = s2f(b[i] & ~127); lut[i * 512 + tid] = a[i] & 127; lut[(16 + i) * 512 + tid] = b[i] & 127; }
        int X[16], Y[16];
#pragma unroll
        for (int t = 0; t < 16; ++t) {
            const float s0 = fa[cx_i(0, t)] + fb[cx_j(0, t)], s1 = fa[cx_i(1, t)] + fb[cx_j(1, t)];
            const int c0 = cx_i(0, t) * 16 + cx_j(0, t), c1 = cx_i(1, t) * 16 + cx_j(1, t);
            X[t] = hh ? ((f2s(s1) & ~255) | c1) : ((f2s(s0) & ~255) | c0);
            const float u0 = fa[cy_i(0, t)] + fb[cy_j(0, t)];
            const int d0 = cy_i(0, t) * 16 + cy_j(0, t);
            int y1 = (int)0x80000000;
            if (t < 2) { const float u1 = fa[cy_i(1, t)] + fb[cy_j(1, t)]; y1 = (f2s(u1) & ~255) | (cy_i(1, t) * 16 + cy_j(1, t)); }
            Y[t] = hh ? y1 : ((f2s(u0) & ~255) | d0);
        }
        bitonic_sort16_desc(X); bitonic_merge16_desc(Y); merge_prune16(X, Y);
#pragma unroll
        for (int i = 0; i < 16; ++i) Y[i] = shx(X[i], 32, lane);
        merge_prune16(X, Y);
        const float mx = s2f(X[0] & ~255);
        float ex[16], den = 0.f;
#pragma unroll
        for (int i = 0; i < 16; ++i) { ex[i] = __builtin_amdgcn_exp2f((s2f(X[i] & ~255) - mx) * 1.4426950408889634f); den += ex[i]; }
        const float rden = 1.0f / den;
        int oi[8]; float og[8];
#pragma unroll
        for (int t = 0; t < 8; ++t) {
            const int msk = -hh;
            const int code = (X[t] ^ ((X[t] ^ X[8 + t]) & msk)) & 255;
            const int e1 = lut[(code >> 4) * 512 + tid], e2 = lut[(16 + (code & 15)) * 512 + tid];
            const int exl = __builtin_bit_cast(int, ex[t]), exh = __builtin_bit_cast(int, ex[8 + t]);
            oi[t] = e1 * 128 + e2; og[t] = __builtin_bit_cast(float, exl ^ ((exl ^ exh) & msk)) * rden;
        }
        int* ip = IDXp + lrow * 128 + h * 16 + 8 * hh; float* gp = GTp + lrow * 128 + h * 16 + 8 * hh;
        *(GAS v4u*)ip = (v4u){(unsigned)oi[0], (unsigned)oi[1], (unsigned)oi[2], (unsigned)oi[3]}; *(GAS v4u*)(ip + 4) = (v4u){(unsigned)oi[4], (unsigned)oi[5], (unsigned)oi[6], (unsigned)oi[7]};
        *(GAS f32x4*)gp = (f32x4){og[0], og[1], og[2], og[3]}; *(GAS f32x4*)(gp + 4) = (f32x4){og[4], og[5], og[6], og[7]};
    }
#undef SK_FETCH
#undef SK_STAGE
#undef Q_FETCH
}

typedef float f32x2v __attribute__((ext_vector_type(2)));
__device__ __forceinline__ void quant_row_fp8(const float* src, const float* colgain, unsigned char* dst, float* sc_out, int lane) {
    const GAS f32x4* s = (const GAS f32x4*)src + 4 * lane;
    f32x4 v[4]; float m = 0.f;
#pragma unroll
    for (int j = 0; j < 4; ++j) { v[j] = s[j]; if (colgain) v[j] = v[j] * ((const GAS f32x4*)colgain + 4 * lane)[j]; m = fmaxf(m, fmaxf(fmaxf(fabsf(v[j].x), fabsf(v[j].y)), fmaxf(fabsf(v[j].z), fabsf(v[j].w)))); }
#pragma unroll
    for (int o = 1; o < 64; o <<= 1) m = fmaxf(m, shx(m, o, lane));
    const float sc = m > 0.f ? 224.0f / m : 1.0f;
    v4u w;
    { int t = 0; t = __builtin_amdgcn_cvt_pk_fp8_f32(v[0].x * sc, v[0].y * sc, t, false); t = __builtin_amdgcn_cvt_pk_fp8_f32(v[0].z * sc, v[0].w * sc, t, true); w.x = (unsigned)t; }
    { int t = 0; t = __builtin_amdgcn_cvt_pk_fp8_f32(v[1].x * sc, v[1].y * sc, t, false); t = __builtin_amdgcn_cvt_pk_fp8_f32(v[1].z * sc, v[1].w * sc, t, true); w.y = (unsigned)t; }
    { int t = 0; t = __builtin_amdgcn_cvt_pk_fp8_f32(v[2].x * sc, v[2].y * sc, t, false); t = __builtin_amdgcn_cvt_pk_fp8_f32(v[2].z * sc, v[2].w * sc, t, true); w.z = (unsigned)t; }
    { int t = 0; t = __builtin_amdgcn_cvt_pk_fp8_f32(v[3].x * sc, v[3].y * sc, t, false); t = __builtin_amdgcn_cvt_pk_fp8_f32(v[3].z * sc, v[3].w * sc, t, true); w.w = (unsigned)t; }
    *(GAS v4u*)(dst + 16 * lane) = w;
    if (lane == 0) *sc_out = m > 0.f ? m * (1.0f / 224.0f) : 1.0f;
}
__device__ __forceinline__ v4u quant16_fp8(const f32x4 (&v)[4], float sc) {
    v4u w;
    { int t = 0; t = __builtin_amdgcn_cvt_pk_fp8_f32(v[0].x * sc, v[0].y * sc, t, false); t = __builtin_amdgcn_cvt_pk_fp8_f32(v[0].z * sc, v[0].w * sc, t, true); w.x = (unsigned)t; }
    { int t = 0; t = __builtin_amdgcn_cvt_pk_fp8_f32(v[1].x * sc, v[1].y * sc, t, false); t = __builtin_amdgcn_cvt_pk_fp8_f32(v[1].z * sc, v[1].w * sc, t, true); w.y = (unsigned)t; }
    { int t = 0; t = __builtin_amdgcn_cvt_pk_fp8_f32(v[2].x * sc, v[2].y * sc, t, false); t = __builtin_amdgcn_cvt_pk_fp8_f32(v[2].z * sc, v[2].w * sc, t, true); w.z = (unsigned)t; }
    { int t = 0; t = __builtin_amdgcn_cvt_pk_fp8_f32(v[3].x * sc, v[3].y * sc, t, false); t = __builtin_amdgcn_cvt_pk_fp8_f32(v[3].z * sc, v[3].w * sc, t, true); w.w = (unsigned)t; }
    return w;
}
__device__ __forceinline__ v4u quant16_i8(const f32x4 (&v)[4], float sc) {
    v4u w; w.x = pack4_i8(v[0].x * sc, v[0].y * sc, v[0].z * sc, v[0].w * sc); w.y = pack4_i8(v[1].x * sc, v[1].y * sc, v[1].z * sc, v[1].w * sc);
    w.z = pack4_i8(v[2].x * sc, v[2].y * sc, v[2].z * sc, v[2].w * sc); w.w = pack4_i8(v[3].x * sc, v[3].y * sc, v[3].z * sc, v[3].w * sc); return w;
}
__device__ __forceinline__ void quant_rows2_fp8(const float* srcA, const float* gainA, unsigned char* dstA, float* scA, const float* srcB, unsigned char* dstB, float* scB, int lane) {
    f32x4 va[4], vb[4];
#pragma unroll
    for (int j = 0; j < 4; ++j) { va[j] = ((const GAS f32x4*)srcA + 4 * lane)[j]; vb[j] = ((const GAS f32x4*)srcB + 4 * lane)[j]; }
    float ma = 0.f, mb = 0.f;
#pragma unroll
    for (int j = 0; j < 4; ++j) { va[j] = va[j] * ((const GAS f32x4*)gainA + 4 * lane)[j];
        ma = fmaxf(ma, fmaxf(fmaxf(fabsf(va[j].x), fabsf(va[j].y)), fmaxf(fabsf(va[j].z), fabsf(va[j].w))));
        mb = fmaxf(mb, fmaxf(fmaxf(fabsf(vb[j].x), fabsf(vb[j].y)), fmaxf(fabsf(vb[j].z), fabsf(vb[j].w)))); }
#pragma unroll
    for (int o = 1; o < 64; o <<= 1) { ma = fmaxf(ma, shx(ma, o, lane)); mb = fmaxf(mb, shx(mb, o, lane)); }
    *(GAS v4u*)(dstA + 16 * lane) = quant16_i8(va, ma > 0.f ? 127.0f / ma : 1.0f);
    *(GAS v4u*)(dstB + 16 * lane) = quant16_fp8(vb, mb > 0.f ? 224.0f / mb : 1.0f);
    if (lane == 0) { *scA = ma > 0.f ? ma * (1.0f / 127.0f) : 1.0f; *scB = mb > 0.f ? mb * (1.0f / 224.0f) : 1.0f; }
}
__device__ __forceinline__ void p0_rows4_expert(const float* xrow, unsigned char* orow, float* sc, size_t rstride, size_t sstride,
                                                const float* srcA, const float* gainA, unsigned char* dstA, float* scA, const float* srcB, unsigned char* dstB, float* scB, int lane) {
    f32x4 v[4][4], va[4], vb[4], ga[4]; float s[4], m[4];
#pragma unroll
    for (int k = 0; k < 4; ++k) { const GAS f32x4* xr = (const GAS f32x4*)(xrow + k * rstride) + lane;
#pragma unroll
        for (int j = 0; j < 4; ++j) v[k][j] = xr[64 * j]; }
#pragma unroll
    for (int j = 0; j < 4; ++j) { va[j] = ((const GAS f32x4*)srcA + 4 * lane)[j]; vb[j] = ((const GAS f32x4*)srcB + 4 * lane)[j]; ga[j] = ((const GAS f32x4*)gainA + 4 * lane)[j]; }
#pragma unroll
    for (int k = 0; k < 4; ++k) { s[k] = 0.f; m[k] = 0.f;
#pragma unroll
        for (int j = 0; j < 4; ++j) { s[k] += (v[k][j].x * v[k][j].x + v[k][j].y * v[k][j].y) + (v[k][j].z * v[k][j].z + v[k][j].w * v[k][j].w);
            m[k] = fmaxf(m[k], fmaxf(fmaxf(fabsf(v[k][j].x), fabsf(v[k][j].y)), fmaxf(fabsf(v[k][j].z), fabsf(v[k][j].w)))); } }
    float ma = 0.f, mb = 0.f;
#pragma unroll
    for (int j = 0; j < 4; ++j) { va[j] = va[j] * ga[j];
        ma = fmaxf(ma, fmaxf(fmaxf(fabsf(va[j].x), fabsf(va[j].y)), fmaxf(fabsf(va[j].z), fabsf(va[j].w))));
        mb = fmaxf(mb, fmaxf(fmaxf(fabsf(vb[j].x), fabsf(vb[j].y)), fmaxf(fabsf(vb[j].z), fabsf(vb[j].w)))); }
#pragma unroll
    for (int o = 1; o < 64; o <<= 1) {
#pragma unroll
        for (int k = 0; k < 4; ++k) { s[k] += shx(s[k], o, lane); m[k] = fmaxf(m[k], shx(m[k], o, lane)); }
        ma = fmaxf(ma, shx(ma, o, lane)); mb = fmaxf(mb, shx(mb, o, lane)); }
#pragma unroll
    for (int k = 0; k < 4; ++k) { const float r = 1.f / sqrtf(s[k] * (1.f / DM) + RMS_EPS); const float qs = m[k] > 0.f ? 127.0f / m[k] : 1.0f;
        GAS unsigned* o4 = (GAS unsigned*)(orow + k * rstride) + lane;
#pragma unroll
        for (int j = 0; j < 4; ++j) o4[64 * j] = pack4_i8(v[k][j].x * qs, v[k][j].y * qs, v[k][j].z * qs, v[k][j].w * qs);
        if (lane == 0) sc[k * sstride] = (m[k] > 0.f ? m[k] * (1.0f / 127.0f) : 1.0f) * r; }
    *(GAS v4u*)(dstA + 16 * lane) = quant16_i8(va, ma > 0.f ? 127.0f / ma : 1.0f);
    *(GAS v4u*)(dstB + 16 * lane) = quant16_fp8(vb, mb > 0.f ? 224.0f / mb : 1.0f);
    if (lane == 0) { *scA = ma > 0.f ? ma * (1.0f / 127.0f) : 1.0f; *scB = mb > 0.f ? mb * (1.0f / 224.0f) : 1.0f; }
}
__device__ __forceinline__ void peer_hq_panel(const bf16* X1B, unsigned char* H8p, LAS const float* r1, LAS float* s1h, const int wid0) {
    const int tid = otid(wid0), lane = tid & 63, wid = __builtin_amdgcn_readfirstlane(tid >> 6);
    for (int ti = 0; ti < 16; ++ti) {
        float h[2][16], m[2];
#pragma unroll
        for (int q = 0; q < 2; ++q) { const bf16* xp = X1B + (size_t)(wid * 32 + ti + 16 * q) * DM + 16 * lane; const v4u a = *(const GAS v4u*)xp, b2 = *(const GAS v4u*)(xp + 8); H_UNPACK(h[q], a, b2); }
#pragma unroll
        for (int q = 0; q < 2; ++q) { m[q] = 0.f;
#pragma unroll
            for (int k = 0; k < 16; ++k) m[q] = fmaxf(m[q], fabsf(h[q][k])); }
#pragma unroll
        for (int o = 1; o < 64; o <<= 1) { m[0] = fmaxf(m[0], shx(m[0], o, lane)); m[1] = fmaxf(m[1], shx(m[1], o, lane)); }
#pragma unroll
        for (int q = 0; q < 2; ++q) { const int lrow = wid * 32 + ti + 16 * q; const float sc = m[q] > 0.f ? 127.0f / m[q] : 1.0f;
            v4u w; w.x = pack4_i8(h[q][0] * sc, h[q][1] * sc, h[q][2] * sc, h[q][3] * sc); w.y = pack4_i8(h[q][4] * sc, h[q][5] * sc, h[q][6] * sc, h[q][7] * sc);
            w.z = pack4_i8(h[q][8] * sc, h[q][9] * sc, h[q][10] * sc, h[q][11] * sc); w.w = pack4_i8(h[q][12] * sc, h[q][13] * sc, h[q][14] * sc, h[q][15] * sc);
            *(GAS v4u*)(H8p + (size_t)lrow * DM + 16 * lane) = w;
            if (lane == 0) s1h[lrow] = r1[lrow] * (m[q] > 0.f ? m[q] * (1.0f / 127.0f) : 1.0f); }
    }
}
__device__ __forceinline__ int dot16_i8(const v4u u, const v4u h) {
    int a = __builtin_amdgcn_sdot4((int)u.x, (int)h.x, 0, false), b = __builtin_amdgcn_sdot4((int)u.y, (int)h.y, 0, false);
    a = __builtin_amdgcn_sdot4((int)u.z, (int)h.z, a, false); b = __builtin_amdgcn_sdot4((int)u.w, (int)h.w, b, false);
    return a + b;
}
#define RS_LEVEL_I(v, n, m) do { _Pragma("unroll") for (int _e = 0; _e < (n); ++_e) { const bool _up = (lane & (m)) != 0; const int _send = _up ? v[_e] : v[_e + (n)]; const int _keep = _up ? v[_e + (n)] : v[_e]; v[_e] = _keep + shx(_send, (m), lane); } } while (0)
__device__ __forceinline__ void dq4(unsigned w, float (&f)[4]) {
    const f32x2v lo = __builtin_amdgcn_cvt_pk_f32_fp8((int)w, false), hi = __builtin_amdgcn_cvt_pk_f32_fp8((int)w, true);
    f[0] = lo.x; f[1] = lo.y; f[2] = hi.x; f[3] = hi.y;
}
__device__ __forceinline__ float dot16_fp8(const v4u u, const float (&h)[16]) {
    const f32x2v x0 = __builtin_amdgcn_cvt_pk_f32_fp8((int)u.x, false), x1 = __builtin_amdgcn_cvt_pk_f32_fp8((int)u.x, true);
    const f32x2v y0 = __builtin_amdgcn_cvt_pk_f32_fp8((int)u.y, false), y1 = __builtin_amdgcn_cvt_pk_f32_fp8((int)u.y, true);
    const f32x2v z0 = __builtin_amdgcn_cvt_pk_f32_fp8((int)u.z, false), z1 = __builtin_amdgcn_cvt_pk_f32_fp8((int)u.z, true);
    const f32x2v w0 = __builtin_amdgcn_cvt_pk_f32_fp8((int)u.w, false), w1 = __builtin_amdgcn_cvt_pk_f32_fp8((int)u.w, true);
    f32x2v a = x0 * (f32x2v){h[0], h[1]}, b = x1 * (f32x2v){h[2], h[3]};
    a = __builtin_elementwise_fma(y0, (f32x2v){h[4], h[5]}, a); b = __builtin_elementwise_fma(y1, (f32x2v){h[6], h[7]}, b);
    a = __builtin_elementwise_fma(z0, (f32x2v){h[8], h[9]}, a); b = __builtin_elementwise_fma(z1, (f32x2v){h[10], h[11]}, b);
    a = __builtin_elementwise_fma(w0, (f32x2v){h[12], h[13]}, a); b = __builtin_elementwise_fma(w1, (f32x2v){h[14], h[15]}, b);
    const f32x2v s = a + b;
    return s.x + s.y;
}
__device__ __forceinline__ void fma16_fp8(float (&o)[16], float cf, const v4u v) {
    float f0[4], f1[4], f2[4], f3[4]; dq4(v.x, f0); dq4(v.y, f1); dq4(v.z, f2); dq4(v.w, f3);
#pragma unroll
    for (int k = 0; k < 4; ++k) { o[k] = fmaf(cf, f0[k], o[k]); o[4 + k] = fmaf(cf, f1[k], o[4 + k]); o[8 + k] = fmaf(cf, f2[k], o[8 + k]); o[12 + k] = fmaf(cf, f3[k], o[12 + k]); }
}
__device__ __forceinline__ void fma16_fp8v(f32x2v (&o)[8], float cf, const v4u v) {
    const f32x2v c2 = (f32x2v){cf, cf};
    o[0] = __builtin_elementwise_fma(__builtin_amdgcn_cvt_pk_f32_fp8((int)v.x, false), c2, o[0]); o[1] = __builtin_elementwise_fma(__builtin_amdgcn_cvt_pk_f32_fp8((int)v.x, true), c2, o[1]);
    o[2] = __builtin_elementwise_fma(__builtin_amdgcn_cvt_pk_f32_fp8((int)v.y, false), c2, o[2]); o[3] = __builtin_elementwise_fma(__builtin_amdgcn_cvt_pk_f32_fp8((int)v.y, true), c2, o[3]);
    o[4] = __builtin_elementwise_fma(__builtin_amdgcn_cvt_pk_f32_fp8((int)v.z, false), c2, o[4]); o[5] = __builtin_elementwise_fma(__builtin_amdgcn_cvt_pk_f32_fp8((int)v.z, true), c2, o[5]);
    o[6] = __builtin_elementwise_fma(__builtin_amdgcn_cvt_pk_f32_fp8((int)v.w, false), c2, o[6]); o[7] = __builtin_elementwise_fma(__builtin_amdgcn_cvt_pk_f32_fp8((int)v.w, true), c2, o[7]);
}
__device__ __forceinline__ float gelu_as(float v) {
    const float av = fabsf(v), t = __builtin_amdgcn_rcpf(av * 0.2316418882f + 1.0f);
    float q = t * 0.5307027145f + (-0.7265760135f); q = q * t + 0.7107068705f; q = q * t + (-0.142248368f); q = q * t + 0.127414796f; q = q * t;
    const float e = __builtin_amdgcn_exp2f((v * v) * (-0.72134752044f));
    const float m = v * (q * e);
    return v < 0.f ? m : v - m;
}
#define RS_LEVEL(v, n, m) do { _Pragma("unroll") for (int _e = 0; _e < (n); ++_e) { const bool _up = (lane & (m)) != 0; const float _send = _up ? v[_e] : v[_e + (n)]; const float _keep = _up ? v[_e + (n)] : v[_e]; v[_e] = _keep + shx(_send, m, lane); } } while (0)
#define BS_CE(KV, EOFF, K, J) { const int p_ = shx(KV, J, lane); const bool asc_ = (((lane + (EOFF)) & (K)) == 0); const int mn_ = KV < p_ ? KV : p_, mx_ = KV < p_ ? p_ : KV; KV = (lower_ == asc_) ? mn_ : mx_; }
#define BS_STAGE(K, J) do { const bool lower_ = (lane & (J)) == 0; BS_CE(k0, 0, K, J) BS_CE(k1, 64, K, J) BS_CE(k2, 0, K, J) BS_CE(k3, 64, K, J) } while (0)
__device__ __forceinline__ void peer_sort_panel(int* IDXp, float* GTp, float* SUp, const float* SU, const float* SV, const int wid0) {
    const int tid = otid(wid0), lane = tid & 63, wid = __builtin_amdgcn_readfirstlane(tid >> 6);
    int ni[4]; float ng[4];
#pragma unroll
    for (int q = 0; q < 4; ++q) { const int o = (wid * 32 + (q >> 1) * 16) * 128 + (q & 1) * 64 + lane; ni[q] = IDXp[o]; ng[q] = GTp[o]; }
    for (int ti = 0; ti < 16; ++ti) {
        const int lrow = wid * 32 + ti;
        int ci[4]; float cg[4];
#pragma unroll
        for (int q = 0; q < 4; ++q) { ci[q] = ni[q]; cg[q] = ng[q]; }
        if (ti < 15) {
#pragma unroll
            for (int q = 0; q < 4; ++q) { const int o = (lrow + 1 + (q >> 1) * 16) * 128 + (q & 1) * 64 + lane; ni[q] = IDXp[o]; ng[q] = GTp[o]; } }
        float cu[4], cw[4];
#pragma unroll
        for (int q = 0; q < 4; ++q) { cu[q] = SU[ci[q]]; cw[q] = SV[ci[q]] * cg[q]; }
        int k0 = (ci[0] << 7) | lane, k1 = (ci[1] << 7) | (64 + lane), k2 = (ci[2] << 7) | lane, k3 = (ci[3] << 7) | (64 + lane);
        BS_STAGE(2, 1);
        BS_STAGE(4, 2); BS_STAGE(4, 1);
        BS_STAGE(8, 4); BS_STAGE(8, 2); BS_STAGE(8, 1);
        BS_STAGE(16, 8); BS_STAGE(16, 4); BS_STAGE(16, 2); BS_STAGE(16, 1);
        BS_STAGE(32, 16); BS_STAGE(32, 8); BS_STAGE(32, 4); BS_STAGE(32, 2); BS_STAGE(32, 1);
        BS_STAGE(64, 32); BS_STAGE(64, 16); BS_STAGE(64, 8); BS_STAGE(64, 4); BS_STAGE(64, 2); BS_STAGE(64, 1);
        { const int mn_ = k0 < k1 ? k0 : k1, mx_ = k0 < k1 ? k1 : k0; k0 = mn_; k1 = mx_; }
        { const int mn_ = k2 < k3 ? k2 : k3, mx_ = k2 < k3 ? k3 : k2; k2 = mn_; k3 = mx_; }
        BS_STAGE(128, 32); BS_STAGE(128, 16); BS_STAGE(128, 8); BS_STAGE(128, 4); BS_STAGE(128, 2); BS_STAGE(128, 1);
#define BS_OUT(KA, KB, UA, UB, WA, WB, LR) do { const int s0 = KA & 127, s1 = KB & 127; \
        const float ua0 = shl_(UA, s0 & 63), ub0 = shl_(UB, s0 & 63), ua1 = shl_(UA, s1 & 63), ub1 = shl_(UB, s1 & 63); \
        const float wa0 = shl_(WA, s0 & 63), wb0 = shl_(WB, s0 & 63), wa1 = shl_(WA, s1 & 63), wb1 = shl_(WB, s1 & 63); \
        IDXp[(LR) * 128 + lane] = KA >> 7; IDXp[(LR) * 128 + 64 + lane] = KB >> 7; \
        SUp[(LR) * 128 + lane] = (s0 < 64) ? ua0 : ub0; SUp[(LR) * 128 + 64 + lane] = (s1 < 64) ? ua1 : ub1; \
        GTp[(LR) * 128 + lane] = (s0 < 64) ? wa0 : wb0; GTp[(LR) * 128 + 64 + lane] = (s1 < 64) ? wa1 : wb1; } while (0)
        BS_OUT(k0, k1, cu[0], cu[1], cw[0], cw[1], lrow);
        BS_OUT(k2, k3, cu[2], cu[3], cw[2], cw[3], lrow + 16);
#undef BS_OUT
    }
}
#define DPPC_ROR8 0x128
#define DPPC_SHL4 0x104
#define DPPC_SHR4 0x114
#define DPPC_X2 0x4E
#define DPPC_X1 0xB1
template <int CTRL> __device__ __forceinline__ int dpp_i(int x) { return __builtin_amdgcn_update_dpp(0, x, CTRL, 0xF, 0xF, true); }
__device__ __forceinline__ int dot16_i8c(const v4u u, const v4u h) {
    int a = __builtin_amdgcn_sdot4((int)u.x, (int)h.x, 0, false);
    a = __builtin_amdgcn_sdot4((int)u.y, (int)h.y, a, false); a = __builtin_amdgcn_sdot4((int)u.z, (int)h.z, a, false); a = __builtin_amdgcn_sdot4((int)u.w, (int)h.w, a, false);
    return a;
}
template <int NP>
__device__ __forceinline__ void peer_usweep2_panel(const int dp, const unsigned char* H8p, LAS const float* s1h, const int* IDXp, const float* GMp, const float* SUp, float* CFp, const unsigned char* EU8, const int wid0) {
    constexpr int LG = 64 / NP, TG = 16 / NP, NSTEP = 16 * TG;
    const int wid = wid0;
    const int lane = lane_id();
    const int grp = lane / LG, tq = (lane >> 3) & 1, pj = lane & 7;
    const unsigned kof = (unsigned)(1024 / NP) * (unsigned)dp + 16u * (unsigned)(lane & (LG - 1));
    const int gb4 = (lane & ~(LG - 1)) << 2;
    const bool last = dp == NP - 1;
    int ix_n, pd_n = 0; float gm_n = 0.f, su_n = 0.f; v4u h0_n, h1_n;
#define US2_META(s_) do { const int c_ = (s_) / TG, tg_ = (s_) % TG; const int lr_ = wid * 32 + 2 * NP * tg_ + 2 * grp; const int off_ = (lr_ + tq) * 128 + 8 * c_ + pj; \
        ix_n = IDXp[off_] << 10; \
        if (dp) pd_n = ((const int*)CFp)[off_]; \
        if (last) { gm_n = GMp[off_]; su_n = SUp[off_] * s1h[lr_ + tq]; } \
        const unsigned char* h0_ = H8p + (unsigned)(lr_ * DM) + kof; h0_n = *(const GAS v4u*)h0_; h1_n = *(const GAS v4u*)(h0_ + DM); } while (0)
#ifndef STAG_U
#define STAG_U 40
#endif
    if (STAG_U && wid >= 4) __builtin_amdgcn_s_sleep(STAG_U);
    US2_META(0);
#pragma nounroll
    for (int s = 0; s < NSTEP; ++s) {
        const int ix10 = ix_n, pd = pd_n; const float gm = gm_n, su = su_n; const v4u h0 = h0_n, h1 = h1_n;
        v4u ua[16]; int p[16];
        unsigned exo[16];
#pragma unroll
        for (int j = 0; j < 16; ++j) exo[j] = (unsigned)__builtin_amdgcn_ds_bpermute(gb4 + 4 * j, ix10) + kof;
        asm volatile("" : "+v"(exo[0]), "+v"(exo[1]), "+v"(exo[2]), "+v"(exo[3]), "+v"(exo[4]), "+v"(exo[5]), "+v"(exo[6]), "+v"(exo[7]), "+v"(exo[8]), "+v"(exo[9]), "+v"(exo[10]), "+v"(exo[11]), "+v"(exo[12]), "+v"(exo[13]), "+v"(exo[14]), "+v"(exo[15]));
#pragma unroll
        for (int j = 0; j < 8; ++j) ua[j] = *(const GAS v4u*)(EU8 + exo[j]);
        if (s < NSTEP - 1) US2_META(s + 1);
#pragma unroll
        for (int j = 0; j < 8; ++j) p[j] = dot16_i8c(ua[j], h0);
        asm volatile("" : "+v"(p[0]), "+v"(p[1]), "+v"(p[2]), "+v"(p[3]), "+v"(p[4]), "+v"(p[5]), "+v"(p[6]), "+v"(p[7]) :: "memory");
#pragma unroll
        for (int j = 8; j < 16; ++j) ua[j] = *(const GAS v4u*)(EU8 + exo[j]);
#pragma unroll
        for (int j = 8; j < 16; ++j) p[j] = dot16_i8c(ua[j], h1);
        const bool b3 = (lane & 8) != 0, b2 = (lane & 4) != 0, b1 = (lane & 2) != 0, b0 = (lane & 1) != 0;
#pragma unroll
        for (int e = 0; e < 8; ++e) { const int t = p[e] + dpp_i<DPPC_ROR8>(p[e]), u = p[e + 8] + dpp_i<DPPC_ROR8>(p[e + 8]); p[e] = b3 ? u : t; }
#pragma unroll
        for (int e = 0; e < 4; ++e) { const int t = p[e] + dpp_i<DPPC_SHL4>(p[e]), u = p[e + 4] + dpp_i<DPPC_SHR4>(p[e + 4]); p[e] = b2 ? u : t; }
#pragma unroll
        for (int e = 0; e < 2; ++e) { const int t = p[e] + dpp_i<DPPC_X2>(p[e]), u = p[e + 2] + dpp_i<DPPC_X2>(p[e + 2]); p[e] = b1 ? u : t; }
        int di; { const int t = p[0] + dpp_i<DPPC_X1>(p[0]), u = p[1] + dpp_i<DPPC_X1>(p[1]); di = b0 ? u : t; }
        if (NP == 2) { const auto r = __builtin_amdgcn_permlane16_swap(di, di, false, false); di = (int)r[0] + (int)r[1]; }
        di += pd;
        const int c = s / TG, tg = s % TG;
        const int off = (wid * 32 + 2 * NP * tg + 2 * grp + tq) * 128 + 8 * c + pj;
        const bool st = NP == 4 || (lane & 16) == 0;
        if (!last) { if (st) ((int*)CFp)[off] = di; }
        else { const float act = gelu_as((float)di * su); if (st) CFp[off] = gm * act; }
    }
#undef US2_META
}
__device__ __forceinline__ void peer_vsweep2_panel(int panel, const bf16* X1B, bf16* X2B, LAS float* r3, const int* IDXp, const float* CFp, const unsigned char* EV8, const int wid0) {
    const int wid = wid0;
#ifndef STAG_V
#define STAG_V 40
#endif
    if (STAG_V && wid >= 4) __builtin_amdgcn_s_sleep(STAG_V);
#pragma nounroll
    for (int it = 0; it < 8; ++it) {
        const int dp = it >> 2, g2 = it & 3;
        const int lane = lane_id(); const int half = lane >> 5, li = lane & 31;
        const int lr0 = wid * 32 + 8 * g2;
        const int colb = 512 * dp + 16 * li;
        float o[4][16];
#pragma unroll
        for (int t = 0; t < 4; ++t) { const bf16* xp = X1B + (size_t)(lr0 + 4 * half + t) * DM + colb; const v4u a = *(const GAS v4u*)xp, b2 = *(const GAS v4u*)(xp + 8); H_UNPACK(o[t], a, b2); }
        const int mA = (lr0 + (lane >> 3)) * 128 + (lane & 7);
        int ix_n = IDXp[mA]; float cf_n = CFp[mA];
#pragma nounroll
        for (int c = 0; c < 16; ++c) {
            const int ix = ix_n; const float cf = cf_n;
            const int lane_c = lane_id(); const int half_c = lane_c >> 5;
            if (c < 15) { const int m2 = (lr0 + (lane_c >> 3)) * 128 + (lane_c & 7) + 8 * (c + 1); ix_n = IDXp[m2]; cf_n = CFp[m2]; }
            const int evo = 512 * dp + 16 * (lane_c & 31);
#ifndef VB
#define VB 8
#endif
            const int hb4 = (lane_c & 32) << 2;
            const int ix10 = ix << 10;
            int exo[32];
#pragma unroll
            for (int e = 0; e < 32; ++e) exo[e] = __builtin_amdgcn_ds_bpermute(hb4 + 4 * e, ix10) + evo;
            asm volatile("" : "+v"(exo[0]), "+v"(exo[1]), "+v"(exo[2]), "+v"(exo[3]), "+v"(exo[4]), "+v"(exo[5]), "+v"(exo[6]), "+v"(exo[7]), "+v"(exo[8]), "+v"(exo[9]), "+v"(exo[10]), "+v"(exo[11]), "+v"(exo[12]), "+v"(exo[13]), "+v"(exo[14]), "+v"(exo[15]));
            asm volatile("" : "+v"(exo[16]), "+v"(exo[17]), "+v"(exo[18]), "+v"(exo[19]), "+v"(exo[20]), "+v"(exo[21]), "+v"(exo[22]), "+v"(exo[23]), "+v"(exo[24]), "+v"(exo[25]), "+v"(exo[26]), "+v"(exo[27]), "+v"(exo[28]), "+v"(exo[29]), "+v"(exo[30]), "+v"(exo[31]));
#pragma unroll
            for (int tp = 0; tp < 32 / VB; ++tp) {
                v4u va[VB]; float cs[VB];
#pragma unroll
                for (int i = 0; i < VB; ++i) { const int e = VB * tp + i; va[i] = *(const GAS v4u*)(EV8 + (unsigned)exo[e]); }
#pragma unroll
                for (int i = 0; i < VB; ++i) { const int e = VB * tp + i; cs[i] = __builtin_bit_cast(float, __builtin_amdgcn_ds_bpermute(hb4 + 4 * e, __builtin_bit_cast(int, cf))); }
#pragma unroll
                for (int i = 0; i < VB; ++i) { const int e = VB * tp + i; fma16_fp8(o[e >> 3], cs[i], va[i]); }
            }
        }
        const int lane2 = lane_id(); const int half2 = lane2 >> 5, li2 = lane2 & 31;
#pragma unroll
        for (int t = 0; t < 4; ++t) {
            const int tok = lr0 + 4 * half2 + t;
            float ss = 0.f;
#pragma unroll
            for (int k = 0; k < 16; ++k) ss += o[t][k] * o[t][k];
#pragma unroll
            for (int m = 1; m < 32; m <<= 1) ss += shx(ss, m, lane2);
            if (li2 == 0) { if (dp == 0) r3[tok] = ss; else r3[tok] = 1.f / sqrtf((r3[tok] + ss) * (1.f / DM) + RMS_EPS); }
            v4u ha, hb;
            ha.x = cvtpk(o[t][0], o[t][1]); ha.y = cvtpk(o[t][2], o[t][3]); ha.z = cvtpk(o[t][4], o[t][5]); ha.w = cvtpk(o[t][6], o[t][7]);
            hb.x = cvtpk(o[t][8], o[t][9]); hb.y = cvtpk(o[t][10], o[t][11]); hb.z = cvtpk(o[t][12], o[t][13]); hb.w = cvtpk(o[t][14], o[t][15]);
            bf16* xo = X2B + (size_t)tok * DM + 512 * dp + 16 * li2;
            *(GAS v4u*)xo = ha; *(GAS v4u*)(xo + 8) = hb;
        }
    }
}


struct Args {
    const float *x, *p, *norm_mix, *w_in, *w_att_up, *w_pool_group, *pool_scale, *w_out, *norm_ffn, *w_query, *sub_keys, *expert_u, *expert_v, *norm_ple, *w_ple_gate, *w_ple, *norm_final;
    float* out; unsigned char* ws; int ph_hi, pad;
};

#ifndef REP_P0
#define REP_P0 1
#endif
#ifndef REP_P1
#define REP_P1 1
#endif
#ifndef REP_P23
#define REP_P23 1
#endif
#ifndef REP_P4
#define REP_P4 1
#endif
#ifndef REP_P567
#define REP_P567 1
#endif
#ifndef REP_P9
#define REP_P9 1
#endif
#ifndef REP_ATT
#define REP_ATT 1
#endif
#ifndef REP_TOPK
#define REP_TOPK 1
#endif
#ifndef REP_MRG
#define REP_MRG 1
#endif
#ifndef MK_PH_HI
#define MK_PH_HI 99
#endif

typedef const __attribute__((address_space(4))) Args* CArgs;
__device__ __forceinline__ CArgs kargs() { CArgs p = (CArgs)__builtin_amdgcn_kernarg_segment_ptr(); asm volatile("" : "+s"(p)); return p; }
#define WSP(T, off) ((T*)(kargs()->ws + (off)))
__global__ void __launch_bounds__(NTHR, 2) mega_fwd(Args a_unused) {
    extern __shared__ __attribute__((aligned(16))) unsigned char lds_raw[];
    LAS unsigned char* lds = (LAS unsigned char*)lds_raw;
    volatile LAS unsigned* MISC = (volatile LAS unsigned*)(lds + MISC_OFF);
    const int G = gridDim.x; const int bx = blockIdx.x;
    const int vcu = (G % 8 == 0) ? (bx % 8) * (G / 8) + bx / 8 : bx;
    gu32* ctl = (gu32*)(kargs()->ws + WS_CTL);
    const int wid0 = __builtin_amdgcn_readfirstlane((int)threadIdx.x >> 6);
#define IS_T0 (otid(wid0) == 0)
    for (int u = otid(wid0); u < (LDS_BYTES - LDSCTL_OFF) / 4; u += NTHR) ((LAS unsigned*)(lds + LDSCTL_OFF))[u] = 0u;
    __syncthreads();
    (void)xcd_barrier_post((unsigned*)(ctl + CW_BAR), MISC + 8, IS_T0);
#define GRID_BAR() do { XcdBarrier _b; _b.bar = (unsigned*)((gu32*)(kargs()->ws + WS_CTL) + CW_BAR); _b.x = xb_xcc_id(); _b.st = (volatile LAS unsigned*)(lds + MISC_OFF) + 8; xcd_barrier(_b, IS_T0); } while (0)
    LAS float* const SS1 = (LAS float*)(lds + LDSCTL_OFF + 1024);
    LAS float* const R3 = (LAS float*)(lds + LDSCTL_OFF + 2048);
    LAS float* const SSF = (LAS float*)(lds + LDSCTL_OFF + 3072);
    LAS float* const S1H = (LAS float*)(lds + LDSCTL_OFF + 4096);
#define LOCAL_SEAM() do { VM_WAIT(); __syncthreads(); if (IS_T0) { __builtin_amdgcn_fence(__ATOMIC_ACQUIRE, "agent"); VM_WAIT(); } __syncthreads(); } while (0)

    for (int rep_ = 0; rep_ < REP_P0; ++rep_) {
        const int tid = otid(wid0), lane = tid & 63, wid = __builtin_amdgcn_readfirstlane(tid >> 6);
        const CArgs a = kargs(); unsigned char* ws = a->ws;
        bf16 *WIN = (bf16*)(ws + WS_WIN), *WOUT = (bf16*)(ws + WS_WOUT), *WQ = (bf16*)(ws + WS_WQ), *WPG = (bf16*)(ws + WS_WPG), *WPLE = (bf16*)(ws + WS_WPLE);
        bf16 *BDA = (bf16*)(ws + WS_BDA), *BDP = (bf16*)(ws + WS_BDP), *SK = (bf16*)(ws + WS_SK), *XN = (bf16*)(ws + WS_XN);
        LAS float* scr = (LAS float*)(lds + wid * 16384);
        const int gw = vcu * NWAVES + wid, NGW = G * NWAVES;
        unsigned* const CMAX = (unsigned*)((gu32*)(ws + WS_CTL) + CW_CMAX);
        constexpr int A_IN = 32 * (4096 / 64), A_Q = 32 * (2048 / 64);
        for (int it = gw; it < A_IN + A_Q; it += NGW) {
            if (it < A_IN) p0_colmax_item(a->w_in, 4096, CMAX, a->norm_mix, 512, C2, it, lane);
            else p0_colmax_item(a->w_query, 2048, CMAX + 4096, a->norm_ffn, 0, 1.f, it - A_IN, lane);
        }
        constexpr int I_OUT = (1024 / 64) * (1024 / 32), I_PG = I_OUT, I_PLE = (256 / 64) * (1024 / 32);
        constexpr int NITEMS = I_OUT + I_PG + I_PLE;
        for (int it = gw; it < NITEMS; it += NGW) {
            int r = it;
            if (r < I_OUT) { p0_transpose_item(a->w_out, 1024, 1024, WOUT, nullptr, 0, 1.f, scr, r, lane); continue; } r -= I_OUT;
            if (r < I_PG) { p0_transpose_item(a->w_ple_gate, 1024, 1024, WPG, a->norm_ple, 0, 1.f, scr, r, lane); continue; } r -= I_PG;
            p0_transpose_item(a->w_ple, 256, 1024, WPLE, nullptr, 0, 1.f, scr, r, lane);
        }
        const int gt = vcu * NTHR + tid, NGT = G * NTHR;
        for (int it = gt; it < 1024 * 16; it += NGT) {
            const int n = it >> 4, k8 = (it & 15) * 8, head = n >> 7, g = n >> 8;
            float va[8], vp[8]; const float ps = a->pool_scale[n];
#pragma unroll
            for (int j = 0; j < 8; ++j) {
                const int k = k8 + j;
                va[j] = ((k >> 6) == (head & 1)) ? a->w_att_up[((size_t)head * 64 + (k & 63)) * 128 + (n & 127)] : 0.f;
                vp[j] = a->w_pool_group[((size_t)g * 128 + k) * 256 + (n & 255)] * ps;
            }
            v4u o; o.x = pk2(va[0], va[1]); o.y = pk2(va[2], va[3]); o.z = pk2(va[4], va[5]); o.w = pk2(va[6], va[7]);
            *(GAS v4u*)(BDA + (size_t)n * 128 + k8) = o;
            o.x = pk2(vp[0], vp[1]); o.y = pk2(vp[2], vp[3]); o.z = pk2(vp[4], vp[5]); o.w = pk2(vp[6], vp[7]);
            *(GAS v4u*)(BDP + (size_t)n * 128 + k8) = o;
        }
        for (int it = gt; it < 16 * 128 * 128 / 8; it += NGT) cvt8_store(a->sub_keys + (size_t)it * 8, SK + (size_t)it * 8);
        { const int panel = bx;
            for (int r = wid, e = gw; r < 64; r += NWAVES, e += NGW) { const size_t row = (size_t)panel * 256 + r;
                p0_rows4_expert(a->x + row * DM, ws + WS_XN + row * DM, (float*)(ws + WS_SX) + row, (size_t)64 * DM, 64,
                                a->expert_u + (size_t)e * DM, a->norm_ffn, ws + WS_EU + (size_t)e * DM, (float*)(ws + WS_SU) + e, a->expert_v + (size_t)e * DM, ws + WS_EV + (size_t)e * DM, (float*)(ws + WS_SV) + e, lane); } }
    }
    GRID_BAR();
    {
        const int tid = otid(wid0), lane = tid & 63, wid = __builtin_amdgcn_readfirstlane(tid >> 6);
        const CArgs a = kargs(); unsigned char* ws = a->ws;
        LAS float* scr = (LAS float*)(lds + wid * 16384);
        const int gw = vcu * NWAVES + wid, NGW = G * NWAVES;
        const unsigned* CMAX = (const unsigned*)((gu32*)(ws + WS_CTL) + CW_CMAX);
        constexpr int B_IN = 16 * (4096 / 32), B_Q = 16 * (2048 / 32);
        for (int it = gw; it < B_IN + B_Q; it += NGW) {
            if (it < B_IN) p0_quant_tile_item(a->w_in, 4096, ws + WS_WIN, (float*)(ws + WS_SBN), CMAX, a->norm_mix, 512, C2, scr, it, lane);
            else p0_quant_tile_item(a->w_query, 2048, ws + WS_WQ, (float*)(ws + WS_SBQ), CMAX + 4096, a->norm_ffn, 0, 1.f, scr, it - B_IN, lane);
        }
    }
    GRID_BAR();

    for (int rep_ = 0; rep_ < REP_P1; ++rep_) {
        const int xg = bx & 7, ig = bx >> 3, ug = ig >> 3;
#pragma nounroll
        for (int ph = 0; ph < 4; ++ph) {
            const int panel = xg + 8 * (8 * ph + (ig & 7));
            { pg8::Gemm g{WSP(bf16, WS_XN), WSP(bf16, WS_WIN), 1024, 1024, 1024, 0, 0, 1, 0}; pg8::PanelSched S{panel, ug < 3 ? 4 : 2, 4, 2, 0, 4 * ug};
              pg8::EpiProjI8 E{WSP(bf16, WS_PQ), WSP(bf16, WS_PK), WSP(bf16, WS_PU), WSP(bf16, WS_PG), WSP(float, WS_SX), WSP(float, WS_SBN)};
              pg8::gemm_phase_i8<pg8::EpiProjI8, pg8::PanelSched, true, true>(lds, g, S, E, wid0); }
            if (ug == 3) { pg8::Gemm g{(const bf16*)(kargs()->ws + WS_WIN + (size_t)1024 * 1024), WSP(bf16, WS_XN), 1024, 1024, 1024, 0, 0, 1, 0}; pg8::PanelSched S{panel, 2, 99, 0, 1, 0};
              pg8::EpiPlainI8 E{WSP(bf16, WS_PVT), TOK, WSP(float, WS_SBN) + 1024, WSP(float, WS_SX)};
              pg8::gemm_phase_i8<pg8::EpiPlainI8, pg8::PanelSched, true, true>(lds, g, S, E, wid0); }
        }
    }
    GRID_BAR();


#define H8P ((unsigned char*)(kargs()->ws + WS_MG + (size_t)panel * 524288 + 262144))
    { const int panel = bx;
        const size_t prow = (size_t)panel * 256;
        for (int rep_ = 0; rep_ < REP_P23; ++rep_) {
        if (MK_PH_HI > 2) { for (int r2_ = 0; r2_ < REP_ATT; ++r2_) attn_panel(panel, WSP(bf16, WS_PQ), WSP(bf16, WS_PK), WSP(bf16, WS_PVT), WSP(bf16, WS_YA), wid0); pool_panel(panel, WSP(bf16, WS_PU), WSP(bf16, WS_YP), wid0); LOCAL_SEAM(); }
        for (int r2_ = 0; r2_ < REP_MRG; ++r2_)
        if (MK_PH_HI > 3) {
            { pg8::Gemm g{WSP(bf16, WS_YA), WSP(bf16, WS_BDA), 128, 512, 128, 128, (long)((WS_YP - WS_YA) / 2), 1, 0}; pg8::PanelSched S{panel, 8, 99, 0, 2}; pg8::EpiMergeChain E{WSP(bf16, WS_PG), WSP(bf16, WS_MG)};
              pg8::gemm_phase<pg8::EpiMergeChain, pg8::PanelSched, true, true>(lds, g, S, E, wid0); }
            LOCAL_SEAM();
        }
        }
        for (int rep_ = 0; rep_ < REP_P4; ++rep_)
        if (MK_PH_HI > 4) {
            { pg8::Gemm g{WSP(bf16, WS_MG), WSP(bf16, WS_WOUT), 1024, 1024, 1024, 0, 0, 1, 0}; pg8::PanelSched S{panel, 4, 99, 0, 0}; pg8::EpiRes E{kargs()->x, (bf16*)kargs()->out, SS1};
              pg8::gemm_phase<pg8::EpiRes, pg8::PanelSched, true, true>(lds, g, S, E, wid0); }
            LOCAL_SEAM();
        }
        { { const int t_ = otid(wid0); if (t_ < 256) SS1[t_] = 1.f / sqrtf(SS1[t_] * (1.f / DM) + RMS_EPS); } __syncthreads(); }
#ifndef REP_WQ
#define REP_WQ 1
#endif
        for (int rq_ = 0; rq_ < REP_WQ; ++rq_) {
        if (MK_PH_HI > 6) { peer_hq_panel((const bf16*)kargs()->out + (size_t)panel * 524288, H8P, SS1, S1H, wid0); LOCAL_SEAM(); }
        {
        if (MK_PH_HI > 6) {
            { pg8::Gemm g{(const bf16*)(kargs()->ws + WS_MG + 262144), WSP(bf16, WS_WQ), 1024, 1024, 1024, 0, 0, 2, 0}; pg8::PanelSched S{panel, 8, 99, 0, 0};
              pg8::EpiPlainScaleI8 E{WSP(bf16, WS_PG), 2048, S1H, WSP(float, WS_SBQ)};
              pg8::gemm_phase_i8<pg8::EpiPlainScaleI8, pg8::PanelSched, true, true>(lds, g, S, E, wid0); }
            LOCAL_SEAM();
        }
        } }
        {
        #define IDXP ((int*)(kargs()->ws + WS_YA + (size_t)panel * 262144))
#define GTP ((float*)(kargs()->ws + WS_YA + (size_t)panel * 262144 + 131072))
        if (MK_PH_HI > 7) { for (int r2_ = 0; r2_ < REP_TOPK; ++r2_) topk_panel(panel, WSP(bf16, WS_PG), WSP(bf16, WS_SK), IDXP, GTP, lds, wid0); LOCAL_SEAM(); }
        }
#ifndef PEER_SWEEP
#define PEER_SWEEP 1
#endif
#define CFP ((float*)(kargs()->ws + WS_YP + (size_t)panel * 262144 + 131072))
#define SUSP ((float*)(kargs()->ws + WS_MG + (size_t)panel * 524288))
        if (MK_PH_HI > 8) {
            if (PEER_SWEEP) {
#ifndef REP_SORT
#define REP_SORT 1
#endif
                for (int rs_ = 0; rs_ < REP_SORT; ++rs_) { peer_sort_panel(IDXP, GTP, SUSP, WSP(float, WS_SU), WSP(float, WS_SV), wid0); LOCAL_SEAM(); }
#ifndef REP_U
#define REP_U 1
#endif
#ifndef REP_V
#define REP_V 1
#endif
#ifndef UNP
#define UNP 2
#endif
                for (int ru_ = 0; ru_ < REP_U; ++ru_) {
#pragma nounroll
                    for (int dpu = 0; dpu < UNP; ++dpu) { peer_usweep2_panel<UNP>(dpu, H8P, S1H, IDXP, GTP, SUSP, CFP, WSP(unsigned char, WS_EU), wid0); LOCAL_SEAM(); } }
                for (int rv_ = 0; rv_ < REP_V; ++rv_)
                    peer_vsweep2_panel(panel, (const bf16*)kargs()->out + (size_t)panel * 524288, WSP(bf16, WS_PG) + (size_t)panel * 524288, R3, IDXP, CFP, WSP(unsigned char, WS_EV), wid0);
                LOCAL_SEAM();
            }
        }
        for (int rep_ = 0; rep_ < REP_P9; ++rep_)
        if (MK_PH_HI > 9) {
            { const int tid = otid(wid0); const float* pp = kargs()->p; bf16* YP = WSP(bf16, WS_YP); for (int it = tid; it < 256 * 256 / 8; it += NTHR) { const int r = it >> 5, c8 = (it & 31) * 8; cvt8_store(pp + (prow + r) * 256 + c8, YP + (prow + r) * 512 + c8); } }
            LOCAL_SEAM();
            { pg8::Gemm g{WSP(bf16, WS_YP), WSP(bf16, WS_WPLE), 256, 512, 256, 0, 0, 1, 0}; pg8::PanelSched S{panel, 4, 99, 0, 0}; pg8::EpiPlain E{WSP(bf16, WS_MG), 1024};
              pg8::gemm_phase<pg8::EpiPlain, pg8::PanelSched, true, true>(lds, g, S, E, wid0); }
            LOCAL_SEAM();
        }
        if (MK_PH_HI > 10) {
            { pg8::Gemm g{WSP(bf16, WS_PG), WSP(bf16, WS_WPG), 1024, 1024, 1024, 0, 0, 2, 0}; pg8::PanelSched S{panel, 4, 99, 0, 0}; pg8::EpiGate E{WSP(bf16, WS_YA), WSP(bf16, WS_PG), WSP(bf16, WS_MG), R3, SSF, (long)((WS_YP - WS_YA) / 2), 0};
              pg8::gemm_phase<pg8::EpiGate, pg8::PanelSched, true, true>(lds, g, S, E, wid0); }
            LOCAL_SEAM();
        }
        if (MK_PH_HI > 11) {
            const int tid = otid(wid0), lane = tid & 63, wid = __builtin_amdgcn_readfirstlane(tid >> 6);
            const GAS f32x4* gr = (const GAS f32x4*)kargs()->norm_final + lane;
            f32x4 gg[4];
#pragma unroll
            for (int j = 0; j < 4; ++j) gg[j] = gr[64 * j];
            const bf16* x3a = WSP(bf16, WS_YA); const long x3h = (long)((WS_YP - WS_YA) / 2);
            for (int r = wid; r < 64; r += NWAVES) {
                v2u v[4][4]; float rr[4];
#pragma unroll
                for (int k = 0; k < 4; ++k) { const bf16* xr = x3a + (prow + r + 64 * k) * 512 + 4 * lane; rr[k] = 1.f / sqrtf(SSF[r + 64 * k] * (1.f / DM) + RMS_EPS);
#pragma unroll
                    for (int j = 0; j < 4; ++j) v[k][j] = *(const GAS v2u*)(xr + (j >= 2 ? x3h : 0) + 256 * (j & 1)); }
#pragma unroll
                for (int k = 0; k < 4; ++k) { GAS f32x4* xw = (GAS f32x4*)(kargs()->out + (prow + r + 64 * k) * DM) + lane;
#pragma unroll
                    for (int j = 0; j < 4; ++j) { f32x4 f; f[0] = bflo(v[k][j].x); f[1] = bfhi(v[k][j].x); f[2] = bflo(v[k][j].y); f[3] = bfhi(v[k][j].y); xw[64 * j] = f * rr[k] * gg[j]; } }
            }
        }
    }
#undef LOCAL_SEAM
}


extern "C" void kernel_launch(void* const* d_in, const int* in_sizes, int n_in, void* d_out, int out_size, void* d_ws, size_t ws_size, hipStream_t stream) {
    static int grid = 0;
    if (grid == 0) {
        if (n_in != 17 || in_sizes[0] != TOK * DM || out_size != TOK * DM || ws_size < WS_END) { fprintf(stderr, "kernel_launch: unexpected shapes (n_in %d, in0 %d, out %d, ws %zu); nothing launched\n", n_in, n_in > 0 ? in_sizes[0] : -1, out_size, ws_size); grid = -1; return; }
        int dev = 0, cus = 0;
        if (hipGetDevice(&dev) != hipSuccess || hipDeviceGetAttribute(&cus, hipDeviceAttributeMultiprocessorCount, dev) != hipSuccess) { fprintf(stderr, "kernel_launch: device query failed\n"); grid = -1; return; }
        if (hipFuncSetAttribute((const void*)mega_fwd, hipFuncAttributeMaxDynamicSharedMemorySize, LDS_BYTES) != hipSuccess) { fprintf(stderr, "kernel_launch: hipFuncSetAttribute failed\n"); grid = -1; return; }
        int per_cu = 0;
        if (hipOccupancyMaxActiveBlocksPerMultiprocessor(&per_cu, (const void*)mega_fwd, NTHR, LDS_BYTES) != hipSuccess || per_cu < 1) fprintf(stderr, "kernel_launch: note: occupancy query reports %d workgroups per CU\n", per_cu);
        (void)hipGetLastError();
        if (cus != NPANEL) fprintf(stderr, "kernel_launch: note: %d CUs; this kernel is built for one 256-token panel per CU on a 256-CU device\n", cus);
        grid = NPANEL;
    }
    if (grid < 0) return;
    if (hipMemsetAsync((char*)d_ws + WS_CTL, 0, CTL_ZERO_BYTES, stream) != hipSuccess) { fprintf(stderr, "kernel_launch: memset failed\n"); return; }
    Args a{};
    a.x = (const float*)d_in[0]; a.p = (const float*)d_in[1]; a.norm_mix = (const float*)d_in[2]; a.w_in = (const float*)d_in[3]; a.w_att_up = (const float*)d_in[4];
    a.w_pool_group = (const float*)d_in[5]; a.pool_scale = (const float*)d_in[6]; a.w_out = (const float*)d_in[7]; a.norm_ffn = (const float*)d_in[8]; a.w_query = (const float*)d_in[9];
    a.sub_keys = (const float*)d_in[10]; a.expert_u = (const float*)d_in[11]; a.expert_v = (const float*)d_in[12]; a.norm_ple = (const float*)d_in[13]; a.w_ple_gate = (const float*)d_in[14];
    a.w_ple = (const float*)d_in[15]; a.norm_final = (const float*)d_in[16];
    a.out = (float*)d_out; a.ws = (unsigned char*)d_ws; a.ph_hi = MK_PH_HI; a.pad = 0;
    hipLaunchKernelGGL(mega_fwd, dim3(grid), dim3(NTHR), LDS_BYTES, stream, a);
    { const hipError_t le = hipPeekAtLastError(); if (le != hipSuccess) fprintf(stderr, "kernel_launch: launch failed: %s\n", hipGetErrorName(le)); }
}
```

```cpp
#include <hip/hip_runtime.h>
#include <cstdio>
#include <cstdint>
#include <math.h>
__device__ __forceinline__ int lane_id() { int l; asm volatile("v_mbcnt_lo_u32_b32 %0, -1, 0\n\tv_mbcnt_hi_u32_b32 %0, -1, %0" : "=v"(l)); return l; }
__device__ __forceinline__ int otid(int wid0) { return (wid0 << 6) | lane_id(); }

namespace pg8 {
#define PG8_LAS __attribute__((address_space(3)))
typedef unsigned short bf16_t;
typedef short bf16x8 __attribute__((ext_vector_type(8)));
typedef float f32x4 __attribute__((ext_vector_type(4)));
typedef unsigned u32x4 __attribute__((ext_vector_type(4)));
typedef int i32x4 __attribute__((ext_vector_type(4)));
constexpr int BM = 256, BK = 64, HALF = 128, HTB = HALF * BK * 2  , STAGE_BYTES = 8 * HTB, NXCD = 8, WGM = 8;

__host__ __device__ __forceinline__ int lds_byte(int r, int c) { const int st = (r >> 4) * 2 + (c >> 5), rr = r & 15, cc = c & 31, ob = rr * 64 + cc * 2; return st * 1024 + (ob ^ (((ob >> 9) & 1) << 5)); }
__host__ __device__ __forceinline__ void stage_rc(int b, int& R, int& C) { const int st = b / 1024, sb = b % 1024, swz = sb ^ (((sb >> 9) & 1) << 5); R = (st >> 1) * 16 + swz / 64; C = (st & 1) * 32 + (swz % 64) / 2; }
__host__ __device__ __forceinline__ int perm32(int rho) { const int n = rho >> 4, i = rho & 15; return 8 * (i >> 2) + 4 * n + (i & 3); }

struct Unit { int pm, pn; };
struct Gemm { const bf16_t* A; const bf16_t* Bt; int K, lda, ldb, akoff; long a2off; int am, pad_; };

struct StaticOrder {
    int nM, nN, nwg, G, c;
    __host__ __device__ void init(int M, int N, int G_, int c_) { nM = M / BM; nN = N / BM; nwg = nM * nN; G = G_; c = c_; }
    __host__ __device__ bool next(int i, Unit& u) const {
        const long L = (long)i * G + c; if (L >= nwg) return false;
        int wgid = (int)L; { const int q = nwg / NXCD, r = nwg % NXCD, xcd = wgid % NXCD, off = wgid / NXCD; wgid = (xcd < r ? xcd * (q + 1) : r * (q + 1) + (xcd - r) * q) + off; }
        const int nig = WGM * nN, gid = wgid / nig, fm = gid * WGM, gsz = (nM - fm) < WGM ? (nM - fm) : WGM;
        u.pm = fm + ((wgid % nig) % gsz); u.pn = (wgid % nig) / gsz; return true;
    }
    __device__ __forceinline__ void a_ready(const Unit&) const {}
    __device__ __forceinline__ void done(const Unit&) const {}
};

template <class Epi, class Sched, bool ALIGN_EPI = false, bool SP2 = false>
__device__ __forceinline__ void gemm_phase(PG8_LAS unsigned char* lds, const Gemm g, const Sched& S, const Epi& E, const int wid0) {
    const int tid = otid(wid0), wid = __builtin_amdgcn_readfirstlane(tid >> 6), lane = tid & 63, wr = wid >> 2, wc = wid & 3, fr = lane & 15, fq = lane >> 4;
    const int K = g.K, nt = K / BK;
    unsigned voffA[2], voffB[2];
#pragma unroll
    for (int i = 0; i < 2; ++i) { int R, C; stage_rc(tid * 16 + i * 8192, R, C); const int Rb = Epi::PERM ? ((R & ~31) + perm32(R & 31)) : R;
        voffA[i] = (unsigned)(R * g.lda + C) * 2u; voffB[i] = (unsigned)(Rb * g.ldb + C) * 2u; }
    const size_t kstep = (size_t)(BK * 2);
    const size_t hstepA = (size_t)HALF * g.lda * 2, hstepB = (size_t)HALF * g.ldb * 2;
    const size_t tstepA = 2 * hstepA, tstepB = 2 * hstepB, akb = (size_t)g.akoff * 2, a2b = (size_t)g.a2off * 2;
    const unsigned ldsw = (unsigned)wid * 1024u;
    const int aoff = lds_byte(wr * 64 + fr, fq * 8), boff = lds_byte(wc * 32 + fr, fq * 8);
#define PG8_SA(b, h) (((b) * 2 + (h)) * HTB)
#define PG8_SB(b, h) ((4 + (b) * 2 + (h)) * HTB)
#define PG8_STAGE(bufoff, gbase, voff) do { _Pragma("unroll") for (int _i = 0; _i < 2; ++_i) \
        __builtin_amdgcn_global_load_lds((const unsigned*)((const char*)(gbase) + (voff)[_i]), (PG8_LAS unsigned*)(lds + (bufoff) + ldsw + _i * 8192), 16, 0, 0); } while (0)
#define PG8_LDA(dst, b, h) do { _Pragma("unroll") for (int m = 0; m < 4; ++m) _Pragma("unroll") for (int k = 0; k < 2; ++k) dst[m][k] = *(const PG8_LAS bf16x8*)(lds + PG8_SA(b, h) + aoff + m * 2048 + k * 1024); } while (0)
#define PG8_LDB(dst, b, h) do { _Pragma("unroll") for (int n = 0; n < 2; ++n) _Pragma("unroll") for (int k = 0; k < 2; ++k) dst[n][k] = *(const PG8_LAS bf16x8*)(lds + PG8_SB(b, h) + boff + n * 2048 + k * 1024); } while (0)
#define PG8_MMA(ai, bj, At, Bt) do { __builtin_amdgcn_s_setprio(1); _Pragma("unroll") for (int m = 0; m < 4; ++m) _Pragma("unroll") for (int n = 0; n < 2; ++n) _Pragma("unroll") for (int k = 0; k < 2; ++k) \
        acc[ai][bj][m][n] = __builtin_amdgcn_mfma_f32_16x16x32_bf16(Bt[n][k], At[m][k], acc[ai][bj][m][n], 0, 0, 0); __builtin_amdgcn_s_setprio(0); } while (0)
#define PG8_WAIT_V(n) asm volatile("s_waitcnt vmcnt(" #n ")" ::: "memory")
#define PG8_WAIT_L(n) asm volatile("s_waitcnt lgkmcnt(" #n ")" ::: "memory")
#define PG8_BAR __builtin_amdgcn_s_barrier()
#define PG8_SCHED __builtin_amdgcn_sched_barrier(0)
    Unit cur, nxt; int ui = 0;
    if (!S.next(0, cur)) return;
    f32x4 acc[2][2][4][2];
#pragma unroll
    for (int a = 0; a < 2; ++a)
#pragma unroll
        for (int b = 0; b < 2; ++b)
#pragma unroll
            for (int m = 0; m < 4; ++m)
#pragma unroll
                for (int n = 0; n < 2; ++n) acc[a][b][m][n] = (f32x4){0.f, 0.f, 0.f, 0.f};
    bf16x8 At[4][2], B0[2][2], B1[2][2];
    const char* cA = (const char*)g.A + (size_t)(cur.pm * g.am) * tstepA + (size_t)(cur.pn & 3) * akb + (size_t)(cur.pn >> 2) * a2b; const char* cB = (const char*)g.Bt + (size_t)cur.pn * tstepB;
    S.a_ready(cur);
    if constexpr (SP2) {
        PG8_STAGE(PG8_SB(0, 0), cB, voffB); PG8_STAGE(PG8_SB(0, 1), cB + hstepB, voffB); PG8_STAGE(PG8_SA(0, 0), cA, voffA); PG8_STAGE(PG8_SA(0, 1), cA + hstepA, voffA);
        if (wr == 1) PG8_BAR;
        PG8_WAIT_V(2); PG8_BAR;
        PG8_STAGE(PG8_SB(1, 0), cB + kstep, voffB); PG8_STAGE(PG8_SA(1, 0), cA + kstep, voffA); PG8_STAGE(PG8_SB(1, 1), cB + hstepB + kstep, voffB);
        PG8_WAIT_V(6); PG8_BAR;
    } else {
        PG8_STAGE(PG8_SB(0, 0), cB, voffB); PG8_STAGE(PG8_SA(0, 0), cA, voffA); PG8_STAGE(PG8_SB(0, 1), cB + hstepB, voffB); PG8_STAGE(PG8_SA(0, 1), cA + hstepA, voffA);
        if (wr == 1) PG8_BAR;
        PG8_WAIT_V(4); PG8_BAR;
        PG8_STAGE(PG8_SB(1, 0), cB + kstep, voffB); PG8_STAGE(PG8_SA(1, 0), cA + kstep, voffA); PG8_STAGE(PG8_SB(1, 1), cB + hstepB + kstep, voffB);
        PG8_WAIT_V(6); PG8_BAR;
    }
    for (;;) {
        const bool has_next = S.next(ui + 1, nxt);
        const char* nA = has_next ? (const char*)g.A + (size_t)(nxt.pm * g.am) * tstepA + (size_t)(nxt.pn & 3) * akb + (size_t)(nxt.pn >> 2) * a2b : cA; const char* nB = has_next ? (const char*)g.Bt + (size_t)nxt.pn * tstepB : cB;
        for (int t = 0; t < nt; t += 2) {
            const bool last = (t == nt - 2);
            const char* a1 = cA + (size_t)(t + 1) * kstep;
            const char* a2 = last ? nA : cA + (size_t)(t + 2) * kstep; const char* b2 = last ? nB : cB + (size_t)(t + 2) * kstep;
            const char* a3 = a2 + kstep; const char* b3 = b2 + kstep;
            if (last && has_next) S.a_ready(nxt);
            if constexpr (SP2) {
            PG8_LDB(B0, 0, 0); PG8_LDB(B1, 0, 1); PG8_SCHED; PG8_LDA(At, 0, 0); PG8_STAGE(PG8_SA(1, 1), a1 + hstepA, voffA);
            PG8_WAIT_V(8); PG8_WAIT_L(0); PG8_BAR; PG8_MMA(0, 0, At, B0); PG8_MMA(0, 1, At, B1); PG8_BAR; PG8_SCHED;
            PG8_LDA(At, 0, 1); PG8_STAGE(PG8_SB(0, 0), b2, voffB); PG8_STAGE(PG8_SB(0, 1), b2 + hstepB, voffB); PG8_STAGE(PG8_SA(0, 0), a2, voffA);
            PG8_WAIT_V(8); PG8_WAIT_L(0); PG8_BAR; PG8_MMA(1, 0, At, B0); PG8_MMA(1, 1, At, B1); PG8_BAR; PG8_SCHED;
            PG8_LDB(B0, 1, 0); PG8_LDB(B1, 1, 1); PG8_SCHED; PG8_LDA(At, 1, 0); PG8_STAGE(PG8_SA(0, 1), a2 + hstepA, voffA);
            PG8_WAIT_V(8); PG8_WAIT_L(0); PG8_BAR; PG8_MMA(0, 0, At, B0); PG8_MMA(0, 1, At, B1); PG8_BAR; PG8_SCHED;
            PG8_LDA(At, 1, 1); PG8_STAGE(PG8_SB(1, 0), b3, voffB); PG8_STAGE(PG8_SB(1, 1), b3 + hstepB, voffB); PG8_STAGE(PG8_SA(1, 0), a3, voffA);
            PG8_WAIT_V(8); PG8_WAIT_L(0); PG8_BAR; PG8_MMA(1, 0, At, B0); PG8_MMA(1, 1, At, B1); PG8_BAR; PG8_SCHED;
            } else {
            PG8_LDB(B0, 0, 0); PG8_SCHED; PG8_LDA(At, 0, 0); PG8_STAGE(PG8_SA(1, 1), a1 + hstepA, voffA);
            PG8_WAIT_L(8); PG8_BAR; PG8_WAIT_L(0); PG8_MMA(0, 0, At, B0); PG8_BAR; PG8_SCHED;
            PG8_LDB(B1, 0, 1); PG8_STAGE(PG8_SB(0, 0), b2, voffB);
            PG8_BAR; PG8_WAIT_L(0); PG8_MMA(0, 1, At, B1); PG8_BAR;
            PG8_LDA(At, 0, 1); PG8_STAGE(PG8_SA(0, 0), a2, voffA);
            PG8_BAR; PG8_WAIT_L(0); PG8_MMA(1, 0, At, B0); PG8_BAR; PG8_SCHED;
            PG8_STAGE(PG8_SB(0, 1), b2 + hstepB, voffB);
            PG8_WAIT_V(6); PG8_BAR; PG8_MMA(1, 1, At, B1); PG8_BAR;
            PG8_LDB(B0, 1, 0); PG8_SCHED; PG8_LDA(At, 1, 0); PG8_STAGE(PG8_SA(0, 1), a2 + hstepA, voffA);
            PG8_WAIT_L(8); PG8_BAR; PG8_WAIT_L(0); PG8_MMA(0, 0, At, B0); PG8_BAR; PG8_SCHED;
            PG8_LDB(B1, 1, 1); PG8_STAGE(PG8_SB(1, 0), b3, voffB);
            PG8_BAR; PG8_WAIT_L(0); PG8_MMA(0, 1, At, B1); PG8_BAR;
            PG8_LDA(At, 1, 1); PG8_STAGE(PG8_SA(1, 0), a3, voffA);
            PG8_BAR; PG8_WAIT_L(0); PG8_MMA(1, 0, At, B0); PG8_BAR; PG8_SCHED;
            PG8_STAGE(PG8_SB(1, 1), b3 + hstepB, voffB);
            PG8_WAIT_V(6); PG8_BAR; PG8_MMA(1, 1, At, B1); PG8_BAR;
            }
        }
        if constexpr (ALIGN_EPI) { if (wr == 0) PG8_BAR; }
        if constexpr (!Epi::AFTER_DRAIN) { E(acc, cur, wr, wc, fr, fq); S.done(cur); }
        if (!has_next) break;
#pragma unroll
        for (int a = 0; a < 2; ++a)
#pragma unroll
            for (int b = 0; b < 2; ++b)
#pragma unroll
                for (int m = 0; m < 4; ++m)
#pragma unroll
                    for (int n = 0; n < 2; ++n) acc[a][b][m][n] = (f32x4){0.f, 0.f, 0.f, 0.f};
        cur = nxt; cA = nA; cB = nB; ++ui;
        if constexpr (ALIGN_EPI) { if (wr == 1) PG8_BAR; }
    }
    PG8_WAIT_V(0);
    if constexpr (!ALIGN_EPI) { if (wr == 0) PG8_BAR; }
    PG8_BAR;
    if constexpr (Epi::AFTER_DRAIN) { E.fused(acc, cur, wr, wc, fr, fq, lds, wid, lane); S.done(cur); }
#undef PG8_SA
#undef PG8_SB
#undef PG8_STAGE
#undef PG8_LDA
#undef PG8_LDB
#undef PG8_MMA
#undef PG8_WAIT_V
#undef PG8_WAIT_L
#undef PG8_BAR
#undef PG8_SCHED
}

template <class Epi, class Sched, bool ALIGN_EPI = false, bool SP2 = false>
__device__ __forceinline__ void gemm_phase_i8(PG8_LAS unsigned char* lds, const Gemm g, const Sched& S, const Epi& E, const int wid0) {
    const int tid = otid(wid0), wid = __builtin_amdgcn_readfirstlane(tid >> 6), lane = tid & 63, wr = wid >> 2, wc = wid & 3, fr = lane & 15, fq = lane >> 4;
    const int K = g.K, nt = K / 128;
    unsigned voffA[2], voffB[2];
#pragma unroll
    for (int i = 0; i < 2; ++i) { int R, C; stage_rc(tid * 16 + i * 8192, R, C); const int Rb = Epi::PERM ? ((R & ~31) + perm32(R & 31)) : R;
        voffA[i] = (unsigned)(R * g.lda + C * 2); voffB[i] = (unsigned)(Rb * g.ldb + C * 2); }
    const size_t kstep = (size_t)(BK * 2);
    const size_t hstepA = (size_t)HALF * g.lda, hstepB = (size_t)HALF * g.ldb;
    const size_t tstepA = 2 * hstepA, tstepB = 2 * hstepB, akb = (size_t)g.akoff, a2b = (size_t)g.a2off;
    const unsigned ldsw = (unsigned)wid * 1024u;
    const int aoff = lds_byte(wr * 64 + fr, fq * 8), boff = lds_byte(wc * 32 + fr, fq * 8);
#define PG8_SA(b, h) (((b) * 2 + (h)) * HTB)
#define PG8_SB(b, h) ((4 + (b) * 2 + (h)) * HTB)
#define PG8_STAGE(bufoff, gbase, voff) do { _Pragma("unroll") for (int _i = 0; _i < 2; ++_i) \
        __builtin_amdgcn_global_load_lds((const unsigned*)((const char*)(gbase) + (voff)[_i]), (PG8_LAS unsigned*)(lds + (bufoff) + ldsw + _i * 8192), 16, 0, 0); } while (0)
#define PG8_LDA(dst, b, h) do { _Pragma("unroll") for (int m = 0; m < 4; ++m) _Pragma("unroll") for (int k = 0; k < 2; ++k) dst[m][k] = *(const PG8_LAS i32x4*)(lds + PG8_SA(b, h) + aoff + m * 2048 + k * 1024); } while (0)
#define PG8_LDB(dst, b, h) do { _Pragma("unroll") for (int n = 0; n < 2; ++n) _Pragma("unroll") for (int k = 0; k < 2; ++k) dst[n][k] = *(const PG8_LAS i32x4*)(lds + PG8_SB(b, h) + boff + n * 2048 + k * 1024); } while (0)
#define PG8_MMA(ai, bj, At, Bt) do { __builtin_amdgcn_s_setprio(1); _Pragma("unroll") for (int m = 0; m < 4; ++m) _Pragma("unroll") for (int n = 0; n < 2; ++n) _Pragma("unroll") for (int k = 0; k < 2; ++k) \
        acc[ai][bj][m][n] = __builtin_amdgcn_mfma_i32_16x16x64_i8(Bt[n][k], At[m][k], acc[ai][bj][m][n], 0, 0, 0); __builtin_amdgcn_s_setprio(0); } while (0)
#define PG8_WAIT_V(n) asm volatile("s_waitcnt vmcnt(" #n ")" ::: "memory")
#define PG8_WAIT_L(n) asm volatile("s_waitcnt lgkmcnt(" #n ")" ::: "memory")
#define PG8_BAR __builtin_amdgcn_s_barrier()
#define PG8_SCHED __builtin_amdgcn_sched_barrier(0)
    Unit cur, nxt; int ui = 0;
    if (!S.next(0, cur)) return;
    i32x4 acc[2][2][4][2];
#pragma unroll
    for (int a = 0; a < 2; ++a)
#pragma unroll
        for (int b = 0; b < 2; ++b)
#pragma unroll
            for (int m = 0; m < 4; ++m)
#pragma unroll
                for (int n = 0; n < 2; ++n) acc[a][b][m][n] = (i32x4){0, 0, 0, 0};
    i32x4 At[4][2], B0[2][2], B1[2][2];
    const char* cA = (const char*)g.A + (size_t)(cur.pm * g.am) * tstepA + (size_t)(cur.pn & 3) * akb + (size_t)(cur.pn >> 2) * a2b; const char* cB = (const char*)g.Bt + (size_t)cur.pn * tstepB;
    S.a_ready(cur);
    if constexpr (SP2) {
        PG8_STAGE(PG8_SB(0, 0), cB, voffB); PG8_STAGE(PG8_SB(0, 1), cB + hstepB, voffB); PG8_STAGE(PG8_SA(0, 0), cA, voffA); PG8_STAGE(PG8_SA(0, 1), cA + hstepA, voffA);
        if (wr == 1) PG8_BAR;
        PG8_WAIT_V(2); PG8_BAR;
        PG8_STAGE(PG8_SB(1, 0), cB + kstep, voffB); PG8_STAGE(PG8_SA(1, 0), cA + kstep, voffA); PG8_STAGE(PG8_SB(1, 1), cB + hstepB + kstep, voffB);
        PG8_WAIT_V(6); PG8_BAR;
    } else {
        PG8_STAGE(PG8_SB(0, 0), cB, voffB); PG8_STAGE(PG8_SA(0, 0), cA, voffA); PG8_STAGE(PG8_SB(0, 1), cB + hstepB, voffB); PG8_STAGE(PG8_SA(0, 1), cA + hstepA, voffA);
        if (wr == 1) PG8_BAR;
        PG8_WAIT_V(4); PG8_BAR;
        PG8_STAGE(PG8_SB(1, 0), cB + kstep, voffB); PG8_STAGE(PG8_SA(1, 0), cA + kstep, voffA); PG8_STAGE(PG8_SB(1, 1), cB + hstepB + kstep, voffB);
        PG8_WAIT_V(6); PG8_BAR;
    }
    for (;;) {
        const bool has_next = S.next(ui + 1, nxt);
        const char* nA = has_next ? (const char*)g.A + (size_t)(nxt.pm * g.am) * tstepA + (size_t)(nxt.pn & 3) * akb + (size_t)(nxt.pn >> 2) * a2b : cA; const char* nB = has_next ? (const char*)g.Bt + (size_t)nxt.pn * tstepB : cB;
        for (int t = 0; t < nt; t += 2) {
            const bool last = (t == nt - 2);
            const char* a1 = cA + (size_t)(t + 1) * kstep;
            const char* a2 = last ? nA : cA + (size_t)(t + 2) * kstep; const char* b2 = last ? nB : cB + (size_t)(t + 2) * kstep;
            const char* a3 = a2 + kstep; const char* b3 = b2 + kstep;
            if (last && has_next) S.a_ready(nxt);
            if constexpr (SP2) {
            PG8_LDB(B0, 0, 0); PG8_LDB(B1, 0, 1); PG8_SCHED; PG8_LDA(At, 0, 0); PG8_STAGE(PG8_SA(1, 1), a1 + hstepA, voffA);
            PG8_WAIT_V(8); PG8_WAIT_L(0); PG8_BAR; PG8_MMA(0, 0, At, B0); PG8_MMA(0, 1, At, B1); PG8_BAR; PG8_SCHED;
            PG8_LDA(At, 0, 1); PG8_STAGE(PG8_SB(0, 0), b2, voffB); PG8_STAGE(PG8_SB(0, 1), b2 + hstepB, voffB); PG8_STAGE(PG8_SA(0, 0), a2, voffA);
            PG8_WAIT_V(8); PG8_WAIT_L(0); PG8_BAR; PG8_MMA(1, 0, At, B0); PG8_MMA(1, 1, At, B1); PG8_BAR; PG8_SCHED;
            PG8_LDB(B0, 1, 0); PG8_LDB(B1, 1, 1); PG8_SCHED; PG8_LDA(At, 1, 0); PG8_STAGE(PG8_SA(0, 1), a2 + hstepA, voffA);
            PG8_WAIT_V(8); PG8_WAIT_L(0); PG8_BAR; PG8_MMA(0, 0, At, B0); PG8_MMA(0, 1, At, B1); PG8_BAR; PG8_SCHED;
            PG8_LDA(At, 1, 1); PG8_STAGE(PG8_SB(1, 0), b3, voffB); PG8_STAGE(PG8_SB(1, 1), b3 + hstepB, voffB); PG8_STAGE(PG8_SA(1, 0), a3, voffA);
            PG8_WAIT_V(8); PG8_WAIT_L(0); PG8_BAR; PG8_MMA(1, 0, At, B0); PG8_MMA(1, 1, At, B1); PG8_BAR; PG8_SCHED;
            } else {
            PG8_LDB(B0, 0, 0); PG8_SCHED; PG8_LDA(At, 0, 0); PG8_STAGE(PG8_SA(1, 1), a1 + hstepA, voffA);
            PG8_WAIT_L(8); PG8_BAR; PG8_WAIT_L(0); PG8_MMA(0, 0, At, B0); PG8_BAR; PG8_SCHED;
            PG8_LDB(B1, 0, 1); PG8_STAGE(PG8_SB(0, 0), b2, voffB);
            PG8_BAR; PG8_WAIT_L(0); PG8_MMA(0, 1, At, B1); PG8_BAR;
            PG8_LDA(At, 0, 1); PG8_STAGE(PG8_SA(0, 0), a2, voffA);
            PG8_BAR; PG8_WAIT_L(0); PG8_MMA(1, 0, At, B0); PG8_BAR; PG8_SCHED;
            PG8_STAGE(PG8_SB(0, 1), b2 + hstepB, voffB);
            PG8_WAIT_V(6); PG8_BAR; PG8_MMA(1, 1, At, B1); PG8_BAR;
            PG8_LDB(B0, 1, 0); PG8_SCHED; PG8_LDA(At, 1, 0); PG8_STAGE(PG8_SA(0, 1), a2 + hstepA, voffA);
            PG8_WAIT_L(8); PG8_BAR; PG8_WAIT_L(0); PG8_MMA(0, 0, At, B0); PG8_BAR; PG8_SCHED;
            PG8_LDB(B1, 1, 1); PG8_STAGE(PG8_SB(1, 0), b3, voffB);
            PG8_BAR; PG8_WAIT_L(0); PG8_MMA(0, 1, At, B1); PG8_BAR;
            PG8_LDA(At, 1, 1); PG8_STAGE(PG8_SA(1, 0), a3, voffA);
            PG8_BAR; PG8_WAIT_L(0); PG8_MMA(1, 0, At, B0); PG8_BAR; PG8_SCHED;
            PG8_STAGE(PG8_SB(1, 1), b3 + hstepB, voffB);
            PG8_WAIT_V(6); PG8_BAR; PG8_MMA(1, 1, At, B1); PG8_BAR;
            }
        }
        if constexpr (ALIGN_EPI) { if (wr == 0) PG8_BAR; }
        if constexpr (!Epi::AFTER_DRAIN) { E(acc, cur, wr, wc, fr, fq); S.done(cur); }
        if (!has_next) break;
#pragma unroll
        for (int a = 0; a < 2; ++a)
#pragma unroll
            for (int b = 0; b < 2; ++b)
#pragma unroll
                for (int m = 0; m < 4; ++m)
#pragma unroll
                    for (int n = 0; n < 2; ++n) acc[a][b][m][n] = (i32x4){0, 0, 0, 0};
        cur = nxt; cA = nA; cB = nB; ++ui;
        if constexpr (ALIGN_EPI) { if (wr == 1) PG8_BAR; }
    }
    PG8_WAIT_V(0);
    if constexpr (!ALIGN_EPI) { if (wr == 0) PG8_BAR; }
    PG8_BAR;
    if constexpr (Epi::AFTER_DRAIN) { E.fused(acc, cur, wr, wc, fr, fq, lds, wid, lane); S.done(cur); }
#undef PG8_SA
#undef PG8_SB
#undef PG8_STAGE
#undef PG8_LDA
#undef PG8_LDB
#undef PG8_MMA
#undef PG8_WAIT_V
#undef PG8_WAIT_L
#undef PG8_BAR
#undef PG8_SCHED
}
}


namespace pg8 {
typedef unsigned u32x2 __attribute__((ext_vector_type(2)));
__device__ __forceinline__ unsigned cvt_pk_bf16(float lo, float hi) { unsigned r; asm volatile("v_cvt_pk_bf16_f32 %0, %1, %2" : "=v"(r) : "v"(lo), "v"(hi)); return r; }
__device__ __forceinline__ float sigm(float x) { return __builtin_amdgcn_rcpf(1.0f + __builtin_amdgcn_exp2f(-1.4426950408889634f * x)); }
__device__ __forceinline__ float bf_lo(unsigned w) { return __uint_as_float(w << 16); }
__device__ __forceinline__ float bf_hi(unsigned w) { return __uint_as_float(w & 0xffff0000u); }

struct PanelSched {
    int panel, n, skip_lo, skip_n, mode, first;
    __device__ __forceinline__ bool next(int i, Unit& u) const {
        if (i >= n) return false;
        if (mode == 0) { const int j = first + i; u.pm = panel; u.pn = j + (j >= skip_lo ? skip_n : 0); } else if (mode == 2) { u.pm = panel; u.pn = (i >> 1) + 4 * (i & 1); } else { u.pm = i; u.pn = panel; }
        return true;
    }
    __device__ __forceinline__ void a_ready(const Unit&) const {}
    __device__ __forceinline__ void done(const Unit&) const {}
};

struct EpiProj {
    static constexpr bool PERM = true, AFTER_DRAIN = false;
    bf16_t *PQ, *PK, *PU, *PG;
    __device__ __forceinline__ void operator()(const f32x4 (&acc)[2][2][4][2], const Unit& u, int wr, int wc, int fr, int fq) const {
        const int pn = u.pn; bf16_t* base; int ld, colt; bool sg = false;
        if (pn < 2) { base = PQ; ld = 512; colt = pn * 256; }
        else if (pn < 4) { base = PK; ld = 512; colt = (pn - 2) * 256; }
        else if (pn < 8) { base = PU; ld = 512; colt = (pn - 6) * 256; }
        else { base = PG; ld = 2048; colt = (pn - 8) * 256; sg = true; }
        const int row0 = u.pm * BM + wr * 64 + fr, col0 = colt + wc * 32 + 8 * fq;
#pragma unroll
        for (int ai = 0; ai < 2; ++ai)
#pragma unroll
            for (int m = 0; m < 4; ++m) { bf16_t* rowp = base + (size_t)(row0 + ai * HALF + m * 16) * ld + col0;
#pragma unroll
                for (int bj = 0; bj < 2; ++bj) { f32x4 v0 = acc[ai][bj][m][0], v1 = acc[ai][bj][m][1];
                    if (sg) { v0 = (f32x4){sigm(v0[0]), sigm(v0[1]), sigm(v0[2]), sigm(v0[3])}; v1 = (f32x4){sigm(v1[0]), sigm(v1[1]), sigm(v1[2]), sigm(v1[3])}; }
                    u32x4 w; w.x = cvt_pk_bf16(v0[0], v0[1]); w.y = cvt_pk_bf16(v0[2], v0[3]); w.z = cvt_pk_bf16(v1[0], v1[1]); w.w = cvt_pk_bf16(v1[2], v1[3]);
                    *(u32x4*)(rowp + bj * HALF) = w; } }
    }
};
__device__ __forceinline__ unsigned gate4_u8(float a, float b, float c, float d) {
    const unsigned ua = (unsigned)__builtin_rintf(a * 255.f), ub = (unsigned)__builtin_rintf(b * 255.f), uc = (unsigned)__builtin_rintf(c * 255.f), ud = (unsigned)__builtin_rintf(d * 255.f);
    return ua | (ub << 8) | (uc << 16) | (ud << 24);
}
struct EpiProjI8 {
    static constexpr bool PERM = true, AFTER_DRAIN = false;
    bf16_t *PQ, *PK, *PU, *PG; const float* rs; const float* cs;
    __device__ __forceinline__ void operator()(const i32x4 (&acc)[2][2][4][2], const Unit& u, int wr, int wc, int fr, int fq) const {
        asm volatile("" : "+v"(fr), "+v"(fq));
        const int pn = u.pn; bf16_t* base; int ld, colt; bool sg = false;
        if (pn < 2) { base = PQ; ld = 512; colt = pn * 256; }
        else if (pn < 4) { base = PK; ld = 512; colt = (pn - 2) * 256; }
        else if (pn < 8) { base = PU; ld = 512; colt = (pn - 6) * 256; }
        else { base = PG; ld = 2048; colt = (pn - 8) * 256; sg = true; }
        const int row0 = u.pm * BM + wr * 64 + fr, col0 = colt + wc * 32 + 8 * fq, ccol0 = pn * BM + wc * 32 + 8 * fq;
        f32x4 cv[2][2];
#pragma unroll
        for (int bj = 0; bj < 2; ++bj) { cv[bj][0] = *(const f32x4*)(cs + ccol0 + bj * HALF); cv[bj][1] = *(const f32x4*)(cs + ccol0 + bj * HALF + 4); }
#pragma unroll
        for (int ai = 0; ai < 2; ++ai)
#pragma unroll
            for (int m = 0; m < 4; ++m) { const int row = row0 + ai * HALF + m * 16; const float r = rs[row]; bf16_t* rowp = base + (size_t)row * ld + col0;
#pragma unroll
                for (int bj = 0; bj < 2; ++bj) { const i32x4 a0 = acc[ai][bj][m][0], a1 = acc[ai][bj][m][1];
                    f32x4 v0 = (f32x4){(float)a0[0], (float)a0[1], (float)a0[2], (float)a0[3]} * cv[bj][0] * r, v1 = (f32x4){(float)a1[0], (float)a1[1], (float)a1[2], (float)a1[3]} * cv[bj][1] * r;
                    if (sg) {
                        const unsigned lo = gate4_u8(sigm(v0[0]), sigm(v0[1]), sigm(v0[2]), sigm(v0[3])), hi = gate4_u8(sigm(v1[0]), sigm(v1[1]), sigm(v1[2]), sigm(v1[3]));
                        *(unsigned long long*)((unsigned char*)PG + (size_t)row * 4096 + col0 + bj * HALF) = (unsigned long long)lo | ((unsigned long long)hi << 32); }
                    else { u32x4 w; w.x = cvt_pk_bf16(v0[0], v0[1]); w.y = cvt_pk_bf16(v0[2], v0[3]); w.z = cvt_pk_bf16(v1[0], v1[1]); w.w = cvt_pk_bf16(v1[2], v1[3]);
                        *(u32x4*)(rowp + bj * HALF) = w; } } }
    }
};
struct EpiPlainScaleI8 {
    static constexpr bool PERM = true, AFTER_DRAIN = false;
    bf16_t* O; int ldc; PG8_LAS const float* rs; const float* cs;
    __device__ __forceinline__ void operator()(const i32x4 (&acc)[2][2][4][2], const Unit& u, int wr, int wc, int fr, int fq) const {
        asm volatile("" : "+v"(fr), "+v"(fq));
        const int col0 = u.pn * BM + wc * 32 + 8 * fq;
        f32x4 cv[2][2];
#pragma unroll
        for (int bj = 0; bj < 2; ++bj) { cv[bj][0] = *(const f32x4*)(cs + col0 + bj * HALF); cv[bj][1] = *(const f32x4*)(cs + col0 + bj * HALF + 4); }
#pragma unroll
        for (int ai = 0; ai < 2; ++ai)
#pragma unroll
            for (int m = 0; m < 4; ++m) { const int lr = ai * HALF + wr * 64 + m * 16 + fr; const float r = rs[lr]; bf16_t* rowp = O + (size_t)(u.pm * BM + lr) * ldc + col0;
#pragma unroll
                for (int bj = 0; bj < 2; ++bj) { const i32x4 a0 = acc[ai][bj][m][0], a1 = acc[ai][bj][m][1];
                    const f32x4 v0 = (f32x4){(float)a0[0], (float)a0[1], (float)a0[2], (float)a0[3]} * cv[bj][0] * r, v1 = (f32x4){(float)a1[0], (float)a1[1], (float)a1[2], (float)a1[3]} * cv[bj][1] * r;
                    u32x4 w; w.x = cvt_pk_bf16(v0[0], v0[1]); w.y = cvt_pk_bf16(v0[2], v0[3]); w.z = cvt_pk_bf16(v1[0], v1[1]); w.w = cvt_pk_bf16(v1[2], v1[3]);
                    *(u32x4*)(rowp + bj * HALF) = w; } }
    }
};
struct EpiPlainI8 {
    static constexpr bool PERM = true, AFTER_DRAIN = false;
    bf16_t* O; int ldc; const float* rs; const float* cs;
    __device__ __forceinline__ void operator()(const i32x4 (&acc)[2][2][4][2], const Unit& u, int wr, int wc, int fr, int fq) const {
        asm volatile("" : "+v"(fr), "+v"(fq));
        const int row0 = u.pm * BM + wr * 64 + fr, col0 = u.pn * BM + wc * 32 + 8 * fq;
        f32x4 cv[2][2];
#pragma unroll
        for (int bj = 0; bj < 2; ++bj) { cv[bj][0] = *(const f32x4*)(cs + col0 + bj * HALF); cv[bj][1] = *(const f32x4*)(cs + col0 + bj * HALF + 4); }
#pragma unroll
        for (int ai = 0; ai < 2; ++ai)
#pragma unroll
            for (int m = 0; m < 4; ++m) { const int row = row0 + ai * HALF + m * 16; const float r = rs[row]; bf16_t* rowp = O + (size_t)row * ldc + col0;
#pragma unroll
                for (int bj = 0; bj < 2; ++bj) { const i32x4 a0 = acc[ai][bj][m][0], a1 = acc[ai][bj][m][1];
                    const f32x4 v0 = (f32x4){(float)a0[0], (float)a0[1], (float)a0[2], (float)a0[3]} * cv[bj][0] * r, v1 = (f32x4){(float)a1[0], (float)a1[1], (float)a1[2], (float)a1[3]} * cv[bj][1] * r;
                    u32x4 w; w.x = cvt_pk_bf16(v0[0], v0[1]); w.y = cvt_pk_bf16(v0[2], v0[3]); w.z = cvt_pk_bf16(v1[0], v1[1]); w.w = cvt_pk_bf16(v1[2], v1[3]);
                    *(u32x4*)(rowp + bj * HALF) = w; } }
    }
};
struct EpiPlain {
    static constexpr bool PERM = true, AFTER_DRAIN = false;
    bf16_t* O; int ldc;
    __device__ __forceinline__ void operator()(const f32x4 (&acc)[2][2][4][2], const Unit& u, int wr, int wc, int fr, int fq) const {
        const int row0 = u.pm * BM + wr * 64 + fr, col0 = u.pn * BM + wc * 32 + 8 * fq;
#pragma unroll
        for (int ai = 0; ai < 2; ++ai)
#pragma unroll
            for (int m = 0; m < 4; ++m) { bf16_t* rowp = O + (size_t)(row0 + ai * HALF + m * 16) * ldc + col0;
#pragma unroll
                for (int bj = 0; bj < 2; ++bj) { const f32x4 v0 = acc[ai][bj][m][0], v1 = acc[ai][bj][m][1];
                    u32x4 w; w.x = cvt_pk_bf16(v0[0], v0[1]); w.y = cvt_pk_bf16(v0[2], v0[3]); w.z = cvt_pk_bf16(v1[0], v1[1]); w.w = cvt_pk_bf16(v1[2], v1[3]);
                    *(u32x4*)(rowp + bj * HALF) = w; } }
    }
};
struct EpiMergeChain {
    static constexpr bool PERM = true, AFTER_DRAIN = false;
    const bf16_t* G; bf16_t* MG;
    __device__ __forceinline__ void operator()(const f32x4 (&acc)[2][2][4][2], const Unit& u, int wr, int wc, int fr, int fq) const {
        const bool add = u.pn >= 4; const int goff = add ? 1024 : 0;
        const int row0 = u.pm * BM + wr * 64 + fr, col0 = (u.pn & 3) * BM + wc * 32 + 8 * fq;
        if (add) asm volatile("s_waitcnt vmcnt(0)" ::: "memory");
#pragma unroll
        for (int ai = 0; ai < 2; ++ai)
#pragma unroll
            for (int m = 0; m < 4; ++m) { const size_t row = (size_t)(row0 + ai * HALF + m * 16);
#pragma unroll
                for (int bj = 0; bj < 2; ++bj) { const f32x4 v0 = acc[ai][bj][m][0], v1 = acc[ai][bj][m][1];
                    const unsigned long long gq = *(const unsigned long long*)((const unsigned char*)G + row * 4096 + goff + col0 + bj * HALF);
                    const unsigned g0 = (unsigned)gq, g1 = (unsigned)(gq >> 32); const float k255 = 1.0f / 255.0f;
                    float r0 = (float)(g0 & 255u) * k255 * v0[0], r1 = (float)((g0 >> 8) & 255u) * k255 * v0[1], r2 = (float)((g0 >> 16) & 255u) * k255 * v0[2], r3 = (float)(g0 >> 24) * k255 * v0[3];
                    float r4 = (float)(g1 & 255u) * k255 * v1[0], r5 = (float)((g1 >> 8) & 255u) * k255 * v1[1], r6 = (float)((g1 >> 16) & 255u) * k255 * v1[2], r7 = (float)(g1 >> 24) * k255 * v1[3];
                    bf16_t* mp = MG + row * 1024 + col0 + bj * HALF;
                    if (add) { const u32x4 pw = *(const u32x4*)mp;
                        r0 += bf_lo(pw.x); r1 += bf_hi(pw.x); r2 += bf_lo(pw.y); r3 += bf_hi(pw.y); r4 += bf_lo(pw.z); r5 += bf_hi(pw.z); r6 += bf_lo(pw.w); r7 += bf_hi(pw.w); }
                    u32x4 w; w.x = cvt_pk_bf16(r0, r1); w.y = cvt_pk_bf16(r2, r3); w.z = cvt_pk_bf16(r4, r5); w.w = cvt_pk_bf16(r6, r7);
                    *(u32x4*)mp = w; }
                if (m == 3) asm volatile("" ::: "memory"); }
    }
};
struct EpiMerge2 {
    static constexpr bool PERM = true, AFTER_DRAIN = false;
    const unsigned char* G; bf16_t* MG;
    __device__ __forceinline__ void operator()(const f32x4 (&acc)[2][2][4][2], const Unit& u, int wr, int wc, int fr, int fq) const {
        asm volatile("" : "+v"(fr), "+v"(fq));
        const int row0 = u.pm * BM + wr * 64 + fr, colm = 256 * (u.pn & 3) + 128 * (u.pn >> 2) + wc * 32 + 8 * fq;
        const float k255 = 1.0f / 255.0f;
#pragma unroll
        for (int ai = 0; ai < 2; ++ai)
#pragma unroll
            for (int m = 0; m < 4; ++m) { const size_t row = (size_t)(row0 + ai * HALF + m * 16);
                const unsigned long long ga = *(const unsigned long long*)(G + row * 4096 + colm), gp = *(const unsigned long long*)(G + row * 4096 + 1024 + colm);
                const unsigned a0 = (unsigned)ga, a1 = (unsigned)(ga >> 32), q0 = (unsigned)gp, q1 = (unsigned)(gp >> 32);
                const f32x4 x0 = acc[ai][0][m][0], x1 = acc[ai][0][m][1], y0 = acc[ai][1][m][0], y1 = acc[ai][1][m][1];
                const float r0 = ((float)(a0 & 255u) * x0[0] + (float)(q0 & 255u) * y0[0]) * k255, r1 = ((float)((a0 >> 8) & 255u) * x0[1] + (float)((q0 >> 8) & 255u) * y0[1]) * k255;
                const float r2 = ((float)((a0 >> 16) & 255u) * x0[2] + (float)((q0 >> 16) & 255u) * y0[2]) * k255, r3 = ((float)(a0 >> 24) * x0[3] + (float)(q0 >> 24) * y0[3]) * k255;
                const float r4 = ((float)(a1 & 255u) * x1[0] + (float)(q1 & 255u) * y1[0]) * k255, r5 = ((float)((a1 >> 8) & 255u) * x1[1] + (float)((q1 >> 8) & 255u) * y1[1]) * k255;
                const float r6 = ((float)((a1 >> 16) & 255u) * x1[2] + (float)((q1 >> 16) & 255u) * y1[2]) * k255, r7 = ((float)(a1 >> 24) * x1[3] + (float)(q1 >> 24) * y1[3]) * k255;
                u32x4 w; w.x = cvt_pk_bf16(r0, r1); w.y = cvt_pk_bf16(r2, r3); w.z = cvt_pk_bf16(r4, r5); w.w = cvt_pk_bf16(r6, r7);
                *(u32x4*)(MG + row * 1024 + colm) = w;
                if (m == 3) asm volatile("" ::: "memory"); }
    }
};
__device__ __forceinline__ void lds_addf(PG8_LAS float* p, float v) { __hip_atomic_fetch_add(p, v, __ATOMIC_RELAXED, __HIP_MEMORY_SCOPE_WORKGROUP); }
__device__ __forceinline__ float quad_row_sum(float s, int lane) {
    s += __builtin_bit_cast(float, __builtin_amdgcn_ds_bpermute((lane ^ 16) << 2, __builtin_bit_cast(int, s)));
    s += __builtin_bit_cast(float, __builtin_amdgcn_ds_bpermute((lane ^ 32) << 2, __builtin_bit_cast(int, s)));
    return s;
}
struct EpiRes {
    static constexpr bool PERM = true, AFTER_DRAIN = false;
    const float* X; bf16_t* OB; PG8_LAS float* ss;
    __device__ __forceinline__ void operator()(const f32x4 (&acc)[2][2][4][2], const Unit& u, int wr, int wc, int fr, int fq) const {
        asm volatile("" : "+v"(fr), "+v"(fq));
        const int col0 = u.pn * BM + wc * 32 + 8 * fq; const int lane = fq * 16 + fr;
#pragma unroll
        for (int ai = 0; ai < 2; ++ai)
#pragma unroll
            for (int m = 0; m < 4; ++m) { const int lr = ai * HALF + wr * 64 + m * 16 + fr; const size_t xoff = (size_t)(u.pm * BM + lr) * 1024 + col0; bf16_t* op = OB + ((size_t)(2 * u.pm) * BM + lr) * 1024 + col0;
                float s = 0.f;
#pragma unroll
                for (int bj = 0; bj < 2; ++bj) { const f32x4 x0 = *(const f32x4*)(X + xoff + bj * HALF), x1 = *(const f32x4*)(X + xoff + bj * HALF + 4);
                    const f32x4 v0 = x0 + acc[ai][bj][m][0], v1 = x1 + acc[ai][bj][m][1];
                    s += (v0[0] * v0[0] + v0[1] * v0[1]) + (v0[2] * v0[2] + v0[3] * v0[3]) + (v1[0] * v1[0] + v1[1] * v1[1]) + (v1[2] * v1[2] + v1[3] * v1[3]);
                    u32x4 w; w.x = cvt_pk_bf16(v0[0], v0[1]); w.y = cvt_pk_bf16(v0[2], v0[3]); w.z = cvt_pk_bf16(v1[0], v1[1]); w.w = cvt_pk_bf16(v1[2], v1[3]);
                    *(u32x4*)(op + bj * HALF) = w; }
                s = quad_row_sum(s, lane); if (fq == 0) lds_addf(ss + lr, s);
                if (m == 3) asm volatile("" ::: "memory"); }
    }
};
struct EpiPlainScale {
    static constexpr bool PERM = true, AFTER_DRAIN = false;
    bf16_t* O; int ldc; PG8_LAS const float* rs;
    __device__ __forceinline__ void operator()(const f32x4 (&acc)[2][2][4][2], const Unit& u, int wr, int wc, int fr, int fq) const {
        asm volatile("" : "+v"(fr), "+v"(fq));
        const int col0 = u.pn * BM + wc * 32 + 8 * fq;
#pragma unroll
        for (int ai = 0; ai < 2; ++ai)
#pragma unroll
            for (int m = 0; m < 4; ++m) { const int lr = ai * HALF + wr * 64 + m * 16 + fr; const float r = rs[lr]; bf16_t* rowp = O + (size_t)(u.pm * BM + lr) * ldc + col0;
#pragma unroll
                for (int bj = 0; bj < 2; ++bj) { const f32x4 v0 = acc[ai][bj][m][0] * r, v1 = acc[ai][bj][m][1] * r;
                    u32x4 w; w.x = cvt_pk_bf16(v0[0], v0[1]); w.y = cvt_pk_bf16(v0[2], v0[3]); w.z = cvt_pk_bf16(v1[0], v1[1]); w.w = cvt_pk_bf16(v1[2], v1[3]);
                    *(u32x4*)(rowp + bj * HALF) = w; } }
    }
};
struct EpiGate {
    static constexpr bool PERM = false, AFTER_DRAIN = false;
    bf16_t* X3; const bf16_t* X2; const bf16_t* E; PG8_LAS const float* rs; PG8_LAS float* ss;
    __device__ __forceinline__ void operator()(const f32x4 (&acc)[2][2][4][2], const Unit& u, int wr, int wc, int fr, int fq) const {
        asm volatile("" : "+v"(fr), "+v"(fq));
        const int col0 = u.pn * BM + wc * 32 + 4 * fq; const int lane = fq * 16 + fr;
        bf16_t* const x3b = X3 + col0;
#pragma unroll
        for (int ai = 0; ai < 2; ++ai)
#pragma unroll
            for (int m = 0; m < 4; ++m) { const int lr = ai * HALF + wr * 64 + m * 16 + fr; const float r = rs[lr];
                const size_t off = (size_t)(u.pm * BM + lr) * 1024 + col0, xo = ((size_t)(2 * u.pm) * BM + lr) * 1024 + col0; float s = 0.f;
#pragma unroll
                for (int bj = 0; bj < 2; ++bj)
#pragma unroll
                    for (int n = 0; n < 2; ++n) { const int co = bj * HALF + n * 16; const u32x2 xw = *(const u32x2*)(X2 + xo + co); const u32x2 ew = *(const u32x2*)(E + off + co); const f32x4 a = acc[ai][bj][m][n] * r;
                        f32x4 v; v[0] = bf_lo(xw.x) + sigm(a[0]) * bf_lo(ew.x); v[1] = bf_hi(xw.x) + sigm(a[1]) * bf_hi(ew.x); v[2] = bf_lo(xw.y) + sigm(a[2]) * bf_lo(ew.y); v[3] = bf_hi(xw.y) + sigm(a[3]) * bf_hi(ew.y);
                        s += (v[0] * v[0] + v[1] * v[1]) + (v[2] * v[2] + v[3] * v[3]);
                        u32x2 w3; w3.x = cvt_pk_bf16(v[0], v[1]); w3.y = cvt_pk_bf16(v[2], v[3]); *(u32x2*)(x3b + (size_t)(u.pm * BM + lr) * 1024 + co) = w3; }
                s = quad_row_sum(s, lane); if (fq == 0) lds_addf(ss + lr, s);
                if (m == 3) asm volatile("" ::: "memory"); }
    }
};
}

#define GAS __attribute__((address_space(1)))
#define LAS __attribute__((address_space(3)))
typedef unsigned short bf16;
typedef unsigned v4u __attribute__((ext_vector_type(4)));
typedef unsigned v2u __attribute__((ext_vector_type(2)));
typedef float f32x4 __attribute__((ext_vector_type(4)));
typedef short bf16x8 __attribute__((ext_vector_type(8)));
typedef GAS unsigned gu32;
typedef GAS unsigned long long gu64;
#define RLX_AGENT __ATOMIC_RELAXED, __HIP_MEMORY_SCOPE_AGENT
#define LDS_WAIT() asm volatile("s_waitcnt lgkmcnt(0)" ::: "memory")
#define VM_WAIT() asm volatile("s_waitcnt vmcnt(0)" ::: "memory")
__device__ __forceinline__ unsigned long long rt() { return __builtin_amdgcn_s_memrealtime(); }
__device__ __forceinline__ unsigned f2bf(float f) { unsigned u = __builtin_bit_cast(unsigned, f); return (u + 0x7fffu + ((u >> 16) & 1u)) >> 16; }
__device__ __forceinline__ unsigned pk2(float lo, float hi) { return f2bf(lo) | (f2bf(hi) << 16); }

#define XB_TMO      128
#define XB_XCNT(j)  (256  + 64 * (j))
#define XB_XSUB(j)  (1280 + 64 * (j))
#define XB_XGEN(j)  (2304 + 64 * (j))
#define XB_TOP      3328
#define XB_TOPGEN   3392
#define XCD_BAR_WORDS 3456
#define XB_SPIN_CAP (1u << 18)

__device__ __forceinline__ unsigned xb_ld(unsigned* p)              { return __hip_atomic_load(p, __ATOMIC_RELAXED, __HIP_MEMORY_SCOPE_AGENT); }
__device__ __forceinline__ unsigned xb_add(unsigned* p, unsigned v) { return __hip_atomic_fetch_add(p, v, __ATOMIC_RELAXED, __HIP_MEMORY_SCOPE_AGENT); }
__device__ __forceinline__ unsigned xb_xcc_id() { return (unsigned)__builtin_amdgcn_s_getreg((3 << 11) | 20) & 0xFu; }
#define XB_SPIN(cond, bar) do { unsigned _sp = 0; while (cond) { __builtin_amdgcn_s_sleep(1); \
    if ((++_sp & 255u) == 0u) { if (xb_ld(&(bar)[XB_TMO])) break; if (_sp > XB_SPIN_CAP) { atomicAdd(&(bar)[XB_TMO], 1u); break; } } } } while (0)

struct XcdBarrier {
    unsigned* bar; unsigned x;
    volatile LAS unsigned* st;
};

__device__ __forceinline__ XcdBarrier xcd_barrier_post(unsigned* bar, volatile LAS unsigned* st, const bool is_t0) {
    XcdBarrier b; b.bar = bar; b.x = xb_xcc_id(); b.st = st;
    if (is_t0) (void)xb_add(&bar[XB_XCNT(b.x)], 1u);
    return b;
}
__device__ __forceinline__ void xcd_barrier_complete(unsigned* bar, unsigned x, unsigned& nloc, unsigned& nx) {
    const unsigned G = gridDim.x * gridDim.y * gridDim.z;
    unsigned sum, cnt, mine, sp = 0u;
    for (;;) {
        sum = 0u; cnt = 0u; mine = 0u;
#pragma unroll
        for (unsigned j = 0; j < 16; ++j) { const unsigned c = xb_ld(&bar[XB_XCNT(j)]); sum += c; cnt += (c > 0u) ? 1u : 0u; mine = (j == x) ? c : mine; }
        if (sum == G) break;
        __builtin_amdgcn_s_sleep(1);
        if ((++sp & 255u) == 0u) { if (xb_ld(&bar[XB_TMO])) break; if (sp > XB_SPIN_CAP) { atomicAdd(&bar[XB_TMO], 1u); break; } }
    }
    nloc = mine > 0u ? mine : 1u; nx = cnt > 0u ? cnt : 1u;
}

__device__ __forceinline__ void xcd_barrier(const XcdBarrier& b, const bool is_t0) {
    asm volatile("s_waitcnt vmcnt(0)" ::: "memory");
    __syncthreads();
    if (is_t0) {
        unsigned* bar = b.bar;
        __builtin_amdgcn_s_waitcnt(0);
        unsigned nloc = b.st[0], nx = b.st[1];
        if (nloc == 0u) { xcd_barrier_complete(bar, b.x, nloc, nx); b.st[0] = nloc; b.st[1] = nx; }
        const unsigned old = xb_add(&bar[XB_XSUB(b.x)], 1u);
        const unsigned gen = old / nloc;
        if (old + 1u == (gen + 1u) * nloc) {
            __builtin_amdgcn_fence(__ATOMIC_RELEASE, "agent");
            asm volatile("s_waitcnt vmcnt(0)" ::: "memory");
            const unsigned og = xb_add(&bar[XB_TOP], 1u);
            const unsigned tg = og / nx;
            if (og + 1u == (tg + 1u) * nx) xb_add(&bar[XB_TOPGEN], 1u);
            else XB_SPIN(xb_ld(&bar[XB_TOPGEN]) == tg, bar);
            __builtin_amdgcn_fence(__ATOMIC_ACQUIRE, "agent");
            xb_add(&bar[XB_XGEN(b.x)], 1u);
            asm volatile("s_waitcnt vmcnt(0)" ::: "memory");
        } else {
            XB_SPIN(xb_ld(&bar[XB_XGEN(b.x)]) == gen, bar);
            __builtin_amdgcn_fence(__ATOMIC_ACQUIRE, "agent");
            asm volatile("s_waitcnt vmcnt(0)" ::: "memory");
        }
    }
    __syncthreads();
}


constexpr int NWAVES = 8, NTHR = 512;
constexpr int TOK = 65536, DM = 1024, SEQ = 8192, NPANEL = 256;
constexpr float RMS_EPS = 1e-6f;
constexpr float C2 = 0.125f * 1.4426950408889634f;
constexpr float SURV_THR = 5.4210108624275222e-20f;
constexpr size_t MiB = 1u << 20;
constexpr size_t WS_CTL = 0, CTL_ZERO_BYTES = 64 * 1024;
constexpr size_t WS_WIN = 2 * MiB, WS_WOUT = 10 * MiB, WS_WQ = 12 * MiB, WS_WPG = 16 * MiB, WS_WPLE = 18 * MiB;
constexpr size_t WS_BD2 = 24 * MiB, WS_SK = 19 * MiB;
constexpr size_t WS_SX = 21 * MiB, WS_SBN = 21 * MiB + 262144, WS_SBQ = 21 * MiB + 262144 + 16384;
constexpr size_t WS_EU = 32 * MiB, WS_EV = 64 * MiB, WS_SU = 20 * MiB, WS_SV = 20 * MiB + 65536;
constexpr size_t WS_XN = 96 * MiB;
constexpr size_t WS_PQ = 224 * MiB, WS_PK = 288 * MiB, WS_PVT = 352 * MiB, WS_PU = 416 * MiB;
constexpr size_t WS_PG = 480 * MiB;
constexpr size_t WS_YA = 736 * MiB, WS_YP = 800 * MiB;
constexpr size_t WS_MG = 864 * MiB, WS_END = 992 * MiB;
constexpr int CW_BAR = 1024, CW_CMAX = 8192;
constexpr int RING_BYTES = 131072, LDSCTL_OFF = RING_BYTES, MISC_OFF = LDSCTL_OFF + 320, LDS_BYTES = 147456;

typedef float f32x16 __attribute__((ext_vector_type(16)));
typedef float f32x2 __attribute__((ext_vector_type(2)));
typedef __bf16 bf16x2v __attribute__((ext_vector_type(2)));

__device__ __forceinline__ int shx(int v, int m, int lane) { return __builtin_amdgcn_ds_bpermute((lane ^ m) << 2, v); }
__device__ __forceinline__ float shx(float v, int m, int lane) { return __builtin_bit_cast(float, __builtin_amdgcn_ds_bpermute((lane ^ m) << 2, __builtin_bit_cast(int, v))); }
__device__ __forceinline__ float shl_(float v, int src) { return __builtin_bit_cast(float, __builtin_amdgcn_ds_bpermute(src << 2, __builtin_bit_cast(int, v))); }
__device__ __forceinline__ float wave_sum(float v, int lane) {
#pragma unroll
    for (int o = 1; o < 64; o <<= 1) v += shx(v, o, lane);
    return v;
}
__device__ __forceinline__ float bflo(unsigned w) { return __uint_as_float(w << 16); }
__device__ __forceinline__ float bfhi(unsigned w) { return __uint_as_float(w & 0xffff0000u); }
__device__ __forceinline__ unsigned cvtpk(float lo, float hi) { return pg8::cvt_pk_bf16(lo, hi); }

#define H_UNPACK(H, A, B) do { H[0] = bflo(A.x); H[1] = bfhi(A.x); H[2] = bflo(A.y); H[3] = bfhi(A.y); H[4] = bflo(A.z); H[5] = bfhi(A.z); H[6] = bflo(A.w); H[7] = bfhi(A.w); \
        H[8] = bflo(B.x); H[9] = bfhi(B.x); H[10] = bflo(B.y); H[11] = bfhi(B.y); H[12] = bflo(B.z); H[13] = bfhi(B.z); H[14] = bflo(B.w); H[15] = bfhi(B.w); } while (0)
__device__ __forceinline__ void p0_transpose_item(const float* W, int K, int N, bf16* WT, const float* kscale, int nlo, float nls, LAS float* scr, int item, int lane) {
    const int nblk = N / 32, kb = item / nblk, nb = item % nblk, k0 = 64 * kb, n0 = 32 * nb;
    const float ns = (n0 + (lane & 31)) < nlo ? nls : 1.0f;
#pragma unroll 8
    for (int i = 0; i < 32; ++i) { const int kk = 2 * i + (lane >> 5); float v = W[(size_t)(k0 + kk) * N + n0 + (lane & 31)] * ns; if (kscale) v *= kscale[k0 + kk]; scr[kk * 33 + (lane & 31)] = v; }
    LDS_WAIT(); asm volatile("" ::: "memory");
    const int c = lane & 7;
#pragma unroll
    for (int j = 0; j < 4; ++j) { const int n = (lane >> 3) + 8 * j; const LAS float* s = scr + (8 * c) * 33 + n;
        v4u o; o.x = pk2(s[0 * 33], s[1 * 33]); o.y = pk2(s[2 * 33], s[3 * 33]); o.z = pk2(s[4 * 33], s[5 * 33]); o.w = pk2(s[6 * 33], s[7 * 33]);
        *(GAS v4u*)(WT + (size_t)(n0 + n) * K + k0 + 8 * c) = o; }
    LDS_WAIT(); asm volatile("" ::: "memory");
}
__device__ __forceinline__ void rms_rows4_to_bf16(const float* xrow, bf16* orow, size_t rstride, int lane) {
    f32x4 v[4][4]; float s[4];
#pragma unroll
    for (int k = 0; k < 4; ++k) { const GAS f32x4* xr = (const GAS f32x4*)(xrow + k * rstride) + lane;
#pragma unroll
        for (int j = 0; j < 4; ++j) v[k][j] = xr[64 * j]; }
#pragma unroll
    for (int k = 0; k < 4; ++k) { s[k] = 0.f;
#pragma unroll
        for (int j = 0; j < 4; ++j) s[k] += (v[k][j].x * v[k][j].x + v[k][j].y * v[k][j].y) + (v[k][j].z * v[k][j].z + v[k][j].w * v[k][j].w); }
#pragma unroll
    for (int o = 1; o < 64; o <<= 1) {
#pragma unroll
        for (int k = 0; k < 4; ++k) s[k] += shx(s[k], o, lane); }
#pragma unroll
    for (int k = 0; k < 4; ++k) { const float r = 1.f / sqrtf(s[k] * (1.f / DM) + RMS_EPS);
        GAS unsigned long long* o8 = (GAS unsigned long long*)(orow + k * rstride) + lane;
#pragma unroll
        for (int j = 0; j < 4; ++j) o8[64 * j] = (unsigned long long)pk2(v[k][j].x * r, v[k][j].y * r) | ((unsigned long long)pk2(v[k][j].z * r, v[k][j].w * r) << 32); }
}
__device__ __forceinline__ unsigned pack4_i8(float a, float b, float c, float d) {
    const int qa = (int)__builtin_rintf(a), qb = (int)__builtin_rintf(b), qc = (int)__builtin_rintf(c), qd = (int)__builtin_rintf(d);
    return (unsigned)(qa & 255) | ((unsigned)(qb & 255) << 8) | ((unsigned)(qc & 255) << 16) | ((unsigned)qd << 24);
}
__device__ __forceinline__ void rms_rows4_to_i8(const float* xrow, unsigned char* orow, float* sc, size_t rstride, size_t sstride, int lane) {
    f32x4 v[4][4]; float s[4], m[4];
#pragma unroll
    for (int k = 0; k < 4; ++k) { const GAS f32x4* xr = (const GAS f32x4*)(xrow + k * rstride) + lane;
#pragma unroll
        for (int j = 0; j < 4; ++j) v[k][j] = xr[64 * j]; }
#pragma unroll
    for (int k = 0; k < 4; ++k) { s[k] = 0.f; m[k] = 0.f;
#pragma unroll
        for (int j = 0; j < 4; ++j) { s[k] += (v[k][j].x * v[k][j].x + v[k][j].y * v[k][j].y) + (v[k][j].z * v[k][j].z + v[k][j].w * v[k][j].w);
            m[k] = fmaxf(m[k], fmaxf(fmaxf(fabsf(v[k][j].x), fabsf(v[k][j].y)), fmaxf(fabsf(v[k][j].z), fabsf(v[k][j].w)))); } }
#pragma unroll
    for (int o = 1; o < 64; o <<= 1) {
#pragma unroll
        for (int k = 0; k < 4; ++k) { s[k] += shx(s[k], o, lane); m[k] = fmaxf(m[k], shx(m[k], o, lane)); } }
#pragma unroll
    for (int k = 0; k < 4; ++k) { const float r = 1.f / sqrtf(s[k] * (1.f / DM) + RMS_EPS); const float qs = m[k] > 0.f ? 127.0f / m[k] : 1.0f;
        GAS unsigned* o4 = (GAS unsigned*)(orow + k * rstride) + lane;
#pragma unroll
        for (int j = 0; j < 4; ++j) o4[64 * j] = pack4_i8(v[k][j].x * qs, v[k][j].y * qs, v[k][j].z * qs, v[k][j].w * qs);
        if (lane == 0) sc[k * sstride] = (m[k] > 0.f ? m[k] * (1.0f / 127.0f) : 1.0f) * r; }
}
__device__ __forceinline__ void p0_colmax_item(const float* W, int N, unsigned* cmax, const float* kscale, int nlo, float nls, int item, int lane) {
    const int nblk = N / 64, ks = item / nblk, nb = item % nblk, n = 64 * nb + lane;
    const float ns = n < nlo ? nls : 1.0f;
    const float* wp = W + (size_t)(32 * ks) * N + n; const float* kp = kscale + 32 * ks;
    float m = 0.f;
#pragma unroll 8
    for (int i = 0; i < 32; ++i) { m = fmaxf(m, fabsf(wp[0] * ns * kp[i])); wp += N; }
    __hip_atomic_fetch_max(cmax + n, __float_as_uint(m), __ATOMIC_RELAXED, __HIP_MEMORY_SCOPE_AGENT);
}
__device__ __forceinline__ void p0_quant_tile_item(const float* W, int N, unsigned char* WT8, float* colsc, const unsigned* cmax, const float* kscale, int nlo, float nls, LAS float* scr, int item, int lane) {
    const int K = 1024; const int nblk = N / 32, kb = item / nblk, nb = item % nblk, k0 = 64 * kb, n0 = 32 * nb;
    const float cm = __uint_as_float(cmax[n0 + (lane & 31)]);
    const float ns = ((n0 + (lane & 31)) < nlo ? nls : 1.0f) * (cm > 0.f ? 127.0f / cm : 1.0f);
    if (kb == 0 && lane < 32) colsc[n0 + lane] = cm > 0.f ? cm * (1.0f / 127.0f) : 1.0f;
#pragma unroll 8
    for (int i = 0; i < 32; ++i) { const int kk = 2 * i + (lane >> 5); scr[kk * 33 + (lane & 31)] = W[(size_t)(k0 + kk) * N + n0 + (lane & 31)] * ns * kscale[k0 + kk]; }
    LDS_WAIT(); asm volatile("" ::: "memory");
    const int c = lane & 7;
#pragma unroll
    for (int j = 0; j < 4; ++j) { const int n = (lane >> 3) + 8 * j; const LAS float* s = scr + (8 * c) * 33 + n;
        const unsigned lo = pack4_i8(s[0 * 33], s[1 * 33], s[2 * 33], s[3 * 33]), hi = pack4_i8(s[4 * 33], s[5 * 33], s[6 * 33], s[7 * 33]);
        *(GAS unsigned long long*)(WT8 + (size_t)(n0 + n) * K + k0 + 8 * c) = (unsigned long long)lo | ((unsigned long long)hi << 32); }
    LDS_WAIT(); asm volatile("" ::: "memory");
}
__device__ __forceinline__ void cvt8_store(const float* src, bf16* dst) {
    const f32x4 a = *(const GAS f32x4*)src, b = *(const GAS f32x4*)(src + 4);
    v4u o; o.x = pk2(a.x, a.y); o.y = pk2(a.z, a.w); o.z = pk2(b.x, b.y); o.w = pk2(b.z, b.w);
    *(GAS v4u*)dst = o;
}

__device__ __forceinline__ void attn_panel(int panel, const bf16* PQ, const bf16* PK, const bf16* PVT, bf16* YA, const int wid0) {
    const int tid = otid(wid0), lane = tid & 63, wid = __builtin_amdgcn_readfirstlane(tid >> 6);
    const int r32 = lane & 31, hh = lane >> 5;
    const size_t seq0 = (size_t)(panel >> 5) * SEQ;
    const int pos0 = (panel & 31) * 256 + wid * 32;
    const int kap = 16 * ((r32 >> 2) & 1) + (r32 & 3) + 4 * (r32 >> 3);
    for (int h = 0; h < 8; ++h) {
        bf16x8 qf[4];
        { const bf16* qrow = PQ + (seq0 + pos0 + r32) * 512 + h * 64 + 8 * hh;
#pragma unroll
          for (int s = 0; s < 4; ++s) qf[s] = *(const GAS bf16x8*)(qrow + 16 * s); }
        f32x16 o0 = {}, o1 = {};
        float Sin = 1.f;
        for (int kb = pos0; kb >= 0; kb -= 32) {
            const bf16* krow = PK + (seq0 + kb + kap) * 512 + h * 64 + 8 * hh;
            const bf16* vrow = PVT + (size_t)(h * 64 + kap) * TOK + seq0 + kb + 16 * hh;
            bf16x8 kf[4], vf[2][2];
#pragma unroll
            for (int s = 0; s < 4; ++s) kf[s] = *(const GAS bf16x8*)(krow + 16 * s);
#pragma unroll
            for (int db = 0; db < 2; ++db)
#pragma unroll
                for (int s = 0; s < 2; ++s) vf[db][s] = *(const GAS bf16x8*)(vrow + (size_t)db * 32 * TOK + 8 * s);
            f32x16 z = {};
#pragma unroll
            for (int s = 0; s < 4; ++s) z = __builtin_amdgcn_mfma_f32_32x32x16_bf16(kf[s], qf[s], z, 0, 0, 0);
            const bool diag = (kb == pos0);
            float w[16]; float Sl = 1.f;
#pragma unroll
            for (int reg = 15; reg >= 0; --reg) {
                float beta = __builtin_amdgcn_rcpf(1.0f + __builtin_amdgcn_exp2f(-z[reg]));
                if (diag && (16 * hh + reg >= r32)) beta = 0.f;
                const float wl = beta * Sl; Sl -= wl; w[reg] = wl;
            }
            const float Pp = shx(Sl, 32, lane);
            const float scale = hh ? Sin : Sin * Pp;
            Sin = Sin * Sl * Pp;
            v4u pw0, pw1;
            pw0.x = cvtpk(w[0] * scale, w[1] * scale); pw0.y = cvtpk(w[2] * scale, w[3] * scale); pw0.z = cvtpk(w[4] * scale, w[5] * scale); pw0.w = cvtpk(w[6] * scale, w[7] * scale);
            pw1.x = cvtpk(w[8] * scale, w[9] * scale); pw1.y = cvtpk(w[10] * scale, w[11] * scale); pw1.z = cvtpk(w[12] * scale, w[13] * scale); pw1.w = cvtpk(w[14] * scale, w[15] * scale);
            const bf16x8 p0 = __builtin_bit_cast(bf16x8, pw0), p1 = __builtin_bit_cast(bf16x8, pw1);
            o0 = __builtin_amdgcn_mfma_f32_32x32x16_bf16(vf[0][0], p0, o0, 0, 0, 0);
            o0 = __builtin_amdgcn_mfma_f32_32x32x16_bf16(vf[0][1], p1, o0, 0, 0, 0);
            o1 = __builtin_amdgcn_mfma_f32_32x32x16_bf16(vf[1][0], p0, o1, 0, 0, 0);
            o1 = __builtin_amdgcn_mfma_f32_32x32x16_bf16(vf[1][1], p1, o1, 0, 0, 0);
            if (__all(Sin < SURV_THR)) break;
        }
        bf16* orow = YA + (seq0 + pos0 + r32) * 1024 + (h >> 1) * 256 + (h & 1) * 64 + 16 * hh;
        v4u a, b2;
        a.x = cvtpk(o0[0], o0[1]); a.y = cvtpk(o0[2], o0[3]); a.z = cvtpk(o0[4], o0[5]); a.w = cvtpk(o0[6], o0[7]);
        b2.x = cvtpk(o0[8], o0[9]); b2.y = cvtpk(o0[10], o0[11]); b2.z = cvtpk(o0[12], o0[13]); b2.w = cvtpk(o0[14], o0[15]);
        *(GAS v4u*)orow = a; *(GAS v4u*)(orow + 8) = b2;
        a.x = cvtpk(o1[0], o1[1]); a.y = cvtpk(o1[2], o1[3]); a.z = cvtpk(o1[4], o1[5]); a.w = cvtpk(o1[6], o1[7]);
        b2.x = cvtpk(o1[8], o1[9]); b2.y = cvtpk(o1[10], o1[11]); b2.z = cvtpk(o1[12], o1[13]); b2.w = cvtpk(o1[14], o1[15]);
        *(GAS v4u*)(orow + 32) = a; *(GAS v4u*)(orow + 40) = b2;
    }
}

__device__ __forceinline__ void pool_panel(int panel, const bf16* PU, bf16* YP, const int wid0) {
    const int tid = otid(wid0);
    const int chunk = tid & 63, tg = tid >> 6, w = 2 << (chunk >> 4);
    const int posb = (panel & 31) * 256; const size_t row0 = (size_t)panel * 256;
    float s[8];
#pragma unroll
    for (int k = 0; k < 8; ++k) s[k] = 0.f;
    { const int t = tg * 32, pos = posb + t, cnt = (pos + 1 < w) ? (pos + 1) : w;
      for (int j = 1; j < cnt; ++j) { const v4u v = *(const GAS v4u*)(PU + (row0 + t - j) * 512 + chunk * 8);
          s[0] += bflo(v.x); s[1] += bfhi(v.x); s[2] += bflo(v.y); s[3] += bfhi(v.y); s[4] += bflo(v.z); s[5] += bfhi(v.z); s[6] += bflo(v.w); s[7] += bfhi(v.w); } }
    for (int i = 0; i < 32; ++i) {
        const int t = tg * 32 + i, pos = posb + t, cnt = (pos + 1 < w) ? (pos + 1) : w;
        const v4u cur = *(const GAS v4u*)(PU + (row0 + t) * 512 + chunk * 8);
        s[0] += bflo(cur.x); s[1] += bfhi(cur.x); s[2] += bflo(cur.y); s[3] += bfhi(cur.y); s[4] += bflo(cur.z); s[5] += bfhi(cur.z); s[6] += bflo(cur.w); s[7] += bfhi(cur.w);
        const float ic = 1.0f / (float)cnt;
        v4u o;
        o.x = cvtpk(s[0] * ic - bflo(cur.x), s[1] * ic - bfhi(cur.x)); o.y = cvtpk(s[2] * ic - bflo(cur.y), s[3] * ic - bfhi(cur.y));
        o.z = cvtpk(s[4] * ic - bflo(cur.z), s[5] * ic - bfhi(cur.z)); o.w = cvtpk(s[6] * ic - bflo(cur.w), s[7] * ic - bfhi(cur.w));
        *(GAS v4u*)(YP + (row0 + t) * 1024 + (chunk >> 4) * 256 + 128 + (chunk & 15) * 8) = o;
        if (pos + 1 >= w) {
            const v4u v = *(const GAS v4u*)(PU + (row0 + t - (w - 1)) * 512 + chunk * 8);
            s[0] -= bflo(v.x); s[1] -= bfhi(v.x); s[2] -= bflo(v.y); s[3] -= bfhi(v.y); s[4] -= bflo(v.z); s[5] -= bfhi(v.z); s[6] -= bflo(v.w); s[7] -= bfhi(v.w);
        }
    }
}

#define HD __host__ __device__ __forceinline__
HD int f2s(float f) { int i = __builtin_bit_cast(int, f); return i ^ ((i >> 31) & 0x7fffffff); }
HD float s2f(int i) { i ^= ((i >> 31) & 0x7fffffff); return __builtin_bit_cast(float, i); }
HD void ce_desc(int& a, int& b) { const int mx = a > b ? a : b, mn = a > b ? b : a; a = mx; b = mn; }
template <int J, int K> HD void bpass16(int (&v)[16]) {
#pragma unroll
    for (int i = 0; i < 16; ++i) { const int l = i ^ J; if (l > i) { if ((i & K) == 0) ce_desc(v[i], v[l]); else ce_desc(v[l], v[i]); } }
}
HD void bitonic_sort16_desc(int (&v)[16]) {
    bpass16<1, 2>(v); bpass16<2, 4>(v); bpass16<1, 4>(v); bpass16<4, 8>(v); bpass16<2, 8>(v); bpass16<1, 8>(v);
    bpass16<8, 16>(v); bpass16<4, 16>(v); bpass16<2, 16>(v); bpass16<1, 16>(v);
}
HD void bitonic_merge16_desc(int (&v)[16]) {
    bpass16<8, 16>(v); bpass16<4, 16>(v); bpass16<2, 16>(v); bpass16<1, 16>(v);
}
HD void merge_prune16(int (&x)[16], const int (&y)[16]) {
#pragma unroll
    for (int i = 0; i < 16; ++i) x[i] = x[i] > y[15 - i] ? x[i] : y[15 - i];
    bitonic_merge16_desc(x);
}
HD int cx_i(int hf, int t) { if (hf == 0) return 0; return t < 5 ? 2 : t < 9 ? 3 : t < 12 ? 4 : t < 14 ? 5 : 6; }
HD int cx_j(int hf, int t) { if (hf == 0) return t; return t < 5 ? t : t < 9 ? t - 5 : t < 12 ? t - 9 : t < 14 ? t - 12 : t - 14; }
HD int cy_i(int hf, int t) { if (hf == 0) return t < 8 ? 1 : 23 - t; return 7; }
HD int cy_j(int hf, int t) { if (hf == 0) return t < 8 ? t : 0; return t; }

__device__ __forceinline__ void top16_of_group(const bf16x8 (&qf)[8], LAS const unsigned char* skl, int r32, int hh, int lane, int (&res)[16]) {
    int v[4][16];
#pragma unroll
    for (int kb = 0; kb < 4; ++kb) {
        f32x16 acc = {};
#pragma unroll
        for (int s = 0; s < 8; ++s) { const bf16x8 af = *(LAS const bf16x8*)(skl + (32 * kb + r32) * 272 + 32 * s + 16 * hh); acc = __builtin_amdgcn_mfma_f32_32x32x16_bf16(af, qf[s], acc, 0, 0, 0); }
#pragma unroll
        for (int reg = 0; reg < 16; ++reg) { const int keyid = 32 * kb + (reg & 3) + 8 * (reg >> 2) + 4 * hh; v[kb][reg] = (f2s(acc[reg]) & ~127) | keyid; }
    }
    bitonic_sort16_desc(v[0]); bitonic_sort16_desc(v[1]); bitonic_sort16_desc(v[2]); bitonic_sort16_desc(v[3]);
    merge_prune16(v[0], v[1]); merge_prune16(v[2], v[3]); merge_prune16(v[0], v[2]);
    int y[16];
#pragma unroll
    for (int i = 0; i < 16; ++i) y[i] = shx(v[0][i], 32, lane);
    merge_prune16(v[0], y);
#pragma unroll
    for (int i = 0; i < 16; ++i) res[i] = v[0][i];
}

__device__ __forceinline__ void topk_panel(int panel, const bf16* QP, const bf16* SK, int* IDXp, float* GTp  , LAS unsigned char* ldsb  , const int wid0) {
    const int tid = otid(wid0), lane = tid & 63, wid = __builtin_amdgcn_readfirstlane(tid >> 6);
    const int r32 = lane & 31, hh = lane >> 5;
    const int lrow = wid * 32 + r32;
    const size_t row = (size_t)panel * 256 + lrow;
    LAS int* lut = (LAS int*)ldsb; LAS unsigned char* skl = ldsb + 65536;
    v4u skr[4];
#define SK_FETCH(g_) do { _Pragma("unroll") for (int i = 0; i < 4; ++i) skr[i] = *((const GAS v4u*)(SK + (size_t)(g_) * 128 * 128) + i * 512 + tid); } while (0)
#define SK_STAGE() do { _Pragma("unroll") for (int i = 0; i < 4; ++i) { const int p = i * 512 + tid; *(LAS v4u*)(skl + (p >> 4) * 272 + (p & 15) * 16) = skr[i]; } } while (0)
    bf16x8 qn[8];
#define Q_FETCH(g_) do { const bf16* qrow_ = QP + row * 2048 + (g_) * 128 + 8 * hh; _Pragma("unroll") for (int s = 0; s < 8; ++s) qn[s] = *(const GAS bf16x8*)(qrow_ + 16 * s); } while (0)
    SK_FETCH(0); Q_FETCH(0);
    for (int h = 0; h < 8; ++h) {
        int a[16], b[16];
#pragma unroll
        for (int c = 0; c < 2; ++c) {
            const int g = 2 * h + c;
            bf16x8 qf[8];
#pragma unroll
            for (int s = 0; s < 8; ++s) qf[s] = qn[s];
            __syncthreads();
            SK_STAGE();
            __syncthreads();
            if (g < 15) { SK_FETCH(g + 1); Q_FETCH(g + 1); }
            if (c == 0) top16_of_group(qf, skl, r32, hh, lane, a); else top16_of_group(qf, skl, r32, hh, lane, b);
        }
        float fa[16], fb[16];
#pragma unroll
        for (int i = 0; i < 16; ++i) { fa[i] = s2f(a[i] & ~127); fb[i] = s2f(b[i] & ~127); lut[i * 512 + tid] = a[i] & 127; lut[(16 + i) * 512 + tid] = b[i] & 127; }
        int X[16], Y[16];
#pragma unroll
        for (int t = 0; t < 16; ++t) {
            const float s0 = fa[cx_i(0, t)] + fb[cx_j(0, t)], s1 = fa[cx_i(1, t)] + fb[cx_j(1, t)];
            const int c0 = cx_i(0, t) * 16 + cx_j(0, t), c1 = cx_i(1, t) * 16 + cx_j(1, t);
            X[t] = hh ? ((f2s(s1) & ~255) | c1) : ((f2s(s0) & ~255) | c0);
            const float u0 = fa[cy_i(0, t)] + fb[cy_j(0, t)];
            const int d0 = cy_i(0, t) * 16 + cy_j(0, t);
            int y1 = (int)0x80000000;
            if (t < 2) { const float u1 = fa[cy_i(1, t)] + fb[cy_j(1, t)]; y1 = (f2s(u1) & ~255) | (cy_i(1, t) * 16 + cy_j(1, t)); }
            Y[t] = hh ? y1 : ((f2s(u0) & ~255) | d0);
        }
        bitonic_sort16_desc(X); bitonic_merge16_desc(Y); merge_prune16(X, Y);
#pragma unroll
        for (int i = 0; i < 16; ++i) Y[i] = shx(X[i], 32, lane);
        merge_prune16(X, Y);
        const float mx = s2f(X[0] & ~255);
        float ex[16], den = 0.f;
#pragma unroll
        for (int i = 0; i < 16; ++i) { ex[i] = __builtin_amdgcn_exp2f((s2f(X[i] & ~255) - mx) * 1.4426950408889634f); den += ex[i]; }
        const float rden = 1.0f / den;
        int oi[8]; float og[8];
#pragma unroll
        for (int t = 0; t < 8; ++t) {
            const int msk = -hh;
            const int code = (X[t] ^ ((X[t] ^ X[8 + t]) & msk)) & 255;
            const int e1 = lut[(code >> 4) * 512 + tid], e2 = lut[(16 + (code & 15)) * 512 + tid];
            const int exl = __builtin_bit_cast(int, ex[t]), exh = __builtin_bit_cast(int, ex[8 + t]);
            oi[t] = e1 * 128 + e2; og[t] = __builtin_bit_cast(float, exl ^ ((exl ^ exh) & msk)) * rden;
        }
        int* ip = IDXp + lrow * 128 + h * 16 + 8 * hh; float* gp = GTp + lrow * 128 + h * 16 + 8 * hh;
        *(GAS v4u*)ip = (v4u){(unsigned)oi[0], (unsigned)oi[1], (unsigned)oi[2], (unsigned)oi[3]}; *(GAS v4u*)(ip + 4) = (v4u){(unsigned)oi[4], (unsigned)oi[5], (unsigned)oi[6], (unsigned)oi[7]};
        *(GAS f32x4*)gp = (f32x4){og[0], og[1], og[2], og[3]}; *(GAS f32x4*)(gp + 4) = (f32x4){og[4], og[5], og[6], og[7]};
    }
#undef SK_FETCH
#undef SK_STAGE
#undef Q_FETCH
}

typedef float f32x2v __attribute__((ext_vector_type(2)));
__device__ __forceinline__ void quant_row_fp8(const float* src, const float* colgain, unsigned char* dst, float* sc_out, int lane) {
    const GAS f32x4* s = (const GAS f32x4*)src + 4 * lane;
    f32x4 v[4]; float m = 0.f;
#pragma unroll
    for (int j = 0; j < 4; ++j) { v[j] = s[j]; if (colgain) v[j] = v[j] * ((const GAS f32x4*)colgain + 4 * lane)[j]; m = fmaxf(m, fmaxf(fmaxf(fabsf(v[j].x), fabsf(v[j].y)), fmaxf(fabsf(v[j].z), fabsf(v[j].w)))); }
#pragma unroll
    for (int o = 1; o < 64; o <<= 1) m = fmaxf(m, shx(m, o, lane));
    const float sc = m > 0.f ? 224.0f / m : 1.0f;
    v4u w;
    { int t = 0; t = __builtin_amdgcn_cvt_pk_fp8_f32(v[0].x * sc, v[0].y * sc, t, false); t = __builtin_amdgcn_cvt_pk_fp8_f32(v[0].z * sc, v[0].w * sc, t, true); w.x = (unsigned)t; }
    { int t = 0; t = __builtin_amdgcn_cvt_pk_fp8_f32(v[1].x * sc, v[1].y * sc, t, false); t = __builtin_amdgcn_cvt_pk_fp8_f32(v[1].z * sc, v[1].w * sc, t, true); w.y = (unsigned)t; }
    { int t = 0; t = __builtin_amdgcn_cvt_pk_fp8_f32(v[2].x * sc, v[2].y * sc, t, false); t = __builtin_amdgcn_cvt_pk_fp8_f32(v[2].z * sc, v[2].w * sc, t, true); w.z = (unsigned)t; }
    { int t = 0; t = __builtin_amdgcn_cvt_pk_fp8_f32(v[3].x * sc, v[3].y * sc, t, false); t = __builtin_amdgcn_cvt_pk_fp8_f32(v[3].z * sc, v[3].w * sc, t, true); w.w = (unsigned)t; }
    *(GAS v4u*)(dst + 16 * lane) = w;
    if (lane == 0) *sc_out = m > 0.f ? m * (1.0f / 224.0f) : 1.0f;
}
__device__ __forceinline__ v4u quant16_fp8(const f32x4 (&v)[4], float sc) {
    v4u w;
    { int t = 0; t = __builtin_amdgcn_cvt_pk_fp8_f32(v[0].x * sc, v[0].y * sc, t, false); t = __builtin_amdgcn_cvt_pk_fp8_f32(v[0].z * sc, v[0].w * sc, t, true); w.x = (unsigned)t; }
    { int t = 0; t = __builtin_amdgcn_cvt_pk_fp8_f32(v[1].x * sc, v[1].y * sc, t, false); t = __builtin_amdgcn_cvt_pk_fp8_f32(v[1].z * sc, v[1].w * sc, t, true); w.y = (unsigned)t; }
    { int t = 0; t = __builtin_amdgcn_cvt_pk_fp8_f32(v[2].x * sc, v[2].y * sc, t, false); t = __builtin_amdgcn_cvt_pk_fp8_f32(v[2].z * sc, v[2].w * sc, t, true); w.z = (unsigned)t; }
    { int t = 0; t = __builtin_amdgcn_cvt_pk_fp8_f32(v[3].x * sc, v[3].y * sc, t, false); t = __builtin_amdgcn_cvt_pk_fp8_f32(v[3].z * sc, v[3].w * sc, t, true); w.w = (unsigned)t; }
    return w;
}
__device__ __forceinline__ v4u quant16_i8(const f32x4 (&v)[4], float sc) {
    v4u w; w.x = pack4_i8(v[0].x * sc, v[0].y * sc, v[0].z * sc, v[0].w * sc); w.y = pack4_i8(v[1].x * sc, v[1].y * sc, v[1].z * sc, v[1].w * sc);
    w.z = pack4_i8(v[2].x * sc, v[2].y * sc, v[2].z * sc, v[2].w * sc); w.w = pack4_i8(v[3].x * sc, v[3].y * sc, v[3].z * sc, v[3].w * sc); return w;
}
__device__ __forceinline__ void quant_rows2_fp8(const float* srcA, const float* gainA, unsigned char* dstA, float* scA, const float* srcB, unsigned char* dstB, float* scB, int lane) {
    f32x4 va[4], vb[4];
#pragma unroll
    for (int j = 0; j < 4; ++j) { va[j] = ((const GAS f32x4*)srcA + 4 * lane)[j]; vb[j] = ((const GAS f32x4*)srcB + 4 * lane)[j]; }
    float ma = 0.f, mb = 0.f;
#pragma unroll
    for (int j = 0; j < 4; ++j) { va[j] = va[j] * ((const GAS f32x4*)gainA + 4 * lane)[j];
        ma = fmaxf(ma, fmaxf(fmaxf(fabsf(va[j].x), fabsf(va[j].y)), fmaxf(fabsf(va[j].z), fabsf(va[j].w))));
        mb = fmaxf(mb, fmaxf(fmaxf(fabsf(vb[j].x), fabsf(vb[j].y)), fmaxf(fabsf(vb[j].z), fabsf(vb[j].w)))); }
#pragma unroll
    for (int o = 1; o < 64; o <<= 1) { ma = fmaxf(ma, shx(ma, o, lane)); mb = fmaxf(mb, shx(mb, o, lane)); }
    *(GAS v4u*)(dstA + 16 * lane) = quant16_i8(va, ma > 0.f ? 127.0f / ma : 1.0f);
    *(GAS v4u*)(dstB + 16 * lane) = quant16_fp8(vb, mb > 0.f ? 224.0f / mb : 1.0f);
    if (lane == 0) { *scA = ma > 0.f ? ma * (1.0f / 127.0f) : 1.0f; *scB = mb > 0.f ? mb * (1.0f / 224.0f) : 1.0f; }
}
__device__ __forceinline__ void p0_rows4_expert(const float* xrow, unsigned char* orow, float* sc, size_t rstride, size_t sstride,
                                                const float* srcA, const float* gainA, unsigned char* dstA, float* scA, const float* srcB, unsigned char* dstB, float* scB, int lane) {
    f32x4 v[4][4], va[4], vb[4], ga[4]; float s[4], m[4];
#pragma unroll
    for (int k = 0; k < 4; ++k) { const GAS f32x4* xr = (const GAS f32x4*)(xrow + k * rstride) + lane;
#pragma unroll
        for (int j = 0; j < 4; ++j) v[k][j] = xr[64 * j]; }
#pragma unroll
    for (int j = 0; j < 4; ++j) { va[j] = ((const GAS f32x4*)srcA + 4 * lane)[j]; vb[j] = ((const GAS f32x4*)srcB + 4 * lane)[j]; ga[j] = ((const GAS f32x4*)gainA + 4 * lane)[j]; }
#pragma unroll
    for (int k = 0; k < 4; ++k) { s[k] = 0.f; m[k] = 0.f;
#pragma unroll
        for (int j = 0; j < 4; ++j) { s[k] += (v[k][j].x * v[k][j].x + v[k][j].y * v[k][j].y) + (v[k][j].z * v[k][j].z + v[k][j].w * v[k][j].w);
            m[k] = fmaxf(m[k], fmaxf(fmaxf(fabsf(v[k][j].x), fabsf(v[k][j].y)), fmaxf(fabsf(v[k][j].z), fabsf(v[k][j].w)))); } }
    float ma = 0.f, mb = 0.f;
#pragma unroll
    for (int j = 0; j < 4; ++j) { va[j] = va[j] * ga[j];
        ma = fmaxf(ma, fmaxf(fmaxf(fabsf(va[j].x), fabsf(va[j].y)), fmaxf(fabsf(va[j].z), fabsf(va[j].w))));
        mb = fmaxf(mb, fmaxf(fmaxf(fabsf(vb[j].x), fabsf(vb[j].y)), fmaxf(fabsf(vb[j].z), fabsf(vb[j].w)))); }
#pragma unroll
    for (int o = 1; o < 64; o <<= 1) {
#pragma unroll
        for (int k = 0; k < 4; ++k) { s[k] += shx(s[k], o, lane); m[k] = fmaxf(m[k], shx(m[k], o, lane)); }
        ma = fmaxf(ma, shx(ma, o, lane)); mb = fmaxf(mb, shx(mb, o, lane)); }
#pragma unroll
    for (int k = 0; k < 4; ++k) { const float r = 1.f / sqrtf(s[k] * (1.f / DM) + RMS_EPS); const float qs = m[k] > 0.f ? 127.0f / m[k] : 1.0f;
        GAS unsigned* o4 = (GAS unsigned*)(orow + k * rstride) + lane;
#pragma unroll
        for (int j = 0; j < 4; ++j) o4[64 * j] = pack4_i8(v[k][j].x * qs, v[k][j].y * qs, v[k][j].z * qs, v[k][j].w * qs);
        if (lane == 0) sc[k * sstride] = (m[k] > 0.f ? m[k] * (1.0f / 127.0f) : 1.0f) * r; }
    *(GAS v4u*)(dstA + 16 * lane) = quant16_i8(va, ma > 0.f ? 127.0f / ma : 1.0f);
    *(GAS v4u*)(dstB + 16 * lane) = quant16_fp8(vb, mb > 0.f ? 224.0f / mb : 1.0f);
    if (lane == 0) { *scA = ma > 0.f ? ma * (1.0f / 127.0f) : 1.0f; *scB = mb > 0.f ? mb * (1.0f / 224.0f) : 1.0f; }
}
__device__ __forceinline__ void peer_hq_panel(const bf16* X1B, unsigned char* H8p, LAS const float* r1, LAS float* s1h, const int wid0) {
    const int tid = otid(wid0), lane = tid & 63, wid = __builtin_amdgcn_readfirstlane(tid >> 6);
    for (int ti = 0; ti < 16; ++ti) {
        float h[2][16], m[2];
#pragma unroll
        for (int q = 0; q < 2; ++q) { const bf16* xp = X1B + (size_t)(wid * 32 + ti + 16 * q) * DM + 16 * lane; const v4u a = *(const GAS v4u*)xp, b2 = *(const GAS v4u*)(xp + 8); H_UNPACK(h[q], a, b2); }
#pragma unroll
        for (int q = 0; q < 2; ++q) { m[q] = 0.f;
#pragma unroll
            for (int k = 0; k < 16; ++k) m[q] = fmaxf(m[q], fabsf(h[q][k])); }
#pragma unroll
        for (int o = 1; o < 64; o <<= 1) { m[0] = fmaxf(m[0], shx(m[0], o, lane)); m[1] = fmaxf(m[1], shx(m[1], o, lane)); }
#pragma unroll
        for (int q = 0; q < 2; ++q) { const int lrow = wid * 32 + ti + 16 * q; const float sc = m[q] > 0.f ? 127.0f / m[q] : 1.0f;
            v4u w; w.x = pack4_i8(h[q][0] * sc, h[q][1] * sc, h[q][2] * sc, h[q][3] * sc); w.y = pack4_i8(h[q][4] * sc, h[q][5] * sc, h[q][6] * sc, h[q][7] * sc);
            w.z = pack4_i8(h[q][8] * sc, h[q][9] * sc, h[q][10] * sc, h[q][11] * sc); w.w = pack4_i8(h[q][12] * sc, h[q][13] * sc, h[q][14] * sc, h[q][15] * sc);
            *(GAS v4u*)(H8p + (size_t)lrow * DM + 16 * lane) = w;
            if (lane == 0) s1h[lrow] = r1[lrow] * (m[q] > 0.f ? m[q] * (1.0f / 127.0f) : 1.0f); }
    }
}
__device__ __forceinline__ int dot16_i8(const v4u u, const v4u h) {
    int a = __builtin_amdgcn_sdot4((int)u.x, (int)h.x, 0, false), b = __builtin_amdgcn_sdot4((int)u.y, (int)h.y, 0, false);
    a = __builtin_amdgcn_sdot4((int)u.z, (int)h.z, a, false); b = __builtin_amdgcn_sdot4((int)u.w, (int)h.w, b, false);
    return a + b;
}
#define RS_LEVEL_I(v, n, m) do { _Pragma("unroll") for (int _e = 0; _e < (n); ++_e) { const bool _up = (lane & (m)) != 0; const int _send = _up ? v[_e] : v[_e + (n)]; const int _keep = _up ? v[_e + (n)] : v[_e]; v[_e] = _keep + shx(_send, (m), lane); } } while (0)
__device__ __forceinline__ void dq4(unsigned w, float (&f)[4]) {
    const f32x2v lo = __builtin_amdgcn_cvt_pk_f32_fp8((int)w, false), hi = __builtin_amdgcn_cvt_pk_f32_fp8((int)w, true);
    f[0] = lo.x; f[1] = lo.y; f[2] = hi.x; f[3] = hi.y;
}
__device__ __forceinline__ float dot16_fp8(const v4u u, const float (&h)[16]) {
    const f32x2v x0 = __builtin_amdgcn_cvt_pk_f32_fp8((int)u.x, false), x1 = __builtin_amdgcn_cvt_pk_f32_fp8((int)u.x, true);
    const f32x2v y0 = __builtin_amdgcn_cvt_pk_f32_fp8((int)u.y, false), y1 = __builtin_amdgcn_cvt_pk_f32_fp8((int)u.y, true);
    const f32x2v z0 = __builtin_amdgcn_cvt_pk_f32_fp8((int)u.z, false), z1 = __builtin_amdgcn_cvt_pk_f32_fp8((int)u.z, true);
    const f32x2v w0 = __builtin_amdgcn_cvt_pk_f32_fp8((int)u.w, false), w1 = __builtin_amdgcn_cvt_pk_f32_fp8((int)u.w, true);
    f32x2v a = x0 * (f32x2v){h[0], h[1]}, b = x1 * (f32x2v){h[2], h[3]};
    a = __builtin_elementwise_fma(y0, (f32x2v){h[4], h[5]}, a); b = __builtin_elementwise_fma(y1, (f32x2v){h[6], h[7]}, b);
    a = __builtin_elementwise_fma(z0, (f32x2v){h[8], h[9]}, a); b = __builtin_elementwise_fma(z1, (f32x2v){h[10], h[11]}, b);
    a = __builtin_elementwise_fma(w0, (f32x2v){h[12], h[13]}, a); b = __builtin_elementwise_fma(w1, (f32x2v){h[14], h[15]}, b);
    const f32x2v s = a + b;
    return s.x + s.y;
}
__device__ __forceinline__ void fma16_fp8(float (&o)[16], float cf, const v4u v) {
    float f0[4], f1[4], f2[4], f3[4]; dq4(v.x, f0); dq4(v.y, f1); dq4(v.z, f2); dq4(v.w, f3);
#pragma unroll
    for (int k = 0; k < 4; ++k) { o[k] = fmaf(cf, f0[k], o[k]); o[4 + k] = fmaf(cf, f1[k], o[4 + k]); o[8 + k] = fmaf(cf, f2[k], o[8 + k]); o[12 + k] = fmaf(cf, f3[k], o[12 + k]); }
}
__device__ __forceinline__ void fma16_fp8v(f32x2v (&o)[8], float cf, const v4u v) {
    const f32x2v c2 = (f32x2v){cf, cf};
    o[0] = __builtin_elementwise_fma(__builtin_amdgcn_cvt_pk_f32_fp8((int)v.x, false), c2, o[0]); o[1] = __builtin_elementwise_fma(__builtin_amdgcn_cvt_pk_f32_fp8((int)v.x, true), c2, o[1]);
    o[2] = __builtin_elementwise_fma(__builtin_amdgcn_cvt_pk_f32_fp8((int)v.y, false), c2, o[2]); o[3] = __builtin_elementwise_fma(__builtin_amdgcn_cvt_pk_f32_fp8((int)v.y, true), c2, o[3]);
    o[4] = __builtin_elementwise_fma(__builtin_amdgcn_cvt_pk_f32_fp8((int)v.z, false), c2, o[4]); o[5] = __builtin_elementwise_fma(__builtin_amdgcn_cvt_pk_f32_fp8((int)v.z, true), c2, o[5]);
    o[6] = __builtin_elementwise_fma(__builtin_amdgcn_cvt_pk_f32_fp8((int)v.w, false), c2, o[6]); o[7] = __builtin_elementwise_fma(__builtin_amdgcn_cvt_pk_f32_fp8((int)v.w, true), c2, o[7]);
}
__device__ __forceinline__ float gelu_as(float v) {
    const float av = fabsf(v), t = __builtin_amdgcn_rcpf(av * 0.2316418882f + 1.0f);
    float q = t * 0.5307027145f + (-0.7265760135f); q = q * t + 0.7107068705f; q = q * t + (-0.142248368f); q = q * t + 0.127414796f; q = q * t;
    const float e = __builtin_amdgcn_exp2f((v * v) * (-0.72134752044f));
    const float m = v * (q * e);
    return v < 0.f ? m : v - m;
}
#define RS_LEVEL(v, n, m) do { _Pragma("unroll") for (int _e = 0; _e < (n); ++_e) { const bool _up = (lane & (m)) != 0; const float _send = _up ? v[_e] : v[_e + (n)]; const float _keep = _up ? v[_e + (n)] : v[_e]; v[_e] = _keep + shx(_send, m, lane); } } while (0)
#define BS_CE(KV, EOFF, K, J) { const int p_ = shx(KV, J, lane); const bool asc_ = (((lane + (EOFF)) & (K)) == 0); const int mn_ = KV < p_ ? KV : p_, mx_ = KV < p_ ? p_ : KV; KV = (lower_ == asc_) ? mn_ : mx_; }
#define BS_STAGE(K, J) do { const bool lower_ = (lane & (J)) == 0; BS_CE(k0, 0, K, J) BS_CE(k1, 64, K, J) BS_CE(k2, 0, K, J) BS_CE(k3, 64, K, J) } while (0)
__device__ __forceinline__ void peer_sort_panel(int* IDXp, float* GTp, float* SUp, const float* SU, const float* SV, const int wid0) {
    const int tid = otid(wid0), lane = tid & 63, wid = __builtin_amdgcn_readfirstlane(tid >> 6);
    int ni[4]; float ng[4];
#pragma unroll
    for (int q = 0; q < 4; ++q) { const int o = (wid * 32 + (q >> 1) * 16) * 128 + (q & 1) * 64 + lane; ni[q] = IDXp[o]; ng[q] = GTp[o]; }
    for (int ti = 0; ti < 16; ++ti) {
        const int lrow = wid * 32 + ti;
        int ci[4]; float cg[4];
#pragma unroll
        for (int q = 0; q < 4; ++q) { ci[q] = ni[q]; cg[q] = ng[q]; }
        if (ti < 15) {
#pragma unroll
            for (int q = 0; q < 4; ++q) { const int o = (lrow + 1 + (q >> 1) * 16) * 128 + (q & 1) * 64 + lane; ni[q] = IDXp[o]; ng[q] = GTp[o]; } }
        float cu[4], cw[4];
#pragma unroll
        for (int q = 0; q < 4; ++q) { cu[q] = SU[ci[q]]; cw[q] = SV[ci[q]] * cg[q]; }
        int k0 = (ci[0] << 7) | lane, k1 = (ci[1] << 7) | (64 + lane), k2 = (ci[2] << 7) | lane, k3 = (ci[3] << 7) | (64 + lane);
        BS_STAGE(2, 1);
        BS_STAGE(4, 2); BS_STAGE(4, 1);
        BS_STAGE(8, 4); BS_STAGE(8, 2); BS_STAGE(8, 1);
        BS_STAGE(16, 8); BS_STAGE(16, 4); BS_STAGE(16, 2); BS_STAGE(16, 1);
        BS_STAGE(32, 16); BS_STAGE(32, 8); BS_STAGE(32, 4); BS_STAGE(32, 2); BS_STAGE(32, 1);
        BS_STAGE(64, 32); BS_STAGE(64, 16); BS_STAGE(64, 8); BS_STAGE(64, 4); BS_STAGE(64, 2); BS_STAGE(64, 1);
        { const int mn_ = k0 < k1 ? k0 : k1, mx_ = k0 < k1 ? k1 : k0; k0 = mn_; k1 = mx_; }
        { const int mn_ = k2 < k3 ? k2 : k3, mx_ = k2 < k3 ? k3 : k2; k2 = mn_; k3 = mx_; }
        BS_STAGE(128, 32); BS_STAGE(128, 16); BS_STAGE(128, 8); BS_STAGE(128, 4); BS_STAGE(128, 2); BS_STAGE(128, 1);
#define BS_OUT(KA, KB, UA, UB, WA, WB, LR) do { const int s0 = KA & 127, s1 = KB & 127; \
        const float ua0 = shl_(UA, s0 & 63), ub0 = shl_(UB, s0 & 63), ua1 = shl_(UA, s1 & 63), ub1 = shl_(UB, s1 & 63); \
        const float wa0 = shl_(WA, s0 & 63), wb0 = shl_(WB, s0 & 63), wa1 = shl_(WA, s1 & 63), wb1 = shl_(WB, s1 & 63); \
        IDXp[(LR) * 128 + lane] = KA >> 7; IDXp[(LR) * 128 + 64 + lane] = KB >> 7; \
        SUp[(LR) * 128 + lane] = (s0 < 64) ? ua0 : ub0; SUp[(LR) * 128 + 64 + lane] = (s1 < 64) ? ua1 : ub1; \
        GTp[(LR) * 128 + lane] = (s0 < 64) ? wa0 : wb0; GTp[(LR) * 128 + 64 + lane] = (s1 < 64) ? wa1 : wb1; } while (0)
        BS_OUT(k0, k1, cu[0], cu[1], cw[0], cw[1], lrow);
        BS_OUT(k2, k3, cu[2], cu[3], cw[2], cw[3], lrow + 16);
#undef BS_OUT
    }
}
#define DPPC_ROR8 0x128
#define DPPC_SHL4 0x104
#define DPPC_SHR4 0x114
#define DPPC_X2 0x4E
#define DPPC_X1 0xB1
template <int CTRL> __device__ __forceinline__ int dpp_i(int x) { return __builtin_amdgcn_update_dpp(0, x, CTRL, 0xF, 0xF, true); }
__device__ __forceinline__ int dot16_i8c(const v4u u, const v4u h) {
    int a = __builtin_amdgcn_sdot4((int)u.x, (int)h.x, 0, false);
    a = __builtin_amdgcn_sdot4((int)u.y, (int)h.y, a, false); a = __builtin_amdgcn_sdot4((int)u.z, (int)h.z, a, false); a = __builtin_amdgcn_sdot4((int)u.w, (int)h.w, a, false);
    return a;
}
template <int NP>
__device__ __forceinline__ void peer_usweep2_panel(const int dp, const unsigned char* H8p, LAS const float* s1h, const int* IDXp, const float* GMp, const float* SUp, float* CFp, const unsigned char* EU8, const int wid0) {
    constexpr int LG = 64 / NP, TG = 16 / NP, NSTEP = 16 * TG;
    const int wid = wid0;
    const int lane = lane_id();
    const int grp = lane / LG, tq = (lane >> 3) & 1, pj = lane & 7;
    const unsigned kof = (unsigned)(1024 / NP) * (unsigned)dp + 16u * (unsigned)(lane & (LG - 1));
    const int gb4 = (lane & ~(LG - 1)) << 2;
    const bool last = dp == NP - 1;
    int ix_n, pd_n = 0; float gm_n = 0.f, su_n = 0.f; v4u h0_n, h1_n;
#define US2_META(s_) do { const int c_ = (s_) / TG, tg_ = (s_) % TG; const int lr_ = wid * 32 + 2 * NP * tg_ + 2 * grp; const int off_ = (lr_ + tq) * 128 + 8 * c_ + pj; \
        ix_n = IDXp[off_] << 10; \
        if (dp) pd_n = ((const int*)CFp)[off_]; \
        if (last) { gm_n = GMp[off_]; su_n = SUp[off_] * s1h[lr_ + tq]; } \
        const unsigned char* h0_ = H8p + (unsigned)(lr_ * DM) + kof; h0_n = *(const GAS v4u*)h0_; h1_n = *(const GAS v4u*)(h0_ + DM); } while (0)
#ifndef STAG_U
#define STAG_U 40
#endif
    if (STAG_U && wid >= 4) __builtin_amdgcn_s_sleep(STAG_U);
    US2_META(0);
#pragma nounroll
    for (int s = 0; s < NSTEP; ++s) {
        const int ix10 = ix_n, pd = pd_n; const float gm = gm_n, su = su_n; const v4u h0 = h0_n, h1 = h1_n;
        v4u ua[16]; int p[16];
        unsigned exo[16];
#pragma unroll
        for (int j = 0; j < 16; ++j) exo[j] = (unsigned)__builtin_amdgcn_ds_bpermute(gb4 + 4 * j, ix10) + kof;
        asm volatile("" : "+v"(exo[0]), "+v"(exo[1]), "+v"(exo[2]), "+v"(exo[3]), "+v"(exo[4]), "+v"(exo[5]), "+v"(exo[6]), "+v"(exo[7]), "+v"(exo[8]), "+v"(exo[9]), "+v"(exo[10]), "+v"(exo[11]), "+v"(exo[12]), "+v"(exo[13]), "+v"(exo[14]), "+v"(exo[15]));
#pragma unroll
        for (int j = 0; j < 8; ++j) ua[j] = *(const GAS v4u*)(EU8 + exo[j]);
        if (s < NSTEP - 1) US2_META(s + 1);
#pragma unroll
        for (int j = 0; j < 8; ++j) p[j] = dot16_i8c(ua[j], h0);
        asm volatile("" : "+v"(p[0]), "+v"(p[1]), "+v"(p[2]), "+v"(p[3]), "+v"(p[4]), "+v"(p[5]), "+v"(p[6]), "+v"(p[7]) :: "memory");
#pragma unroll
        for (int j = 8; j < 16; ++j) ua[j] = *(const GAS v4u*)(EU8 + exo[j]);
#pragma unroll
        for (int j = 8; j < 16; ++j) p[j] = dot16_i8c(ua[j], h1);
        const bool b3 = (lane & 8) != 0, b2 = (lane & 4) != 0, b1 = (lane & 2) != 0, b0 = (lane & 1) != 0;
#pragma unroll
        for (int e = 0; e < 8; ++e) { const int t = p[e] + dpp_i<DPPC_ROR8>(p[e]), u = p[e + 8] + dpp_i<DPPC_ROR8>(p[e + 8]); p[e] = b3 ? u : t; }
#pragma unroll
        for (int e = 0; e < 4; ++e) { const int t = p[e] + dpp_i<DPPC_SHL4>(p[e]), u = p[e + 4] + dpp_i<DPPC_SHR4>(p[e + 4]); p[e] = b2 ? u : t; }
#pragma unroll
        for (int e = 0; e < 2; ++e) { const int t = p[e] + dpp_i<DPPC_X2>(p[e]), u = p[e + 2] + dpp_i<DPPC_X2>(p[e + 2]); p[e] = b1 ? u : t; }
        int di; { const int t = p[0] + dpp_i<DPPC_X1>(p[0]), u = p[1] + dpp_i<DPPC_X1>(p[1]); di = b0 ? u : t; }
        if (NP == 2) { const auto r = __builtin_amdgcn_permlane16_swap(di, di, false, false); di = (int)r[0] + (int)r[1]; }
        di += pd;
        const int c = s / TG, tg = s % TG;
        const int off = (wid * 32 + 2 * NP * tg + 2 * grp + tq) * 128 + 8 * c + pj;
        const bool st = NP == 4 || (lane & 16) == 0;
        if (!last) { if (st) ((int*)CFp)[off] = di; }
        else { const float act = gelu_as((float)di * su); if (st) CFp[off] = gm * act; }
    }
#undef US2_META
}
__device__ __forceinline__ void peer_vsweep2_panel(int panel, const bf16* X1B, bf16* X2B, LAS float* r3, const int* IDXp, const float* CFp, const unsigned char* EV8, const int wid0) {
    const int wid = wid0;
#ifndef STAG_V
#define STAG_V 40
#endif
    if (STAG_V && wid >= 4) __builtin_amdgcn_s_sleep(STAG_V);
#pragma nounroll
    for (int it = 0; it < 8; ++it) {
        const int dp = it >> 2, g2 = it & 3;
        const int lane = lane_id(); const int half = lane >> 5, li = lane & 31;
        const int lr0 = wid * 32 + 8 * g2;
        const int colb = 512 * dp + 16 * li;
        float o[4][16];
#pragma unroll
        for (int t = 0; t < 4; ++t) { const bf16* xp = X1B + (size_t)(lr0 + 4 * half + t) * DM + colb; const v4u a = *(const GAS v4u*)xp, b2 = *(const GAS v4u*)(xp + 8); H_UNPACK(o[t], a, b2); }
        const int mA = (lr0 + (lane >> 3)) * 128 + (lane & 7);
        int ix_n = IDXp[mA]; float cf_n = CFp[mA];
#pragma nounroll
        for (int c = 0; c < 16; ++c) {
            const int ix = ix_n; const float cf = cf_n;
            const int lane_c = lane_id(); const int half_c = lane_c >> 5;
            if (c < 15) { const int m2 = (lr0 + (lane_c >> 3)) * 128 + (lane_c & 7) + 8 * (c + 1); ix_n = IDXp[m2]; cf_n = CFp[m2]; }
            const int evo = 512 * dp + 16 * (lane_c & 31);
#ifndef VB
#define VB 8
#endif
            const int hb4 = (lane_c & 32) << 2;
            const int ix10 = ix << 10;
            int exo[32];
#pragma unroll
            for (int e = 0; e < 32; ++e) exo[e] = __builtin_amdgcn_ds_bpermute(hb4 + 4 * e, ix10) + evo;
            asm volatile("" : "+v"(exo[0]), "+v"(exo[1]), "+v"(exo[2]), "+v"(exo[3]), "+v"(exo[4]), "+v"(exo[5]), "+v"(exo[6]), "+v"(exo[7]), "+v"(exo[8]), "+v"(exo[9]), "+v"(exo[10]), "+v"(exo[11]), "+v"(exo[12]), "+v"(exo[13]), "+v"(exo[14]), "+v"(exo[15]));
            asm volatile("" : "+v"(exo[16]), "+v"(exo[17]), "+v"(exo[18]), "+v"(exo[19]), "+v"(exo[20]), "+v"(exo[21]), "+v"(exo[22]), "+v"(exo[23]), "+v"(exo[24]), "+v"(exo[25]), "+v"(exo[26]), "+v"(exo[27]), "+v"(exo[28]), "+v"(exo[29]), "+v"(exo[30]), "+v"(exo[31]));
#pragma unroll
            for (int tp = 0; tp < 32 / VB; ++tp) {
                v4u va[VB]; float cs[VB];
#pragma unroll
                for (int i = 0; i < VB; ++i) { const int e = VB * tp + i; va[i] = *(const GAS v4u*)(EV8 + (unsigned)exo[e]); }
#pragma unroll
                for (int i = 0; i < VB; ++i) { const int e = VB * tp + i; cs[i] = __builtin_bit_cast(float, __builtin_amdgcn_ds_bpermute(hb4 + 4 * e, __builtin_bit_cast(int, cf))); }
#pragma unroll
                for (int i = 0; i < VB; ++i) { const int e = VB * tp + i; fma16_fp8(o[e >> 3], cs[i], va[i]); }
            }
        }
        const int lane2 = lane_id(); const int half2 = lane2 >> 5, li2 = lane2 & 31;
#pragma unroll
        for (int t = 0; t < 4; ++t) {
            const int tok = lr0 + 4 * half2 + t;
            float ss = 0.f;
#pragma unroll
            for (int k = 0; k < 16; ++k) ss += o[t][k] * o[t][k];
#pragma unroll
            for (int m = 1; m < 32; m <<= 1) ss += shx(ss, m, lane2);
            if (li2 == 0) { if (dp == 0) r3[tok] = ss; else r3[tok] = 1.f / sqrtf((r3[tok] + ss) * (1.f / DM) + RMS_EPS); }
            v4u ha, hb;
            ha.x = cvtpk(o[t][0], o[t][1]); ha.y = cvtpk(o[t][2], o[t][3]); ha.z = cvtpk(o[t][4], o[t][5]); ha.w = cvtpk(o[t][6], o[t][7]);
            hb.x = cvtpk(o[t][8], o[t][9]); hb.y = cvtpk(o[t][10], o[t][11]); hb.z = cvtpk(o[t][12], o[t][13]); hb.w = cvtpk(o[t][14], o[t][15]);
            bf16* xo = X2B + (size_t)tok * DM + 512 * dp + 16 * li2;
            *(GAS v4u*)xo = ha; *(GAS v4u*)(xo + 8) = hb;
        }
    }
}


struct Args {
    const float *x, *p, *norm_mix, *w_in, *w_att_up, *w_pool_group, *pool_scale, *w_out, *norm_ffn, *w_query, *sub_keys, *expert_u, *expert_v, *norm_ple, *w_ple_gate, *w_ple, *norm_final;
    float* out; unsigned char* ws; int ph_hi, pad;
};

#ifndef REP_P0
#define REP_P0 1
#endif
#ifndef REP_P1
#define REP_P1 1
#endif
#ifndef REP_P23
#define REP_P23 1
#endif
#ifndef REP_P4
#define REP_P4 1
#endif
#ifndef REP_P567
#define REP_P567 1
#endif
#ifndef REP_P9
#define REP_P9 1
#endif
#ifndef REP_ATT
#define REP_ATT 1
#endif
#ifndef REP_TOPK
#define REP_TOPK 1
#endif
#ifndef REP_MRG
#define REP_MRG 1
#endif
#ifndef MK_PH_HI
#define MK_PH_HI 99
#endif

typedef const __attribute__((address_space(4))) Args* CArgs;
__device__ __forceinline__ CArgs kargs() { CArgs p = (CArgs)__builtin_amdgcn_kernarg_segment_ptr(); asm volatile("" : "+s"(p)); return p; }
#define WSP(T, off) ((T*)(kargs()->ws + (off)))
__global__ void __launch_bounds__(NTHR, 2) mega_fwd(Args a_unused) {
    extern __shared__ __attribute__((aligned(16))) unsigned char lds_raw[];
    LAS unsigned char* lds = (LAS unsigned char*)lds_raw;
    volatile LAS unsigned* MISC = (volatile LAS unsigned*)(lds + MISC_OFF);
    const int G = gridDim.x; const int bx = blockIdx.x;
    const int vcu = (G % 8 == 0) ? (bx % 8) * (G / 8) + bx / 8 : bx;
    gu32* ctl = (gu32*)(kargs()->ws + WS_CTL);
    const int wid0 = __builtin_amdgcn_readfirstlane((int)threadIdx.x >> 6);
#define IS_T0 (otid(wid0) == 0)
    for (int u = otid(wid0); u < (LDS_BYTES - LDSCTL_OFF) / 4; u += NTHR) ((LAS unsigned*)(lds + LDSCTL_OFF))[u] = 0u;
    __syncthreads();
    (void)xcd_barrier_post((unsigned*)(ctl + CW_BAR), MISC + 8, IS_T0);
#define GRID_BAR() do { XcdBarrier _b; _b.bar = (unsigned*)((gu32*)(kargs()->ws + WS_CTL) + CW_BAR); _b.x = xb_xcc_id(); _b.st = (volatile LAS unsigned*)(lds + MISC_OFF) + 8; xcd_barrier(_b, IS_T0); } while (0)
    LAS float* const SS1 = (LAS float*)(lds + LDSCTL_OFF + 1024);
    LAS float* const R3 = (LAS float*)(lds + LDSCTL_OFF + 2048);
    LAS float* const SSF = (LAS float*)(lds + LDSCTL_OFF + 3072);
    LAS float* const S1H = (LAS float*)(lds + LDSCTL_OFF + 4096);
#define LOCAL_SEAM() do { VM_WAIT(); __syncthreads(); if (IS_T0) { __builtin_amdgcn_fence(__ATOMIC_ACQUIRE, "agent"); VM_WAIT(); } __syncthreads(); } while (0)

    for (int rep_ = 0; rep_ < REP_P0; ++rep_) {
        const int tid = otid(wid0), lane = tid & 63, wid = __builtin_amdgcn_readfirstlane(tid >> 6);
        const CArgs a = kargs(); unsigned char* ws = a->ws;
        bf16 *WIN = (bf16*)(ws + WS_WIN), *WOUT = (bf16*)(ws + WS_WOUT), *WQ = (bf16*)(ws + WS_WQ), *WPG = (bf16*)(ws + WS_WPG), *WPLE = (bf16*)(ws + WS_WPLE);
        bf16 *BD2 = (bf16*)(ws + WS_BD2), *SK = (bf16*)(ws + WS_SK), *XN = (bf16*)(ws + WS_XN);
        LAS float* scr = (LAS float*)(lds + wid * 16384);
        const int gw = vcu * NWAVES + wid, NGW = G * NWAVES;
        unsigned* const CMAX = (unsigned*)((gu32*)(ws + WS_CTL) + CW_CMAX);
        constexpr int A_IN = 32 * (4096 / 64), A_Q = 32 * (2048 / 64);
        for (int it = gw; it < A_IN + A_Q; it += NGW) {
            if (it < A_IN) p0_colmax_item(a->w_in, 4096, CMAX, a->norm_mix, 512, C2, it, lane);
            else p0_colmax_item(a->w_query, 2048, CMAX + 4096, a->norm_ffn, 0, 1.f, it - A_IN, lane);
        }
        constexpr int I_OUT = (1024 / 64) * (1024 / 32), I_PG = I_OUT, I_PLE = (256 / 64) * (1024 / 32);
        constexpr int NITEMS = I_OUT + I_PG + I_PLE;
        for (int it = gw; it < NITEMS; it += NGW) {
            int r = it;
            if (r < I_OUT) { p0_transpose_item(a->w_out, 1024, 1024, WOUT, nullptr, 0, 1.f, scr, r, lane); continue; } r -= I_OUT;
            if (r < I_PG) { p0_transpose_item(a->w_ple_gate, 1024, 1024, WPG, a->norm_ple, 0, 1.f, scr, r, lane); continue; } r -= I_PG;
            p0_transpose_item(a->w_ple, 256, 1024, WPLE, nullptr, 0, 1.f, scr, r, lane);
        }
        const int gt = vcu * NTHR + tid, NGT = G * NTHR;
        for (int it = gt; it < 2048 * 32; it += NGT) {
            const int rr = it >> 5, k8 = (it & 31) * 8, ti = rr >> 8, r = rr & 255, n = 256 * (ti & 3) + 128 * (ti >> 2) + (r & 127), head = n >> 7, g = n >> 8;
            float v[8];
#pragma unroll
            for (int j = 0; j < 8; ++j) { const int k = (k8 + j) & 127;
                if (r < 128) v[j] = (k8 < 128 && (k >> 6) == (head & 1)) ? a->w_att_up[((size_t)head * 64 + (k & 63)) * 128 + (n & 127)] : 0.f;
                else v[j] = (k8 >= 128) ? a->w_pool_group[((size_t)g * 128 + k) * 256 + (n & 255)] * a->pool_scale[n] : 0.f; }
            v4u o; o.x = pk2(v[0], v[1]); o.y = pk2(v[2], v[3]); o.z = pk2(v[4], v[5]); o.w = pk2(v[6], v[7]);
            *(GAS v4u*)(BD2 + (size_t)rr * 256 + k8) = o;
        }
        for (int it = gt; it < 16 * 128 * 128 / 8; it += NGT) cvt8_store(a->sub_keys + (size_t)it * 8, SK + (size_t)it * 8);
        { const int panel = bx;
            for (int r = wid, e = gw; r < 64; r += NWAVES, e += NGW) { const size_t row = (size_t)panel * 256 + r;
                p0_rows4_expert(a->x + row * DM, ws + WS_XN + row * DM, (float*)(ws + WS_SX) + row, (size_t)64 * DM, 64,
                                a->expert_u + (size_t)e * DM, a->norm_ffn, ws + WS_EU + (size_t)e * DM, (float*)(ws + WS_SU) + e, a->expert_v + (size_t)e * DM, ws + WS_EV + (size_t)e * DM, (float*)(ws + WS_SV) + e, lane); } }
    }
    GRID_BAR();
    {
        const int tid = otid(wid0), lane = tid & 63, wid = __builtin_amdgcn_readfirstlane(tid >> 6);
        const CArgs a = kargs(); unsigned char* ws = a->ws;
        LAS float* scr = (LAS float*)(lds + wid * 16384);
        const int gw = vcu * NWAVES + wid, NGW = G * NWAVES;
        const unsigned* CMAX = (const unsigned*)((gu32*)(ws + WS_CTL) + CW_CMAX);
        constexpr int B_IN = 16 * (4096 / 32), B_Q = 16 * (2048 / 32);
        for (int it = gw; it < B_IN + B_Q; it += NGW) {
            if (it < B_IN) p0_quant_tile_item(a->w_in, 4096, ws + WS_WIN, (float*)(ws + WS_SBN), CMAX, a->norm_mix, 512, C2, scr, it, lane);
            else p0_quant_tile_item(a->w_query, 2048, ws + WS_WQ, (float*)(ws + WS_SBQ), CMAX + 4096, a->norm_ffn, 0, 1.f, scr, it - B_IN, lane);
        }
    }
    GRID_BAR();

    for (int rep_ = 0; rep_ < REP_P1; ++rep_) {
        const int xg = bx & 7, ig = bx >> 3, ug = ig >> 3;
#pragma nounroll
        for (int ph = 0; ph < 4; ++ph) {
            const int panel = xg + 8 * (8 * ph + (ig & 7));
            { pg8::Gemm g{WSP(bf16, WS_XN), WSP(bf16, WS_WIN), 1024, 1024, 1024, 0, 0, 1, 0}; pg8::PanelSched S{panel, ug < 3 ? 4 : 2, 4, 2, 0, 4 * ug};
              pg8::EpiProjI8 E{WSP(bf16, WS_PQ), WSP(bf16, WS_PK), WSP(bf16, WS_PU), WSP(bf16, WS_PG), WSP(float, WS_SX), WSP(float, WS_SBN)};
              pg8::gemm_phase_i8<pg8::EpiProjI8, pg8::PanelSched, true, true>(lds, g, S, E, wid0); }
            if (ug == 3) { pg8::Gemm g{(const bf16*)(kargs()->ws + WS_WIN + (size_t)1024 * 1024), WSP(bf16, WS_XN), 1024, 1024, 1024, 0, 0, 1, 0}; pg8::PanelSched S{panel, 2, 99, 0, 1, 0};
              pg8::EpiPlainI8 E{WSP(bf16, WS_PVT), TOK, WSP(float, WS_SBN) + 1024, WSP(float, WS_SX)};
              pg8::gemm_phase_i8<pg8::EpiPlainI8, pg8::PanelSched, true, true>(lds, g, S, E, wid0); }
        }
    }
    GRID_BAR();


#define H8P ((unsigned char*)(kargs()->ws + WS_MG + (size_t)panel * 524288 + 262144))
    { const int panel = bx;
        const size_t prow = (size_t)panel * 256;
        for (int rep_ = 0; rep_ < REP_P23; ++rep_) {
        if (MK_PH_HI > 2) { for (int r2_ = 0; r2_ < REP_ATT; ++r2_) attn_panel(panel, WSP(bf16, WS_PQ), WSP(bf16, WS_PK), WSP(bf16, WS_PVT), WSP(bf16, WS_YA), wid0); pool_panel(panel, WSP(bf16, WS_PU), WSP(bf16, WS_YA), wid0); LOCAL_SEAM(); }
        for (int r2_ = 0; r2_ < REP_MRG; ++r2_)
        if (MK_PH_HI > 3) {
            { pg8::Gemm g{WSP(bf16, WS_YA), WSP(bf16, WS_BD2), 256, 1024, 256, 256, 0, 1, 0}; pg8::PanelSched S{panel, 8, 99, 0, 0}; pg8::EpiMerge2 E{WSP(unsigned char, WS_PG), WSP(bf16, WS_MG)};
              pg8::gemm_phase<pg8::EpiMerge2, pg8::PanelSched, true, true>(lds, g, S, E, wid0); }
            LOCAL_SEAM();
        }
        }
        for (int rep_ = 0; rep_ < REP_P4; ++rep_)
        if (MK_PH_HI > 4) {
            { pg8::Gemm g{WSP(bf16, WS_MG), WSP(bf16, WS_WOUT), 1024, 1024, 1024, 0, 0, 1, 0}; pg8::PanelSched S{panel, 4, 99, 0, 0}; pg8::EpiRes E{kargs()->x, (bf16*)kargs()->out, SS1};
              pg8::gemm_phase<pg8::EpiRes, pg8::PanelSched, true, true>(lds, g, S, E, wid0); }
            LOCAL_SEAM();
        }
        { { const int t_ = otid(wid0); if (t_ < 256) SS1[t_] = 1.f / sqrtf(SS1[t_] * (1.f / DM) + RMS_EPS); } __syncthreads(); }
#ifndef REP_WQ
#define REP_WQ 1
#endif
        for (int rq_ = 0; rq_ < REP_WQ; ++rq_) {
        if (MK_PH_HI > 6) { peer_hq_panel((const bf16*)kargs()->out + (size_t)panel * 524288, H8P, SS1, S1H, wid0); LOCAL_SEAM(); }
        {
        if (MK_PH_HI > 6) {
            { pg8::Gemm g{(const bf16*)(kargs()->ws + WS_MG + 262144), WSP(bf16, WS_WQ), 1024, 1024, 1024, 0, 0, 2, 0}; pg8::PanelSched S{panel, 8, 99, 0, 0};
              pg8::EpiPlainScaleI8 E{WSP(bf16, WS_PG), 2048, S1H, WSP(float, WS_SBQ)};
              pg8::gemm_phase_i8<pg8::EpiPlainScaleI8, pg8::PanelSched, true, true>(lds, g, S, E, wid0); }
            LOCAL_SEAM();
        }
        } }
        {
        #define IDXP ((int*)(kargs()->ws + WS_YA + (size_t)panel * 524288))
#define GTP ((float*)(kargs()->ws + WS_YA + (size_t)panel * 524288 + 131072))
        if (MK_PH_HI > 7) { for (int r2_ = 0; r2_ < REP_TOPK; ++r2_) topk_panel(panel, WSP(bf16, WS_PG), WSP(bf16, WS_SK), IDXP, GTP, lds, wid0); LOCAL_SEAM(); }
        }
#ifndef PEER_SWEEP
#define PEER_SWEEP 1
#endif
#define CFP ((float*)(kargs()->ws + WS_YA + (size_t)panel * 524288 + 262144))
#define SUSP ((float*)(kargs()->ws + WS_MG + (size_t)panel * 524288))
        if (MK_PH_HI > 8) {
            if (PEER_SWEEP) {
#ifndef REP_SORT
#define REP_SORT 1
#endif
                for (int rs_ = 0; rs_ < REP_SORT; ++rs_) { peer_sort_panel(IDXP, GTP, SUSP, WSP(float, WS_SU), WSP(float, WS_SV), wid0); LOCAL_SEAM(); }
#ifndef REP_U
#define REP_U 1
#endif
#ifndef REP_V
#define REP_V 1
#endif
#ifndef UNP
#define UNP 2
#endif
                for (int ru_ = 0; ru_ < REP_U; ++ru_) {
#pragma nounroll
                    for (int dpu = 0; dpu < UNP; ++dpu) { peer_usweep2_panel<UNP>(dpu, H8P, S1H, IDXP, GTP, SUSP, CFP, WSP(unsigned char, WS_EU), wid0); LOCAL_SEAM(); } }
                for (int rv_ = 0; rv_ < REP_V; ++rv_)
                    peer_vsweep2_panel(panel, (const bf16*)kargs()->out + (size_t)panel * 524288, WSP(bf16, WS_PG) + (size_t)panel * 524288, R3, IDXP, CFP, WSP(unsigned char, WS_EV), wid0);
                LOCAL_SEAM();
            }
        }
        for (int rep_ = 0; rep_ < REP_P9; ++rep_)
        if (MK_PH_HI > 9) {
#define PBP ((bf16*)(kargs()->ws + WS_YA + (size_t)panel * 524288 + 393216))
            { const int tid = otid(wid0); const float* pp = kargs()->p; bf16* PB = PBP; for (int it = tid; it < 256 * 256 / 8; it += NTHR) { const int r = it >> 5, c8 = (it & 31) * 8; cvt8_store(pp + (prow + r) * 256 + c8, PB + r * 256 + c8); } }
            LOCAL_SEAM();
            { pg8::Gemm g{(const bf16*)(kargs()->ws + WS_YA + 393216), WSP(bf16, WS_WPLE), 256, 256, 256, 0, 0, 4, 0}; pg8::PanelSched S{panel, 4, 99, 0, 0};
              pg8::EpiPlain E{WSP(bf16, WS_MG), 1024};
              pg8::gemm_phase<pg8::EpiPlain, pg8::PanelSched, true, true>(lds, g, S, E, wid0); }
            LOCAL_SEAM();
        }
        if (MK_PH_HI > 10) {
            { pg8::Gemm g{WSP(bf16, WS_PG), WSP(bf16, WS_WPG), 1024, 1024, 1024, 0, 0, 2, 0}; pg8::PanelSched S{panel, 4, 99, 0, 0}; pg8::EpiGate E{WSP(bf16, WS_YA), WSP(bf16, WS_PG), WSP(bf16, WS_MG), R3, SSF};
              pg8::gemm_phase<pg8::EpiGate, pg8::PanelSched, true, true>(lds, g, S, E, wid0); }
            LOCAL_SEAM();
        }
        if (MK_PH_HI > 11) {
            const int tid = otid(wid0), lane = tid & 63, wid = __builtin_amdgcn_readfirstlane(tid >> 6);
            const GAS f32x4* gr = (const GAS f32x4*)kargs()->norm_final + lane;
            f32x4 gg[4];
#pragma unroll
            for (int j = 0; j < 4; ++j) gg[j] = gr[64 * j];
            const bf16* x3a = WSP(bf16, WS_YA);
            for (int r = wid; r < 64; r += NWAVES) {
                v2u v[4][4]; float rr[4];
#pragma unroll
                for (int k = 0; k < 4; ++k) { const bf16* xr = x3a + (prow + r + 64 * k) * 1024 + 4 * lane; rr[k] = 1.f / sqrtf(SSF[r + 64 * k] * (1.f / DM) + RMS_EPS);
#pragma unroll
                    for (int j = 0; j < 4; ++j) v[k][j] = *(const GAS v2u*)(xr + 256 * j); }
#pragma unroll
                for (int k = 0; k < 4; ++k) { GAS f32x4* xw = (GAS f32x4*)(kargs()->out + (prow + r + 64 * k) * DM) + lane;
#pragma unroll
                    for (int j = 0; j < 4; ++j) { f32x4 f; f[0] = bflo(v[k][j].x); f[1] = bfhi(v[k][j].x); f[2] = bflo(v[k][j].y); f[3] = bfhi(v[k][j].y); xw[64 * j] = f * rr[k] * gg[j]; } }
            }
        }
    }
#undef LOCAL_SEAM
}


extern "C" void kernel_launch(void* const* d_in, const int* in_sizes, int n_in, void* d_out, int out_size, void* d_ws, size_t ws_size, hipStream_t stream) {
    static int grid = 0;
    if (grid == 0) {
        if (n_in != 17 || in_sizes[0] != TOK * DM || out_size != TOK * DM || ws_size < WS_END) { fprintf(stderr, "kernel_launch: unexpected shapes (n_in %d, in0 %d, out %d, ws %zu); nothing launched\n", n_in, n_in > 0 ? in_sizes[0] : -1, out_size, ws_size); grid = -1; return; }
        int dev = 0, cus = 0;
        if (hipGetDevice(&dev) != hipSuccess || hipDeviceGetAttribute(&cus, hipDeviceAttributeMultiprocessorCount, dev) != hipSuccess) { fprintf(stderr, "kernel_launch: device query failed\n"); grid = -1; return; }
        if (hipFuncSetAttribute((const void*)mega_fwd, hipFuncAttributeMaxDynamicSharedMemorySize, LDS_BYTES) != hipSuccess) { fprintf(stderr, "kernel_launch: hipFuncSetAttribute failed\n"); grid = -1; return; }
        int per_cu = 0;
        if (hipOccupancyMaxActiveBlocksPerMultiprocessor(&per_cu, (const void*)mega_fwd, NTHR, LDS_BYTES) != hipSuccess || per_cu < 1) fprintf(stderr, "kernel_launch: note: occupancy query reports %d workgroups per CU\n", per_cu);
        (void)hipGetLastError();
        if (cus != NPANEL) fprintf(stderr, "kernel_launch: note: %d CUs; this kernel is built for one 256-token panel per CU on a 256-CU device\n", cus);
        grid = NPANEL;
    }
    if (grid < 0) return;
    if (hipMemsetAsync((char*)d_ws + WS_CTL, 0, CTL_ZERO_BYTES, stream) != hipSuccess) { fprintf(stderr, "kernel_launch: memset failed\n"); return; }
    Args a{};
    a.x = (const float*)d_in[0]; a.p = (const float*)d_in[1]; a.norm_mix = (const float*)d_in[2]; a.w_in = (const float*)d_in[3]; a.w_att_up = (const float*)d_in[4];
    a.w_pool_group = (const float*)d_in[5]; a.pool_scale = (const float*)d_in[6]; a.w_out = (const float*)d_in[7]; a.norm_ffn = (const float*)d_in[8]; a.w_query = (const float*)d_in[9];
    a.sub_keys = (const float*)d_in[10]; a.expert_u = (const float*)d_in[11]; a.expert_v = (const float*)d_in[12]; a.norm_ple = (const float*)d_in[13]; a.w_ple_gate = (const float*)d_in[14];
    a.w_ple = (const float*)d_in[15]; a.norm_final = (const float*)d_in[16];
    a.out = (float*)d_out; a.ws = (unsigned char*)d_ws; a.ph_hi = MK_PH_HI; a.pad = 0;
    hipLaunchKernelGGL(mega_fwd, dim3(grid), dim3(NTHR), LDS_BYTES, stream, a);
    { const hipError_t le = hipPeekAtLastError(); if (le != hipSuccess) fprintf(stderr, "kernel_launch: launch failed: %s\n", hipGetErrorName(le)); }
}
```

```cpp
#include <hip/hip_runtime.h>
#include <cstdio>
#include <cstdint>
#include <math.h>
__device__ __forceinline__ int lane_id() { int l; asm volatile("v_mbcnt_lo_u32_b32 %0, -1, 0\n\tv_mbcnt_hi_u32_b32 %0, -1, %0" : "=v"(l)); return l; }
__device__ __forceinline__ int otid(int wid0) { return (wid0 << 6) | lane_id(); }

namespace pg8 {
#define PG8_LAS __attribute__((address_space(3)))
typedef unsigned short bf16_t;
typedef short bf16x8 __attribute__((ext_vector_type(8)));
typedef float f32x4 __attribute__((ext_vector_type(4)));
typedef unsigned u32x4 __attribute__((ext_vector_type(4)));
typedef int i32x4 __attribute__((ext_vector_type(4)));
constexpr int BM = 256, BK = 64, HALF = 128, HTB = HALF * BK * 2  , STAGE_BYTES = 8 * HTB, NXCD = 8, WGM = 8;

__host__ __device__ __forceinline__ int lds_byte(int r, int c) { const int st = (r >> 4) * 2 + (c >> 5), rr = r & 15, cc = c & 31, ob = rr * 64 + cc * 2; return st * 1024 + (ob ^ (((ob >> 9) & 1) << 5)); }
__host__ __device__ __forceinline__ void stage_rc(int b, int& R, int& C) { const int st = b / 1024, sb = b % 1024, swz = sb ^ (((sb >> 9) & 1) << 5); R = (st >> 1) * 16 + swz / 64; C = (st & 1) * 32 + (swz % 64) / 2; }
__host__ __device__ __forceinline__ int perm32(int rho) { const int n = rho >> 4, i = rho & 15; return 8 * (i >> 2) + 4 * n + (i & 3); }

struct Unit { int pm, pn; };
struct Gemm { const bf16_t* A; const bf16_t* Bt; int K, lda, ldb, akoff; long a2off; int am, pad_; };

struct StaticOrder {
    int nM, nN, nwg, G, c;
    __host__ __device__ void init(int M, int N, int G_, int c_) { nM = M / BM; nN = N / BM; nwg = nM * nN; G = G_; c = c_; }
    __host__ __device__ bool next(int i, Unit& u) const {
        const long L = (long)i * G + c; if (L >= nwg) return false;
        int wgid = (int)L; { const int q = nwg / NXCD, r = nwg % NXCD, xcd = wgid % NXCD, off = wgid / NXCD; wgid = (xcd < r ? xcd * (q + 1) : r * (q + 1) + (xcd - r) * q) + off; }
        const int nig = WGM * nN, gid = wgid / nig, fm = gid * WGM, gsz = (nM - fm) < WGM ? (nM - fm) : WGM;
        u.pm = fm + ((wgid % nig) % gsz); u.pn = (wgid % nig) / gsz; return true;
    }
    __device__ __forceinline__ void a_ready(const Unit&) const {}
    __device__ __forceinline__ void done(const Unit&) const {}
};

template <class Epi, class Sched, bool ALIGN_EPI = false, bool SP2 = false>
__device__ __forceinline__ void gemm_phase(PG8_LAS unsigned char* lds, const Gemm g, const Sched& S, const Epi& E, const int wid0) {
    const int tid = otid(wid0), wid = __builtin_amdgcn_readfirstlane(tid >> 6), lane = tid & 63, wr = wid >> 2, wc = wid & 3, fr = lane & 15, fq = lane >> 4;
    const int K = g.K, nt = K / BK;
    unsigned voffA[2], voffB[2];
#pragma unroll
    for (int i = 0; i < 2; ++i) { int R, C; stage_rc(tid * 16 + i * 8192, R, C); const int Rb = Epi::PERM ? ((R & ~31) + perm32(R & 31)) : R;
        voffA[i] = (unsigned)(R * g.lda + C) * 2u; voffB[i] = (unsigned)(Rb * g.ldb + C) * 2u; }
    const size_t kstep = (size_t)(BK * 2);
    const size_t hstepA = (size_t)HALF * g.lda * 2, hstepB = (size_t)HALF * g.ldb * 2;
    const size_t tstepA = 2 * hstepA, tstepB = 2 * hstepB, akb = (size_t)g.akoff * 2, a2b = (size_t)g.a2off * 2;
    const unsigned ldsw = (unsigned)wid * 1024u;
    const int aoff = lds_byte(wr * 64 + fr, fq * 8), boff = lds_byte(wc * 32 + fr, fq * 8);
#define PG8_SA(b, h) (((b) * 2 + (h)) * HTB)
#define PG8_SB(b, h) ((4 + (b) * 2 + (h)) * HTB)
#define PG8_STAGE(bufoff, gbase, voff) do { _Pragma("unroll") for (int _i = 0; _i < 2; ++_i) \
        __builtin_amdgcn_global_load_lds((const unsigned*)((const char*)(gbase) + (voff)[_i]), (PG8_LAS unsigned*)(lds + (bufoff) + ldsw + _i * 8192), 16, 0, 0); } while (0)
#define PG8_LDA(dst, b, h) do { _Pragma("unroll") for (int m = 0; m < 4; ++m) _Pragma("unroll") for (int k = 0; k < 2; ++k) dst[m][k] = *(const PG8_LAS bf16x8*)(lds + PG8_SA(b, h) + aoff + m * 2048 + k * 1024); } while (0)
#define PG8_LDB(dst, b, h) do { _Pragma("unroll") for (int n = 0; n < 2; ++n) _Pragma("unroll") for (int k = 0; k < 2; ++k) dst[n][k] = *(const PG8_LAS bf16x8*)(lds + PG8_SB(b, h) + boff + n * 2048 + k * 1024); } while (0)
#define PG8_MMA(ai, bj, At, Bt) do { __builtin_amdgcn_s_setprio(1); _Pragma("unroll") for (int m = 0; m < 4; ++m) _Pragma("unroll") for (int n = 0; n < 2; ++n) _Pragma("unroll") for (int k = 0; k < 2; ++k) \
        acc[ai][bj][m][n] = __builtin_amdgcn_mfma_f32_16x16x32_bf16(Bt[n][k], At[m][k], acc[ai][bj][m][n], 0, 0, 0); __builtin_amdgcn_s_setprio(0); } while (0)
#define PG8_WAIT_V(n) asm volatile("s_waitcnt vmcnt(" #n ")" ::: "memory")
#define PG8_WAIT_L(n) asm volatile("s_waitcnt lgkmcnt(" #n ")" ::: "memory")
#define PG8_BAR __builtin_amdgcn_s_barrier()
#define PG8_SCHED __builtin_amdgcn_sched_barrier(0)
    Unit cur, nxt; int ui = 0;
    if (!S.next(0, cur)) return;
    f32x4 acc[2][2][4][2];
#pragma unroll
    for (int a = 0; a < 2; ++a)
#pragma unroll
        for (int b = 0; b < 2; ++b)
#pragma unroll
            for (int m = 0; m < 4; ++m)
#pragma unroll
                for (int n = 0; n < 2; ++n) acc[a][b][m][n] = (f32x4){0.f, 0.f, 0.f, 0.f};
    bf16x8 At[4][2], B0[2][2], B1[2][2];
    const char* cA = (const char*)g.A + (size_t)(cur.pm * g.am) * tstepA + (size_t)(cur.pn & 3) * akb + (size_t)(cur.pn >> 2) * a2b; const char* cB = (const char*)g.Bt + (size_t)cur.pn * tstepB;
    S.a_ready(cur);
    if constexpr (SP2) {
        PG8_STAGE(PG8_SB(0, 0), cB, voffB); PG8_STAGE(PG8_SB(0, 1), cB + hstepB, voffB); PG8_STAGE(PG8_SA(0, 0), cA, voffA); PG8_STAGE(PG8_SA(0, 1), cA + hstepA, voffA);
        if (wr == 1) PG8_BAR;
        PG8_WAIT_V(2); PG8_BAR;
        PG8_STAGE(PG8_SB(1, 0), cB + kstep, voffB); PG8_STAGE(PG8_SA(1, 0), cA + kstep, voffA); PG8_STAGE(PG8_SB(1, 1), cB + hstepB + kstep, voffB);
        PG8_WAIT_V(6); PG8_BAR;
    } else {
        PG8_STAGE(PG8_SB(0, 0), cB, voffB); PG8_STAGE(PG8_SA(0, 0), cA, voffA); PG8_STAGE(PG8_SB(0, 1), cB + hstepB, voffB); PG8_STAGE(PG8_SA(0, 1), cA + hstepA, voffA);
        if (wr == 1) PG8_BAR;
        PG8_WAIT_V(4); PG8_BAR;
        PG8_STAGE(PG8_SB(1, 0), cB + kstep, voffB); PG8_STAGE(PG8_SA(1, 0), cA + kstep, voffA); PG8_STAGE(PG8_SB(1, 1), cB + hstepB + kstep, voffB);
        PG8_WAIT_V(6); PG8_BAR;
    }
    for (;;) {
        const bool has_next = S.next(ui + 1, nxt);
        const char* nA = has_next ? (const char*)g.A + (size_t)(nxt.pm * g.am) * tstepA + (size_t)(nxt.pn & 3) * akb + (size_t)(nxt.pn >> 2) * a2b : cA; const char* nB = has_next ? (const char*)g.Bt + (size_t)nxt.pn * tstepB : cB;
        for (int t = 0; t < nt; t += 2) {
            const bool last = (t == nt - 2);
            const char* a1 = cA + (size_t)(t + 1) * kstep;
            const char* a2 = last ? nA : cA + (size_t)(t + 2) * kstep; const char* b2 = last ? nB : cB + (size_t)(t + 2) * kstep;
            const char* a3 = a2 + kstep; const char* b3 = b2 + kstep;
            if (last && has_next) S.a_ready(nxt);
            if constexpr (SP2) {
            PG8_LDB(B0, 0, 0); PG8_LDB(B1, 0, 1); PG8_SCHED; PG8_LDA(At, 0, 0); PG8_STAGE(PG8_SA(1, 1), a1 + hstepA, voffA);
            PG8_WAIT_V(8); PG8_WAIT_L(0); PG8_BAR; PG8_MMA(0, 0, At, B0); PG8_MMA(0, 1, At, B1); PG8_BAR; PG8_SCHED;
            PG8_LDA(At, 0, 1); PG8_STAGE(PG8_SB(0, 0), b2, voffB); PG8_STAGE(PG8_SB(0, 1), b2 + hstepB, voffB); PG8_STAGE(PG8_SA(0, 0), a2, voffA);
            PG8_WAIT_V(8); PG8_WAIT_L(0); PG8_BAR; PG8_MMA(1, 0, At, B0); PG8_MMA(1, 1, At, B1); PG8_BAR; PG8_SCHED;
            PG8_LDB(B0, 1, 0); PG8_LDB(B1, 1, 1); PG8_SCHED; PG8_LDA(At, 1, 0); PG8_STAGE(PG8_SA(0, 1), a2 + hstepA, voffA);
            PG8_WAIT_V(8); PG8_WAIT_L(0); PG8_BAR; PG8_MMA(0, 0, At, B0); PG8_MMA(0, 1, At, B1); PG8_BAR; PG8_SCHED;
            PG8_LDA(At, 1, 1); PG8_STAGE(PG8_SB(1, 0), b3, voffB); PG8_STAGE(PG8_SB(1, 1), b3 + hstepB, voffB); PG8_STAGE(PG8_SA(1, 0), a3, voffA);
            PG8_WAIT_V(8); PG8_WAIT_L(0); PG8_BAR; PG8_MMA(1, 0, At, B0); PG8_MMA(1, 1, At, B1); PG8_BAR; PG8_SCHED;
            } else {
            PG8_LDB(B0, 0, 0); PG8_SCHED; PG8_LDA(At, 0, 0); PG8_STAGE(PG8_SA(1, 1), a1 + hstepA, voffA);
            PG8_WAIT_L(8); PG8_BAR; PG8_WAIT_L(0); PG8_MMA(0, 0, At, B0); PG8_BAR; PG8_SCHED;
            PG8_LDB(B1, 0, 1); PG8_STAGE(PG8_SB(0, 0), b2, voffB);
            PG8_BAR; PG8_WAIT_L(0); PG8_MMA(0, 1, At, B1); PG8_BAR;
            PG8_LDA(At, 0, 1); PG8_STAGE(PG8_SA(0, 0), a2, voffA);
            PG8_BAR; PG8_WAIT_L(0); PG8_MMA(1, 0, At, B0); PG8_BAR; PG8_SCHED;
            PG8_STAGE(PG8_SB(0, 1), b2 + hstepB, voffB);
            PG8_WAIT_V(6); PG8_BAR; PG8_MMA(1, 1, At, B1); PG8_BAR;
            PG8_LDB(B0, 1, 0); PG8_SCHED; PG8_LDA(At, 1, 0); PG8_STAGE(PG8_SA(0, 1), a2 + hstepA, voffA);
            PG8_WAIT_L(8); PG8_BAR; PG8_WAIT_L(0); PG8_MMA(0, 0, At, B0); PG8_BAR; PG8_SCHED;
            PG8_LDB(B1, 1, 1); PG8_STAGE(PG8_SB(1, 0), b3, voffB);
            PG8_BAR; PG8_WAIT_L(0); PG8_MMA(0, 1, At, B1); PG8_BAR;
            PG8_LDA(At, 1, 1); PG8_STAGE(PG8_SA(1, 0), a3, voffA);
            PG8_BAR; PG8_WAIT_L(0); PG8_MMA(1, 0, At, B0); PG8_BAR; PG8_SCHED;
            PG8_STAGE(PG8_SB(1, 1), b3 + hstepB, voffB);
            PG8_WAIT_V(6); PG8_BAR; PG8_MMA(1, 1, At, B1); PG8_BAR;
            }
        }
        if constexpr (ALIGN_EPI) { if (wr == 0) PG8_BAR; }
        if constexpr (!Epi::AFTER_DRAIN) { E(acc, cur, wr, wc, fr, fq); S.done(cur); }
        if (!has_next) break;
#pragma unroll
        for (int a = 0; a < 2; ++a)
#pragma unroll
            for (int b = 0; b < 2; ++b)
#pragma unroll
                for (int m = 0; m < 4; ++m)
#pragma unroll
                    for (int n = 0; n < 2; ++n) acc[a][b][m][n] = (f32x4){0.f, 0.f, 0.f, 0.f};
        cur = nxt; cA = nA; cB = nB; ++ui;
        if constexpr (ALIGN_EPI) { if (wr == 1) PG8_BAR; }
    }
    PG8_WAIT_V(0);
    if constexpr (!ALIGN_EPI) { if (wr == 0) PG8_BAR; }
    PG8_BAR;
    if constexpr (Epi::AFTER_DRAIN) { E.fused(acc, cur, wr, wc, fr, fq, lds, wid, lane); S.done(cur); }
#undef PG8_SA
#undef PG8_SB
#undef PG8_STAGE
#undef PG8_LDA
#undef PG8_LDB
#undef PG8_MMA
#undef PG8_WAIT_V
#undef PG8_WAIT_L
#undef PG8_BAR
#undef PG8_SCHED
}

template <class Epi, class Sched, bool ALIGN_EPI = false, bool SP2 = false>
__device__ __forceinline__ void gemm_phase_i8(PG8_LAS unsigned char* lds, const Gemm g, const Sched& S, const Epi& E, const int wid0) {
    const int tid = otid(wid0), wid = __builtin_amdgcn_readfirstlane(tid >> 6), lane = tid & 63, wr = wid >> 2, wc = wid & 3, fr = lane & 15, fq = lane >> 4;
    const int K = g.K, nt = K / 128;
    unsigned voffA[2], voffB[2];
#pragma unroll
    for (int i = 0; i < 2; ++i) { int R, C; stage_rc(tid * 16 + i * 8192, R, C); const int Rb = Epi::PERM ? ((R & ~31) + perm32(R & 31)) : R;
        voffA[i] = (unsigned)(R * g.lda + C * 2); voffB[i] = (unsigned)(Rb * g.ldb + C * 2); }
    const size_t kstep = (size_t)(BK * 2);
    const size_t hstepA = (size_t)HALF * g.lda, hstepB = (size_t)HALF * g.ldb;
    const size_t tstepA = 2 * hstepA, tstepB = 2 * hstepB, akb = (size_t)g.akoff, a2b = (size_t)g.a2off;
    const unsigned ldsw = (unsigned)wid * 1024u;
    const int aoff = lds_byte(wr * 64 + fr, fq * 8), boff = lds_byte(wc * 32 + fr, fq * 8);
#define PG8_SA(b, h) (((b) * 2 + (h)) * HTB)
#define PG8_SB(b, h) ((4 + (b) * 2 + (h)) * HTB)
#define PG8_STAGE(bufoff, gbase, voff) do { _Pragma("unroll") for (int _i = 0; _i < 2; ++_i) \
        __builtin_amdgcn_global_load_lds((const unsigned*)((const char*)(gbase) + (voff)[_i]), (PG8_LAS unsigned*)(lds + (bufoff) + ldsw + _i * 8192), 16, 0, 0); } while (0)
#define PG8_LDA(dst, b, h) do { _Pragma("unroll") for (int m = 0; m < 4; ++m) _Pragma("unroll") for (int k = 0; k < 2; ++k) dst[m][k] = *(const PG8_LAS i32x4*)(lds + PG8_SA(b, h) + aoff + m * 2048 + k * 1024); } while (0)
#define PG8_LDB(dst, b, h) do { _Pragma("unroll") for (int n = 0; n < 2; ++n) _Pragma("unroll") for (int k = 0; k < 2; ++k) dst[n][k] = *(const PG8_LAS i32x4*)(lds + PG8_SB(b, h) + boff + n * 2048 + k * 1024); } while (0)
#define PG8_MMA(ai, bj, At, Bt) do { __builtin_amdgcn_s_setprio(1); _Pragma("unroll") for (int m = 0; m < 4; ++m) _Pragma("unroll") for (int n = 0; n < 2; ++n) _Pragma("unroll") for (int k = 0; k < 2; ++k) \
        acc[ai][bj][m][n] = __builtin_amdgcn_mfma_i32_16x16x64_i8(Bt[n][k], At[m][k], acc[ai][bj][m][n], 0, 0, 0); __builtin_amdgcn_s_setprio(0); } while (0)
#define PG8_WAIT_V(n) asm volatile("s_waitcnt vmcnt(" #n ")" ::: "memory")
#define PG8_WAIT_L(n) asm volatile("s_waitcnt lgkmcnt(" #n ")" ::: "memory")
#define PG8_BAR __builtin_amdgcn_s_barrier()
#define PG8_SCHED __builtin_amdgcn_sched_barrier(0)
    Unit cur, nxt; int ui = 0;
    if (!S.next(0, cur)) return;
    i32x4 acc[2][2][4][2];
#pragma unroll
    for (int a = 0; a < 2; ++a)
#pragma unroll
        for (int b = 0; b < 2; ++b)
#pragma unroll
            for (int m = 0; m < 4; ++m)
#pragma unroll
                for (int n = 0; n < 2; ++n) acc[a][b][m][n] = (i32x4){0, 0, 0, 0};
    i32x4 At[4][2], B0[2][2], B1[2][2];
    const char* cA = (const char*)g.A + (size_t)(cur.pm * g.am) * tstepA + (size_t)(cur.pn & 3) * akb + (size_t)(cur.pn >> 2) * a2b; const char* cB = (const char*)g.Bt + (size_t)cur.pn * tstepB;
    S.a_ready(cur);
    if constexpr (SP2) {
        PG8_STAGE(PG8_SB(0, 0), cB, voffB); PG8_STAGE(PG8_SB(0, 1), cB + hstepB, voffB); PG8_STAGE(PG8_SA(0, 0), cA, voffA); PG8_STAGE(PG8_SA(0, 1), cA + hstepA, voffA);
        if (wr == 1) PG8_BAR;
        PG8_WAIT_V(2); PG8_BAR;
        PG8_STAGE(PG8_SB(1, 0), cB + kstep, voffB); PG8_STAGE(PG8_SA(1, 0), cA + kstep, voffA); PG8_STAGE(PG8_SB(1, 1), cB + hstepB + kstep, voffB);
        PG8_WAIT_V(6); PG8_BAR;
    } else {
        PG8_STAGE(PG8_SB(0, 0), cB, voffB); PG8_STAGE(PG8_SA(0, 0), cA, voffA); PG8_STAGE(PG8_SB(0, 1), cB + hstepB, voffB); PG8_STAGE(PG8_SA(0, 1), cA + hstepA, voffA);
        if (wr == 1) PG8_BAR;
        PG8_WAIT_V(4); PG8_BAR;
        PG8_STAGE(PG8_SB(1, 0), cB + kstep, voffB); PG8_STAGE(PG8_SA(1, 0), cA + kstep, voffA); PG8_STAGE(PG8_SB(1, 1), cB + hstepB + kstep, voffB);
        PG8_WAIT_V(6); PG8_BAR;
    }
    for (;;) {
        const bool has_next = S.next(ui + 1, nxt);
        const char* nA = has_next ? (const char*)g.A + (size_t)(nxt.pm * g.am) * tstepA + (size_t)(nxt.pn & 3) * akb + (size_t)(nxt.pn >> 2) * a2b : cA; const char* nB = has_next ? (const char*)g.Bt + (size_t)nxt.pn * tstepB : cB;
        for (int t = 0; t < nt; t += 2) {
            const bool last = (t == nt - 2);
            const char* a1 = cA + (size_t)(t + 1) * kstep;
            const char* a2 = last ? nA : cA + (size_t)(t + 2) * kstep; const char* b2 = last ? nB : cB + (size_t)(t + 2) * kstep;
            const char* a3 = a2 + kstep; const char* b3 = b2 + kstep;
            if (last && has_next) S.a_ready(nxt);
            if constexpr (SP2) {
            PG8_LDB(B0, 0, 0); PG8_LDB(B1, 0, 1); PG8_SCHED; PG8_LDA(At, 0, 0); PG8_STAGE(PG8_SA(1, 1), a1 + hstepA, voffA);
            PG8_WAIT_V(8); PG8_WAIT_L(0); PG8_BAR; PG8_MMA(0, 0, At, B0); PG8_MMA(0, 1, At, B1); PG8_BAR; PG8_SCHED;
            PG8_LDA(At, 0, 1); PG8_STAGE(PG8_SB(0, 0), b2, voffB); PG8_STAGE(PG8_SB(0, 1), b2 + hstepB, voffB); PG8_STAGE(PG8_SA(0, 0), a2, voffA);
            PG8_WAIT_V(8); PG8_WAIT_L(0); PG8_BAR; PG8_MMA(1, 0, At, B0); PG8_MMA(1, 1, At, B1); PG8_BAR; PG8_SCHED;
            PG8_LDB(B0, 1, 0); PG8_LDB(B1, 1, 1); PG8_SCHED; PG8_LDA(At, 1, 0); PG8_STAGE(PG8_SA(0, 1), a2 + hstepA, voffA);
            PG8_WAIT_V(8); PG8_WAIT_L(0); PG8_BAR; PG8_MMA(0, 0, At, B0); PG8_MMA(0, 1, At, B1); PG8_BAR; PG8_SCHED;
            PG8_LDA(At, 1, 1); PG8_STAGE(PG8_SB(1, 0), b3, voffB); PG8_STAGE(PG8_SB(1, 1), b3 + hstepB, voffB); PG8_STAGE(PG8_SA(1, 0), a3, voffA);
            PG8_WAIT_V(8); PG8_WAIT_L(0); PG8_BAR; PG8_MMA(1, 0, At, B0); PG8_MMA(1, 1, At, B1); PG8_BAR; PG8_SCHED;
            } else {
            PG8_LDB(B0, 0, 0); PG8_SCHED; PG8_LDA(At, 0, 0); PG8_STAGE(PG8_SA(1, 1), a1 + hstepA, voffA);
            PG8_WAIT_L(8); PG8_BAR; PG8_WAIT_L(0); PG8_MMA(0, 0, At, B0); PG8_BAR; PG8_SCHED;
            PG8_LDB(B1, 0, 1); PG8_STAGE(PG8_SB(0, 0), b2, voffB);
            PG8_BAR; PG8_WAIT_L(0); PG8_MMA(0, 1, At, B1); PG8_BAR;
            PG8_LDA(At, 0, 1); PG8_STAGE(PG8_SA(0, 0), a2, voffA);
            PG8_BAR; PG8_WAIT_L(0); PG8_MMA(1, 0, At, B0); PG8_BAR; PG8_SCHED;
            PG8_STAGE(PG8_SB(0, 1), b2 + hstepB, voffB);
            PG8_WAIT_V(6); PG8_BAR; PG8_MMA(1, 1, At, B1); PG8_BAR;
            PG8_LDB(B0, 1, 0); PG8_SCHED; PG8_LDA(At, 1, 0); PG8_STAGE(PG8_SA(0, 1), a2 + hstepA, voffA);
            PG8_WAIT_L(8); PG8_BAR; PG8_WAIT_L(0); PG8_MMA(0, 0, At, B0); PG8_BAR; PG8_SCHED;
            PG8_LDB(B1, 1, 1); PG8_STAGE(PG8_SB(1, 0), b3, voffB);
            PG8_BAR; PG8_WAIT_L(0); PG8_MMA(0, 1, At, B1); PG8_BAR;
            PG8_LDA(At, 1, 1); PG8_STAGE(PG8_SA(1, 0), a3, voffA);
            PG8_BAR; PG8_WAIT_L(0); PG8_MMA(1, 0, At, B0); PG8_BAR; PG8_SCHED;
            PG8_STAGE(PG8_SB(1, 1), b3 + hstepB, voffB);
            PG8_WAIT_V(6); PG8_BAR; PG8_MMA(1, 1, At, B1); PG8_BAR;
            }
        }
        if constexpr (ALIGN_EPI) { if (wr == 0) PG8_BAR; }
        if constexpr (!Epi::AFTER_DRAIN) { E(acc, cur, wr, wc, fr, fq); S.done(cur); }
        if (!has_next) break;
#pragma unroll
        for (int a = 0; a < 2; ++a)
#pragma unroll
            for (int b = 0; b < 2; ++b)
#pragma unroll
                for (int m = 0; m < 4; ++m)
#pragma unroll
                    for (int n = 0; n < 2; ++n) acc[a][b][m][n] = (i32x4){0, 0, 0, 0};
        cur = nxt; cA = nA; cB = nB; ++ui;
        if constexpr (ALIGN_EPI) { if (wr == 1) PG8_BAR; }
    }
    PG8_WAIT_V(0);
    if constexpr (!ALIGN_EPI) { if (wr == 0) PG8_BAR; }
    PG8_BAR;
    if constexpr (Epi::AFTER_DRAIN) { E.fused(acc, cur, wr, wc, fr, fq, lds, wid, lane); S.done(cur); }
#undef PG8_SA
#undef PG8_SB
#undef PG8_STAGE
#undef PG8_LDA
#undef PG8_LDB
#undef PG8_MMA
#undef PG8_WAIT_V
#undef PG8_WAIT_L
#undef PG8_BAR
#undef PG8_SCHED
}
}


namespace pg8 {
typedef unsigned u32x2 __attribute__((ext_vector_type(2)));
__device__ __forceinline__ unsigned cvt_pk_bf16(float lo, float hi) { unsigned r; asm volatile("v_cvt_pk_bf16_f32 %0, %1, %2" : "=v"(r) : "v"(lo), "v"(hi)); return r; }
__device__ __forceinline__ float sigm(float x) { return __builtin_amdgcn_rcpf(1.0f + __builtin_amdgcn_exp2f(-1.4426950408889634f * x)); }
__device__ __forceinline__ float bf_lo(unsigned w) { return __uint_as_float(w << 16); }
__device__ __forceinline__ float bf_hi(unsigned w) { return __uint_as_float(w & 0xffff0000u); }

struct PanelSched {
    int panel, n, skip_lo, skip_n, mode, first;
    __device__ __forceinline__ bool next(int i, Unit& u) const {
        if (i >= n) return false;
        if (mode == 0) { const int j = first + i; u.pm = panel; u.pn = j + (j >= skip_lo ? skip_n : 0); } else if (mode == 2) { u.pm = panel; u.pn = (i >> 1) + 4 * (i & 1); } else { u.pm = i; u.pn = panel; }
        return true;
    }
    __device__ __forceinline__ void a_ready(const Unit&) const {}
    __device__ __forceinline__ void done(const Unit&) const {}
};

struct EpiProj {
    static constexpr bool PERM = true, AFTER_DRAIN = false;
    bf16_t *PQ, *PK, *PU, *PG;
    __device__ __forceinline__ void operator()(const f32x4 (&acc)[2][2][4][2], const Unit& u, int wr, int wc, int fr, int fq) const {
        const int pn = u.pn; bf16_t* base; int ld, colt; bool sg = false;
        if (pn < 2) { base = PQ; ld = 512; colt = pn * 256; }
        else if (pn < 4) { base = PK; ld = 512; colt = (pn - 2) * 256; }
        else if (pn < 8) { base = PU; ld = 512; colt = (pn - 6) * 256; }
        else { base = PG; ld = 2048; colt = (pn - 8) * 256; sg = true; }
        const int row0 = u.pm * BM + wr * 64 + fr, col0 = colt + wc * 32 + 8 * fq;
#pragma unroll
        for (int ai = 0; ai < 2; ++ai)
#pragma unroll
            for (int m = 0; m < 4; ++m) { bf16_t* rowp = base + (size_t)(row0 + ai * HALF + m * 16) * ld + col0;
#pragma unroll
                for (int bj = 0; bj < 2; ++bj) { f32x4 v0 = acc[ai][bj][m][0], v1 = acc[ai][bj][m][1];
                    if (sg) { v0 = (f32x4){sigm(v0[0]), sigm(v0[1]), sigm(v0[2]), sigm(v0[3])}; v1 = (f32x4){sigm(v1[0]), sigm(v1[1]), sigm(v1[2]), sigm(v1[3])}; }
                    u32x4 w; w.x = cvt_pk_bf16(v0[0], v0[1]); w.y = cvt_pk_bf16(v0[2], v0[3]); w.z = cvt_pk_bf16(v1[0], v1[1]); w.w = cvt_pk_bf16(v1[2], v1[3]);
                    *(u32x4*)(rowp + bj * HALF) = w; } }
    }
};
__device__ __forceinline__ unsigned gate4_u8(float a, float b, float c, float d) {
    const unsigned ua = (unsigned)__builtin_rintf(a * 255.f), ub = (unsigned)__builtin_rintf(b * 255.f), uc = (unsigned)__builtin_rintf(c * 255.f), ud = (unsigned)__builtin_rintf(d * 255.f);
    return ua | (ub << 8) | (uc << 16) | (ud << 24);
}
struct EpiProjI8 {
    static constexpr bool PERM = true, AFTER_DRAIN = false;
    bf16_t *PQ, *PK, *PU, *PG; const float* rs; const float* cs;
    __device__ __forceinline__ void operator()(const i32x4 (&acc)[2][2][4][2], const Unit& u, int wr, int wc, int fr, int fq) const {
        asm volatile("" : "+v"(fr), "+v"(fq));
        const int pn = u.pn; bf16_t* base; int ld, colt; bool sg = false;
        if (pn < 2) { base = PQ; ld = 512; colt = pn * 256; }
        else if (pn < 4) { base = PK; ld = 512; colt = (pn - 2) * 256; }
        else if (pn < 8) { base = PU; ld = 512; colt = (pn - 6) * 256; }
        else { base = PG; ld = 2048; colt = (pn - 8) * 256; sg = true; }
        const int row0 = u.pm * BM + wr * 64 + fr, col0 = colt + wc * 32 + 8 * fq, ccol0 = pn * BM + wc * 32 + 8 * fq;
        f32x4 cv[2][2];
#pragma unroll
        for (int bj = 0; bj < 2; ++bj) { cv[bj][0] = *(const f32x4*)(cs + ccol0 + bj * HALF); cv[bj][1] = *(const f32x4*)(cs + ccol0 + bj * HALF + 4); }
#pragma unroll
        for (int ai = 0; ai < 2; ++ai)
#pragma unroll
            for (int m = 0; m < 4; ++m) { const int row = row0 + ai * HALF + m * 16; const float r = rs[row]; bf16_t* rowp = base + (size_t)row * ld + col0;
#pragma unroll
                for (int bj = 0; bj < 2; ++bj) { const i32x4 a0 = acc[ai][bj][m][0], a1 = acc[ai][bj][m][1];
                    f32x4 v0 = (f32x4){(float)a0[0], (float)a0[1], (float)a0[2], (float)a0[3]} * cv[bj][0] * r, v1 = (f32x4){(float)a1[0], (float)a1[1], (float)a1[2], (float)a1[3]} * cv[bj][1] * r;
                    if (sg) {
                        const unsigned lo = gate4_u8(sigm(v0[0]), sigm(v0[1]), sigm(v0[2]), sigm(v0[3])), hi = gate4_u8(sigm(v1[0]), sigm(v1[1]), sigm(v1[2]), sigm(v1[3]));
                        *(unsigned long long*)((unsigned char*)PG + (size_t)row * 4096 + col0 + bj * HALF) = (unsigned long long)lo | ((unsigned long long)hi << 32); }
                    else { u32x4 w; w.x = cvt_pk_bf16(v0[0], v0[1]); w.y = cvt_pk_bf16(v0[2], v0[3]); w.z = cvt_pk_bf16(v1[0], v1[1]); w.w = cvt_pk_bf16(v1[2], v1[3]);
                        *(u32x4*)(rowp + bj * HALF) = w; } } }
    }
};
struct EpiPlainScaleI8 {
    static constexpr bool PERM = true, AFTER_DRAIN = false;
    bf16_t* O; int ldc; PG8_LAS const float* rs; const float* cs;
    __device__ __forceinline__ void operator()(const i32x4 (&acc)[2][2][4][2], const Unit& u, int wr, int wc, int fr, int fq) const {
        asm volatile("" : "+v"(fr), "+v"(fq));
        const int col0 = u.pn * BM + wc * 32 + 8 * fq;
        f32x4 cv[2][2];
#pragma unroll
        for (int bj = 0; bj < 2; ++bj) { cv[bj][0] = *(const f32x4*)(cs + col0 + bj * HALF); cv[bj][1] = *(const f32x4*)(cs + col0 + bj * HALF + 4); }
#pragma unroll
        for (int ai = 0; ai < 2; ++ai)
#pragma unroll
            for (int m = 0; m < 4; ++m) { const int lr = ai * HALF + wr * 64 + m * 16 + fr; const float r = rs[lr]; bf16_t* rowp = O + (size_t)(u.pm * BM + lr) * ldc + col0;
#pragma unroll
                for (int bj = 0; bj < 2; ++bj) { const i32x4 a0 = acc[ai][bj][m][0], a1 = acc[ai][bj][m][1];
                    const f32x4 v0 = (f32x4){(float)a0[0], (float)a0[1], (float)a0[2], (float)a0[3]} * cv[bj][0] * r, v1 = (f32x4){(float)a1[0], (float)a1[1], (float)a1[2], (float)a1[3]} * cv[bj][1] * r;
                    u32x4 w; w.x = cvt_pk_bf16(v0[0], v0[1]); w.y = cvt_pk_bf16(v0[2], v0[3]); w.z = cvt_pk_bf16(v1[0], v1[1]); w.w = cvt_pk_bf16(v1[2], v1[3]);
                    *(u32x4*)(rowp + bj * HALF) = w; } }
    }
};
struct EpiPlainI8 {
    static constexpr bool PERM = true, AFTER_DRAIN = false;
    bf16_t* O; int ldc; const float* rs; const float* cs;
    __device__ __forceinline__ void operator()(const i32x4 (&acc)[2][2][4][2], const Unit& u, int wr, int wc, int fr, int fq) const {
        asm volatile("" : "+v"(fr), "+v"(fq));
        const int row0 = u.pm * BM + wr * 64 + fr, col0 = u.pn * BM + wc * 32 + 8 * fq;
        f32x4 cv[2][2];
#pragma unroll
        for (int bj = 0; bj < 2; ++bj) { cv[bj][0] = *(const f32x4*)(cs + col0 + bj * HALF); cv[bj][1] = *(const f32x4*)(cs + col0 + bj * HALF + 4); }
#pragma unroll
        for (int ai = 0; ai < 2; ++ai)
#pragma unroll
            for (int m = 0; m < 4; ++m) { const int row = row0 + ai * HALF + m * 16; const float r = rs[row]; bf16_t* rowp = O + (size_t)row * ldc + col0;
#pragma unroll
                for (int bj = 0; bj < 2; ++bj) { const i32x4 a0 = acc[ai][bj][m][0], a1 = acc[ai][bj][m][1];
                    const f32x4 v0 = (f32x4){(float)a0[0], (float)a0[1], (float)a0[2], (float)a0[3]} * cv[bj][0] * r, v1 = (f32x4){(float)a1[0], (float)a1[1], (float)a1[2], (float)a1[3]} * cv[bj][1] * r;
                    u32x4 w; w.x = cvt_pk_bf16(v0[0], v0[1]); w.y = cvt_pk_bf16(v0[2], v0[3]); w.z = cvt_pk_bf16(v1[0], v1[1]); w.w = cvt_pk_bf16(v1[2], v1[3]);
                    *(u32x4*)(rowp + bj * HALF) = w; } }
    }
};
struct EpiPlain {
    static constexpr bool PERM = true, AFTER_DRAIN = false;
    bf16_t* O; int ldc;
    __device__ __forceinline__ void operator()(const f32x4 (&acc)[2][2][4][2], const Unit& u, int wr, int wc, int fr, int fq) const {
        const int row0 = u.pm * BM + wr * 64 + fr, col0 = u.pn * BM + wc * 32 + 8 * fq;
#pragma unroll
        for (int ai = 0; ai < 2; ++ai)
#pragma unroll
            for (int m = 0; m < 4; ++m) { bf16_t* rowp = O + (size_t)(row0 + ai * HALF + m * 16) * ldc + col0;
#pragma unroll
                for (int bj = 0; bj < 2; ++bj) { const f32x4 v0 = acc[ai][bj][m][0], v1 = acc[ai][bj][m][1];
                    u32x4 w; w.x = cvt_pk_bf16(v0[0], v0[1]); w.y = cvt_pk_bf16(v0[2], v0[3]); w.z = cvt_pk_bf16(v1[0], v1[1]); w.w = cvt_pk_bf16(v1[2], v1[3]);
                    *(u32x4*)(rowp + bj * HALF) = w; } }
    }
};
struct EpiMergeChain {
    static constexpr bool PERM = true, AFTER_DRAIN = false;
    const bf16_t* G; bf16_t* MG;
    __device__ __forceinline__ void operator()(const f32x4 (&acc)[2][2][4][2], const Unit& u, int wr, int wc, int fr, int fq) const {
        const bool add = u.pn >= 4; const int goff = add ? 1024 : 0;
        const int row0 = u.pm * BM + wr * 64 + fr, col0 = (u.pn & 3) * BM + wc * 32 + 8 * fq;
        if (add) asm volatile("s_waitcnt vmcnt(0)" ::: "memory");
#pragma unroll
        for (int ai = 0; ai < 2; ++ai)
#pragma unroll
            for (int m = 0; m < 4; ++m) { const size_t row = (size_t)(row0 + ai * HALF + m * 16);
#pragma unroll
                for (int bj = 0; bj < 2; ++bj) { const f32x4 v0 = acc[ai][bj][m][0], v1 = acc[ai][bj][m][1];
                    const unsigned long long gq = *(const unsigned long long*)((const unsigned char*)G + row * 4096 + goff + col0 + bj * HALF);
                    const unsigned g0 = (unsigned)gq, g1 = (unsigned)(gq >> 32); const float k255 = 1.0f / 255.0f;
                    float r0 = (float)(g0 & 255u) * k255 * v0[0], r1 = (float)((g0 >> 8) & 255u) * k255 * v0[1], r2 = (float)((g0 >> 16) & 255u) * k255 * v0[2], r3 = (float)(g0 >> 24) * k255 * v0[3];
                    float r4 = (float)(g1 & 255u) * k255 * v1[0], r5 = (float)((g1 >> 8) & 255u) * k255 * v1[1], r6 = (float)((g1 >> 16) & 255u) * k255 * v1[2], r7 = (float)(g1 >> 24) * k255 * v1[3];
                    bf16_t* mp = MG + row * 1024 + col0 + bj * HALF;
                    if (add) { const u32x4 pw = *(const u32x4*)mp;
                        r0 += bf_lo(pw.x); r1 += bf_hi(pw.x); r2 += bf_lo(pw.y); r3 += bf_hi(pw.y); r4 += bf_lo(pw.z); r5 += bf_hi(pw.z); r6 += bf_lo(pw.w); r7 += bf_hi(pw.w); }
                    u32x4 w; w.x = cvt_pk_bf16(r0, r1); w.y = cvt_pk_bf16(r2, r3); w.z = cvt_pk_bf16(r4, r5); w.w = cvt_pk_bf16(r6, r7);
                    *(u32x4*)mp = w; }
                if (m == 3) asm volatile("" ::: "memory"); }
    }
};
struct EpiMerge2 {
    static constexpr bool PERM = true, AFTER_DRAIN = false;
    const unsigned char* G; bf16_t* MG;
    __device__ __forceinline__ void operator()(const f32x4 (&acc)[2][2][4][2], const Unit& u, int wr, int wc, int fr, int fq) const {
        asm volatile("" : "+v"(fr), "+v"(fq));
        const int row0 = u.pm * BM + wr * 64 + fr, colm = 256 * (u.pn & 3) + 128 * (u.pn >> 2) + wc * 32 + 8 * fq;
        const float k255 = 1.0f / 255.0f;
#pragma unroll
        for (int ai = 0; ai < 2; ++ai)
#pragma unroll
            for (int m = 0; m < 4; ++m) { const size_t row = (size_t)(row0 + ai * HALF + m * 16);
                const unsigned long long ga = *(const unsigned long long*)(G + row * 4096 + colm), gp = *(const unsigned long long*)(G + row * 4096 + 1024 + colm);
                const unsigned a0 = (unsigned)ga, a1 = (unsigned)(ga >> 32), q0 = (unsigned)gp, q1 = (unsigned)(gp >> 32);
                const f32x4 x0 = acc[ai][0][m][0], x1 = acc[ai][0][m][1], y0 = acc[ai][1][m][0], y1 = acc[ai][1][m][1];
                const float r0 = ((float)(a0 & 255u) * x0[0] + (float)(q0 & 255u) * y0[0]) * k255, r1 = ((float)((a0 >> 8) & 255u) * x0[1] + (float)((q0 >> 8) & 255u) * y0[1]) * k255;
                const float r2 = ((float)((a0 >> 16) & 255u) * x0[2] + (float)((q0 >> 16) & 255u) * y0[2]) * k255, r3 = ((float)(a0 >> 24) * x0[3] + (float)(q0 >> 24) * y0[3]) * k255;
                const float r4 = ((float)(a1 & 255u) * x1[0] + (float)(q1 & 255u) * y1[0]) * k255, r5 = ((float)((a1 >> 8) & 255u) * x1[1] + (float)((q1 >> 8) & 255u) * y1[1]) * k255;
                const float r6 = ((float)((a1 >> 16) & 255u) * x1[2] + (float)((q1 >> 16) & 255u) * y1[2]) * k255, r7 = ((float)(a1 >> 24) * x1[3] + (float)(q1 >> 24) * y1[3]) * k255;
                u32x4 w; w.x = cvt_pk_bf16(r0, r1); w.y = cvt_pk_bf16(r2, r3); w.z = cvt_pk_bf16(r4, r5); w.w = cvt_pk_bf16(r6, r7);
                *(u32x4*)(MG + row * 1024 + colm) = w;
                if (m == 3) asm volatile("" ::: "memory"); }
    }
};
__device__ __forceinline__ void lds_addf(PG8_LAS float* p, float v) { __hip_atomic_fetch_add(p, v, __ATOMIC_RELAXED, __HIP_MEMORY_SCOPE_WORKGROUP); }
__device__ __forceinline__ float quad_row_sum(float s, int lane) {
    s += __builtin_bit_cast(float, __builtin_amdgcn_ds_bpermute((lane ^ 16) << 2, __builtin_bit_cast(int, s)));
    s += __builtin_bit_cast(float, __builtin_amdgcn_ds_bpermute((lane ^ 32) << 2, __builtin_bit_cast(int, s)));
    return s;
}
struct EpiRes {
    static constexpr bool PERM = true, AFTER_DRAIN = false;
    const float* X; bf16_t* OB; PG8_LAS float* ss;
    __device__ __forceinline__ void operator()(const f32x4 (&acc)[2][2][4][2], const Unit& u, int wr, int wc, int fr, int fq) const {
        asm volatile("" : "+v"(fr), "+v"(fq));
        const int col0 = u.pn * BM + wc * 32 + 8 * fq; const int lane = fq * 16 + fr;
#pragma unroll
        for (int ai = 0; ai < 2; ++ai)
#pragma unroll
            for (int m = 0; m < 4; ++m) { const int lr = ai * HALF + wr * 64 + m * 16 + fr; const size_t xoff = (size_t)(u.pm * BM + lr) * 1024 + col0; bf16_t* op = OB + ((size_t)(2 * u.pm) * BM + lr) * 1024 + col0;
                float s = 0.f;
#pragma unroll
                for (int bj = 0; bj < 2; ++bj) { const f32x4 x0 = *(const f32x4*)(X + xoff + bj * HALF), x1 = *(const f32x4*)(X + xoff + bj * HALF + 4);
                    const f32x4 v0 = x0 + acc[ai][bj][m][0], v1 = x1 + acc[ai][bj][m][1];
                    s += (v0[0] * v0[0] + v0[1] * v0[1]) + (v0[2] * v0[2] + v0[3] * v0[3]) + (v1[0] * v1[0] + v1[1] * v1[1]) + (v1[2] * v1[2] + v1[3] * v1[3]);
                    u32x4 w; w.x = cvt_pk_bf16(v0[0], v0[1]); w.y = cvt_pk_bf16(v0[2], v0[3]); w.z = cvt_pk_bf16(v1[0], v1[1]); w.w = cvt_pk_bf16(v1[2], v1[3]);
                    *(u32x4*)(op + bj * HALF) = w; }
                s = quad_row_sum(s, lane); if (fq == 0) lds_addf(ss + lr, s);
                if (m == 3) asm volatile("" ::: "memory"); }
    }
};
struct EpiPlainScale {
    static constexpr bool PERM = true, AFTER_DRAIN = false;
    bf16_t* O; int ldc; PG8_LAS const float* rs;
    __device__ __forceinline__ void operator()(const f32x4 (&acc)[2][2][4][2], const Unit& u, int wr, int wc, int fr, int fq) const {
        asm volatile("" : "+v"(fr), "+v"(fq));
        const int col0 = u.pn * BM + wc * 32 + 8 * fq;
#pragma unroll
        for (int ai = 0; ai < 2; ++ai)
#pragma unroll
            for (int m = 0; m < 4; ++m) { const int lr = ai * HALF + wr * 64 + m * 16 + fr; const float r = rs[lr]; bf16_t* rowp = O + (size_t)(u.pm * BM + lr) * ldc + col0;
#pragma unroll
                for (int bj = 0; bj < 2; ++bj) { const f32x4 v0 = acc[ai][bj][m][0] * r, v1 = acc[ai][bj][m][1] * r;
                    u32x4 w; w.x = cvt_pk_bf16(v0[0], v0[1]); w.y = cvt_pk_bf16(v0[2], v0[3]); w.z = cvt_pk_bf16(v1[0], v1[1]); w.w = cvt_pk_bf16(v1[2], v1[3]);
                    *(u32x4*)(rowp + bj * HALF) = w; } }
    }
};
struct EpiGate {
    static constexpr bool PERM = false, AFTER_DRAIN = false;
    bf16_t* X3; const bf16_t* X2; const bf16_t* E; PG8_LAS const float* rs; PG8_LAS float* ss;
    __device__ __forceinline__ void operator()(const f32x4 (&acc)[2][2][4][2], const Unit& u, int wr, int wc, int fr, int fq) const {
        asm volatile("" : "+v"(fr), "+v"(fq));
        const int col0 = u.pn * BM + wc * 32 + 4 * fq; const int lane = fq * 16 + fr;
        bf16_t* const x3b = X3 + col0;
#pragma unroll
        for (int ai = 0; ai < 2; ++ai)
#pragma unroll
            for (int m = 0; m < 4; ++m) { const int lr = ai * HALF + wr * 64 + m * 16 + fr; const float r = rs[lr];
                const size_t off = (size_t)(u.pm * BM + lr) * 1024 + col0, xo = ((size_t)(2 * u.pm) * BM + lr) * 1024 + col0; float s = 0.f;
#pragma unroll
                for (int bj = 0; bj < 2; ++bj)
#pragma unroll
                    for (int n = 0; n < 2; ++n) { const int co = bj * HALF + n * 16; const u32x2 xw = *(const u32x2*)(X2 + xo + co); const u32x2 ew = *(const u32x2*)(E + off + co); const f32x4 a = acc[ai][bj][m][n] * r;
                        f32x4 v; v[0] = bf_lo(xw.x) + sigm(a[0]) * bf_lo(ew.x); v[1] = bf_hi(xw.x) + sigm(a[1]) * bf_hi(ew.x); v[2] = bf_lo(xw.y) + sigm(a[2]) * bf_lo(ew.y); v[3] = bf_hi(xw.y) + sigm(a[3]) * bf_hi(ew.y);
                        s += (v[0] * v[0] + v[1] * v[1]) + (v[2] * v[2] + v[3] * v[3]);
                        u32x2 w3; w3.x = cvt_pk_bf16(v[0], v[1]); w3.y = cvt_pk_bf16(v[2], v[3]); *(u32x2*)(x3b + (size_t)(u.pm * BM + lr) * 1024 + co) = w3; }
                s = quad_row_sum(s, lane); if (fq == 0) lds_addf(ss + lr, s);
                if (m == 3) asm volatile("" ::: "memory"); }
    }
};
struct EpiGateI8 {
    static constexpr bool PERM = true, AFTER_DRAIN = false;
    bf16_t* X3; const bf16_t* X2; const bf16_t* E; PG8_LAS const float* rs; const float* cs; PG8_LAS float* ss;
    __device__ __forceinline__ void operator()(const i32x4 (&acc)[2][2][4][2], const Unit& u, int wr, int wc, int fr, int fq) const {
        asm volatile("" : "+v"(fr), "+v"(fq));
        const int col0 = u.pn * BM + wc * 32 + 8 * fq; const int lane = fq * 16 + fr;
        f32x4 cv[2][2];
#pragma unroll
        for (int bj = 0; bj < 2; ++bj) { cv[bj][0] = *(const f32x4*)(cs + col0 + bj * HALF); cv[bj][1] = *(const f32x4*)(cs + col0 + bj * HALF + 4); }
#pragma unroll
        for (int ai = 0; ai < 2; ++ai)
#pragma unroll
            for (int m = 0; m < 4; ++m) { const int lr = ai * HALF + wr * 64 + m * 16 + fr; const float r = rs[lr];
                const size_t off = (size_t)(u.pm * BM + lr) * 1024 + col0, xo = ((size_t)(2 * u.pm) * BM + lr) * 1024 + col0; float s = 0.f;
#pragma unroll
                for (int bj = 0; bj < 2; ++bj) { const i32x4 a0 = acc[ai][bj][m][0], a1 = acc[ai][bj][m][1];
                    const u32x4 xw = *(const u32x4*)(X2 + xo + bj * HALF), ew = *(const u32x4*)(E + off + bj * HALF);
                    const f32x4 l0 = (f32x4){(float)a0[0], (float)a0[1], (float)a0[2], (float)a0[3]} * cv[bj][0] * r, l1 = (f32x4){(float)a1[0], (float)a1[1], (float)a1[2], (float)a1[3]} * cv[bj][1] * r;
                    const float v0 = bf_lo(xw.x) + sigm(l0[0]) * bf_lo(ew.x), v1 = bf_hi(xw.x) + sigm(l0[1]) * bf_hi(ew.x), v2 = bf_lo(xw.y) + sigm(l0[2]) * bf_lo(ew.y), v3 = bf_hi(xw.y) + sigm(l0[3]) * bf_hi(ew.y);
                    const float v4 = bf_lo(xw.z) + sigm(l1[0]) * bf_lo(ew.z), v5 = bf_hi(xw.z) + sigm(l1[1]) * bf_hi(ew.z), v6 = bf_lo(xw.w) + sigm(l1[2]) * bf_lo(ew.w), v7 = bf_hi(xw.w) + sigm(l1[3]) * bf_hi(ew.w);
                    s += ((v0 * v0 + v1 * v1) + (v2 * v2 + v3 * v3)) + ((v4 * v4 + v5 * v5) + (v6 * v6 + v7 * v7));
                    u32x4 w; w.x = cvt_pk_bf16(v0, v1); w.y = cvt_pk_bf16(v2, v3); w.z = cvt_pk_bf16(v4, v5); w.w = cvt_pk_bf16(v6, v7);
                    *(u32x4*)(X3 + off + bj * HALF) = w; }
                s = quad_row_sum(s, lane); if (fq == 0) lds_addf(ss + lr, s);
                if (m == 3) asm volatile("" ::: "memory"); }
    }
};
}

#define GAS __attribute__((address_space(1)))
#define LAS __attribute__((address_space(3)))
typedef unsigned short bf16;
typedef unsigned v4u __attribute__((ext_vector_type(4)));
typedef unsigned v2u __attribute__((ext_vector_type(2)));
typedef float f32x4 __attribute__((ext_vector_type(4)));
typedef short bf16x8 __attribute__((ext_vector_type(8)));
typedef GAS unsigned gu32;
typedef GAS unsigned long long gu64;
#define RLX_AGENT __ATOMIC_RELAXED, __HIP_MEMORY_SCOPE_AGENT
#define LDS_WAIT() asm volatile("s_waitcnt lgkmcnt(0)" ::: "memory")
#define VM_WAIT() asm volatile("s_waitcnt vmcnt(0)" ::: "memory")
__device__ __forceinline__ unsigned long long rt() { return __builtin_amdgcn_s_memrealtime(); }
__device__ __forceinline__ unsigned f2bf(float f) { unsigned u = __builtin_bit_cast(unsigned, f); return (u + 0x7fffu + ((u >> 16) & 1u)) >> 16; }
__device__ __forceinline__ unsigned pk2(float lo, float hi) { return f2bf(lo) | (f2bf(hi) << 16); }

#define XB_TMO      128
#define XB_XCNT(j)  (256  + 64 * (j))
#define XB_XSUB(j)  (1280 + 64 * (j))
#define XB_XGEN(j)  (2304 + 64 * (j))
#define XB_TOP      3328
#define XB_TOPGEN   3392
#define XCD_BAR_WORDS 3456
#define XB_SPIN_CAP (1u << 18)

__device__ __forceinline__ unsigned xb_ld(unsigned* p)              { return __hip_atomic_load(p, __ATOMIC_RELAXED, __HIP_MEMORY_SCOPE_AGENT); }
__device__ __forceinline__ unsigned xb_add(unsigned* p, unsigned v) { return __hip_atomic_fetch_add(p, v, __ATOMIC_RELAXED, __HIP_MEMORY_SCOPE_AGENT); }
__device__ __forceinline__ unsigned xb_xcc_id() { return (unsigned)__builtin_amdgcn_s_getreg((3 << 11) | 20) & 0xFu; }
#define XB_SPIN(cond, bar) do { unsigned _sp = 0; while (cond) { __builtin_amdgcn_s_sleep(1); \
    if ((++_sp & 255u) == 0u) { if (xb_ld(&(bar)[XB_TMO])) break; if (_sp > XB_SPIN_CAP) { atomicAdd(&(bar)[XB_TMO], 1u); break; } } } } while (0)

struct XcdBarrier {
    unsigned* bar; unsigned x;
    volatile LAS unsigned* st;
};

__device__ __forceinline__ XcdBarrier xcd_barrier_post(unsigned* bar, volatile LAS unsigned* st, const bool is_t0) {
    XcdBarrier b; b.bar = bar; b.x = xb_xcc_id(); b.st = st;
    if (is_t0) (void)xb_add(&bar[XB_XCNT(b.x)], 1u);
    return b;
}
__device__ __forceinline__ void xcd_barrier_complete(unsigned* bar, unsigned x, unsigned& nloc, unsigned& nx) {
    const unsigned G = gridDim.x * gridDim.y * gridDim.z;
    unsigned sum, cnt, mine, sp = 0u;
    for (;;) {
        sum = 0u; cnt = 0u; mine = 0u;
#pragma unroll
        for (unsigned j = 0; j < 16; ++j) { const unsigned c = xb_ld(&bar[XB_XCNT(j)]); sum += c; cnt += (c > 0u) ? 1u : 0u; mine = (j == x) ? c : mine; }
        if (sum == G) break;
        __builtin_amdgcn_s_sleep(1);
        if ((++sp & 255u) == 0u) { if (xb_ld(&bar[XB_TMO])) break; if (sp > XB_SPIN_CAP) { atomicAdd(&bar[XB_TMO], 1u); break; } }
    }
    nloc = mine > 0u ? mine : 1u; nx = cnt > 0u ? cnt : 1u;
}

__device__ __forceinline__ void xcd_barrier(const XcdBarrier& b, const bool is_t0) {
    asm volatile("s_waitcnt vmcnt(0)" ::: "memory");
    __syncthreads();
    if (is_t0) {
        unsigned* bar = b.bar;
        __builtin_amdgcn_s_waitcnt(0);
        unsigned nloc = b.st[0], nx = b.st[1];
        if (nloc == 0u) { xcd_barrier_complete(bar, b.x, nloc, nx); b.st[0] = nloc; b.st[1] = nx; }
        const unsigned old = xb_add(&bar[XB_XSUB(b.x)], 1u);
        const unsigned gen = old / nloc;
        if (old + 1u == (gen + 1u) * nloc) {
            __builtin_amdgcn_fence(__ATOMIC_RELEASE, "agent");
            asm volatile("s_waitcnt vmcnt(0)" ::: "memory");
            const unsigned og = xb_add(&bar[XB_TOP], 1u);
            const unsigned tg = og / nx;
            if (og + 1u == (tg + 1u) * nx) xb_add(&bar[XB_TOPGEN], 1u);
            else XB_SPIN(xb_ld(&bar[XB_TOPGEN]) == tg, bar);
            __builtin_amdgcn_fence(__ATOMIC_ACQUIRE, "agent");
            xb_add(&bar[XB_XGEN(b.x)], 1u);
            asm volatile("s_waitcnt vmcnt(0)" ::: "memory");
        } else {
            XB_SPIN(xb_ld(&bar[XB_XGEN(b.x)]) == gen, bar);
            __builtin_amdgcn_fence(__ATOMIC_ACQUIRE, "agent");
            asm volatile("s_waitcnt vmcnt(0)" ::: "memory");
        }
    }
    __syncthreads();
}


constexpr int NWAVES = 8, NTHR = 512;
constexpr int TOK = 65536, DM = 1024, SEQ = 8192, NPANEL = 256;
constexpr float RMS_EPS = 1e-6f;
constexpr float C2 = 0.125f * 1.4426950408889634f;
constexpr float SURV_THR = 5.4210108624275222e-20f;
constexpr size_t MiB = 1u << 20;
constexpr size_t WS_CTL = 0, CTL_ZERO_BYTES = 64 * 1024;
constexpr size_t WS_WIN = 2 * MiB, WS_WOUT = 10 * MiB, WS_WQ = 12 * MiB, WS_WPG = 16 * MiB, WS_WPLE = 18 * MiB;
constexpr size_t WS_BD2 = 24 * MiB, WS_SK = 19 * MiB;
constexpr size_t WS_SX = 21 * MiB, WS_SBN = 21 * MiB + 262144, WS_SBQ = 21 * MiB + 262144 + 16384, WS_SBG = 21 * MiB + 262144 + 16384 + 8192;
constexpr size_t WS_EU = 32 * MiB, WS_EV = 64 * MiB, WS_SU = 20 * MiB, WS_SV = 20 * MiB + 65536;
constexpr size_t WS_XN = 96 * MiB;
constexpr size_t WS_PQ = 224 * MiB, WS_PK = 288 * MiB, WS_PVT = 352 * MiB, WS_PU = 416 * MiB;
constexpr size_t WS_PG = 480 * MiB;
constexpr size_t WS_YA = 736 * MiB, WS_YP = 800 * MiB;
constexpr size_t WS_MG = 864 * MiB, WS_END = 992 * MiB;
constexpr int CW_BAR = 1024, CW_CMAX = 8192;
constexpr int RING_BYTES = 131072, LDSCTL_OFF = RING_BYTES, MISC_OFF = LDSCTL_OFF + 320, LDS_BYTES = 147456;

typedef float f32x16 __attribute__((ext_vector_type(16)));
typedef float f32x2 __attribute__((ext_vector_type(2)));
typedef __bf16 bf16x2v __attribute__((ext_vector_type(2)));

__device__ __forceinline__ int shx(int v, int m, int lane) { return __builtin_amdgcn_ds_bpermute((lane ^ m) << 2, v); }
__device__ __forceinline__ float shx(float v, int m, int lane) { return __builtin_bit_cast(float, __builtin_amdgcn_ds_bpermute((lane ^ m) << 2, __builtin_bit_cast(int, v))); }
__device__ __forceinline__ float shl_(float v, int src) { return __builtin_bit_cast(float, __builtin_amdgcn_ds_bpermute(src << 2, __builtin_bit_cast(int, v))); }
__device__ __forceinline__ float wave_sum(float v, int lane) {
#pragma unroll
    for (int o = 1; o < 64; o <<= 1) v += shx(v, o, lane);
    return v;
}
__device__ __forceinline__ float bflo(unsigned w) { return __uint_as_float(w << 16); }
__device__ __forceinline__ float bfhi(unsigned w) { return __uint_as_float(w & 0xffff0000u); }
__device__ __forceinline__ unsigned cvtpk(float lo, float hi) { return pg8::cvt_pk_bf16(lo, hi); }

#define H_UNPACK(H, A, B) do { H[0] = bflo(A.x); H[1] = bfhi(A.x); H[2] = bflo(A.y); H[3] = bfhi(A.y); H[4] = bflo(A.z); H[5] = bfhi(A.z); H[6] = bflo(A.w); H[7] = bfhi(A.w); \
        H[8] = bflo(B.x); H[9] = bfhi(B.x); H[10] = bflo(B.y); H[11] = bfhi(B.y); H[12] = bflo(B.z); H[13] = bfhi(B.z); H[14] = bflo(B.w); H[15] = bfhi(B.w); } while (0)
__device__ __forceinline__ void p0_transpose_item(const float* W, int K, int N, bf16* WT, const float* kscale, int nlo, float nls, LAS float* scr, int item, int lane) {
    const int nblk = N / 32, kb = item / nblk, nb = item % nblk, k0 = 64 * kb, n0 = 32 * nb;
    const float ns = (n0 + (lane & 31)) < nlo ? nls : 1.0f;
#pragma unroll 8
    for (int i = 0; i < 32; ++i) { const int kk = 2 * i + (lane >> 5); float v = W[(size_t)(k0 + kk) * N + n0 + (lane & 31)] * ns; if (kscale) v *= kscale[k0 + kk]; scr[kk * 33 + (lane & 31)] = v; }
    LDS_WAIT(); asm volatile("" ::: "memory");
    const int c = lane & 7;
#pragma unroll
    for (int j = 0; j < 4; ++j) { const int n = (lane >> 3) + 8 * j; const LAS float* s = scr + (8 * c) * 33 + n;
        v4u o; o.x = pk2(s[0 * 33], s[1 * 33]); o.y = pk2(s[2 * 33], s[3 * 33]); o.z = pk2(s[4 * 33], s[5 * 33]); o.w = pk2(s[6 * 33], s[7 * 33]);
        *(GAS v4u*)(WT + (size_t)(n0 + n) * K + k0 + 8 * c) = o; }
    LDS_WAIT(); asm volatile("" ::: "memory");
}
__device__ __forceinline__ void rms_rows4_to_bf16(const float* xrow, bf16* orow, size_t rstride, int lane) {
    f32x4 v[4][4]; float s[4];
#pragma unroll
    for (int k = 0; k < 4; ++k) { const GAS f32x4* xr = (const GAS f32x4*)(xrow + k * rstride) + lane;
#pragma unroll
        for (int j = 0; j < 4; ++j) v[k][j] = xr[64 * j]; }
#pragma unroll
    for (int k = 0; k < 4; ++k) { s[k] = 0.f;
#pragma unroll
        for (int j = 0; j < 4; ++j) s[k] += (v[k][j].x * v[k][j].x + v[k][j].y * v[k][j].y) + (v[k][j].z * v[k][j].z + v[k][j].w * v[k][j].w); }
#pragma unroll
    for (int o = 1; o < 64; o <<= 1) {
#pragma unroll
        for (int k = 0; k < 4; ++k) s[k] += shx(s[k], o, lane); }
#pragma unroll
    for (int k = 0; k < 4; ++k) { const float r = 1.f / sqrtf(s[k] * (1.f / DM) + RMS_EPS);
        GAS unsigned long long* o8 = (GAS unsigned long long*)(orow + k * rstride) + lane;
#pragma unroll
        for (int j = 0; j < 4; ++j) o8[64 * j] = (unsigned long long)pk2(v[k][j].x * r, v[k][j].y * r) | ((unsigned long long)pk2(v[k][j].z * r, v[k][j].w * r) << 32); }
}
__device__ __forceinline__ unsigned pack4_i8(float a, float b, float c, float d) {
    const int qa = (int)__builtin_rintf(a), qb = (int)__builtin_rintf(b), qc = (int)__builtin_rintf(c), qd = (int)__builtin_rintf(d);
    return (unsigned)(qa & 255) | ((unsigned)(qb & 255) << 8) | ((unsigned)(qc & 255) << 16) | ((unsigned)qd << 24);
}
__device__ __forceinline__ void rms_rows4_to_i8(const float* xrow, unsigned char* orow, float* sc, size_t rstride, size_t sstride, int lane) {
    f32x4 v[4][4]; float s[4], m[4];
#pragma unroll
    for (int k = 0; k < 4; ++k) { const GAS f32x4* xr = (const GAS f32x4*)(xrow + k * rstride) + lane;
#pragma unroll
        for (int j = 0; j < 4; ++j) v[k][j] = xr[64 * j]; }
#pragma unroll
    for (int k = 0; k < 4; ++k) { s[k] = 0.f; m[k] = 0.f;
#pragma unroll
        for (int j = 0; j < 4; ++j) { s[k] += (v[k][j].x * v[k][j].x + v[k][j].y * v[k][j].y) + (v[k][j].z * v[k][j].z + v[k][j].w * v[k][j].w);
            m[k] = fmaxf(m[k], fmaxf(fmaxf(fabsf(v[k][j].x), fabsf(v[k][j].y)), fmaxf(fabsf(v[k][j].z), fabsf(v[k][j].w)))); } }
#pragma unroll
    for (int o = 1; o < 64; o <<= 1) {
#pragma unroll
        for (int k = 0; k < 4; ++k) { s[k] += shx(s[k], o, lane); m[k] = fmaxf(m[k], shx(m[k], o, lane)); } }
#pragma unroll
    for (int k = 0; k < 4; ++k) { const float r = 1.f / sqrtf(s[k] * (1.f / DM) + RMS_EPS); const float qs = m[k] > 0.f ? 127.0f / m[k] : 1.0f;
        GAS unsigned* o4 = (GAS unsigned*)(orow + k * rstride) + lane;
#pragma unroll
        for (int j = 0; j < 4; ++j) o4[64 * j] = pack4_i8(v[k][j].x * qs, v[k][j].y * qs, v[k][j].z * qs, v[k][j].w * qs);
        if (lane == 0) sc[k * sstride] = (m[k] > 0.f ? m[k] * (1.0f / 127.0f) : 1.0f) * r; }
}
__device__ __forceinline__ void p0_colmax_item(const float* W, int N, unsigned* cmax, const float* kscale, int nlo, float nls, int item, int lane) {
    const int nblk = N / 64, ks = item / nblk, nb = item % nblk, n = 64 * nb + lane;
    const float ns = n < nlo ? nls : 1.0f;
    const float* wp = W + (size_t)(32 * ks) * N + n; const float* kp = kscale + 32 * ks;
    float m = 0.f;
#pragma unroll 8
    for (int i = 0; i < 32; ++i) { m = fmaxf(m, fabsf(wp[0] * ns * kp[i])); wp += N; }
    __hip_atomic_fetch_max(cmax + n, __float_as_uint(m), __ATOMIC_RELAXED, __HIP_MEMORY_SCOPE_AGENT);
}
__device__ __forceinline__ void p0_quant_tile_item(const float* W, int N, unsigned char* WT8, float* colsc, const unsigned* cmax, const float* kscale, int nlo, float nls, LAS float* scr, int item, int lane) {
    const int K = 1024; const int nblk = N / 32, kb = item / nblk, nb = item % nblk, k0 = 64 * kb, n0 = 32 * nb;
    const float cm = __uint_as_float(cmax[n0 + (lane & 31)]);
    const float ns = ((n0 + (lane & 31)) < nlo ? nls : 1.0f) * (cm > 0.f ? 127.0f / cm : 1.0f);
    if (kb == 0 && lane < 32) colsc[n0 + lane] = cm > 0.f ? cm * (1.0f / 127.0f) : 1.0f;
#pragma unroll 8
    for (int i = 0; i < 32; ++i) { const int kk = 2 * i + (lane >> 5); scr[kk * 33 + (lane & 31)] = W[(size_t)(k0 + kk) * N + n0 + (lane & 31)] * ns * kscale[k0 + kk]; }
    LDS_WAIT(); asm volatile("" ::: "memory");
    const int c = lane & 7;
#pragma unroll
    for (int j = 0; j < 4; ++j) { const int n = (lane >> 3) + 8 * j; const LAS float* s = scr + (8 * c) * 33 + n;
        const unsigned lo = pack4_i8(s[0 * 33], s[1 * 33], s[2 * 33], s[3 * 33]), hi = pack4_i8(s[4 * 33], s[5 * 33], s[6 * 33], s[7 * 33]);
        *(GAS unsigned long long*)(WT8 + (size_t)(n0 + n) * K + k0 + 8 * c) = (unsigned long long)lo | ((unsigned long long)hi << 32); }
    LDS_WAIT(); asm volatile("" ::: "memory");
}
__device__ __forceinline__ void cvt8_store(const float* src, bf16* dst) {
    const f32x4 a = *(const GAS f32x4*)src, b = *(const GAS f32x4*)(src + 4);
    v4u o; o.x = pk2(a.x, a.y); o.y = pk2(a.z, a.w); o.z = pk2(b.x, b.y); o.w = pk2(b.z, b.w);
    *(GAS v4u*)dst = o;
}

__device__ __forceinline__ void attn_panel(int panel, const bf16* PQ, const bf16* PK, const bf16* PVT, bf16* YA, const int wid0) {
    const int tid = otid(wid0), lane = tid & 63, wid = __builtin_amdgcn_readfirstlane(tid >> 6);
    const int r32 = lane & 31, hh = lane >> 5;
    const size_t seq0 = (size_t)(panel >> 5) * SEQ;
    const int pos0 = (panel & 31) * 256 + wid * 32;
    const int kap = 16 * ((r32 >> 2) & 1) + (r32 & 3) + 4 * (r32 >> 3);
    for (int h = 0; h < 8; ++h) {
        bf16x8 qf[4];
        { const bf16* qrow = PQ + (seq0 + pos0 + r32) * 512 + h * 64 + 8 * hh;
#pragma unroll
          for (int s = 0; s < 4; ++s) qf[s] = *(const GAS bf16x8*)(qrow + 16 * s); }
        f32x16 o0 = {}, o1 = {};
        float Sin = 1.f;
        for (int kb = pos0; kb >= 0; kb -= 32) {
            const bf16* krow = PK + (seq0 + kb + kap) * 512 + h * 64 + 8 * hh;
            const bf16* vrow = PVT + (size_t)(h * 64 + kap) * TOK + seq0 + kb + 16 * hh;
            bf16x8 kf[4], vf[2][2];
#pragma unroll
            for (int s = 0; s < 4; ++s) kf[s] = *(const GAS bf16x8*)(krow + 16 * s);
#pragma unroll
            for (int db = 0; db < 2; ++db)
#pragma unroll
                for (int s = 0; s < 2; ++s) vf[db][s] = *(const GAS bf16x8*)(vrow + (size_t)db * 32 * TOK + 8 * s);
            f32x16 z = {};
#pragma unroll
            for (int s = 0; s < 4; ++s) z = __builtin_amdgcn_mfma_f32_32x32x16_bf16(kf[s], qf[s], z, 0, 0, 0);
            const bool diag = (kb == pos0);
            float w[16]; float Sl = 1.f;
#pragma unroll
            for (int reg = 15; reg >= 0; --reg) {
                float beta = __builtin_amdgcn_rcpf(1.0f + __builtin_amdgcn_exp2f(-z[reg]));
                if (diag && (16 * hh + reg >= r32)) beta = 0.f;
                const float wl = beta * Sl; Sl -= wl; w[reg] = wl;
            }
            const float Pp = shx(Sl, 32, lane);
            const float scale = hh ? Sin : Sin * Pp;
            Sin = Sin * Sl * Pp;
            v4u pw0, pw1;
            pw0.x = cvtpk(w[0] * scale, w[1] * scale); pw0.y = cvtpk(w[2] * scale, w[3] * scale); pw0.z = cvtpk(w[4] * scale, w[5] * scale); pw0.w = cvtpk(w[6] * scale, w[7] * scale);
            pw1.x = cvtpk(w[8] * scale, w[9] * scale); pw1.y = cvtpk(w[10] * scale, w[11] * scale); pw1.z = cvtpk(w[12] * scale, w[13] * scale); pw1.w = cvtpk(w[14] * scale, w[15] * scale);
            const bf16x8 p0 = __builtin_bit_cast(bf16x8, pw0), p1 = __builtin_bit_cast(bf16x8, pw1);
            o0 = __builtin_amdgcn_mfma_f32_32x32x16_bf16(vf[0][0], p0, o0, 0, 0, 0);
            o0 = __builtin_amdgcn_mfma_f32_32x32x16_bf16(vf[0][1], p1, o0, 0, 0, 0);
            o1 = __builtin_amdgcn_mfma_f32_32x32x16_bf16(vf[1][0], p0, o1, 0, 0, 0);
            o1 = __builtin_amdgcn_mfma_f32_32x32x16_bf16(vf[1][1], p1, o1, 0, 0, 0);
            if (__all(Sin < SURV_THR)) break;
        }
        bf16* orow = YA + (seq0 + pos0 + r32) * 1024 + (h >> 1) * 256 + (h & 1) * 64 + 16 * hh;
        v4u a, b2;
        a.x = cvtpk(o0[0], o0[1]); a.y = cvtpk(o0[2], o0[3]); a.z = cvtpk(o0[4], o0[5]); a.w = cvtpk(o0[6], o0[7]);
        b2.x = cvtpk(o0[8], o0[9]); b2.y = cvtpk(o0[10], o0[11]); b2.z = cvtpk(o0[12], o0[13]); b2.w = cvtpk(o0[14], o0[15]);
        *(GAS v4u*)orow = a; *(GAS v4u*)(orow + 8) = b2;
        a.x = cvtpk(o1[0], o1[1]); a.y = cvtpk(o1[2], o1[3]); a.z = cvtpk(o1[4], o1[5]); a.w = cvtpk(o1[6], o1[7]);
        b2.x = cvtpk(o1[8], o1[9]); b2.y = cvtpk(o1[10], o1[11]); b2.z = cvtpk(o1[12], o1[13]); b2.w = cvtpk(o1[14], o1[15]);
        *(GAS v4u*)(orow + 32) = a; *(GAS v4u*)(orow + 40) = b2;
    }
}

__device__ __forceinline__ void pool_panel(int panel, const bf16* PU, bf16* YP, const int wid0) {
    const int tid = otid(wid0);
    const int chunk = tid & 63, tg = tid >> 6, w = 2 << (chunk >> 4);
    const int posb = (panel & 31) * 256; const size_t row0 = (size_t)panel * 256;
    float s[8];
#pragma unroll
    for (int k = 0; k < 8; ++k) s[k] = 0.f;
    { const int t = tg * 32, pos = posb + t, cnt = (pos + 1 < w) ? (pos + 1) : w;
      for (int j = 1; j < cnt; ++j) { const v4u v = *(const GAS v4u*)(PU + (row0 + t - j) * 512 + chunk * 8);
          s[0] += bflo(v.x); s[1] += bfhi(v.x); s[2] += bflo(v.y); s[3] += bfhi(v.y); s[4] += bflo(v.z); s[5] += bfhi(v.z); s[6] += bflo(v.w); s[7] += bfhi(v.w); } }
    for (int i = 0; i < 32; ++i) {
        const int t = tg * 32 + i, pos = posb + t, cnt = (pos + 1 < w) ? (pos + 1) : w;
        const v4u cur = *(const GAS v4u*)(PU + (row0 + t) * 512 + chunk * 8);
        s[0] += bflo(cur.x); s[1] += bfhi(cur.x); s[2] += bflo(cur.y); s[3] += bfhi(cur.y); s[4] += bflo(cur.z); s[5] += bfhi(cur.z); s[6] += bflo(cur.w); s[7] += bfhi(cur.w);
        const float ic = 1.0f / (float)cnt;
        v4u o;
        o.x = cvtpk(s[0] * ic - bflo(cur.x), s[1] * ic - bfhi(cur.x)); o.y = cvtpk(s[2] * ic - bflo(cur.y), s[3] * ic - bfhi(cur.y));
        o.z = cvtpk(s[4] * ic - bflo(cur.z), s[5] * ic - bfhi(cur.z)); o.w = cvtpk(s[6] * ic - bflo(cur.w), s[7] * ic - bfhi(cur.w));
        *(GAS v4u*)(YP + (row0 + t) * 1024 + (chunk >> 4) * 256 + 128 + (chunk & 15) * 8) = o;
        if (pos + 1 >= w) {
            const v4u v = *(const GAS v4u*)(PU + (row0 + t - (w - 1)) * 512 + chunk * 8);
            s[0] -= bflo(v.x); s[1] -= bfhi(v.x); s[2] -= bflo(v.y); s[3] -= bfhi(v.y); s[4] -= bflo(v.z); s[5] -= bfhi(v.z); s[6] -= bflo(v.w); s[7] -= bfhi(v.w);
        }
    }
}

#define HD __host__ __device__ __forceinline__
HD int f2s(float f) { int i = __builtin_bit_cast(int, f); return i ^ ((i >> 31) & 0x7fffffff); }
HD float s2f(int i) { i ^= ((i >> 31) & 0x7fffffff); return __builtin_bit_cast(float, i); }
HD void ce_desc(int& a, int& b) { const int mx = a > b ? a : b, mn = a > b ? b : a; a = mx; b = mn; }
template <int J, int K> HD void bpass16(int (&v)[16]) {
#pragma unroll
    for (int i = 0; i < 16; ++i) { const int l = i ^ J; if (l > i) { if ((i & K) == 0) ce_desc(v[i], v[l]); else ce_desc(v[l], v[i]); } }
}
HD void bitonic_sort16_desc(int (&v)[16]) {
    bpass16<1, 2>(v); bpass16<2, 4>(v); bpass16<1, 4>(v); bpass16<4, 8>(v); bpass16<2, 8>(v); bpass16<1, 8>(v);
    bpass16<8, 16>(v); bpass16<4, 16>(v); bpass16<2, 16>(v); bpass16<1, 16>(v);
}
HD void bitonic_merge16_desc(int (&v)[16]) {
    bpass16<8, 16>(v); bpass16<4, 16>(v); bpass16<2, 16>(v); bpass16<1, 16>(v);
}
HD void merge_prune16(int (&x)[16], const int (&y)[16]) {
#pragma unroll
    for (int i = 0; i < 16; ++i) x[i] = x[i] > y[15 - i] ? x[i] : y[15 - i];
    bitonic_merge16_desc(x);
}
HD int cx_i(int hf, int t) { if (hf == 0) return 0; return t < 5 ? 2 : t < 9 ? 3 : t < 12 ? 4 : t < 14 ? 5 : 6; }
HD int cx_j(int hf, int t) { if (hf == 0) return t; return t < 5 ? t : t < 9 ? t - 5 : t < 12 ? t - 9 : t < 14 ? t - 12 : t - 14; }
HD int cy_i(int hf, int t) { if (hf == 0) return t < 8 ? 1 : 23 - t; return 7; }
HD int cy_j(int hf, int t) { if (hf == 0) return t < 8 ? t : 0; return t; }

__device__ __forceinline__ void top16_of_group(const bf16x8 (&qf)[8], LAS const unsigned char* skl, int r32, int hh, int lane, int (&res)[16]) {
    int v[4][16];
#pragma unroll
    for (int kb = 0; kb < 4; ++kb) {
        f32x16 acc = {};
#pragma unroll
        for (int s = 0; s < 8; ++s) { const bf16x8 af = *(LAS const bf16x8*)(skl + (32 * kb + r32) * 272 + 32 * s + 16 * hh); acc = __builtin_amdgcn_mfma_f32_32x32x16_bf16(af, qf[s], acc, 0, 0, 0); }
#pragma unroll
        for (int reg = 0; reg < 16; ++reg) { const int keyid = 32 * kb + (reg & 3) + 8 * (reg >> 2) + 4 * hh; v[kb][reg] = (f2s(acc[reg]) & ~127) | keyid; }
    }
    bitonic_sort16_desc(v[0]); bitonic_sort16_desc(v[1]); bitonic_sort16_desc(v[2]); bitonic_sort16_desc(v[3]);
    merge_prune16(v[0], v[1]); merge_prune16(v[2], v[3]); merge_prune16(v[0], v[2]);
    int y[16];
#pragma unroll
    for (int i = 0; i < 16; ++i) y[i] = shx(v[0][i], 32, lane);
    merge_prune16(v[0], y);
#pragma unroll
    for (int i = 0; i < 16; ++i) res[i] = v[0][i];
}

__device__ __forceinline__ void topk_panel(int panel, const bf16* QP, const bf16* SK, int* IDXp, float* GTp  , LAS unsigned char* ldsb  , const int wid0) {
    const int tid = otid(wid0), lane = tid & 63, wid = __builtin_amdgcn_readfirstlane(tid >> 6);
    const int r32 = lane & 31, hh = lane >> 5;
    const int lrow = wid * 32 + r32;
    const size_t row = (size_t)panel * 256 + lrow;
    LAS int* lut = (LAS int*)ldsb; LAS unsigned char* skl = ldsb + 65536;
    v4u skr[4];
#define SK_FETCH(g_) do { _Pragma("unroll") for (int i = 0; i < 4; ++i) skr[i] = *((const GAS v4u*)(SK + (size_t)(g_) * 128 * 128) + i * 512 + tid); } while (0)
#define SK_STAGE() do { _Pragma("unroll") for (int i = 0; i < 4; ++i) { const int p = i * 512 + tid; *(LAS v4u*)(skl + (p >> 4) * 272 + (p & 15) * 16) = skr[i]; } } while (0)
    bf16x8 qn[8];
#define Q_FETCH(g_) do { const bf16* qrow_ = QP + row * 2048 + (g_) * 128 + 8 * hh; _Pragma("unroll") for (int s = 0; s < 8; ++s) qn[s] = *(const GAS bf16x8*)(qrow_ + 16 * s); } while (0)
    SK_FETCH(0); Q_FETCH(0);
    for (int h = 0; h < 8; ++h) {
        int a[16], b[16];
#pragma unroll
        for (int c = 0; c < 2; ++c) {
            const int g = 2 * h + c;
            bf16x8 qf[8];
#pragma unroll
            for (int s = 0; s < 8; ++s) qf[s] = qn[s];
            __syncthreads();
            SK_STAGE();
            __syncthreads();
            if (g < 15) { SK_FETCH(g + 1); Q_FETCH(g + 1); }
            if (c == 0) top16_of_group(qf, skl, r32, hh, lane, a); else top16_of_group(qf, skl, r32, hh, lane, b);
        }
        float fa[16], fb[16];
#pragma unroll
        for (int i = 0; i < 16; ++i) { fa[i] = s2f(a[i] & ~127); fb[i] = s2f(b[i] & ~127); lut[i * 512 + tid] = a[i] & 127; lut[(16 + i) * 512 + tid] = b[i] & 127; }
        int X[16], Y[16];
#pragma unroll
        for (int t = 0; t < 16; ++t) {
            const float s0 = fa[cx_i(0, t)] + fb[cx_j(0, t)], s1 = fa[cx_i(1, t)] + fb[cx_j(1, t)];
            const int c0 = cx_i(0, t) * 16 + cx_j(0, t), c1 = cx_i(1, t) * 16 + cx_j(1, t);
            X[t] = hh ? ((f2s(s1) & ~255) | c1) : ((f2s(s0) & ~255) | c0);
            const float u0 = fa[cy_i(0, t)] + fb[cy_j(0, t)];
            const int d0 = cy_i(0, t) * 16 + cy_j(0, t);
            int y1 = (int)0x80000000;
            if (t < 2) { const float u1 = fa[cy_i(1, t)] + fb[cy_j(1, t)]; y1 = (f2s(u1) & ~255) | (cy_i(1, t) * 16 + cy_j(1, t)); }
            Y[t] = hh ? y1 : ((f2s(u0) & ~255) | d0);
        }
        bitonic_sort16_desc(X); bitonic_merge16_desc(Y); merge_prune16(X, Y);
#pragma unroll
        for (int i = 0; i < 16; ++i) Y[i] = shx(X[i], 32, lane);
        merge_prune16(X, Y);
        const float mx = s2f(X[0] & ~255);
        float ex[16], den = 0.f;
#pragma unroll
        for (int i = 0; i < 16; ++i) { ex[i] = __builtin_amdgcn_exp2f((s2f(X[i] & ~255) - mx) * 1.4426950408889634f); den += ex[i]; }
        const float rden = 1.0f / den;
        int oi[8]; float og[8];
#pragma unroll
        for (int t = 0; t < 8; ++t) {
            const int msk = -hh;
            const int code = (X[t] ^ ((X[t] ^ X[8 + t]) & msk)) & 255;
            const int e1 = lut[(code >> 4) * 512 + tid], e2 = lut[(16 + (code & 15)) * 512 + tid];
            const int exl = __builtin_bit_cast(int, ex[t]), exh = __builtin_bit_cast(int, ex[8 + t]);
            oi[t] = e1 * 128 + e2; og[t] = __builtin_bit_cast(float, exl ^ ((exl ^ exh) & msk)) * rden;
        }
        int* ip = IDXp + lrow * 128 + h * 16 + 8 * hh; float* gp = GTp + lrow * 128 + h * 16 + 8 * hh;
        *(GAS v4u*)ip = (v4u){(unsigned)oi[0], (unsigned)oi[1], (unsigned)oi[2], (unsigned)oi[3]}; *(GAS v4u*)(ip + 4) = (v4u){(unsigned)oi[4], (unsigned)oi[5], (unsigned)oi[6], (unsigned)oi[7]};
        *(GAS f32x4*)gp = (f32x4){og[0], og[1], og[2], og[3]}; *(GAS f32x4*)(gp + 4) = (f32x4){og[4], og[5], og[6], og[7]};
    }
#undef SK_FETCH
#undef SK_STAGE
#undef Q_FETCH
}

typedef float f32x2v __attribute__((ext_vector_type(2)));
__device__ __forceinline__ void quant_row_fp8(const float* src, const float* colgain, unsigned char* dst, float* sc_out, int lane) {
    const GAS f32x4* s = (const GAS f32x4*)src + 4 * lane;
    f32x4 v[4]; float m = 0.f;
#pragma unroll
    for (int j = 0; j < 4; ++j) { v[j] = s[j]; if (colgain) v[j] = v[j] * ((const GAS f32x4*)colgain + 4 * lane)[j]; m = fmaxf(m, fmaxf(fmaxf(fabsf(v[j].x), fabsf(v[j].y)), fmaxf(fabsf(v[j].z), fabsf(v[j].w)))); }
#pragma unroll
    for (int o = 1; o < 64; o <<= 1) m = fmaxf(m, shx(m, o, lane));
    const float sc = m > 0.f ? 224.0f / m : 1.0f;
    v4u w;
    { int t = 0; t = __builtin_amdgcn_cvt_pk_fp8_f32(v[0].x * sc, v[0].y * sc, t, false); t = __builtin_amdgcn_cvt_pk_fp8_f32(v[0].z * sc, v[0].w * sc, t, true); w.x = (unsigned)t; }
    { int t = 0; t = __builtin_amdgcn_cvt_pk_fp8_f32(v[1].x * sc, v[1].y * sc, t, false); t = __builtin_amdgcn_cvt_pk_fp8_f32(v[1].z * sc, v[1].w * sc, t, true); w.y = (unsigned)t; }
    { int t = 0; t = __builtin_amdgcn_cvt_pk_fp8_f32(v[2].x * sc, v[2].y * sc, t, false); t = __builtin_amdgcn_cvt_pk_fp8_f32(v[2].z * sc, v[2].w * sc, t, true); w.z = (unsigned)t; }
    { int t = 0; t = __builtin_amdgcn_cvt_pk_fp8_f32(v[3].x * sc, v[3].y * sc, t, false); t = __builtin_amdgcn_cvt_pk_fp8_f32(v[3].z * sc, v[3].w * sc, t, true); w.w = (unsigned)t; }
    *(GAS v4u*)(dst + 16 * lane) = w;
    if (lane == 0) *sc_out = m > 0.f ? m * (1.0f / 224.0f) : 1.0f;
}
__device__ __forceinline__ v4u quant16_fp8(const f32x4 (&v)[4], float sc) {
    v4u w;
    { int t = 0; t = __builtin_amdgcn_cvt_pk_fp8_f32(v[0].x * sc, v[0].y * sc, t, false); t = __builtin_amdgcn_cvt_pk_fp8_f32(v[0].z * sc, v[0].w * sc, t, true); w.x = (unsigned)t; }
    { int t = 0; t = __builtin_amdgcn_cvt_pk_fp8_f32(v[1].x * sc, v[1].y * sc, t, false); t = __builtin_amdgcn_cvt_pk_fp8_f32(v[1].z * sc, v[1].w * sc, t, true); w.y = (unsigned)t; }
    { int t = 0; t = __builtin_amdgcn_cvt_pk_fp8_f32(v[2].x * sc, v[2].y * sc, t, false); t = __builtin_amdgcn_cvt_pk_fp8_f32(v[2].z * sc, v[2].w * sc, t, true); w.z = (unsigned)t; }
    { int t = 0; t = __builtin_amdgcn_cvt_pk_fp8_f32(v[3].x * sc, v[3].y * sc, t, false); t = __builtin_amdgcn_cvt_pk_fp8_f32(v[3].z * sc, v[3].w * sc, t, true); w.w = (unsigned)t; }
    return w;
}
__device__ __forceinline__ v4u quant16_i8(const f32x4 (&v)[4], float sc) {
    v4u w; w.x = pack4_i8(v[0].x * sc, v[0].y * sc, v[0].z * sc, v[0].w * sc); w.y = pack4_i8(v[1].x * sc, v[1].y * sc, v[1].z * sc, v[1].w * sc);
    w.z = pack4_i8(v[2].x * sc, v[2].y * sc, v[2].z * sc, v[2].w * sc); w.w = pack4_i8(v[3].x * sc, v[3].y * sc, v[3].z * sc, v[3].w * sc); return w;
}
__device__ __forceinline__ void quant_rows2_fp8(const float* srcA, const float* gainA, unsigned char* dstA, float* scA, const float* srcB, unsigned char* dstB, float* scB, int lane) {
    f32x4 va[4], vb[4];
#pragma unroll
    for (int j = 0; j < 4; ++j) { va[j] = ((const GAS f32x4*)srcA + 4 * lane)[j]; vb[j] = ((const GAS f32x4*)srcB + 4 * lane)[j]; }
    float ma = 0.f, mb = 0.f;
#pragma unroll
    for (int j = 0; j < 4; ++j) { va[j] = va[j] * ((const GAS f32x4*)gainA + 4 * lane)[j];
        ma = fmaxf(ma, fmaxf(fmaxf(fabsf(va[j].x), fabsf(va[j].y)), fmaxf(fabsf(va[j].z), fabsf(va[j].w))));
        mb = fmaxf(mb, fmaxf(fmaxf(fabsf(vb[j].x), fabsf(vb[j].y)), fmaxf(fabsf(vb[j].z), fabsf(vb[j].w)))); }
#pragma unroll
    for (int o = 1; o < 64; o <<= 1) { ma = fmaxf(ma, shx(ma, o, lane)); mb = fmaxf(mb, shx(mb, o, lane)); }
    *(GAS v4u*)(dstA + 16 * lane) = quant16_i8(va, ma > 0.f ? 127.0f / ma : 1.0f);
    *(GAS v4u*)(dstB + 16 * lane) = quant16_fp8(vb, mb > 0.f ? 224.0f / mb : 1.0f);
    if (lane == 0) { *scA = ma > 0.f ? ma * (1.0f / 127.0f) : 1.0f; *scB = mb > 0.f ? mb * (1.0f / 224.0f) : 1.0f; }
}
__device__ __forceinline__ void p0_rows4_expert(const float* xrow, unsigned char* orow, float* sc, size_t rstride, size_t sstride,
                                                const float* srcA, const float* gainA, unsigned char* dstA, float* scA, const float* srcB, unsigned char* dstB, float* scB, int lane) {
    f32x4 v[4][4], va[4], vb[4], ga[4]; float s[4], m[4];
#pragma unroll
    for (int k = 0; k < 4; ++k) { const GAS f32x4* xr = (const GAS f32x4*)(xrow + k * rstride) + lane;
#pragma unroll
        for (int j = 0; j < 4; ++j) v[k][j] = xr[64 * j]; }
#pragma unroll
    for (int j = 0; j < 4; ++j) { va[j] = ((const GAS f32x4*)srcA + 4 * lane)[j]; vb[j] = ((const GAS f32x4*)srcB + 4 * lane)[j]; ga[j] = ((const GAS f32x4*)gainA + 4 * lane)[j]; }
#pragma unroll
    for (int k = 0; k < 4; ++k) { s[k] = 0.f; m[k] = 0.f;
#pragma unroll
        for (int j = 0; j < 4; ++j) { s[k] += (v[k][j].x * v[k][j].x + v[k][j].y * v[k][j].y) + (v[k][j].z * v[k][j].z + v[k][j].w * v[k][j].w);
            m[k] = fmaxf(m[k], fmaxf(fmaxf(fabsf(v[k][j].x), fabsf(v[k][j].y)), fmaxf(fabsf(v[k][j].z), fabsf(v[k][j].w)))); } }
    float ma = 0.f, mb = 0.f;
#pragma unroll
    for (int j = 0; j < 4; ++j) { va[j] = va[j] * ga[j];
        ma = fmaxf(ma, fmaxf(fmaxf(fabsf(va[j].x), fabsf(va[j].y)), fmaxf(fabsf(va[j].z), fabsf(va[j].w))));
        mb = fmaxf(mb, fmaxf(fmaxf(fabsf(vb[j].x), fabsf(vb[j].y)), fmaxf(fabsf(vb[j].z), fabsf(vb[j].w)))); }
#pragma unroll
    for (int o = 1; o < 64; o <<= 1) {
#pragma unroll
        for (int k = 0; k < 4; ++k) { s[k] += shx(s[k], o, lane); m[k] = fmaxf(m[k], shx(m[k], o, lane)); }
        ma = fmaxf(ma, shx(ma, o, lane)); mb = fmaxf(mb, shx(mb, o, lane)); }
#pragma unroll
    for (int k = 0; k < 4; ++k) { const float r = 1.f / sqrtf(s[k] * (1.f / DM) + RMS_EPS); const float qs = m[k] > 0.f ? 127.0f / m[k] : 1.0f;
        GAS unsigned* o4 = (GAS unsigned*)(orow + k * rstride) + lane;
#pragma unroll
        for (int j = 0; j < 4; ++j) o4[64 * j] = pack4_i8(v[k][j].x * qs, v[k][j].y * qs, v[k][j].z * qs, v[k][j].w * qs);
        if (lane == 0) sc[k * sstride] = (m[k] > 0.f ? m[k] * (1.0f / 127.0f) : 1.0f) * r; }
    *(GAS v4u*)(dstA + 16 * lane) = quant16_i8(va, ma > 0.f ? 127.0f / ma : 1.0f);
    *(GAS v4u*)(dstB + 16 * lane) = quant16_fp8(vb, mb > 0.f ? 224.0f / mb : 1.0f);
    if (lane == 0) { *scA = ma > 0.f ? ma * (1.0f / 127.0f) : 1.0f; *scB = mb > 0.f ? mb * (1.0f / 224.0f) : 1.0f; }
}
__device__ __forceinline__ void peer_hq_panel(const bf16* X1B, unsigned char* H8p, LAS const float* r1, LAS float* s1h, const int wid0) {
    const int tid = otid(wid0), lane = tid & 63, wid = __builtin_amdgcn_readfirstlane(tid >> 6);
    for (int ti = 0; ti < 16; ++ti) {
        float h[2][16], m[2];
#pragma unroll
        for (int q = 0; q < 2; ++q) { const bf16* xp = X1B + (size_t)(wid * 32 + ti + 16 * q) * DM + 16 * lane; const v4u a = *(const GAS v4u*)xp, b2 = *(const GAS v4u*)(xp + 8); H_UNPACK(h[q], a, b2); }
#pragma unroll
        for (int q = 0; q < 2; ++q) { m[q] = 0.f;
#pragma unroll
            for (int k = 0; k < 16; ++k) m[q] = fmaxf(m[q], fabsf(h[q][k])); }
#pragma unroll
        for (int o = 1; o < 64; o <<= 1) { m[0] = fmaxf(m[0], shx(m[0], o, lane)); m[1] = fmaxf(m[1], shx(m[1], o, lane)); }
#pragma unroll
        for (int q = 0; q < 2; ++q) { const int lrow = wid * 32 + ti + 16 * q; const float sc = m[q] > 0.f ? 127.0f / m[q] : 1.0f;
            v4u w; w.x = pack4_i8(h[q][0] * sc, h[q][1] * sc, h[q][2] * sc, h[q][3] * sc); w.y = pack4_i8(h[q][4] * sc, h[q][5] * sc, h[q][6] * sc, h[q][7] * sc);
            w.z = pack4_i8(h[q][8] * sc, h[q][9] * sc, h[q][10] * sc, h[q][11] * sc); w.w = pack4_i8(h[q][12] * sc, h[q][13] * sc, h[q][14] * sc, h[q][15] * sc);
            *(GAS v4u*)(H8p + (size_t)lrow * DM + 16 * lane) = w;
            if (lane == 0) s1h[lrow] = r1[lrow] * (m[q] > 0.f ? m[q] * (1.0f / 127.0f) : 1.0f); }
    }
}
__device__ __forceinline__ int dot16_i8(const v4u u, const v4u h) {
    int a = __builtin_amdgcn_sdot4((int)u.x, (int)h.x, 0, false), b = __builtin_amdgcn_sdot4((int)u.y, (int)h.y, 0, false);
    a = __builtin_amdgcn_sdot4((int)u.z, (int)h.z, a, false); b = __builtin_amdgcn_sdot4((int)u.w, (int)h.w, b, false);
    return a + b;
}
#define RS_LEVEL_I(v, n, m) do { _Pragma("unroll") for (int _e = 0; _e < (n); ++_e) { const bool _up = (lane & (m)) != 0; const int _send = _up ? v[_e] : v[_e + (n)]; const int _keep = _up ? v[_e + (n)] : v[_e]; v[_e] = _keep + shx(_send, (m), lane); } } while (0)
__device__ __forceinline__ void dq4(unsigned w, float (&f)[4]) {
    const f32x2v lo = __builtin_amdgcn_cvt_pk_f32_fp8((int)w, false), hi = __builtin_amdgcn_cvt_pk_f32_fp8((int)w, true);
    f[0] = lo.x; f[1] = lo.y; f[2] = hi.x; f[3] = hi.y;
}
__device__ __forceinline__ float dot16_fp8(const v4u u, const float (&h)[16]) {
    const f32x2v x0 = __builtin_amdgcn_cvt_pk_f32_fp8((int)u.x, false), x1 = __builtin_amdgcn_cvt_pk_f32_fp8((int)u.x, true);
    const f32x2v y0 = __builtin_amdgcn_cvt_pk_f32_fp8((int)u.y, false), y1 = __builtin_amdgcn_cvt_pk_f32_fp8((int)u.y, true);
    const f32x2v z0 = __builtin_amdgcn_cvt_pk_f32_fp8((int)u.z, false), z1 = __builtin_amdgcn_cvt_pk_f32_fp8((int)u.z, true);
    const f32x2v w0 = __builtin_amdgcn_cvt_pk_f32_fp8((int)u.w, false), w1 = __builtin_amdgcn_cvt_pk_f32_fp8((int)u.w, true);
    f32x2v a = x0 * (f32x2v){h[0], h[1]}, b = x1 * (f32x2v){h[2], h[3]};
    a = __builtin_elementwise_fma(y0, (f32x2v){h[4], h[5]}, a); b = __builtin_elementwise_fma(y1, (f32x2v){h[6], h[7]}, b);
    a = __builtin_elementwise_fma(z0, (f32x2v){h[8], h[9]}, a); b = __builtin_elementwise_fma(z1, (f32x2v){h[10], h[11]}, b);
    a = __builtin_elementwise_fma(w0, (f32x2v){h[12], h[13]}, a); b = __builtin_elementwise_fma(w1, (f32x2v){h[14], h[15]}, b);
    const f32x2v s = a + b;
    return s.x + s.y;
}
__device__ __forceinline__ void fma16_fp8(float (&o)[16], float cf, const v4u v) {
    float f0[4], f1[4], f2[4], f3[4]; dq4(v.x, f0); dq4(v.y, f1); dq4(v.z, f2); dq4(v.w, f3);
#pragma unroll
    for (int k = 0; k < 4; ++k) { o[k] = fmaf(cf, f0[k], o[k]); o[4 + k] = fmaf(cf, f1[k], o[4 + k]); o[8 + k] = fmaf(cf, f2[k], o[8 + k]); o[12 + k] = fmaf(cf, f3[k], o[12 + k]); }
}
__device__ __forceinline__ void fma16_fp8v(f32x2v (&o)[8], float cf, const v4u v) {
    const f32x2v c2 = (f32x2v){cf, cf};
    o[0] = __builtin_elementwise_fma(__builtin_amdgcn_cvt_pk_f32_fp8((int)v.x, false), c2, o[0]); o[1] = __builtin_elementwise_fma(__builtin_amdgcn_cvt_pk_f32_fp8((int)v.x, true), c2, o[1]);
    o[2] = __builtin_elementwise_fma(__builtin_amdgcn_cvt_pk_f32_fp8((int)v.y, false), c2, o[2]); o[3] = __builtin_elementwise_fma(__builtin_amdgcn_cvt_pk_f32_fp8((int)v.y, true), c2, o[3]);
    o[4] = __builtin_elementwise_fma(__builtin_amdgcn_cvt_pk_f32_fp8((int)v.z, false), c2, o[4]); o[5] = __builtin_elementwise_fma(__builtin_amdgcn_cvt_pk_f32_fp8((int)v.z, true), c2, o[5]);
    o[6] = __builtin_elementwise_fma(__builtin_amdgcn_cvt_pk_f32_fp8((int)v.w, false), c2, o[6]); o[7] = __builtin_elementwise_fma(__builtin_amdgcn_cvt_pk_f32_fp8((int)v.w, true), c2, o[7]);
}
__device__ __forceinline__ float gelu_as(float v) {
    const float av = fabsf(v), t = __builtin_amdgcn_rcpf(av * 0.2316418882f + 1.0f);
    float q = t * 0.5307027145f + (-0.7265760135f); q = q * t + 0.7107068705f; q = q * t + (-0.142248368f); q = q * t + 0.127414796f; q = q * t;
    const float e = __builtin_amdgcn_exp2f((v * v) * (-0.72134752044f));
    const float m = v * (q * e);
    return v < 0.f ? m : v - m;
}
#define RS_LEVEL(v, n, m) do { _Pragma("unroll") for (int _e = 0; _e < (n); ++_e) { const bool _up = (lane & (m)) != 0; const float _send = _up ? v[_e] : v[_e + (n)]; const float _keep = _up ? v[_e + (n)] : v[_e]; v[_e] = _keep + shx(_send, m, lane); } } while (0)
#define BS_CE(KV, EOFF, K, J) { const int p_ = shx(KV, J, lane); const bool asc_ = (((lane + (EOFF)) & (K)) == 0); const int mn_ = KV < p_ ? KV : p_, mx_ = KV < p_ ? p_ : KV; KV = (lower_ == asc_) ? mn_ : mx_; }
#define BS_STAGE(K, J) do { const bool lower_ = (lane & (J)) == 0; BS_CE(k0, 0, K, J) BS_CE(k1, 64, K, J) BS_CE(k2, 0, K, J) BS_CE(k3, 64, K, J) } while (0)
__device__ __forceinline__ void peer_sort_panel(int* IDXp, float* GTp, float* SUp, const float* SU, const float* SV, const int wid0) {
    const int tid = otid(wid0), lane = tid & 63, wid = __builtin_amdgcn_readfirstlane(tid >> 6);
    int ni[4]; float ng[4];
#pragma unroll
    for (int q = 0; q < 4; ++q) { const int o = (wid * 32 + (q >> 1) * 16) * 128 + (q & 1) * 64 + lane; ni[q] = IDXp[o]; ng[q] = GTp[o]; }
    for (int ti = 0; ti < 16; ++ti) {
        const int lrow = wid * 32 + ti;
        int ci[4]; float cg[4];
#pragma unroll
        for (int q = 0; q < 4; ++q) { ci[q] = ni[q]; cg[q] = ng[q]; }
        if (ti < 15) {
#pragma unroll
            for (int q = 0; q < 4; ++q) { const int o = (lrow + 1 + (q >> 1) * 16) * 128 + (q & 1) * 64 + lane; ni[q] = IDXp[o]; ng[q] = GTp[o]; } }
        float cu[4], cw[4];
#pragma unroll
        for (int q = 0; q < 4; ++q) { cu[q] = SU[ci[q]]; cw[q] = SV[ci[q]] * cg[q]; }
        int k0 = (ci[0] << 7) | lane, k1 = (ci[1] << 7) | (64 + lane), k2 = (ci[2] << 7) | lane, k3 = (ci[3] << 7) | (64 + lane);
        BS_STAGE(2, 1);
        BS_STAGE(4, 2); BS_STAGE(4, 1);
        BS_STAGE(8, 4); BS_STAGE(8, 2); BS_STAGE(8, 1);
        BS_STAGE(16, 8); BS_STAGE(16, 4); BS_STAGE(16, 2); BS_STAGE(16, 1);
        BS_STAGE(32, 16); BS_STAGE(32, 8); BS_STAGE(32, 4); BS_STAGE(32, 2); BS_STAGE(32, 1);
        BS_STAGE(64, 32); BS_STAGE(64, 16); BS_STAGE(64, 8); BS_STAGE(64, 4); BS_STAGE(64, 2); BS_STAGE(64, 1);
        { const int mn_ = k0 < k1 ? k0 : k1, mx_ = k0 < k1 ? k1 : k0; k0 = mn_; k1 = mx_; }
        { const int mn_ = k2 < k3 ? k2 : k3, mx_ = k2 < k3 ? k3 : k2; k2 = mn_; k3 = mx_; }
        BS_STAGE(128, 32); BS_STAGE(128, 16); BS_STAGE(128, 8); BS_STAGE(128, 4); BS_STAGE(128, 2); BS_STAGE(128, 1);
#define BS_OUT(KA, KB, UA, UB, WA, WB, LR) do { const int s0 = KA & 127, s1 = KB & 127; \
        const float ua0 = shl_(UA, s0 & 63), ub0 = shl_(UB, s0 & 63), ua1 = shl_(UA, s1 & 63), ub1 = shl_(UB, s1 & 63); \
        const float wa0 = shl_(WA, s0 & 63), wb0 = shl_(WB, s0 & 63), wa1 = shl_(WA, s1 & 63), wb1 = shl_(WB, s1 & 63); \
        IDXp[(LR) * 128 + lane] = KA >> 7; IDXp[(LR) * 128 + 64 + lane] = KB >> 7; \
        SUp[(LR) * 128 + lane] = (s0 < 64) ? ua0 : ub0; SUp[(LR) * 128 + 64 + lane] = (s1 < 64) ? ua1 : ub1; \
        GTp[(LR) * 128 + lane] = (s0 < 64) ? wa0 : wb0; GTp[(LR) * 128 + 64 + lane] = (s1 < 64) ? wa1 : wb1; } while (0)
        BS_OUT(k0, k1, cu[0], cu[1], cw[0], cw[1], lrow);
        BS_OUT(k2, k3, cu[2], cu[3], cw[2], cw[3], lrow + 16);
#undef BS_OUT
    }
}
#define DPPC_ROR8 0x128
#define DPPC_SHL4 0x104
#define DPPC_SHR4 0x114
#define DPPC_X2 0x4E
#define DPPC_X1 0xB1
template <int CTRL> __device__ __forceinline__ int dpp_i(int x) { return __builtin_amdgcn_update_dpp(0, x, CTRL, 0xF, 0xF, true); }
__device__ __forceinline__ int dot16_i8c(const v4u u, const v4u h) {
    int a = __builtin_amdgcn_sdot4((int)u.x, (int)h.x, 0, false);
    a = __builtin_amdgcn_sdot4((int)u.y, (int)h.y, a, false); a = __builtin_amdgcn_sdot4((int)u.z, (int)h.z, a, false); a = __builtin_amdgcn_sdot4((int)u.w, (int)h.w, a, false);
    return a;
}
template <int NP>
__device__ __forceinline__ void peer_usweep2_panel(const int dp, const unsigned char* H8p, LAS const float* s1h, const int* IDXp, const float* GMp, const float* SUp, float* CFp, const unsigned char* EU8, const int wid0) {
    constexpr int LG = 64 / NP, TG = 16 / NP, NSTEP = 16 * TG;
    const int wid = wid0;
    const int lane = lane_id();
    const int grp = lane / LG, tq = (lane >> 3) & 1, pj = lane & 7;
    const unsigned kof = (unsigned)(1024 / NP) * (unsigned)dp + 16u * (unsigned)(lane & (LG - 1));
    const int gb4 = (lane & ~(LG - 1)) << 2;
    const bool last = dp == NP - 1;
    int ix_n, pd_n = 0; float gm_n = 0.f, su_n = 0.f; v4u h0_n, h1_n;
#define US2_META(s_) do { const int c_ = (s_) / TG, tg_ = (s_) % TG; const int lr_ = wid * 32 + 2 * NP * tg_ + 2 * grp; const int off_ = (lr_ + tq) * 128 + 8 * c_ + pj; \
        ix_n = IDXp[off_] << 10; \
        if (dp) pd_n = ((const int*)CFp)[off_]; \
        if (last) { gm_n = GMp[off_]; su_n = SUp[off_] * s1h[lr_ + tq]; } \
        const unsigned char* h0_ = H8p + (unsigned)(lr_ * DM) + kof; h0_n = *(const GAS v4u*)h0_; h1_n = *(const GAS v4u*)(h0_ + DM); } while (0)
#ifndef STAG_U
#define STAG_U 40
#endif
    if (STAG_U && wid >= 4) __builtin_amdgcn_s_sleep(STAG_U);
    US2_META(0);
#pragma nounroll
    for (int s = 0; s < NSTEP; ++s) {
        const int ix10 = ix_n, pd = pd_n; const float gm = gm_n, su = su_n; const v4u h0 = h0_n, h1 = h1_n;
        v4u ua[16]; int p[16];
        unsigned exo[16];
#pragma unroll
        for (int j = 0; j < 16; ++j) exo[j] = (unsigned)__builtin_amdgcn_ds_bpermute(gb4 + 4 * j, ix10) + kof;
        asm volatile("" : "+v"(exo[0]), "+v"(exo[1]), "+v"(exo[2]), "+v"(exo[3]), "+v"(exo[4]), "+v"(exo[5]), "+v"(exo[6]), "+v"(exo[7]), "+v"(exo[8]), "+v"(exo[9]), "+v"(exo[10]), "+v"(exo[11]), "+v"(exo[12]), "+v"(exo[13]), "+v"(exo[14]), "+v"(exo[15]));
#pragma unroll
        for (int j = 0; j < 8; ++j) ua[j] = *(const GAS v4u*)(EU8 + exo[j]);
        if (s < NSTEP - 1) US2_META(s + 1);
#pragma unroll
        for (int j = 0; j < 8; ++j) p[j] = dot16_i8c(ua[j], h0);
        asm volatile("" : "+v"(p[0]), "+v"(p[1]), "+v"(p[2]), "+v"(p[3]), "+v"(p[4]), "+v"(p[5]), "+v"(p[6]), "+v"(p[7]) :: "memory");
#pragma unroll
        for (int j = 8; j < 16; ++j) ua[j] = *(const GAS v4u*)(EU8 + exo[j]);
#pragma unroll
        for (int j = 8; j < 16; ++j) p[j] = dot16_i8c(ua[j], h1);
        const bool b3 = (lane & 8) != 0, b2 = (lane & 4) != 0, b1 = (lane & 2) != 0, b0 = (lane & 1) != 0;
#pragma unroll
        for (int e = 0; e < 8; ++e) { const int t = p[e] + dpp_i<DPPC_ROR8>(p[e]), u = p[e + 8] + dpp_i<DPPC_ROR8>(p[e + 8]); p[e] = b3 ? u : t; }
#pragma unroll
        for (int e = 0; e < 4; ++e) { const int t = p[e] + dpp_i<DPPC_SHL4>(p[e]), u = p[e + 4] + dpp_i<DPPC_SHR4>(p[e + 4]); p[e] = b2 ? u : t; }
#pragma unroll
        for (int e = 0; e < 2; ++e) { const int t = p[e] + dpp_i<DPPC_X2>(p[e]), u = p[e + 2] + dpp_i<DPPC_X2>(p[e + 2]); p[e] = b1 ? u : t; }
        int di; { const int t = p[0] + dpp_i<DPPC_X1>(p[0]), u = p[1] + dpp_i<DPPC_X1>(p[1]); di = b0 ? u : t; }
        if (NP == 2) { const auto r = __builtin_amdgcn_permlane16_swap(di, di, false, false); di = (int)r[0] + (int)r[1]; }
        di += pd;
        const int c = s / TG, tg = s % TG;
        const int off = (wid * 32 + 2 * NP * tg + 2 * grp + tq) * 128 + 8 * c + pj;
        const bool st = NP == 4 || (lane & 16) == 0;
        if (!last) { if (st) ((int*)CFp)[off] = di; }
        else { const float act = gelu_as((float)di * su); if (st) CFp[off] = gm * act; }
    }
#undef US2_META
}
__device__ __forceinline__ void peer_vsweep2_panel(int panel, const bf16* X1B, bf16* X2B, LAS float* r3, const int* IDXp, const float* CFp, const unsigned char* EV8, const int wid0) {
    const int wid = wid0;
#ifndef STAG_V
#define STAG_V 40
#endif
    if (STAG_V && wid >= 4) __builtin_amdgcn_s_sleep(STAG_V);
#pragma nounroll
    for (int it = 0; it < 8; ++it) {
        const int dp = it >> 2, g2 = it & 3;
        const int lane = lane_id(); const int half = lane >> 5, li = lane & 31;
        const int lr0 = wid * 32 + 8 * g2;
        const int colb = 512 * dp + 16 * li;
        float o[4][16];
#pragma unroll
        for (int t = 0; t < 4; ++t) { const bf16* xp = X1B + (size_t)(lr0 + 4 * half + t) * DM + colb; const v4u a = *(const GAS v4u*)xp, b2 = *(const GAS v4u*)(xp + 8); H_UNPACK(o[t], a, b2); }
        const int mA = (lr0 + (lane >> 3)) * 128 + (lane & 7);
        int ix_n = IDXp[mA]; float cf_n = CFp[mA];
#pragma nounroll
        for (int c = 0; c < 16; ++c) {
            const int ix = ix_n; const float cf = cf_n;
            const int lane_c = lane_id(); const int half_c = lane_c >> 5;
            if (c < 15) { const int m2 = (lr0 + (lane_c >> 3)) * 128 + (lane_c & 7) + 8 * (c + 1); ix_n = IDXp[m2]; cf_n = CFp[m2]; }
            const int evo = 512 * dp + 16 * (lane_c & 31);
#ifndef VB
#define VB 8
#endif
            const int hb4 = (lane_c & 32) << 2;
            const int ix10 = ix << 10;
            int exo[32];
#pragma unroll
            for (int e = 0; e < 32; ++e) exo[e] = __builtin_amdgcn_ds_bpermute(hb4 + 4 * e, ix10) + evo;
            asm volatile("" : "+v"(exo[0]), "+v"(exo[1]), "+v"(exo[2]), "+v"(exo[3]), "+v"(exo[4]), "+v"(exo[5]), "+v"(exo[6]), "+v"(exo[7]), "+v"(exo[8]), "+v"(exo[9]), "+v"(exo[10]), "+v"(exo[11]), "+v"(exo[12]), "+v"(exo[13]), "+v"(exo[14]), "+v"(exo[15]));
            asm volatile("" : "+v"(exo[16]), "+v"(exo[17]), "+v"(exo[18]), "+v"(exo[19]), "+v"(exo[20]), "+v"(exo[21]), "+v"(exo[22]), "+v"(exo[23]), "+v"(exo[24]), "+v"(exo[25]), "+v"(exo[26]), "+v"(exo[27]), "+v"(exo[28]), "+v"(exo[29]), "+v"(exo[30]), "+v"(exo[31]));
#pragma unroll
            for (int tp = 0; tp < 32 / VB; ++tp) {
                v4u va[VB]; float cs[VB];
#pragma unroll
                for (int i = 0; i < VB; ++i) { const int e = VB * tp + i; va[i] = *(const GAS v4u*)(EV8 + (unsigned)exo[e]); }
#pragma unroll
                for (int i = 0; i < VB; ++i) { const int e = VB * tp + i; cs[i] = __builtin_bit_cast(float, __builtin_amdgcn_ds_bpermute(hb4 + 4 * e, __builtin_bit_cast(int, cf))); }
#pragma unroll
                for (int i = 0; i < VB; ++i) { const int e = VB * tp + i; fma16_fp8(o[e >> 3], cs[i], va[i]); }
            }
        }
        const int lane2 = lane_id(); const int half2 = lane2 >> 5, li2 = lane2 & 31;
#pragma unroll
        for (int t = 0; t < 4; ++t) {
            const int tok = lr0 + 4 * half2 + t;
            float ss = 0.f;
#pragma unroll
            for (int k = 0; k < 16; ++k) ss += o[t][k] * o[t][k];
#pragma unroll
            for (int m = 1; m < 32; m <<= 1) ss += shx(ss, m, lane2);
            if (li2 == 0) { if (dp == 0) r3[tok] = ss; else r3[tok] = 1.f / sqrtf((r3[tok] + ss) * (1.f / DM) + RMS_EPS); }
            v4u ha, hb;
            ha.x = cvtpk(o[t][0], o[t][1]); ha.y = cvtpk(o[t][2], o[t][3]); ha.z = cvtpk(o[t][4], o[t][5]); ha.w = cvtpk(o[t][6], o[t][7]);
            hb.x = cvtpk(o[t][8], o[t][9]); hb.y = cvtpk(o[t][10], o[t][11]); hb.z = cvtpk(o[t][12], o[t][13]); hb.w = cvtpk(o[t][14], o[t][15]);
            bf16* xo = X2B + (size_t)tok * DM + 512 * dp + 16 * li2;
            *(GAS v4u*)xo = ha; *(GAS v4u*)(xo + 8) = hb;
        }
    }
}


struct Args {
    const float *x, *p, *norm_mix, *w_in, *w_att_up, *w_pool_group, *pool_scale, *w_out, *norm_ffn, *w_query, *sub_keys, *expert_u, *expert_v, *norm_ple, *w_ple_gate, *w_ple, *norm_final;
    float* out; unsigned char* ws; int ph_hi, pad;
};

#ifndef REP_P0
#define REP_P0 1
#endif
#ifndef REP_P1
#define REP_P1 1
#endif
#ifndef REP_P23
#define REP_P23 1
#endif
#ifndef REP_P4
#define REP_P4 1
#endif
#ifndef REP_P567
#define REP_P567 1
#endif
#ifndef REP_P9
#define REP_P9 1
#endif
#ifndef REP_ATT
#define REP_ATT 1
#endif
#ifndef REP_TOPK
#define REP_TOPK 1
#endif
#ifndef REP_MRG
#define REP_MRG 1
#endif
#ifndef MK_PH_HI
#define MK_PH_HI 99
#endif

typedef const __attribute__((address_space(4))) Args* CArgs;
__device__ __forceinline__ CArgs kargs() { CArgs p = (CArgs)__builtin_amdgcn_kernarg_segment_ptr(); asm volatile("" : "+s"(p)); return p; }
#define WSP(T, off) ((T*)(kargs()->ws + (off)))
__global__ void __launch_bounds__(NTHR, 2) mega_fwd(Args a_unused) {
    extern __shared__ __attribute__((aligned(16))) unsigned char lds_raw[];
    LAS unsigned char* lds = (LAS unsigned char*)lds_raw;
    volatile LAS unsigned* MISC = (volatile LAS unsigned*)(lds + MISC_OFF);
    const int G = gridDim.x; const int bx = blockIdx.x;
    const int vcu = (G % 8 == 0) ? (bx % 8) * (G / 8) + bx / 8 : bx;
    gu32* ctl = (gu32*)(kargs()->ws + WS_CTL);
    const int wid0 = __builtin_amdgcn_readfirstlane((int)threadIdx.x >> 6);
#define IS_T0 (otid(wid0) == 0)
    for (int u = otid(wid0); u < (LDS_BYTES - LDSCTL_OFF) / 4; u += NTHR) ((LAS unsigned*)(lds + LDSCTL_OFF))[u] = 0u;
    __syncthreads();
    (void)xcd_barrier_post((unsigned*)(ctl + CW_BAR), MISC + 8, IS_T0);
#define GRID_BAR() do { XcdBarrier _b; _b.bar = (unsigned*)((gu32*)(kargs()->ws + WS_CTL) + CW_BAR); _b.x = xb_xcc_id(); _b.st = (volatile LAS unsigned*)(lds + MISC_OFF) + 8; xcd_barrier(_b, IS_T0); } while (0)
    LAS float* const SS1 = (LAS float*)(lds + LDSCTL_OFF + 1024);
    LAS float* const R3 = (LAS float*)(lds + LDSCTL_OFF + 2048);
    LAS float* const SSF = (LAS float*)(lds + LDSCTL_OFF + 3072);
    LAS float* const S1H = (LAS float*)(lds + LDSCTL_OFF + 4096);
#define LOCAL_SEAM() do { VM_WAIT(); __syncthreads(); if (IS_T0) { __builtin_amdgcn_fence(__ATOMIC_ACQUIRE, "agent"); VM_WAIT(); } __syncthreads(); } while (0)

    for (int rep_ = 0; rep_ < REP_P0; ++rep_) {
        const int tid = otid(wid0), lane = tid & 63, wid = __builtin_amdgcn_readfirstlane(tid >> 6);
        const CArgs a = kargs(); unsigned char* ws = a->ws;
        bf16 *WIN = (bf16*)(ws + WS_WIN), *WOUT = (bf16*)(ws + WS_WOUT), *WQ = (bf16*)(ws + WS_WQ), *WPG = (bf16*)(ws + WS_WPG), *WPLE = (bf16*)(ws + WS_WPLE);
        bf16 *BD2 = (bf16*)(ws + WS_BD2), *SK = (bf16*)(ws + WS_SK), *XN = (bf16*)(ws + WS_XN);
        LAS float* scr = (LAS float*)(lds + wid * 16384);
        const int gw = vcu * NWAVES + wid, NGW = G * NWAVES;
        unsigned* const CMAX = (unsigned*)((gu32*)(ws + WS_CTL) + CW_CMAX);
        constexpr int A_IN = 32 * (4096 / 64), A_Q = 32 * (2048 / 64), A_G = 32 * (1024 / 64);
        for (int it = gw; it < A_IN + A_Q + A_G; it += NGW) {
            if (it < A_IN) p0_colmax_item(a->w_in, 4096, CMAX, a->norm_mix, 512, C2, it, lane);
            else if (it < A_IN + A_Q) p0_colmax_item(a->w_query, 2048, CMAX + 4096, a->norm_ffn, 0, 1.f, it - A_IN, lane);
            else p0_colmax_item(a->w_ple_gate, 1024, CMAX + 6144, a->norm_ple, 0, 1.f, it - A_IN - A_Q, lane);
        }
        constexpr int I_OUT = (1024 / 64) * (1024 / 32), I_PLE = (256 / 64) * (1024 / 32);
        constexpr int NITEMS = I_OUT + I_PLE;
        for (int it = gw; it < NITEMS; it += NGW) {
            int r = it;
            if (r < I_OUT) { p0_transpose_item(a->w_out, 1024, 1024, WOUT, nullptr, 0, 1.f, scr, r, lane); continue; } r -= I_OUT;
            p0_transpose_item(a->w_ple, 256, 1024, WPLE, nullptr, 0, 1.f, scr, r, lane);
        }
        const int gt = vcu * NTHR + tid, NGT = G * NTHR;
        for (int it = gt; it < 2048 * 32; it += NGT) {
            const int rr = it >> 5, k8 = (it & 31) * 8, ti = rr >> 8, r = rr & 255, n = 256 * (ti & 3) + 128 * (ti >> 2) + (r & 127), head = n >> 7, g = n >> 8;
            float v[8];
#pragma unroll
            for (int j = 0; j < 8; ++j) { const int k = (k8 + j) & 127;
                if (r < 128) v[j] = (k8 < 128 && (k >> 6) == (head & 1)) ? a->w_att_up[((size_t)head * 64 + (k & 63)) * 128 + (n & 127)] : 0.f;
                else v[j] = (k8 >= 128) ? a->w_pool_group[((size_t)g * 128 + k) * 256 + (n & 255)] * a->pool_scale[n] : 0.f; }
            v4u o; o.x = pk2(v[0], v[1]); o.y = pk2(v[2], v[3]); o.z = pk2(v[4], v[5]); o.w = pk2(v[6], v[7]);
            *(GAS v4u*)(BD2 + (size_t)rr * 256 + k8) = o;
        }
        for (int it = gt; it < 16 * 128 * 128 / 8; it += NGT) cvt8_store(a->sub_keys + (size_t)it * 8, SK + (size_t)it * 8);
        { const int panel = bx;
            for (int r = wid, e = gw; r < 64; r += NWAVES, e += NGW) { const size_t row = (size_t)panel * 256 + r;
                p0_rows4_expert(a->x + row * DM, ws + WS_XN + row * DM, (float*)(ws + WS_SX) + row, (size_t)64 * DM, 64,
                                a->expert_u + (size_t)e * DM, a->norm_ffn, ws + WS_EU + (size_t)e * DM, (float*)(ws + WS_SU) + e, a->expert_v + (size_t)e * DM, ws + WS_EV + (size_t)e * DM, (float*)(ws + WS_SV) + e, lane); } }
    }
    GRID_BAR();
    {
        const int tid = otid(wid0), lane = tid & 63, wid = __builtin_amdgcn_readfirstlane(tid >> 6);
        const CArgs a = kargs(); unsigned char* ws = a->ws;
        LAS float* scr = (LAS float*)(lds + wid * 16384);
        const int gw = vcu * NWAVES + wid, NGW = G * NWAVES;
        const unsigned* CMAX = (const unsigned*)((gu32*)(ws + WS_CTL) + CW_CMAX);
        constexpr int B_IN = 16 * (4096 / 32), B_Q = 16 * (2048 / 32), B_G = 16 * (1024 / 32);
        for (int it = gw; it < B_IN + B_Q + B_G; it += NGW) {
            if (it < B_IN) p0_quant_tile_item(a->w_in, 4096, ws + WS_WIN, (float*)(ws + WS_SBN), CMAX, a->norm_mix, 512, C2, scr, it, lane);
            else if (it < B_IN + B_Q) p0_quant_tile_item(a->w_query, 2048, ws + WS_WQ, (float*)(ws + WS_SBQ), CMAX + 4096, a->norm_ffn, 0, 1.f, scr, it - B_IN, lane);
            else p0_quant_tile_item(a->w_ple_gate, 1024, ws + WS_WPG, (float*)(ws + WS_SBG), CMAX + 6144, a->norm_ple, 0, 1.f, scr, it - B_IN - B_Q, lane);
        }
    }
    GRID_BAR();

    for (int rep_ = 0; rep_ < REP_P1; ++rep_) {
        const int xg = bx & 7, ig = bx >> 3, ug = ig >> 3;
#pragma nounroll
        for (int ph = 0; ph < 4; ++ph) {
            const int panel = xg + 8 * (8 * ph + (ig & 7));
            { pg8::Gemm g{WSP(bf16, WS_XN), WSP(bf16, WS_WIN), 1024, 1024, 1024, 0, 0, 1, 0}; pg8::PanelSched S{panel, ug < 3 ? 4 : 2, 4, 2, 0, 4 * ug};
              pg8::EpiProjI8 E{WSP(bf16, WS_PQ), WSP(bf16, WS_PK), WSP(bf16, WS_PU), WSP(bf16, WS_PG), WSP(float, WS_SX), WSP(float, WS_SBN)};
              pg8::gemm_phase_i8<pg8::EpiProjI8, pg8::PanelSched, true, true>(lds, g, S, E, wid0); }
            if (ug == 3) { pg8::Gemm g{(const bf16*)(kargs()->ws + WS_WIN + (size_t)1024 * 1024), WSP(bf16, WS_XN), 1024, 1024, 1024, 0, 0, 1, 0}; pg8::PanelSched S{panel, 2, 99, 0, 1, 0};
              pg8::EpiPlainI8 E{WSP(bf16, WS_PVT), TOK, WSP(float, WS_SBN) + 1024, WSP(float, WS_SX)};
              pg8::gemm_phase_i8<pg8::EpiPlainI8, pg8::PanelSched, true, true>(lds, g, S, E, wid0); }
        }
    }
    GRID_BAR();


#define H8P ((unsigned char*)(kargs()->ws + WS_MG + (size_t)panel * 524288 + 262144))
    { const int panel = bx;
        const size_t prow = (size_t)panel * 256;
        for (int rep_ = 0; rep_ < REP_P23; ++rep_) {
        if (MK_PH_HI > 2) { for (int r2_ = 0; r2_ < REP_ATT; ++r2_) attn_panel(panel, WSP(bf16, WS_PQ), WSP(bf16, WS_PK), WSP(bf16, WS_PVT), WSP(bf16, WS_YA), wid0); pool_panel(panel, WSP(bf16, WS_PU), WSP(bf16, WS_YA), wid0); LOCAL_SEAM(); }
        for (int r2_ = 0; r2_ < REP_MRG; ++r2_)
        if (MK_PH_HI > 3) {
            { pg8::Gemm g{WSP(bf16, WS_YA), WSP(bf16, WS_BD2), 256, 1024, 256, 256, 0, 1, 0}; pg8::PanelSched S{panel, 8, 99, 0, 0}; pg8::EpiMerge2 E{WSP(unsigned char, WS_PG), WSP(bf16, WS_MG)};
              pg8::gemm_phase<pg8::EpiMerge2, pg8::PanelSched, true, true>(lds, g, S, E, wid0); }
            LOCAL_SEAM();
        }
        }
        for (int rep_ = 0; rep_ < REP_P4; ++rep_)
        if (MK_PH_HI > 4) {
            { pg8::Gemm g{WSP(bf16, WS_MG), WSP(bf16, WS_WOUT), 1024, 1024, 1024, 0, 0, 1, 0}; pg8::PanelSched S{panel, 4, 99, 0, 0}; pg8::EpiRes E{kargs()->x, (bf16*)kargs()->out, SS1};
              pg8::gemm_phase<pg8::EpiRes, pg8::PanelSched, true, true>(lds, g, S, E, wid0); }
            LOCAL_SEAM();
        }
        { { const int t_ = otid(wid0); if (t_ < 256) SS1[t_] = 1.f / sqrtf(SS1[t_] * (1.f / DM) + RMS_EPS); } __syncthreads(); }
#ifndef REP_WQ
#define REP_WQ 1
#endif
        for (int rq_ = 0; rq_ < REP_WQ; ++rq_) {
        if (MK_PH_HI > 6) { peer_hq_panel((const bf16*)kargs()->out + (size_t)panel * 524288, H8P, SS1, S1H, wid0); LOCAL_SEAM(); }
        {
        if (MK_PH_HI > 6) {
            { pg8::Gemm g{(const bf16*)(kargs()->ws + WS_MG + 262144), WSP(bf16, WS_WQ), 1024, 1024, 1024, 0, 0, 2, 0}; pg8::PanelSched S{panel, 8, 99, 0, 0};
              pg8::EpiPlainScaleI8 E{WSP(bf16, WS_PG), 2048, S1H, WSP(float, WS_SBQ)};
              pg8::gemm_phase_i8<pg8::EpiPlainScaleI8, pg8::PanelSched, true, true>(lds, g, S, E, wid0); }
            LOCAL_SEAM();
        }
        } }
        {
        #define IDXP ((int*)(kargs()->ws + WS_YA + (size_t)panel * 524288))
#define GTP ((float*)(kargs()->ws + WS_YA + (size_t)panel * 524288 + 131072))
        if (MK_PH_HI > 7) { for (int r2_ = 0; r2_ < REP_TOPK; ++r2_) topk_panel(panel, WSP(bf16, WS_PG), WSP(bf16, WS_SK), IDXP, GTP, lds, wid0); LOCAL_SEAM(); }
        }
#ifndef PEER_SWEEP
#define PEER_SWEEP 1
#endif
#define CFP ((float*)(kargs()->ws + WS_YA + (size_t)panel * 524288 + 262144))
#define SUSP ((float*)(kargs()->ws + WS_MG + (size_t)panel * 524288))
        if (MK_PH_HI > 8) {
            if (PEER_SWEEP) {
#ifndef REP_SORT
#define REP_SORT 1
#endif
                for (int rs_ = 0; rs_ < REP_SORT; ++rs_) { peer_sort_panel(IDXP, GTP, SUSP, WSP(float, WS_SU), WSP(float, WS_SV), wid0); LOCAL_SEAM(); }
#ifndef REP_U
#define REP_U 1
#endif
#ifndef REP_V
#define REP_V 1
#endif
#ifndef UNP
#define UNP 2
#endif
                for (int ru_ = 0; ru_ < REP_U; ++ru_) {
#pragma nounroll
                    for (int dpu = 0; dpu < UNP; ++dpu) { peer_usweep2_panel<UNP>(dpu, H8P, S1H, IDXP, GTP, SUSP, CFP, WSP(unsigned char, WS_EU), wid0); LOCAL_SEAM(); } }
                for (int rv_ = 0; rv_ < REP_V; ++rv_)
                    peer_vsweep2_panel(panel, (const bf16*)kargs()->out + (size_t)panel * 524288, WSP(bf16, WS_PG) + (size_t)panel * 524288, R3, IDXP, CFP, WSP(unsigned char, WS_EV), wid0);
                LOCAL_SEAM();
            }
        }
        for (int rep_ = 0; rep_ < REP_P9; ++rep_)
        if (MK_PH_HI > 9) {
#define PBP ((bf16*)(kargs()->ws + WS_YA + (size_t)panel * 524288 + 393216))
            { const int tid = otid(wid0); const float* pp = kargs()->p; bf16* PB = PBP; for (int it = tid; it < 256 * 256 / 8; it += NTHR) { const int r = it >> 5, c8 = (it & 31) * 8; cvt8_store(pp + (prow + r) * 256 + c8, PB + r * 256 + c8); } }
            LOCAL_SEAM();
            { pg8::Gemm g{(const bf16*)(kargs()->ws + WS_YA + 393216), WSP(bf16, WS_WPLE), 256, 256, 256, 0, 0, 4, 0}; pg8::PanelSched S{panel, 4, 99, 0, 0};
              pg8::EpiPlain E{WSP(bf16, WS_MG), 1024};
              pg8::gemm_phase<pg8::EpiPlain, pg8::PanelSched, true, true>(lds, g, S, E, wid0); }
            LOCAL_SEAM();
        }
        if (MK_PH_HI > 10) {
#define X2I8 ((unsigned char*)(kargs()->ws + WS_PG + (size_t)panel * 1048576 + 524288))
            peer_hq_panel(WSP(bf16, WS_PG) + (size_t)panel * 524288, X2I8, R3, S1H, wid0); LOCAL_SEAM();
            { pg8::Gemm g{(const bf16*)(kargs()->ws + WS_PG + 524288), WSP(bf16, WS_WPG), 1024, 1024, 1024, 0, 0, 4, 0}; pg8::PanelSched S{panel, 4, 99, 0, 0};
              pg8::EpiGateI8 E{WSP(bf16, WS_YA), WSP(bf16, WS_PG), WSP(bf16, WS_MG), S1H, WSP(float, WS_SBG), SSF};
              pg8::gemm_phase_i8<pg8::EpiGateI8, pg8::PanelSched, true, true>(lds, g, S, E, wid0); }
            LOCAL_SEAM();
        }
        if (MK_PH_HI > 11) {
            const int tid = otid(wid0), lane = tid & 63, wid = __builtin_amdgcn_readfirstlane(tid >> 6);
            const GAS f32x4* gr = (const GAS f32x4*)kargs()->norm_final + lane;
            f32x4 gg[4];
#pragma unroll
            for (int j = 0; j < 4; ++j) gg[j] = gr[64 * j];
            const bf16* x3a = WSP(bf16, WS_YA);
            for (int r = wid; r < 64; r += NWAVES) {
                v2u v[4][4]; float rr[4];
#pragma unroll
                for (int k = 0; k < 4; ++k) { const bf16* xr = x3a + (prow + r + 64 * k) * 1024 + 4 * lane; rr[k] = 1.f / sqrtf(SSF[r + 64 * k] * (1.f / DM) + RMS_EPS);
#pragma unroll
                    for (int j = 0; j < 4; ++j) v[k][j] = *(const GAS v2u*)(xr + 256 * j); }
#pragma unroll
                for (int k = 0; k < 4; ++k) { GAS f32x4* xw = (GAS f32x4*)(kargs()->out + (prow + r + 64 * k) * DM) + lane;
#pragma unroll
                    for (int j = 0; j < 4; ++j) { f32x4 f; f[0] = bflo(v[k][j].x); f[1] = bfhi(v[k][j].x); f[2] = bflo(v[k][j].y); f[3] = bfhi(v[k][j].y); xw[64 * j] = f * rr[k] * gg[j]; } }
            }
        }
    }
#undef LOCAL_SEAM
}


extern "C" void kernel_launch(void* const* d_in, const int* in_sizes, int n_in, void* d_out, int out_size, void* d_ws, size_t ws_size, hipStream_t stream) {
    static int grid = 0;
    if (grid == 0) {
        if (n_in != 17 || in_sizes[0] != TOK * DM || out_size != TOK * DM || ws_size < WS_END) { fprintf(stderr, "kernel_launch: unexpected shapes (n_in %d, in0 %d, out %d, ws %zu); nothing launched\n", n_in, n_in > 0 ? in_sizes[0] : -1, out_size, ws_size); grid = -1; return; }
        int dev = 0, cus = 0;
        if (hipGetDevice(&dev) != hipSuccess || hipDeviceGetAttribute(&cus, hipDeviceAttributeMultiprocessorCount, dev) != hipSuccess) { fprintf(stderr, "kernel_launch: device query failed\n"); grid = -1; return; }
        if (hipFuncSetAttribute((const void*)mega_fwd, hipFuncAttributeMaxDynamicSharedMemorySize, LDS_BYTES) != hipSuccess) { fprintf(stderr, "kernel_launch: hipFuncSetAttribute failed\n"); grid = -1; return; }
        int per_cu = 0;
        if (hipOccupancyMaxActiveBlocksPerMultiprocessor(&per_cu, (const void*)mega_fwd, NTHR, LDS_BYTES) != hipSuccess || per_cu < 1) fprintf(stderr, "kernel_launch: note: occupancy query reports %d workgroups per CU\n", per_cu);
        (void)hipGetLastError();
        if (cus != NPANEL) fprintf(stderr, "kernel_launch: note: %d CUs; this kernel is built for one 256-token panel per CU on a 256-CU device\n", cus);
        grid = NPANEL;
    }
    if (grid < 0) return;
    if (hipMemsetAsync((char*)d_ws + WS_CTL, 0, CTL_ZERO_BYTES, stream) != hipSuccess) { fprintf(stderr, "kernel_launch: memset failed\n"); return; }
    Args a{};
    a.x = (const float*)d_in[0]; a.p = (const float*)d_in[1]; a.norm_mix = (const float*)d_in[2]; a.w_in = (const float*)d_in[3]; a.w_att_up = (const float*)d_in[4];
    a.w_pool_group = (const float*)d_in[5]; a.pool_scale = (const float*)d_in[6]; a.w_out = (const float*)d_in[7]; a.norm_ffn = (const float*)d_in[8]; a.w_query = (const float*)d_in[9];
    a.sub_keys = (const float*)d_in[10]; a.expert_u = (const float*)d_in[11]; a.expert_v = (const float*)d_in[12]; a.norm_ple = (const float*)d_in[13]; a.w_ple_gate = (const float*)d_in[14];
    a.w_ple = (const float*)d_in[15]; a.norm_final = (const float*)d_in[16];
    a.out = (float*)d_out; a.ws = (unsigned char*)d_ws; a.ph_hi = MK_PH_HI; a.pad = 0;
    hipLaunchKernelGGL(mega_fwd, dim3(grid), dim3(NTHR), LDS_BYTES, stream, a);
    { const hipError_t le = hipPeekAtLastError(); if (le != hipSuccess) fprintf(stderr, "kernel_launch: launch failed: %s\n", hipGetErrorName(le)); }
}
```

```cpp
#include <hip/hip_runtime.h>
#include <cstdio>
#include <cstdint>
#include <math.h>
__device__ __forceinline__ int lane_id() { int l; asm volatile("v_mbcnt_lo_u32_b32 %0, -1, 0\n\tv_mbcnt_hi_u32_b32 %0, -1, %0" : "=v"(l)); return l; }
__device__ __forceinline__ int otid(int wid0) { return (wid0 << 6) | lane_id(); }

namespace pg8 {
#define PG8_LAS __attribute__((address_space(3)))
typedef unsigned short bf16_t;
typedef short bf16x8 __attribute__((ext_vector_type(8)));
typedef float f32x4 __attribute__((ext_vector_type(4)));
typedef unsigned u32x4 __attribute__((ext_vector_type(4)));
typedef int i32x4 __attribute__((ext_vector_type(4)));
constexpr int BM = 256, BK = 64, HALF = 128, HTB = HALF * BK * 2  , STAGE_BYTES = 8 * HTB, NXCD = 8, WGM = 8;

__host__ __device__ __forceinline__ int lds_byte(int r, int c) { const int st = (r >> 4) * 2 + (c >> 5), rr = r & 15, cc = c & 31, ob = rr * 64 + cc * 2; return st * 1024 + (ob ^ (((ob >> 9) & 1) << 5)); }
__host__ __device__ __forceinline__ void stage_rc(int b, int& R, int& C) { const int st = b / 1024, sb = b % 1024, swz = sb ^ (((sb >> 9) & 1) << 5); R = (st >> 1) * 16 + swz / 64; C = (st & 1) * 32 + (swz % 64) / 2; }
__host__ __device__ __forceinline__ int perm32(int rho) { const int n = rho >> 4, i = rho & 15; return 8 * (i >> 2) + 4 * n + (i & 3); }

struct Unit { int pm, pn; };
struct Gemm { const bf16_t* A; const bf16_t* Bt; int K, lda, ldb, akoff; long a2off; int am, pad_; };

struct StaticOrder {
    int nM, nN, nwg, G, c;
    __host__ __device__ void init(int M, int N, int G_, int c_) { nM = M / BM; nN = N / BM; nwg = nM * nN; G = G_; c = c_; }
    __host__ __device__ bool next(int i, Unit& u) const {
        const long L = (long)i * G + c; if (L >= nwg) return false;
        int wgid = (int)L; { const int q = nwg / NXCD, r = nwg % NXCD, xcd = wgid % NXCD, off = wgid / NXCD; wgid = (xcd < r ? xcd * (q + 1) : r * (q + 1) + (xcd - r) * q) + off; }
        const int nig = WGM * nN, gid = wgid / nig, fm = gid * WGM, gsz = (nM - fm) < WGM ? (nM - fm) : WGM;
        u.pm = fm + ((wgid % nig) % gsz); u.pn = (wgid % nig) / gsz; return true;
    }
    __device__ __forceinline__ void a_ready(const Unit&) const {}
    __device__ __forceinline__ void done(const Unit&) const {}
};

template <class Epi, class Sched, bool ALIGN_EPI = false, bool SP2 = false>
__device__ __forceinline__ void gemm_phase(PG8_LAS unsigned char* lds, const Gemm g, const Sched& S, const Epi& E, const int wid0) {
    const int tid = otid(wid0), wid = __builtin_amdgcn_readfirstlane(tid >> 6), lane = tid & 63, wr = wid >> 2, wc = wid & 3, fr = lane & 15, fq = lane >> 4;
    const int K = g.K, nt = K / BK;
    unsigned voffA[2], voffB[2];
#pragma unroll
    for (int i = 0; i < 2; ++i) { int R, C; stage_rc(tid * 16 + i * 8192, R, C); const int Rb = Epi::PERM ? ((R & ~31) + perm32(R & 31)) : R;
        voffA[i] = (unsigned)(R * g.lda + C) * 2u; voffB[i] = (unsigned)(Rb * g.ldb + C) * 2u; }
    const size_t kstep = (size_t)(BK * 2);
    const size_t hstepA = (size_t)HALF * g.lda * 2, hstepB = (size_t)HALF * g.ldb * 2;
    const size_t tstepA = 2 * hstepA, tstepB = 2 * hstepB, akb = (size_t)g.akoff * 2, a2b = (size_t)g.a2off * 2;
    const unsigned ldsw = (unsigned)wid * 1024u;
    const int aoff = lds_byte(wr * 64 + fr, fq * 8), boff = lds_byte(wc * 32 + fr, fq * 8);
#define PG8_SA(b, h) (((b) * 2 + (h)) * HTB)
#define PG8_SB(b, h) ((4 + (b) * 2 + (h)) * HTB)
#define PG8_STAGE(bufoff, gbase, voff) do { _Pragma("unroll") for (int _i = 0; _i < 2; ++_i) \
        __builtin_amdgcn_global_load_lds((const unsigned*)((const char*)(gbase) + (voff)[_i]), (PG8_LAS unsigned*)(lds + (bufoff) + ldsw + _i * 8192), 16, 0, 0); } while (0)
#define PG8_LDA(dst, b, h) do { _Pragma("unroll") for (int m = 0; m < 4; ++m) _Pragma("unroll") for (int k = 0; k < 2; ++k) dst[m][k] = *(const PG8_LAS bf16x8*)(lds + PG8_SA(b, h) + aoff + m * 2048 + k * 1024); } while (0)
#define PG8_LDB(dst, b, h) do { _Pragma("unroll") for (int n = 0; n < 2; ++n) _Pragma("unroll") for (int k = 0; k < 2; ++k) dst[n][k] = *(const PG8_LAS bf16x8*)(lds + PG8_SB(b, h) + boff + n * 2048 + k * 1024); } while (0)
#define PG8_MMA(ai, bj, At, Bt) do { __builtin_amdgcn_s_setprio(1); _Pragma("unroll") for (int m = 0; m < 4; ++m) _Pragma("unroll") for (int n = 0; n < 2; ++n) _Pragma("unroll") for (int k = 0; k < 2; ++k) \
        acc[ai][bj][m][n] = __builtin_amdgcn_mfma_f32_16x16x32_bf16(Bt[n][k], At[m][k], acc[ai][bj][m][n], 0, 0, 0); __builtin_amdgcn_s_setprio(0); } while (0)
#define PG8_WAIT_V(n) asm volatile("s_waitcnt vmcnt(" #n ")" ::: "memory")
#define PG8_WAIT_L(n) asm volatile("s_waitcnt lgkmcnt(" #n ")" ::: "memory")
#define PG8_BAR __builtin_amdgcn_s_barrier()
#define PG8_SCHED __builtin_amdgcn_sched_barrier(0)
    Unit cur, nxt; int ui = 0;
    if (!S.next(0, cur)) return;
    f32x4 acc[2][2][4][2];
#pragma unroll
    for (int a = 0; a < 2; ++a)
#pragma unroll
        for (int b = 0; b < 2; ++b)
#pragma unroll
            for (int m = 0; m < 4; ++m)
#pragma unroll
                for (int n = 0; n < 2; ++n) acc[a][b][m][n] = (f32x4){0.f, 0.f, 0.f, 0.f};
    bf16x8 At[4][2], B0[2][2], B1[2][2];
    const char* cA = (const char*)g.A + (size_t)(cur.pm * g.am) * tstepA + (size_t)(cur.pn & 3) * akb + (size_t)(cur.pn >> 2) * a2b; const char* cB = (const char*)g.Bt + (size_t)cur.pn * tstepB;
    S.a_ready(cur);
    if constexpr (SP2) {
        PG8_STAGE(PG8_SB(0, 0), cB, voffB); PG8_STAGE(PG8_SB(0, 1), cB + hstepB, voffB); PG8_STAGE(PG8_SA(0, 0), cA, voffA); PG8_STAGE(PG8_SA(0, 1), cA + hstepA, voffA);
        if (wr == 1) PG8_BAR;
        PG8_WAIT_V(2); PG8_BAR;
        PG8_STAGE(PG8_SB(1, 0), cB + kstep, voffB); PG8_STAGE(PG8_SA(1, 0), cA + kstep, voffA); PG8_STAGE(PG8_SB(1, 1), cB + hstepB + kstep, voffB);
        PG8_WAIT_V(6); PG8_BAR;
    } else {
        PG8_STAGE(PG8_SB(0, 0), cB, voffB); PG8_STAGE(PG8_SA(0, 0), cA, voffA); PG8_STAGE(PG8_SB(0, 1), cB + hstepB, voffB); PG8_STAGE(PG8_SA(0, 1), cA + hstepA, voffA);
        if (wr == 1) PG8_BAR;
        PG8_WAIT_V(4); PG8_BAR;
        PG8_STAGE(PG8_SB(1, 0), cB + kstep, voffB); PG8_STAGE(PG8_SA(1, 0), cA + kstep, voffA); PG8_STAGE(PG8_SB(1, 1), cB + hstepB + kstep, voffB);
        PG8_WAIT_V(6); PG8_BAR;
    }
    for (;;) {
        const bool has_next = S.next(ui + 1, nxt);
        const char* nA = has_next ? (const char*)g.A + (size_t)(nxt.pm * g.am) * tstepA + (size_t)(nxt.pn & 3) * akb + (size_t)(nxt.pn >> 2) * a2b : cA; const char* nB = has_next ? (const char*)g.Bt + (size_t)nxt.pn * tstepB : cB;
        for (int t = 0; t < nt; t += 2) {
            const bool last = (t == nt - 2);
            const char* a1 = cA + (size_t)(t + 1) * kstep;
            const char* a2 = last ? nA : cA + (size_t)(t + 2) * kstep; const char* b2 = last ? nB : cB + (size_t)(t + 2) * kstep;
            const char* a3 = a2 + kstep; const char* b3 = b2 + kstep;
            if (last && has_next) S.a_ready(nxt);
            if constexpr (SP2) {
            PG8_LDB(B0, 0, 0); PG8_LDB(B1, 0, 1); PG8_SCHED; PG8_LDA(At, 0, 0); PG8_STAGE(PG8_SA(1, 1), a1 + hstepA, voffA);
            PG8_WAIT_V(8); PG8_WAIT_L(0); PG8_BAR; PG8_MMA(0, 0, At, B0); PG8_MMA(0, 1, At, B1); PG8_BAR; PG8_SCHED;
            PG8_LDA(At, 0, 1); PG8_STAGE(PG8_SB(0, 0), b2, voffB); PG8_STAGE(PG8_SB(0, 1), b2 + hstepB, voffB); PG8_STAGE(PG8_SA(0, 0), a2, voffA);
            PG8_WAIT_V(8); PG8_WAIT_L(0); PG8_BAR; PG8_MMA(1, 0, At, B0); PG8_MMA(1, 1, At, B1); PG8_BAR; PG8_SCHED;
            PG8_LDB(B0, 1, 0); PG8_LDB(B1, 1, 1); PG8_SCHED; PG8_LDA(At, 1, 0); PG8_STAGE(PG8_SA(0, 1), a2 + hstepA, voffA);
            PG8_WAIT_V(8); PG8_WAIT_L(0); PG8_BAR; PG8_MMA(0, 0, At, B0); PG8_MMA(0, 1, At, B1); PG8_BAR; PG8_SCHED;
            PG8_LDA(At, 1, 1); PG8_STAGE(PG8_SB(1, 0), b3, voffB); PG8_STAGE(PG8_SB(1, 1), b3 + hstepB, voffB); PG8_STAGE(PG8_SA(1, 0), a3, voffA);
            PG8_WAIT_V(8); PG8_WAIT_L(0); PG8_BAR; PG8_MMA(1, 0, At, B0); PG8_MMA(1, 1, At, B1); PG8_BAR; PG8_SCHED;
            } else {
            PG8_LDB(B0, 0, 0); PG8_SCHED; PG8_LDA(At, 0, 0); PG8_STAGE(PG8_SA(1, 1), a1 + hstepA, voffA);
            PG8_WAIT_L(8); PG8_BAR; PG8_WAIT_L(0); PG8_MMA(0, 0, At, B0); PG8_BAR; PG8_SCHED;
            PG8_LDB(B1, 0, 1); PG8_STAGE(PG8_SB(0, 0), b2, voffB);
            PG8_BAR; PG8_WAIT_L(0); PG8_MMA(0, 1, At, B1); PG8_BAR;
            PG8_LDA(At, 0, 1); PG8_STAGE(PG8_SA(0, 0), a2, voffA);
            PG8_BAR; PG8_WAIT_L(0); PG8_MMA(1, 0, At, B0); PG8_BAR; PG8_SCHED;
            PG8_STAGE(PG8_SB(0, 1), b2 + hstepB, voffB);
            PG8_WAIT_V(6); PG8_BAR; PG8_MMA(1, 1, At, B1); PG8_BAR;
            PG8_LDB(B0, 1, 0); PG8_SCHED; PG8_LDA(At, 1, 0); PG8_STAGE(PG8_SA(0, 1), a2 + hstepA, voffA);
            PG8_WAIT_L(8); PG8_BAR; PG8_WAIT_L(0); PG8_MMA(0, 0, At, B0); PG8_BAR; PG8_SCHED;
            PG8_LDB(B1, 1, 1); PG8_STAGE(PG8_SB(1, 0), b3, voffB);
            PG8_BAR; PG8_WAIT_L(0); PG8_MMA(0, 1, At, B1); PG8_BAR;
            PG8_LDA(At, 1, 1); PG8_STAGE(PG8_SA(1, 0), a3, voffA);
            PG8_BAR; PG8_WAIT_L(0); PG8_MMA(1, 0, At, B0); PG8_BAR; PG8_SCHED;
            PG8_STAGE(PG8_SB(1, 1), b3 + hstepB, voffB);
            PG8_WAIT_V(6); PG8_BAR; PG8_MMA(1, 1, At, B1); PG8_BAR;
            }
        }
        if constexpr (ALIGN_EPI) { if (wr == 0) PG8_BAR; }
        if constexpr (!Epi::AFTER_DRAIN) { E(acc, cur, wr, wc, fr, fq); S.done(cur); }
        if (!has_next) break;
#pragma unroll
        for (int a = 0; a < 2; ++a)
#pragma unroll
            for (int b = 0; b < 2; ++b)
#pragma unroll
                for (int m = 0; m < 4; ++m)
#pragma unroll
                    for (int n = 0; n < 2; ++n) acc[a][b][m][n] = (f32x4){0.f, 0.f, 0.f, 0.f};
        cur = nxt; cA = nA; cB = nB; ++ui;
        if constexpr (ALIGN_EPI) { if (wr == 1) PG8_BAR; }
    }
    PG8_WAIT_V(0);
    if constexpr (!ALIGN_EPI) { if (wr == 0) PG8_BAR; }
    PG8_BAR;
    if constexpr (Epi::AFTER_DRAIN) { E.fused(acc, cur, wr, wc, fr, fq, lds, wid, lane); S.done(cur); }
#undef PG8_SA
#undef PG8_SB
#undef PG8_STAGE
#undef PG8_LDA
#undef PG8_LDB
#undef PG8_MMA
#undef PG8_WAIT_V
#undef PG8_WAIT_L
#undef PG8_BAR
#undef PG8_SCHED
}

template <class Epi, class Sched, bool ALIGN_EPI = false, bool SP2 = false>
__device__ __forceinline__ void gemm_phase_i8(PG8_LAS unsigned char* lds, const Gemm g, const Sched& S, const Epi& E, const int wid0) {
    const int tid = otid(wid0), wid = __builtin_amdgcn_readfirstlane(tid >> 6), lane = tid & 63, wr = wid >> 2, wc = wid & 3, fr = lane & 15, fq = lane >> 4;
    const int K = g.K, nt = K / 128;
    unsigned voffA[2], voffB[2];
#pragma unroll
    for (int i = 0; i < 2; ++i) { int R, C; stage_rc(tid * 16 + i * 8192, R, C); const int Rb = Epi::PERM ? ((R & ~31) + perm32(R & 31)) : R;
        voffA[i] = (unsigned)(R * g.lda + C * 2); voffB[i] = (unsigned)(Rb * g.ldb + C * 2); }
    const size_t kstep = (size_t)(BK * 2);
    const size_t hstepA = (size_t)HALF * g.lda, hstepB = (size_t)HALF * g.ldb;
    const size_t tstepA = 2 * hstepA, tstepB = 2 * hstepB, akb = (size_t)g.akoff, a2b = (size_t)g.a2off;
    const unsigned ldsw = (unsigned)wid * 1024u;
    const int aoff = lds_byte(wr * 64 + fr, fq * 8), boff = lds_byte(wc * 32 + fr, fq * 8);
#define PG8_SA(b, h) (((b) * 2 + (h)) * HTB)
#define PG8_SB(b, h) ((4 + (b) * 2 + (h)) * HTB)
#define PG8_STAGE(bufoff, gbase, voff) do { _Pragma("unroll") for (int _i = 0; _i < 2; ++_i) \
        __builtin_amdgcn_global_load_lds((const unsigned*)((const char*)(gbase) + (voff)[_i]), (PG8_LAS unsigned*)(lds + (bufoff) + ldsw + _i * 8192), 16, 0, 0); } while (0)
#define PG8_LDA(dst, b, h) do { _Pragma("unroll") for (int m = 0; m < 4; ++m) _Pragma("unroll") for (int k = 0; k < 2; ++k) dst[m][k] = *(const PG8_LAS i32x4*)(lds + PG8_SA(b, h) + aoff + m * 2048 + k * 1024); } while (0)
#define PG8_LDB(dst, b, h) do { _Pragma("unroll") for (int n = 0; n < 2; ++n) _Pragma("unroll") for (int k = 0; k < 2; ++k) dst[n][k] = *(const PG8_LAS i32x4*)(lds + PG8_SB(b, h) + boff + n * 2048 + k * 1024); } while (0)
#define PG8_MMA(ai, bj, At, Bt) do { __builtin_amdgcn_s_setprio(1); _Pragma("unroll") for (int m = 0; m < 4; ++m) _Pragma("unroll") for (int n = 0; n < 2; ++n) _Pragma("unroll") for (int k = 0; k < 2; ++k) \
        acc[ai][bj][m][n] = __builtin_amdgcn_mfma_i32_16x16x64_i8(Bt[n][k], At[m][k], acc[ai][bj][m][n], 0, 0, 0); __builtin_amdgcn_s_setprio(0); } while (0)
#define PG8_WAIT_V(n) asm volatile("s_waitcnt vmcnt(" #n ")" ::: "memory")
#define PG8_WAIT_L(n) asm volatile("s_waitcnt lgkmcnt(" #n ")" ::: "memory")
#define PG8_BAR __builtin_amdgcn_s_barrier()
#define PG8_SCHED __builtin_amdgcn_sched_barrier(0)
    Unit cur, nxt; int ui = 0;
    if (!S.next(0, cur)) return;
    i32x4 acc[2][2][4][2];
#pragma unroll
    for (int a = 0; a < 2; ++a)
#pragma unroll
        for (int b = 0; b < 2; ++b)
#pragma unroll
            for (int m = 0; m < 4; ++m)
#pragma unroll
                for (int n = 0; n < 2; ++n) acc[a][b][m][n] = (i32x4){0, 0, 0, 0};
    i32x4 At[4][2], B0[2][2], B1[2][2];
    const char* cA = (const char*)g.A + (size_t)(cur.pm * g.am) * tstepA + (size_t)(cur.pn & 3) * akb + (size_t)(cur.pn >> 2) * a2b; const char* cB = (const char*)g.Bt + (size_t)cur.pn * tstepB;
    S.a_ready(cur);
    if constexpr (SP2) {
        PG8_STAGE(PG8_SB(0, 0), cB, voffB); PG8_STAGE(PG8_SB(0, 1), cB + hstepB, voffB); PG8_STAGE(PG8_SA(0, 0), cA, voffA); PG8_STAGE(PG8_SA(0, 1), cA + hstepA, voffA);
        if (wr == 1) PG8_BAR;
        PG8_WAIT_V(2); PG8_BAR;
        PG8_STAGE(PG8_SB(1, 0), cB + kstep, voffB); PG8_STAGE(PG8_SA(1, 0), cA + kstep, voffA); PG8_STAGE(PG8_SB(1, 1), cB + hstepB + kstep, voffB);
        PG8_WAIT_V(6); PG8_BAR;
    } else {
        PG8_STAGE(PG8_SB(0, 0), cB, voffB); PG8_STAGE(PG8_SA(0, 0), cA, voffA); PG8_STAGE(PG8_SB(0, 1), cB + hstepB, voffB); PG8_STAGE(PG8_SA(0, 1), cA + hstepA, voffA);
        if (wr == 1) PG8_BAR;
        PG8_WAIT_V(4); PG8_BAR;
        PG8_STAGE(PG8_SB(1, 0), cB + kstep, voffB); PG8_STAGE(PG8_SA(1, 0), cA + kstep, voffA); PG8_STAGE(PG8_SB(1, 1), cB + hstepB + kstep, voffB);
        PG8_WAIT_V(6); PG8_BAR;
    }
    for (;;) {
        const bool has_next = S.next(ui + 1, nxt);
        const char* nA = has_next ? (const char*)g.A + (size_t)(nxt.pm * g.am) * tstepA + (size_t)(nxt.pn & 3) * akb + (size_t)(nxt.pn >> 2) * a2b : cA; const char* nB = has_next ? (const char*)g.Bt + (size_t)nxt.pn * tstepB : cB;
        for (int t = 0; t < nt; t += 2) {
            const bool last = (t == nt - 2);
            const char* a1 = cA + (size_t)(t + 1) * kstep;
            const char* a2 = last ? nA : cA + (size_t)(t + 2) * kstep; const char* b2 = last ? nB : cB + (size_t)(t + 2) * kstep;
            const char* a3 = a2 + kstep; const char* b3 = b2 + kstep;
            if (last && has_next) S.a_ready(nxt);
            if constexpr (SP2) {
            PG8_LDB(B0, 0, 0); PG8_LDB(B1, 0, 1); PG8_SCHED; PG8_LDA(At, 0, 0); PG8_STAGE(PG8_SA(1, 1), a1 + hstepA, voffA);
            PG8_WAIT_V(8); PG8_WAIT_L(0); PG8_BAR; PG8_MMA(0, 0, At, B0); PG8_MMA(0, 1, At, B1); PG8_BAR; PG8_SCHED;
            PG8_LDA(At, 0, 1); PG8_STAGE(PG8_SB(0, 0), b2, voffB); PG8_STAGE(PG8_SB(0, 1), b2 + hstepB, voffB); PG8_STAGE(PG8_SA(0, 0), a2, voffA);
            PG8_WAIT_V(8); PG8_WAIT_L(0); PG8_BAR; PG8_MMA(1, 0, At, B0); PG8_MMA(1, 1, At, B1); PG8_BAR; PG8_SCHED;
            PG8_LDB(B0, 1, 0); PG8_LDB(B1, 1, 1); PG8_SCHED; PG8_LDA(At, 1, 0); PG8_STAGE(PG8_SA(0, 1), a2 + hstepA, voffA);
            PG8_WAIT_V(8); PG8_WAIT_L(0); PG8_BAR; PG8_MMA(0, 0, At, B0); PG8_MMA(0, 1, At, B1); PG8_BAR; PG8_SCHED;
            PG8_LDA(At, 1, 1); PG8_STAGE(PG8_SB(1, 0), b3, voffB); PG8_STAGE(PG8_SB(1, 1), b3 + hstepB, voffB); PG8_STAGE(PG8_SA(1, 0), a3, voffA);
            PG8_WAIT_V(8); PG8_WAIT_L(0); PG8_BAR; PG8_MMA(1, 0, At, B0); PG8_MMA(1, 1, At, B1); PG8_BAR; PG8_SCHED;
            } else {
            PG8_LDB(B0, 0, 0); PG8_SCHED; PG8_LDA(At, 0, 0); PG8_STAGE(PG8_SA(1, 1), a1 + hstepA, voffA);
            PG8_WAIT_L(8); PG8_BAR; PG8_WAIT_L(0); PG8_MMA(0, 0, At, B0); PG8_BAR; PG8_SCHED;
            PG8_LDB(B1, 0, 1); PG8_STAGE(PG8_SB(0, 0), b2, voffB);
            PG8_BAR; PG8_WAIT_L(0); PG8_MMA(0, 1, At, B1); PG8_BAR;
            PG8_LDA(At, 0, 1); PG8_STAGE(PG8_SA(0, 0), a2, voffA);
            PG8_BAR; PG8_WAIT_L(0); PG8_MMA(1, 0, At, B0); PG8_BAR; PG8_SCHED;
            PG8_STAGE(PG8_SB(0, 1), b2 + hstepB, voffB);
            PG8_WAIT_V(6); PG8_BAR; PG8_MMA(1, 1, At, B1); PG8_BAR;
            PG8_LDB(B0, 1, 0); PG8_SCHED; PG8_LDA(At, 1, 0); PG8_STAGE(PG8_SA(0, 1), a2 + hstepA, voffA);
            PG8_WAIT_L(8); PG8_BAR; PG8_WAIT_L(0); PG8_MMA(0, 0, At, B0); PG8_BAR; PG8_SCHED;
            PG8_LDB(B1, 1, 1); PG8_STAGE(PG8_SB(1, 0), b3, voffB);
            PG8_BAR; PG8_WAIT_L(0); PG8_MMA(0, 1, At, B1); PG8_BAR;
            PG8_LDA(At, 1, 1); PG8_STAGE(PG8_SA(1, 0), a3, voffA);
            PG8_BAR; PG8_WAIT_L(0); PG8_MMA(1, 0, At, B0); PG8_BAR; PG8_SCHED;
            PG8_STAGE(PG8_SB(1, 1), b3 + hstepB, voffB);
            PG8_WAIT_V(6); PG8_BAR; PG8_MMA(1, 1, At, B1); PG8_BAR;
            }
        }
        if constexpr (ALIGN_EPI) { if (wr == 0) PG8_BAR; }
        if constexpr (!Epi::AFTER_DRAIN) { E(acc, cur, wr, wc, fr, fq); S.done(cur); }
        if (!has_next) break;
#pragma unroll
        for (int a = 0; a < 2; ++a)
#pragma unroll
            for (int b = 0; b < 2; ++b)
#pragma unroll
                for (int m = 0; m < 4; ++m)
#pragma unroll
                    for (int n = 0; n < 2; ++n) acc[a][b][m][n] = (i32x4){0, 0, 0, 0};
        cur = nxt; cA = nA; cB = nB; ++ui;
        if constexpr (ALIGN_EPI) { if (wr == 1) PG8_BAR; }
    }
    PG8_WAIT_V(0);
    if constexpr (!ALIGN_EPI) { if (wr == 0) PG8_BAR; }
    PG8_BAR;
    if constexpr (Epi::AFTER_DRAIN) { E.fused(acc, cur, wr, wc, fr, fq, lds, wid, lane); S.done(cur); }
#undef PG8_SA
#undef PG8_SB
#undef PG8_STAGE
#undef PG8_LDA
#undef PG8_LDB
#undef PG8_MMA
#undef PG8_WAIT_V
#undef PG8_WAIT_L
#undef PG8_BAR
#undef PG8_SCHED
}
}


namespace pg8 {
typedef unsigned u32x2 __attribute__((ext_vector_type(2)));
__device__ __forceinline__ unsigned cvt_pk_bf16(float lo, float hi) { unsigned r; asm volatile("v_cvt_pk_bf16_f32 %0, %1, %2" : "=v"(r) : "v"(lo), "v"(hi)); return r; }
__device__ __forceinline__ float sigm(float x) { return __builtin_amdgcn_rcpf(1.0f + __builtin_amdgcn_exp2f(-1.4426950408889634f * x)); }
__device__ __forceinline__ float bf_lo(unsigned w) { return __uint_as_float(w << 16); }
__device__ __forceinline__ float bf_hi(unsigned w) { return __uint_as_float(w & 0xffff0000u); }

struct PanelSched {
    int panel, n, skip_lo, skip_n, mode, first;
    __device__ __forceinline__ bool next(int i, Unit& u) const {
        if (i >= n) return false;
        if (mode == 0) { const int j = first + i; u.pm = panel; u.pn = j + (j >= skip_lo ? skip_n : 0); } else if (mode == 2) { u.pm = panel; u.pn = (i >> 1) + 4 * (i & 1); } else { u.pm = i; u.pn = panel; }
        return true;
    }
    __device__ __forceinline__ void a_ready(const Unit&) const {}
    __device__ __forceinline__ void done(const Unit&) const {}
};

struct EpiProj {
    static constexpr bool PERM = true, AFTER_DRAIN = false;
    bf16_t *PQ, *PK, *PU, *PG;
    __device__ __forceinline__ void operator()(const f32x4 (&acc)[2][2][4][2], const Unit& u, int wr, int wc, int fr, int fq) const {
        const int pn = u.pn; bf16_t* base; int ld, colt; bool sg = false;
        if (pn < 2) { base = PQ; ld = 512; colt = pn * 256; }
        else if (pn < 4) { base = PK; ld = 512; colt = (pn - 2) * 256; }
        else if (pn < 8) { base = PU; ld = 512; colt = (pn - 6) * 256; }
        else { base = PG; ld = 2048; colt = (pn - 8) * 256; sg = true; }
        const int row0 = u.pm * BM + wr * 64 + fr, col0 = colt + wc * 32 + 8 * fq;
#pragma unroll
        for (int ai = 0; ai < 2; ++ai)
#pragma unroll
            for (int m = 0; m < 4; ++m) { bf16_t* rowp = base + (size_t)(row0 + ai * HALF + m * 16) * ld + col0;
#pragma unroll
                for (int bj = 0; bj < 2; ++bj) { f32x4 v0 = acc[ai][bj][m][0], v1 = acc[ai][bj][m][1];
                    if (sg) { v0 = (f32x4){sigm(v0[0]), sigm(v0[1]), sigm(v0[2]), sigm(v0[3])}; v1 = (f32x4){sigm(v1[0]), sigm(v1[1]), sigm(v1[2]), sigm(v1[3])}; }
                    u32x4 w; w.x = cvt_pk_bf16(v0[0], v0[1]); w.y = cvt_pk_bf16(v0[2], v0[3]); w.z = cvt_pk_bf16(v1[0], v1[1]); w.w = cvt_pk_bf16(v1[2], v1[3]);
                    *(u32x4*)(rowp + bj * HALF) = w; } }
    }
};
__device__ __forceinline__ unsigned gate4_u8(float a, float b, float c, float d) {
    const unsigned ua = (unsigned)__builtin_rintf(a * 255.f), ub = (unsigned)__builtin_rintf(b * 255.f), uc = (unsigned)__builtin_rintf(c * 255.f), ud = (unsigned)__builtin_rintf(d * 255.f);
    return ua | (ub << 8) | (uc << 16) | (ud << 24);
}
struct EpiProjI8 {
    static constexpr bool PERM = true, AFTER_DRAIN = false;
    bf16_t *PQ, *PK, *PU, *PG; const float* rs; const float* cs;
    __device__ __forceinline__ void operator()(const i32x4 (&acc)[2][2][4][2], const Unit& u, int wr, int wc, int fr, int fq) const {
        asm volatile("" : "+v"(fr), "+v"(fq));
        const int pn = u.pn; bf16_t* base; int ld, colt; bool sg = false;
        if (pn < 2) { base = PQ; ld = 512; colt = pn * 256; }
        else if (pn < 4) { base = PK; ld = 512; colt = (pn - 2) * 256; }
        else if (pn < 8) { base = PU; ld = 512; colt = (pn - 6) * 256; }
        else { base = PG; ld = 2048; colt = (pn - 8) * 256; sg = true; }
        const int row0 = u.pm * BM + wr * 64 + fr, col0 = colt + wc * 32 + 8 * fq, ccol0 = pn * BM + wc * 32 + 8 * fq;
        f32x4 cv[2][2];
#pragma unroll
        for (int bj = 0; bj < 2; ++bj) { cv[bj][0] = *(const f32x4*)(cs + ccol0 + bj * HALF); cv[bj][1] = *(const f32x4*)(cs + ccol0 + bj * HALF + 4); }
#pragma unroll
        for (int ai = 0; ai < 2; ++ai)
#pragma unroll
            for (int m = 0; m < 4; ++m) { const int row = row0 + ai * HALF + m * 16; const float r = rs[row]; bf16_t* rowp = base + (size_t)row * ld + col0;
#pragma unroll
                for (int bj = 0; bj < 2; ++bj) { const i32x4 a0 = acc[ai][bj][m][0], a1 = acc[ai][bj][m][1];
                    f32x4 v0 = (f32x4){(float)a0[0], (float)a0[1], (float)a0[2], (float)a0[3]} * cv[bj][0] * r, v1 = (f32x4){(float)a1[0], (float)a1[1], (float)a1[2], (float)a1[3]} * cv[bj][1] * r;
                    if (sg) {
                        const unsigned lo = gate4_u8(sigm(v0[0]), sigm(v0[1]), sigm(v0[2]), sigm(v0[3])), hi = gate4_u8(sigm(v1[0]), sigm(v1[1]), sigm(v1[2]), sigm(v1[3]));
                        *(unsigned long long*)((unsigned char*)PG + (size_t)row * 4096 + col0 + bj * HALF) = (unsigned long long)lo | ((unsigned long long)hi << 32); }
                    else { u32x4 w; w.x = cvt_pk_bf16(v0[0], v0[1]); w.y = cvt_pk_bf16(v0[2], v0[3]); w.z = cvt_pk_bf16(v1[0], v1[1]); w.w = cvt_pk_bf16(v1[2], v1[3]);
                        *(u32x4*)(rowp + bj * HALF) = w; } } }
    }
};
struct EpiPlainScaleI8 {
    static constexpr bool PERM = true, AFTER_DRAIN = false;
    bf16_t* O; int ldc; PG8_LAS const float* rs; const float* cs;
    __device__ __forceinline__ void operator()(const i32x4 (&acc)[2][2][4][2], const Unit& u, int wr, int wc, int fr, int fq) const {
        asm volatile("" : "+v"(fr), "+v"(fq));
        const int col0 = u.pn * BM + wc * 32 + 8 * fq;
        f32x4 cv[2][2];
#pragma unroll
        for (int bj = 0; bj < 2; ++bj) { cv[bj][0] = *(const f32x4*)(cs + col0 + bj * HALF); cv[bj][1] = *(const f32x4*)(cs + col0 + bj * HALF + 4); }
#pragma unroll
        for (int ai = 0; ai < 2; ++ai)
#pragma unroll
            for (int m = 0; m < 4; ++m) { const int lr = ai * HALF + wr * 64 + m * 16 + fr; const float r = rs[lr]; bf16_t* rowp = O + (size_t)(u.pm * BM + lr) * ldc + col0;
#pragma unroll
                for (int bj = 0; bj < 2; ++bj) { const i32x4 a0 = acc[ai][bj][m][0], a1 = acc[ai][bj][m][1];
                    const f32x4 v0 = (f32x4){(float)a0[0], (float)a0[1], (float)a0[2], (float)a0[3]} * cv[bj][0] * r, v1 = (f32x4){(float)a1[0], (float)a1[1], (float)a1[2], (float)a1[3]} * cv[bj][1] * r;
                    u32x4 w; w.x = cvt_pk_bf16(v0[0], v0[1]); w.y = cvt_pk_bf16(v0[2], v0[3]); w.z = cvt_pk_bf16(v1[0], v1[1]); w.w = cvt_pk_bf16(v1[2], v1[3]);
                    *(u32x4*)(rowp + bj * HALF) = w; } }
    }
};
struct EpiPlainI8 {
    static constexpr bool PERM = true, AFTER_DRAIN = false;
    bf16_t* O; int ldc; const float* rs; const float* cs;
    __device__ __forceinline__ void operator()(const i32x4 (&acc)[2][2][4][2], const Unit& u, int wr, int wc, int fr, int fq) const {
        asm volatile("" : "+v"(fr), "+v"(fq));
        const int row0 = u.pm * BM + wr * 64 + fr, col0 = u.pn * BM + wc * 32 + 8 * fq;
        f32x4 cv[2][2];
#pragma unroll
        for (int bj = 0; bj < 2; ++bj) { cv[bj][0] = *(const f32x4*)(cs + col0 + bj * HALF); cv[bj][1] = *(const f32x4*)(cs + col0 + bj * HALF + 4); }
#pragma unroll
        for (int ai = 0; ai < 2; ++ai)
#pragma unroll
            for (int m = 0; m < 4; ++m) { const int row = row0 + ai * HALF + m * 16; const float r = rs[row]; bf16_t* rowp = O + (size_t)row * ldc + col0;
#pragma unroll
                for (int bj = 0; bj < 2; ++bj) { const i32x4 a0 = acc[ai][bj][m][0], a1 = acc[ai][bj][m][1];
                    const f32x4 v0 = (f32x4){(float)a0[0], (float)a0[1], (float)a0[2], (float)a0[3]} * cv[bj][0] * r, v1 = (f32x4){(float)a1[0], (float)a1[1], (float)a1[2], (float)a1[3]} * cv[bj][1] * r;
                    u32x4 w; w.x = cvt_pk_bf16(v0[0], v0[1]); w.y = cvt_pk_bf16(v0[2], v0[3]); w.z = cvt_pk_bf16(v1[0], v1[1]); w.w = cvt_pk_bf16(v1[2], v1[3]);
                    *(u32x4*)(rowp + bj * HALF) = w; } }
    }
};
struct EpiPlain {
    static constexpr bool PERM = true, AFTER_DRAIN = false;
    bf16_t* O; int ldc;
    __device__ __forceinline__ void operator()(const f32x4 (&acc)[2][2][4][2], const Unit& u, int wr, int wc, int fr, int fq) const {
        const int row0 = u.pm * BM + wr * 64 + fr, col0 = u.pn * BM + wc * 32 + 8 * fq;
#pragma unroll
        for (int ai = 0; ai < 2; ++ai)
#pragma unroll
            for (int m = 0; m < 4; ++m) { bf16_t* rowp = O + (size_t)(row0 + ai * HALF + m * 16) * ldc + col0;
#pragma unroll
                for (int bj = 0; bj < 2; ++bj) { const f32x4 v0 = acc[ai][bj][m][0], v1 = acc[ai][bj][m][1];
                    u32x4 w; w.x = cvt_pk_bf16(v0[0], v0[1]); w.y = cvt_pk_bf16(v0[2], v0[3]); w.z = cvt_pk_bf16(v1[0], v1[1]); w.w = cvt_pk_bf16(v1[2], v1[3]);
                    *(u32x4*)(rowp + bj * HALF) = w; } }
    }
};
struct EpiMergeChain {
    static constexpr bool PERM = true, AFTER_DRAIN = false;
    const bf16_t* G; bf16_t* MG;
    __device__ __forceinline__ void operator()(const f32x4 (&acc)[2][2][4][2], const Unit& u, int wr, int wc, int fr, int fq) const {
        const bool add = u.pn >= 4; const int goff = add ? 1024 : 0;
        const int row0 = u.pm * BM + wr * 64 + fr, col0 = (u.pn & 3) * BM + wc * 32 + 8 * fq;
        if (add) asm volatile("s_waitcnt vmcnt(0)" ::: "memory");
#pragma unroll
        for (int ai = 0; ai < 2; ++ai)
#pragma unroll
            for (int m = 0; m < 4; ++m) { const size_t row = (size_t)(row0 + ai * HALF + m * 16);
#pragma unroll
                for (int bj = 0; bj < 2; ++bj) { const f32x4 v0 = acc[ai][bj][m][0], v1 = acc[ai][bj][m][1];
                    const unsigned long long gq = *(const unsigned long long*)((const unsigned char*)G + row * 4096 + goff + col0 + bj * HALF);
                    const unsigned g0 = (unsigned)gq, g1 = (unsigned)(gq >> 32); const float k255 = 1.0f / 255.0f;
                    float r0 = (float)(g0 & 255u) * k255 * v0[0], r1 = (float)((g0 >> 8) & 255u) * k255 * v0[1], r2 = (float)((g0 >> 16) & 255u) * k255 * v0[2], r3 = (float)(g0 >> 24) * k255 * v0[3];
                    float r4 = (float)(g1 & 255u) * k255 * v1[0], r5 = (float)((g1 >> 8) & 255u) * k255 * v1[1], r6 = (float)((g1 >> 16) & 255u) * k255 * v1[2], r7 = (float)(g1 >> 24) * k255 * v1[3];
                    bf16_t* mp = MG + row * 1024 + col0 + bj * HALF;
                    if (add) { const u32x4 pw = *(const u32x4*)mp;
                        r0 += bf_lo(pw.x); r1 += bf_hi(pw.x); r2 += bf_lo(pw.y); r3 += bf_hi(pw.y); r4 += bf_lo(pw.z); r5 += bf_hi(pw.z); r6 += bf_lo(pw.w); r7 += bf_hi(pw.w); }
                    u32x4 w; w.x = cvt_pk_bf16(r0, r1); w.y = cvt_pk_bf16(r2, r3); w.z = cvt_pk_bf16(r4, r5); w.w = cvt_pk_bf16(r6, r7);
                    *(u32x4*)mp = w; }
                if (m == 3) asm volatile("" ::: "memory"); }
    }
};
struct EpiMerge2 {
    static constexpr bool PERM = true, AFTER_DRAIN = false;
    const unsigned char* G; bf16_t* MG;
    __device__ __forceinline__ void operator()(const f32x4 (&acc)[2][2][4][2], const Unit& u, int wr, int wc, int fr, int fq) const {
        asm volatile("" : "+v"(fr), "+v"(fq));
        const int row0 = u.pm * BM + wr * 64 + fr, colm = 256 * (u.pn & 3) + 128 * (u.pn >> 2) + wc * 32 + 8 * fq;
        const float k255 = 1.0f / 255.0f;
#pragma unroll
        for (int ai = 0; ai < 2; ++ai)
#pragma unroll
            for (int m = 0; m < 4; ++m) { const size_t row = (size_t)(row0 + ai * HALF + m * 16);
                const unsigned long long ga = *(const unsigned long long*)(G + row * 4096 + colm), gp = *(const unsigned long long*)(G + row * 4096 + 1024 + colm);
                const unsigned a0 = (unsigned)ga, a1 = (unsigned)(ga >> 32), q0 = (unsigned)gp, q1 = (unsigned)(gp >> 32);
                const f32x4 x0 = acc[ai][0][m][0], x1 = acc[ai][0][m][1], y0 = acc[ai][1][m][0], y1 = acc[ai][1][m][1];
                const float r0 = ((float)(a0 & 255u) * x0[0] + (float)(q0 & 255u) * y0[0]) * k255, r1 = ((float)((a0 >> 8) & 255u) * x0[1] + (float)((q0 >> 8) & 255u) * y0[1]) * k255;
                const float r2 = ((float)((a0 >> 16) & 255u) * x0[2] + (float)((q0 >> 16) & 255u) * y0[2]) * k255, r3 = ((float)(a0 >> 24) * x0[3] + (float)(q0 >> 24) * y0[3]) * k255;
                const float r4 = ((float)(a1 & 255u) * x1[0] + (float)(q1 & 255u) * y1[0]) * k255, r5 = ((float)((a1 >> 8) & 255u) * x1[1] + (float)((q1 >> 8) & 255u) * y1[1]) * k255;
                const float r6 = ((float)((a1 >> 16) & 255u) * x1[2] + (float)((q1 >> 16) & 255u) * y1[2]) * k255, r7 = ((float)(a1 >> 24) * x1[3] + (float)(q1 >> 24) * y1[3]) * k255;
                u32x4 w; w.x = cvt_pk_bf16(r0, r1); w.y = cvt_pk_bf16(r2, r3); w.z = cvt_pk_bf16(r4, r5); w.w = cvt_pk_bf16(r6, r7);
                *(u32x4*)(MG + row * 1024 + colm) = w;
                if (m == 3) asm volatile("" ::: "memory"); }
    }
};
__device__ __forceinline__ void lds_addf(PG8_LAS float* p, float v) { __hip_atomic_fetch_add(p, v, __ATOMIC_RELAXED, __HIP_MEMORY_SCOPE_WORKGROUP); }
__device__ __forceinline__ float quad_row_sum(float s, int lane) {
    s += __builtin_bit_cast(float, __builtin_amdgcn_ds_bpermute((lane ^ 16) << 2, __builtin_bit_cast(int, s)));
    s += __builtin_bit_cast(float, __builtin_amdgcn_ds_bpermute((lane ^ 32) << 2, __builtin_bit_cast(int, s)));
    return s;
}
struct EpiRes {
    static constexpr bool PERM = true, AFTER_DRAIN = false;
    const float* X; bf16_t* OB; PG8_LAS float* ss;
    __device__ __forceinline__ void operator()(const f32x4 (&acc)[2][2][4][2], const Unit& u, int wr, int wc, int fr, int fq) const {
        asm volatile("" : "+v"(fr), "+v"(fq));
        const int col0 = u.pn * BM + wc * 32 + 8 * fq; const int lane = fq * 16 + fr;
#pragma unroll
        for (int ai = 0; ai < 2; ++ai)
#pragma unroll
            for (int m = 0; m < 4; ++m) { const int lr = ai * HALF + wr * 64 + m * 16 + fr; const size_t xoff = (size_t)(u.pm * BM + lr) * 1024 + col0; bf16_t* op = OB + ((size_t)(2 * u.pm) * BM + lr) * 1024 + col0;
                float s = 0.f;
#pragma unroll
                for (int bj = 0; bj < 2; ++bj) { const f32x4 x0 = *(const f32x4*)(X + xoff + bj * HALF), x1 = *(const f32x4*)(X + xoff + bj * HALF + 4);
                    const f32x4 v0 = x0 + acc[ai][bj][m][0], v1 = x1 + acc[ai][bj][m][1];
                    s += (v0[0] * v0[0] + v0[1] * v0[1]) + (v0[2] * v0[2] + v0[3] * v0[3]) + (v1[0] * v1[0] + v1[1] * v1[1]) + (v1[2] * v1[2] + v1[3] * v1[3]);
                    u32x4 w; w.x = cvt_pk_bf16(v0[0], v0[1]); w.y = cvt_pk_bf16(v0[2], v0[3]); w.z = cvt_pk_bf16(v1[0], v1[1]); w.w = cvt_pk_bf16(v1[2], v1[3]);
                    *(u32x4*)(op + bj * HALF) = w; }
                s = quad_row_sum(s, lane); if (fq == 0) lds_addf(ss + lr, s);
                if (m == 3) asm volatile("" ::: "memory"); }
    }
};
struct EpiResI8 {
    static constexpr bool PERM = true, AFTER_DRAIN = false;
    const float* X; bf16_t* OB; PG8_LAS float* ss; PG8_LAS const float* rs; const float* cs;
    __device__ __forceinline__ void operator()(const i32x4 (&acc)[2][2][4][2], const Unit& u, int wr, int wc, int fr, int fq) const {
        asm volatile("" : "+v"(fr), "+v"(fq));
        const int col0 = u.pn * BM + wc * 32 + 8 * fq; const int lane = fq * 16 + fr;
        f32x4 cv[2][2];
#pragma unroll
        for (int bj = 0; bj < 2; ++bj) { cv[bj][0] = *(const f32x4*)(cs + col0 + bj * HALF); cv[bj][1] = *(const f32x4*)(cs + col0 + bj * HALF + 4); }
#pragma unroll
        for (int ai = 0; ai < 2; ++ai)
#pragma unroll
            for (int m = 0; m < 4; ++m) { const int lr = ai * HALF + wr * 64 + m * 16 + fr; const float r = rs[lr]; const size_t xoff = (size_t)(u.pm * BM + lr) * 1024 + col0; bf16_t* op = OB + ((size_t)(2 * u.pm) * BM + lr) * 1024 + col0;
                float s = 0.f;
#pragma unroll
                for (int bj = 0; bj < 2; ++bj) { const f32x4 x0 = *(const f32x4*)(X + xoff + bj * HALF), x1 = *(const f32x4*)(X + xoff + bj * HALF + 4); const i32x4 a0 = acc[ai][bj][m][0], a1 = acc[ai][bj][m][1];
                    const f32x4 v0 = x0 + (f32x4){(float)a0[0], (float)a0[1], (float)a0[2], (float)a0[3]} * cv[bj][0] * r, v1 = x1 + (f32x4){(float)a1[0], (float)a1[1], (float)a1[2], (float)a1[3]} * cv[bj][1] * r;
                    s += (v0[0] * v0[0] + v0[1] * v0[1]) + (v0[2] * v0[2] + v0[3] * v0[3]) + (v1[0] * v1[0] + v1[1] * v1[1]) + (v1[2] * v1[2] + v1[3] * v1[3]);
                    u32x4 w; w.x = cvt_pk_bf16(v0[0], v0[1]); w.y = cvt_pk_bf16(v0[2], v0[3]); w.z = cvt_pk_bf16(v1[0], v1[1]); w.w = cvt_pk_bf16(v1[2], v1[3]);
                    *(u32x4*)(op + bj * HALF) = w; }
                s = quad_row_sum(s, lane); if (fq == 0) lds_addf(ss + lr, s);
                if (m == 3) asm volatile("" ::: "memory"); }
    }
};
struct EpiPlainScale {
    static constexpr bool PERM = true, AFTER_DRAIN = false;
    bf16_t* O; int ldc; PG8_LAS const float* rs;
    __device__ __forceinline__ void operator()(const f32x4 (&acc)[2][2][4][2], const Unit& u, int wr, int wc, int fr, int fq) const {
        asm volatile("" : "+v"(fr), "+v"(fq));
        const int col0 = u.pn * BM + wc * 32 + 8 * fq;
#pragma unroll
        for (int ai = 0; ai < 2; ++ai)
#pragma unroll
            for (int m = 0; m < 4; ++m) { const int lr = ai * HALF + wr * 64 + m * 16 + fr; const float r = rs[lr]; bf16_t* rowp = O + (size_t)(u.pm * BM + lr) * ldc + col0;
#pragma unroll
                for (int bj = 0; bj < 2; ++bj) { const f32x4 v0 = acc[ai][bj][m][0] * r, v1 = acc[ai][bj][m][1] * r;
                    u32x4 w; w.x = cvt_pk_bf16(v0[0], v0[1]); w.y = cvt_pk_bf16(v0[2], v0[3]); w.z = cvt_pk_bf16(v1[0], v1[1]); w.w = cvt_pk_bf16(v1[2], v1[3]);
                    *(u32x4*)(rowp + bj * HALF) = w; } }
    }
};
struct EpiGate {
    static constexpr bool PERM = false, AFTER_DRAIN = false;
    bf16_t* X3; const bf16_t* X2; const bf16_t* E; PG8_LAS const float* rs; PG8_LAS float* ss;
    __device__ __forceinline__ void operator()(const f32x4 (&acc)[2][2][4][2], const Unit& u, int wr, int wc, int fr, int fq) const {
        asm volatile("" : "+v"(fr), "+v"(fq));
        const int col0 = u.pn * BM + wc * 32 + 4 * fq; const int lane = fq * 16 + fr;
        bf16_t* const x3b = X3 + col0;
#pragma unroll
        for (int ai = 0; ai < 2; ++ai)
#pragma unroll
            for (int m = 0; m < 4; ++m) { const int lr = ai * HALF + wr * 64 + m * 16 + fr; const float r = rs[lr];
                const size_t off = (size_t)(u.pm * BM + lr) * 1024 + col0, xo = ((size_t)(2 * u.pm) * BM + lr) * 1024 + col0; float s = 0.f;
#pragma unroll
                for (int bj = 0; bj < 2; ++bj)
#pragma unroll
                    for (int n = 0; n < 2; ++n) { const int co = bj * HALF + n * 16; const u32x2 xw = *(const u32x2*)(X2 + xo + co); const u32x2 ew = *(const u32x2*)(E + off + co); const f32x4 a = acc[ai][bj][m][n] * r;
                        f32x4 v; v[0] = bf_lo(xw.x) + sigm(a[0]) * bf_lo(ew.x); v[1] = bf_hi(xw.x) + sigm(a[1]) * bf_hi(ew.x); v[2] = bf_lo(xw.y) + sigm(a[2]) * bf_lo(ew.y); v[3] = bf_hi(xw.y) + sigm(a[3]) * bf_hi(ew.y);
                        s += (v[0] * v[0] + v[1] * v[1]) + (v[2] * v[2] + v[3] * v[3]);
                        u32x2 w3; w3.x = cvt_pk_bf16(v[0], v[1]); w3.y = cvt_pk_bf16(v[2], v[3]); *(u32x2*)(x3b + (size_t)(u.pm * BM + lr) * 1024 + co) = w3; }
                s = quad_row_sum(s, lane); if (fq == 0) lds_addf(ss + lr, s);
                if (m == 3) asm volatile("" ::: "memory"); }
    }
};
struct EpiGateI8 {
    static constexpr bool PERM = true, AFTER_DRAIN = false;
    bf16_t* X3; const bf16_t* X2; const bf16_t* E; PG8_LAS const float* rs; const float* cs; PG8_LAS float* ss;
    __device__ __forceinline__ void operator()(const i32x4 (&acc)[2][2][4][2], const Unit& u, int wr, int wc, int fr, int fq) const {
        asm volatile("" : "+v"(fr), "+v"(fq));
        const int col0 = u.pn * BM + wc * 32 + 8 * fq; const int lane = fq * 16 + fr;
        f32x4 cv[2][2];
#pragma unroll
        for (int bj = 0; bj < 2; ++bj) { cv[bj][0] = *(const f32x4*)(cs + col0 + bj * HALF); cv[bj][1] = *(const f32x4*)(cs + col0 + bj * HALF + 4); }
#pragma unroll
        for (int ai = 0; ai < 2; ++ai)
#pragma unroll
            for (int m = 0; m < 4; ++m) { const int lr = ai * HALF + wr * 64 + m * 16 + fr; const float r = rs[lr];
                const size_t off = (size_t)(u.pm * BM + lr) * 1024 + col0, xo = ((size_t)(2 * u.pm) * BM + lr) * 1024 + col0; float s = 0.f;
#pragma unroll
                for (int bj = 0; bj < 2; ++bj) { const i32x4 a0 = acc[ai][bj][m][0], a1 = acc[ai][bj][m][1];
                    const u32x4 xw = *(const u32x4*)(X2 + xo + bj * HALF), ew = *(const u32x4*)(E + off + bj * HALF);
                    const f32x4 l0 = (f32x4){(float)a0[0], (float)a0[1], (float)a0[2], (float)a0[3]} * cv[bj][0] * r, l1 = (f32x4){(float)a1[0], (float)a1[1], (float)a1[2], (float)a1[3]} * cv[bj][1] * r;
                    const float v0 = bf_lo(xw.x) + sigm(l0[0]) * bf_lo(ew.x), v1 = bf_hi(xw.x) + sigm(l0[1]) * bf_hi(ew.x), v2 = bf_lo(xw.y) + sigm(l0[2]) * bf_lo(ew.y), v3 = bf_hi(xw.y) + sigm(l0[3]) * bf_hi(ew.y);
                    const float v4 = bf_lo(xw.z) + sigm(l1[0]) * bf_lo(ew.z), v5 = bf_hi(xw.z) + sigm(l1[1]) * bf_hi(ew.z), v6 = bf_lo(xw.w) + sigm(l1[2]) * bf_lo(ew.w), v7 = bf_hi(xw.w) + sigm(l1[3]) * bf_hi(ew.w);
                    s += ((v0 * v0 + v1 * v1) + (v2 * v2 + v3 * v3)) + ((v4 * v4 + v5 * v5) + (v6 * v6 + v7 * v7));
                    u32x4 w; w.x = cvt_pk_bf16(v0, v1); w.y = cvt_pk_bf16(v2, v3); w.z = cvt_pk_bf16(v4, v5); w.w = cvt_pk_bf16(v6, v7);
                    *(u32x4*)(X3 + off + bj * HALF) = w; }
                s = quad_row_sum(s, lane); if (fq == 0) lds_addf(ss + lr, s);
                if (m == 3) asm volatile("" ::: "memory"); }
    }
};
}

#define GAS __attribute__((address_space(1)))
#define LAS __attribute__((address_space(3)))
typedef unsigned short bf16;
typedef unsigned v4u __attribute__((ext_vector_type(4)));
typedef unsigned v2u __attribute__((ext_vector_type(2)));
typedef float f32x4 __attribute__((ext_vector_type(4)));
typedef short bf16x8 __attribute__((ext_vector_type(8)));
typedef GAS unsigned gu32;
typedef GAS unsigned long long gu64;
#define RLX_AGENT __ATOMIC_RELAXED, __HIP_MEMORY_SCOPE_AGENT
#define LDS_WAIT() asm volatile("s_waitcnt lgkmcnt(0)" ::: "memory")
#define VM_WAIT() asm volatile("s_waitcnt vmcnt(0)" ::: "memory")
__device__ __forceinline__ unsigned long long rt() { return __builtin_amdgcn_s_memrealtime(); }
__device__ __forceinline__ unsigned f2bf(float f) { unsigned u = __builtin_bit_cast(unsigned, f); return (u + 0x7fffu + ((u >> 16) & 1u)) >> 16; }
__device__ __forceinline__ unsigned pk2(float lo, float hi) { return f2bf(lo) | (f2bf(hi) << 16); }

#define XB_TMO      128
#define XB_XCNT(j)  (256  + 64 * (j))
#define XB_XSUB(j)  (1280 + 64 * (j))
#define XB_XGEN(j)  (2304 + 64 * (j))
#define XB_TOP      3328
#define XB_TOPGEN   3392
#define XCD_BAR_WORDS 3456
#define XB_SPIN_CAP (1u << 18)

__device__ __forceinline__ unsigned xb_ld(unsigned* p)              { return __hip_atomic_load(p, __ATOMIC_RELAXED, __HIP_MEMORY_SCOPE_AGENT); }
__device__ __forceinline__ unsigned xb_add(unsigned* p, unsigned v) { return __hip_atomic_fetch_add(p, v, __ATOMIC_RELAXED, __HIP_MEMORY_SCOPE_AGENT); }
__device__ __forceinline__ unsigned xb_xcc_id() { return (unsigned)__builtin_amdgcn_s_getreg((3 << 11) | 20) & 0xFu; }
#define XB_SPIN(cond, bar) do { unsigned _sp = 0; while (cond) { __builtin_amdgcn_s_sleep(1); \
    if ((++_sp & 255u) == 0u) { if (xb_ld(&(bar)[XB_TMO])) break; if (_sp > XB_SPIN_CAP) { atomicAdd(&(bar)[XB_TMO], 1u); break; } } } } while (0)

struct XcdBarrier {
    unsigned* bar; unsigned x;
    volatile LAS unsigned* st;
};

__device__ __forceinline__ XcdBarrier xcd_barrier_post(unsigned* bar, volatile LAS unsigned* st, const bool is_t0) {
    XcdBarrier b; b.bar = bar; b.x = xb_xcc_id(); b.st = st;
    if (is_t0) (void)xb_add(&bar[XB_XCNT(b.x)], 1u);
    return b;
}
__device__ __forceinline__ void xcd_barrier_complete(unsigned* bar, unsigned x, unsigned& nloc, unsigned& nx) {
    const unsigned G = gridDim.x * gridDim.y * gridDim.z;
    unsigned sum, cnt, mine, sp = 0u;
    for (;;) {
        sum = 0u; cnt = 0u; mine = 0u;
#pragma unroll
        for (unsigned j = 0; j < 16; ++j) { const unsigned c = xb_ld(&bar[XB_XCNT(j)]); sum += c; cnt += (c > 0u) ? 1u : 0u; mine = (j == x) ? c : mine; }
        if (sum == G) break;
        __builtin_amdgcn_s_sleep(1);
        if ((++sp & 255u) == 0u) { if (xb_ld(&bar[XB_TMO])) break; if (sp > XB_SPIN_CAP) { atomicAdd(&bar[XB_TMO], 1u); break; } }
    }
    nloc = mine > 0u ? mine : 1u; nx = cnt > 0u ? cnt : 1u;
}

__device__ __forceinline__ void xcd_barrier(const XcdBarrier& b, const bool is_t0) {
    asm volatile("s_waitcnt vmcnt(0)" ::: "memory");
    __syncthreads();
    if (is_t0) {
        unsigned* bar = b.bar;
        __builtin_amdgcn_s_waitcnt(0);
        unsigned nloc = b.st[0], nx = b.st[1];
        if (nloc == 0u) { xcd_barrier_complete(bar, b.x, nloc, nx); b.st[0] = nloc; b.st[1] = nx; }
        const unsigned old = xb_add(&bar[XB_XSUB(b.x)], 1u);
        const unsigned gen = old / nloc;
        if (old + 1u == (gen + 1u) * nloc) {
            __builtin_amdgcn_fence(__ATOMIC_RELEASE, "agent");
            asm volatile("s_waitcnt vmcnt(0)" ::: "memory");
            const unsigned og = xb_add(&bar[XB_TOP], 1u);
            const unsigned tg = og / nx;
            if (og + 1u == (tg + 1u) * nx) xb_add(&bar[XB_TOPGEN], 1u);
            else XB_SPIN(xb_ld(&bar[XB_TOPGEN]) == tg, bar);
            __builtin_amdgcn_fence(__ATOMIC_ACQUIRE, "agent");
            xb_add(&bar[XB_XGEN(b.x)], 1u);
            asm volatile("s_waitcnt vmcnt(0)" ::: "memory");
        } else {
            XB_SPIN(xb_ld(&bar[XB_XGEN(b.x)]) == gen, bar);
            __builtin_amdgcn_fence(__ATOMIC_ACQUIRE, "agent");
            asm volatile("s_waitcnt vmcnt(0)" ::: "memory");
        }
    }
    __syncthreads();
}


constexpr int NWAVES = 8, NTHR = 512;
constexpr int TOK = 65536, DM = 1024, SEQ = 8192, NPANEL = 256;
constexpr float RMS_EPS = 1e-6f;
constexpr float C2 = 0.125f * 1.4426950408889634f;
constexpr float SURV_THR = 5.4210108624275222e-20f;
constexpr size_t MiB = 1u << 20;
constexpr size_t WS_CTL = 0, CTL_ZERO_BYTES = 64 * 1024;
constexpr size_t WS_WIN = 2 * MiB, WS_WOUT = 10 * MiB, WS_WQ = 12 * MiB, WS_WPG = 16 * MiB, WS_WPLE = 18 * MiB;
constexpr size_t WS_BD2 = 24 * MiB, WS_SK = 19 * MiB;
constexpr size_t WS_SX = 21 * MiB, WS_SBN = 21 * MiB + 262144, WS_SBQ = 21 * MiB + 262144 + 16384, WS_SBG = 21 * MiB + 262144 + 16384 + 8192, WS_SBO = 21 * MiB + 262144 + 16384 + 8192 + 4096;
constexpr size_t WS_EU = 32 * MiB, WS_EV = 64 * MiB, WS_SU = 20 * MiB, WS_SV = 20 * MiB + 65536;
constexpr size_t WS_XN = 96 * MiB;
constexpr size_t WS_PQ = 224 * MiB, WS_PK = 288 * MiB, WS_PVT = 352 * MiB, WS_PU = 416 * MiB;
constexpr size_t WS_PG = 480 * MiB;
constexpr size_t WS_YA = 736 * MiB, WS_YP = 800 * MiB;
constexpr size_t WS_MG = 864 * MiB, WS_END = 992 * MiB;
constexpr int CW_BAR = 1024, CW_CMAX = 8192;
constexpr int RING_BYTES = 131072, LDSCTL_OFF = RING_BYTES, MISC_OFF = LDSCTL_OFF + 320, LDS_BYTES = 147456;

typedef float f32x16 __attribute__((ext_vector_type(16)));
typedef float f32x2 __attribute__((ext_vector_type(2)));
typedef __bf16 bf16x2v __attribute__((ext_vector_type(2)));

__device__ __forceinline__ int shx(int v, int m, int lane) { return __builtin_amdgcn_ds_bpermute((lane ^ m) << 2, v); }
__device__ __forceinline__ float shx(float v, int m, int lane) { return __builtin_bit_cast(float, __builtin_amdgcn_ds_bpermute((lane ^ m) << 2, __builtin_bit_cast(int, v))); }
__device__ __forceinline__ float shl_(float v, int src) { return __builtin_bit_cast(float, __builtin_amdgcn_ds_bpermute(src << 2, __builtin_bit_cast(int, v))); }
__device__ __forceinline__ float wave_sum(float v, int lane) {
#pragma unroll
    for (int o = 1; o < 64; o <<= 1) v += shx(v, o, lane);
    return v;
}
__device__ __forceinline__ float bflo(unsigned w) { return __uint_as_float(w << 16); }
__device__ __forceinline__ float bfhi(unsigned w) { return __uint_as_float(w & 0xffff0000u); }
__device__ __forceinline__ unsigned cvtpk(float lo, float hi) { return pg8::cvt_pk_bf16(lo, hi); }

#define H_UNPACK(H, A, B) do { H[0] = bflo(A.x); H[1] = bfhi(A.x); H[2] = bflo(A.y); H[3] = bfhi(A.y); H[4] = bflo(A.z); H[5] = bfhi(A.z); H[6] = bflo(A.w); H[7] = bfhi(A.w); \
        H[8] = bflo(B.x); H[9] = bfhi(B.x); H[10] = bflo(B.y); H[11] = bfhi(B.y); H[12] = bflo(B.z); H[13] = bfhi(B.z); H[14] = bflo(B.w); H[15] = bfhi(B.w); } while (0)
__device__ __forceinline__ void p0_transpose_item(const float* W, int K, int N, bf16* WT, const float* kscale, int nlo, float nls, LAS float* scr, int item, int lane) {
    const int nblk = N / 32, kb = item / nblk, nb = item % nblk, k0 = 64 * kb, n0 = 32 * nb;
    const float ns = (n0 + (lane & 31)) < nlo ? nls : 1.0f;
#pragma unroll 8
    for (int i = 0; i < 32; ++i) { const int kk = 2 * i + (lane >> 5); float v = W[(size_t)(k0 + kk) * N + n0 + (lane & 31)] * ns; if (kscale) v *= kscale[k0 + kk]; scr[kk * 33 + (lane & 31)] = v; }
    LDS_WAIT(); asm volatile("" ::: "memory");
    const int c = lane & 7;
#pragma unroll
    for (int j = 0; j < 4; ++j) { const int n = (lane >> 3) + 8 * j; const LAS float* s = scr + (8 * c) * 33 + n;
        v4u o; o.x = pk2(s[0 * 33], s[1 * 33]); o.y = pk2(s[2 * 33], s[3 * 33]); o.z = pk2(s[4 * 33], s[5 * 33]); o.w = pk2(s[6 * 33], s[7 * 33]);
        *(GAS v4u*)(WT + (size_t)(n0 + n) * K + k0 + 8 * c) = o; }
    LDS_WAIT(); asm volatile("" ::: "memory");
}
__device__ __forceinline__ void rms_rows4_to_bf16(const float* xrow, bf16* orow, size_t rstride, int lane) {
    f32x4 v[4][4]; float s[4];
#pragma unroll
    for (int k = 0; k < 4; ++k) { const GAS f32x4* xr = (const GAS f32x4*)(xrow + k * rstride) + lane;
#pragma unroll
        for (int j = 0; j < 4; ++j) v[k][j] = xr[64 * j]; }
#pragma unroll
    for (int k = 0; k < 4; ++k) { s[k] = 0.f;
#pragma unroll
        for (int j = 0; j < 4; ++j) s[k] += (v[k][j].x * v[k][j].x + v[k][j].y * v[k][j].y) + (v[k][j].z * v[k][j].z + v[k][j].w * v[k][j].w); }
#pragma unroll
    for (int o = 1; o < 64; o <<= 1) {
#pragma unroll
        for (int k = 0; k < 4; ++k) s[k] += shx(s[k], o, lane); }
#pragma unroll
    for (int k = 0; k < 4; ++k) { const float r = 1.f / sqrtf(s[k] * (1.f / DM) + RMS_EPS);
        GAS unsigned long long* o8 = (GAS unsigned long long*)(orow + k * rstride) + lane;
#pragma unroll
        for (int j = 0; j < 4; ++j) o8[64 * j] = (unsigned long long)pk2(v[k][j].x * r, v[k][j].y * r) | ((unsigned long long)pk2(v[k][j].z * r, v[k][j].w * r) << 32); }
}
__device__ __forceinline__ unsigned pack4_i8(float a, float b, float c, float d) {
    const int qa = (int)__builtin_rintf(a), qb = (int)__builtin_rintf(b), qc = (int)__builtin_rintf(c), qd = (int)__builtin_rintf(d);
    return (unsigned)(qa & 255) | ((unsigned)(qb & 255) << 8) | ((unsigned)(qc & 255) << 16) | ((unsigned)qd << 24);
}
__device__ __forceinline__ void rms_rows4_to_i8(const float* xrow, unsigned char* orow, float* sc, size_t rstride, size_t sstride, int lane) {
    f32x4 v[4][4]; float s[4], m[4];
#pragma unroll
    for (int k = 0; k < 4; ++k) { const GAS f32x4* xr = (const GAS f32x4*)(xrow + k * rstride) + lane;
#pragma unroll
        for (int j = 0; j < 4; ++j) v[k][j] = xr[64 * j]; }
#pragma unroll
    for (int k = 0; k < 4; ++k) { s[k] = 0.f; m[k] = 0.f;
#pragma unroll
        for (int j = 0; j < 4; ++j) { s[k] += (v[k][j].x * v[k][j].x + v[k][j].y * v[k][j].y) + (v[k][j].z * v[k][j].z + v[k][j].w * v[k][j].w);
            m[k] = fmaxf(m[k], fmaxf(fmaxf(fabsf(v[k][j].x), fabsf(v[k][j].y)), fmaxf(fabsf(v[k][j].z), fabsf(v[k][j].w)))); } }
#pragma unroll
    for (int o = 1; o < 64; o <<= 1) {
#pragma unroll
        for (int k = 0; k < 4; ++k) { s[k] += shx(s[k], o, lane); m[k] = fmaxf(m[k], shx(m[k], o, lane)); } }
#pragma unroll
    for (int k = 0; k < 4; ++k) { const float r = 1.f / sqrtf(s[k] * (1.f / DM) + RMS_EPS); const float qs = m[k] > 0.f ? 127.0f / m[k] : 1.0f;
        GAS unsigned* o4 = (GAS unsigned*)(orow + k * rstride) + lane;
#pragma unroll
        for (int j = 0; j < 4; ++j) o4[64 * j] = pack4_i8(v[k][j].x * qs, v[k][j].y * qs, v[k][j].z * qs, v[k][j].w * qs);
        if (lane == 0) sc[k * sstride] = (m[k] > 0.f ? m[k] * (1.0f / 127.0f) : 1.0f) * r; }
}
__device__ __forceinline__ void p0_colmax_item(const float* W, int N, unsigned* cmax, const float* kscale, int nlo, float nls, int item, int lane) {
    const int nblk = N / 64, ks = item / nblk, nb = item % nblk, n = 64 * nb + lane;
    const float ns = n < nlo ? nls : 1.0f;
    const float* wp = W + (size_t)(32 * ks) * N + n; const float* kp = kscale + 32 * ks;
    float m = 0.f;
#pragma unroll 8
    for (int i = 0; i < 32; ++i) { m = fmaxf(m, fabsf(wp[0] * ns * (kscale ? kp[i] : 1.0f))); wp += N; }
    __hip_atomic_fetch_max(cmax + n, __float_as_uint(m), __ATOMIC_RELAXED, __HIP_MEMORY_SCOPE_AGENT);
}
__device__ __forceinline__ void p0_quant_tile_item(const float* W, int N, unsigned char* WT8, float* colsc, const unsigned* cmax, const float* kscale, int nlo, float nls, LAS float* scr, int item, int lane) {
    const int K = 1024; const int nblk = N / 32, kb = item / nblk, nb = item % nblk, k0 = 64 * kb, n0 = 32 * nb;
    const float cm = __uint_as_float(cmax[n0 + (lane & 31)]);
    const float ns = ((n0 + (lane & 31)) < nlo ? nls : 1.0f) * (cm > 0.f ? 127.0f / cm : 1.0f);
    if (kb == 0 && lane < 32) colsc[n0 + lane] = cm > 0.f ? cm * (1.0f / 127.0f) : 1.0f;
#pragma unroll 8
    for (int i = 0; i < 32; ++i) { const int kk = 2 * i + (lane >> 5); scr[kk * 33 + (lane & 31)] = W[(size_t)(k0 + kk) * N + n0 + (lane & 31)] * ns * (kscale ? kscale[k0 + kk] : 1.0f); }
    LDS_WAIT(); asm volatile("" ::: "memory");
    const int c = lane & 7;
#pragma unroll
    for (int j = 0; j < 4; ++j) { const int n = (lane >> 3) + 8 * j; const LAS float* s = scr + (8 * c) * 33 + n;
        const unsigned lo = pack4_i8(s[0 * 33], s[1 * 33], s[2 * 33], s[3 * 33]), hi = pack4_i8(s[4 * 33], s[5 * 33], s[6 * 33], s[7 * 33]);
        *(GAS unsigned long long*)(WT8 + (size_t)(n0 + n) * K + k0 + 8 * c) = (unsigned long long)lo | ((unsigned long long)hi << 32); }
    LDS_WAIT(); asm volatile("" ::: "memory");
}
__device__ __forceinline__ void cvt8_store(const float* src, bf16* dst) {
    const f32x4 a = *(const GAS f32x4*)src, b = *(const GAS f32x4*)(src + 4);
    v4u o; o.x = pk2(a.x, a.y); o.y = pk2(a.z, a.w); o.z = pk2(b.x, b.y); o.w = pk2(b.z, b.w);
    *(GAS v4u*)dst = o;
}

__device__ __forceinline__ void attn_panel(int panel, const bf16* PQ, const bf16* PK, const bf16* PVT, bf16* YA, const int wid0) {
    const int tid = otid(wid0), lane = tid & 63, wid = __builtin_amdgcn_readfirstlane(tid >> 6);
    const int r32 = lane & 31, hh = lane >> 5;
    const size_t seq0 = (size_t)(panel >> 5) * SEQ;
    const int pos0 = (panel & 31) * 256 + wid * 32;
    const int kap = 16 * ((r32 >> 2) & 1) + (r32 & 3) + 4 * (r32 >> 3);
    for (int h = 0; h < 8; ++h) {
        bf16x8 qf[4];
        { const bf16* qrow = PQ + (seq0 + pos0 + r32) * 512 + h * 64 + 8 * hh;
#pragma unroll
          for (int s = 0; s < 4; ++s) qf[s] = *(const GAS bf16x8*)(qrow + 16 * s); }
        f32x16 o0 = {}, o1 = {};
        float Sin = 1.f;
        for (int kb = pos0; kb >= 0; kb -= 32) {
            const bf16* krow = PK + (seq0 + kb + kap) * 512 + h * 64 + 8 * hh;
            const bf16* vrow = PVT + (size_t)(h * 64 + kap) * TOK + seq0 + kb + 16 * hh;
            bf16x8 kf[4], vf[2][2];
#pragma unroll
            for (int s = 0; s < 4; ++s) kf[s] = *(const GAS bf16x8*)(krow + 16 * s);
#pragma unroll
            for (int db = 0; db < 2; ++db)
#pragma unroll
                for (int s = 0; s < 2; ++s) vf[db][s] = *(const GAS bf16x8*)(vrow + (size_t)db * 32 * TOK + 8 * s);
            f32x16 z = {};
#pragma unroll
            for (int s = 0; s < 4; ++s) z = __builtin_amdgcn_mfma_f32_32x32x16_bf16(kf[s], qf[s], z, 0, 0, 0);
            const bool diag = (kb == pos0);
            float w[16]; float Sl = 1.f;
#pragma unroll
            for (int reg = 15; reg >= 0; --reg) {
                float beta = __builtin_amdgcn_rcpf(1.0f + __builtin_amdgcn_exp2f(-z[reg]));
                if (diag && (16 * hh + reg >= r32)) beta = 0.f;
                const float wl = beta * Sl; Sl -= wl; w[reg] = wl;
            }
            const float Pp = shx(Sl, 32, lane);
            const float scale = hh ? Sin : Sin * Pp;
            Sin = Sin * Sl * Pp;
            v4u pw0, pw1;
            pw0.x = cvtpk(w[0] * scale, w[1] * scale); pw0.y = cvtpk(w[2] * scale, w[3] * scale); pw0.z = cvtpk(w[4] * scale, w[5] * scale); pw0.w = cvtpk(w[6] * scale, w[7] * scale);
            pw1.x = cvtpk(w[8] * scale, w[9] * scale); pw1.y = cvtpk(w[10] * scale, w[11] * scale); pw1.z = cvtpk(w[12] * scale, w[13] * scale); pw1.w = cvtpk(w[14] * scale, w[15] * scale);
            const bf16x8 p0 = __builtin_bit_cast(bf16x8, pw0), p1 = __builtin_bit_cast(bf16x8, pw1);
            o0 = __builtin_amdgcn_mfma_f32_32x32x16_bf16(vf[0][0], p0, o0, 0, 0, 0);
            o0 = __builtin_amdgcn_mfma_f32_32x32x16_bf16(vf[0][1], p1, o0, 0, 0, 0);
            o1 = __builtin_amdgcn_mfma_f32_32x32x16_bf16(vf[1][0], p0, o1, 0, 0, 0);
            o1 = __builtin_amdgcn_mfma_f32_32x32x16_bf16(vf[1][1], p1, o1, 0, 0, 0);
            if (__all(Sin < SURV_THR)) break;
        }
        bf16* orow = YA + (seq0 + pos0 + r32) * 1024 + (h >> 1) * 256 + (h & 1) * 64 + 16 * hh;
        v4u a, b2;
        a.x = cvtpk(o0[0], o0[1]); a.y = cvtpk(o0[2], o0[3]); a.z = cvtpk(o0[4], o0[5]); a.w = cvtpk(o0[6], o0[7]);
        b2.x = cvtpk(o0[8], o0[9]); b2.y = cvtpk(o0[10], o0[11]); b2.z = cvtpk(o0[12], o0[13]); b2.w = cvtpk(o0[14], o0[15]);
        *(GAS v4u*)orow = a; *(GAS v4u*)(orow + 8) = b2;
        a.x = cvtpk(o1[0], o1[1]); a.y = cvtpk(o1[2], o1[3]); a.z = cvtpk(o1[4], o1[5]); a.w = cvtpk(o1[6], o1[7]);
        b2.x = cvtpk(o1[8], o1[9]); b2.y = cvtpk(o1[10], o1[11]); b2.z = cvtpk(o1[12], o1[13]); b2.w = cvtpk(o1[14], o1[15]);
        *(GAS v4u*)(orow + 32) = a; *(GAS v4u*)(orow + 40) = b2;
    }
}

__device__ __forceinline__ void pool_panel(int panel, const bf16* PU, bf16* YP, const int wid0) {
    const int tid = otid(wid0);
    const int chunk = tid & 63, tg = tid >> 6, w = 2 << (chunk >> 4);
    const int posb = (panel & 31) * 256; const size_t row0 = (size_t)panel * 256;
    float s[8];
#pragma unroll
    for (int k = 0; k < 8; ++k) s[k] = 0.f;
    { const int t = tg * 32, pos = posb + t, cnt = (pos + 1 < w) ? (pos + 1) : w;
      for (int j = 1; j < cnt; ++j) { const v4u v = *(const GAS v4u*)(PU + (row0 + t - j) * 512 + chunk * 8);
          s[0] += bflo(v.x); s[1] += bfhi(v.x); s[2] += bflo(v.y); s[3] += bfhi(v.y); s[4] += bflo(v.z); s[5] += bfhi(v.z); s[6] += bflo(v.w); s[7] += bfhi(v.w); } }
    for (int i = 0; i < 32; ++i) {
        const int t = tg * 32 + i, pos = posb + t, cnt = (pos + 1 < w) ? (pos + 1) : w;
        const v4u cur = *(const GAS v4u*)(PU + (row0 + t) * 512 + chunk * 8);
        s[0] += bflo(cur.x); s[1] += bfhi(cur.x); s[2] += bflo(cur.y); s[3] += bfhi(cur.y); s[4] += bflo(cur.z); s[5] += bfhi(cur.z); s[6] += bflo(cur.w); s[7] += bfhi(cur.w);
        const float ic = 1.0f / (float)cnt;
        v4u o;
        o.x = cvtpk(s[0] * ic - bflo(cur.x), s[1] * ic - bfhi(cur.x)); o.y = cvtpk(s[2] * ic - bflo(cur.y), s[3] * ic - bfhi(cur.y));
        o.z = cvtpk(s[4] * ic - bflo(cur.z), s[5] * ic - bfhi(cur.z)); o.w = cvtpk(s[6] * ic - bflo(cur.w), s[7] * ic - bfhi(cur.w));
        *(GAS v4u*)(YP + (row0 + t) * 1024 + (chunk >> 4) * 256 + 128 + (chunk & 15) * 8) = o;
        if (pos + 1 >= w) {
            const v4u v = *(const GAS v4u*)(PU + (row0 + t - (w - 1)) * 512 + chunk * 8);
            s[0] -= bflo(v.x); s[1] -= bfhi(v.x); s[2] -= bflo(v.y); s[3] -= bfhi(v.y); s[4] -= bflo(v.z); s[5] -= bfhi(v.z); s[6] -= bflo(v.w); s[7] -= bfhi(v.w);
        }
    }
}

#define HD __host__ __device__ __forceinline__
HD int f2s(float f) { int i = __builtin_bit_cast(int, f); return i ^ ((i >> 31) & 0x7fffffff); }
HD float s2f(int i) { i ^= ((i >> 31) & 0x7fffffff); return __builtin_bit_cast(float, i); }
HD void ce_desc(int& a, int& b) { const int mx = a > b ? a : b, mn = a > b ? b : a; a = mx; b = mn; }
template <int J, int K> HD void bpass16(int (&v)[16]) {
#pragma unroll
    for (int i = 0; i < 16; ++i) { const int l = i ^ J; if (l > i) { if ((i & K) == 0) ce_desc(v[i], v[l]); else ce_desc(v[l], v[i]); } }
}
HD void bitonic_sort16_desc(int (&v)[16]) {
    bpass16<1, 2>(v); bpass16<2, 4>(v); bpass16<1, 4>(v); bpass16<4, 8>(v); bpass16<2, 8>(v); bpass16<1, 8>(v);
    bpass16<8, 16>(v); bpass16<4, 16>(v); bpass16<2, 16>(v); bpass16<1, 16>(v);
}
HD void bitonic_merge16_desc(int (&v)[16]) {
    bpass16<8, 16>(v); bpass16<4, 16>(v); bpass16<2, 16>(v); bpass16<1, 16>(v);
}
HD void merge_prune16(int (&x)[16], const int (&y)[16]) {
#pragma unroll
    for (int i = 0; i < 16; ++i) x[i] = x[i] > y[15 - i] ? x[i] : y[15 - i];
    bitonic_merge16_desc(x);
}
HD int cx_i(int hf, int t) { if (hf == 0) return 0; return t < 5 ? 2 : t < 9 ? 3 : t < 12 ? 4 : t < 14 ? 5 : 6; }
HD int cx_j(int hf, int t) { if (hf == 0) return t; return t < 5 ? t : t < 9 ? t - 5 : t < 12 ? t - 9 : t < 14 ? t - 12 : t - 14; }
HD int cy_i(int hf, int t) { if (hf == 0) return t < 8 ? 1 : 23 - t; return 7; }
HD int cy_j(int hf, int t) { if (hf == 0) return t < 8 ? t : 0; return t; }

__device__ __forceinline__ void top16_of_group(const bf16x8 (&qf)[8], LAS const unsigned char* skl, int r32, int hh, int lane, int (&res)[16]) {
    int v[4][16];
#pragma unroll
    for (int kb = 0; kb < 4; ++kb) {
        f32x16 acc = {};
#pragma unroll
        for (int s = 0; s < 8; ++s) { const bf16x8 af = *(LAS const bf16x8*)(skl + (32 * kb + r32) * 272 + 32 * s + 16 * hh); acc = __builtin_amdgcn_mfma_f32_32x32x16_bf16(af, qf[s], acc, 0, 0, 0); }
#pragma unroll
        for (int reg = 0; reg < 16; ++reg) { const int keyid = 32 * kb + (reg & 3) + 8 * (reg >> 2) + 4 * hh; v[kb][reg] = (f2s(acc[reg]) & ~127) | keyid; }
    }
    bitonic_sort16_desc(v[0]); bitonic_sort16_desc(v[1]); bitonic_sort16_desc(v[2]); bitonic_sort16_desc(v[3]);
    merge_prune16(v[0], v[1]); merge_prune16(v[2], v[3]); merge_prune16(v[0], v[2]);
    int y[16];
#pragma unroll
    for (int i = 0; i < 16; ++i) y[i] = shx(v[0][i], 32, lane);
    merge_prune16(v[0], y);
#pragma unroll
    for (int i = 0; i < 16; ++i) res[i] = v[0][i];
}

__device__ __forceinline__ void topk_panel(int panel, const bf16* QP, const bf16* SK, int* IDXp, float* GTp  , LAS unsigned char* ldsb  , const int wid0) {
    const int tid = otid(wid0), lane = tid & 63, wid = __builtin_amdgcn_readfirstlane(tid >> 6);
    const int r32 = lane & 31, hh = lane >> 5;
    const int lrow = wid * 32 + r32;
    const size_t row = (size_t)panel * 256 + lrow;
    LAS int* lut = (LAS int*)ldsb; LAS unsigned char* skl = ldsb + 65536;
    v4u skr[4];
#define SK_FETCH(g_) do { _Pragma("unroll") for (int i = 0; i < 4; ++i) skr[i] = *((const GAS v4u*)(SK + (size_t)(g_) * 128 * 128) + i * 512 + tid); } while (0)
#define SK_STAGE() do { _Pragma("unroll") for (int i = 0; i < 4; ++i) { const int p = i * 512 + tid; *(LAS v4u*)(skl + (p >> 4) * 272 + (p & 15) * 16) = skr[i]; } } while (0)
    bf16x8 qn[8];
#define Q_FETCH(g_) do { const bf16* qrow_ = QP + row * 2048 + (g_) * 128 + 8 * hh; _Pragma("unroll") for (int s = 0; s < 8; ++s) qn[s] = *(const GAS bf16x8*)(qrow_ + 16 * s); } while (0)
    SK_FETCH(0); Q_FETCH(0);
    for (int h = 0; h < 8; ++h) {
        int a[16], b[16];
#pragma unroll
        for (int c = 0; c < 2; ++c) {
            const int g = 2 * h + c;
            bf16x8 qf[8];
#pragma unroll
            for (int s = 0; s < 8; ++s) qf[s] = qn[s];
            __syncthreads();
            SK_STAGE();
            __syncthreads();
            if (g < 15) { SK_FETCH(g + 1); Q_FETCH(g + 1); }
            if (c == 0) top16_of_group(qf, skl, r32, hh, lane, a); else top16_of_group(qf, skl, r32, hh, lane, b);
        }
        float fa[16], fb[16];
#pragma unroll
        for (int i = 0; i < 16; ++i) { fa[i] = s2f(a[i] & ~127); fb[i] = s2f(b[i] & ~127); lut[i * 512 + tid] = a[i] & 127; lut[(16 + i) * 512 + tid] = b[i] & 127; }
        int X[16], Y[16];
#pragma unroll
        for (int t = 0; t < 16; ++t) {
            const float s0 = fa[cx_i(0, t)] + fb[cx_j(0, t)], s1 = fa[cx_i(1, t)] + fb[cx_j(1, t)];
            const int c0 = cx_i(0, t) * 16 + cx_j(0, t), c1 = cx_i(1, t) * 16 + cx_j(1, t);
            X[t] = hh ? ((f2s(s1) & ~255) | c1) : ((f2s(s0) & ~255) | c0);
            const float u0 = fa[cy_i(0, t)] + fb[cy_j(0, t)];
            const int d0 = cy_i(0, t) * 16 + cy_j(0, t);
            int y1 = (int)0x80000000;
            if (t < 2) { const float u1 = fa[cy_i(1, t)] + fb[cy_j(1, t)]; y1 = (f2s(u1) & ~255) | (cy_i(1, t) * 16 + cy_j(1, t)); }
            Y[t] = hh ? y1 : ((f2s(u0) & ~255) | d0);
        }
        bitonic_sort16_desc(X); bitonic_merge16_desc(Y); merge_prune16(X, Y);
#pragma unroll
        for (int i = 0; i < 16; ++i) Y[i] = shx(X[i], 32, lane);
        merge_prune16(X, Y);
        const float mx = s2f(X[0] & ~255);
        float ex[16], den = 0.f;
#pragma unroll
        for (int i = 0; i < 16; ++i) { ex[i] = __builtin_amdgcn_exp2f((s2f(X[i] & ~255) - mx) * 1.4426950408889634f); den += ex[i]; }
        const float rden = 1.0f / den;
        int oi[8]; float og[8];
#pragma unroll
        for (int t = 0; t < 8; ++t) {
            const int msk = -hh;
            const int code = (X[t] ^ ((X[t] ^ X[8 + t]) & msk)) & 255;
            const int e1 = lut[(code >> 4) * 512 + tid], e2 = lut[(16 + (code & 15)) * 512 + tid];
            const int exl = __builtin_bit_cast(int, ex[t]), exh = __builtin_bit_cast(int, ex[8 + t]);
            oi[t] = e1 * 128 + e2; og[t] = __builtin_bit_cast(float, exl ^ ((exl ^ exh) & msk)) * rden;
        }
        int* ip = IDXp + lrow * 128 + h * 16 + 8 * hh; float* gp = GTp + lrow * 128 + h * 16 + 8 * hh;
        *(GAS v4u*)ip = (v4u){(unsigned)oi[0], (unsigned)oi[1], (unsigned)oi[2], (unsigned)oi[3]}; *(GAS v4u*)(ip + 4) = (v4u){(unsigned)oi[4], (unsigned)oi[5], (unsigned)oi[6], (unsigned)oi[7]};
        *(GAS f32x4*)gp = (f32x4){og[0], og[1], og[2], og[3]}; *(GAS f32x4*)(gp + 4) = (f32x4){og[4], og[5], og[6], og[7]};
    }
#undef SK_FETCH
#undef SK_STAGE
#undef Q_FETCH
}

typedef float f32x2v __attribute__((ext_vector_type(2)));
__device__ __forceinline__ void quant_row_fp8(const float* src, const float* colgain, unsigned char* dst, float* sc_out, int lane) {
    const GAS f32x4* s = (const GAS f32x4*)src + 4 * lane;
    f32x4 v[4]; float m = 0.f;
#pragma unroll
    for (int j = 0; j < 4; ++j) { v[j] = s[j]; if (colgain) v[j] = v[j] * ((const GAS f32x4*)colgain + 4 * lane)[j]; m = fmaxf(m, fmaxf(fmaxf(fabsf(v[j].x), fabsf(v[j].y)), fmaxf(fabsf(v[j].z), fabsf(v[j].w)))); }
#pragma unroll
    for (int o = 1; o < 64; o <<= 1) m = fmaxf(m, shx(m, o, lane));
    const float sc = m > 0.f ? 224.0f / m : 1.0f;
    v4u w;
    { int t = 0; t = __builtin_amdgcn_cvt_pk_fp8_f32(v[0].x * sc, v[0].y * sc, t, false); t = __builtin_amdgcn_cvt_pk_fp8_f32(v[0].z * sc, v[0].w * sc, t, true); w.x = (unsigned)t; }
    { int t = 0; t = __builtin_amdgcn_cvt_pk_fp8_f32(v[1].x * sc, v[1].y * sc, t, false); t = __builtin_amdgcn_cvt_pk_fp8_f32(v[1].z * sc, v[1].w * sc, t, true); w.y = (unsigned)t; }
    { int t = 0; t = __builtin_amdgcn_cvt_pk_fp8_f32(v[2].x * sc, v[2].y * sc, t, false); t = __builtin_amdgcn_cvt_pk_fp8_f32(v[2].z * sc, v[2].w * sc, t, true); w.z = (unsigned)t; }
    { int t = 0; t = __builtin_amdgcn_cvt_pk_fp8_f32(v[3].x * sc, v[3].y * sc, t, false); t = __builtin_amdgcn_cvt_pk_fp8_f32(v[3].z * sc, v[3].w * sc, t, true); w.w = (unsigned)t; }
    *(GAS v4u*)(dst + 16 * lane) = w;
    if (lane == 0) *sc_out = m > 0.f ? m * (1.0f / 224.0f) : 1.0f;
}
__device__ __forceinline__ v4u quant16_fp8(const f32x4 (&v)[4], float sc) {
    v4u w;
    { int t = 0; t = __builtin_amdgcn_cvt_pk_fp8_f32(v[0].x * sc, v[0].y * sc, t, false); t = __builtin_amdgcn_cvt_pk_fp8_f32(v[0].z * sc, v[0].w * sc, t, true); w.x = (unsigned)t; }
    { int t = 0; t = __builtin_amdgcn_cvt_pk_fp8_f32(v[1].x * sc, v[1].y * sc, t, false); t = __builtin_amdgcn_cvt_pk_fp8_f32(v[1].z * sc, v[1].w * sc, t, true); w.y = (unsigned)t; }
    { int t = 0; t = __builtin_amdgcn_cvt_pk_fp8_f32(v[2].x * sc, v[2].y * sc, t, false); t = __builtin_amdgcn_cvt_pk_fp8_f32(v[2].z * sc, v[2].w * sc, t, true); w.z = (unsigned)t; }
    { int t = 0; t = __builtin_amdgcn_cvt_pk_fp8_f32(v[3].x * sc, v[3].y * sc, t, false); t = __builtin_amdgcn_cvt_pk_fp8_f32(v[3].z * sc, v[3].w * sc, t, true); w.w = (unsigned)t; }
    return w;
}
__device__ __forceinline__ v4u quant16_i8(const f32x4 (&v)[4], float sc) {
    v4u w; w.x = pack4_i8(v[0].x * sc, v[0].y * sc, v[0].z * sc, v[0].w * sc); w.y = pack4_i8(v[1].x * sc, v[1].y * sc, v[1].z * sc, v[1].w * sc);
    w.z = pack4_i8(v[2].x * sc, v[2].y * sc, v[2].z * sc, v[2].w * sc); w.w = pack4_i8(v[3].x * sc, v[3].y * sc, v[3].z * sc, v[3].w * sc); return w;
}
__device__ __forceinline__ void quant_rows2_fp8(const float* srcA, const float* gainA, unsigned char* dstA, float* scA, const float* srcB, unsigned char* dstB, float* scB, int lane) {
    f32x4 va[4], vb[4];
#pragma unroll
    for (int j = 0; j < 4; ++j) { va[j] = ((const GAS f32x4*)srcA + 4 * lane)[j]; vb[j] = ((const GAS f32x4*)srcB + 4 * lane)[j]; }
    float ma = 0.f, mb = 0.f;
#pragma unroll
    for (int j = 0; j < 4; ++j) { va[j] = va[j] * ((const GAS f32x4*)gainA + 4 * lane)[j];
        ma = fmaxf(ma, fmaxf(fmaxf(fabsf(va[j].x), fabsf(va[j].y)), fmaxf(fabsf(va[j].z), fabsf(va[j].w))));
        mb = fmaxf(mb, fmaxf(fmaxf(fabsf(vb[j].x), fabsf(vb[j].y)), fmaxf(fabsf(vb[j].z), fabsf(vb[j].w)))); }
#pragma unroll
    for (int o = 1; o < 64; o <<= 1) { ma = fmaxf(ma, shx(ma, o, lane)); mb = fmaxf(mb, shx(mb, o, lane)); }
    *(GAS v4u*)(dstA + 16 * lane) = quant16_i8(va, ma > 0.f ? 127.0f / ma : 1.0f);
    *(GAS v4u*)(dstB + 16 * lane) = quant16_fp8(vb, mb > 0.f ? 224.0f / mb : 1.0f);
    if (lane == 0) { *scA = ma > 0.f ? ma * (1.0f / 127.0f) : 1.0f; *scB = mb > 0.f ? mb * (1.0f / 224.0f) : 1.0f; }
}
__device__ __forceinline__ void p0_rows4_expert(const float* xrow, unsigned char* orow, float* sc, size_t rstride, size_t sstride,
                                                const float* srcA, const float* gainA, unsigned char* dstA, float* scA, const float* srcB, unsigned char* dstB, float* scB, int lane) {
    f32x4 v[4][4], va[4], vb[4], ga[4]; float s[4], m[4];
#pragma unroll
    for (int k = 0; k < 4; ++k) { const GAS f32x4* xr = (const GAS f32x4*)(xrow + k * rstride) + lane;
#pragma unroll
        for (int j = 0; j < 4; ++j) v[k][j] = xr[64 * j]; }
#pragma unroll
    for (int j = 0; j < 4; ++j) { va[j] = ((const GAS f32x4*)srcA + 4 * lane)[j]; vb[j] = ((const GAS f32x4*)srcB + 4 * lane)[j]; ga[j] = ((const GAS f32x4*)gainA + 4 * lane)[j]; }
#pragma unroll
    for (int k = 0; k < 4; ++k) { s[k] = 0.f; m[k] = 0.f;
#pragma unroll
        for (int j = 0; j < 4; ++j) { s[k] += (v[k][j].x * v[k][j].x + v[k][j].y * v[k][j].y) + (v[k][j].z * v[k][j].z + v[k][j].w * v[k][j].w);
            m[k] = fmaxf(m[k], fmaxf(fmaxf(fabsf(v[k][j].x), fabsf(v[k][j].y)), fmaxf(fabsf(v[k][j].z), fabsf(v[k][j].w)))); } }
    float ma = 0.f, mb = 0.f;
#pragma unroll
    for (int j = 0; j < 4; ++j) { va[j] = va[j] * ga[j];
        ma = fmaxf(ma, fmaxf(fmaxf(fabsf(va[j].x), fabsf(va[j].y)), fmaxf(fabsf(va[j].z), fabsf(va[j].w))));
        mb = fmaxf(mb, fmaxf(fmaxf(fabsf(vb[j].x), fabsf(vb[j].y)), fmaxf(fabsf(vb[j].z), fabsf(vb[j].w)))); }
#pragma unroll
    for (int o = 1; o < 64; o <<= 1) {
#pragma unroll
        for (int k = 0; k < 4; ++k) { s[k] += shx(s[k], o, lane); m[k] = fmaxf(m[k], shx(m[k], o, lane)); }
        ma = fmaxf(ma, shx(ma, o, lane)); mb = fmaxf(mb, shx(mb, o, lane)); }
#pragma unroll
    for (int k = 0; k < 4; ++k) { const float r = 1.f / sqrtf(s[k] * (1.f / DM) + RMS_EPS); const float qs = m[k] > 0.f ? 127.0f / m[k] : 1.0f;
        GAS unsigned* o4 = (GAS unsigned*)(orow + k * rstride) + lane;
#pragma unroll
        for (int j = 0; j < 4; ++j) o4[64 * j] = pack4_i8(v[k][j].x * qs, v[k][j].y * qs, v[k][j].z * qs, v[k][j].w * qs);
        if (lane == 0) sc[k * sstride] = (m[k] > 0.f ? m[k] * (1.0f / 127.0f) : 1.0f) * r; }
    *(GAS v4u*)(dstA + 16 * lane) = quant16_i8(va, ma > 0.f ? 127.0f / ma : 1.0f);
    *(GAS v4u*)(dstB + 16 * lane) = quant16_fp8(vb, mb > 0.f ? 224.0f / mb : 1.0f);
    if (lane == 0) { *scA = ma > 0.f ? ma * (1.0f / 127.0f) : 1.0f; *scB = mb > 0.f ? mb * (1.0f / 224.0f) : 1.0f; }
}
template <bool USE_R = true>
__device__ __forceinline__ void peer_hq_panel(const bf16* X1B, unsigned char* H8p, LAS const float* r1, LAS float* s1h, const int wid0) {
    const int tid = otid(wid0), lane = tid & 63, wid = __builtin_amdgcn_readfirstlane(tid >> 6);
    for (int ti = 0; ti < 16; ++ti) {
        float h[2][16], m[2];
#pragma unroll
        for (int q = 0; q < 2; ++q) { const bf16* xp = X1B + (size_t)(wid * 32 + ti + 16 * q) * DM + 16 * lane; const v4u a = *(const GAS v4u*)xp, b2 = *(const GAS v4u*)(xp + 8); H_UNPACK(h[q], a, b2); }
#pragma unroll
        for (int q = 0; q < 2; ++q) { m[q] = 0.f;
#pragma unroll
            for (int k = 0; k < 16; ++k) m[q] = fmaxf(m[q], fabsf(h[q][k])); }
#pragma unroll
        for (int o = 1; o < 64; o <<= 1) { m[0] = fmaxf(m[0], shx(m[0], o, lane)); m[1] = fmaxf(m[1], shx(m[1], o, lane)); }
#pragma unroll
        for (int q = 0; q < 2; ++q) { const int lrow = wid * 32 + ti + 16 * q; const float sc = m[q] > 0.f ? 127.0f / m[q] : 1.0f;
            v4u w; w.x = pack4_i8(h[q][0] * sc, h[q][1] * sc, h[q][2] * sc, h[q][3] * sc); w.y = pack4_i8(h[q][4] * sc, h[q][5] * sc, h[q][6] * sc, h[q][7] * sc);
            w.z = pack4_i8(h[q][8] * sc, h[q][9] * sc, h[q][10] * sc, h[q][11] * sc); w.w = pack4_i8(h[q][12] * sc, h[q][13] * sc, h[q][14] * sc, h[q][15] * sc);
            *(GAS v4u*)(H8p + (size_t)lrow * DM + 16 * lane) = w;
            if (lane == 0) s1h[lrow] = (USE_R ? r1[lrow] : 1.0f) * (m[q] > 0.f ? m[q] * (1.0f / 127.0f) : 1.0f); }
    }
}
__device__ __forceinline__ int dot16_i8(const v4u u, const v4u h) {
    int a = __builtin_amdgcn_sdot4((int)u.x, (int)h.x, 0, false), b = __builtin_amdgcn_sdot4((int)u.y, (int)h.y, 0, false);
    a = __builtin_amdgcn_sdot4((int)u.z, (int)h.z, a, false); b = __builtin_amdgcn_sdot4((int)u.w, (int)h.w, b, false);
    return a + b;
}
#define RS_LEVEL_I(v, n, m) do { _Pragma("unroll") for (int _e = 0; _e < (n); ++_e) { const bool _up = (lane & (m)) != 0; const int _send = _up ? v[_e] : v[_e + (n)]; const int _keep = _up ? v[_e + (n)] : v[_e]; v[_e] = _keep + shx(_send, (m), lane); } } while (0)
__device__ __forceinline__ void dq4(unsigned w, float (&f)[4]) {
    const f32x2v lo = __builtin_amdgcn_cvt_pk_f32_fp8((int)w, false), hi = __builtin_amdgcn_cvt_pk_f32_fp8((int)w, true);
    f[0] = lo.x; f[1] = lo.y; f[2] = hi.x; f[3] = hi.y;
}
__device__ __forceinline__ float dot16_fp8(const v4u u, const float (&h)[16]) {
    const f32x2v x0 = __builtin_amdgcn_cvt_pk_f32_fp8((int)u.x, false), x1 = __builtin_amdgcn_cvt_pk_f32_fp8((int)u.x, true);
    const f32x2v y0 = __builtin_amdgcn_cvt_pk_f32_fp8((int)u.y, false), y1 = __builtin_amdgcn_cvt_pk_f32_fp8((int)u.y, true);
    const f32x2v z0 = __builtin_amdgcn_cvt_pk_f32_fp8((int)u.z, false), z1 = __builtin_amdgcn_cvt_pk_f32_fp8((int)u.z, true);
    const f32x2v w0 = __builtin_amdgcn_cvt_pk_f32_fp8((int)u.w, false), w1 = __builtin_amdgcn_cvt_pk_f32_fp8((int)u.w, true);
    f32x2v a = x0 * (f32x2v){h[0], h[1]}, b = x1 * (f32x2v){h[2], h[3]};
    a = __builtin_elementwise_fma(y0, (f32x2v){h[4], h[5]}, a); b = __builtin_elementwise_fma(y1, (f32x2v){h[6], h[7]}, b);
    a = __builtin_elementwise_fma(z0, (f32x2v){h[8], h[9]}, a); b = __builtin_elementwise_fma(z1, (f32x2v){h[10], h[11]}, b);
    a = __builtin_elementwise_fma(w0, (f32x2v){h[12], h[13]}, a); b = __builtin_elementwise_fma(w1, (f32x2v){h[14], h[15]}, b);
    const f32x2v s = a + b;
    return s.x + s.y;
}
__device__ __forceinline__ void fma16_fp8(float (&o)[16], float cf, const v4u v) {
    float f0[4], f1[4], f2[4], f3[4]; dq4(v.x, f0); dq4(v.y, f1); dq4(v.z, f2); dq4(v.w, f3);
#pragma unroll
    for (int k = 0; k < 4; ++k) { o[k] = fmaf(cf, f0[k], o[k]); o[4 + k] = fmaf(cf, f1[k], o[4 + k]); o[8 + k] = fmaf(cf, f2[k], o[8 + k]); o[12 + k] = fmaf(cf, f3[k], o[12 + k]); }
}
__device__ __forceinline__ void fma16_fp8v(f32x2v (&o)[8], float cf, const v4u v) {
    const f32x2v c2 = (f32x2v){cf, cf};
    o[0] = __builtin_elementwise_fma(__builtin_amdgcn_cvt_pk_f32_fp8((int)v.x, false), c2, o[0]); o[1] = __builtin_elementwise_fma(__builtin_amdgcn_cvt_pk_f32_fp8((int)v.x, true), c2, o[1]);
    o[2] = __builtin_elementwise_fma(__builtin_amdgcn_cvt_pk_f32_fp8((int)v.y, false), c2, o[2]); o[3] = __builtin_elementwise_fma(__builtin_amdgcn_cvt_pk_f32_fp8((int)v.y, true), c2, o[3]);
    o[4] = __builtin_elementwise_fma(__builtin_amdgcn_cvt_pk_f32_fp8((int)v.z, false), c2, o[4]); o[5] = __builtin_elementwise_fma(__builtin_amdgcn_cvt_pk_f32_fp8((int)v.z, true), c2, o[5]);
    o[6] = __builtin_elementwise_fma(__builtin_amdgcn_cvt_pk_f32_fp8((int)v.w, false), c2, o[6]); o[7] = __builtin_elementwise_fma(__builtin_amdgcn_cvt_pk_f32_fp8((int)v.w, true), c2, o[7]);
}
__device__ __forceinline__ float gelu_as(float v) {
    const float av = fabsf(v), t = __builtin_amdgcn_rcpf(av * 0.2316418882f + 1.0f);
    float q = t * 0.5307027145f + (-0.7265760135f); q = q * t + 0.7107068705f; q = q * t + (-0.142248368f); q = q * t + 0.127414796f; q = q * t;
    const float e = __builtin_amdgcn_exp2f((v * v) * (-0.72134752044f));
    const float m = v * (q * e);
    return v < 0.f ? m : v - m;
}
#define RS_LEVEL(v, n, m) do { _Pragma("unroll") for (int _e = 0; _e < (n); ++_e) { const bool _up = (lane & (m)) != 0; const float _send = _up ? v[_e] : v[_e + (n)]; const float _keep = _up ? v[_e + (n)] : v[_e]; v[_e] = _keep + shx(_send, m, lane); } } while (0)
#define BS_CE(KV, EOFF, K, J) { const int p_ = shx(KV, J, lane); const bool asc_ = (((lane + (EOFF)) & (K)) == 0); const int mn_ = KV < p_ ? KV : p_, mx_ = KV < p_ ? p_ : KV; KV = (lower_ == asc_) ? mn_ : mx_; }
#define BS_STAGE(K, J) do { const bool lower_ = (lane & (J)) == 0; BS_CE(k0, 0, K, J) BS_CE(k1, 64, K, J) BS_CE(k2, 0, K, J) BS_CE(k3, 64, K, J) } while (0)
__device__ __forceinline__ void peer_sort_panel(int* IDXp, float* GTp, float* SUp, const float* SU, const float* SV, const int wid0) {
    const int tid = otid(wid0), lane = tid & 63, wid = __builtin_amdgcn_readfirstlane(tid >> 6);
    int ni[4]; float ng[4];
#pragma unroll
    for (int q = 0; q < 4; ++q) { const int o = (wid * 32 + (q >> 1) * 16) * 128 + (q & 1) * 64 + lane; ni[q] = IDXp[o]; ng[q] = GTp[o]; }
    for (int ti = 0; ti < 16; ++ti) {
        const int lrow = wid * 32 + ti;
        int ci[4]; float cg[4];
#pragma unroll
        for (int q = 0; q < 4; ++q) { ci[q] = ni[q]; cg[q] = ng[q]; }
        if (ti < 15) {
#pragma unroll
            for (int q = 0; q < 4; ++q) { const int o = (lrow + 1 + (q >> 1) * 16) * 128 + (q & 1) * 64 + lane; ni[q] = IDXp[o]; ng[q] = GTp[o]; } }
        float cu[4], cw[4];
#pragma unroll
        for (int q = 0; q < 4; ++q) { cu[q] = SU[ci[q]]; cw[q] = SV[ci[q]] * cg[q]; }
        int k0 = (ci[0] << 7) | lane, k1 = (ci[1] << 7) | (64 + lane), k2 = (ci[2] << 7) | lane, k3 = (ci[3] << 7) | (64 + lane);
        BS_STAGE(2, 1);
        BS_STAGE(4, 2); BS_STAGE(4, 1);
        BS_STAGE(8, 4); BS_STAGE(8, 2); BS_STAGE(8, 1);
        BS_STAGE(16, 8); BS_STAGE(16, 4); BS_STAGE(16, 2); BS_STAGE(16, 1);
        BS_STAGE(32, 16); BS_STAGE(32, 8); BS_STAGE(32, 4); BS_STAGE(32, 2); BS_STAGE(32, 1);
        BS_STAGE(64, 32); BS_STAGE(64, 16); BS_STAGE(64, 8); BS_STAGE(64, 4); BS_STAGE(64, 2); BS_STAGE(64, 1);
        { const int mn_ = k0 < k1 ? k0 : k1, mx_ = k0 < k1 ? k1 : k0; k0 = mn_; k1 = mx_; }
        { const int mn_ = k2 < k3 ? k2 : k3, mx_ = k2 < k3 ? k3 : k2; k2 = mn_; k3 = mx_; }
        BS_STAGE(128, 32); BS_STAGE(128, 16); BS_STAGE(128, 8); BS_STAGE(128, 4); BS_STAGE(128, 2); BS_STAGE(128, 1);
#define BS_OUT(KA, KB, UA, UB, WA, WB, LR) do { const int s0 = KA & 127, s1 = KB & 127; \
        const float ua0 = shl_(UA, s0 & 63), ub0 = shl_(UB, s0 & 63), ua1 = shl_(UA, s1 & 63), ub1 = shl_(UB, s1 & 63); \
        const float wa0 = shl_(WA, s0 & 63), wb0 = shl_(WB, s0 & 63), wa1 = shl_(WA, s1 & 63), wb1 = shl_(WB, s1 & 63); \
        IDXp[(LR) * 128 + lane] = KA >> 7; IDXp[(LR) * 128 + 64 + lane] = KB >> 7; \
        SUp[(LR) * 128 + lane] = (s0 < 64) ? ua0 : ub0; SUp[(LR) * 128 + 64 + lane] = (s1 < 64) ? ua1 : ub1; \
        GTp[(LR) * 128 + lane] = (s0 < 64) ? wa0 : wb0; GTp[(LR) * 128 + 64 + lane] = (s1 < 64) ? wa1 : wb1; } while (0)
        BS_OUT(k0, k1, cu[0], cu[1], cw[0], cw[1], lrow);
        BS_OUT(k2, k3, cu[2], cu[3], cw[2], cw[3], lrow + 16);
#undef BS_OUT
    }
}
#define DPPC_ROR8 0x128
#define DPPC_SHL4 0x104
#define DPPC_SHR4 0x114
#define DPPC_X2 0x4E
#define DPPC_X1 0xB1
template <int CTRL> __device__ __forceinline__ int dpp_i(int x) { return __builtin_amdgcn_update_dpp(0, x, CTRL, 0xF, 0xF, true); }
__device__ __forceinline__ int dot16_i8c(const v4u u, const v4u h) {
    int a = __builtin_amdgcn_sdot4((int)u.x, (int)h.x, 0, false);
    a = __builtin_amdgcn_sdot4((int)u.y, (int)h.y, a, false); a = __builtin_amdgcn_sdot4((int)u.z, (int)h.z, a, false); a = __builtin_amdgcn_sdot4((int)u.w, (int)h.w, a, false);
    return a;
}
template <int NP>
__device__ __forceinline__ void peer_usweep2_panel(const int dp, const unsigned char* H8p, LAS const float* s1h, const int* IDXp, const float* GMp, const float* SUp, float* CFp, const unsigned char* EU8, const int wid0) {
    constexpr int LG = 64 / NP, TG = 16 / NP, NSTEP = 16 * TG;
    const int wid = wid0;
    const int lane = lane_id();
    const int grp = lane / LG, tq = (lane >> 3) & 1, pj = lane & 7;
    const unsigned kof = (unsigned)(1024 / NP) * (unsigned)dp + 16u * (unsigned)(lane & (LG - 1));
    const int gb4 = (lane & ~(LG - 1)) << 2;
    const bool last = dp == NP - 1;
    int ix_n, pd_n = 0; float gm_n = 0.f, su_n = 0.f; v4u h0_n, h1_n;
#define US2_META(s_) do { const int c_ = (s_) / TG, tg_ = (s_) % TG; const int lr_ = wid * 32 + 2 * NP * tg_ + 2 * grp; const int off_ = (lr_ + tq) * 128 + 8 * c_ + pj; \
        ix_n = IDXp[off_] << 10; \
        if (dp) pd_n = ((const int*)CFp)[off_]; \
        if (last) { gm_n = GMp[off_]; su_n = SUp[off_] * s1h[lr_ + tq]; } \
        const unsigned char* h0_ = H8p + (unsigned)(lr_ * DM) + kof; h0_n = *(const GAS v4u*)h0_; h1_n = *(const GAS v4u*)(h0_ + DM); } while (0)
#ifndef STAG_U
#define STAG_U 40
#endif
    if (STAG_U && wid >= 4) __builtin_amdgcn_s_sleep(STAG_U);
    US2_META(0);
#pragma nounroll
    for (int s = 0; s < NSTEP; ++s) {
        const int ix10 = ix_n, pd = pd_n; const float gm = gm_n, su = su_n; const v4u h0 = h0_n, h1 = h1_n;
        v4u ua[16]; int p[16];
        unsigned exo[16];
#pragma unroll
        for (int j = 0; j < 16; ++j) exo[j] = (unsigned)__builtin_amdgcn_ds_bpermute(gb4 + 4 * j, ix10) + kof;
        asm volatile("" : "+v"(exo[0]), "+v"(exo[1]), "+v"(exo[2]), "+v"(exo[3]), "+v"(exo[4]), "+v"(exo[5]), "+v"(exo[6]), "+v"(exo[7]), "+v"(exo[8]), "+v"(exo[9]), "+v"(exo[10]), "+v"(exo[11]), "+v"(exo[12]), "+v"(exo[13]), "+v"(exo[14]), "+v"(exo[15]));
#pragma unroll
        for (int j = 0; j < 8; ++j) ua[j] = *(const GAS v4u*)(EU8 + exo[j]);
        if (s < NSTEP - 1) US2_META(s + 1);
#pragma unroll
        for (int j = 0; j < 8; ++j) p[j] = dot16_i8c(ua[j], h0);
        asm volatile("" : "+v"(p[0]), "+v"(p[1]), "+v"(p[2]), "+v"(p[3]), "+v"(p[4]), "+v"(p[5]), "+v"(p[6]), "+v"(p[7]) :: "memory");
#pragma unroll
        for (int j = 8; j < 16; ++j) ua[j] = *(const GAS v4u*)(EU8 + exo[j]);
#pragma unroll
        for (int j = 8; j < 16; ++j) p[j] = dot16_i8c(ua[j], h1);
        const bool b3 = (lane & 8) != 0, b2 = (lane & 4) != 0, b1 = (lane & 2) != 0, b0 = (lane & 1) != 0;
#pragma unroll
        for (int e = 0; e < 8; ++e) { const int t = p[e] + dpp_i<DPPC_ROR8>(p[e]), u = p[e + 8] + dpp_i<DPPC_ROR8>(p[e + 8]); p[e] = b3 ? u : t; }
#pragma unroll
        for (int e = 0; e < 4; ++e) { const int t = p[e] + dpp_i<DPPC_SHL4>(p[e]), u = p[e + 4] + dpp_i<DPPC_SHR4>(p[e + 4]); p[e] = b2 ? u : t; }
#pragma unroll
        for (int e = 0; e < 2; ++e) { const int t = p[e] + dpp_i<DPPC_X2>(p[e]), u = p[e + 2] + dpp_i<DPPC_X2>(p[e + 2]); p[e] = b1 ? u : t; }
        int di; { const int t = p[0] + dpp_i<DPPC_X1>(p[0]), u = p[1] + dpp_i<DPPC_X1>(p[1]); di = b0 ? u : t; }
        if (NP == 2) { const auto r = __builtin_amdgcn_permlane16_swap(di, di, false, false); di = (int)r[0] + (int)r[1]; }
        di += pd;
        const int c = s / TG, tg = s % TG;
        const int off = (wid * 32 + 2 * NP * tg + 2 * grp + tq) * 128 + 8 * c + pj;
        const bool st = NP == 4 || (lane & 16) == 0;
        if (!last) { if (st) ((int*)CFp)[off] = di; }
        else { const float act = gelu_as((float)di * su); if (st) CFp[off] = gm * act; }
    }
#undef US2_META
}
__device__ __forceinline__ void peer_vsweep2_panel(int panel, const bf16* X1B, bf16* X2B, LAS float* r3, const int* IDXp, const float* CFp, const unsigned char* EV8, const int wid0) {
    const int wid = wid0;
#ifndef STAG_V
#define STAG_V 40
#endif
    if (STAG_V && wid >= 4) __builtin_amdgcn_s_sleep(STAG_V);
#pragma nounroll
    for (int it = 0; it < 8; ++it) {
        const int dp = it >> 2, g2 = it & 3;
        const int lane = lane_id(); const int half = lane >> 5, li = lane & 31;
        const int lr0 = wid * 32 + 8 * g2;
        const int colb = 512 * dp + 16 * li;
        float o[4][16];
#pragma unroll
        for (int t = 0; t < 4; ++t) { const bf16* xp = X1B + (size_t)(lr0 + 4 * half + t) * DM + colb; const v4u a = *(const GAS v4u*)xp, b2 = *(const GAS v4u*)(xp + 8); H_UNPACK(o[t], a, b2); }
        const int mA = (lr0 + (lane >> 3)) * 128 + (lane & 7);
        int ix_n = IDXp[mA]; float cf_n = CFp[mA];
#pragma nounroll
        for (int c = 0; c < 16; ++c) {
            const int ix = ix_n; const float cf = cf_n;
            const int lane_c = lane_id(); const int half_c = lane_c >> 5;
            if (c < 15) { const int m2 = (lr0 + (lane_c >> 3)) * 128 + (lane_c & 7) + 8 * (c + 1); ix_n = IDXp[m2]; cf_n = CFp[m2]; }
            const int evo = 512 * dp + 16 * (lane_c & 31);
#ifndef VB
#define VB 8
#endif
            const int hb4 = (lane_c & 32) << 2;
            const int ix10 = ix << 10;
            int exo[32];
#pragma unroll
            for (int e = 0; e < 32; ++e) exo[e] = __builtin_amdgcn_ds_bpermute(hb4 + 4 * e, ix10) + evo;
            asm volatile("" : "+v"(exo[0]), "+v"(exo[1]), "+v"(exo[2]), "+v"(exo[3]), "+v"(exo[4]), "+v"(exo[5]), "+v"(exo[6]), "+v"(exo[7]), "+v"(exo[8]), "+v"(exo[9]), "+v"(exo[10]), "+v"(exo[11]), "+v"(exo[12]), "+v"(exo[13]), "+v"(exo[14]), "+v"(exo[15]));
            asm volatile("" : "+v"(exo[16]), "+v"(exo[17]), "+v"(exo[18]), "+v"(exo[19]), "+v"(exo[20]), "+v"(exo[21]), "+v"(exo[22]), "+v"(exo[23]), "+v"(exo[24]), "+v"(exo[25]), "+v"(exo[26]), "+v"(exo[27]), "+v"(exo[28]), "+v"(exo[29]), "+v"(exo[30]), "+v"(exo[31]));
#pragma unroll
            for (int tp = 0; tp < 32 / VB; ++tp) {
                v4u va[VB]; float cs[VB];
#pragma unroll
                for (int i = 0; i < VB; ++i) { const int e = VB * tp + i; va[i] = *(const GAS v4u*)(EV8 + (unsigned)exo[e]); }
#pragma unroll
                for (int i = 0; i < VB; ++i) { const int e = VB * tp + i; cs[i] = __builtin_bit_cast(float, __builtin_amdgcn_ds_bpermute(hb4 + 4 * e, __builtin_bit_cast(int, cf))); }
#pragma unroll
                for (int i = 0; i < VB; ++i) { const int e = VB * tp + i; fma16_fp8(o[e >> 3], cs[i], va[i]); }
            }
        }
        const int lane2 = lane_id(); const int half2 = lane2 >> 5, li2 = lane2 & 31;
#pragma unroll
        for (int t = 0; t < 4; ++t) {
            const int tok = lr0 + 4 * half2 + t;
            float ss = 0.f;
#pragma unroll
            for (int k = 0; k < 16; ++k) ss += o[t][k] * o[t][k];
#pragma unroll
            for (int m = 1; m < 32; m <<= 1) ss += shx(ss, m, lane2);
            if (li2 == 0) { if (dp == 0) r3[tok] = ss; else r3[tok] = 1.f / sqrtf((r3[tok] + ss) * (1.f / DM) + RMS_EPS); }
            v4u ha, hb;
            ha.x = cvtpk(o[t][0], o[t][1]); ha.y = cvtpk(o[t][2], o[t][3]); ha.z = cvtpk(o[t][4], o[t][5]); ha.w = cvtpk(o[t][6], o[t][7]);
            hb.x = cvtpk(o[t][8], o[t][9]); hb.y = cvtpk(o[t][10], o[t][11]); hb.z = cvtpk(o[t][12], o[t][13]); hb.w = cvtpk(o[t][14], o[t][15]);
            bf16* xo = X2B + (size_t)tok * DM + 512 * dp + 16 * li2;
            *(GAS v4u*)xo = ha; *(GAS v4u*)(xo + 8) = hb;
        }
    }
}


struct Args {
    const float *x, *p, *norm_mix, *w_in, *w_att_up, *w_pool_group, *pool_scale, *w_out, *norm_ffn, *w_query, *sub_keys, *expert_u, *expert_v, *norm_ple, *w_ple_gate, *w_ple, *norm_final;
    float* out; unsigned char* ws; int ph_hi, pad;
};

#ifndef REP_P0
#define REP_P0 1
#endif
#ifndef REP_P1
#define REP_P1 1
#endif
#ifndef REP_P23
#define REP_P23 1
#endif
#ifndef REP_P4
#define REP_P4 1
#endif
#ifndef REP_P567
#define REP_P567 1
#endif
#ifndef REP_P9
#define REP_P9 1
#endif
#ifndef REP_ATT
#define REP_ATT 1
#endif
#ifndef REP_TOPK
#define REP_TOPK 1
#endif
#ifndef REP_MRG
#define REP_MRG 1
#endif
#ifndef MK_PH_HI
#define MK_PH_HI 99
#endif

typedef const __attribute__((address_space(4))) Args* CArgs;
__device__ __forceinline__ CArgs kargs() { CArgs p = (CArgs)__builtin_amdgcn_kernarg_segment_ptr(); asm volatile("" : "+s"(p)); return p; }
#define WSP(T, off) ((T*)(kargs()->ws + (off)))
__global__ void __launch_bounds__(NTHR, 2) mega_fwd(Args a_unused) {
    extern __shared__ __attribute__((aligned(16))) unsigned char lds_raw[];
    LAS unsigned char* lds = (LAS unsigned char*)lds_raw;
    volatile LAS unsigned* MISC = (volatile LAS unsigned*)(lds + MISC_OFF);
    const int G = gridDim.x; const int bx = blockIdx.x;
    const int vcu = (G % 8 == 0) ? (bx % 8) * (G / 8) + bx / 8 : bx;
    gu32* ctl = (gu32*)(kargs()->ws + WS_CTL);
    const int wid0 = __builtin_amdgcn_readfirstlane((int)threadIdx.x >> 6);
#define IS_T0 (otid(wid0) == 0)
    for (int u = otid(wid0); u < (LDS_BYTES - LDSCTL_OFF) / 4; u += NTHR) ((LAS unsigned*)(lds + LDSCTL_OFF))[u] = 0u;
    __syncthreads();
    (void)xcd_barrier_post((unsigned*)(ctl + CW_BAR), MISC + 8, IS_T0);
#define GRID_BAR() do { XcdBarrier _b; _b.bar = (unsigned*)((gu32*)(kargs()->ws + WS_CTL) + CW_BAR); _b.x = xb_xcc_id(); _b.st = (volatile LAS unsigned*)(lds + MISC_OFF) + 8; xcd_barrier(_b, IS_T0); } while (0)
    LAS float* const SS1 = (LAS float*)(lds + LDSCTL_OFF + 1024);
    LAS float* const R3 = (LAS float*)(lds + LDSCTL_OFF + 2048);
    LAS float* const SSF = (LAS float*)(lds + LDSCTL_OFF + 3072);
    LAS float* const S1H = (LAS float*)(lds + LDSCTL_OFF + 4096);
#define LOCAL_SEAM() do { VM_WAIT(); __syncthreads(); if (IS_T0) { __builtin_amdgcn_fence(__ATOMIC_ACQUIRE, "agent"); VM_WAIT(); } __syncthreads(); } while (0)

    for (int rep_ = 0; rep_ < REP_P0; ++rep_) {
        const int tid = otid(wid0), lane = tid & 63, wid = __builtin_amdgcn_readfirstlane(tid >> 6);
        const CArgs a = kargs(); unsigned char* ws = a->ws;
        bf16 *WIN = (bf16*)(ws + WS_WIN), *WOUT = (bf16*)(ws + WS_WOUT), *WQ = (bf16*)(ws + WS_WQ), *WPG = (bf16*)(ws + WS_WPG), *WPLE = (bf16*)(ws + WS_WPLE);
        bf16 *BD2 = (bf16*)(ws + WS_BD2), *SK = (bf16*)(ws + WS_SK), *XN = (bf16*)(ws + WS_XN);
        LAS float* scr = (LAS float*)(lds + wid * 16384);
        const int gw = vcu * NWAVES + wid, NGW = G * NWAVES;
        unsigned* const CMAX = (unsigned*)((gu32*)(ws + WS_CTL) + CW_CMAX);
        constexpr int A_IN = 32 * (4096 / 64), A_Q = 32 * (2048 / 64), A_G = 32 * (1024 / 64);
        for (int it = gw; it < A_IN + A_Q + 2 * A_G; it += NGW) {
            if (it < A_IN) p0_colmax_item(a->w_in, 4096, CMAX, a->norm_mix, 512, C2, it, lane);
            else if (it < A_IN + A_Q) p0_colmax_item(a->w_query, 2048, CMAX + 4096, a->norm_ffn, 0, 1.f, it - A_IN, lane);
            else if (it < A_IN + A_Q + A_G) p0_colmax_item(a->w_ple_gate, 1024, CMAX + 6144, a->norm_ple, 0, 1.f, it - A_IN - A_Q, lane);
            else p0_colmax_item(a->w_out, 1024, CMAX + 7168, nullptr, 0, 1.f, it - A_IN - A_Q - A_G, lane);
        }
        constexpr int I_PLE = (256 / 64) * (1024 / 32);
        for (int it = gw; it < I_PLE; it += NGW) p0_transpose_item(a->w_ple, 256, 1024, WPLE, nullptr, 0, 1.f, scr, it, lane);
        const int gt = vcu * NTHR + tid, NGT = G * NTHR;
        for (int it = gt; it < 2048 * 32; it += NGT) {
            const int rr = it >> 5, k8 = (it & 31) * 8, ti = rr >> 8, r = rr & 255, n = 256 * (ti & 3) + 128 * (ti >> 2) + (r & 127), head = n >> 7, g = n >> 8;
            float v[8];
#pragma unroll
            for (int j = 0; j < 8; ++j) { const int k = (k8 + j) & 127;
                if (r < 128) v[j] = (k8 < 128 && (k >> 6) == (head & 1)) ? a->w_att_up[((size_t)head * 64 + (k & 63)) * 128 + (n & 127)] : 0.f;
                else v[j] = (k8 >= 128) ? a->w_pool_group[((size_t)g * 128 + k) * 256 + (n & 255)] * a->pool_scale[n] : 0.f; }
            v4u o; o.x = pk2(v[0], v[1]); o.y = pk2(v[2], v[3]); o.z = pk2(v[4], v[5]); o.w = pk2(v[6], v[7]);
            *(GAS v4u*)(BD2 + (size_t)rr * 256 + k8) = o;
        }
        for (int it = gt; it < 16 * 128 * 128 / 8; it += NGT) cvt8_store(a->sub_keys + (size_t)it * 8, SK + (size_t)it * 8);
        { const int panel = bx;
            for (int r = wid, e = gw; r < 64; r += NWAVES, e += NGW) { const size_t row = (size_t)panel * 256 + r;
                p0_rows4_expert(a->x + row * DM, ws + WS_XN + row * DM, (float*)(ws + WS_SX) + row, (size_t)64 * DM, 64,
                                a->expert_u + (size_t)e * DM, a->norm_ffn, ws + WS_EU + (size_t)e * DM, (float*)(ws + WS_SU) + e, a->expert_v + (size_t)e * DM, ws + WS_EV + (size_t)e * DM, (float*)(ws + WS_SV) + e, lane); } }
    }
    GRID_BAR();
    {
        const int tid = otid(wid0), lane = tid & 63, wid = __builtin_amdgcn_readfirstlane(tid >> 6);
        const CArgs a = kargs(); unsigned char* ws = a->ws;
        LAS float* scr = (LAS float*)(lds + wid * 16384);
        const int gw = vcu * NWAVES + wid, NGW = G * NWAVES;
        const unsigned* CMAX = (const unsigned*)((gu32*)(ws + WS_CTL) + CW_CMAX);
        constexpr int B_IN = 16 * (4096 / 32), B_Q = 16 * (2048 / 32), B_G = 16 * (1024 / 32);
        for (int it = gw; it < B_IN + B_Q + 2 * B_G; it += NGW) {
            if (it < B_IN) p0_quant_tile_item(a->w_in, 4096, ws + WS_WIN, (float*)(ws + WS_SBN), CMAX, a->norm_mix, 512, C2, scr, it, lane);
            else if (it < B_IN + B_Q) p0_quant_tile_item(a->w_query, 2048, ws + WS_WQ, (float*)(ws + WS_SBQ), CMAX + 4096, a->norm_ffn, 0, 1.f, scr, it - B_IN, lane);
            else if (it < B_IN + B_Q + B_G) p0_quant_tile_item(a->w_ple_gate, 1024, ws + WS_WPG, (float*)(ws + WS_SBG), CMAX + 6144, a->norm_ple, 0, 1.f, scr, it - B_IN - B_Q, lane);
            else p0_quant_tile_item(a->w_out, 1024, ws + WS_WOUT, (float*)(ws + WS_SBO), CMAX + 7168, nullptr, 0, 1.f, scr, it - B_IN - B_Q - B_G, lane);
        }
    }
    GRID_BAR();

    for (int rep_ = 0; rep_ < REP_P1; ++rep_) {
        const int xg = bx & 7, ig = bx >> 3, ug = ig >> 3;
#pragma nounroll
        for (int ph = 0; ph < 4; ++ph) {
            const int panel = xg + 8 * (8 * ph + (ig & 7));
            { pg8::Gemm g{WSP(bf16, WS_XN), WSP(bf16, WS_WIN), 1024, 1024, 1024, 0, 0, 1, 0}; pg8::PanelSched S{panel, ug < 3 ? 4 : 2, 4, 2, 0, 4 * ug};
              pg8::EpiProjI8 E{WSP(bf16, WS_PQ), WSP(bf16, WS_PK), WSP(bf16, WS_PU), WSP(bf16, WS_PG), WSP(float, WS_SX), WSP(float, WS_SBN)};
              pg8::gemm_phase_i8<pg8::EpiProjI8, pg8::PanelSched, true, true>(lds, g, S, E, wid0); }
            if (ug == 3) { pg8::Gemm g{(const bf16*)(kargs()->ws + WS_WIN + (size_t)1024 * 1024), WSP(bf16, WS_XN), 1024, 1024, 1024, 0, 0, 1, 0}; pg8::PanelSched S{panel, 2, 99, 0, 1, 0};
              pg8::EpiPlainI8 E{WSP(bf16, WS_PVT), TOK, WSP(float, WS_SBN) + 1024, WSP(float, WS_SX)};
              pg8::gemm_phase_i8<pg8::EpiPlainI8, pg8::PanelSched, true, true>(lds, g, S, E, wid0); }
        }
    }
    GRID_BAR();


#define H8P ((unsigned char*)(kargs()->ws + WS_MG + (size_t)panel * 524288 + 262144))
    { const int panel = bx;
        const size_t prow = (size_t)panel * 256;
        for (int rep_ = 0; rep_ < REP_P23; ++rep_) {
        if (MK_PH_HI > 2) { for (int r2_ = 0; r2_ < REP_ATT; ++r2_) attn_panel(panel, WSP(bf16, WS_PQ), WSP(bf16, WS_PK), WSP(bf16, WS_PVT), WSP(bf16, WS_YA), wid0); pool_panel(panel, WSP(bf16, WS_PU), WSP(bf16, WS_YA), wid0); LOCAL_SEAM(); }
        for (int r2_ = 0; r2_ < REP_MRG; ++r2_)
        if (MK_PH_HI > 3) {
            { pg8::Gemm g{WSP(bf16, WS_YA), WSP(bf16, WS_BD2), 256, 1024, 256, 256, 0, 1, 0}; pg8::PanelSched S{panel, 8, 99, 0, 0}; pg8::EpiMerge2 E{WSP(unsigned char, WS_PG), WSP(bf16, WS_MG)};
              pg8::gemm_phase<pg8::EpiMerge2, pg8::PanelSched, true, true>(lds, g, S, E, wid0); }
            LOCAL_SEAM();
        }
        }
        if (MK_PH_HI > 4) {
            peer_hq_panel<false>(WSP(bf16, WS_MG) + (size_t)panel * 262144, (unsigned char*)(kargs()->ws + WS_YA + (size_t)panel * 524288), SS1, S1H, wid0); LOCAL_SEAM();
            { pg8::Gemm g{WSP(bf16, WS_YA), WSP(bf16, WS_WOUT), 1024, 1024, 1024, 0, 0, 2, 0}; pg8::PanelSched S{panel, 4, 99, 0, 0};
              pg8::EpiResI8 E{kargs()->x, (bf16*)kargs()->out, SS1, S1H, WSP(float, WS_SBO)};
              pg8::gemm_phase_i8<pg8::EpiResI8, pg8::PanelSched, true, true>(lds, g, S, E, wid0); }
            LOCAL_SEAM();
        }
        { { const int t_ = otid(wid0); if (t_ < 256) SS1[t_] = 1.f / sqrtf(SS1[t_] * (1.f / DM) + RMS_EPS); } __syncthreads(); }
#ifndef REP_WQ
#define REP_WQ 1
#endif
        for (int rq_ = 0; rq_ < REP_WQ; ++rq_) {
        if (MK_PH_HI > 6) { peer_hq_panel((const bf16*)kargs()->out + (size_t)panel * 524288, H8P, SS1, S1H, wid0); LOCAL_SEAM(); }
        {
        if (MK_PH_HI > 6) {
            { pg8::Gemm g{(const bf16*)(kargs()->ws + WS_MG + 262144), WSP(bf16, WS_WQ), 1024, 1024, 1024, 0, 0, 2, 0}; pg8::PanelSched S{panel, 8, 99, 0, 0};
              pg8::EpiPlainScaleI8 E{WSP(bf16, WS_PG), 2048, S1H, WSP(float, WS_SBQ)};
              pg8::gemm_phase_i8<pg8::EpiPlainScaleI8, pg8::PanelSched, true, true>(lds, g, S, E, wid0); }
            LOCAL_SEAM();
        }
        } }
        {
        #define IDXP ((int*)(kargs()->ws + WS_YA + (size_t)panel * 524288))
#define GTP ((float*)(kargs()->ws + WS_YA + (size_t)panel * 524288 + 131072))
        if (MK_PH_HI > 7) { for (int r2_ = 0; r2_ < REP_TOPK; ++r2_) topk_panel(panel, WSP(bf16, WS_PG), WSP(bf16, WS_SK), IDXP, GTP, lds, wid0); LOCAL_SEAM(); }
        }
#ifndef PEER_SWEEP
#define PEER_SWEEP 1
#endif
#define CFP ((float*)(kargs()->ws + WS_YA + (size_t)panel * 524288 + 262144))
#define SUSP ((float*)(kargs()->ws + WS_MG + (size_t)panel * 524288))
        if (MK_PH_HI > 8) {
            if (PEER_SWEEP) {
#ifndef REP_SORT
#define REP_SORT 1
#endif
                for (int rs_ = 0; rs_ < REP_SORT; ++rs_) { peer_sort_panel(IDXP, GTP, SUSP, WSP(float, WS_SU), WSP(float, WS_SV), wid0); LOCAL_SEAM(); }
#ifndef REP_U
#define REP_U 1
#endif
#ifndef REP_V
#define REP_V 1
#endif
#ifndef UNP
#define UNP 2
#endif
                for (int ru_ = 0; ru_ < REP_U; ++ru_) {
#pragma nounroll
                    for (int dpu = 0; dpu < UNP; ++dpu) { peer_usweep2_panel<UNP>(dpu, H8P, S1H, IDXP, GTP, SUSP, CFP, WSP(unsigned char, WS_EU), wid0); LOCAL_SEAM(); } }
                for (int rv_ = 0; rv_ < REP_V; ++rv_)
                    peer_vsweep2_panel(panel, (const bf16*)kargs()->out + (size_t)panel * 524288, WSP(bf16, WS_PG) + (size_t)panel * 524288, R3, IDXP, CFP, WSP(unsigned char, WS_EV), wid0);
                LOCAL_SEAM();
            }
        }
        for (int rep_ = 0; rep_ < REP_P9; ++rep_)
        if (MK_PH_HI > 9) {
#define PBP ((bf16*)(kargs()->ws + WS_YA + (size_t)panel * 524288 + 393216))
            { const int tid = otid(wid0); const float* pp = kargs()->p; bf16* PB = PBP; for (int it = tid; it < 256 * 256 / 8; it += NTHR) { const int r = it >> 5, c8 = (it & 31) * 8; cvt8_store(pp + (prow + r) * 256 + c8, PB + r * 256 + c8); } }
            LOCAL_SEAM();
            { pg8::Gemm g{(const bf16*)(kargs()->ws + WS_YA + 393216), WSP(bf16, WS_WPLE), 256, 256, 256, 0, 0, 4, 0}; pg8::PanelSched S{panel, 4, 99, 0, 0};
              pg8::EpiPlain E{WSP(bf16, WS_MG), 1024};
              pg8::gemm_phase<pg8::EpiPlain, pg8::PanelSched, true, true>(lds, g, S, E, wid0); }
            LOCAL_SEAM();
        }
        if (MK_PH_HI > 10) {
#define X2I8 ((unsigned char*)(kargs()->ws + WS_PG + (size_t)panel * 1048576 + 524288))
            peer_hq_panel(WSP(bf16, WS_PG) + (size_t)panel * 524288, X2I8, R3, S1H, wid0); LOCAL_SEAM();
            { pg8::Gemm g{(const bf16*)(kargs()->ws + WS_PG + 524288), WSP(bf16, WS_WPG), 1024, 1024, 1024, 0, 0, 4, 0}; pg8::PanelSched S{panel, 4, 99, 0, 0};
              pg8::EpiGateI8 E{WSP(bf16, WS_YA), WSP(bf16, WS_PG), WSP(bf16, WS_MG), S1H, WSP(float, WS_SBG), SSF};
              pg8::gemm_phase_i8<pg8::EpiGateI8, pg8::PanelSched, true, true>(lds, g, S, E, wid0); }
            LOCAL_SEAM();
        }
        if (MK_PH_HI > 11) {
            const int tid = otid(wid0), lane = tid & 63, wid = __builtin_amdgcn_readfirstlane(tid >> 6);
            const GAS f32x4* gr = (const GAS f32x4*)kargs()->norm_final + lane;
            f32x4 gg[4];
#pragma unroll
            for (int j = 0; j < 4; ++j) gg[j] = gr[64 * j];
            const bf16* x3a = WSP(bf16, WS_YA);
            for (int r = wid; r < 64; r += NWAVES) {
                v2u v[4][4]; float rr[4];
#pragma unroll
                for (int k = 0; k < 4; ++k) { const bf16* xr = x3a + (prow + r + 64 * k) * 1024 + 4 * lane; rr[k] = 1.f / sqrtf(SSF[r + 64 * k] * (1.f / DM) + RMS_EPS);
#pragma unroll
                    for (int j = 0; j < 4; ++j) v[k][j] = *(const GAS v2u*)(xr + 256 * j); }
#pragma unroll
                for (int k = 0; k < 4; ++k) { GAS f32x4* xw = (GAS f32x4*)(kargs()->out + (prow + r + 64 * k) * DM) + lane;
#pragma unroll
                    for (int j = 0; j < 4; ++j) { f32x4 f; f[0] = bflo(v[k][j].x); f[1] = bfhi(v[k][j].x); f[2] = bflo(v[k][j].y); f[3] = bfhi(v[k][j].y); xw[64 * j] = f * rr[k] * gg[j]; } }
            }
        }
    }
#undef LOCAL_SEAM
}


extern "C" void kernel_launch(void* const* d_in, const int* in_sizes, int n_in, void* d_out, int out_size, void* d_ws, size_t ws_size, hipStream_t stream) {
    static int grid = 0;
    if (grid == 0) {
        if (n_in != 17 || in_sizes[0] != TOK * DM || out_size != TOK * DM || ws_size < WS_END) { fprintf(stderr, "kernel_launch: unexpected shapes (n_in %d, in0 %d, out %d, ws %zu); nothing launched\n", n_in, n_in > 0 ? in_sizes[0] : -1, out_size, ws_size); grid = -1; return; }
        int dev = 0, cus = 0;
        if (hipGetDevice(&dev) != hipSuccess || hipDeviceGetAttribute(&cus, hipDeviceAttributeMultiprocessorCount, dev) != hipSuccess) { fprintf(stderr, "kernel_launch: device query failed\n"); grid = -1; return; }
        if (hipFuncSetAttribute((const void*)mega_fwd, hipFuncAttributeMaxDynamicSharedMemorySize, LDS_BYTES) != hipSuccess) { fprintf(stderr, "kernel_launch: hipFuncSetAttribute failed\n"); grid = -1; return; }
        int per_cu = 0;
        if (hipOccupancyMaxActiveBlocksPerMultiprocessor(&per_cu, (const void*)mega_fwd, NTHR, LDS_BYTES) != hipSuccess || per_cu < 1) fprintf(stderr, "kernel_launch: note: occupancy query reports %d workgroups per CU\n", per_cu);
        (void)hipGetLastError();
        if (cus != NPANEL) fprintf(stderr, "kernel_launch: note: %d CUs; this kernel is built for one 256-token panel per CU on a 256-CU device\n", cus);
        grid = NPANEL;
    }
    if (grid < 0) return;
    if (hipMemsetAsync((char*)d_ws + WS_CTL, 0, CTL_ZERO_BYTES, stream) != hipSuccess) { fprintf(stderr, "kernel_launch: memset failed\n"); return; }
    Args a{};
    a.x = (const float*)d_in[0]; a.p = (const float*)d_in[1]; a.norm_mix = (const float*)d_in[2]; a.w_in = (const float*)d_in[3]; a.w_att_up = (const float*)d_in[4];
    a.w_pool_group = (const float*)d_in[5]; a.pool_scale = (const float*)d_in[6]; a.w_out = (const float*)d_in[7]; a.norm_ffn = (const float*)d_in[8]; a.w_query = (const float*)d_in[9];
    a.sub_keys = (const float*)d_in[10]; a.expert_u = (const float*)d_in[11]; a.expert_v = (const float*)d_in[12]; a.norm_ple = (const float*)d_in[13]; a.w_ple_gate = (const float*)d_in[14];
    a.w_ple = (const float*)d_in[15]; a.norm_final = (const float*)d_in[16];
    a.out = (float*)d_out; a.ws = (unsigned char*)d_ws; a.ph_hi = MK_PH_HI; a.pad = 0;
    hipLaunchKernelGGL(mega_fwd, dim3(grid), dim3(NTHR), LDS_BYTES, stream, a);
    { const hipError_t le = hipPeekAtLastError(); if (le != hipSuccess) fprintf(stderr, "kernel_launch: launch failed: %s\n", hipGetErrorName(le)); }
}
```
